# Optimizing an MI355X kernel written in HIP

```python
import math
import jax
import jax.numpy as jnp
from jax import lax
import numpy as np

D_MODEL = 1024
BATCH = 16
SEQ = 4096
DEPTH = 1

N_META = 16
BLOCK = 128
PAD = BLOCK - N_META
NEG = -1e30
LN_EPS = 1e-5

ATT_HEADS = 4
ATT_QK_DIM = 64
ATT_V_DIM = 2 * ATT_QK_DIM
ATT_WIDTH = ATT_HEADS * ATT_V_DIM
ROPE_THETA = 10000.0

ML_HEADS = 4
ML_DH = 128
ML_WIDTH = ML_HEADS * ML_DH
CONV_K = 4

N_EXPERTS = 32
TOP_K = 4
D_EXPERT = D_MODEL
SWIGLU_LIMIT = 7.0
SWIGLU_ALPHA = 1.702
MOE_BLOCK = 512

DN_ALPHA = (2 * DEPTH) ** 0.25
DN_BETA = (8 * DEPTH) ** -0.25

IN_SPLITS = (ATT_HEADS * 2 * ATT_QK_DIM, ATT_HEADS * 2 * ATT_QK_DIM, ATT_WIDTH,
             2 * ML_WIDTH, ML_WIDTH, ML_WIDTH, 2 * ML_HEADS, D_MODEL, D_MODEL)
N_IN = sum(IN_SPLITS)

kernel_name = 'hybrid_diffattn_mlstm_moe_block'


def layer_norm(x, g, b):
    xf = x.astype(jnp.float32)
    mu = jnp.mean(xf, axis=-1, keepdims=True)
    var = jnp.mean(jnp.square(xf - mu), axis=-1, keepdims=True)
    y = (xf - mu) * lax.rsqrt(var + LN_EPS) * g.astype(jnp.float32) + b.astype(jnp.float32)
    return y.astype(x.dtype)


def rms_norm(x, g):
    xf = x.astype(jnp.float32)
    y = xf * lax.rsqrt(jnp.mean(jnp.square(xf), axis=-1, keepdims=True) + LN_EPS) * g.astype(jnp.float32)
    return y.astype(x.dtype)


def rotary(x, pos):
    half = x.shape[-1] // 2
    inv_freq = ROPE_THETA ** (-jnp.arange(half, dtype=jnp.float32) / half)
    ang = pos.astype(jnp.float32)[:, None] * inv_freq[None, :]
    cos = jnp.cos(ang)[:, None, :]
    sin = jnp.sin(ang)[:, None, :]
    xf = x.astype(jnp.float32)
    x1, x2 = xf[..., :half], xf[..., half:]
    return jnp.concatenate([x1 * cos - x2 * sin, x2 * cos + x1 * sin], axis=-1).astype(x.dtype)


def causal_conv(x, w, b):
    y = lax.conv_general_dilated(x, w[:, None, :], window_strides=(1,), padding=((CONV_K - 1, 0),),
                                 dimension_numbers=('NWC', 'WIO', 'NWC'),
                                 feature_group_count=x.shape[-1])
    return y + b


def diff_attention(q, k, v, lam, lambda_init, norm_g):
    B, T = q.shape[0], q.shape[1]
    Tp = T + PAD
    def pad(a):
        return jnp.pad(a, ((0, 0), (PAD, 0)) + ((0, 0),) * (a.ndim - 2))
    qh = pad(q).transpose(0, 2, 3, 1, 4)
    kh = pad(k).transpose(0, 2, 3, 1, 4)
    vh = pad(v).transpose(0, 2, 1, 3)
    key_idx = jnp.arange(Tp)
    scale = ATT_QK_DIM ** -0.5

    def one_block(start):
        qb = lax.dynamic_slice_in_dim(qh, start, BLOCK, axis=3)
        s = jnp.einsum('bhmqd,bhmkd->bhmqk', qb, kh).astype(jnp.float32) * scale
        q_idx = start + jnp.arange(BLOCK)
        mask = (key_idx[None, :] <= q_idx[:, None]) & (key_idx[None, :] >= PAD)
        p = jax.nn.softmax(jnp.where(mask, s, NEG), axis=-1)
        a = p[:, :, 0] - lam * p[:, :, 1]
        return jnp.einsum('bhqk,bhke->bqhe', a.astype(vh.dtype), vh)

    starts = jnp.arange(Tp // BLOCK) * BLOCK
    o = lax.map(one_block, starts)
    o = o.transpose(1, 0, 2, 3, 4).reshape(B, Tp, ATT_HEADS, ATT_V_DIM)[:, PAD:]
    o = rms_norm(o, norm_g) * (1.0 - lambda_init)
    return o.reshape(B, T, ATT_WIDTH)


def mlstm_chunk(carry, inp):
    C, n, m = carry
    q, k, v, ig, lf = inp
    causal = jnp.tril(jnp.ones((BLOCK, BLOCK), dtype=bool))
    b = jnp.cumsum(lf, axis=-1)
    dlog = jnp.where(causal, b[..., :, None] - b[..., None, :] + ig[..., None, :], NEG)
    inter = b + m[..., None]
    m_s = jnp.maximum(inter, jnp.max(dlog, axis=-1))
    w_intra = jnp.exp(dlog - m_s[..., None])
    w_inter = jnp.exp(inter - m_s)
    s = jnp.einsum('bhsd,bhrd->bhsr', q, k) * w_intra
    num = w_inter[..., None] * jnp.einsum('bhed,bhsd->bhse', C, q) + jnp.einsum('bhsr,bhre->bhse', s, v)
    den = w_inter * jnp.einsum('bhd,bhsd->bhs', n, q) + jnp.sum(s, axis=-1)
    h = num / jnp.maximum(jnp.abs(den), jnp.exp(-m_s))[..., None]
    b_last = b[..., -1]
    upd = b_last[..., None] - b + ig
    m_new = jnp.maximum(b_last + m, jnp.max(upd, axis=-1))
    w_old = jnp.exp(b_last + m - m_new)
    w_r = jnp.exp(upd - m_new[..., None])
    C_new = w_old[..., None, None] * C + jnp.einsum('bhre,bhrd->bhed', v * w_r[..., None], k)
    n_new = w_old[..., None] * n + jnp.einsum('bhr,bhrd->bhd', w_r, k)
    return (C_new, n_new, m_new), h


def mlstm(q, k, v, ig, lf):
    B, T = q.shape[0], q.shape[1]
    Tp = T + PAD
    nc = Tp // BLOCK
    def chunks(a, fill):
        a = jnp.pad(a.astype(jnp.float32), ((0, 0), (PAD, 0)) + ((0, 0),) * (a.ndim - 2),
                    constant_values=fill)
        a = a.reshape((B, nc, BLOCK) + a.shape[2:])
        return jnp.swapaxes(jnp.swapaxes(a, 0, 1), 2, 3)
    qc = chunks(q, 0.0)
    kc = chunks(k * (ML_DH ** -0.5), 0.0)
    vc = chunks(v, 0.0)
    igc = chunks(ig, NEG)
    lfc = chunks(lf, 0.0)
    init = (jnp.zeros((B, ML_HEADS, ML_DH, ML_DH), jnp.float32),
            jnp.zeros((B, ML_HEADS, ML_DH), jnp.float32),
            jnp.zeros((B, ML_HEADS), jnp.float32))
    _, h = lax.scan(mlstm_chunk, init, (qc, kc, vc, igc, lfc))
    h = jnp.swapaxes(jnp.swapaxes(h, 2, 3), 0, 1).reshape(B, Tp, ML_HEADS, ML_DH)[:, PAD:]
    return h


def hybrid_mixer(h, pos, lambda_init, w_in, conv_w, conv_b, gate_bias, lam_q1, lam_k1, lam_q2, lam_k2,
                 att_norm_g, ml_norm_g, w_att_out, w_ml_out, w_o):
    B, T, _ = h.shape
    z = h @ w_in
    aq, ak, av, mqk, mv, mo, mgate, ga, gm = jnp.split(z, np.cumsum(IN_SPLITS)[:-1].tolist(), axis=-1)
    aq = rotary(aq.reshape(B, T, 2 * ATT_HEADS, ATT_QK_DIM), pos).reshape(B, T, ATT_HEADS, 2, ATT_QK_DIM)
    ak = rotary(ak.reshape(B, T, 2 * ATT_HEADS, ATT_QK_DIM), pos).reshape(B, T, ATT_HEADS, 2, ATT_QK_DIM)
    lam = (jnp.exp(jnp.sum(lam_q1.astype(jnp.float32) * lam_k1.astype(jnp.float32)))
           - jnp.exp(jnp.sum(lam_q2.astype(jnp.float32) * lam_k2.astype(jnp.float32))) + lambda_init)
    y_att = diff_attention(aq, ak, av.reshape(B, T, ATT_HEADS, ATT_V_DIM), lam, lambda_init, att_norm_g)
    mqk = jax.nn.silu(causal_conv(mqk, conv_w, conv_b))
    mq, mk = jnp.split(mqk, 2, axis=-1)
    gates = mgate.astype(jnp.float32) + gate_bias.astype(jnp.float32)
    ig = gates[..., :ML_HEADS]
    lf = jax.nn.log_sigmoid(gates[..., ML_HEADS:])
    hm = mlstm(mq.reshape(B, T, ML_HEADS, ML_DH), mk.reshape(B, T, ML_HEADS, ML_DH),
               mv.reshape(B, T, ML_HEADS, ML_DH), ig, lf)
    hm = rms_norm(hm, ml_norm_g.reshape(ML_HEADS, ML_DH)).astype(h.dtype)
    y_ml = jax.nn.sigmoid(mo) * hm.reshape(B, T, ML_WIDTH)
    merged = jax.nn.sigmoid(ga) * (y_att @ w_att_out) + jax.nn.sigmoid(gm) * (y_ml @ w_ml_out)
    return merged @ w_o


def moe(x, w_router, b_router, w_gu, b_gu, w_down, b_down):
    N, D = x.shape
    logits = x.astype(jnp.float32) @ w_router.astype(jnp.float32) + b_router.astype(jnp.float32)
    top_val, top_idx = lax.top_k(logits, TOP_K)
    gate = jax.nn.softmax(top_val, axis=-1)
    M = N * TOP_K
    e_flat = top_idx.reshape(M).astype(jnp.int32)
    t_flat = jnp.repeat(jnp.arange(N, dtype=jnp.int32), TOP_K)
    order = jnp.argsort(e_flat)
    e_s, t_s, g_s = e_flat[order], t_flat[order], gate.reshape(M)[order]
    counts = jnp.bincount(e_flat, length=N_EXPERTS)
    starts = jnp.cumsum(counts) - counts
    padded = (counts + MOE_BLOCK - 1) // MOE_BLOCK * MOE_BLOCK
    pends = jnp.cumsum(padded)
    pstarts = pends - padded
    dest = pstarts[e_s] + jnp.arange(M, dtype=jnp.int32) - starts[e_s]
    nb = -(-(M + N_EXPERTS * (MOE_BLOCK - 1)) // MOE_BLOCK)
    tok_buf = jnp.full((nb * MOE_BLOCK,), N, jnp.int32).at[dest].set(t_s).reshape(nb, MOE_BLOCK)
    gate_buf = jnp.zeros((nb * MOE_BLOCK,), jnp.float32).at[dest].set(g_s).reshape(nb, MOE_BLOCK)
    blk_exp = jnp.minimum(jnp.searchsorted(pends, jnp.arange(nb, dtype=jnp.int32) * MOE_BLOCK, side='right'),
                          N_EXPERTS - 1)
    x_ext = jnp.concatenate([x, jnp.zeros((1, D), x.dtype)], axis=0)

    def expert_block(acc, inp):
        toks, g, e = inp
        hid = x_ext[toks] @ w_gu[e] + b_gu[e]
        glu = jnp.minimum(hid[:, ::2], SWIGLU_LIMIT)
        lin = jnp.clip(hid[:, 1::2], -SWIGLU_LIMIT, SWIGLU_LIMIT)
        act = glu * jax.nn.sigmoid(SWIGLU_ALPHA * glu) * (lin + 1.0)
        y = (act @ w_down[e] + b_down[e]) * g.astype(x.dtype)[:, None]
        return acc.at[toks].add(y.astype(acc.dtype)), None

    acc, _ = lax.scan(expert_block, jnp.zeros((N + 1, D), x.dtype), (tok_buf, gate_buf, blk_exp))
    return acc[:N]


def setup_inputs(seed: int = 0) -> dict:
    key = jax.random.key(seed)
    ks = jax.random.split(key, 32)
    f32 = jnp.float32
    L, D, E, F = DEPTH, D_MODEL, N_EXPERTS, D_EXPERT

    def nrm(k, shape, scale):
        return jax.random.normal(k, shape, f32) * scale

    f_bias = jnp.linspace(3.0, 6.0, ML_HEADS, dtype=f32)[None, :] + nrm(ks[7], (L, ML_HEADS), 0.1)
    i_bias = nrm(ks[8], (L, ML_HEADS), 0.1)
    return {
        'x': nrm(ks[0], (BATCH, SEQ, D), 1.0),
        'meta': nrm(ks[1], (N_META, D), 1.0),
        'emb_ln_g': 1.0 + nrm(ks[2], (D,), 0.02),
        'emb_ln_b': nrm(ks[3], (D,), 0.02),
        'w_in': nrm(ks[4], (L, D, N_IN), D ** -0.5),
        'conv_w': nrm(ks[5], (L, CONV_K, 2 * ML_WIDTH), CONV_K ** -0.5),
        'conv_b': nrm(ks[6], (L, 2 * ML_WIDTH), 0.02),
        'gate_bias': jnp.concatenate([i_bias, f_bias], axis=-1),
        'lam_q1': nrm(ks[9], (L, ATT_QK_DIM), 0.1),
        'lam_k1': nrm(ks[10], (L, ATT_QK_DIM), 0.1),
        'lam_q2': nrm(ks[11], (L, ATT_QK_DIM), 0.1),
        'lam_k2': nrm(ks[12], (L, ATT_QK_DIM), 0.1),
        'att_norm_g': 1.0 + nrm(ks[13], (L, ATT_V_DIM), 0.02),
        'ml_norm_g': 1.0 + nrm(ks[14], (L, ML_WIDTH), 0.02),
        'w_att_out': nrm(ks[15], (L, ATT_WIDTH, D), ATT_WIDTH ** -0.5 * DN_BETA),
        'w_ml_out': nrm(ks[16], (L, ML_WIDTH, D), ML_WIDTH ** -0.5 * DN_BETA),
        'w_o': nrm(ks[17], (L, D, D), D ** -0.5 * DN_BETA),
        'ln1_g': 1.0 + nrm(ks[18], (L, D), 0.02),
        'ln1_b': nrm(ks[19], (L, D), 0.02),
        'w_router': nrm(ks[20], (L, D, E), D ** -0.5),
        'b_router': nrm(ks[21], (L, E), 0.01),
        'w_gu': nrm(ks[22], (L, E, D, 2 * F), D ** -0.5),
        'b_gu': nrm(ks[23], (L, E, 2 * F), 0.02),
        'w_down': nrm(ks[24], (L, E, F, D), F ** -0.5 * DN_BETA),
        'b_down': nrm(ks[25], (L, E, D), 0.02),
        'ln2_g': 1.0 + nrm(ks[26], (L, D), 0.02),
        'ln2_b': nrm(ks[27], (L, D), 0.02),
    }


def reference(x, meta, emb_ln_g, emb_ln_b, w_in, conv_w, conv_b, gate_bias, lam_q1, lam_k1, lam_q2, lam_k2,
              att_norm_g, ml_norm_g, w_att_out, w_ml_out, w_o, ln1_g, ln1_b, w_router, b_router,
              w_gu, b_gu, w_down, b_down, ln2_g, ln2_b):
    B = x.shape[0]
    h = jnp.concatenate([jnp.broadcast_to(meta[None], (B, N_META, D_MODEL)).astype(x.dtype), x], axis=1)
    h = layer_norm(h, emb_ln_g, emb_ln_b)
    T = h.shape[1]
    pos = jnp.arange(T)
    for l in range(DEPTH):
        lambda_init = 0.8 - 0.6 * math.exp(-0.3 * l)
        mix = hybrid_mixer(h, pos, lambda_init, w_in[l], conv_w[l], conv_b[l], gate_bias[l],
                           lam_q1[l], lam_k1[l], lam_q2[l], lam_k2[l], att_norm_g[l], ml_norm_g[l],
                           w_att_out[l], w_ml_out[l], w_o[l])
        h = layer_norm(DN_ALPHA * h + mix, ln1_g[l], ln1_b[l])
        ffn = moe(h.reshape(B * T, D_MODEL), w_router[l], b_router[l], w_gu[l], b_gu[l],
                  w_down[l], b_down[l]).reshape(B, T, D_MODEL)
        h = layer_norm(DN_ALPHA * h + ffn, ln2_g[l], ln2_b[l])
    return h[:, N_META:]
```

```cpp
#include <hip/hip_runtime.h>
#include <hip/hip_bf16.h>
#include <cstdio>
#include <cstdint>
#include <cmath>

#ifndef MK_PER_PHASE
#define MK_PER_PHASE 0
#endif

#define LAS __attribute__((address_space(3)))
#define GAS __attribute__((address_space(1)))
typedef unsigned short bf16_t;
typedef short bf16x8 __attribute__((ext_vector_type(8)));
typedef float f32x4 __attribute__((ext_vector_type(4)));
typedef float f32x2 __attribute__((ext_vector_type(2)));
typedef unsigned u32x4 __attribute__((ext_vector_type(4)));
typedef unsigned u32x2 __attribute__((ext_vector_type(2)));
typedef __bf16 bf16x2_t __attribute__((ext_vector_type(2)));
#define RLX_AGENT __ATOMIC_RELAXED, __HIP_MEMORY_SCOPE_AGENT

constexpr int NB = 16, SEQ = 4096, NMETA = 16, TT = SEQ + NMETA  , MROWS = NB * TT  , DM = 1024;
constexpr int NZ = 5632;
constexpr int ZQ = 0, ZK = 512, ZV = 1024, ZMQ = 1536, ZMK = 2048, ZMV = 2560, ZMO = 3072, ZGA = 3584, ZGM = 4608;
constexpr int ZYC = 0, ZTMP = 1024, ZMRG = 2048;
constexpr int NIN = 5640;
constexpr int NE = 32, FF = 1024;
constexpr int OROWS = 4352;
constexpr float LN_EPS = 1e-5f;
constexpr float DN_ALPHA = 1.189207115002721f;
constexpr float LAMBDA_INIT = 0.2f;
constexpr float ATT_C2 = 0.125f * 1.4426950408889634f;

constexpr size_t MiB = 1u << 20;
constexpr size_t WS_CTL = 0, CTL_ZERO_BYTES = 1 * MiB;
constexpr size_t WS_WIN = 2 * MiB;
constexpr size_t WS_WA = 13 * MiB;
constexpr size_t WS_WM = 14 * MiB;
constexpr size_t WS_WO = 15 * MiB;
constexpr size_t WS_ROPE = 17 * MiB;
constexpr size_t WS_STATS = 19 * MiB;
constexpr size_t WS_GATES = 20 * MiB;
constexpr size_t WS_TOKE = 23 * MiB;
constexpr size_t WS_TOKG = 24 * MiB + 512 * 1024;
constexpr size_t WS_HIST = 26 * MiB;
constexpr size_t WS_ROWOFF = 27 * MiB;
constexpr size_t WS_ROWSLOT = 28 * MiB + 512 * 1024;
constexpr size_t WS_ROWGATE = 30 * MiB;
constexpr size_t WS_TILEEXP = 31 * MiB + 512 * 1024;
constexpr size_t WS_H = 32 * MiB;
constexpr size_t WS_Z = 162 * MiB;
constexpr size_t WS_Y = WS_Z;
constexpr size_t WS_ACT = WS_Z + 516 * MiB;
constexpr size_t WS_END = 1024 * MiB;
constexpr size_t DO_O = 0;
constexpr size_t DO_HM = 136 * MiB;
constexpr size_t DO_WGU = 0;
constexpr size_t DO_WDN = 128 * MiB;
constexpr int CW_TMO = 0, CW_NT = 64, CW_BAR = 4096;

constexpr int LDS_BYTES = 147456;
constexpr int MISC_OFF = 147456 - 512;
constexpr int NWAVES = 8;

__device__ __forceinline__ unsigned pkbf(float lo, float hi) { f32x2 v = {lo, hi}; bf16x2_t b = __builtin_convertvector(v, bf16x2_t); return __builtin_bit_cast(unsigned, b); }
__device__ __forceinline__ float bflo(unsigned w) { return __uint_as_float(w << 16); }
__device__ __forceinline__ float bfhi(unsigned w) { return __uint_as_float(w & 0xffff0000u); }
__device__ __forceinline__ float sigmoidf_(float x) { return __builtin_amdgcn_rcpf(1.0f + __expf(-x)); }
__device__ __forceinline__ float wave_sum(float v) {
#pragma unroll
    for (int o = 1; o < 64; o <<= 1) v += __shfl_xor(v, o);
    return v;
}
__device__ __forceinline__ float wave_max(float v) {
#pragma unroll
    for (int o = 1; o < 64; o <<= 1) v = fmaxf(v, __shfl_xor(v, o));
    return v;
}
__device__ __forceinline__ int ld_agent_i(const int* p) { return __hip_atomic_load(p, RLX_AGENT); }
__device__ __forceinline__ float ld_agent_f(const float* p) { return __hip_atomic_load(p, RLX_AGENT); }
#define LDS_WAIT() asm volatile("s_waitcnt lgkmcnt(0)" ::: "memory")
__device__ __forceinline__ const void* ldptr(LAS const unsigned long long* t, int i) { const unsigned long long v = t[i];
    const unsigned lo = (unsigned)__builtin_amdgcn_readfirstlane((int)(unsigned)v), hi = (unsigned)__builtin_amdgcn_readfirstlane((int)(unsigned)(v >> 32));
    return (const void*)(const GAS void*)(((unsigned long long)hi << 32) | lo); }

namespace pg8 {
constexpr int BM = 256, BK = 64, HALF = 128, HTB = HALF * BK * 2, STAGE_BYTES = 8 * HTB, NXCD = 8, WGM = 8;
__host__ __device__ __forceinline__ int lds_byte(int r, int c) { const int st = (r >> 4) * 2 + (c >> 5), rr = r & 15, cc = c & 31, ob = rr * 64 + cc * 2; return st * 1024 + (ob ^ (((ob >> 9) & 1) << 5)); }
__host__ __device__ __forceinline__ void stage_rc(int b, int& R, int& C) { const int st = b / 1024, sb = b % 1024, swz = sb ^ (((sb >> 9) & 1) << 5); R = (st >> 1) * 16 + swz / 64; C = (st & 1) * 32 + (swz % 64) / 2; }
__host__ __device__ __forceinline__ int perm32(int rho) { const int n = rho >> 4, i = rho & 15; return 8 * (i >> 2) + 4 * n + (i & 3); }

struct Unit { int pm, pn; };
struct Gemm { const bf16_t* A; const bf16_t* Bt; int lda, K, nN; const int* row_off; const int* tile_exp; int pm0; };
struct StaticOrder {
    int nM, nN, nwg, G, c;
    __device__ __forceinline__ void init(int nM_, int nN_, int G_, int c_) { nM = nM_; nN = nN_; nwg = nM * nN; G = G_; c = c_; }
    __device__ __forceinline__ bool next(int i, Unit& u) const {
        const long L = (long)i * G + c; if (L >= nwg) return false;
        int wgid = (int)L; { const int q = nwg / NXCD, r = nwg % NXCD, xcd = wgid % NXCD, off = wgid / NXCD; wgid = (xcd < r ? xcd * (q + 1) : r * (q + 1) + (xcd - r) * q) + off; }
        const int nig = WGM * nN, gid = wgid / nig, fm = gid * WGM, gsz = (nM - fm) < WGM ? (nM - fm) : WGM;
        u.pm = fm + ((wgid % nig) % gsz); u.pn = (wgid % nig) / gsz; return true;
    }
};

template <int MODE, class Epi>
__device__ __forceinline__ void gemm_phase(LAS unsigned char* lds, const Gemm g, const StaticOrder& S, const Epi& E) {
    const int tid = threadIdx.x, wid = __builtin_amdgcn_readfirstlane(tid >> 6), lane = tid & 63, wr = wid >> 2, wc = wid & 3, fr = lane & 15, fq = lane >> 4;
    const int K = g.K, nt = K / BK;
    unsigned voffA[2], voffB[2]; int Rst[2], Cst[2];
#pragma unroll
    for (int i = 0; i < 2; ++i) { int R, C; stage_rc(tid * 16 + i * 8192, R, C); const int Rb = Epi::PERM ? ((R & ~31) + perm32(R & 31)) : R;
        voffA[i] = (unsigned)(R * g.lda + C) * 2u; voffB[i] = (unsigned)(Rb * K + C) * 2u; Rst[i] = R; Cst[i] = C * 2; }
    const size_t kstep = (size_t)(BK * 2);
    const size_t hstepA = (size_t)HALF * g.lda * 2, hstepB = (size_t)HALF * K * 2;
    const size_t tstepA = 2 * hstepA, tstepB = 2 * hstepB;
    const unsigned ldsw = (unsigned)wid * 1024u;
    const int aoff = lds_byte(wr * 64 + fr, fq * 8), boff = lds_byte(wc * 32 + fr, fq * 8);
    unsigned vC[2][2] = {{0u, 0u}, {0u, 0u}}, vN[2][2] = {{0u, 0u}, {0u, 0u}};
#define PG8_SA(b, h) (((b) * 2 + (h)) * HTB)
#define PG8_SB(b, h) ((4 + (b) * 2 + (h)) * HTB)
#define PG8_STAGE_B(bufoff, gbase) do { _Pragma("unroll") for (int _i = 0; _i < 2; ++_i) \
        __builtin_amdgcn_global_load_lds((const unsigned*)((const char*)(gbase) + voffB[_i]), (LAS unsigned*)(lds + (bufoff) + ldsw + _i * 8192), 16, 0, 0); } while (0)
#define PG8_STAGE_A(bufoff, gbase, h, nx) do { _Pragma("unroll") for (int _i = 0; _i < 2; ++_i) { \
        const char* _p = (MODE == 1) ? ((const char*)(gbase) + ((nx) ? vN[h][_i] : vC[h][_i])) : ((const char*)(gbase) + (h) * hstepA + voffA[_i]); \
        __builtin_amdgcn_global_load_lds((const unsigned*)_p, (LAS unsigned*)(lds + (bufoff) + ldsw + _i * 8192), 16, 0, 0); } } while (0)
#define PG8_LDA(dst, b, h) do { _Pragma("unroll") for (int m = 0; m < 4; ++m) _Pragma("unroll") for (int k = 0; k < 2; ++k) dst[m][k] = *(const LAS bf16x8*)(lds + PG8_SA(b, h) + aoff + m * 2048 + k * 1024); } while (0)
#define PG8_LDB(dst, b, h) do { _Pragma("unroll") for (int n = 0; n < 2; ++n) _Pragma("unroll") for (int k = 0; k < 2; ++k) dst[n][k] = *(const LAS bf16x8*)(lds + PG8_SB(b, h) + boff + n * 2048 + k * 1024); } while (0)
#define PG8_MMA(ai, bj, At, Bt) do { __builtin_amdgcn_s_setprio(1); _Pragma("unroll") for (int m = 0; m < 4; ++m) _Pragma("unroll") for (int n = 0; n < 2; ++n) _Pragma("unroll") for (int k = 0; k < 2; ++k) \
        acc[ai][bj][m][n] = __builtin_amdgcn_mfma_f32_16x16x32_bf16(Bt[n][k], At[m][k], acc[ai][bj][m][n], 0, 0, 0); __builtin_amdgcn_s_setprio(0); } while (0)
#define PG8_WAIT_V(n) asm volatile("s_waitcnt vmcnt(" #n ")" ::: "memory")
#define PG8_WAIT_L(n) asm volatile("s_waitcnt lgkmcnt(" #n ")" ::: "memory")
#define PG8_BAR __builtin_amdgcn_s_barrier()
#define PG8_SCHED __builtin_amdgcn_sched_barrier(0)
#define PG8_ABASE(u) ((MODE == 1) ? (const char*)g.A : (const char*)g.A + (size_t)(u).pm * tstepA)
#define PG8_BBASE(u) ((MODE == 0) ? (const char*)g.Bt + (size_t)(u).pn * tstepB : (const char*)g.Bt + ((size_t)__builtin_amdgcn_readfirstlane(ld_agent_i(g.tile_exp + g.pm0 + (u).pm)) * g.nN + (u).pn) * tstepB)
#define PG8_GATHER(dst, u) do { if (MODE == 1) { _Pragma("unroll") for (int _h = 0; _h < 2; ++_h) _Pragma("unroll") for (int _i = 0; _i < 2; ++_i) \
        dst[_h][_i] = (unsigned)ld_agent_i(g.row_off + (size_t)(g.pm0 + (u).pm) * BM + _h * HALF + Rst[_i]) + (unsigned)Cst[_i]; } } while (0)
    Unit cur, nxt; int ui = 0;
    if (!S.next(0, cur)) return;
    f32x4 acc[2][2][4][2];
#pragma unroll
    for (int a = 0; a < 2; ++a)
#pragma unroll
        for (int b = 0; b < 2; ++b)
#pragma unroll
            for (int m = 0; m < 4; ++m)
#pragma unroll
                for (int n = 0; n < 2; ++n) acc[a][b][m][n] = (f32x4){0.f, 0.f, 0.f, 0.f};
    bf16x8 At[4][2], B0[2][2], B1[2][2];
    const char* cA = PG8_ABASE(cur); const char* cB = PG8_BBASE(cur);
    PG8_GATHER(vC, cur);
    PG8_STAGE_B(PG8_SB(0, 0), cB); PG8_STAGE_B(PG8_SB(0, 1), cB + hstepB); PG8_STAGE_A(PG8_SA(0, 0), cA, 0, false); PG8_STAGE_A(PG8_SA(0, 1), cA, 1, false);
    if (wr == 1) PG8_BAR;
    PG8_WAIT_V(2); PG8_BAR;
    PG8_STAGE_B(PG8_SB(1, 0), cB + kstep); PG8_STAGE_A(PG8_SA(1, 0), cA + kstep, 0, false); PG8_STAGE_B(PG8_SB(1, 1), cB + hstepB + kstep);
    PG8_WAIT_V(6); PG8_BAR;
    for (;;) {
        const bool has_next = S.next(ui + 1, nxt);
        const char* nA = has_next ? PG8_ABASE(nxt) : cA; const char* nB = has_next ? PG8_BBASE(nxt) : cB;
        if (MODE == 1) { if (has_next) { PG8_GATHER(vN, nxt); } else {
#pragma unroll
            for (int _h = 0; _h < 2; ++_h)
#pragma unroll
                for (int _i = 0; _i < 2; ++_i) vN[_h][_i] = vC[_h][_i]; } }
        for (int t = 0; t < nt; t += 2) {
            const bool last = (t == nt - 2);
            const char* a1 = cA + (size_t)(t + 1) * kstep;
            const char* a2 = last ? nA : cA + (size_t)(t + 2) * kstep; const char* b2 = last ? nB : cB + (size_t)(t + 2) * kstep;
            const char* a3 = a2 + kstep; const char* b3 = b2 + kstep;
            PG8_LDB(B0, 0, 0); PG8_LDB(B1, 0, 1); PG8_SCHED; PG8_LDA(At, 0, 0); PG8_STAGE_A(PG8_SA(1, 1), a1, 1, false);
            PG8_WAIT_V(8); PG8_WAIT_L(0); PG8_BAR; PG8_MMA(0, 0, At, B0); PG8_MMA(0, 1, At, B1); PG8_BAR; PG8_SCHED;
            PG8_LDA(At, 0, 1); PG8_STAGE_B(PG8_SB(0, 0), b2); PG8_STAGE_B(PG8_SB(0, 1), b2 + hstepB); PG8_STAGE_A(PG8_SA(0, 0), a2, 0, last);
            PG8_WAIT_V(8); PG8_WAIT_L(0); PG8_BAR; PG8_MMA(1, 0, At, B0); PG8_MMA(1, 1, At, B1); PG8_BAR; PG8_SCHED;
            PG8_LDB(B0, 1, 0); PG8_LDB(B1, 1, 1); PG8_SCHED; PG8_LDA(At, 1, 0); PG8_STAGE_A(PG8_SA(0, 1), a2, 1, last);
            PG8_WAIT_V(8); PG8_WAIT_L(0); PG8_BAR; PG8_MMA(0, 0, At, B0); PG8_MMA(0, 1, At, B1); PG8_BAR; PG8_SCHED;
            PG8_LDA(At, 1, 1); PG8_STAGE_B(PG8_SB(1, 0), b3); PG8_STAGE_B(PG8_SB(1, 1), b3 + hstepB); PG8_STAGE_A(PG8_SA(1, 0), a3, 0, last);
            PG8_WAIT_V(8); PG8_WAIT_L(0); PG8_BAR; PG8_MMA(1, 0, At, B0); PG8_MMA(1, 1, At, B1); PG8_BAR; PG8_SCHED;
        }
        if (wr == 0) PG8_BAR;
        E(acc, cur, wr, wc, fr, fq);
        if (!has_next) break;
#pragma unroll
        for (int a = 0; a < 2; ++a)
#pragma unroll
            for (int b = 0; b < 2; ++b)
#pragma unroll
                for (int m = 0; m < 4; ++m)
#pragma unroll
                    for (int n = 0; n < 2; ++n) acc[a][b][m][n] = (f32x4){0.f, 0.f, 0.f, 0.f};
        cur = nxt; cA = nA; cB = nB; ++ui;
        if (MODE == 1) {
#pragma unroll
            for (int _h = 0; _h < 2; ++_h)
#pragma unroll
                for (int _i = 0; _i < 2; ++_i) vC[_h][_i] = vN[_h][_i]; }
        if (wr == 1) PG8_BAR;
    }
    PG8_WAIT_V(0);
    PG8_BAR;
#undef PG8_SA
#undef PG8_SB
#undef PG8_STAGE_A
#undef PG8_STAGE_B
#undef PG8_LDA
#undef PG8_LDB
#undef PG8_MMA
#undef PG8_WAIT_V
#undef PG8_WAIT_L
#undef PG8_BAR
#undef PG8_SCHED
#undef PG8_ABASE
#undef PG8_BBASE
#undef PG8_GATHER
}

struct EpiZ {
    static constexpr bool PERM = true;
    bf16_t* Z; const float* ropec; const float* ropes;
    __device__ __forceinline__ void operator()(const f32x4 (&acc)[2][2][4][2], const Unit& u, int wr, int wc, int fr, int fq) const {
        const int row0 = u.pm * BM + wr * 64 + fr;
        if (u.pn < 4) {
            const float sc = (u.pn < 2) ? ATT_C2 : 1.0f;
            const int dl = 16 * (wc & 1) + 4 * fq;
#pragma unroll
            for (int ai = 0; ai < 2; ++ai)
#pragma unroll
                for (int m = 0; m < 4; ++m) {
                    const int row = row0 + ai * HALF + m * 16; const int t = row % TT;
                    const f32x4 c = *(const f32x4*)(ropec + t * 32 + dl) * sc, s = *(const f32x4*)(ropes + t * 32 + dl) * sc;
#pragma unroll
                    for (int bj = 0; bj < 2; ++bj) {
                        const int hb = 4 * u.pn + 2 * bj + (wc >> 1);
                        const f32x4 x1 = acc[ai][bj][m][0], x2 = acc[ai][bj][m][1];
                        const f32x4 o1 = x1 * c - x2 * s, o2 = x2 * c + x1 * s;
                        bf16_t* p = Z + (size_t)row * NZ + hb * 64 + dl;
                        u32x2 w1, w2; w1.x = pkbf(o1[0], o1[1]); w1.y = pkbf(o1[2], o1[3]); w2.x = pkbf(o2[0], o2[1]); w2.y = pkbf(o2[2], o2[3]);
                        *(u32x2*)p = w1; *(u32x2*)(p + 32) = w2;
                    }
                }
        } else {
            const int col0 = u.pn * BM + wc * 32 + 8 * fq;
#pragma unroll
            for (int ai = 0; ai < 2; ++ai)
#pragma unroll
                for (int m = 0; m < 4; ++m) {
                    bf16_t* rowp = Z + (size_t)(row0 + ai * HALF + m * 16) * NZ + col0;
#pragma unroll
                    for (int bj = 0; bj < 2; ++bj) { const f32x4 v0 = acc[ai][bj][m][0], v1 = acc[ai][bj][m][1];
                        u32x4 w; w.x = pkbf(v0[0], v0[1]); w.y = pkbf(v0[2], v0[3]); w.z = pkbf(v1[0], v1[1]); w.w = pkbf(v1[2], v1[3]);
                        *(u32x4*)(rowp + bj * HALF) = w; }
                }
        }
    }
};
template <bool SECOND> struct EpiGate {
    static constexpr bool PERM = true;
    bf16_t* Z;
    __device__ __forceinline__ void operator()(const f32x4 (&acc)[2][2][4][2], const Unit& u, int wr, int wc, int fr, int fq) const {
        const int row0 = u.pm * BM + wr * 64 + fr, col0 = u.pn * BM + wc * 32 + 8 * fq;
#pragma unroll
        for (int ai = 0; ai < 2; ++ai)
#pragma unroll
            for (int m = 0; m < 4; ++m) {
                bf16_t* rowp = Z + (size_t)(row0 + ai * HALF + m * 16) * NZ + col0;
#pragma unroll
                for (int bj = 0; bj < 2; ++bj) {
                    const u32x4 gw = *(const u32x4*)(rowp + (SECOND ? ZGM : ZGA) + bj * HALF);
                    const f32x4 v0 = acc[ai][bj][m][0], v1 = acc[ai][bj][m][1];
                    float o[8];
                    o[0] = sigmoidf_(bflo(gw.x)) * v0[0]; o[1] = sigmoidf_(bfhi(gw.x)) * v0[1]; o[2] = sigmoidf_(bflo(gw.y)) * v0[2]; o[3] = sigmoidf_(bfhi(gw.y)) * v0[3];
                    o[4] = sigmoidf_(bflo(gw.z)) * v1[0]; o[5] = sigmoidf_(bfhi(gw.z)) * v1[1]; o[6] = sigmoidf_(bflo(gw.w)) * v1[2]; o[7] = sigmoidf_(bfhi(gw.w)) * v1[3];
                    if (SECOND) { const u32x4 tw = *(const u32x4*)(rowp + ZTMP + bj * HALF);
                        o[0] += bflo(tw.x); o[1] += bfhi(tw.x); o[2] += bflo(tw.y); o[3] += bfhi(tw.y); o[4] += bflo(tw.z); o[5] += bfhi(tw.z); o[6] += bflo(tw.w); o[7] += bfhi(tw.w); }
                    u32x4 w; w.x = pkbf(o[0], o[1]); w.y = pkbf(o[2], o[3]); w.z = pkbf(o[4], o[5]); w.w = pkbf(o[6], o[7]);
                    *(u32x4*)(rowp + (SECOND ? ZMRG : ZTMP) + bj * HALF) = w;
                }
            }
    }
};
struct EpiPre1 {
    static constexpr bool PERM = false;
    float* P1; const float* x; const float* meta; const float* stats; const float* g0; const float* b0;
    __device__ __forceinline__ void operator()(const f32x4 (&acc)[2][2][4][2], const Unit& u, int wr, int wc, int fr, int fq) const {
        const int row0 = u.pm * BM + wr * 64 + fr, col0 = u.pn * BM + wc * 32 + 4 * fq;
        f32x4 gv[2][2], bv[2][2];
#pragma unroll
        for (int bj = 0; bj < 2; ++bj)
#pragma unroll
            for (int n = 0; n < 2; ++n) { gv[bj][n] = *(const f32x4*)(g0 + col0 + bj * HALF + n * 16); bv[bj][n] = *(const f32x4*)(b0 + col0 + bj * HALF + n * 16); }
#pragma unroll
        for (int ai = 0; ai < 2; ++ai)
#pragma unroll
            for (int m = 0; m < 4; ++m) {
                const int row = row0 + ai * HALF + m * 16; const int b = row / TT, t = row - b * TT;
                const float* xr = (t < NMETA) ? meta + (size_t)t * DM : x + ((size_t)b * SEQ + (t - NMETA)) * DM;
                const float mean = ld_agent_f(stats + 2 * row), rstd = ld_agent_f(stats + 2 * row + 1);
                float* orow = P1 + (size_t)row * (NZ / 2) + col0;
#pragma unroll
                for (int bj = 0; bj < 2; ++bj)
#pragma unroll
                    for (int n = 0; n < 2; ++n) { const f32x4 xv = *(const f32x4*)(xr + col0 + bj * HALF + n * 16);
                        const f32x4 hv = (xv - mean) * rstd * gv[bj][n] + bv[bj][n];
                        *(f32x4*)(orow + bj * HALF + n * 16) = hv * DN_ALPHA + acc[ai][bj][m][n]; }
            }
    }
};
struct EpiAct {
    static constexpr bool PERM = true;
    bf16_t* ACT; const float* b_gu; const int* tile_exp; int pm0;
    __device__ __forceinline__ void operator()(const f32x4 (&acc)[2][2][4][2], const Unit& u, int wr, int wc, int fr, int fq) const {
        const int e = __builtin_amdgcn_readfirstlane(ld_agent_i(tile_exp + pm0 + u.pm));
        const int ac0 = u.pn * HALF + wc * 32 + 8 * fq;
        const float* bp = b_gu + (size_t)e * 2 * FF + 2 * ac0;
        float bg[8], bl[8];
#pragma unroll
        for (int q = 0; q < 4; ++q) { const f32x4 v = *(const f32x4*)(bp + 4 * q); bg[2 * q] = v[0]; bl[2 * q] = v[1]; bg[2 * q + 1] = v[2]; bl[2 * q + 1] = v[3]; }
        const int row0 = u.pm * BM + wr * 64 + fr;
#pragma unroll
        for (int ai = 0; ai < 2; ++ai)
#pragma unroll
            for (int m = 0; m < 4; ++m) {
                float o[8];
#pragma unroll
                for (int j = 0; j < 8; ++j) {
                    float gl = acc[ai][0][m][j >> 2][j & 3] + bg[j], li = acc[ai][1][m][j >> 2][j & 3] + bl[j];
                    gl = fminf(gl, 7.0f); li = fminf(fmaxf(li, -7.0f), 7.0f);
                    o[j] = gl * sigmoidf_(1.702f * gl) * (li + 1.0f);
                }
                u32x4 w; w.x = pkbf(o[0], o[1]); w.y = pkbf(o[2], o[3]); w.z = pkbf(o[4], o[5]); w.w = pkbf(o[6], o[7]);
                *(u32x4*)(ACT + (size_t)(row0 + ai * HALF + m * 16) * FF + ac0) = w;
            }
    }
};
struct EpiDown {
    static constexpr bool PERM = true;
    bf16_t* Y; const float* b_down; const int* tile_exp; const int* row_slot; const float* row_gate; int pm0;
    __device__ __forceinline__ void operator()(const f32x4 (&acc)[2][2][4][2], const Unit& u, int wr, int wc, int fr, int fq) const {
        const int e = __builtin_amdgcn_readfirstlane(ld_agent_i(tile_exp + pm0 + u.pm));
        const int col0 = u.pn * BM + wc * 32 + 8 * fq;
        f32x4 bv[2][2];
#pragma unroll
        for (int bj = 0; bj < 2; ++bj)
#pragma unroll
            for (int n = 0; n < 2; ++n) bv[bj][n] = *(const f32x4*)(b_down + (size_t)e * DM + col0 + bj * HALF + 4 * n);
        const int r0 = (pm0 + u.pm) * BM + wr * 64 + fr;
#pragma unroll
        for (int ai = 0; ai < 2; ++ai)
#pragma unroll
            for (int m = 0; m < 4; ++m) {
                const int r = r0 + ai * HALF + m * 16;
                const int slot = ld_agent_i(row_slot + r); const float gt = ld_agent_f(row_gate + r);
                bf16_t* rowp = Y + (size_t)slot * DM + col0;
#pragma unroll
                for (int bj = 0; bj < 2; ++bj) { const f32x4 v0 = (acc[ai][bj][m][0] + bv[bj][0]) * gt, v1 = (acc[ai][bj][m][1] + bv[bj][1]) * gt;
                    u32x4 w; w.x = pkbf(v0[0], v0[1]); w.y = pkbf(v0[2], v0[3]); w.z = pkbf(v1[0], v1[1]); w.w = pkbf(v1[2], v1[3]);
                    *(u32x4*)(rowp + bj * HALF) = w; }
            }
    }
};
}

namespace attn_body {
using bf16 = __hip_bfloat16;
using s16x4 = __attribute__((ext_vector_type(4))) short;
using f32x16 = __attribute__((ext_vector_type(16))) float;
constexpr int D = 64, PZ = NZ, PO = 1024;
constexpr int NW = 8, QBLK = 32, QB = QBLK * NW, KVBLK = 64;
__device__ __forceinline__ int crow(int r, int hi) { return (r & 3) + 8 * (r >> 2) + 4 * hi; }
#define SBAR() __builtin_amdgcn_sched_barrier(0)
__device__ __forceinline__ void cmask(f32x16& p0, f32x16& p1, int jb, int qrel, int hi) {
    const float NEG = -INFINITY; const int d = qrel - 64 * jb - 4 * hi;
#pragma unroll
    for (int r = 0; r < 16; ++r) { const int c = (r & 3) + 8 * (r >> 2); if (c > d) p0[r] = NEG; if (c + 32 > d) p1[r] = NEG; }
}
constexpr int NSLOT = 3, SLOTB = 8192;
constexpr int LDS_K = 0, LDS_V = NSLOT * SLOTB, LDS_WS = 2 * NSLOT * SLOTB, LDS_OST = LDS_WS + NW * 64 * 4, LDS_BYTES_A = LDS_OST + NW * 4096;
__device__ __forceinline__ void glds16(const void* gsrc, unsigned lds_dst) { unsigned keep;
    asm volatile("s_mov_b32 %0, m0\n\ts_mov_b32 m0, %2\n\ts_nop 0\n\tglobal_load_lds_dwordx4 %1, off\n\ts_mov_b32 m0, %0" : "=&s"(keep) : "v"(gsrc), "s"(lds_dst) : "memory"); }
__device__ __forceinline__ float max3f(float a, float b, float c) { float r; asm("v_max3_f32 %0, %1, %2, %3" : "=v"(r) : "v"(a), "v"(b), "v"(c)); return r; }
__device__ __forceinline__ float max2f(float a, float b) { float r; asm("v_max_f32_e32 %0, %1, %2" : "=v"(r) : "v"(a), "v"(b)); return r; }
__device__ __forceinline__ float fadd_s(float a, float b) { float r; asm("v_add_f32_e32 %0, %1, %2" : "=v"(r) : "v"(a), "v"(b)); return r; }
__device__ __forceinline__ float fsub_s(float a, float b) { float r; asm("v_sub_f32_e32 %0, %1, %2" : "=v"(r) : "v"(a), "v"(b)); return r; }
__device__ __forceinline__ unsigned cvtpk_s(float lo, float hi) { return pkbf(lo, hi); }
#define WAIT_BAR(N) asm volatile("s_waitcnt vmcnt(" #N ") lgkmcnt(0)\n\ts_barrier" ::: "memory")
__device__ __forceinline__ void qkt(f32x16& p0, f32x16& p1, const char* Kslot, const bf16x8* qr, const f32x16& negm, int r32, int hi) {
    const char* kb = Kslot + hi * 1024 + r32 * 16;
#pragma unroll
    for (int d0 = 0; d0 < 4; ++d0) {
        const bf16x8 b0 = *reinterpret_cast<const bf16x8*>(kb + d0 * 2048);
        const bf16x8 b1 = *reinterpret_cast<const bf16x8*>(kb + d0 * 2048 + 512);
        if (d0 == 0) { p0 = __builtin_amdgcn_mfma_f32_32x32x16_bf16(b0, qr[0], negm, 0, 0, 0); p1 = __builtin_amdgcn_mfma_f32_32x32x16_bf16(b1, qr[0], negm, 0, 0, 0); }
        else { p0 = __builtin_amdgcn_mfma_f32_32x32x16_bf16(b0, qr[d0], p0, 0, 0, 0); p1 = __builtin_amdgcn_mfma_f32_32x32x16_bf16(b1, qr[d0], p1, 0, 0, 0); } }
}
typedef __attribute__((address_space(3))) const char* lds_cptr;
typedef short v4i16_t __attribute__((ext_vector_type(4)));
__device__ __forceinline__ void kload8(bf16x8* kf, lds_cptr kp) {
    kf[0] = *(const __attribute__((address_space(3))) bf16x8*)(kp);        kf[1] = *(const __attribute__((address_space(3))) bf16x8*)(kp + 512);
    kf[2] = *(const __attribute__((address_space(3))) bf16x8*)(kp + 2048); kf[3] = *(const __attribute__((address_space(3))) bf16x8*)(kp + 2560);
    kf[4] = *(const __attribute__((address_space(3))) bf16x8*)(kp + 4096); kf[5] = *(const __attribute__((address_space(3))) bf16x8*)(kp + 4608);
    kf[6] = *(const __attribute__((address_space(3))) bf16x8*)(kp + 6144); kf[7] = *(const __attribute__((address_space(3))) bf16x8*)(kp + 6656);
}
__device__ __forceinline__ void kload2(bf16x8* kf, lds_cptr kp, int j) { kf[2 * j] = *(const __attribute__((address_space(3))) bf16x8*)(kp + j * 2048); kf[2 * j + 1] = *(const __attribute__((address_space(3))) bf16x8*)(kp + j * 2048 + 512); }
__device__ __forceinline__ s16x4 vtr(lds_cptr p) { return __builtin_bit_cast(s16x4, __builtin_amdgcn_ds_read_tr16_b64_v4i16((__attribute__((address_space(3))) v4i16_t*)p)); }
__device__ __forceinline__ float rowmax(const f32x16& p0, const f32x16& p1) {
    float a = max3f(p0[0], p0[1], p1[0]), b = max3f(p0[2], p0[3], p1[1]); a = max3f(a, p1[2], p1[3]);
#pragma unroll
    for (int r = 4; r < 16; r += 4) { a = max3f(a, p0[r], p0[r + 1]); b = max3f(b, p0[r + 2], p0[r + 3]); a = max3f(a, p1[r], p1[r + 1]); b = max3f(b, p1[r + 2], p1[r + 3]); }
    const float m = max2f(a, b);
    auto rr = __builtin_amdgcn_permlane32_swap(__float_as_uint(m), __float_as_uint(m), false, false);
    return max2f(__uint_as_float(rr[0]), __uint_as_float(rr[1]));
}
__device__ __forceinline__ void pv(f32x16* o, int vb, bf16x8 pa0, bf16x8 pa1, bf16x8 pa2, bf16x8 pa3) {
#pragma unroll
    for (int d0 = 0; d0 < 2; ++d0) { s16x4 lo[4], hi[4];
#pragma unroll
        for (int ks = 0; ks < 4; ++ks) {
            asm volatile("ds_read_b64_tr_b16 %0,%1 offset:%c2" : "=&v"(lo[ks]) : "v"(vb), "i"(d0 * 4096 + ks * 1024) : "memory");
            asm volatile("ds_read_b64_tr_b16 %0,%1 offset:%c2" : "=&v"(hi[ks]) : "v"(vb), "i"(d0 * 4096 + ks * 1024 + 512) : "memory"); }
        asm volatile("s_waitcnt lgkmcnt(0)" ::: "memory"); SBAR();
#define PK(k) (bf16x8){lo[k][0], lo[k][1], lo[k][2], lo[k][3], hi[k][0], hi[k][1], hi[k][2], hi[k][3]}
        o[d0] = __builtin_amdgcn_mfma_f32_32x32x16_bf16(pa0, PK(0), o[d0], 0, 0, 0);
        o[d0] = __builtin_amdgcn_mfma_f32_32x32x16_bf16(pa1, PK(1), o[d0], 0, 0, 0);
        o[d0] = __builtin_amdgcn_mfma_f32_32x32x16_bf16(pa2, PK(2), o[d0], 0, 0, 0);
        o[d0] = __builtin_amdgcn_mfma_f32_32x32x16_bf16(pa3, PK(3), o[d0], 0, 0, 0);
#undef PK
    }
}
#define ATTN_STORE16(p, v) (*(u32x4*)(p) = (v))
template <int THRL> __device__ __forceinline__ void attn_unit(int qb, const bf16* Qh, const bf16* __restrict__ Kh, const bf16* __restrict__ Vh, bf16* Oh, char* shm) {
    const int tid = threadIdx.x; int lane = tid & 63; asm volatile("" : "+v"(lane));
    const int r32 = lane & 31, hi = lane >> 5; const int wid = __builtin_amdgcn_readfirstlane(tid >> 6);
    const int q0 = qb * QB;
    const bf16* Qw = Qh + (long)(q0 + wid * QBLK) * PZ;
    const unsigned lds0 = (unsigned)(uintptr_t)shm;
    float* wsf = (float*)(shm + LDS_WS) + wid * 64;
    const bf16* ksrc = Kh + (long)lane * PZ + wid * 8;
    const bf16* vsrc = Vh + (long)(16 * (wid & 3) + (lane >> 2)) * PZ + (wid >> 2) * 32 + (lane & 3) * 8;
    const unsigned kdst = lds0 + LDS_K + wid * 1024, vdst = lds0 + LDS_V + wid * 1024;
#define DMA_K(t, slot) glds16(ksrc + (long)(t) * KVBLK * PZ, (unsigned)__builtin_amdgcn_readfirstlane(kdst + (slot)))
#define DMA_V(t, slot) glds16(vsrc + (long)(t) * KVBLK * PZ, (unsigned)__builtin_amdgcn_readfirstlane(vdst + (slot)))
    const int vb0 = (int)(lds0 + LDS_V) + ((lane >> 4) & 1) * 32 + (lane & 3) * 8 + (4 * hi + ((lane & 15) >> 2)) * 64;
    const char* Kbase = shm + LDS_K; bf16x8 kf[8];
    const lds_cptr shm3 = (lds_cptr)shm; const lds_cptr kp0 = shm3 + LDS_K + hi * 1024 + r32 * 16; const lds_cptr vp0 = shm3 + LDS_V + ((lane >> 4) & 1) * 32 + (lane & 3) * 8 + (4 * hi + ((lane & 15) >> 2)) * 64;
    const int NT = (q0 + QB) / KVBLK;
    DMA_K(0, 0); DMA_V(0, 0); DMA_K(1, SLOTB);
    bf16x8 qr[4];
#pragma unroll
    for (int d0 = 0; d0 < 4; ++d0) qr[d0] = *reinterpret_cast<const bf16x8*>(&Qw[(long)r32 * PZ + d0 * 16 + hi * 8]);
    float mhat = 0.f, l_reg = 0.f; f32x16 o[2]; o[0] = f32x16{}; o[1] = f32x16{}; f32x16 negm = f32x16{}; asm volatile("" : "+v"(negm));
    const int qrel = wid * QBLK + r32;
#define CMASK(P0, P1, t) do { int jb_ = (t) - (NT - 4); if (jb_ >= 0) cmask(P0, P1, jb_, qrel, hi); } while (0)
    bool resc = false;
#define START(P0, P1) do { const float rm = rowmax(P0, P1); resc = false; \
    { const float dl = rm; mhat = fadd_s(mhat, dl); \
      _Pragma("unroll") for (int r = 0; r < 16; ++r) { P0[r] = fsub_s(P0[r], dl); P1[r] = fsub_s(P1[r], dl); } \
      _Pragma("unroll") for (int r = 0; r < 16; ++r) negm[r] = -mhat; asm volatile("" : "+v"(negm)); } \
    _Pragma("unroll") for (int r = 0; r < 16; ++r) P0[r] = __builtin_amdgcn_exp2f(P0[r]); } while (0)
#define RESC() do { if (resc) { asm volatile("s_waitcnt lgkmcnt(0)" ::: "memory"); \
      _Pragma("unroll") for (int d_ = 0; d_ < 2; ++d_) _Pragma("unroll") for (int r = 0; r < 16; ++r) o[d_][r] *= wsf[crow(r, hi)]; } } while (0)
    f32x16 pA0, pA1, pB0, pB1;
    int sl_prev = 0, sl_cur = 0, sl_next = SLOTB;
#define ROT() do { sl_prev = sl_cur; sl_cur = sl_next; sl_next = (sl_next == (NSLOT - 1) * SLOTB) ? 0 : sl_next + SLOTB; } while (0)
    DMA_K(2, 2 * SLOTB);
    WAIT_BAR(3);
    qkt(pA0, pA1, Kbase, qr, negm, r32, hi); asm volatile("s_nop 15\n\ts_nop 7" : "+v"(pA0), "+v"(pA1)); CMASK(pA0, pA1, 0);
    START(pA0, pA1);
    _Pragma("unroll") for (int r = 0; r < 16; ++r) pA1[r] = __builtin_amdgcn_exp2f(pA1[r]);
    WAIT_BAR(0);
    DMA_K(3, 0); DMA_V(1, SLOTB);
    ROT();
    kload8(kf, kp0 + sl_cur);
    WAIT_BAR(2);
    s16x4 vlo[8], vhi[8]; u32x4 pw0, pw1, pw2, pw3;
#define PKW(P, B) cvtpk_s(P[B], P[B + 1])
#define PAF(k) __builtin_bit_cast(bf16x8, pw##k)
#define VFR(i) (bf16x8){vlo[i][0], vlo[i][1], vlo[i][2], vlo[i][3], vhi[i][0], vhi[i][1], vhi[i][2], vhi[i][3]}
#define PIN(x) asm volatile("" : "+v"(x))
#define MX3(a, b, c) __builtin_fmaxf(__builtin_fmaxf((a), (b)), (c))
#define GAPA(MF, A0, A1, A2, A3, W0, W1, PW) do { MF; sacc += A0; sacc += A1; sacc += A2; sacc += A3; PIN(sacc); W0; W1; PIN(PW); SBAR(); } while (0)
#define EX(v) __builtin_amdgcn_exp2f(v)
#define GAPB(MF, X, B) do { MF; X[B] = EX(X[B]); X[B + 1] = EX(X[B + 1]); X[B + 2] = EX(X[B + 2]); X[B + 3] = EX(X[B + 3]); PIN(X); SBAR(); } while (0)
#define VRD(i) do { vlo[i] = vtr(vp_ + (((i) >> 2) * 4096 + ((i) & 3) * 1024)); vhi[i] = vtr(vp_ + (((i) >> 2) * 4096 + ((i) & 3) * 1024 + 512)); } while (0)
#define KRD(G, j) do { if (G) { kload2(kf, kp0 + sl_next, j); SBAR(); } } while (0)
#define STEP(C0, C1, P0, P1, t, GK, GV, GL) do { SBAR(); \
    const lds_cptr vp_ = vp0 + sl_prev; \
    VRD(0); SBAR(); float sacc = (P0[0] + P0[1]); \
    GAPA(C0 = __builtin_amdgcn_mfma_f32_32x32x16_bf16(kf[0], qr[0], negm, 0, 0, 0), P0[2], P0[3], P0[4], P0[5],     pw0[0] = PKW(P0, 0), pw0[1] = PKW(P0, 2), pw0); \
    VRD(4); SBAR(); GAPA(C1 = __builtin_amdgcn_mfma_f32_32x32x16_bf16(kf[1], qr[0], negm, 0, 0, 0), P0[6], P0[7], P0[8], P0[9],     pw0[2] = PKW(P0, 4), pw0[3] = PKW(P0, 6), pw0); \
    VRD(1); SBAR(); GAPA(C0 = __builtin_amdgcn_mfma_f32_32x32x16_bf16(kf[2], qr[1], C0, 0, 0, 0),   P0[10], P0[11], P0[12], P0[13], pw1[0] = PKW(P0, 8), pw1[1] = PKW(P0, 10), pw1); \
    VRD(5); SBAR(); GAPA(C1 = __builtin_amdgcn_mfma_f32_32x32x16_bf16(kf[3], qr[1], C1, 0, 0, 0),   P0[14], P0[15], P1[0], P1[1],   pw1[2] = PKW(P0, 12), pw1[3] = PKW(P0, 14), pw1); \
    VRD(2); SBAR(); GAPA(C0 = __builtin_amdgcn_mfma_f32_32x32x16_bf16(kf[4], qr[2], C0, 0, 0, 0),   P1[2], P1[3], P1[4], P1[5],     pw2[0] = PKW(P1, 0), pw2[1] = PKW(P1, 2), pw2); \
    VRD(6); SBAR(); GAPA(C1 = __builtin_amdgcn_mfma_f32_32x32x16_bf16(kf[5], qr[2], C1, 0, 0, 0),   P1[6], P1[7], P1[8], P1[9],     pw2[2] = PKW(P1, 4), pw2[3] = PKW(P1, 6), pw2); \
    VRD(3); SBAR(); GAPA(C0 = __builtin_amdgcn_mfma_f32_32x32x16_bf16(kf[6], qr[3], C0, 0, 0, 0),   P1[10], P1[11], P1[12], P1[13], pw3[0] = PKW(P1, 8), pw3[1] = PKW(P1, 10), pw3); \
    VRD(7); SBAR(); GAPA(C1 = __builtin_amdgcn_mfma_f32_32x32x16_bf16(kf[7], qr[3], C1, 0, 0, 0),   P1[14], P1[15], 0.f, 0.f,       pw3[2] = PKW(P1, 12), pw3[3] = PKW(P1, 14), pw3); \
    l_reg += sacc; \
    if (GK) { DMA_K((t) + 3, sl_cur); } if (GV) { DMA_V((t) + 1, sl_next); } \
    CMASK(C0, C1, t); \
    { float a = MX3(C0[0], C0[1], C1[0]), b = MX3(C0[2], C0[3], C1[1]); a = MX3(a, C1[2], C1[3]); \
      _Pragma("unroll") for (int r = 4; r < 16; r += 4) { a = MX3(a, C0[r], C0[r + 1]); b = MX3(b, C0[r + 2], C0[r + 3]); a = MX3(a, C1[r], C1[r + 1]); b = MX3(b, C1[r + 2], C1[r + 3]); } \
      float rm = __builtin_fmaxf(a, b); { auto rr = __builtin_amdgcn_permlane32_swap(__float_as_uint(rm), __float_as_uint(rm), false, false); rm = __builtin_fmaxf(__uint_as_float(rr[0]), __uint_as_float(rr[1])); } \
      resc = false; \
      if (__builtin_expect(__any(rm > (float)THRL), 0)) { const float dl = __builtin_fmaxf(rm, 0.f); mhat += dl; \
        _Pragma("unroll") for (int r = 0; r < 16; ++r) { C0[r] -= dl; C1[r] -= dl; } \
        _Pragma("unroll") for (int r = 0; r < 16; ++r) negm[r] = -mhat; asm volatile("" : "+v"(negm)); \
        const float f = __builtin_amdgcn_exp2f(-dl); l_reg *= f; if (hi == 0) wsf[r32] = f; resc = true; } } \
    SBAR(); \
    GAPB(o[0] = __builtin_amdgcn_mfma_f32_32x32x16_bf16(PAF(0), VFR(0), o[0], 0, 0, 0), C0, 0); \
    GAPB(o[1] = __builtin_amdgcn_mfma_f32_32x32x16_bf16(PAF(0), VFR(4), o[1], 0, 0, 0), C0, 4); \
    KRD(GL, 0); GAPB(o[0] = __builtin_amdgcn_mfma_f32_32x32x16_bf16(PAF(1), VFR(1), o[0], 0, 0, 0), C0, 8); \
    KRD(GL, 1); GAPB(o[1] = __builtin_amdgcn_mfma_f32_32x32x16_bf16(PAF(1), VFR(5), o[1], 0, 0, 0), C0, 12); \
    KRD(GL, 2); GAPB(o[0] = __builtin_amdgcn_mfma_f32_32x32x16_bf16(PAF(2), VFR(2), o[0], 0, 0, 0), C1, 0); \
    KRD(GL, 3); GAPB(o[1] = __builtin_amdgcn_mfma_f32_32x32x16_bf16(PAF(2), VFR(6), o[1], 0, 0, 0), C1, 4); \
    GAPB(o[0] = __builtin_amdgcn_mfma_f32_32x32x16_bf16(PAF(3), VFR(3), o[0], 0, 0, 0), C1, 8); \
    GAPB(o[1] = __builtin_amdgcn_mfma_f32_32x32x16_bf16(PAF(3), VFR(7), o[1], 0, 0, 0), C1, 12); \
    } while (0)
    int t = 1;
#undef CMASK
#define CMASK(P0, P1, t) do {} while (0)
    for (; t + 5 < NT; t += 2) {
        STEP(pB0, pB1, pA0, pA1, t, true, true, true);     WAIT_BAR(2); RESC(); ROT();
        STEP(pA0, pA1, pB0, pB1, t + 1, true, true, true); WAIT_BAR(2); RESC(); ROT();
    }
#undef CMASK
#define CMASK(P0, P1, t) do { int jb_ = (t) - (NT - 4); if (jb_ >= 0) cmask(P0, P1, jb_, qrel, hi); } while (0)
#define ENDW(tt) do { if ((tt) + 3 < NT) { WAIT_BAR(2); } else if ((tt) + 2 < NT) { WAIT_BAR(1); } else { WAIT_BAR(0); } } while (0)
    for (; t + 1 < NT; t += 2) {
        STEP(pB0, pB1, pA0, pA1, t, (t + 3 < NT), (t + 1 < NT), (t + 1 < NT));       ENDW(t);     RESC(); ROT();
        STEP(pA0, pA1, pB0, pB1, t + 1, (t + 4 < NT), (t + 2 < NT), (t + 2 < NT));   ENDW(t + 1); RESC(); ROT();
    }
    STEP(pB0, pB1, pA0, pA1, NT - 1, false, false, false); RESC();
    { float sacc = pB0[0] + pB0[1]; _Pragma("unroll") for (int r = 2; r < 16; ++r) sacc += pB0[r]; _Pragma("unroll") for (int r = 0; r < 16; ++r) sacc += pB1[r]; l_reg += sacc;
      pw0 = (u32x4){PKW(pB0, 0), PKW(pB0, 2), PKW(pB0, 4), PKW(pB0, 6)}; pw1 = (u32x4){PKW(pB0, 8), PKW(pB0, 10), PKW(pB0, 12), PKW(pB0, 14)}; pw2 = (u32x4){PKW(pB1, 0), PKW(pB1, 2), PKW(pB1, 4), PKW(pB1, 6)}; pw3 = (u32x4){PKW(pB1, 8), PKW(pB1, 10), PKW(pB1, 12), PKW(pB1, 14)};
      SBAR(); pv(o, vb0 + sl_cur, PAF(0), PAF(1), PAF(2), PAF(3)); }
#undef PKW
#undef PAF
#undef VFR
#undef PIN
#undef MX3
#undef GAPA
#undef GAPB
#undef EX
#undef VRD
#undef KRD
#undef STEP
#undef ENDW
    { auto rr = __builtin_amdgcn_permlane32_swap(__float_as_uint(l_reg), __float_as_uint(l_reg), false, false); l_reg = __uint_as_float(rr[0]) + __uint_as_float(rr[1]); }
    int lane2 = lane; asm volatile("" : "+v"(lane2));
    const int r32e = lane2 & 31, hie = lane2 >> 5;
    if (hie == 0) wsf[32 + r32e] = l_reg; asm volatile("s_waitcnt lgkmcnt(0)" ::: "memory");
    float rli[16];
#pragma unroll
    for (int r = 0; r < 16; ++r) rli[r] = __builtin_amdgcn_rcpf(wsf[32 + crow(r, hie)]);
    bf16* Ow = Oh + (long)(q0 + wid * QBLK) * PO;
    { bf16* stg = (bf16*)(shm + LDS_OST) + wid * 2048;
#pragma unroll
      for (int r = 0; r < 16; ++r) { const int orow = crow(r, hie);
#pragma unroll
        for (int d0 = 0; d0 < 2; ++d0) stg[orow * 64 + d0 * 32 + r32e] = __float2bfloat16(o[d0][r] * rli[r]); }
      asm volatile("s_waitcnt lgkmcnt(0)" ::: "memory");
#pragma unroll
      for (int i = 0; i < 4; ++i) { const int row = i * 8 + (lane2 >> 3), ch = lane2 & 7; const u32x4 v = *(const u32x4*)(stg + row * 64 + ch * 8); ATTN_STORE16(Ow + (long)row * PO + ch * 8, v); } }
    asm volatile("s_waitcnt lgkmcnt(0)\n\ts_barrier" ::: "memory");
#undef DMA_K
#undef DMA_V
#undef CMASK
#undef START
#undef RESC
#undef ROT
}
#undef SBAR
#undef WAIT_BAR
}

#define XB_TMO      128
#define XB_XCNT(j)  (256  + 64 * (j))
#define XB_XSUB(j)  (1280 + 64 * (j))
#define XB_XGEN(j)  (2304 + 64 * (j))
#define XB_TOP      3328
#define XB_TOPGEN   3392
#define XCD_BAR_WORDS 3456
#define XB_SPIN_CAP (1u << 18)
__device__ __forceinline__ unsigned xb_ld(unsigned* p)              { return __hip_atomic_load(p, __ATOMIC_RELAXED, __HIP_MEMORY_SCOPE_AGENT); }
__device__ __forceinline__ unsigned xb_add(unsigned* p, unsigned v) { return __hip_atomic_fetch_add(p, v, __ATOMIC_RELAXED, __HIP_MEMORY_SCOPE_AGENT); }
__device__ __forceinline__ unsigned xb_xcc_id() { return (unsigned)__builtin_amdgcn_s_getreg((3 << 11) | 20) & 0xFu; }
#define XB_SPIN(cond, bar) do { unsigned _sp = 0; while (cond) { __builtin_amdgcn_s_sleep(1); \
    if ((++_sp & 255u) == 0u) { if (xb_ld(&(bar)[XB_TMO])) break; if (_sp > XB_SPIN_CAP) { atomicAdd(&(bar)[XB_TMO], 1u); break; } } } } while (0)
struct XcdBarrier { unsigned* bar; unsigned x; volatile LAS unsigned* st; };
__device__ __forceinline__ XcdBarrier xcd_barrier_post(unsigned* bar, volatile LAS unsigned* st) {
    XcdBarrier b; b.bar = bar; b.x = xb_xcc_id(); b.st = st;
    if (threadIdx.x == 0) (void)xb_add(&bar[XB_XCNT(b.x)], 1u);
    return b;
}
__device__ __forceinline__ void xcd_barrier_complete(unsigned* bar, unsigned x, unsigned& nloc, unsigned& nx) {
    const unsigned G = gridDim.x * gridDim.y * gridDim.z;
    unsigned sum, cnt, mine, sp = 0u;
    for (;;) {
        sum = 0u; cnt = 0u; mine = 0u;
#pragma unroll
        for (unsigned j = 0; j < 16; ++j) { const unsigned c = xb_ld(&bar[XB_XCNT(j)]); sum += c; cnt += (c > 0u) ? 1u : 0u; mine = (j == x) ? c : mine; }
        if (sum == G) break;
        __builtin_amdgcn_s_sleep(1);
        if ((++sp & 255u) == 0u) { if (xb_ld(&bar[XB_TMO])) break; if (sp > XB_SPIN_CAP) { atomicAdd(&bar[XB_TMO], 1u); break; } }
    }
    nloc = mine > 0u ? mine : 1u; nx = cnt > 0u ? cnt : 1u;
}
__device__ __forceinline__ void xcd_barrier(const XcdBarrier& b) {
    asm volatile("s_waitcnt vmcnt(0)" ::: "memory");
    __syncthreads();
    if (threadIdx.x == 0) {
        unsigned* bar = b.bar;
        __builtin_amdgcn_s_waitcnt(0);
        unsigned nloc = b.st[0], nx = b.st[1];
        if (nloc == 0u) { xcd_barrier_complete(bar, b.x, nloc, nx); b.st[0] = nloc; b.st[1] = nx; }
        const unsigned old = xb_add(&bar[XB_XSUB(b.x)], 1u);
        const unsigned gen = old / nloc;
        if (old + 1u == (gen + 1u) * nloc) {
            __builtin_amdgcn_fence(__ATOMIC_RELEASE, "agent");
            asm volatile("s_waitcnt vmcnt(0)" ::: "memory");
            const unsigned og = xb_add(&bar[XB_TOP], 1u);
            const unsigned tg = og / nx;
            if (og + 1u == (tg + 1u) * nx) xb_add(&bar[XB_TOPGEN], 1u);
            else XB_SPIN(xb_ld(&bar[XB_TOPGEN]) == tg, bar);
            __builtin_amdgcn_fence(__ATOMIC_ACQUIRE, "agent");
            xb_add(&bar[XB_XGEN(b.x)], 1u);
            asm volatile("s_waitcnt vmcnt(0)" ::: "memory");
        } else {
            XB_SPIN(xb_ld(&bar[XB_XGEN(b.x)]) == gen, bar);
            __builtin_amdgcn_fence(__ATOMIC_ACQUIRE, "agent");
            asm volatile("s_waitcnt vmcnt(0)" ::: "memory");
        }
    }
    __syncthreads();
}

struct Args {
    const float *x, *meta, *ln0_g, *ln0_b, *w_in, *conv_w, *conv_b, *gate_bias, *lq1, *lk1, *lq2, *lk2, *att_g, *ml_g, *w_att_out, *w_ml_out, *w_o,
                *ln1_g, *ln1_b, *w_router, *b_router, *w_gu, *b_gu, *w_down, *b_down, *ln2_g, *ln2_b;
    float* out; unsigned char* ws; int ph_lo, ph_hi;
};

template <class ColMap>
__device__ __forceinline__ void transpose_item(const float* W, int K, int N, bf16_t* WT, LAS float* scr, int kb, int nb, int lane, ColMap cm) {
    const int k0 = 64 * kb, n0 = 32 * nb;
    const int lc = cm(n0 + (lane & 31));
#pragma unroll 8
    for (int i = 0; i < 32; ++i) { const int kk = 2 * i + (lane >> 5); scr[kk * 33 + (lane & 31)] = W[(size_t)(k0 + kk) * N + lc]; }
    LDS_WAIT(); asm volatile("" ::: "memory");
    const int c = lane & 7;
#pragma unroll
    for (int j = 0; j < 4; ++j) { const int n = (lane >> 3) + 8 * j; const LAS float* s = scr + (8 * c) * 33 + n;
        u32x4 o; o.x = pkbf(s[0 * 33], s[1 * 33]); o.y = pkbf(s[2 * 33], s[3 * 33]); o.z = pkbf(s[4 * 33], s[5 * 33]); o.w = pkbf(s[6 * 33], s[7 * 33]);
        *(u32x4*)(WT + (size_t)(n0 + n) * K + k0 + 8 * c) = o; }
    LDS_WAIT(); asm volatile("" ::: "memory");
}
struct CmIdent { __device__ __forceinline__ int operator()(int p) const { return p; } };
struct CmWin {
    __device__ __forceinline__ int operator()(int P) const {
        if (P < 1024) { const int hb = P >> 6, p = P & 63, wcp = p >> 5, fq = (p & 31) >> 3, n = (p & 7) >> 2, j = p & 3; return hb * 64 + 32 * n + 16 * wcp + 4 * fq + j; }
        if (P < 3584) return P;
        return P + 8;
    }
};
struct CmGu {
    __device__ __forceinline__ int operator()(int P) const { const int pn = P >> 8, s = (P >> 7) & 1, i = P & 127; return 2 * (128 * pn + i) + s; }
};

__global__ void __launch_bounds__(NWAVES * 64, 2) hybrid_fwd(Args a) {
    extern __shared__ __attribute__((aligned(16))) unsigned char lds[];
    LAS unsigned char* L = (LAS unsigned char*)lds;
    const int tid = threadIdx.x, lane = tid & 63, wave = __builtin_amdgcn_readfirstlane(tid >> 6);
    const int G = gridDim.x, blk = blockIdx.x;
    const int gw = blk * NWAVES + wave, NGW = G * NWAVES;
    if (tid < 16) ((LAS unsigned*)(L + MISC_OFF))[tid] = 0u;
    LAS unsigned long long* ptab = (LAS unsigned long long*)(L + MISC_OFF + 64);
    if (tid == 0) {
        ptab[0] = (unsigned long long)a.x; ptab[1] = (unsigned long long)a.meta; ptab[2] = (unsigned long long)a.ln0_g; ptab[3] = (unsigned long long)a.ln0_b; ptab[4] = (unsigned long long)a.w_in;
        ptab[5] = (unsigned long long)a.conv_w; ptab[6] = (unsigned long long)a.conv_b; ptab[7] = (unsigned long long)a.gate_bias; ptab[8] = (unsigned long long)a.lq1; ptab[9] = (unsigned long long)a.lk1;
        ptab[10] = (unsigned long long)a.lq2; ptab[11] = (unsigned long long)a.lk2; ptab[12] = (unsigned long long)a.att_g; ptab[13] = (unsigned long long)a.ml_g; ptab[14] = (unsigned long long)a.w_att_out;
        ptab[15] = (unsigned long long)a.w_ml_out; ptab[16] = (unsigned long long)a.w_o; ptab[17] = (unsigned long long)a.ln1_g; ptab[18] = (unsigned long long)a.ln1_b; ptab[19] = (unsigned long long)a.w_router;
        ptab[20] = (unsigned long long)a.b_router; ptab[21] = (unsigned long long)a.w_gu; ptab[22] = (unsigned long long)a.b_gu; ptab[23] = (unsigned long long)a.w_down; ptab[24] = (unsigned long long)a.b_down;
        ptab[25] = (unsigned long long)a.ln2_g; ptab[26] = (unsigned long long)a.ln2_b; ptab[27] = (unsigned long long)a.out; ptab[28] = (unsigned long long)a.ws;
    }
    asm volatile("s_waitcnt lgkmcnt(0)" ::: "memory");
    __syncthreads();
    asm volatile("" ::: "memory");
#define PF(i) ((const float*)ldptr(ptab, (i)))
#define WSP ((unsigned char*)ldptr(ptab, 28))
#define DOUTP ((unsigned char*)ldptr(ptab, 27))
#define ctl ((unsigned*)(WSP + WS_CTL))
#define WinT ((bf16_t*)(WSP + WS_WIN))
#define WaT ((bf16_t*)(WSP + WS_WA))
#define WmT ((bf16_t*)(WSP + WS_WM))
#define WoT ((bf16_t*)(WSP + WS_WO))
#define ropec ((float*)(WSP + WS_ROPE))
#define ropes (ropec + TT * 32)
#define stats ((float*)(WSP + WS_STATS))
#define gates ((float*)(WSP + WS_GATES))
#define tok_e ((int*)(WSP + WS_TOKE))
#define tok_g ((float*)(WSP + WS_TOKG))
#define hist ((int*)(WSP + WS_HIST))
#define row_off ((int*)(WSP + WS_ROWOFF))
#define row_slot ((int*)(WSP + WS_ROWSLOT))
#define row_gate ((float*)(WSP + WS_ROWGATE))
#define tile_exp ((int*)(WSP + WS_TILEEXP))
#define Hb ((bf16_t*)(WSP + WS_H))
#define Z ((bf16_t*)(WSP + WS_Z))
#define Y ((bf16_t*)(WSP + WS_Y))
#define ACT ((bf16_t*)(WSP + WS_ACT))
#define Ob ((bf16_t*)(DOUTP + DO_O))
#define HMb ((bf16_t*)(DOUTP + DO_HM))
#define WguT ((bf16_t*)(DOUTP + DO_WGU))
#define WdnT ((bf16_t*)(DOUTP + DO_WDN))
#if !MK_PER_PHASE
    XcdBarrier bar = xcd_barrier_post(ctl + CW_BAR, (volatile LAS unsigned*)(L + MISC_OFF + 32));
#define GRID_BAR() xcd_barrier(bar)
#else
#define GRID_BAR() do {} while (0)
#endif
    const int lo = a.ph_lo, hi = a.ph_hi;
#define IN(k) (lo <= (k) && (k) < hi)
#define BOTH(k) (IN(k) && IN((k) + 1))

    if (IN(0)) {
        {   LAS float* scr = (LAS float*)(L + wave * 16384);
            constexpr int I_IN = 16 * (NZ / 32), I_A = 8 * 32, I_O = 16 * 32;
            constexpr int NIT = I_IN + 2 * I_A + I_O;
            for (int it = gw; it < NIT; it += NGW) {
                int r = it;
                if (r < I_IN) { transpose_item(PF(4), 1024, NIN, WinT, scr, r / (NZ / 32), r % (NZ / 32), lane, CmWin()); continue; } r -= I_IN;
                if (r < I_A) { transpose_item(PF(14), 512, 1024, WaT, scr, r / 32, r % 32, lane, CmIdent()); continue; } r -= I_A;
                if (r < I_A) { transpose_item(PF(15), 512, 1024, WmT, scr, r / 32, r % 32, lane, CmIdent()); continue; } r -= I_A;
                transpose_item(PF(16), 1024, 1024, WoT, scr, r / 32, r % 32, lane, CmIdent());
            }
        }
        for (int i = blk * 512 + tid; i < TT * 32; i += G * 512) {
            const int t = i >> 5, f = i & 31;
            const double inv = exp2(-(double)f * (13.287712379549449 / 32.0));
            const double rev = (double)t * inv * 0.15915494309189535;
            const float fr = (float)(rev - floor(rev));
            ropec[i] = __builtin_amdgcn_cosf(fr); ropes[i] = __builtin_amdgcn_sinf(fr);
        }
        __syncthreads();
        LAS float* wg = (LAS float*)L;
        for (int i = tid; i < 8 * 1024; i += 512) { const int gc = i >> 10, k = i & 1023; wg[i] = PF(4)[(size_t)k * NIN + 3584 + gc]; }
        __syncthreads();
        for (int row = gw; row < MROWS; row += NGW) {
            const int b = row / TT, t = row - b * TT;
            const float* xr = (t < NMETA) ? PF(1) + (size_t)t * DM : PF(0) + ((size_t)b * SEQ + (t - NMETA)) * DM;
            f32x4 v[4]; float s = 0.f;
#pragma unroll
            for (int j = 0; j < 4; ++j) { v[j] = *(const f32x4*)(xr + 4 * lane + 256 * j); s += (v[j][0] + v[j][1]) + (v[j][2] + v[j][3]); }
            const float mean = wave_sum(s) * (1.f / DM); float s2 = 0.f;
#pragma unroll
            for (int j = 0; j < 4; ++j) { const f32x4 d = v[j] - mean; s2 += (d[0] * d[0] + d[1] * d[1]) + (d[2] * d[2] + d[3] * d[3]); }
            const float rstd = 1.0f / sqrtf(wave_sum(s2) * (1.f / DM) + LN_EPS);
            if (lane == 0) { stats[2 * row] = mean; stats[2 * row + 1] = rstd; }
            float gp[8];
#pragma unroll
            for (int q = 0; q < 8; ++q) gp[q] = 0.f;
#pragma unroll
            for (int j = 0; j < 4; ++j) {
                const f32x4 gg = *(const f32x4*)(PF(2) + 4 * lane + 256 * j), bb = *(const f32x4*)(PF(3) + 4 * lane + 256 * j);
                const f32x4 hv = (v[j] - mean) * rstd * gg + bb;
                u32x2 w; w.x = pkbf(hv[0], hv[1]); w.y = pkbf(hv[2], hv[3]);
                *(u32x2*)(Hb + (size_t)row * DM + 4 * lane + 256 * j) = w;
#pragma unroll
                for (int q = 0; q < 8; ++q) { const f32x4 wv = *(const LAS f32x4*)(wg + q * 1024 + 4 * lane + 256 * j); gp[q] += (hv[0] * wv[0] + hv[1] * wv[1]) + (hv[2] * wv[2] + hv[3] * wv[3]); }
            }
#pragma unroll
            for (int q = 0; q < 8; ++q) gp[q] = wave_sum(gp[q]);
            if (lane < 8) {
                float gsel = gp[0];
#pragma unroll
                for (int q = 1; q < 8; ++q) gsel = (lane == q) ? gp[q] : gsel;
                float gv = gsel + PF(7)[lane];
                if (lane >= 4) gv = (gv >= 0.f) ? -log1pf(expf(-gv)) : gv - log1pf(expf(gv));
                gates[(size_t)row * 8 + lane] = gv;
            }
        }
        __syncthreads();
        if (BOTH(0)) GRID_BAR();
    }

    if (IN(1)) {
        pg8::Gemm g{Hb, WinT, DM, DM, NZ / 256, nullptr, nullptr, 0};
        pg8::StaticOrder S; S.init(MROWS / 256, NZ / 256, G, blk);
        pg8::EpiZ E{Z, ropec, ropes};
        pg8::gemm_phase<0, pg8::EpiZ>(L, g, S, E);
        if (BOTH(1)) GRID_BAR();
    }

    if (IN(2)) {
        for (int Lidx = blk; Lidx < NB * 16 * 17; Lidx += G) {
            const int bvh = Lidx & 255, qb = Lidx >> 8;
            const int b = bvh >> 4, vh = bvh & 15, hm = vh >> 1, vhalf = vh & 1, h = hm >> 1;
            const bf16_t* Zb = Z + (size_t)b * TT * NZ;
            attn_body::attn_unit<8>(qb, (const attn_body::bf16*)(Zb + ZQ + hm * 64), (const attn_body::bf16*)(Zb + ZK + hm * 64), (const attn_body::bf16*)(Zb + ZV + h * 128 + vhalf * 64),
                                    (attn_body::bf16*)(Ob + (size_t)b * OROWS * 1024 + vh * 64), (char*)lds);
        }
        __syncthreads();
        {
            constexpr int PQ = 136;
            LAS bf16_t* Qs = (LAS bf16_t*)L;
            LAS bf16_t* Ks = Qs + 128 * PQ;
            LAS bf16_t* KTs = Ks + 128 * PQ;
            LAS bf16_t* VTs = KTs + 128 * PQ;
            LAS bf16_t* Cs = VTs + 48 * PQ;
            LAS float* fv = (LAS float*)(Cs + 48 * PQ);
            LAS float* v_a = fv;
            LAS float* v_M = fv + 128;
            LAS float* v_b = fv + 256;
            LAS float* v_sc = fv + 384;
            LAS float* cw = fv + 400;
            for (int u = blk; u < NB * 4 * 4; u += G) {
                const int b = u >> 4, h = (u >> 2) & 3, es = u & 3;
                __syncthreads();
                for (int i = tid; i < 5 * 256; i += 512) { const int j = i >> 8, c = i & 255; const int ch = (c < 128) ? (h * 128 + c) : (512 + h * 128 + (c - 128));
                    cw[i] = (j < 4) ? PF(5)[j * 1024 + ch] : PF(6)[ch]; }
                for (int i = tid; i < 48 * PQ; i += 512) { const int rr = i / PQ; VTs[i] = (rr == 32) ? (bf16_t)0x3f80 : (bf16_t)0; Cs[i] = 0; }
                if (tid == 0) v_sc[0] = 0.f;
                f32x4 Cst[3]; Cst[0] = (f32x4){0.f, 0.f, 0.f, 0.f}; Cst[1] = Cst[0]; Cst[2] = Cst[0];
                const bf16_t* Zb = Z + (size_t)b * TT * NZ;
                const int fr = lane & 15, quad = lane >> 4;
                for (int c = 0; c < 33; ++c) {
                    const int t0 = c * 128;
                    __syncthreads();
                    if (wave == 0) {
                        const float m_old = v_sc[0];
                        float x0, x1, i0, i1;
                        { const int ta = t0 + 2 * lane, tb = ta + 1;
                          x0 = (ta < TT) ? ld_agent_f(gates + (size_t)(b * TT + ta) * 8 + 4 + h) : 0.f; i0 = (ta < TT) ? ld_agent_f(gates + (size_t)(b * TT + ta) * 8 + h) : -1e30f;
                          x1 = (tb < TT) ? ld_agent_f(gates + (size_t)(b * TT + tb) * 8 + 4 + h) : 0.f; i1 = (tb < TT) ? ld_agent_f(gates + (size_t)(b * TT + tb) * 8 + h) : -1e30f; }
                        float sacc = x0 + x1;
#pragma unroll
                        for (int o = 1; o < 64; o <<= 1) { const float tv = __shfl_up(sacc, o); if (lane >= o) sacc += tv; }
                        const float ex = sacc - (x0 + x1);
                        const float b0 = ex + x0, b1 = b0 + x1;
                        const float a0 = i0 - b0, a1 = i1 - b1;
                        float mx = fmaxf(a0, a1);
#pragma unroll
                        for (int o = 1; o < 64; o <<= 1) { const float tv = __shfl_up(mx, o); if (lane >= o) mx = fmaxf(mx, tv); }
                        float exm = __shfl_up(mx, 1); if (lane == 0) exm = -INFINITY;
                        const float M0 = fmaxf(fmaxf(m_old, exm), a0), M1 = fmaxf(M0, a1);
                        v_b[2 * lane] = b0; v_b[2 * lane + 1] = b1; v_a[2 * lane] = a0; v_a[2 * lane + 1] = a1; v_M[2 * lane] = M0; v_M[2 * lane + 1] = M1;
                        if (lane == 63) v_sc[1] = M1;
                    }
                    __syncthreads();
                    const float Mlast = v_sc[1], m_old = v_sc[0];
#pragma unroll 1
                    for (int i = 0; i < 4; ++i) {
                        const int p = tid + 512 * i, s = p >> 4, dg = p & 15;
                        const int t = t0 + s;
                        float qv[8], kv[8];
#pragma unroll
                        for (int e = 0; e < 8; ++e) { qv[e] = cw[4 * 256 + dg * 8 + e]; kv[e] = cw[4 * 256 + 128 + dg * 8 + e]; }
#pragma unroll
                        for (int j = 0; j < 4; ++j) {
                            const int tj = t - 3 + j;
                            if (tj >= 0 && tj < TT) {
                                const u32x4 zq = *(const u32x4*)(Zb + (size_t)tj * NZ + ZMQ + h * 128 + dg * 8);
                                const u32x4 zk = *(const u32x4*)(Zb + (size_t)tj * NZ + ZMK + h * 128 + dg * 8);
                                const LAS float* wq = cw + j * 256 + dg * 8; const LAS float* wk = wq + 128;
                                qv[0] += wq[0] * bflo(zq.x); qv[1] += wq[1] * bfhi(zq.x); qv[2] += wq[2] * bflo(zq.y); qv[3] += wq[3] * bfhi(zq.y);
                                qv[4] += wq[4] * bflo(zq.z); qv[5] += wq[5] * bfhi(zq.z); qv[6] += wq[6] * bflo(zq.w); qv[7] += wq[7] * bfhi(zq.w);
                                kv[0] += wk[0] * bflo(zk.x); kv[1] += wk[1] * bfhi(zk.x); kv[2] += wk[2] * bflo(zk.y); kv[3] += wk[3] * bfhi(zk.y);
                                kv[4] += wk[4] * bflo(zk.z); kv[5] += wk[5] * bfhi(zk.z); kv[6] += wk[6] * bflo(zk.w); kv[7] += wk[7] * bfhi(zk.w);
                            }
                        }
                        const bool live = (t < TT);
                        const float wrs = live ? __expf(v_a[s] - Mlast) : 0.f;
#pragma unroll
                        for (int e = 0; e < 8; ++e) { qv[e] = live ? qv[e] * sigmoidf_(qv[e]) : 0.f; kv[e] = live ? kv[e] * sigmoidf_(kv[e]) * 0.08838834764831845f : 0.f; }
                        u32x4 wq4, wk4; wq4.x = pkbf(qv[0], qv[1]); wq4.y = pkbf(qv[2], qv[3]); wq4.z = pkbf(qv[4], qv[5]); wq4.w = pkbf(qv[6], qv[7]);
                        wk4.x = pkbf(kv[0], kv[1]); wk4.y = pkbf(kv[2], kv[3]); wk4.z = pkbf(kv[4], kv[5]); wk4.w = pkbf(kv[6], kv[7]);
                        *(LAS u32x4*)(Qs + s * PQ + dg * 8) = wq4; *(LAS u32x4*)(Ks + s * PQ + dg * 8) = wk4;
#pragma unroll
                        for (int e = 0; e < 8; ++e) KTs[(dg * 8 + e) * PQ + s] = (bf16_t)(pkbf(kv[e] * wrs, 0.f) & 0xffffu);
                    }
                    { const int s = tid >> 2, eg = tid & 3, t = t0 + s;
                      u32x4 zv = (u32x4){0u, 0u, 0u, 0u};
                      if (t < TT) zv = *(const u32x4*)(Zb + (size_t)t * NZ + ZMV + h * 128 + es * 32 + eg * 8);
                      VTs[(eg * 8 + 0) * PQ + s] = (bf16_t)(zv.x & 0xffffu); VTs[(eg * 8 + 1) * PQ + s] = (bf16_t)(zv.x >> 16);
                      VTs[(eg * 8 + 2) * PQ + s] = (bf16_t)(zv.y & 0xffffu); VTs[(eg * 8 + 3) * PQ + s] = (bf16_t)(zv.y >> 16);
                      VTs[(eg * 8 + 4) * PQ + s] = (bf16_t)(zv.z & 0xffffu); VTs[(eg * 8 + 5) * PQ + s] = (bf16_t)(zv.z >> 16);
                      VTs[(eg * 8 + 6) * PQ + s] = (bf16_t)(zv.w & 0xffffu); VTs[(eg * 8 + 7) * PQ + s] = (bf16_t)(zv.w >> 16); }
                    __syncthreads();
                    f32x4 St[8];
#pragma unroll
                    for (int j = 0; j < 8; ++j) St[j] = (f32x4){0.f, 0.f, 0.f, 0.f};
                    {
                        bf16x8 af[4];
#pragma unroll
                        for (int kk = 0; kk < 4; ++kk) af[kk] = *(const LAS bf16x8*)(Qs + (16 * wave + fr) * PQ + kk * 32 + quad * 8);
#pragma unroll
                        for (int j = 0; j < 8; ++j) if (j <= wave) {
#pragma unroll
                            for (int kk = 0; kk < 4; ++kk) { const bf16x8 bfv = *(const LAS bf16x8*)(Ks + (16 * j + fr) * PQ + kk * 32 + quad * 8);
                                St[j] = __builtin_amdgcn_mfma_f32_16x16x32_bf16(af[kk], bfv, St[j], 0, 0, 0); }
                        }
                    }
                    __syncthreads();
                    {
                        float Ms[4];
#pragma unroll
                        for (int jj = 0; jj < 4; ++jj) Ms[jj] = v_M[16 * wave + 4 * quad + jj];
#pragma unroll
                        for (int j = 0; j < 8; ++j) {
                            const int r = 16 * j + fr; const float ar = v_a[r];
#pragma unroll
                            for (int jj = 0; jj < 4; ++jj) { const int s = 16 * wave + 4 * quad + jj;
                                const float w = (j <= wave && r <= s) ? St[j][jj] * __expf(ar - Ms[jj]) : 0.f;
                                Ks[s * PQ + r] = (bf16_t)(pkbf(w, 0.f) & 0xffffu); }
                        }
                    }
                    __syncthreads();
                    {
                        f32x4 n1[3], n2[3];
#pragma unroll
                        for (int jt = 0; jt < 3; ++jt) { n1[jt] = (f32x4){0.f, 0.f, 0.f, 0.f}; n2[jt] = n1[jt]; }
#pragma unroll
                        for (int kk = 0; kk < 4; ++kk) {
                            const bf16x8 aq = *(const LAS bf16x8*)(Qs + (16 * wave + fr) * PQ + kk * 32 + quad * 8);
                            const bf16x8 as_ = *(const LAS bf16x8*)(Ks + (16 * wave + fr) * PQ + kk * 32 + quad * 8);
#pragma unroll
                            for (int jt = 0; jt < 3; ++jt) {
                                const bf16x8 bc = *(const LAS bf16x8*)(Cs + (16 * jt + fr) * PQ + kk * 32 + quad * 8);
                                const bf16x8 bvv = *(const LAS bf16x8*)(VTs + (16 * jt + fr) * PQ + kk * 32 + quad * 8);
                                n1[jt] = __builtin_amdgcn_mfma_f32_16x16x32_bf16(aq, bc, n1[jt], 0, 0, 0);
                                n2[jt] = __builtin_amdgcn_mfma_f32_16x16x32_bf16(as_, bvv, n2[jt], 0, 0, 0);
                            }
                        }
#pragma unroll
                        for (int jj = 0; jj < 4; ++jj) {
                            const int s = 16 * wave + 4 * quad + jj; const int t = t0 + s;
                            const float Ms = v_M[s]; const float winter = __expf(m_old - Ms);
                            float den = winter * n1[2][jj] + n2[2][jj];
                            den = __shfl(den, lane & 48);
                            const float ms = v_b[s] + Ms;
                            const float dd = fmaxf(fabsf(den), __expf(-ms));
                            const float rd = 1.0f / dd;
                            if (t < TT) {
                                bf16_t* op = HMb + (size_t)(b * TT + t) * 512 + h * 128 + es * 32 + fr;
                                op[0] = (bf16_t)(pkbf((winter * n1[0][jj] + n2[0][jj]) * rd, 0.f) & 0xffffu);
                                op[16] = (bf16_t)(pkbf((winter * n1[1][jj] + n2[1][jj]) * rd, 0.f) & 0xffffu);
                            }
                        }
                    }
                    __syncthreads();
                    {
                        const float w_old = __expf(m_old - Mlast);
#pragma unroll
                        for (int jt = 0; jt < 3; ++jt) Cst[jt] = Cst[jt] * w_old;
#pragma unroll
                        for (int kk = 0; kk < 4; ++kk) {
                            const bf16x8 bk = *(const LAS bf16x8*)(KTs + (16 * wave + fr) * PQ + kk * 32 + quad * 8);
#pragma unroll
                            for (int jt = 0; jt < 3; ++jt) { const bf16x8 av = *(const LAS bf16x8*)(VTs + (16 * jt + fr) * PQ + kk * 32 + quad * 8);
                                Cst[jt] = __builtin_amdgcn_mfma_f32_16x16x32_bf16(av, bk, Cst[jt], 0, 0, 0); }
                        }
#pragma unroll
                        for (int jt = 0; jt < 3; ++jt)
#pragma unroll
                            for (int jj = 0; jj < 4; ++jj) Cs[(16 * jt + 4 * quad + jj) * PQ + 16 * wave + fr] = (bf16_t)(pkbf(Cst[jt][jj], 0.f) & 0xffffu);
                        if (tid == 0) v_sc[0] = v_b[127] + Mlast;
                    }
                }
            }
        }
        __syncthreads();
        if (BOTH(2)) GRID_BAR();
    }

    if (IN(3)) {
        float lam;
        { const float p1 = wave_sum(PF(8)[lane] * PF(9)[lane]), p2 = wave_sum(PF(10)[lane] * PF(11)[lane]); lam = expf(p1) - expf(p2) + LAMBDA_INIT; }
        const int hd = lane >> 4, e0 = (lane & 15) * 8;
        float ga[8], gm[8];
#pragma unroll
        for (int e = 0; e < 8; ++e) { ga[e] = PF(12)[e0 + e] * (1.0f - LAMBDA_INIT); gm[e] = PF(13)[hd * 128 + e0 + e]; }
        for (int row = gw; row < MROWS; row += NGW) {
            const int b = row / TT, t = row - b * TT;
            const bf16_t* orow = Ob + ((size_t)b * OROWS + t) * 1024 + hd * 256 + e0;
            const u32x4 w0 = *(const u32x4*)orow, w1 = *(const u32x4*)(orow + 128);
            float o[8];
            o[0] = bflo(w0.x) - lam * bflo(w1.x); o[1] = bfhi(w0.x) - lam * bfhi(w1.x); o[2] = bflo(w0.y) - lam * bflo(w1.y); o[3] = bfhi(w0.y) - lam * bfhi(w1.y);
            o[4] = bflo(w0.z) - lam * bflo(w1.z); o[5] = bfhi(w0.z) - lam * bfhi(w1.z); o[6] = bflo(w0.w) - lam * bflo(w1.w); o[7] = bfhi(w0.w) - lam * bfhi(w1.w);
            float ss = 0.f;
#pragma unroll
            for (int e = 0; e < 8; ++e) ss += o[e] * o[e];
            ss += __shfl_xor(ss, 1); ss += __shfl_xor(ss, 2); ss += __shfl_xor(ss, 4); ss += __shfl_xor(ss, 8);
            float rs = 1.0f / sqrtf(ss * (1.f / 128.f) + LN_EPS);
            u32x4 wo; wo.x = pkbf(o[0] * rs * ga[0], o[1] * rs * ga[1]); wo.y = pkbf(o[2] * rs * ga[2], o[3] * rs * ga[3]); wo.z = pkbf(o[4] * rs * ga[4], o[5] * rs * ga[5]); wo.w = pkbf(o[6] * rs * ga[6], o[7] * rs * ga[7]);
            bf16_t* zrow = Z + (size_t)row * NZ;
            const u32x4 hw = *(const u32x4*)(HMb + (size_t)row * 512 + hd * 128 + e0);
            const u32x4 mw = *(const u32x4*)(zrow + ZMO + hd * 128 + e0);
            *(u32x4*)(zrow + ZYC + hd * 128 + e0) = wo;
            float hv[8]; hv[0] = bflo(hw.x); hv[1] = bfhi(hw.x); hv[2] = bflo(hw.y); hv[3] = bfhi(hw.y); hv[4] = bflo(hw.z); hv[5] = bfhi(hw.z); hv[6] = bflo(hw.w); hv[7] = bfhi(hw.w);
            float mo[8]; mo[0] = bflo(mw.x); mo[1] = bfhi(mw.x); mo[2] = bflo(mw.y); mo[3] = bfhi(mw.y); mo[4] = bflo(mw.z); mo[5] = bfhi(mw.z); mo[6] = bflo(mw.w); mo[7] = bfhi(mw.w);
            ss = 0.f;
#pragma unroll
            for (int e = 0; e < 8; ++e) ss += hv[e] * hv[e];
            ss += __shfl_xor(ss, 1); ss += __shfl_xor(ss, 2); ss += __shfl_xor(ss, 4); ss += __shfl_xor(ss, 8);
            rs = 1.0f / sqrtf(ss * (1.f / 128.f) + LN_EPS);
            float y[8];
#pragma unroll
            for (int e = 0; e < 8; ++e) y[e] = sigmoidf_(mo[e]) * (hv[e] * rs * gm[e]);
            u32x4 wy; wy.x = pkbf(y[0], y[1]); wy.y = pkbf(y[2], y[3]); wy.z = pkbf(y[4], y[5]); wy.w = pkbf(y[6], y[7]);
            *(u32x4*)(zrow + ZYC + 512 + hd * 128 + e0) = wy;
        }
        if (BOTH(3)) GRID_BAR();
    }

    if (IN(4)) {
        {   LAS float* scr = (LAS float*)(L + wave * 16384);
            constexpr int I_GU = 16 * 64, I_DN = 16 * 32;
            for (int it = gw; it < NE * (I_GU + I_DN); it += NGW) {
                const int e = it / (I_GU + I_DN); int r = it - e * (I_GU + I_DN);
                if (r < I_GU) transpose_item(PF(21) + (size_t)e * 1024 * 2048, 1024, 2048, WguT + (size_t)e * 2048 * 1024, scr, r / 64, r % 64, lane, CmGu());
                else { r -= I_GU; transpose_item(PF(23) + (size_t)e * 1024 * 1024, 1024, 1024, WdnT + (size_t)e * 1024 * 1024, scr, r / 32, r % 32, lane, CmIdent()); }
            }
        }
        __syncthreads();
        {   pg8::Gemm g{Z + ZYC, WaT, NZ, 512, 4, nullptr, nullptr, 0};
            pg8::StaticOrder S; S.init(MROWS / 256, 4, G, blk);
            pg8::EpiGate<false> E{Z};
            pg8::gemm_phase<0, pg8::EpiGate<false>>(L, g, S, E); }
        {   pg8::Gemm g{Z + ZYC + 512, WmT, NZ, 512, 4, nullptr, nullptr, 0};
            pg8::StaticOrder S; S.init(MROWS / 256, 4, G, blk);
            pg8::EpiGate<true> E{Z};
            pg8::gemm_phase<0, pg8::EpiGate<true>>(L, g, S, E); }
        if (BOTH(4)) GRID_BAR();
    }

    if (IN(5)) {
        pg8::Gemm g{Z + ZMRG, WoT, NZ, 1024, 4, nullptr, nullptr, 0};
        pg8::StaticOrder S; S.init(MROWS / 256, 4, G, blk);
        pg8::EpiPre1 E{(float*)(Z + ZGA), PF(0), PF(1), stats, PF(2), PF(3)};
        pg8::gemm_phase<0, pg8::EpiPre1>(L, g, S, E);
        if (BOTH(5)) GRID_BAR();
    }

    const int RPB = (MROWS + G - 1) / G;
    if (IN(6)) {
        LAS float* wrT = (LAS float*)L;
        LAS int* hcnt = (LAS int*)(L + 131072);
        for (int i = tid; i < 32 * 1024; i += 512) { const int k = i >> 5, e = i & 31; wrT[e * 1024 + k] = PF(19)[i]; }
        if (tid < 32) hcnt[tid] = 0;
        __syncthreads();
        const float* P1 = (const float*)(Z + ZGA);
        const int rbeg = blk * RPB, rend = (rbeg + RPB < MROWS) ? rbeg + RPB : MROWS;
        for (int row = rbeg + wave; row < rend; row += NWAVES) {
            const float* pr = P1 + (size_t)row * (NZ / 2);
            f32x4 v[4]; float s = 0.f;
#pragma unroll
            for (int j = 0; j < 4; ++j) { v[j] = *(const f32x4*)(pr + 4 * lane + 256 * j); s += (v[j][0] + v[j][1]) + (v[j][2] + v[j][3]); }
            const float mean = wave_sum(s) * (1.f / DM); float s2 = 0.f;
#pragma unroll
            for (int j = 0; j < 4; ++j) { const f32x4 d = v[j] - mean; s2 += (d[0] * d[0] + d[1] * d[1]) + (d[2] * d[2] + d[3] * d[3]); }
            const float rstd = 1.0f / sqrtf(wave_sum(s2) * (1.f / DM) + LN_EPS);
#pragma unroll
            for (int j = 0; j < 4; ++j) {
                const f32x4 gg = *(const f32x4*)(PF(17) + 4 * lane + 256 * j), bb = *(const f32x4*)(PF(18) + 4 * lane + 256 * j);
                v[j] = (v[j] - mean) * rstd * gg + bb;
                u32x2 w; w.x = pkbf(v[j][0], v[j][1]); w.y = pkbf(v[j][2], v[j][3]);
                *(u32x2*)(Hb + (size_t)row * DM + 4 * lane + 256 * j) = w;
            }
            float mylogit = -INFINITY;
#pragma unroll 4
            for (int e = 0; e < 32; ++e) {
                float p = 0.f;
#pragma unroll
                for (int j = 0; j < 4; ++j) { const f32x4 wv = *(const LAS f32x4*)(wrT + e * 1024 + 4 * lane + 256 * j); p += (v[j][0] * wv[0] + v[j][1] * wv[1]) + (v[j][2] * wv[2] + v[j][3] * wv[3]); }
                p = wave_sum(p);
                if (lane == e) mylogit = p + PF(20)[e];
            }
            float tv[4]; int ti[4];
#pragma unroll
            for (int k = 0; k < 4; ++k) {
                const float mx = wave_max(mylogit);
                const unsigned long long bal = __ballot(mylogit == mx);
                const int idx = __ffsll((long long)bal) - 1;
                tv[k] = mx; ti[k] = idx;
                if (lane == idx) mylogit = -INFINITY;
            }
            const float e1 = __expf(tv[1] - tv[0]), e2 = __expf(tv[2] - tv[0]), e3 = __expf(tv[3] - tv[0]);
            const float inv = 1.0f / (1.0f + e1 + e2 + e3);
            if (lane < 4) {
                const int idx = (lane == 0) ? ti[0] : (lane == 1) ? ti[1] : (lane == 2) ? ti[2] : ti[3];
                const float gv = ((lane == 0) ? 1.0f : (lane == 1) ? e1 : (lane == 2) ? e2 : e3) * inv;
                tok_e[(size_t)row * 4 + lane] = idx; tok_g[(size_t)row * 4 + lane] = gv;
                atomicAdd((int*)&hcnt[idx], 1);
            }
        }
        __syncthreads();
        if (tid < 32) hist[blk * 32 + tid] = hcnt[tid];
        if (BOTH(6)) GRID_BAR();
    }

    if (IN(7)) {
        LAS int* cnt_s = (LAS int*)L; LAS int* base_s = cnt_s + 32; LAS int* pst_s = cnt_s + 64; LAS int* ent = cnt_s + 128;
        const int rbeg = blk * RPB, rend = (rbeg + RPB < MROWS) ? rbeg + RPB : MROWS; const int nr = (rend > rbeg) ? rend - rbeg : 0;
        if (tid < 32) { int tot = 0, bs = 0; for (int b2 = 0; b2 < G; ++b2) { const int v = ld_agent_i(hist + b2 * 32 + tid); if (b2 < blk) bs += v; tot += v; } cnt_s[tid] = tot; base_s[tid] = bs; }
        __syncthreads();
        if (tid == 0) { int p = 0; for (int e = 0; e < 32; ++e) { pst_s[e] = p; p += (cnt_s[e] + 255) & ~255; } pst_s[32] = p; }
        for (int i = tid; i < nr * 4; i += 512) ent[i] = ld_agent_i(tok_e + (size_t)rbeg * 4 + i);
        __syncthreads();
        if (tid < 32) { int pos = pst_s[tid] + base_s[tid];
            for (int i = 0; i < nr * 4; ++i) if (ent[i] == tid) { row_off[pos] = (rbeg + (i >> 2)) * (DM * 2); row_slot[pos] = rbeg * 4 + i; row_gate[pos] = ld_agent_f(tok_g + (size_t)rbeg * 4 + i); ++pos; } }
        for (int e = blk; e < 32; e += G) for (int r = pst_s[e] + cnt_s[e] + tid; r < pst_s[e + 1]; r += 512) { row_off[r] = 0; row_slot[r] = MROWS * 4; row_gate[r] = 0.f; }
        if (blk == 0) { const int nT = pst_s[32] >> 8;
            for (int t = tid; t < nT; t += 512) { int e = 0; while (e < 31 && t * 256 >= pst_s[e + 1]) ++e; tile_exp[t] = e; }
            if (tid == 0) __hip_atomic_store((int*)(ctl + CW_NT), nT, RLX_AGENT); }
        __syncthreads();
        if (BOTH(7)) GRID_BAR();
    }

    {
        int nT = 0, TPC = 0;
        if (lo < 12 && hi > 8) { nT = __builtin_amdgcn_readfirstlane(ld_agent_i((const int*)(ctl + CW_NT))); TPC = (nT + 1) >> 1; }
        if (IN(8)) {
            pg8::Gemm g{Hb, WguT, DM, DM, 8, row_off, tile_exp, 0};
            pg8::StaticOrder S; S.init(TPC, 8, G, blk);
            pg8::EpiAct E{ACT, PF(22), tile_exp, 0};
            pg8::gemm_phase<1, pg8::EpiAct>(L, g, S, E);
            if (BOTH(8)) GRID_BAR();
        }
        if (IN(9)) {
            pg8::Gemm g{ACT, WdnT, FF, FF, 4, nullptr, tile_exp, 0};
            pg8::StaticOrder S; S.init(TPC, 4, G, blk);
            pg8::EpiDown E{Y, PF(24), tile_exp, row_slot, row_gate, 0};
            pg8::gemm_phase<2, pg8::EpiDown>(L, g, S, E);
            if (BOTH(9)) GRID_BAR();
        }
        if (IN(10)) {
            pg8::Gemm g{Hb, WguT, DM, DM, 8, row_off, tile_exp, TPC};
            pg8::StaticOrder S; S.init(nT - TPC, 8, G, blk);
            pg8::EpiAct E{ACT, PF(22), tile_exp, TPC};
            pg8::gemm_phase<1, pg8::EpiAct>(L, g, S, E);
            if (BOTH(10)) GRID_BAR();
        }
        if (IN(11)) {
            pg8::Gemm g{ACT, WdnT, FF, FF, 4, nullptr, tile_exp, TPC};
            pg8::StaticOrder S; S.init(nT - TPC, 4, G, blk);
            pg8::EpiDown E{Y, PF(24), tile_exp, row_slot, row_gate, TPC};
            pg8::gemm_phase<2, pg8::EpiDown>(L, g, S, E);
            if (BOTH(11)) GRID_BAR();
        }
    }

    if (IN(12)) {
        for (int row = gw; row < MROWS; row += NGW) {
            const int b = row / TT, t = row - b * TT;
            if (t < NMETA) continue;
            f32x4 v[4]; float s = 0.f;
#pragma unroll
            for (int j = 0; j < 4; ++j) {
                const u32x2 hw = *(const u32x2*)(Hb + (size_t)row * DM + 4 * lane + 256 * j);
                f32x4 acc = (f32x4){bflo(hw.x), bfhi(hw.x), bflo(hw.y), bfhi(hw.y)} * DN_ALPHA;
#pragma unroll
                for (int k = 0; k < 4; ++k) { const u32x2 yw = *(const u32x2*)(Y + ((size_t)row * 4 + k) * DM + 4 * lane + 256 * j);
                    acc += (f32x4){bflo(yw.x), bfhi(yw.x), bflo(yw.y), bfhi(yw.y)}; }
                v[j] = acc; s += (acc[0] + acc[1]) + (acc[2] + acc[3]);
            }
            const float mean = wave_sum(s) * (1.f / DM); float s2 = 0.f;
#pragma unroll
            for (int j = 0; j < 4; ++j) { const f32x4 d = v[j] - mean; s2 += (d[0] * d[0] + d[1] * d[1]) + (d[2] * d[2] + d[3] * d[3]); }
            const float rstd = 1.0f / sqrtf(wave_sum(s2) * (1.f / DM) + LN_EPS);
            float* orow = (float*)DOUTP + ((size_t)b * SEQ + (t - NMETA)) * DM;
#pragma unroll
            for (int j = 0; j < 4; ++j) {
                const f32x4 gg = *(const f32x4*)(PF(25) + 4 * lane + 256 * j), bb = *(const f32x4*)(PF(26) + 4 * lane + 256 * j);
                *(f32x4*)(orow + 4 * lane + 256 * j) = (v[j] - mean) * rstd * gg + bb;
            }
        }
    }
#undef IN
#undef BOTH
#undef GRID_BAR
}

constexpr int N_PHASES = 13;
extern "C" void kernel_launch(void* const* d_in, const int* in_sizes, int n_in, void* d_out, int out_size, void* d_ws, size_t ws_size, hipStream_t stream) {
    static int grid = 0;
    if (grid == 0) {
        if (n_in != 27 || ws_size < WS_END) { fprintf(stderr, "kernel_launch: unexpected n_in %d / ws_size %zu\n", n_in, ws_size); grid = -1; return; }
        int dev = 0, cus = 0;
        if (hipGetDevice(&dev) != hipSuccess || hipDeviceGetAttribute(&cus, hipDeviceAttributeMultiprocessorCount, dev) != hipSuccess) { grid = -1; return; }
        if (hipFuncSetAttribute((const void*)hybrid_fwd, hipFuncAttributeMaxDynamicSharedMemorySize, LDS_BYTES) != hipSuccess) { fprintf(stderr, "kernel_launch: hipFuncSetAttribute failed\n"); grid = -1; return; }
        int per_cu = 0;
        (void)hipOccupancyMaxActiveBlocksPerMultiprocessor(&per_cu, (const void*)hybrid_fwd, NWAVES * 64, LDS_BYTES);
        (void)hipGetLastError();
        grid = cus > 0 ? cus : 256;
    }
    if (grid < 0) return;
    (void)hipMemsetAsync((char*)d_ws + WS_CTL, 0, CTL_ZERO_BYTES, stream);
    Args a{};
    const float** fp = (const float**)&a;
    for (int i = 0; i < 27; ++i) fp[i] = (const float*)d_in[i];
    a.out = (float*)d_out; a.ws = (unsigned char*)d_ws;
#if MK_PER_PHASE
    for (int p = 0; p < N_PHASES; ++p) { a.ph_lo = p; a.ph_hi = p + 1; hipLaunchKernelGGL(hybrid_fwd, dim3(grid), dim3(NWAVES * 64), LDS_BYTES, stream, a); }
#else
    a.ph_lo = 0; a.ph_hi = N_PHASES;
    hipLaunchKernelGGL(hybrid_fwd, dim3(grid), dim3(NWAVES * 64), LDS_BYTES, stream, a);
#endif
}
```

```cpp
#include <hip/hip_runtime.h>
#include <hip/hip_bf16.h>
#include <cstdio>
#include <cstdint>
#include <cmath>

#ifndef MK_PER_PHASE
#define MK_PER_PHASE 0
#endif

#ifndef REP_ALL
#define REP_ALL 1
#endif
#ifndef REP_0
#define REP_0 REP_ALL
#endif
#ifndef REP_1
#define REP_1 REP_ALL
#endif
#ifndef REP_2A
#define REP_2A REP_ALL
#endif
#ifndef REP_2B
#define REP_2B REP_ALL
#endif
#ifndef REP_3
#define REP_3 REP_ALL
#endif
#ifndef REP_4
#define REP_4 REP_ALL
#endif
#ifndef REP_5
#define REP_5 REP_ALL
#endif
#ifndef REP_6
#define REP_6 REP_ALL
#endif
#ifndef REP_7
#define REP_7 REP_ALL
#endif
#ifndef REP_8
#define REP_8 REP_ALL
#endif
#ifndef REP_9
#define REP_9 REP_ALL
#endif
#ifndef REP_10
#define REP_10 REP_ALL
#endif
#ifndef REP_11
#define REP_11 REP_ALL
#endif
#ifndef REP_12
#define REP_12 REP_ALL
#endif
#define REPLOOP(k) _Pragma("unroll 1") for (int rep_ = 0; rep_ < REP_##k; ++rep_)
#define LAS __attribute__((address_space(3)))
#define GAS __attribute__((address_space(1)))
typedef unsigned short bf16_t;
typedef short bf16x8 __attribute__((ext_vector_type(8)));
typedef float f32x4 __attribute__((ext_vector_type(4)));
typedef float f32x2 __attribute__((ext_vector_type(2)));
typedef unsigned u32x4 __attribute__((ext_vector_type(4)));
typedef unsigned u32x2 __attribute__((ext_vector_type(2)));
typedef __bf16 bf16x2_t __attribute__((ext_vector_type(2)));
#define RLX_AGENT __ATOMIC_RELAXED, __HIP_MEMORY_SCOPE_AGENT

constexpr int NB = 16, SEQ = 4096, NMETA = 16, TT = SEQ + NMETA  , MROWS = NB * TT  , DM = 1024;
constexpr int NZ = 5632;
constexpr int ZQ = 0, ZK = 512, ZV = 1024, ZMQ = 1536, ZMK = 2048, ZMV = 2560, ZMO = 3072, ZGA = 3584, ZGM = 4608;
constexpr int ZYC = 0, ZTMP = 1024, ZMRG = 2048;
constexpr int NIN = 5640;
constexpr int NE = 32, FF = 1024;
constexpr int OROWS = 4352;
constexpr float LN_EPS = 1e-5f;
constexpr float DN_ALPHA = 1.189207115002721f;
constexpr float LAMBDA_INIT = 0.2f;
constexpr float ATT_C2 = 0.125f * 1.4426950408889634f;

constexpr size_t MiB = 1u << 20;
constexpr size_t WS_CTL = 0, CTL_ZERO_BYTES = 1 * MiB;
constexpr size_t WS_WIN = 2 * MiB;
constexpr size_t WS_WA = 13 * MiB;
constexpr size_t WS_WM = 14 * MiB;
constexpr size_t WS_WO = 15 * MiB;
constexpr size_t WS_ROPE = 17 * MiB;
constexpr size_t WS_STATS = 19 * MiB;
constexpr size_t WS_GATES = 20 * MiB;
constexpr size_t WS_TOKE = 23 * MiB;
constexpr size_t WS_TOKG = 24 * MiB + 512 * 1024;
constexpr size_t WS_HIST = 26 * MiB;
constexpr size_t WS_ROWOFF = 27 * MiB;
constexpr size_t WS_ROWSLOT = 28 * MiB + 512 * 1024;
constexpr size_t WS_ROWGATE = 30 * MiB;
constexpr size_t WS_TILEEXP = 31 * MiB + 512 * 1024;
constexpr size_t WS_H = 32 * MiB;
constexpr size_t WS_Z = 162 * MiB;
constexpr size_t WS_Y = WS_Z;
constexpr size_t WS_ACT = WS_Z + 516 * MiB;
constexpr size_t WS_END = 1024 * MiB;
constexpr size_t DO_O = 0;
constexpr size_t DO_HM = 136 * MiB;
constexpr size_t DO_WGU = 0;
constexpr size_t DO_WDN = 128 * MiB;
constexpr int CW_TMO = 0, CW_NT = 64, CW_BAR = 4096;

constexpr int LDS_BYTES = 147456;
constexpr int MISC_OFF = 147456 - 512;
constexpr int NWAVES = 8;

__device__ __forceinline__ unsigned pkbf(float lo, float hi) { f32x2 v = {lo, hi}; bf16x2_t b = __builtin_convertvector(v, bf16x2_t); return __builtin_bit_cast(unsigned, b); }
__device__ __forceinline__ float bflo(unsigned w) { return __uint_as_float(w << 16); }
__device__ __forceinline__ float bfhi(unsigned w) { return __uint_as_float(w & 0xffff0000u); }
__device__ __forceinline__ float sigmoidf_(float x) { return __builtin_amdgcn_rcpf(1.0f + __expf(-x)); }
template <int CTRL> __device__ __forceinline__ float dppf(float v) { return __builtin_bit_cast(float, __builtin_amdgcn_update_dpp(0, __builtin_bit_cast(int, v), CTRL, 0xF, 0xF, true)); }
__device__ __forceinline__ float rdlane(float v, int l) { return __builtin_bit_cast(float, __builtin_amdgcn_readlane(__builtin_bit_cast(int, v), l)); }
__device__ __forceinline__ float row_sum16(float v) { v += dppf<0xB1>(v); v += dppf<0x4E>(v); v += dppf<0x141>(v); v += dppf<0x140>(v); return v; }
__device__ __forceinline__ float wave_sum(float v) { v = row_sum16(v); return (rdlane(v, 0) + rdlane(v, 16)) + (rdlane(v, 32) + rdlane(v, 48)); }
__device__ __forceinline__ float wave_max(float v) {
    v = fmaxf(v, dppf<0xB1>(v)); v = fmaxf(v, dppf<0x4E>(v)); v = fmaxf(v, dppf<0x141>(v)); v = fmaxf(v, dppf<0x140>(v));
    return fmaxf(fmaxf(rdlane(v, 0), rdlane(v, 16)), fmaxf(rdlane(v, 32), rdlane(v, 48)));
}
__device__ __forceinline__ float xreduce32(float (&p)[32], int lane) {
    float a[16], b[8], c[4], d[2];
#pragma unroll
    for (int i = 0; i < 16; ++i) { auto r = __builtin_amdgcn_permlane32_swap(__float_as_uint(p[i]), __float_as_uint(p[16 + i]), false, false); a[i] = __uint_as_float(r[0]) + __uint_as_float(r[1]); }
#pragma unroll
    for (int i = 0; i < 8; ++i) { auto r = __builtin_amdgcn_permlane16_swap(__float_as_uint(a[i]), __float_as_uint(a[8 + i]), false, false); b[i] = __uint_as_float(r[0]) + __uint_as_float(r[1]); }
    const bool b3 = (lane & 8) != 0, b2 = (lane & 4) != 0, b1 = (lane & 2) != 0;
#pragma unroll
    for (int i = 0; i < 4; ++i) { const float keep = b3 ? b[4 + i] : b[i], send = b3 ? b[i] : b[4 + i]; c[i] = keep + dppf<0x128>(send); }
#pragma unroll
    for (int i = 0; i < 2; ++i) { const float keep = b2 ? c[2 + i] : c[i], send = b2 ? c[i] : c[2 + i]; d[i] = keep + dppf<0x141>(send); }
    const float keep = b1 ? d[1] : d[0], send = b1 ? d[0] : d[1];
    float r = keep + dppf<0x4E>(send);
    r += dppf<0xB1>(r);
    return r;
}
__device__ __forceinline__ int ld_agent_i(const int* p) { return __hip_atomic_load(p, RLX_AGENT); }
__device__ __forceinline__ float ld_agent_f(const float* p) { return __hip_atomic_load(p, RLX_AGENT); }
#define LDS_WAIT() asm volatile("s_waitcnt lgkmcnt(0)" ::: "memory")
__device__ __forceinline__ const void* ldptr(LAS const unsigned long long* t, int i) { const unsigned long long v = t[i];
    const unsigned lo = (unsigned)__builtin_amdgcn_readfirstlane((int)(unsigned)v), hi = (unsigned)__builtin_amdgcn_readfirstlane((int)(unsigned)(v >> 32));
    return (const void*)(const GAS void*)(((unsigned long long)hi << 32) | lo); }

namespace pg8 {
constexpr int BM = 256, BK = 64, HALF = 128, HTB = HALF * BK * 2, STAGE_BYTES = 8 * HTB, NXCD = 8, WGM = 8;
__host__ __device__ __forceinline__ int lds_byte(int r, int c) { const int st = (r >> 4) * 2 + (c >> 5), rr = r & 15, cc = c & 31, ob = rr * 64 + cc * 2; return st * 1024 + (ob ^ (((ob >> 9) & 1) << 5)); }
__host__ __device__ __forceinline__ void stage_rc(int b, int& R, int& C) { const int st = b / 1024, sb = b % 1024, swz = sb ^ (((sb >> 9) & 1) << 5); R = (st >> 1) * 16 + swz / 64; C = (st & 1) * 32 + (swz % 64) / 2; }
__host__ __device__ __forceinline__ int perm32(int rho) { const int n = rho >> 4, i = rho & 15; return 8 * (i >> 2) + 4 * n + (i & 3); }

struct Unit { int pm, pn; };
struct Gemm { const bf16_t* A; const bf16_t* Bt; int lda, K, nN; const int* row_off; const int* tile_exp; int pm0; };
struct StaticOrder {
    int nM, nN, nwg, G, c;
    __device__ __forceinline__ void init(int nM_, int nN_, int G_, int c_) { nM = nM_; nN = nN_; nwg = nM * nN; G = G_; c = c_; }
    __device__ __forceinline__ bool next(int i, Unit& u) const {
        const long L = (long)i * G + c; if (L >= nwg) return false;
        int wgid = (int)L; { const int q = nwg / NXCD, r = nwg % NXCD, xcd = wgid % NXCD, off = wgid / NXCD; wgid = (xcd < r ? xcd * (q + 1) : r * (q + 1) + (xcd - r) * q) + off; }
        const int nig = WGM * nN, gid = wgid / nig, fm = gid * WGM, gsz = (nM - fm) < WGM ? (nM - fm) : WGM;
        u.pm = fm + ((wgid % nig) % gsz); u.pn = (wgid % nig) / gsz; return true;
    }
};

template <int MODE, class Epi>
__device__ __forceinline__ void gemm_phase(LAS unsigned char* lds, const Gemm g, const StaticOrder& S, const Epi& E) {
    const int tid = threadIdx.x, wid = __builtin_amdgcn_readfirstlane(tid >> 6), lane = tid & 63, wr = wid >> 2, wc = wid & 3, fr = lane & 15, fq = lane >> 4;
    const int K = g.K, nt = K / BK;
    unsigned voffA[2], voffB[2]; int Rst[2], Cst[2];
#pragma unroll
    for (int i = 0; i < 2; ++i) { int R, C; stage_rc(tid * 16 + i * 8192, R, C); const int Rb = Epi::PERM ? ((R & ~31) + perm32(R & 31)) : R;
        voffA[i] = (unsigned)(R * g.lda + C) * 2u; voffB[i] = (unsigned)(Rb * K + C) * 2u; Rst[i] = R; Cst[i] = C * 2; }
    const size_t kstep = (size_t)(BK * 2);
    const size_t hstepA = (size_t)HALF * g.lda * 2, hstepB = (size_t)HALF * K * 2;
    const size_t tstepA = 2 * hstepA, tstepB = 2 * hstepB;
    const unsigned ldsw = (unsigned)wid * 1024u;
    const int aoff = lds_byte(wr * 64 + fr, fq * 8), boff = lds_byte(wc * 32 + fr, fq * 8);
    unsigned vC[2][2] = {{0u, 0u}, {0u, 0u}}, vN[2][2] = {{0u, 0u}, {0u, 0u}};
#define PG8_SA(b, h) (((b) * 2 + (h)) * HTB)
#define PG8_SB(b, h) ((4 + (b) * 2 + (h)) * HTB)
#define PG8_STAGE_B(bufoff, gbase) do { _Pragma("unroll") for (int _i = 0; _i < 2; ++_i) \
        __builtin_amdgcn_global_load_lds((const unsigned*)((const char*)(gbase) + voffB[_i]), (LAS unsigned*)(lds + (bufoff) + ldsw + _i * 8192), 16, 0, 0); } while (0)
#define PG8_STAGE_A(bufoff, gbase, h, nx) do { _Pragma("unroll") for (int _i = 0; _i < 2; ++_i) { \
        const char* _p = (MODE == 1) ? ((const char*)(gbase) + ((nx) ? vN[h][_i] : vC[h][_i])) : ((const char*)(gbase) + (h) * hstepA + voffA[_i]); \
        __builtin_amdgcn_global_load_lds((const unsigned*)_p, (LAS unsigned*)(lds + (bufoff) + ldsw + _i * 8192), 16, 0, 0); } } while (0)
#define PG8_LDA(dst, b, h) do { _Pragma("unroll") for (int m = 0; m < 4; ++m) _Pragma("unroll") for (int k = 0; k < 2; ++k) dst[m][k] = *(const LAS bf16x8*)(lds + PG8_SA(b, h) + aoff + m * 2048 + k * 1024); } while (0)
#define PG8_LDB(dst, b, h) do { _Pragma("unroll") for (int n = 0; n < 2; ++n) _Pragma("unroll") for (int k = 0; k < 2; ++k) dst[n][k] = *(const LAS bf16x8*)(lds + PG8_SB(b, h) + boff + n * 2048 + k * 1024); } while (0)
#define PG8_MMA(ai, bj, At, Bt) do { __builtin_amdgcn_s_setprio(1); _Pragma("unroll") for (int m = 0; m < 4; ++m) _Pragma("unroll") for (int n = 0; n < 2; ++n) _Pragma("unroll") for (int k = 0; k < 2; ++k) \
        acc[ai][bj][m][n] = __builtin_amdgcn_mfma_f32_16x16x32_bf16(Bt[n][k], At[m][k], acc[ai][bj][m][n], 0, 0, 0); __builtin_amdgcn_s_setprio(0); } while (0)
#define PG8_WAIT_V(n) asm volatile("s_waitcnt vmcnt(" #n ")" ::: "memory")
#define PG8_WAIT_L(n) asm volatile("s_waitcnt lgkmcnt(" #n ")" ::: "memory")
#define PG8_BAR __builtin_amdgcn_s_barrier()
#define PG8_SCHED __builtin_amdgcn_sched_barrier(0)
#define PG8_ABASE(u) ((MODE == 1) ? (const char*)g.A : (const char*)g.A + (size_t)(u).pm * tstepA)
#define PG8_BBASE(u) ((MODE == 0) ? (const char*)g.Bt + (size_t)(u).pn * tstepB : (const char*)g.Bt + ((size_t)__builtin_amdgcn_readfirstlane(ld_agent_i(g.tile_exp + g.pm0 + (u).pm)) * g.nN + (u).pn) * tstepB)
#define PG8_GATHER(dst, u) do { if (MODE == 1) { _Pragma("unroll") for (int _h = 0; _h < 2; ++_h) _Pragma("unroll") for (int _i = 0; _i < 2; ++_i) \
        dst[_h][_i] = (unsigned)ld_agent_i(g.row_off + (size_t)(g.pm0 + (u).pm) * BM + _h * HALF + Rst[_i]) + (unsigned)Cst[_i]; } } while (0)
    Unit cur, nxt; int ui = 0;
    if (!S.next(0, cur)) return;
    f32x4 acc[2][2][4][2];
#pragma unroll
    for (int a = 0; a < 2; ++a)
#pragma unroll
        for (int b = 0; b < 2; ++b)
#pragma unroll
            for (int m = 0; m < 4; ++m)
#pragma unroll
                for (int n = 0; n < 2; ++n) acc[a][b][m][n] = (f32x4){0.f, 0.f, 0.f, 0.f};
    bf16x8 At[4][2], B0[2][2], B1[2][2];
    const char* cA = PG8_ABASE(cur); const char* cB = PG8_BBASE(cur);
    PG8_GATHER(vC, cur);
    PG8_STAGE_B(PG8_SB(0, 0), cB); PG8_STAGE_B(PG8_SB(0, 1), cB + hstepB); PG8_STAGE_A(PG8_SA(0, 0), cA, 0, false); PG8_STAGE_A(PG8_SA(0, 1), cA, 1, false);
    if (wr == 1) PG8_BAR;
    PG8_WAIT_V(2); PG8_BAR;
    PG8_STAGE_B(PG8_SB(1, 0), cB + kstep); PG8_STAGE_A(PG8_SA(1, 0), cA + kstep, 0, false); PG8_STAGE_B(PG8_SB(1, 1), cB + hstepB + kstep);
    PG8_WAIT_V(6); PG8_BAR;
    for (;;) {
        const bool has_next = S.next(ui + 1, nxt);
        const char* nA = has_next ? PG8_ABASE(nxt) : cA; const char* nB = has_next ? PG8_BBASE(nxt) : cB;
        if (MODE == 1) { if (has_next) { PG8_GATHER(vN, nxt); } else {
#pragma unroll
            for (int _h = 0; _h < 2; ++_h)
#pragma unroll
                for (int _i = 0; _i < 2; ++_i) vN[_h][_i] = vC[_h][_i]; } }
        for (int t = 0; t < nt; t += 2) {
            const bool last = (t == nt - 2);
            const char* a1 = cA + (size_t)(t + 1) * kstep;
            const char* a2 = last ? nA : cA + (size_t)(t + 2) * kstep; const char* b2 = last ? nB : cB + (size_t)(t + 2) * kstep;
            const char* a3 = a2 + kstep; const char* b3 = b2 + kstep;
            PG8_LDB(B0, 0, 0); PG8_LDB(B1, 0, 1); PG8_SCHED; PG8_LDA(At, 0, 0); PG8_STAGE_A(PG8_SA(1, 1), a1, 1, false);
            PG8_WAIT_V(8); PG8_WAIT_L(0); PG8_BAR; PG8_MMA(0, 0, At, B0); PG8_MMA(0, 1, At, B1); PG8_BAR; PG8_SCHED;
            PG8_LDA(At, 0, 1); PG8_STAGE_B(PG8_SB(0, 0), b2); PG8_STAGE_B(PG8_SB(0, 1), b2 + hstepB); PG8_STAGE_A(PG8_SA(0, 0), a2, 0, last);
            PG8_WAIT_V(8); PG8_WAIT_L(0); PG8_BAR; PG8_MMA(1, 0, At, B0); PG8_MMA(1, 1, At, B1); PG8_BAR; PG8_SCHED;
            PG8_LDB(B0, 1, 0); PG8_LDB(B1, 1, 1); PG8_SCHED; PG8_LDA(At, 1, 0); PG8_STAGE_A(PG8_SA(0, 1), a2, 1, last);
            PG8_WAIT_V(8); PG8_WAIT_L(0); PG8_BAR; PG8_MMA(0, 0, At, B0); PG8_MMA(0, 1, At, B1); PG8_BAR; PG8_SCHED;
            PG8_LDA(At, 1, 1); PG8_STAGE_B(PG8_SB(1, 0), b3); PG8_STAGE_B(PG8_SB(1, 1), b3 + hstepB); PG8_STAGE_A(PG8_SA(1, 0), a3, 0, last);
            PG8_WAIT_V(8); PG8_WAIT_L(0); PG8_BAR; PG8_MMA(1, 0, At, B0); PG8_MMA(1, 1, At, B1); PG8_BAR; PG8_SCHED;
        }
        if (wr == 0) PG8_BAR;
        E(acc, cur, wr, wc, fr, fq);
        if (!has_next) break;
#pragma unroll
        for (int a = 0; a < 2; ++a)
#pragma unroll
            for (int b = 0; b < 2; ++b)
#pragma unroll
                for (int m = 0; m < 4; ++m)
#pragma unroll
                    for (int n = 0; n < 2; ++n) acc[a][b][m][n] = (f32x4){0.f, 0.f, 0.f, 0.f};
        cur = nxt; cA = nA; cB = nB; ++ui;
        if (MODE == 1) {
#pragma unroll
            for (int _h = 0; _h < 2; ++_h)
#pragma unroll
                for (int _i = 0; _i < 2; ++_i) vC[_h][_i] = vN[_h][_i]; }
        if (wr == 1) PG8_BAR;
    }
    PG8_WAIT_V(0);
    PG8_BAR;
#undef PG8_SA
#undef PG8_SB
#undef PG8_STAGE_A
#undef PG8_STAGE_B
#undef PG8_LDA
#undef PG8_LDB
#undef PG8_MMA
#undef PG8_WAIT_V
#undef PG8_WAIT_L
#undef PG8_BAR
#undef PG8_SCHED
#undef PG8_ABASE
#undef PG8_BBASE
#undef PG8_GATHER
}

struct EpiZ {
    static constexpr bool PERM = true;
    bf16_t* Z; const float* ropec; const float* ropes;
    __device__ __forceinline__ void operator()(const f32x4 (&acc)[2][2][4][2], const Unit& u, int wr, int wc, int fr, int fq) const {
        const int row0 = u.pm * BM + wr * 64 + fr;
        if (u.pn < 4) {
            const float sc = (u.pn < 2) ? ATT_C2 : 1.0f;
            const int dl = 16 * (wc & 1) + 4 * fq;
#pragma unroll
            for (int ai = 0; ai < 2; ++ai)
#pragma unroll
                for (int m = 0; m < 4; ++m) {
                    const int row = row0 + ai * HALF + m * 16; const int t = row % TT;
                    const f32x4 c = *(const f32x4*)(ropec + t * 32 + dl) * sc, s = *(const f32x4*)(ropes + t * 32 + dl) * sc;
#pragma unroll
                    for (int bj = 0; bj < 2; ++bj) {
                        const int hb = 4 * u.pn + 2 * bj + (wc >> 1);
                        const f32x4 x1 = acc[ai][bj][m][0], x2 = acc[ai][bj][m][1];
                        const f32x4 o1 = x1 * c - x2 * s, o2 = x2 * c + x1 * s;
                        bf16_t* p = Z + (size_t)row * NZ + hb * 64 + dl;
                        u32x2 w1, w2; w1.x = pkbf(o1[0], o1[1]); w1.y = pkbf(o1[2], o1[3]); w2.x = pkbf(o2[0], o2[1]); w2.y = pkbf(o2[2], o2[3]);
                        *(u32x2*)p = w1; *(u32x2*)(p + 32) = w2;
                    }
                }
        } else {
            const int col0 = u.pn * BM + wc * 32 + 8 * fq;
#pragma unroll
            for (int ai = 0; ai < 2; ++ai)
#pragma unroll
                for (int m = 0; m < 4; ++m) {
                    bf16_t* rowp = Z + (size_t)(row0 + ai * HALF + m * 16) * NZ + col0;
#pragma unroll
                    for (int bj = 0; bj < 2; ++bj) { const f32x4 v0 = acc[ai][bj][m][0], v1 = acc[ai][bj][m][1];
                        u32x4 w; w.x = pkbf(v0[0], v0[1]); w.y = pkbf(v0[2], v0[3]); w.z = pkbf(v1[0], v1[1]); w.w = pkbf(v1[2], v1[3]);
                        *(u32x4*)(rowp + bj * HALF) = w; }
                }
        }
    }
};
template <bool SECOND> struct EpiGate {
    static constexpr bool PERM = true;
    bf16_t* Z;
    __device__ __forceinline__ void operator()(const f32x4 (&acc)[2][2][4][2], const Unit& u, int wr, int wc, int fr, int fq) const {
        const int row0 = u.pm * BM + wr * 64 + fr, col0 = u.pn * BM + wc * 32 + 8 * fq;
#pragma unroll
        for (int ai = 0; ai < 2; ++ai)
#pragma unroll
            for (int m = 0; m < 4; ++m) {
                bf16_t* rowp = Z + (size_t)(row0 + ai * HALF + m * 16) * NZ + col0;
#pragma unroll
                for (int bj = 0; bj < 2; ++bj) {
                    const u32x4 gw = *(const u32x4*)(rowp + (SECOND ? ZGM : ZGA) + bj * HALF);
                    const f32x4 v0 = acc[ai][bj][m][0], v1 = acc[ai][bj][m][1];
                    float o[8];
                    o[0] = sigmoidf_(bflo(gw.x)) * v0[0]; o[1] = sigmoidf_(bfhi(gw.x)) * v0[1]; o[2] = sigmoidf_(bflo(gw.y)) * v0[2]; o[3] = sigmoidf_(bfhi(gw.y)) * v0[3];
                    o[4] = sigmoidf_(bflo(gw.z)) * v1[0]; o[5] = sigmoidf_(bfhi(gw.z)) * v1[1]; o[6] = sigmoidf_(bflo(gw.w)) * v1[2]; o[7] = sigmoidf_(bfhi(gw.w)) * v1[3];
                    if (SECOND) { const u32x4 tw = *(const u32x4*)(rowp + ZTMP + bj * HALF);
                        o[0] += bflo(tw.x); o[1] += bfhi(tw.x); o[2] += bflo(tw.y); o[3] += bfhi(tw.y); o[4] += bflo(tw.z); o[5] += bfhi(tw.z); o[6] += bflo(tw.w); o[7] += bfhi(tw.w); }
                    u32x4 w; w.x = pkbf(o[0], o[1]); w.y = pkbf(o[2], o[3]); w.z = pkbf(o[4], o[5]); w.w = pkbf(o[6], o[7]);
                    *(u32x4*)(rowp + (SECOND ? ZMRG : ZTMP) + bj * HALF) = w;
                }
            }
    }
};
struct EpiPre1 {
    static constexpr bool PERM = false;
    float* P1; const float* x; const float* meta; const float* stats; const float* g0; const float* b0;
    __device__ __forceinline__ void operator()(const f32x4 (&acc)[2][2][4][2], const Unit& u, int wr, int wc, int fr, int fq) const {
        const int row0 = u.pm * BM + wr * 64 + fr, col0 = u.pn * BM + wc * 32 + 4 * fq;
        f32x4 gv[2][2], bv[2][2];
#pragma unroll
        for (int bj = 0; bj < 2; ++bj)
#pragma unroll
            for (int n = 0; n < 2; ++n) { gv[bj][n] = *(const f32x4*)(g0 + col0 + bj * HALF + n * 16); bv[bj][n] = *(const f32x4*)(b0 + col0 + bj * HALF + n * 16); }
#pragma unroll
        for (int ai = 0; ai < 2; ++ai)
#pragma unroll
            for (int m = 0; m < 4; ++m) {
                const int row = row0 + ai * HALF + m * 16; const int b = row / TT, t = row - b * TT;
                const float* xr = (t < NMETA) ? meta + (size_t)t * DM : x + ((size_t)b * SEQ + (t - NMETA)) * DM;
                const float mean = ld_agent_f(stats + 2 * row), rstd = ld_agent_f(stats + 2 * row + 1);
                float* orow = P1 + (size_t)row * (NZ / 2) + col0;
#pragma unroll
                for (int bj = 0; bj < 2; ++bj)
#pragma unroll
                    for (int n = 0; n < 2; ++n) { const f32x4 xv = *(const f32x4*)(xr + col0 + bj * HALF + n * 16);
                        const f32x4 hv = (xv - mean) * rstd * gv[bj][n] + bv[bj][n];
                        *(f32x4*)(orow + bj * HALF + n * 16) = hv * DN_ALPHA + acc[ai][bj][m][n]; }
            }
    }
};
struct EpiAct {
    static constexpr bool PERM = true;
    bf16_t* ACT; const float* b_gu; const int* tile_exp; int pm0;
    __device__ __forceinline__ void operator()(const f32x4 (&acc)[2][2][4][2], const Unit& u, int wr, int wc, int fr, int fq) const {
        const int e = __builtin_amdgcn_readfirstlane(ld_agent_i(tile_exp + pm0 + u.pm));
        const int ac0 = u.pn * HALF + wc * 32 + 8 * fq;
        const float* bp = b_gu + (size_t)e * 2 * FF + 2 * ac0;
        float bg[8], bl[8];
#pragma unroll
        for (int q = 0; q < 4; ++q) { const f32x4 v = *(const f32x4*)(bp + 4 * q); bg[2 * q] = v[0]; bl[2 * q] = v[1]; bg[2 * q + 1] = v[2]; bl[2 * q + 1] = v[3]; }
        const int row0 = u.pm * BM + wr * 64 + fr;
#pragma unroll
        for (int ai = 0; ai < 2; ++ai)
#pragma unroll
            for (int m = 0; m < 4; ++m) {
                float o[8];
#pragma unroll
                for (int j = 0; j < 8; ++j) {
                    float gl = acc[ai][0][m][j >> 2][j & 3] + bg[j], li = acc[ai][1][m][j >> 2][j & 3] + bl[j];
                    gl = fminf(gl, 7.0f); li = fminf(fmaxf(li, -7.0f), 7.0f);
                    o[j] = gl * sigmoidf_(1.702f * gl) * (li + 1.0f);
                }
                u32x4 w; w.x = pkbf(o[0], o[1]); w.y = pkbf(o[2], o[3]); w.z = pkbf(o[4], o[5]); w.w = pkbf(o[6], o[7]);
                *(u32x4*)(ACT + (size_t)(row0 + ai * HALF + m * 16) * FF + ac0) = w;
            }
    }
};
struct EpiDown {
    static constexpr bool PERM = true;
    bf16_t* Y; const float* b_down; const int* tile_exp; const int* row_slot; const float* row_gate; int pm0;
    __device__ __forceinline__ void operator()(const f32x4 (&acc)[2][2][4][2], const Unit& u, int wr, int wc, int fr, int fq) const {
        const int e = __builtin_amdgcn_readfirstlane(ld_agent_i(tile_exp + pm0 + u.pm));
        const int col0 = u.pn * BM + wc * 32 + 8 * fq;
        f32x4 bv[2][2];
#pragma unroll
        for (int bj = 0; bj < 2; ++bj)
#pragma unroll
            for (int n = 0; n < 2; ++n) bv[bj][n] = *(const f32x4*)(b_down + (size_t)e * DM + col0 + bj * HALF + 4 * n);
        const int r0 = (pm0 + u.pm) * BM + wr * 64 + fr;
#pragma unroll
        for (int ai = 0; ai < 2; ++ai)
#pragma unroll
            for (int m = 0; m < 4; ++m) {
                const int r = r0 + ai * HALF + m * 16;
                const int slot = ld_agent_i(row_slot + r); const float gt = ld_agent_f(row_gate + r);
                bf16_t* rowp = Y + (size_t)slot * DM + col0;
#pragma unroll
                for (int bj = 0; bj < 2; ++bj) { const f32x4 v0 = (acc[ai][bj][m][0] + bv[bj][0]) * gt, v1 = (acc[ai][bj][m][1] + bv[bj][1]) * gt;
                    u32x4 w; w.x = pkbf(v0[0], v0[1]); w.y = pkbf(v0[2], v0[3]); w.z = pkbf(v1[0], v1[1]); w.w = pkbf(v1[2], v1[3]);
                    *(u32x4*)(rowp + bj * HALF) = w; }
            }
    }
};
}

namespace attn_body {
using bf16 = __hip_bfloat16;
using s16x4 = __attribute__((ext_vector_type(4))) short;
using f32x16 = __attribute__((ext_vector_type(16))) float;
constexpr int D = 64, PZ = NZ, PO = 1024;
constexpr int NW = 8, QBLK = 32, QB = QBLK * NW, KVBLK = 64;
__device__ __forceinline__ int crow(int r, int hi) { return (r & 3) + 8 * (r >> 2) + 4 * hi; }
#define SBAR() __builtin_amdgcn_sched_barrier(0)
__device__ __forceinline__ void cmask(f32x16& p0, f32x16& p1, int jb, int qrel, int hi) {
    const float NEG = -INFINITY; const int d = qrel - 64 * jb - 4 * hi;
#pragma unroll
    for (int r = 0; r < 16; ++r) { const int c = (r & 3) + 8 * (r >> 2); if (c > d) p0[r] = NEG; if (c + 32 > d) p1[r] = NEG; }
}
constexpr int NSLOT = 3, SLOTB = 8192;
constexpr int LDS_K = 0, LDS_V = NSLOT * SLOTB, LDS_WS = 2 * NSLOT * SLOTB, LDS_OST = LDS_WS + NW * 64 * 4, LDS_BYTES_A = LDS_OST + NW * 4096;
__device__ __forceinline__ void glds16(const void* gsrc, unsigned lds_dst) { unsigned keep;
    asm volatile("s_mov_b32 %0, m0\n\ts_mov_b32 m0, %2\n\ts_nop 0\n\tglobal_load_lds_dwordx4 %1, off\n\ts_mov_b32 m0, %0" : "=&s"(keep) : "v"(gsrc), "s"(lds_dst) : "memory"); }
__device__ __forceinline__ float max3f(float a, float b, float c) { float r; asm("v_max3_f32 %0, %1, %2, %3" : "=v"(r) : "v"(a), "v"(b), "v"(c)); return r; }
__device__ __forceinline__ float max2f(float a, float b) { float r; asm("v_max_f32_e32 %0, %1, %2" : "=v"(r) : "v"(a), "v"(b)); return r; }
__device__ __forceinline__ float fadd_s(float a, float b) { float r; asm("v_add_f32_e32 %0, %1, %2" : "=v"(r) : "v"(a), "v"(b)); return r; }
__device__ __forceinline__ float fsub_s(float a, float b) { float r; asm("v_sub_f32_e32 %0, %1, %2" : "=v"(r) : "v"(a), "v"(b)); return r; }
__device__ __forceinline__ unsigned cvtpk_s(float lo, float hi) { return pkbf(lo, hi); }
#define WAIT_BAR(N) asm volatile("s_waitcnt vmcnt(" #N ") lgkmcnt(0)\n\ts_barrier" ::: "memory")
__device__ __forceinline__ void qkt(f32x16& p0, f32x16& p1, const char* Kslot, const bf16x8* qr, const f32x16& negm, int r32, int hi) {
    const char* kb = Kslot + hi * 1024 + r32 * 16;
#pragma unroll
    for (int d0 = 0; d0 < 4; ++d0) {
        const bf16x8 b0 = *reinterpret_cast<const bf16x8*>(kb + d0 * 2048);
        const bf16x8 b1 = *reinterpret_cast<const bf16x8*>(kb + d0 * 2048 + 512);
        if (d0 == 0) { p0 = __builtin_amdgcn_mfma_f32_32x32x16_bf16(b0, qr[0], negm, 0, 0, 0); p1 = __builtin_amdgcn_mfma_f32_32x32x16_bf16(b1, qr[0], negm, 0, 0, 0); }
        else { p0 = __builtin_amdgcn_mfma_f32_32x32x16_bf16(b0, qr[d0], p0, 0, 0, 0); p1 = __builtin_amdgcn_mfma_f32_32x32x16_bf16(b1, qr[d0], p1, 0, 0, 0); } }
}
typedef __attribute__((address_space(3))) const char* lds_cptr;
typedef short v4i16_t __attribute__((ext_vector_type(4)));
__device__ __forceinline__ void kload8(bf16x8* kf, lds_cptr kp) {
    kf[0] = *(const __attribute__((address_space(3))) bf16x8*)(kp);        kf[1] = *(const __attribute__((address_space(3))) bf16x8*)(kp + 512);
    kf[2] = *(const __attribute__((address_space(3))) bf16x8*)(kp + 2048); kf[3] = *(const __attribute__((address_space(3))) bf16x8*)(kp + 2560);
    kf[4] = *(const __attribute__((address_space(3))) bf16x8*)(kp + 4096); kf[5] = *(const __attribute__((address_space(3))) bf16x8*)(kp + 4608);
    kf[6] = *(const __attribute__((address_space(3))) bf16x8*)(kp + 6144); kf[7] = *(const __attribute__((address_space(3))) bf16x8*)(kp + 6656);
}
__device__ __forceinline__ void kload2(bf16x8* kf, lds_cptr kp, int j) { kf[2 * j] = *(const __attribute__((address_space(3))) bf16x8*)(kp + j * 2048); kf[2 * j + 1] = *(const __attribute__((address_space(3))) bf16x8*)(kp + j * 2048 + 512); }
__device__ __forceinline__ s16x4 vtr(lds_cptr p) { return __builtin_bit_cast(s16x4, __builtin_amdgcn_ds_read_tr16_b64_v4i16((__attribute__((address_space(3))) v4i16_t*)p)); }
__device__ __forceinline__ float rowmax(const f32x16& p0, const f32x16& p1) {
    float a = max3f(p0[0], p0[1], p1[0]), b = max3f(p0[2], p0[3], p1[1]); a = max3f(a, p1[2], p1[3]);
#pragma unroll
    for (int r = 4; r < 16; r += 4) { a = max3f(a, p0[r], p0[r + 1]); b = max3f(b, p0[r + 2], p0[r + 3]); a = max3f(a, p1[r], p1[r + 1]); b = max3f(b, p1[r + 2], p1[r + 3]); }
    const float m = max2f(a, b);
    auto rr = __builtin_amdgcn_permlane32_swap(__float_as_uint(m), __float_as_uint(m), false, false);
    return max2f(__uint_as_float(rr[0]), __uint_as_float(rr[1]));
}
__device__ __forceinline__ void pv(f32x16* o, int vb, bf16x8 pa0, bf16x8 pa1, bf16x8 pa2, bf16x8 pa3) {
#pragma unroll
    for (int d0 = 0; d0 < 2; ++d0) { s16x4 lo[4], hi[4];
#pragma unroll
        for (int ks = 0; ks < 4; ++ks) {
            asm volatile("ds_read_b64_tr_b16 %0,%1 offset:%c2" : "=&v"(lo[ks]) : "v"(vb), "i"(d0 * 4096 + ks * 1024) : "memory");
            asm volatile("ds_read_b64_tr_b16 %0,%1 offset:%c2" : "=&v"(hi[ks]) : "v"(vb), "i"(d0 * 4096 + ks * 1024 + 512) : "memory"); }
        asm volatile("s_waitcnt lgkmcnt(0)" ::: "memory"); SBAR();
#define PK(k) (bf16x8){lo[k][0], lo[k][1], lo[k][2], lo[k][3], hi[k][0], hi[k][1], hi[k][2], hi[k][3]}
        o[d0] = __builtin_amdgcn_mfma_f32_32x32x16_bf16(pa0, PK(0), o[d0], 0, 0, 0);
        o[d0] = __builtin_amdgcn_mfma_f32_32x32x16_bf16(pa1, PK(1), o[d0], 0, 0, 0);
        o[d0] = __builtin_amdgcn_mfma_f32_32x32x16_bf16(pa2, PK(2), o[d0], 0, 0, 0);
        o[d0] = __builtin_amdgcn_mfma_f32_32x32x16_bf16(pa3, PK(3), o[d0], 0, 0, 0);
#undef PK
    }
}
#define ATTN_STORE16(p, v) (*(u32x4*)(p) = (v))
template <int THRL> __device__ __forceinline__ void attn_unit(int qb, const bf16* Qh, const bf16* __restrict__ Kh, const bf16* __restrict__ Vh, bf16* Oh, char* shm) {
    const int tid = threadIdx.x; int lane = tid & 63; asm volatile("" : "+v"(lane));
    const int r32 = lane & 31, hi = lane >> 5; const int wid = __builtin_amdgcn_readfirstlane(tid >> 6);
    const int q0 = qb * QB;
    const bf16* Qw = Qh + (long)(q0 + wid * QBLK) * PZ;
    const unsigned lds0 = (unsigned)(uintptr_t)shm;
    float* wsf = (float*)(shm + LDS_WS) + wid * 64;
    const bf16* ksrc = Kh + (long)lane * PZ + wid * 8;
    const bf16* vsrc = Vh + (long)(16 * (wid & 3) + (lane >> 2)) * PZ + (wid >> 2) * 32 + (lane & 3) * 8;
    const unsigned kdst = lds0 + LDS_K + wid * 1024, vdst = lds0 + LDS_V + wid * 1024;
#define DMA_K(t, slot) glds16(ksrc + (long)(t) * KVBLK * PZ, (unsigned)__builtin_amdgcn_readfirstlane(kdst + (slot)))
#define DMA_V(t, slot) glds16(vsrc + (long)(t) * KVBLK * PZ, (unsigned)__builtin_amdgcn_readfirstlane(vdst + (slot)))
    const int vb0 = (int)(lds0 + LDS_V) + ((lane >> 4) & 1) * 32 + (lane & 3) * 8 + (4 * hi + ((lane & 15) >> 2)) * 64;
    const char* Kbase = shm + LDS_K; bf16x8 kf[8];
    const lds_cptr shm3 = (lds_cptr)shm; const lds_cptr kp0 = shm3 + LDS_K + hi * 1024 + r32 * 16; const lds_cptr vp0 = shm3 + LDS_V + ((lane >> 4) & 1) * 32 + (lane & 3) * 8 + (4 * hi + ((lane & 15) >> 2)) * 64;
    const int NT = (q0 + QB) / KVBLK;
    DMA_K(0, 0); DMA_V(0, 0); DMA_K(1, SLOTB);
    bf16x8 qr[4];
#pragma unroll
    for (int d0 = 0; d0 < 4; ++d0) qr[d0] = *reinterpret_cast<const bf16x8*>(&Qw[(long)r32 * PZ + d0 * 16 + hi * 8]);
    float mhat = 0.f, l_reg = 0.f; f32x16 o[2]; o[0] = f32x16{}; o[1] = f32x16{}; f32x16 negm = f32x16{}; asm volatile("" : "+v"(negm));
    const int qrel = wid * QBLK + r32;
#define CMASK(P0, P1, t) do { int jb_ = (t) - (NT - 4); if (jb_ >= 0) cmask(P0, P1, jb_, qrel, hi); } while (0)
    bool resc = false;
#define START(P0, P1) do { const float rm = rowmax(P0, P1); resc = false; \
    { const float dl = rm; mhat = fadd_s(mhat, dl); \
      _Pragma("unroll") for (int r = 0; r < 16; ++r) { P0[r] = fsub_s(P0[r], dl); P1[r] = fsub_s(P1[r], dl); } \
      _Pragma("unroll") for (int r = 0; r < 16; ++r) negm[r] = -mhat; asm volatile("" : "+v"(negm)); } \
    _Pragma("unroll") for (int r = 0; r < 16; ++r) P0[r] = __builtin_amdgcn_exp2f(P0[r]); } while (0)
#define RESC() do { if (resc) { asm volatile("s_waitcnt lgkmcnt(0)" ::: "memory"); \
      _Pragma("unroll") for (int d_ = 0; d_ < 2; ++d_) _Pragma("unroll") for (int r = 0; r < 16; ++r) o[d_][r] *= wsf[crow(r, hi)]; } } while (0)
    f32x16 pA0, pA1, pB0, pB1;
    int sl_prev = 0, sl_cur = 0, sl_next = SLOTB;
#define ROT() do { sl_prev = sl_cur; sl_cur = sl_next; sl_next = (sl_next == (NSLOT - 1) * SLOTB) ? 0 : sl_next + SLOTB; } while (0)
    DMA_K(2, 2 * SLOTB);
    WAIT_BAR(3);
    qkt(pA0, pA1, Kbase, qr, negm, r32, hi); asm volatile("s_nop 15\n\ts_nop 7" : "+v"(pA0), "+v"(pA1)); CMASK(pA0, pA1, 0);
    START(pA0, pA1);
    _Pragma("unroll") for (int r = 0; r < 16; ++r) pA1[r] = __builtin_amdgcn_exp2f(pA1[r]);
    WAIT_BAR(0);
    DMA_K(3, 0); DMA_V(1, SLOTB);
    ROT();
    kload8(kf, kp0 + sl_cur);
    WAIT_BAR(2);
    s16x4 vlo[8], vhi[8]; u32x4 pw0, pw1, pw2, pw3;
#define PKW(P, B) cvtpk_s(P[B], P[B + 1])
#define PAF(k) __builtin_bit_cast(bf16x8, pw##k)
#define VFR(i) (bf16x8){vlo[i][0], vlo[i][1], vlo[i][2], vlo[i][3], vhi[i][0], vhi[i][1], vhi[i][2], vhi[i][3]}
#define PIN(x) asm volatile("" : "+v"(x))
#define MX3(a, b, c) __builtin_fmaxf(__builtin_fmaxf((a), (b)), (c))
#define GAPA(MF, A0, A1, A2, A3, W0, W1, PW) do { MF; sacc += A0; sacc += A1; sacc += A2; sacc += A3; PIN(sacc); W0; W1; PIN(PW); SBAR(); } while (0)
#define EX(v) __builtin_amdgcn_exp2f(v)
#define GAPB(MF, X, B) do { MF; X[B] = EX(X[B]); X[B + 1] = EX(X[B + 1]); X[B + 2] = EX(X[B + 2]); X[B + 3] = EX(X[B + 3]); PIN(X); SBAR(); } while (0)
#define VRD(i) do { vlo[i] = vtr(vp_ + (((i) >> 2) * 4096 + ((i) & 3) * 1024)); vhi[i] = vtr(vp_ + (((i) >> 2) * 4096 + ((i) & 3) * 1024 + 512)); } while (0)
#define KRD(G, j) do { if (G) { kload2(kf, kp0 + sl_next, j); SBAR(); } } while (0)
#define STEP(C0, C1, P0, P1, t, GK, GV, GL) do { SBAR(); \
    const lds_cptr vp_ = vp0 + sl_prev; \
    VRD(0); SBAR(); float sacc = (P0[0] + P0[1]); \
    GAPA(C0 = __builtin_amdgcn_mfma_f32_32x32x16_bf16(kf[0], qr[0], negm, 0, 0, 0), P0[2], P0[3], P0[4], P0[5],     pw0[0] = PKW(P0, 0), pw0[1] = PKW(P0, 2), pw0); \
    VRD(4); SBAR(); GAPA(C1 = __builtin_amdgcn_mfma_f32_32x32x16_bf16(kf[1], qr[0], negm, 0, 0, 0), P0[6], P0[7], P0[8], P0[9],     pw0[2] = PKW(P0, 4), pw0[3] = PKW(P0, 6), pw0); \
    VRD(1); SBAR(); GAPA(C0 = __builtin_amdgcn_mfma_f32_32x32x16_bf16(kf[2], qr[1], C0, 0, 0, 0),   P0[10], P0[11], P0[12], P0[13], pw1[0] = PKW(P0, 8), pw1[1] = PKW(P0, 10), pw1); \
    VRD(5); SBAR(); GAPA(C1 = __builtin_amdgcn_mfma_f32_32x32x16_bf16(kf[3], qr[1], C1, 0, 0, 0),   P0[14], P0[15], P1[0], P1[1],   pw1[2] = PKW(P0, 12), pw1[3] = PKW(P0, 14), pw1); \
    VRD(2); SBAR(); GAPA(C0 = __builtin_amdgcn_mfma_f32_32x32x16_bf16(kf[4], qr[2], C0, 0, 0, 0),   P1[2], P1[3], P1[4], P1[5],     pw2[0] = PKW(P1, 0), pw2[1] = PKW(P1, 2), pw2); \
    VRD(6); SBAR(); GAPA(C1 = __builtin_amdgcn_mfma_f32_32x32x16_bf16(kf[5], qr[2], C1, 0, 0, 0),   P1[6], P1[7], P1[8], P1[9],     pw2[2] = PKW(P1, 4), pw2[3] = PKW(P1, 6), pw2); \
    VRD(3); SBAR(); GAPA(C0 = __builtin_amdgcn_mfma_f32_32x32x16_bf16(kf[6], qr[3], C0, 0, 0, 0),   P1[10], P1[11], P1[12], P1[13], pw3[0] = PKW(P1, 8), pw3[1] = PKW(P1, 10), pw3); \
    VRD(7); SBAR(); GAPA(C1 = __builtin_amdgcn_mfma_f32_32x32x16_bf16(kf[7], qr[3], C1, 0, 0, 0),   P1[14], P1[15], 0.f, 0.f,       pw3[2] = PKW(P1, 12), pw3[3] = PKW(P1, 14), pw3); \
    l_reg += sacc; \
    if (GK) { DMA_K((t) + 3, sl_cur); } if (GV) { DMA_V((t) + 1, sl_next); } \
    CMASK(C0, C1, t); \
    { float a = MX3(C0[0], C0[1], C1[0]), b = MX3(C0[2], C0[3], C1[1]); a = MX3(a, C1[2], C1[3]); \
      _Pragma("unroll") for (int r = 4; r < 16; r += 4) { a = MX3(a, C0[r], C0[r + 1]); b = MX3(b, C0[r + 2], C0[r + 3]); a = MX3(a, C1[r], C1[r + 1]); b = MX3(b, C1[r + 2], C1[r + 3]); } \
      float rm = __builtin_fmaxf(a, b); { auto rr = __builtin_amdgcn_permlane32_swap(__float_as_uint(rm), __float_as_uint(rm), false, false); rm = __builtin_fmaxf(__uint_as_float(rr[0]), __uint_as_float(rr[1])); } \
      resc = false; \
      if (__builtin_expect(__any(rm > (float)THRL), 0)) { const float dl = __builtin_fmaxf(rm, 0.f); mhat += dl; \
        _Pragma("unroll") for (int r = 0; r < 16; ++r) { C0[r] -= dl; C1[r] -= dl; } \
        _Pragma("unroll") for (int r = 0; r < 16; ++r) negm[r] = -mhat; asm volatile("" : "+v"(negm)); \
        const float f = __builtin_amdgcn_exp2f(-dl); l_reg *= f; if (hi == 0) wsf[r32] = f; resc = true; } } \
    SBAR(); \
    GAPB(o[0] = __builtin_amdgcn_mfma_f32_32x32x16_bf16(PAF(0), VFR(0), o[0], 0, 0, 0), C0, 0); \
    GAPB(o[1] = __builtin_amdgcn_mfma_f32_32x32x16_bf16(PAF(0), VFR(4), o[1], 0, 0, 0), C0, 4); \
    KRD(GL, 0); GAPB(o[0] = __builtin_amdgcn_mfma_f32_32x32x16_bf16(PAF(1), VFR(1), o[0], 0, 0, 0), C0, 8); \
    KRD(GL, 1); GAPB(o[1] = __builtin_amdgcn_mfma_f32_32x32x16_bf16(PAF(1), VFR(5), o[1], 0, 0, 0), C0, 12); \
    KRD(GL, 2); GAPB(o[0] = __builtin_amdgcn_mfma_f32_32x32x16_bf16(PAF(2), VFR(2), o[0], 0, 0, 0), C1, 0); \
    KRD(GL, 3); GAPB(o[1] = __builtin_amdgcn_mfma_f32_32x32x16_bf16(PAF(2), VFR(6), o[1], 0, 0, 0), C1, 4); \
    GAPB(o[0] = __builtin_amdgcn_mfma_f32_32x32x16_bf16(PAF(3), VFR(3), o[0], 0, 0, 0), C1, 8); \
    GAPB(o[1] = __builtin_amdgcn_mfma_f32_32x32x16_bf16(PAF(3), VFR(7), o[1], 0, 0, 0), C1, 12); \
    } while (0)
    int t = 1;
#undef CMASK
#define CMASK(P0, P1, t) do {} while (0)
    for (; t + 5 < NT; t += 2) {
        STEP(pB0, pB1, pA0, pA1, t, true, true, true);     WAIT_BAR(2); RESC(); ROT();
        STEP(pA0, pA1, pB0, pB1, t + 1, true, true, true); WAIT_BAR(2); RESC(); ROT();
    }
#undef CMASK
#define CMASK(P0, P1, t) do { int jb_ = (t) - (NT - 4); if (jb_ >= 0) cmask(P0, P1, jb_, qrel, hi); } while (0)
#define ENDW(tt) do { if ((tt) + 3 < NT) { WAIT_BAR(2); } else if ((tt) + 2 < NT) { WAIT_BAR(1); } else { WAIT_BAR(0); } } while (0)
    for (; t + 1 < NT; t += 2) {
        STEP(pB0, pB1, pA0, pA1, t, (t + 3 < NT), (t + 1 < NT), (t + 1 < NT));       ENDW(t);     RESC(); ROT();
        STEP(pA0, pA1, pB0, pB1, t + 1, (t + 4 < NT), (t + 2 < NT), (t + 2 < NT));   ENDW(t + 1); RESC(); ROT();
    }
    STEP(pB0, pB1, pA0, pA1, NT - 1, false, false, false); RESC();
    { float sacc = pB0[0] + pB0[1]; _Pragma("unroll") for (int r = 2; r < 16; ++r) sacc += pB0[r]; _Pragma("unroll") for (int r = 0; r < 16; ++r) sacc += pB1[r]; l_reg += sacc;
      pw0 = (u32x4){PKW(pB0, 0), PKW(pB0, 2), PKW(pB0, 4), PKW(pB0, 6)}; pw1 = (u32x4){PKW(pB0, 8), PKW(pB0, 10), PKW(pB0, 12), PKW(pB0, 14)}; pw2 = (u32x4){PKW(pB1, 0), PKW(pB1, 2), PKW(pB1, 4), PKW(pB1, 6)}; pw3 = (u32x4){PKW(pB1, 8), PKW(pB1, 10), PKW(pB1, 12), PKW(pB1, 14)};
      SBAR(); pv(o, vb0 + sl_cur, PAF(0), PAF(1), PAF(2), PAF(3)); }
#undef PKW
#undef PAF
#undef VFR
#undef PIN
#undef MX3
#undef GAPA
#undef GAPB
#undef EX
#undef VRD
#undef KRD
#undef STEP
#undef ENDW
    { auto rr = __builtin_amdgcn_permlane32_swap(__float_as_uint(l_reg), __float_as_uint(l_reg), false, false); l_reg = __uint_as_float(rr[0]) + __uint_as_float(rr[1]); }
    int lane2 = lane; asm volatile("" : "+v"(lane2));
    const int r32e = lane2 & 31, hie = lane2 >> 5;
    if (hie == 0) wsf[32 + r32e] = l_reg; asm volatile("s_waitcnt lgkmcnt(0)" ::: "memory");
    float rli[16];
#pragma unroll
    for (int r = 0; r < 16; ++r) rli[r] = __builtin_amdgcn_rcpf(wsf[32 + crow(r, hie)]);
    bf16* Ow = Oh + (long)(q0 + wid * QBLK) * PO;
    { bf16* stg = (bf16*)(shm + LDS_OST) + wid * 2048;
#pragma unroll
      for (int r = 0; r < 16; ++r) { const int orow = crow(r, hie);
#pragma unroll
        for (int d0 = 0; d0 < 2; ++d0) stg[orow * 64 + d0 * 32 + r32e] = __float2bfloat16(o[d0][r] * rli[r]); }
      asm volatile("s_waitcnt lgkmcnt(0)" ::: "memory");
#pragma unroll
      for (int i = 0; i < 4; ++i) { const int row = i * 8 + (lane2 >> 3), ch = lane2 & 7; const u32x4 v = *(const u32x4*)(stg + row * 64 + ch * 8); ATTN_STORE16(Ow + (long)row * PO + ch * 8, v); } }
    asm volatile("s_waitcnt lgkmcnt(0)\n\ts_barrier" ::: "memory");
#undef DMA_K
#undef DMA_V
#undef CMASK
#undef START
#undef RESC
#undef ROT
}
#undef SBAR
#undef WAIT_BAR
}

#define XB_TMO      128
#define XB_XCNT(j)  (256  + 64 * (j))
#define XB_XSUB(j)  (1280 + 64 * (j))
#define XB_XGEN(j)  (2304 + 64 * (j))
#define XB_TOP      3328
#define XB_TOPGEN   3392
#define XCD_BAR_WORDS 3456
#define XB_SPIN_CAP (1u << 18)
__device__ __forceinline__ unsigned xb_ld(unsigned* p)              { return __hip_atomic_load(p, __ATOMIC_RELAXED, __HIP_MEMORY_SCOPE_AGENT); }
__device__ __forceinline__ unsigned xb_add(unsigned* p, unsigned v) { return __hip_atomic_fetch_add(p, v, __ATOMIC_RELAXED, __HIP_MEMORY_SCOPE_AGENT); }
__device__ __forceinline__ unsigned xb_xcc_id() { return (unsigned)__builtin_amdgcn_s_getreg((3 << 11) | 20) & 0xFu; }
#define XB_SPIN(cond, bar) do { unsigned _sp = 0; while (cond) { __builtin_amdgcn_s_sleep(1); \
    if ((++_sp & 255u) == 0u) { if (xb_ld(&(bar)[XB_TMO])) break; if (_sp > XB_SPIN_CAP) { atomicAdd(&(bar)[XB_TMO], 1u); break; } } } } while (0)
struct XcdBarrier { unsigned* bar; unsigned x; volatile LAS unsigned* st; };
__device__ __forceinline__ XcdBarrier xcd_barrier_post(unsigned* bar, volatile LAS unsigned* st) {
    XcdBarrier b; b.bar = bar; b.x = xb_xcc_id(); b.st = st;
    if (threadIdx.x == 0) (void)xb_add(&bar[XB_XCNT(b.x)], 1u);
    return b;
}
__device__ __forceinline__ void xcd_barrier_complete(unsigned* bar, unsigned x, unsigned& nloc, unsigned& nx) {
    const unsigned G = gridDim.x * gridDim.y * gridDim.z;
    unsigned sum, cnt, mine, sp = 0u;
    for (;;) {
        sum = 0u; cnt = 0u; mine = 0u;
#pragma unroll
        for (unsigned j = 0; j < 16; ++j) { const unsigned c = xb_ld(&bar[XB_XCNT(j)]); sum += c; cnt += (c > 0u) ? 1u : 0u; mine = (j == x) ? c : mine; }
        if (sum == G) break;
        __builtin_amdgcn_s_sleep(1);
        if ((++sp & 255u) == 0u) { if (xb_ld(&bar[XB_TMO])) break; if (sp > XB_SPIN_CAP) { atomicAdd(&bar[XB_TMO], 1u); break; } }
    }
    nloc = mine > 0u ? mine : 1u; nx = cnt > 0u ? cnt : 1u;
}
__device__ __forceinline__ void xcd_barrier(const XcdBarrier& b) {
    asm volatile("s_waitcnt vmcnt(0)" ::: "memory");
    __syncthreads();
    if (threadIdx.x == 0) {
        unsigned* bar = b.bar;
        __builtin_amdgcn_s_waitcnt(0);
        unsigned nloc = b.st[0], nx = b.st[1];
        if (nloc == 0u) { xcd_barrier_complete(bar, b.x, nloc, nx); b.st[0] = nloc; b.st[1] = nx; }
        const unsigned old = xb_add(&bar[XB_XSUB(b.x)], 1u);
        const unsigned gen = old / nloc;
        if (old + 1u == (gen + 1u) * nloc) {
            __builtin_amdgcn_fence(__ATOMIC_RELEASE, "agent");
            asm volatile("s_waitcnt vmcnt(0)" ::: "memory");
            const unsigned og = xb_add(&bar[XB_TOP], 1u);
            const unsigned tg = og / nx;
            if (og + 1u == (tg + 1u) * nx) xb_add(&bar[XB_TOPGEN], 1u);
            else XB_SPIN(xb_ld(&bar[XB_TOPGEN]) == tg, bar);
            __builtin_amdgcn_fence(__ATOMIC_ACQUIRE, "agent");
            xb_add(&bar[XB_XGEN(b.x)], 1u);
            asm volatile("s_waitcnt vmcnt(0)" ::: "memory");
        } else {
            XB_SPIN(xb_ld(&bar[XB_XGEN(b.x)]) == gen, bar);
            __builtin_amdgcn_fence(__ATOMIC_ACQUIRE, "agent");
            asm volatile("s_waitcnt vmcnt(0)" ::: "memory");
        }
    }
    __syncthreads();
}

struct Args {
    const float *x, *meta, *ln0_g, *ln0_b, *w_in, *conv_w, *conv_b, *gate_bias, *lq1, *lk1, *lq2, *lk2, *att_g, *ml_g, *w_att_out, *w_ml_out, *w_o,
                *ln1_g, *ln1_b, *w_router, *b_router, *w_gu, *b_gu, *w_down, *b_down, *ln2_g, *ln2_b;
    float* out; unsigned char* ws; int ph_lo, ph_hi;
};

template <class ColMap>
__device__ __forceinline__ void transpose_item(const float* W, int K, int N, bf16_t* WT, LAS float* scr, int kb, int nb, int lane, ColMap cm) {
    const int k0 = 64 * kb, n0 = 32 * nb;
    const int lc = cm(n0 + (lane & 31));
#pragma unroll 8
    for (int i = 0; i < 32; ++i) { const int kk = 2 * i + (lane >> 5); scr[kk * 33 + (lane & 31)] = W[(size_t)(k0 + kk) * N + lc]; }
    LDS_WAIT(); asm volatile("" ::: "memory");
    const int c = lane & 7;
#pragma unroll
    for (int j = 0; j < 4; ++j) { const int n = (lane >> 3) + 8 * j; const LAS float* s = scr + (8 * c) * 33 + n;
        u32x4 o; o.x = pkbf(s[0 * 33], s[1 * 33]); o.y = pkbf(s[2 * 33], s[3 * 33]); o.z = pkbf(s[4 * 33], s[5 * 33]); o.w = pkbf(s[6 * 33], s[7 * 33]);
        *(u32x4*)(WT + (size_t)(n0 + n) * K + k0 + 8 * c) = o; }
    LDS_WAIT(); asm volatile("" ::: "memory");
}
struct CmIdent { __device__ __forceinline__ int operator()(int p) const { return p; } };
struct CmWin {
    __device__ __forceinline__ int operator()(int P) const {
        if (P < 1024) { const int hb = P >> 6, p = P & 63, wcp = p >> 5, fq = (p & 31) >> 3, n = (p & 7) >> 2, j = p & 3; return hb * 64 + 32 * n + 16 * wcp + 4 * fq + j; }
        if (P < 3584) return P;
        return P + 8;
    }
};
struct CmGu {
    __device__ __forceinline__ int operator()(int P) const { const int pn = P >> 8, s = (P >> 7) & 1, i = P & 127; return 2 * (128 * pn + i) + s; }
};

__global__ void __launch_bounds__(NWAVES * 64, 2) hybrid_fwd(Args a) {
    extern __shared__ __attribute__((aligned(16))) unsigned char lds[];
    LAS unsigned char* L = (LAS unsigned char*)lds;
    const int tid = threadIdx.x, lane = tid & 63, wave = __builtin_amdgcn_readfirstlane(tid >> 6);
    const int G = gridDim.x, blk = blockIdx.x;
    const int gw = blk * NWAVES + wave, NGW = G * NWAVES;
    if (tid < 16) ((LAS unsigned*)(L + MISC_OFF))[tid] = 0u;
    LAS unsigned long long* ptab = (LAS unsigned long long*)(L + MISC_OFF + 64);
    if (tid == 0) {
        ptab[0] = (unsigned long long)a.x; ptab[1] = (unsigned long long)a.meta; ptab[2] = (unsigned long long)a.ln0_g; ptab[3] = (unsigned long long)a.ln0_b; ptab[4] = (unsigned long long)a.w_in;
        ptab[5] = (unsigned long long)a.conv_w; ptab[6] = (unsigned long long)a.conv_b; ptab[7] = (unsigned long long)a.gate_bias; ptab[8] = (unsigned long long)a.lq1; ptab[9] = (unsigned long long)a.lk1;
        ptab[10] = (unsigned long long)a.lq2; ptab[11] = (unsigned long long)a.lk2; ptab[12] = (unsigned long long)a.att_g; ptab[13] = (unsigned long long)a.ml_g; ptab[14] = (unsigned long long)a.w_att_out;
        ptab[15] = (unsigned long long)a.w_ml_out; ptab[16] = (unsigned long long)a.w_o; ptab[17] = (unsigned long long)a.ln1_g; ptab[18] = (unsigned long long)a.ln1_b; ptab[19] = (unsigned long long)a.w_router;
        ptab[20] = (unsigned long long)a.b_router; ptab[21] = (unsigned long long)a.w_gu; ptab[22] = (unsigned long long)a.b_gu; ptab[23] = (unsigned long long)a.w_down; ptab[24] = (unsigned long long)a.b_down;
        ptab[25] = (unsigned long long)a.ln2_g; ptab[26] = (unsigned long long)a.ln2_b; ptab[27] = (unsigned long long)a.out; ptab[28] = (unsigned long long)a.ws;
    }
    asm volatile("s_waitcnt lgkmcnt(0)" ::: "memory");
    __syncthreads();
    asm volatile("" ::: "memory");
#define PF(i) ((const float*)ldptr(ptab, (i)))
#define WSP ((unsigned char*)ldptr(ptab, 28))
#define DOUTP ((unsigned char*)ldptr(ptab, 27))
#define ctl ((unsigned*)(WSP + WS_CTL))
#define WinT ((bf16_t*)(WSP + WS_WIN))
#define WaT ((bf16_t*)(WSP + WS_WA))
#define WmT ((bf16_t*)(WSP + WS_WM))
#define WoT ((bf16_t*)(WSP + WS_WO))
#define ropec ((float*)(WSP + WS_ROPE))
#define ropes (ropec + TT * 32)
#define stats ((float*)(WSP + WS_STATS))
#define gates ((float*)(WSP + WS_GATES))
#define tok_e ((int*)(WSP + WS_TOKE))
#define tok_g ((float*)(WSP + WS_TOKG))
#define hist ((int*)(WSP + WS_HIST))
#define row_off ((int*)(WSP + WS_ROWOFF))
#define row_slot ((int*)(WSP + WS_ROWSLOT))
#define row_gate ((float*)(WSP + WS_ROWGATE))
#define tile_exp ((int*)(WSP + WS_TILEEXP))
#define Hb ((bf16_t*)(WSP + WS_H))
#define Z ((bf16_t*)(WSP + WS_Z))
#define Y ((bf16_t*)(WSP + WS_Y))
#define ACT ((bf16_t*)(WSP + WS_ACT))
#define Ob ((bf16_t*)(DOUTP + DO_O))
#define HMb ((bf16_t*)(DOUTP + DO_HM))
#define WguT ((bf16_t*)(DOUTP + DO_WGU))
#define WdnT ((bf16_t*)(DOUTP + DO_WDN))
#if !MK_PER_PHASE
    XcdBarrier bar = xcd_barrier_post(ctl + CW_BAR, (volatile LAS unsigned*)(L + MISC_OFF + 32));
#define GRID_BAR() xcd_barrier(bar)
#else
#define GRID_BAR() do {} while (0)
#endif
    const int lo = a.ph_lo, hi = a.ph_hi;
#define IN(k) (lo <= (k) && (k) < hi)
#define BOTH(k) (IN(k) && IN((k) + 1))

    if (IN(0)) REPLOOP(0) {
        {   LAS float* scr = (LAS float*)(L + wave * 16384);
            constexpr int I_IN = 16 * (NZ / 32), I_A = 8 * 32, I_O = 16 * 32;
            constexpr int NIT = I_IN + 2 * I_A + I_O;
            for (int it = gw; it < NIT; it += NGW) {
                int r = it;
                if (r < I_IN) { transpose_item(PF(4), 1024, NIN, WinT, scr, r / (NZ / 32), r % (NZ / 32), lane, CmWin()); continue; } r -= I_IN;
                if (r < I_A) { transpose_item(PF(14), 512, 1024, WaT, scr, r / 32, r % 32, lane, CmIdent()); continue; } r -= I_A;
                if (r < I_A) { transpose_item(PF(15), 512, 1024, WmT, scr, r / 32, r % 32, lane, CmIdent()); continue; } r -= I_A;
                transpose_item(PF(16), 1024, 1024, WoT, scr, r / 32, r % 32, lane, CmIdent());
            }
        }
        for (int i = blk * 512 + tid; i < TT * 32; i += G * 512) {
            const int t = i >> 5, f = i & 31;
            const double inv = exp2(-(double)f * (13.287712379549449 / 32.0));
            const double rev = (double)t * inv * 0.15915494309189535;
            const float fr = (float)(rev - floor(rev));
            ropec[i] = __builtin_amdgcn_cosf(fr); ropes[i] = __builtin_amdgcn_sinf(fr);
        }
        __syncthreads();
        LAS float* wg = (LAS float*)L;
        for (int i = tid; i < 8 * 1024; i += 512) { const int gc = i >> 10, k = i & 1023; wg[i] = PF(4)[(size_t)k * NIN + 3584 + gc]; }
        __syncthreads();
        for (int row = gw; row < MROWS; row += NGW) {
            const int b = row / TT, t = row - b * TT;
            const float* xr = (t < NMETA) ? PF(1) + (size_t)t * DM : PF(0) + ((size_t)b * SEQ + (t - NMETA)) * DM;
            f32x4 v[4]; float s = 0.f;
#pragma unroll
            for (int j = 0; j < 4; ++j) { v[j] = *(const f32x4*)(xr + 4 * lane + 256 * j); s += (v[j][0] + v[j][1]) + (v[j][2] + v[j][3]); }
            const float mean = wave_sum(s) * (1.f / DM); float s2 = 0.f;
#pragma unroll
            for (int j = 0; j < 4; ++j) { const f32x4 d = v[j] - mean; s2 += (d[0] * d[0] + d[1] * d[1]) + (d[2] * d[2] + d[3] * d[3]); }
            const float rstd = 1.0f / sqrtf(wave_sum(s2) * (1.f / DM) + LN_EPS);
            if (lane == 0) { stats[2 * row] = mean; stats[2 * row + 1] = rstd; }
            float gp[8];
#pragma unroll
            for (int q = 0; q < 8; ++q) gp[q] = 0.f;
#pragma unroll
            for (int j = 0; j < 4; ++j) {
                const f32x4 gg = *(const f32x4*)(PF(2) + 4 * lane + 256 * j), bb = *(const f32x4*)(PF(3) + 4 * lane + 256 * j);
                const f32x4 hv = (v[j] - mean) * rstd * gg + bb;
                u32x2 w; w.x = pkbf(hv[0], hv[1]); w.y = pkbf(hv[2], hv[3]);
                *(u32x2*)(Hb + (size_t)row * DM + 4 * lane + 256 * j) = w;
#pragma unroll
                for (int q = 0; q < 8; ++q) { const f32x4 wv = *(const LAS f32x4*)(wg + q * 1024 + 4 * lane + 256 * j); gp[q] += (hv[0] * wv[0] + hv[1] * wv[1]) + (hv[2] * wv[2] + hv[3] * wv[3]); }
            }
#pragma unroll
            for (int q = 0; q < 8; ++q) gp[q] = wave_sum(gp[q]);
            if (lane < 8) {
                float gsel = gp[0];
#pragma unroll
                for (int q = 1; q < 8; ++q) gsel = (lane == q) ? gp[q] : gsel;
                float gv = gsel + PF(7)[lane];
                if (lane >= 4) gv = (gv >= 0.f) ? -log1pf(expf(-gv)) : gv - log1pf(expf(gv));
                gates[(size_t)row * 8 + lane] = gv;
            }
        }
        __syncthreads();
        if (BOTH(0) || rep_ + 1 < REP_0) GRID_BAR();
    }

    if (IN(1)) REPLOOP(1) {
        pg8::Gemm g{Hb, WinT, DM, DM, NZ / 256, nullptr, nullptr, 0};
        pg8::StaticOrder S; S.init(MROWS / 256, NZ / 256, G, blk);
        pg8::EpiZ E{Z, ropec, ropes};
        pg8::gemm_phase<0, pg8::EpiZ>(L, g, S, E);
        if (BOTH(1) || rep_ + 1 < REP_1) GRID_BAR();
    }

    if (IN(2)) {
        REPLOOP(2A)
        for (int Lidx = blk; Lidx < NB * 16 * 17; Lidx += G) {
            const int bvh = Lidx & 255, qb = Lidx >> 8;
            const int b = bvh >> 4, vh = bvh & 15, hm = vh >> 1, vhalf = vh & 1, h = hm >> 1;
            const bf16_t* Zb = Z + (size_t)b * TT * NZ;
            attn_body::attn_unit<8>(qb, (const attn_body::bf16*)(Zb + ZQ + hm * 64), (const attn_body::bf16*)(Zb + ZK + hm * 64), (const attn_body::bf16*)(Zb + ZV + h * 128 + vhalf * 64),
                                    (attn_body::bf16*)(Ob + (size_t)b * OROWS * 1024 + vh * 64), (char*)lds);
        }
        __syncthreads();
        REPLOOP(2B) {
            constexpr int PQ = 136;
            LAS bf16_t* Qs = (LAS bf16_t*)L;
            LAS bf16_t* Ks = Qs + 128 * PQ;
            LAS bf16_t* KTs = Ks + 128 * PQ;
            LAS bf16_t* VTs = KTs + 128 * PQ;
            LAS bf16_t* Cs = VTs + 48 * PQ;
            LAS float* fv = (LAS float*)(Cs + 48 * PQ);
            LAS float* v_a = fv;
            LAS float* v_M = fv + 128;
            LAS float* v_b = fv + 256;
            LAS float* v_sc = fv + 384;
            LAS float* cw = fv + 400;
            for (int u = blk; u < NB * 4 * 4; u += G) {
                const int b = u >> 4, h = (u >> 2) & 3, es = u & 3;
                __syncthreads();
                for (int i = tid; i < 5 * 256; i += 512) { const int j = i >> 8, c = i & 255; const int ch = (c < 128) ? (h * 128 + c) : (512 + h * 128 + (c - 128));
                    cw[i] = (j < 4) ? PF(5)[j * 1024 + ch] : PF(6)[ch]; }
                for (int i = tid; i < 48 * PQ; i += 512) { const int rr = i / PQ; VTs[i] = (rr == 32) ? (bf16_t)0x3f80 : (bf16_t)0; Cs[i] = 0; }
                if (tid == 0) v_sc[0] = 0.f;
                f32x4 Cst[3]; Cst[0] = (f32x4){0.f, 0.f, 0.f, 0.f}; Cst[1] = Cst[0]; Cst[2] = Cst[0];
                const bf16_t* Zb = Z + (size_t)b * TT * NZ;
                const int fr = lane & 15, quad = lane >> 4;
                for (int c = 0; c < 33; ++c) {
                    const int t0 = c * 128;
                    __syncthreads();
                    if (wave == 0) {
                        const float m_old = v_sc[0];
                        float x0, x1, i0, i1;
                        { const int ta = t0 + 2 * lane, tb = ta + 1;
                          x0 = (ta < TT) ? ld_agent_f(gates + (size_t)(b * TT + ta) * 8 + 4 + h) : 0.f; i0 = (ta < TT) ? ld_agent_f(gates + (size_t)(b * TT + ta) * 8 + h) : -1e30f;
                          x1 = (tb < TT) ? ld_agent_f(gates + (size_t)(b * TT + tb) * 8 + 4 + h) : 0.f; i1 = (tb < TT) ? ld_agent_f(gates + (size_t)(b * TT + tb) * 8 + h) : -1e30f; }
                        float sacc = x0 + x1;
#pragma unroll
                        for (int o = 1; o < 64; o <<= 1) { const float tv = __shfl_up(sacc, o); if (lane >= o) sacc += tv; }
                        const float ex = sacc - (x0 + x1);
                        const float b0 = ex + x0, b1 = b0 + x1;
                        const float a0 = i0 - b0, a1 = i1 - b1;
                        float mx = fmaxf(a0, a1);
#pragma unroll
                        for (int o = 1; o < 64; o <<= 1) { const float tv = __shfl_up(mx, o); if (lane >= o) mx = fmaxf(mx, tv); }
                        float exm = __shfl_up(mx, 1); if (lane == 0) exm = -INFINITY;
                        const float M0 = fmaxf(fmaxf(m_old, exm), a0), M1 = fmaxf(M0, a1);
                        v_b[2 * lane] = b0; v_b[2 * lane + 1] = b1; v_a[2 * lane] = a0; v_a[2 * lane + 1] = a1; v_M[2 * lane] = M0; v_M[2 * lane + 1] = M1;
                        if (lane == 63) v_sc[1] = M1;
                    }
                    __syncthreads();
                    const float Mlast = v_sc[1], m_old = v_sc[0];
#pragma unroll 1
                    for (int i = 0; i < 4; ++i) {
                        const int p = tid + 512 * i, s = p >> 4, dg = p & 15;
                        const int t = t0 + s;
                        float qv[8], kv[8];
#pragma unroll
                        for (int e = 0; e < 8; ++e) { qv[e] = cw[4 * 256 + dg * 8 + e]; kv[e] = cw[4 * 256 + 128 + dg * 8 + e]; }
#pragma unroll
                        for (int j = 0; j < 4; ++j) {
                            const int tj = t - 3 + j;
                            if (tj >= 0 && tj < TT) {
                                const u32x4 zq = *(const u32x4*)(Zb + (size_t)tj * NZ + ZMQ + h * 128 + dg * 8);
                                const u32x4 zk = *(const u32x4*)(Zb + (size_t)tj * NZ + ZMK + h * 128 + dg * 8);
                                const LAS float* wq = cw + j * 256 + dg * 8; const LAS float* wk = wq + 128;
                                qv[0] += wq[0] * bflo(zq.x); qv[1] += wq[1] * bfhi(zq.x); qv[2] += wq[2] * bflo(zq.y); qv[3] += wq[3] * bfhi(zq.y);
                                qv[4] += wq[4] * bflo(zq.z); qv[5] += wq[5] * bfhi(zq.z); qv[6] += wq[6] * bflo(zq.w); qv[7] += wq[7] * bfhi(zq.w);
                                kv[0] += wk[0] * bflo(zk.x); kv[1] += wk[1] * bfhi(zk.x); kv[2] += wk[2] * bflo(zk.y); kv[3] += wk[3] * bfhi(zk.y);
                                kv[4] += wk[4] * bflo(zk.z); kv[5] += wk[5] * bfhi(zk.z); kv[6] += wk[6] * bflo(zk.w); kv[7] += wk[7] * bfhi(zk.w);
                            }
                        }
                        const bool live = (t < TT);
                        const float wrs = live ? __expf(v_a[s] - Mlast) : 0.f;
#pragma unroll
                        for (int e = 0; e < 8; ++e) { qv[e] = live ? qv[e] * sigmoidf_(qv[e]) : 0.f; kv[e] = live ? kv[e] * sigmoidf_(kv[e]) * 0.08838834764831845f : 0.f; }
                        u32x4 wq4, wk4; wq4.x = pkbf(qv[0], qv[1]); wq4.y = pkbf(qv[2], qv[3]); wq4.z = pkbf(qv[4], qv[5]); wq4.w = pkbf(qv[6], qv[7]);
                        wk4.x = pkbf(kv[0], kv[1]); wk4.y = pkbf(kv[2], kv[3]); wk4.z = pkbf(kv[4], kv[5]); wk4.w = pkbf(kv[6], kv[7]);
                        *(LAS u32x4*)(Qs + s * PQ + dg * 8) = wq4; *(LAS u32x4*)(Ks + s * PQ + dg * 8) = wk4;
#pragma unroll
                        for (int e = 0; e < 8; ++e) KTs[(dg * 8 + e) * PQ + s] = (bf16_t)(pkbf(kv[e] * wrs, 0.f) & 0xffffu);
                    }
                    { const int s = tid >> 2, eg = tid & 3, t = t0 + s;
                      u32x4 zv = (u32x4){0u, 0u, 0u, 0u};
                      if (t < TT) zv = *(const u32x4*)(Zb + (size_t)t * NZ + ZMV + h * 128 + es * 32 + eg * 8);
                      VTs[(eg * 8 + 0) * PQ + s] = (bf16_t)(zv.x & 0xffffu); VTs[(eg * 8 + 1) * PQ + s] = (bf16_t)(zv.x >> 16);
                      VTs[(eg * 8 + 2) * PQ + s] = (bf16_t)(zv.y & 0xffffu); VTs[(eg * 8 + 3) * PQ + s] = (bf16_t)(zv.y >> 16);
                      VTs[(eg * 8 + 4) * PQ + s] = (bf16_t)(zv.z & 0xffffu); VTs[(eg * 8 + 5) * PQ + s] = (bf16_t)(zv.z >> 16);
                      VTs[(eg * 8 + 6) * PQ + s] = (bf16_t)(zv.w & 0xffffu); VTs[(eg * 8 + 7) * PQ + s] = (bf16_t)(zv.w >> 16); }
                    __syncthreads();
                    f32x4 St[8];
#pragma unroll
                    for (int j = 0; j < 8; ++j) St[j] = (f32x4){0.f, 0.f, 0.f, 0.f};
                    {
                        bf16x8 af[4];
#pragma unroll
                        for (int kk = 0; kk < 4; ++kk) af[kk] = *(const LAS bf16x8*)(Qs + (16 * wave + fr) * PQ + kk * 32 + quad * 8);
#pragma unroll
                        for (int j = 0; j < 8; ++j) if (j <= wave) {
#pragma unroll
                            for (int kk = 0; kk < 4; ++kk) { const bf16x8 bfv = *(const LAS bf16x8*)(Ks + (16 * j + fr) * PQ + kk * 32 + quad * 8);
                                St[j] = __builtin_amdgcn_mfma_f32_16x16x32_bf16(af[kk], bfv, St[j], 0, 0, 0); }
                        }
                    }
                    __syncthreads();
                    {
                        float Ms[4];
#pragma unroll
                        for (int jj = 0; jj < 4; ++jj) Ms[jj] = v_M[16 * wave + 4 * quad + jj];
#pragma unroll
                        for (int j = 0; j < 8; ++j) {
                            const int r = 16 * j + fr; const float ar = v_a[r];
#pragma unroll
                            for (int jj = 0; jj < 4; ++jj) { const int s = 16 * wave + 4 * quad + jj;
                                const float w = (j <= wave && r <= s) ? St[j][jj] * __expf(ar - Ms[jj]) : 0.f;
                                Ks[s * PQ + r] = (bf16_t)(pkbf(w, 0.f) & 0xffffu); }
                        }
                    }
                    __syncthreads();
                    {
                        f32x4 n1[3], n2[3];
#pragma unroll
                        for (int jt = 0; jt < 3; ++jt) { n1[jt] = (f32x4){0.f, 0.f, 0.f, 0.f}; n2[jt] = n1[jt]; }
#pragma unroll
                        for (int kk = 0; kk < 4; ++kk) {
                            const bf16x8 aq = *(const LAS bf16x8*)(Qs + (16 * wave + fr) * PQ + kk * 32 + quad * 8);
                            const bf16x8 as_ = *(const LAS bf16x8*)(Ks + (16 * wave + fr) * PQ + kk * 32 + quad * 8);
#pragma unroll
                            for (int jt = 0; jt < 3; ++jt) {
                                const bf16x8 bc = *(const LAS bf16x8*)(Cs + (16 * jt + fr) * PQ + kk * 32 + quad * 8);
                                const bf16x8 bvv = *(const LAS bf16x8*)(VTs + (16 * jt + fr) * PQ + kk * 32 + quad * 8);
                                n1[jt] = __builtin_amdgcn_mfma_f32_16x16x32_bf16(aq, bc, n1[jt], 0, 0, 0);
                                n2[jt] = __builtin_amdgcn_mfma_f32_16x16x32_bf16(as_, bvv, n2[jt], 0, 0, 0);
                            }
                        }
#pragma unroll
                        for (int jj = 0; jj < 4; ++jj) {
                            const int s = 16 * wave + 4 * quad + jj; const int t = t0 + s;
                            const float Ms = v_M[s]; const float winter = __expf(m_old - Ms);
                            float den = winter * n1[2][jj] + n2[2][jj];
                            den = __shfl(den, lane & 48);
                            const float ms = v_b[s] + Ms;
                            const float dd = fmaxf(fabsf(den), __expf(-ms));
                            const float rd = 1.0f / dd;
                            if (t < TT) {
                                bf16_t* op = HMb + (size_t)(b * TT + t) * 512 + h * 128 + es * 32 + fr;
                                op[0] = (bf16_t)(pkbf((winter * n1[0][jj] + n2[0][jj]) * rd, 0.f) & 0xffffu);
                                op[16] = (bf16_t)(pkbf((winter * n1[1][jj] + n2[1][jj]) * rd, 0.f) & 0xffffu);
                            }
                        }
                    }
                    __syncthreads();
                    {
                        const float w_old = __expf(m_old - Mlast);
#pragma unroll
                        for (int jt = 0; jt < 3; ++jt) Cst[jt] = Cst[jt] * w_old;
#pragma unroll
                        for (int kk = 0; kk < 4; ++kk) {
                            const bf16x8 bk = *(const LAS bf16x8*)(KTs + (16 * wave + fr) * PQ + kk * 32 + quad * 8);
#pragma unroll
                            for (int jt = 0; jt < 3; ++jt) { const bf16x8 av = *(const LAS bf16x8*)(VTs + (16 * jt + fr) * PQ + kk * 32 + quad * 8);
                                Cst[jt] = __builtin_amdgcn_mfma_f32_16x16x32_bf16(av, bk, Cst[jt], 0, 0, 0); }
                        }
#pragma unroll
                        for (int jt = 0; jt < 3; ++jt)
#pragma unroll
                            for (int jj = 0; jj < 4; ++jj) Cs[(16 * jt + 4 * quad + jj) * PQ + 16 * wave + fr] = (bf16_t)(pkbf(Cst[jt][jj], 0.f) & 0xffffu);
                        if (tid == 0) v_sc[0] = v_b[127] + Mlast;
                    }
                }
            }
        }
        __syncthreads();
        if (BOTH(2)) GRID_BAR();
    }

    if (IN(3)) REPLOOP(3) {
        float lam;
        { const float p1 = wave_sum(PF(8)[lane] * PF(9)[lane]), p2 = wave_sum(PF(10)[lane] * PF(11)[lane]); lam = expf(p1) - expf(p2) + LAMBDA_INIT; }
        const int hd = lane >> 4, e0 = (lane & 15) * 8;
        float ga[8], gm[8];
#pragma unroll
        for (int e = 0; e < 8; ++e) { ga[e] = PF(12)[e0 + e] * (1.0f - LAMBDA_INIT); gm[e] = PF(13)[hd * 128 + e0 + e]; }
        for (int row = gw; row < MROWS; row += NGW) {
            const int b = row / TT, t = row - b * TT;
            const bf16_t* orow = Ob + ((size_t)b * OROWS + t) * 1024 + hd * 256 + e0;
            const u32x4 w0 = *(const u32x4*)orow, w1 = *(const u32x4*)(orow + 128);
            float o[8];
            o[0] = bflo(w0.x) - lam * bflo(w1.x); o[1] = bfhi(w0.x) - lam * bfhi(w1.x); o[2] = bflo(w0.y) - lam * bflo(w1.y); o[3] = bfhi(w0.y) - lam * bfhi(w1.y);
            o[4] = bflo(w0.z) - lam * bflo(w1.z); o[5] = bfhi(w0.z) - lam * bfhi(w1.z); o[6] = bflo(w0.w) - lam * bflo(w1.w); o[7] = bfhi(w0.w) - lam * bfhi(w1.w);
            float ss = 0.f;
#pragma unroll
            for (int e = 0; e < 8; ++e) ss += o[e] * o[e];
            ss = row_sum16(ss);
            float rs = 1.0f / sqrtf(ss * (1.f / 128.f) + LN_EPS);
            u32x4 wo; wo.x = pkbf(o[0] * rs * ga[0], o[1] * rs * ga[1]); wo.y = pkbf(o[2] * rs * ga[2], o[3] * rs * ga[3]); wo.z = pkbf(o[4] * rs * ga[4], o[5] * rs * ga[5]); wo.w = pkbf(o[6] * rs * ga[6], o[7] * rs * ga[7]);
            bf16_t* zrow = Z + (size_t)row * NZ;
            const u32x4 hw = *(const u32x4*)(HMb + (size_t)row * 512 + hd * 128 + e0);
            const u32x4 mw = *(const u32x4*)(zrow + ZMO + hd * 128 + e0);
            *(u32x4*)(zrow + ZYC + hd * 128 + e0) = wo;
            float hv[8]; hv[0] = bflo(hw.x); hv[1] = bfhi(hw.x); hv[2] = bflo(hw.y); hv[3] = bfhi(hw.y); hv[4] = bflo(hw.z); hv[5] = bfhi(hw.z); hv[6] = bflo(hw.w); hv[7] = bfhi(hw.w);
            float mo[8]; mo[0] = bflo(mw.x); mo[1] = bfhi(mw.x); mo[2] = bflo(mw.y); mo[3] = bfhi(mw.y); mo[4] = bflo(mw.z); mo[5] = bfhi(mw.z); mo[6] = bflo(mw.w); mo[7] = bfhi(mw.w);
            ss = 0.f;
#pragma unroll
            for (int e = 0; e < 8; ++e) ss += hv[e] * hv[e];
            ss = row_sum16(ss);
            rs = 1.0f / sqrtf(ss * (1.f / 128.f) + LN_EPS);
            float y[8];
#pragma unroll
            for (int e = 0; e < 8; ++e) y[e] = sigmoidf_(mo[e]) * (hv[e] * rs * gm[e]);
            u32x4 wy; wy.x = pkbf(y[0], y[1]); wy.y = pkbf(y[2], y[3]); wy.z = pkbf(y[4], y[5]); wy.w = pkbf(y[6], y[7]);
            *(u32x4*)(zrow + ZYC + 512 + hd * 128 + e0) = wy;
        }
        if (BOTH(3) || rep_ + 1 < REP_3) GRID_BAR();
    }

    if (IN(4)) REPLOOP(4) {
        {   LAS float* scr = (LAS float*)(L + wave * 16384);
            constexpr int I_GU = 16 * 64, I_DN = 16 * 32;
            for (int it = gw; it < NE * (I_GU + I_DN); it += NGW) {
                const int e = it / (I_GU + I_DN); int r = it - e * (I_GU + I_DN);
                if (r < I_GU) transpose_item(PF(21) + (size_t)e * 1024 * 2048, 1024, 2048, WguT + (size_t)e * 2048 * 1024, scr, r / 64, r % 64, lane, CmGu());
                else { r -= I_GU; transpose_item(PF(23) + (size_t)e * 1024 * 1024, 1024, 1024, WdnT + (size_t)e * 1024 * 1024, scr, r / 32, r % 32, lane, CmIdent()); }
            }
        }
        __syncthreads();
        {   pg8::Gemm g{Z + ZYC, WaT, NZ, 512, 4, nullptr, nullptr, 0};
            pg8::StaticOrder S; S.init(MROWS / 256, 4, G, blk);
            pg8::EpiGate<false> E{Z};
            pg8::gemm_phase<0, pg8::EpiGate<false>>(L, g, S, E); }
        {   pg8::Gemm g{Z + ZYC + 512, WmT, NZ, 512, 4, nullptr, nullptr, 0};
            pg8::StaticOrder S; S.init(MROWS / 256, 4, G, blk);
            pg8::EpiGate<true> E{Z};
            pg8::gemm_phase<0, pg8::EpiGate<true>>(L, g, S, E); }
        if (BOTH(4) || rep_ + 1 < REP_4) GRID_BAR();
    }

    if (IN(5)) REPLOOP(5) {
        pg8::Gemm g{Z + ZMRG, WoT, NZ, 1024, 4, nullptr, nullptr, 0};
        pg8::StaticOrder S; S.init(MROWS / 256, 4, G, blk);
        pg8::EpiPre1 E{(float*)(Z + ZGA), PF(0), PF(1), stats, PF(2), PF(3)};
        pg8::gemm_phase<0, pg8::EpiPre1>(L, g, S, E);
        if (BOTH(5) || rep_ + 1 < REP_5) GRID_BAR();
    }

    constexpr int NPART = 256, RPP = MROWS / NPART;
    static_assert(NPART * RPP == MROWS, "partitions");
    if (IN(6)) REPLOOP(6) {
        LAS float* wrT = (LAS float*)L;
        LAS int* hcnt = (LAS int*)(L + 131072);
        { const float* wr = PF(19); for (int i = tid; i < 32 * 1024; i += 512) { const int k = i >> 5, e = i & 31; wrT[e * 1024 + k] = wr[i]; } }
        const float* P1 = (const float*)(Z + ZGA);
        f32x4 gg[4], bb[4];
        { const float* g1 = PF(17); const float* b1 = PF(18);
#pragma unroll
          for (int j = 0; j < 4; ++j) { gg[j] = *(const f32x4*)(g1 + 4 * lane + 256 * j); bb[j] = *(const f32x4*)(b1 + 4 * lane + 256 * j); } }
        const float brt = PF(20)[(lane >> 1) & 31];
        bf16_t* Hbp = Hb; int* tokE = tok_e; float* tokG = tok_g; int* histp = hist;
        for (int part = blk; part < NPART; part += G) {
            __syncthreads();
            if (tid < 32) hcnt[tid] = 0;
            __syncthreads();
            const int rbeg = part * RPP, rend = rbeg + RPP;
            constexpr int RPW = (RPP + NWAVES - 1) / NWAVES;
            const int wbeg = rbeg + wave * RPW, wend = (wbeg + RPW < rend) ? wbeg + RPW : rend;
            for (int row = wbeg; row < wend; row += 2) {
                const bool two = (row + 1 < wend);
                const int row1 = two ? row + 1 : row;
                const float* pr0 = P1 + (size_t)row * (NZ / 2); const float* pr1 = P1 + (size_t)row1 * (NZ / 2);
                f32x4 v0[4], v1[4]; float s0 = 0.f, s1 = 0.f;
#pragma unroll
                for (int j = 0; j < 4; ++j) { v0[j] = *(const f32x4*)(pr0 + 4 * lane + 256 * j); v1[j] = *(const f32x4*)(pr1 + 4 * lane + 256 * j); }
#pragma unroll
                for (int j = 0; j < 4; ++j) { s0 += (v0[j][0] + v0[j][1]) + (v0[j][2] + v0[j][3]); s1 += (v1[j][0] + v1[j][1]) + (v1[j][2] + v1[j][3]); }
                const float mean0 = wave_sum(s0) * (1.f / DM), mean1 = wave_sum(s1) * (1.f / DM); float q0 = 0.f, q1 = 0.f;
#pragma unroll
                for (int j = 0; j < 4; ++j) { const f32x4 d0 = v0[j] - mean0, d1 = v1[j] - mean1;
                    q0 += (d0[0] * d0[0] + d0[1] * d0[1]) + (d0[2] * d0[2] + d0[3] * d0[3]); q1 += (d1[0] * d1[0] + d1[1] * d1[1]) + (d1[2] * d1[2] + d1[3] * d1[3]); }
                const float rstd0 = 1.0f / sqrtf(wave_sum(q0) * (1.f / DM) + LN_EPS), rstd1 = 1.0f / sqrtf(wave_sum(q1) * (1.f / DM) + LN_EPS);
#pragma unroll
                for (int j = 0; j < 4; ++j) {
                    v0[j] = (v0[j] - mean0) * rstd0 * gg[j] + bb[j]; v1[j] = (v1[j] - mean1) * rstd1 * gg[j] + bb[j];
                    u32x2 w; w.x = pkbf(v0[j][0], v0[j][1]); w.y = pkbf(v0[j][2], v0[j][3]);
                    *(u32x2*)(Hbp + (size_t)row * DM + 4 * lane + 256 * j) = w;
                    if (two) { w.x = pkbf(v1[j][0], v1[j][1]); w.y = pkbf(v1[j][2], v1[j][3]); *(u32x2*)(Hbp + (size_t)row1 * DM + 4 * lane + 256 * j) = w; }
                }
                float p0[32], p1[32];
#pragma unroll
                for (int e = 0; e < 32; ++e) {
                    float a0 = 0.f, a1 = 0.f;
#pragma unroll
                    for (int j = 0; j < 4; ++j) { const f32x4 wv = *(const LAS f32x4*)(wrT + e * 1024 + 4 * lane + 256 * j);
                        a0 += (v0[j][0] * wv[0] + v0[j][1] * wv[1]) + (v0[j][2] * wv[2] + v0[j][3] * wv[3]);
                        a1 += (v1[j][0] * wv[0] + v1[j][1] * wv[1]) + (v1[j][2] * wv[2] + v1[j][3] * wv[3]); }
                    p0[e] = a0; p1[e] = a1;
                }
                float lg0 = xreduce32(p0, lane) + brt, lg1 = xreduce32(p1, lane) + brt;
#pragma unroll
                for (int rr = 0; rr < 2; ++rr) {
                    float lg = rr ? lg1 : lg0; const int rw = rr ? row1 : row;
                    float tv[4]; int ti[4];
#pragma unroll
                    for (int k = 0; k < 4; ++k) {
                        const float mx = wave_max(lg);
                        const unsigned long long bal = __ballot(lg == mx);
                        const int idx = (__ffsll((long long)bal) - 1) >> 1;
                        tv[k] = mx; ti[k] = idx;
                        if ((lane >> 1) == idx) lg = -INFINITY;
                    }
                    const float e1 = __expf(tv[1] - tv[0]), e2 = __expf(tv[2] - tv[0]), e3 = __expf(tv[3] - tv[0]);
                    const float inv = 1.0f / (1.0f + e1 + e2 + e3);
                    if (lane < 4 && (rr == 0 || two)) {
                        const int idx = (lane == 0) ? ti[0] : (lane == 1) ? ti[1] : (lane == 2) ? ti[2] : ti[3];
                        const float gv = ((lane == 0) ? 1.0f : (lane == 1) ? e1 : (lane == 2) ? e2 : e3) * inv;
                        tokE[(size_t)rw * 4 + lane] = idx; tokG[(size_t)rw * 4 + lane] = gv;
                        atomicAdd((int*)&hcnt[idx], 1);
                    }
                }
            }
            __syncthreads();
            if (tid < 32) histp[part * 32 + tid] = hcnt[tid];
        }
        if (BOTH(6) || rep_ + 1 < REP_6) GRID_BAR();
    }

    if (IN(7)) REPLOOP(7) {
        LAS int* cnt_s = (LAS int*)L; LAS int* base_s = cnt_s + 32; LAS int* pst_s = cnt_s + 64;
        LAS int* ptot = cnt_s + 128; LAS int* pbase = ptot + 512;
        LAS int* ccnt = pbase + 512;
        LAS int* ent = ccnt + 1024; LAS int* lrank = ent + RPP * 4 + 64;
        int* rowOff = row_off; int* rowSlot = row_slot; float* rowGate = row_gate; const int* histp = hist; const int* tokE = tok_e; const float* tokG = tok_g;
        for (int part = blk; part < NPART; part += G) {
            __syncthreads();
            { const int e = tid & 31, q = tid >> 5; int tot = 0, bs = 0;
#pragma unroll 4
              for (int b2 = q * 16; b2 < q * 16 + 16; ++b2) { const int v = ld_agent_i(histp + b2 * 32 + e); tot += v; bs += (b2 < part) ? v : 0; }
              ptot[q * 32 + e] = tot; pbase[q * 32 + e] = bs; }
            const int rbeg = part * RPP, n4 = RPP * 4;
            for (int i = tid; i < n4; i += 512) ent[i] = ld_agent_i(tokE + (size_t)rbeg * 4 + i);
            __syncthreads();
            if (tid < 32) { int tot = 0, bs = 0;
#pragma unroll
                for (int q = 0; q < 16; ++q) { tot += ptot[q * 32 + tid]; bs += pbase[q * 32 + tid]; }
                cnt_s[tid] = tot; base_s[tid] = bs; }
            constexpr int NCH = (RPP * 4 + 63) / 64;
            for (int c = wave; c < NCH; c += NWAVES) {
                const int i = 64 * c + lane; const int my = (i < n4) ? ent[i] : -1; int lr = 0;
#pragma unroll 4
                for (int e = 0; e < 32; ++e) { const unsigned long long b = __ballot(my == e);
                    if (lane == e) ccnt[c * 32 + e] = __popcll(b);
                    if (my == e) lr = __popcll(b & ((1ull << lane) - 1ull)); }
                if (i < n4) lrank[i] = lr;
            }
            __syncthreads();
            if (tid == 0) { int p = 0; for (int e = 0; e < 32; ++e) { pst_s[e] = p; p += (cnt_s[e] + 255) & ~255; } pst_s[32] = p; }
            __syncthreads();
            if (tid < 32) { int run = pst_s[tid] + base_s[tid];
                for (int c = 0; c < NCH; ++c) { const int tmp = ccnt[c * 32 + tid]; ccnt[c * 32 + tid] = run; run += tmp; } }
            __syncthreads();
            for (int i = tid; i < n4; i += 512) { const int e = ent[i]; const int pos = ccnt[(i >> 6) * 32 + e] + lrank[i];
                rowOff[pos] = (rbeg + (i >> 2)) * (DM * 2); rowSlot[pos] = rbeg * 4 + i; rowGate[pos] = ld_agent_f(tokG + (size_t)rbeg * 4 + i); }
            if (part < 32) { const int e = part; for (int r = pst_s[e] + cnt_s[e] + tid; r < pst_s[e + 1]; r += 512) { rowOff[r] = 0; rowSlot[r] = MROWS * 4; rowGate[r] = 0.f; } }
            if (part == 0) { const int nT = pst_s[32] >> 8; int* te = tile_exp;
                for (int t = tid; t < nT; t += 512) { int e = 0; while (e < 31 && t * 256 >= pst_s[e + 1]) ++e; te[t] = e; }
                if (tid == 0) __hip_atomic_store((int*)(ctl + CW_NT), nT, RLX_AGENT); }
        }
        __syncthreads();
        if (BOTH(7) || rep_ + 1 < REP_7) GRID_BAR();
    }

    {
        int nT = 0, TPC = 0;
        if (lo < 12 && hi > 8) { nT = __builtin_amdgcn_readfirstlane(ld_agent_i((const int*)(ctl + CW_NT))); TPC = (nT + 1) >> 1; }
        if (IN(8)) REPLOOP(8) {
            pg8::Gemm g{Hb, WguT, DM, DM, 8, row_off, tile_exp, 0};
            pg8::StaticOrder S; S.init(TPC, 8, G, blk);
            pg8::EpiAct E{ACT, PF(22), tile_exp, 0};
            pg8::gemm_phase<1, pg8::EpiAct>(L, g, S, E);
            if (BOTH(8) || rep_ + 1 < REP_8) GRID_BAR();
        }
        if (IN(9)) REPLOOP(9) {
            pg8::Gemm g{ACT, WdnT, FF, FF, 4, nullptr, tile_exp, 0};
            pg8::StaticOrder S; S.init(TPC, 4, G, blk);
            pg8::EpiDown E{Y, PF(24), tile_exp, row_slot, row_gate, 0};
            pg8::gemm_phase<2, pg8::EpiDown>(L, g, S, E);
            if (BOTH(9) || rep_ + 1 < REP_9) GRID_BAR();
        }
        if (IN(10)) REPLOOP(10) {
            pg8::Gemm g{Hb, WguT, DM, DM, 8, row_off, tile_exp, TPC};
            pg8::StaticOrder S; S.init(nT - TPC, 8, G, blk);
            pg8::EpiAct E{ACT, PF(22), tile_exp, TPC};
            pg8::gemm_phase<1, pg8::EpiAct>(L, g, S, E);
            if (BOTH(10) || rep_ + 1 < REP_10) GRID_BAR();
        }
        if (IN(11)) REPLOOP(11) {
            pg8::Gemm g{ACT, WdnT, FF, FF, 4, nullptr, tile_exp, TPC};
            pg8::StaticOrder S; S.init(nT - TPC, 4, G, blk);
            pg8::EpiDown E{Y, PF(24), tile_exp, row_slot, row_gate, TPC};
            pg8::gemm_phase<2, pg8::EpiDown>(L, g, S, E);
            if (BOTH(11) || rep_ + 1 < REP_11) GRID_BAR();
        }
    }

    if (IN(12)) REPLOOP(12) {
        for (int row = gw; row < MROWS; row += NGW) {
            const int b = row / TT, t = row - b * TT;
            if (t < NMETA) continue;
            f32x4 v[4]; float s = 0.f;
#pragma unroll
            for (int j = 0; j < 4; ++j) {
                const u32x2 hw = *(const u32x2*)(Hb + (size_t)row * DM + 4 * lane + 256 * j);
                f32x4 acc = (f32x4){bflo(hw.x), bfhi(hw.x), bflo(hw.y), bfhi(hw.y)} * DN_ALPHA;
#pragma unroll
                for (int k = 0; k < 4; ++k) { const u32x2 yw = *(const u32x2*)(Y + ((size_t)row * 4 + k) * DM + 4 * lane + 256 * j);
                    acc += (f32x4){bflo(yw.x), bfhi(yw.x), bflo(yw.y), bfhi(yw.y)}; }
                v[j] = acc; s += (acc[0] + acc[1]) + (acc[2] + acc[3]);
            }
            const float mean = wave_sum(s) * (1.f / DM); float s2 = 0.f;
#pragma unroll
            for (int j = 0; j < 4; ++j) { const f32x4 d = v[j] - mean; s2 += (d[0] * d[0] + d[1] * d[1]) + (d[2] * d[2] + d[3] * d[3]); }
            const float rstd = 1.0f / sqrtf(wave_sum(s2) * (1.f / DM) + LN_EPS);
            float* orow = (float*)DOUTP + ((size_t)b * SEQ + (t - NMETA)) * DM;
#pragma unroll
            for (int j = 0; j < 4; ++j) {
                const f32x4 gg = *(const f32x4*)(PF(25) + 4 * lane + 256 * j), bb = *(const f32x4*)(PF(26) + 4 * lane + 256 * j);
                *(f32x4*)(orow + 4 * lane + 256 * j) = (v[j] - mean) * rstd * gg + bb;
            }
        }
    }
#undef IN
#undef BOTH
#undef GRID_BAR
}

constexpr int N_PHASES = 13;
extern "C" void kernel_launch(void* const* d_in, const int* in_sizes, int n_in, void* d_out, int out_size, void* d_ws, size_t ws_size, hipStream_t stream) {
    static int grid = 0;
    if (grid == 0) {
        if (n_in != 27 || ws_size < WS_END) { fprintf(stderr, "kernel_launch: unexpected n_in %d / ws_size %zu\n", n_in, ws_size); grid = -1; return; }
        int dev = 0, cus = 0;
        if (hipGetDevice(&dev) != hipSuccess || hipDeviceGetAttribute(&cus, hipDeviceAttributeMultiprocessorCount, dev) != hipSuccess) { grid = -1; return; }
        if (hipFuncSetAttribute((const void*)hybrid_fwd, hipFuncAttributeMaxDynamicSharedMemorySize, LDS_BYTES) != hipSuccess) { fprintf(stderr, "kernel_launch: hipFuncSetAttribute failed\n"); grid = -1; return; }
        int per_cu = 0;
        (void)hipOccupancyMaxActiveBlocksPerMultiprocessor(&per_cu, (const void*)hybrid_fwd, NWAVES * 64, LDS_BYTES);
        (void)hipGetLastError();
        grid = cus > 0 ? cus : 256;
    }
    if (grid < 0) return;
    (void)hipMemsetAsync((char*)d_ws + WS_CTL, 0, CTL_ZERO_BYTES, stream);
    Args a{};
    const float** fp = (const float**)&a;
    for (int i = 0; i < 27; ++i) fp[i] = (const float*)d_in[i];
    a.out = (float*)d_out; a.ws = (unsigned char*)d_ws;
#if MK_PER_PHASE
    for (int p = 0; p < N_PHASES; ++p) { a.ph_lo = p; a.ph_hi = p + 1; hipLaunchKernelGGL(hybrid_fwd, dim3(grid), dim3(NWAVES * 64), LDS_BYTES, stream, a); }
#else
    a.ph_lo = 0; a.ph_hi = N_PHASES;
    hipLaunchKernelGGL(hybrid_fwd, dim3(grid), dim3(NWAVES * 64), LDS_BYTES, stream, a);
#endif
}
```

```cpp
#include <hip/hip_runtime.h>
#include <hip/hip_bf16.h>
#include <cstdio>
#include <cstdint>
#include <cmath>

#ifndef MK_PER_PHASE
#define MK_PER_PHASE 0
#endif

#ifndef REP_ALL
#define REP_ALL 1
#endif
#ifndef REP_0
#define REP_0 REP_ALL
#endif
#ifndef REP_1
#define REP_1 REP_ALL
#endif
#ifndef REP_2A
#define REP_2A REP_ALL
#endif
#ifndef REP_2B
#define REP_2B REP_ALL
#endif
#ifndef REP_3
#define REP_3 REP_ALL
#endif
#ifndef REP_4
#define REP_4 REP_ALL
#endif
#ifndef REP_5
#define REP_5 REP_ALL
#endif
#ifndef REP_6
#define REP_6 REP_ALL
#endif
#ifndef REP_7
#define REP_7 REP_ALL
#endif
#ifndef REP_8
#define REP_8 REP_ALL
#endif
#ifndef REP_9
#define REP_9 REP_ALL
#endif
#ifndef REP_10
#define REP_10 REP_ALL
#endif
#ifndef REP_11
#define REP_11 REP_ALL
#endif
#ifndef REP_12
#define REP_12 REP_ALL
#endif
#define REPLOOP(k) _Pragma("unroll 1") for (int rep_ = 0; rep_ < REP_##k; ++rep_)
#define LAS __attribute__((address_space(3)))
#define GAS __attribute__((address_space(1)))
typedef unsigned short bf16_t;
typedef short bf16x8 __attribute__((ext_vector_type(8)));
typedef float f32x4 __attribute__((ext_vector_type(4)));
typedef float f32x2 __attribute__((ext_vector_type(2)));
typedef unsigned u32x4 __attribute__((ext_vector_type(4)));
typedef unsigned u32x2 __attribute__((ext_vector_type(2)));
typedef __bf16 bf16x2_t __attribute__((ext_vector_type(2)));
#define RLX_AGENT __ATOMIC_RELAXED, __HIP_MEMORY_SCOPE_AGENT

constexpr int NB = 16, SEQ = 4096, NMETA = 16, TT = SEQ + NMETA  , MROWS = NB * TT  , DM = 1024;
constexpr int NZP = 5632;
constexpr int NZ = 4096;
constexpr int ZMQ = 0, ZMK = 512, ZMV = 1024, ZMO = 1536, ZGA = 2048, ZGM = 3072;
constexpr int ZYC = 0;
constexpr int NIN = 5640;
constexpr int NE = 32, FF = 1024;
constexpr int OROWS = 4352;
constexpr float LN_EPS = 1e-5f;
constexpr float DN_ALPHA = 1.189207115002721f;
constexpr float LAMBDA_INIT = 0.2f;
constexpr float ATT_C2 = 0.125f * 1.4426950408889634f;

constexpr size_t MiB = 1u << 20;
constexpr size_t WS_CTL = 0, CTL_ZERO_BYTES = 1 * MiB;
constexpr size_t WS_WIN = 2 * MiB;
constexpr size_t WS_WA = 13 * MiB;
constexpr size_t WS_WM = 14 * MiB;
constexpr size_t WS_WO = 15 * MiB;
constexpr size_t WS_ROPE = 17 * MiB;
constexpr size_t WS_STATS = 19 * MiB;
constexpr size_t WS_GATES = 20 * MiB;
constexpr size_t WS_TOKE = 23 * MiB;
constexpr size_t WS_TOKG = 24 * MiB + 512 * 1024;
constexpr size_t WS_HIST = 26 * MiB;
constexpr size_t WS_ROWOFF = 27 * MiB;
constexpr size_t WS_ROWSLOT = 28 * MiB + 512 * 1024;
constexpr size_t WS_ROWGATE = 30 * MiB;
constexpr size_t WS_TILEEXP = 31 * MiB + 512 * 1024;
constexpr size_t WS_H = 32 * MiB;
constexpr size_t WS_Z = 162 * MiB;
constexpr size_t WS_Y = WS_Z;
constexpr size_t WS_ACT = WS_Z + 516 * MiB;
constexpr size_t WS_QC = 680 * MiB;
constexpr size_t WS_KC = 745 * MiB;
constexpr size_t WS_VC = 810 * MiB;
constexpr size_t WS_TMP = 680 * MiB;
constexpr size_t WS_MRG = 810 * MiB;
constexpr size_t WS_END = 1024 * MiB;
constexpr size_t DO_O = 0;
constexpr size_t DO_HM = 136 * MiB;
constexpr size_t DO_WGU = 0;
constexpr size_t DO_WDN = 128 * MiB;
constexpr int CW_TMO = 0, CW_NT = 64, CW_TICKET = 128  , CW_BAR = 4096;

constexpr int LDS_BYTES = 163840;
constexpr int MISC_OFF = 163840 - 512;
constexpr int NWAVES = 8;

__device__ __forceinline__ unsigned pkbf(float lo, float hi) { f32x2 v = {lo, hi}; bf16x2_t b = __builtin_convertvector(v, bf16x2_t); return __builtin_bit_cast(unsigned, b); }
__device__ __forceinline__ float bflo(unsigned w) { return __uint_as_float(w << 16); }
__device__ __forceinline__ float bfhi(unsigned w) { return __uint_as_float(w & 0xffff0000u); }
__device__ __forceinline__ float sigmoidf_(float x) { return __builtin_amdgcn_rcpf(1.0f + __expf(-x)); }
template <int CTRL> __device__ __forceinline__ float dppf(float v) { return __builtin_bit_cast(float, __builtin_amdgcn_update_dpp(0, __builtin_bit_cast(int, v), CTRL, 0xF, 0xF, true)); }
__device__ __forceinline__ float rdlane(float v, int l) { return __builtin_bit_cast(float, __builtin_amdgcn_readlane(__builtin_bit_cast(int, v), l)); }
__device__ __forceinline__ float row_sum16(float v) { v += dppf<0xB1>(v); v += dppf<0x4E>(v); v += dppf<0x141>(v); v += dppf<0x140>(v); return v; }
__device__ __forceinline__ float wave_sum(float v) { v = row_sum16(v); return (rdlane(v, 0) + rdlane(v, 16)) + (rdlane(v, 32) + rdlane(v, 48)); }
__device__ __forceinline__ float wave_max(float v) {
    v = fmaxf(v, dppf<0xB1>(v)); v = fmaxf(v, dppf<0x4E>(v)); v = fmaxf(v, dppf<0x141>(v)); v = fmaxf(v, dppf<0x140>(v));
    return fmaxf(fmaxf(rdlane(v, 0), rdlane(v, 16)), fmaxf(rdlane(v, 32), rdlane(v, 48)));
}
__device__ __forceinline__ float xreduce32(float (&p)[32], int lane) {
    float a[16], b[8], c[4], d[2];
#pragma unroll
    for (int i = 0; i < 16; ++i) { auto r = __builtin_amdgcn_permlane32_swap(__float_as_uint(p[i]), __float_as_uint(p[16 + i]), false, false); a[i] = __uint_as_float(r[0]) + __uint_as_float(r[1]); }
#pragma unroll
    for (int i = 0; i < 8; ++i) { auto r = __builtin_amdgcn_permlane16_swap(__float_as_uint(a[i]), __float_as_uint(a[8 + i]), false, false); b[i] = __uint_as_float(r[0]) + __uint_as_float(r[1]); }
    const bool b3 = (lane & 8) != 0, b2 = (lane & 4) != 0, b1 = (lane & 2) != 0;
#pragma unroll
    for (int i = 0; i < 4; ++i) { const float keep = b3 ? b[4 + i] : b[i], send = b3 ? b[i] : b[4 + i]; c[i] = keep + dppf<0x128>(send); }
#pragma unroll
    for (int i = 0; i < 2; ++i) { const float keep = b2 ? c[2 + i] : c[i], send = b2 ? c[i] : c[2 + i]; d[i] = keep + dppf<0x141>(send); }
    const float keep = b1 ? d[1] : d[0], send = b1 ? d[0] : d[1];
    float r = keep + dppf<0x4E>(send);
    r += dppf<0xB1>(r);
    return r;
}
__device__ __forceinline__ int ld_agent_i(const int* p) { return __hip_atomic_load(p, RLX_AGENT); }
__device__ __forceinline__ float ld_agent_f(const float* p) { return __hip_atomic_load(p, RLX_AGENT); }
#define LDS_WAIT() asm volatile("s_waitcnt lgkmcnt(0)" ::: "memory")
__device__ __forceinline__ const void* ldptr(LAS const unsigned long long* t, int i) { const unsigned long long v = t[i];
    const unsigned lo = (unsigned)__builtin_amdgcn_readfirstlane((int)(unsigned)v), hi = (unsigned)__builtin_amdgcn_readfirstlane((int)(unsigned)(v >> 32));
    return (const void*)(const GAS void*)(((unsigned long long)hi << 32) | lo); }

namespace pg8 {
constexpr int BM = 256, BK = 64, HALF = 128, HTB = HALF * BK * 2, STAGE_BYTES = 8 * HTB, NXCD = 8, WGM = 8;
__host__ __device__ __forceinline__ int lds_byte(int r, int c) { const int st = (r >> 4) * 2 + (c >> 5), rr = r & 15, cc = c & 31, ob = rr * 64 + cc * 2; return st * 1024 + (ob ^ (((ob >> 9) & 1) << 5)); }
__host__ __device__ __forceinline__ void stage_rc(int b, int& R, int& C) { const int st = b / 1024, sb = b % 1024, swz = sb ^ (((sb >> 9) & 1) << 5); R = (st >> 1) * 16 + swz / 64; C = (st & 1) * 32 + (swz % 64) / 2; }
__host__ __device__ __forceinline__ int perm32(int rho) { const int n = rho >> 4, i = rho & 15; return 8 * (i >> 2) + 4 * n + (i & 3); }

struct Unit { int pm, pn; };
struct Gemm { const bf16_t* A; const bf16_t* Bt; int lda, K, nN; const int* row_off; const int* tile_exp; int pm0; };
struct StaticOrder {
    int nM, nN, nwg, G, c;
    __device__ __forceinline__ void init(int nM_, int nN_, int G_, int c_) { nM = nM_; nN = nN_; nwg = nM * nN; G = G_; c = c_; }
    __device__ __forceinline__ bool next(int i, Unit& u) const {
        const long L = (long)i * G + c; if (L >= nwg) return false;
        int wgid = (int)L; { const int q = nwg / NXCD, r = nwg % NXCD, xcd = wgid % NXCD, off = wgid / NXCD; wgid = (xcd < r ? xcd * (q + 1) : r * (q + 1) + (xcd - r) * q) + off; }
        const int nig = WGM * nN, gid = wgid / nig, fm = gid * WGM, gsz = (nM - fm) < WGM ? (nM - fm) : WGM;
        u.pm = fm + ((wgid % nig) % gsz); u.pn = (wgid % nig) / gsz; return true;
    }
};

template <int MODE, class Epi>
__device__ __forceinline__ void gemm_phase(LAS unsigned char* lds, const Gemm g, const StaticOrder& S, const Epi& E) {
    const int tid = threadIdx.x, wid = __builtin_amdgcn_readfirstlane(tid >> 6), lane = tid & 63, wr = wid >> 2, wc = wid & 3, fr = lane & 15, fq = lane >> 4;
    const int K = g.K, nt = K / BK;
    unsigned voffA[2], voffB[2]; int Rst[2], Cst[2];
#pragma unroll
    for (int i = 0; i < 2; ++i) { int R, C; stage_rc(tid * 16 + i * 8192, R, C); const int Rb = Epi::PERM ? ((R & ~31) + perm32(R & 31)) : R;
        voffA[i] = (unsigned)(R * g.lda + C) * 2u; voffB[i] = (unsigned)(Rb * K + C) * 2u; Rst[i] = R; Cst[i] = C * 2; }
    const size_t kstep = (size_t)(BK * 2);
    const size_t hstepA = (size_t)HALF * g.lda * 2, hstepB = (size_t)HALF * K * 2;
    const size_t tstepA = 2 * hstepA, tstepB = 2 * hstepB;
    const unsigned ldsw = (unsigned)wid * 1024u;
    const int aoff = lds_byte(wr * 64 + fr, fq * 8), boff = lds_byte(wc * 32 + fr, fq * 8);
    unsigned vC[2][2] = {{0u, 0u}, {0u, 0u}}, vN[2][2] = {{0u, 0u}, {0u, 0u}};
#define PG8_SA(b, h) (((b) * 2 + (h)) * HTB)
#define PG8_SB(b, h) ((4 + (b) * 2 + (h)) * HTB)
#define PG8_STAGE_B(bufoff, gbase) do { _Pragma("unroll") for (int _i = 0; _i < 2; ++_i) \
        __builtin_amdgcn_global_load_lds((const unsigned*)((const char*)(gbase) + voffB[_i]), (LAS unsigned*)(lds + (bufoff) + ldsw + _i * 8192), 16, 0, 0); } while (0)
#define PG8_STAGE_A(bufoff, gbase, h, nx) do { _Pragma("unroll") for (int _i = 0; _i < 2; ++_i) { \
        const char* _p = (MODE == 1) ? ((const char*)(gbase) + ((nx) ? vN[h][_i] : vC[h][_i])) : ((const char*)(gbase) + (h) * hstepA + voffA[_i]); \
        __builtin_amdgcn_global_load_lds((const unsigned*)_p, (LAS unsigned*)(lds + (bufoff) + ldsw + _i * 8192), 16, 0, 0); } } while (0)
#define PG8_LDA(dst, b, h) do { _Pragma("unroll") for (int m = 0; m < 4; ++m) _Pragma("unroll") for (int k = 0; k < 2; ++k) dst[m][k] = *(const LAS bf16x8*)(lds + PG8_SA(b, h) + aoff + m * 2048 + k * 1024); } while (0)
#define PG8_LDB(dst, b, h) do { _Pragma("unroll") for (int n = 0; n < 2; ++n) _Pragma("unroll") for (int k = 0; k < 2; ++k) dst[n][k] = *(const LAS bf16x8*)(lds + PG8_SB(b, h) + boff + n * 2048 + k * 1024); } while (0)
#define PG8_MMA(ai, bj, At, Bt) do { __builtin_amdgcn_s_setprio(1); _Pragma("unroll") for (int m = 0; m < 4; ++m) _Pragma("unroll") for (int n = 0; n < 2; ++n) _Pragma("unroll") for (int k = 0; k < 2; ++k) \
        acc[ai][bj][m][n] = __builtin_amdgcn_mfma_f32_16x16x32_bf16(Bt[n][k], At[m][k], acc[ai][bj][m][n], 0, 0, 0); __builtin_amdgcn_s_setprio(0); } while (0)
#define PG8_WAIT_V(n) asm volatile("s_waitcnt vmcnt(" #n ")" ::: "memory")
#define PG8_WAIT_L(n) asm volatile("s_waitcnt lgkmcnt(" #n ")" ::: "memory")
#define PG8_BAR __builtin_amdgcn_s_barrier()
#define PG8_SCHED __builtin_amdgcn_sched_barrier(0)
#define PG8_ABASE(u) ((MODE == 1) ? (const char*)g.A : (const char*)g.A + (size_t)(u).pm * tstepA)
#define PG8_BBASE(u) ((MODE == 0) ? (const char*)g.Bt + (size_t)(u).pn * tstepB : (const char*)g.Bt + ((size_t)__builtin_amdgcn_readfirstlane(ld_agent_i(g.tile_exp + g.pm0 + (u).pm)) * g.nN + (u).pn) * tstepB)
#define PG8_GATHER(dst, u) do { if (MODE == 1) { _Pragma("unroll") for (int _h = 0; _h < 2; ++_h) _Pragma("unroll") for (int _i = 0; _i < 2; ++_i) \
        dst[_h][_i] = (unsigned)ld_agent_i(g.row_off + (size_t)(g.pm0 + (u).pm) * BM + _h * HALF + Rst[_i]) + (unsigned)Cst[_i]; } } while (0)
    Unit cur, nxt; int ui = 0;
    if (!S.next(0, cur)) return;
    f32x4 acc[2][2][4][2];
#pragma unroll
    for (int a = 0; a < 2; ++a)
#pragma unroll
        for (int b = 0; b < 2; ++b)
#pragma unroll
            for (int m = 0; m < 4; ++m)
#pragma unroll
                for (int n = 0; n < 2; ++n) acc[a][b][m][n] = (f32x4){0.f, 0.f, 0.f, 0.f};
    bf16x8 At[4][2], B0[2][2], B1[2][2];
    const char* cA = PG8_ABASE(cur); const char* cB = PG8_BBASE(cur);
    PG8_GATHER(vC, cur);
    PG8_STAGE_B(PG8_SB(0, 0), cB); PG8_STAGE_B(PG8_SB(0, 1), cB + hstepB); PG8_STAGE_A(PG8_SA(0, 0), cA, 0, false); PG8_STAGE_A(PG8_SA(0, 1), cA, 1, false);
    if (wr == 1) PG8_BAR;
    PG8_WAIT_V(2); PG8_BAR;
    PG8_STAGE_B(PG8_SB(1, 0), cB + kstep); PG8_STAGE_A(PG8_SA(1, 0), cA + kstep, 0, false); PG8_STAGE_B(PG8_SB(1, 1), cB + hstepB + kstep);
    PG8_WAIT_V(6); PG8_BAR;
    for (;;) {
        const bool has_next = S.next(ui + 1, nxt);
        const char* nA = has_next ? PG8_ABASE(nxt) : cA; const char* nB = has_next ? PG8_BBASE(nxt) : cB;
        if (MODE == 1) { if (has_next) { PG8_GATHER(vN, nxt); } else {
#pragma unroll
            for (int _h = 0; _h < 2; ++_h)
#pragma unroll
                for (int _i = 0; _i < 2; ++_i) vN[_h][_i] = vC[_h][_i]; } }
        for (int t = 0; t < nt; t += 2) {
            const bool last = (t == nt - 2);
            const char* a1 = cA + (size_t)(t + 1) * kstep;
            const char* a2 = last ? nA : cA + (size_t)(t + 2) * kstep; const char* b2 = last ? nB : cB + (size_t)(t + 2) * kstep;
            const char* a3 = a2 + kstep; const char* b3 = b2 + kstep;
            PG8_LDB(B0, 0, 0); PG8_LDB(B1, 0, 1); PG8_SCHED; PG8_LDA(At, 0, 0); PG8_STAGE_A(PG8_SA(1, 1), a1, 1, false);
            PG8_WAIT_V(8); PG8_WAIT_L(0); PG8_BAR; PG8_MMA(0, 0, At, B0); PG8_MMA(0, 1, At, B1); PG8_BAR; PG8_SCHED;
            PG8_LDA(At, 0, 1); PG8_STAGE_B(PG8_SB(0, 0), b2); PG8_STAGE_B(PG8_SB(0, 1), b2 + hstepB); PG8_STAGE_A(PG8_SA(0, 0), a2, 0, last);
            PG8_WAIT_V(8); PG8_WAIT_L(0); PG8_BAR; PG8_MMA(1, 0, At, B0); PG8_MMA(1, 1, At, B1); PG8_BAR; PG8_SCHED;
            PG8_LDB(B0, 1, 0); PG8_LDB(B1, 1, 1); PG8_SCHED; PG8_LDA(At, 1, 0); PG8_STAGE_A(PG8_SA(0, 1), a2, 1, last);
            PG8_WAIT_V(8); PG8_WAIT_L(0); PG8_BAR; PG8_MMA(0, 0, At, B0); PG8_MMA(0, 1, At, B1); PG8_BAR; PG8_SCHED;
            PG8_LDA(At, 1, 1); PG8_STAGE_B(PG8_SB(1, 0), b3); PG8_STAGE_B(PG8_SB(1, 1), b3 + hstepB); PG8_STAGE_A(PG8_SA(1, 0), a3, 0, last);
            PG8_WAIT_V(8); PG8_WAIT_L(0); PG8_BAR; PG8_MMA(1, 0, At, B0); PG8_MMA(1, 1, At, B1); PG8_BAR; PG8_SCHED;
        }
        if (wr == 0) PG8_BAR;
        E(acc, cur, wr, wc, fr, fq);
        if (!has_next) break;
#pragma unroll
        for (int a = 0; a < 2; ++a)
#pragma unroll
            for (int b = 0; b < 2; ++b)
#pragma unroll
                for (int m = 0; m < 4; ++m)
#pragma unroll
                    for (int n = 0; n < 2; ++n) acc[a][b][m][n] = (f32x4){0.f, 0.f, 0.f, 0.f};
        cur = nxt; cA = nA; cB = nB; ++ui;
        if (MODE == 1) {
#pragma unroll
            for (int _h = 0; _h < 2; ++_h)
#pragma unroll
                for (int _i = 0; _i < 2; ++_i) vC[_h][_i] = vN[_h][_i]; }
        if (wr == 1) PG8_BAR;
    }
    PG8_WAIT_V(0);
    PG8_BAR;
#undef PG8_SA
#undef PG8_SB
#undef PG8_STAGE_A
#undef PG8_STAGE_B
#undef PG8_LDA
#undef PG8_LDB
#undef PG8_MMA
#undef PG8_WAIT_V
#undef PG8_WAIT_L
#undef PG8_BAR
#undef PG8_SCHED
#undef PG8_ABASE
#undef PG8_BBASE
#undef PG8_GATHER
}

struct EpiZ {
    static constexpr bool PERM = true;
    bf16_t* Z; bf16_t* Qc; bf16_t* Kc; bf16_t* Vc; const float* ropec; const float* ropes;
    __device__ __forceinline__ void operator()(const f32x4 (&acc)[2][2][4][2], const Unit& u, int wr, int wc, int fr, int fq) const {
        const int row0 = u.pm * BM + wr * 64 + fr;
        if (u.pn < 4) {
            const float sc = (u.pn < 2) ? ATT_C2 : 1.0f;
            bf16_t* base = (u.pn < 2) ? Qc : Kc;
            const int dl = 16 * (wc & 1) + 4 * fq;
#pragma unroll
            for (int ai = 0; ai < 2; ++ai)
#pragma unroll
                for (int m = 0; m < 4; ++m) {
                    const int row = row0 + ai * HALF + m * 16; const int b = row / TT, t = row - b * TT;
                    const f32x4 c = *(const f32x4*)(ropec + t * 32 + dl) * sc, s = *(const f32x4*)(ropes + t * 32 + dl) * sc;
#pragma unroll
                    for (int bj = 0; bj < 2; ++bj) {
                        const int hm = 4 * (u.pn & 1) + 2 * bj + (wc >> 1);
                        const f32x4 x1 = acc[ai][bj][m][0], x2 = acc[ai][bj][m][1];
                        const f32x4 o1 = x1 * c - x2 * s, o2 = x2 * c + x1 * s;
                        bf16_t* p = base + ((size_t)(b * 8 + hm) * TT + t) * 64 + dl;
                        u32x2 w1, w2; w1.x = pkbf(o1[0], o1[1]); w1.y = pkbf(o1[2], o1[3]); w2.x = pkbf(o2[0], o2[1]); w2.y = pkbf(o2[2], o2[3]);
                        *(u32x2*)p = w1; *(u32x2*)(p + 32) = w2;
                    }
                }
        } else if (u.pn < 6) {
            const int e0 = wc * 32 + 8 * fq;
#pragma unroll
            for (int ai = 0; ai < 2; ++ai)
#pragma unroll
                for (int m = 0; m < 4; ++m) {
                    const int row = row0 + ai * HALF + m * 16; const int b = row / TT, t = row - b * TT;
#pragma unroll
                    for (int bj = 0; bj < 2; ++bj) { const int h = (u.pn - 4) * 2 + bj; const f32x4 v0 = acc[ai][bj][m][0], v1 = acc[ai][bj][m][1];
                        u32x4 w; w.x = pkbf(v0[0], v0[1]); w.y = pkbf(v0[2], v0[3]); w.z = pkbf(v1[0], v1[1]); w.w = pkbf(v1[2], v1[3]);
                        *(u32x4*)(Vc + ((size_t)(b * 4 + h) * TT + t) * 128 + e0) = w; }
                }
        } else {
            const int col0 = (u.pn - 6) * BM + wc * 32 + 8 * fq;
#pragma unroll
            for (int ai = 0; ai < 2; ++ai)
#pragma unroll
                for (int m = 0; m < 4; ++m) {
                    bf16_t* rowp = Z + (size_t)(row0 + ai * HALF + m * 16) * NZ + col0;
#pragma unroll
                    for (int bj = 0; bj < 2; ++bj) { const f32x4 v0 = acc[ai][bj][m][0], v1 = acc[ai][bj][m][1];
                        u32x4 w; w.x = pkbf(v0[0], v0[1]); w.y = pkbf(v0[2], v0[3]); w.z = pkbf(v1[0], v1[1]); w.w = pkbf(v1[2], v1[3]);
                        *(u32x4*)(rowp + bj * HALF) = w; }
                }
        }
    }
};
template <bool SECOND> struct EpiGate {
    static constexpr bool PERM = true;
    bf16_t* Z; bf16_t* TMP; bf16_t* MRG;
    __device__ __forceinline__ void operator()(const f32x4 (&acc)[2][2][4][2], const Unit& u, int wr, int wc, int fr, int fq) const {
        const int row0 = u.pm * BM + wr * 64 + fr, col0 = u.pn * BM + wc * 32 + 8 * fq;
#pragma unroll
        for (int ai = 0; ai < 2; ++ai)
#pragma unroll
            for (int m = 0; m < 4; ++m) {
                bf16_t* rowp = Z + (size_t)(row0 + ai * HALF + m * 16) * NZ + col0; bf16_t* tmpp = TMP + (size_t)(row0 + ai * HALF + m * 16) * DM + col0; bf16_t* mrgp = MRG + (size_t)(row0 + ai * HALF + m * 16) * DM + col0;
#pragma unroll
                for (int bj = 0; bj < 2; ++bj) {
                    const u32x4 gw = *(const u32x4*)(rowp + (SECOND ? ZGM : ZGA) + bj * HALF);
                    const f32x4 v0 = acc[ai][bj][m][0], v1 = acc[ai][bj][m][1];
                    float o[8];
                    o[0] = sigmoidf_(bflo(gw.x)) * v0[0]; o[1] = sigmoidf_(bfhi(gw.x)) * v0[1]; o[2] = sigmoidf_(bflo(gw.y)) * v0[2]; o[3] = sigmoidf_(bfhi(gw.y)) * v0[3];
                    o[4] = sigmoidf_(bflo(gw.z)) * v1[0]; o[5] = sigmoidf_(bfhi(gw.z)) * v1[1]; o[6] = sigmoidf_(bflo(gw.w)) * v1[2]; o[7] = sigmoidf_(bfhi(gw.w)) * v1[3];
                    if (SECOND) { const u32x4 tw = *(const u32x4*)(tmpp + bj * HALF);
                        o[0] += bflo(tw.x); o[1] += bfhi(tw.x); o[2] += bflo(tw.y); o[3] += bfhi(tw.y); o[4] += bflo(tw.z); o[5] += bfhi(tw.z); o[6] += bflo(tw.w); o[7] += bfhi(tw.w); }
                    u32x4 w; w.x = pkbf(o[0], o[1]); w.y = pkbf(o[2], o[3]); w.z = pkbf(o[4], o[5]); w.w = pkbf(o[6], o[7]);
                    if (SECOND) *(u32x4*)(mrgp + bj * HALF) = w; else *(u32x4*)(tmpp + bj * HALF) = w;
                }
            }
    }
};
struct EpiPre1 {
    static constexpr bool PERM = false;
    float* P1; const float* x; const float* meta; const float* stats; const float* g0; const float* b0;
    __device__ __forceinline__ void operator()(const f32x4 (&acc)[2][2][4][2], const Unit& u, int wr, int wc, int fr, int fq) const {
        const int row0 = u.pm * BM + wr * 64 + fr, col0 = u.pn * BM + wc * 32 + 4 * fq;
        f32x4 gv[2][2], bv[2][2];
#pragma unroll
        for (int bj = 0; bj < 2; ++bj)
#pragma unroll
            for (int n = 0; n < 2; ++n) { gv[bj][n] = *(const f32x4*)(g0 + col0 + bj * HALF + n * 16); bv[bj][n] = *(const f32x4*)(b0 + col0 + bj * HALF + n * 16); }
#pragma unroll
        for (int ai = 0; ai < 2; ++ai)
#pragma unroll
            for (int m = 0; m < 4; ++m) {
                const int row = row0 + ai * HALF + m * 16; const int b = row / TT, t = row - b * TT;
                const float* xr = (t < NMETA) ? meta + (size_t)t * DM : x + ((size_t)b * SEQ + (t - NMETA)) * DM;
                const float mean = ld_agent_f(stats + 2 * row), rstd = ld_agent_f(stats + 2 * row + 1);
                float* orow = P1 + (size_t)row * (NZ / 2) + col0;
#pragma unroll
                for (int bj = 0; bj < 2; ++bj)
#pragma unroll
                    for (int n = 0; n < 2; ++n) { const f32x4 xv = *(const f32x4*)(xr + col0 + bj * HALF + n * 16);
                        const f32x4 hv = (xv - mean) * rstd * gv[bj][n] + bv[bj][n];
                        *(f32x4*)(orow + bj * HALF + n * 16) = hv * DN_ALPHA + acc[ai][bj][m][n]; }
            }
    }
};
struct EpiAct {
    static constexpr bool PERM = true;
    bf16_t* ACT; const float* b_gu; const int* tile_exp; int pm0;
    __device__ __forceinline__ void operator()(const f32x4 (&acc)[2][2][4][2], const Unit& u, int wr, int wc, int fr, int fq) const {
        const int e = __builtin_amdgcn_readfirstlane(ld_agent_i(tile_exp + pm0 + u.pm));
        const int ac0 = u.pn * HALF + wc * 32 + 8 * fq;
        const float* bp = b_gu + (size_t)e * 2 * FF + 2 * ac0;
        float bg[8], bl[8];
#pragma unroll
        for (int q = 0; q < 4; ++q) { const f32x4 v = *(const f32x4*)(bp + 4 * q); bg[2 * q] = v[0]; bl[2 * q] = v[1]; bg[2 * q + 1] = v[2]; bl[2 * q + 1] = v[3]; }
        const int row0 = u.pm * BM + wr * 64 + fr;
#pragma unroll
        for (int ai = 0; ai < 2; ++ai)
#pragma unroll
            for (int m = 0; m < 4; ++m) {
                float o[8];
#pragma unroll
                for (int j = 0; j < 8; ++j) {
                    float gl = acc[ai][0][m][j >> 2][j & 3] + bg[j], li = acc[ai][1][m][j >> 2][j & 3] + bl[j];
                    gl = fminf(gl, 7.0f); li = fminf(fmaxf(li, -7.0f), 7.0f);
                    o[j] = gl * sigmoidf_(1.702f * gl) * (li + 1.0f);
                }
                u32x4 w; w.x = pkbf(o[0], o[1]); w.y = pkbf(o[2], o[3]); w.z = pkbf(o[4], o[5]); w.w = pkbf(o[6], o[7]);
                *(u32x4*)(ACT + (size_t)(row0 + ai * HALF + m * 16) * FF + ac0) = w;
            }
    }
};
struct EpiDown {
    static constexpr bool PERM = true;
    bf16_t* Y; const float* b_down; const int* tile_exp; const int* row_slot; const float* row_gate; int pm0;
    __device__ __forceinline__ void operator()(const f32x4 (&acc)[2][2][4][2], const Unit& u, int wr, int wc, int fr, int fq) const {
        const int e = __builtin_amdgcn_readfirstlane(ld_agent_i(tile_exp + pm0 + u.pm));
        const int col0 = u.pn * BM + wc * 32 + 8 * fq;
        f32x4 bv[2][2];
#pragma unroll
        for (int bj = 0; bj < 2; ++bj)
#pragma unroll
            for (int n = 0; n < 2; ++n) bv[bj][n] = *(const f32x4*)(b_down + (size_t)e * DM + col0 + bj * HALF + 4 * n);
        const int r0 = (pm0 + u.pm) * BM + wr * 64 + fr;
#pragma unroll
        for (int ai = 0; ai < 2; ++ai)
#pragma unroll
            for (int m = 0; m < 4; ++m) {
                const int r = r0 + ai * HALF + m * 16;
                const int slot = ld_agent_i(row_slot + r); const float gt = ld_agent_f(row_gate + r);
                bf16_t* rowp = Y + (size_t)slot * DM + col0;
#pragma unroll
                for (int bj = 0; bj < 2; ++bj) { const f32x4 v0 = (acc[ai][bj][m][0] + bv[bj][0]) * gt, v1 = (acc[ai][bj][m][1] + bv[bj][1]) * gt;
                    u32x4 w; w.x = pkbf(v0[0], v0[1]); w.y = pkbf(v0[2], v0[3]); w.z = pkbf(v1[0], v1[1]); w.w = pkbf(v1[2], v1[3]);
                    *(u32x4*)(rowp + bj * HALF) = w; }
            }
    }
};
}

namespace attn_body {
using bf16 = __hip_bfloat16;
using s16x4 = __attribute__((ext_vector_type(4))) short;
using f32x16 = __attribute__((ext_vector_type(16))) float;
constexpr int D = 64, PZ = 64, PV = 128, PO = 1024;
constexpr int NW = 8, QBLK = 32, QB = QBLK * NW, KVBLK = 64;
__device__ __forceinline__ int crow(int r, int hi) { return (r & 3) + 8 * (r >> 2) + 4 * hi; }
#define SBAR() __builtin_amdgcn_sched_barrier(0)
__device__ __forceinline__ void cmask(f32x16& p0, f32x16& p1, int jb, int qrel, int hi) {
    const float NEG = -INFINITY; const int d = qrel - 64 * jb - 4 * hi;
#pragma unroll
    for (int r = 0; r < 16; ++r) { const int c = (r & 3) + 8 * (r >> 2); if (c > d) p0[r] = NEG; if (c + 32 > d) p1[r] = NEG; }
}
constexpr int NSLOT = 3, SLOTB = 8192;
constexpr int LDS_K = 0, LDS_V = NSLOT * SLOTB, LDS_WS = 2 * NSLOT * SLOTB, LDS_OST = LDS_WS + NW * 64 * 4, LDS_BYTES_A = LDS_OST + NW * 4096;
__device__ __forceinline__ void glds16(const void* gsrc, unsigned lds_dst) { unsigned keep;
    asm volatile("s_mov_b32 %0, m0\n\ts_mov_b32 m0, %2\n\ts_nop 0\n\tglobal_load_lds_dwordx4 %1, off\n\ts_mov_b32 m0, %0" : "=&s"(keep) : "v"(gsrc), "s"(lds_dst) : "memory"); }
__device__ __forceinline__ float max3f(float a, float b, float c) { float r; asm("v_max3_f32 %0, %1, %2, %3" : "=v"(r) : "v"(a), "v"(b), "v"(c)); return r; }
__device__ __forceinline__ float max2f(float a, float b) { float r; asm("v_max_f32_e32 %0, %1, %2" : "=v"(r) : "v"(a), "v"(b)); return r; }
__device__ __forceinline__ float fadd_s(float a, float b) { float r; asm("v_add_f32_e32 %0, %1, %2" : "=v"(r) : "v"(a), "v"(b)); return r; }
__device__ __forceinline__ float fsub_s(float a, float b) { float r; asm("v_sub_f32_e32 %0, %1, %2" : "=v"(r) : "v"(a), "v"(b)); return r; }
__device__ __forceinline__ unsigned cvtpk_s(float lo, float hi) { return pkbf(lo, hi); }
#define WAIT_BAR(N) asm volatile("s_waitcnt vmcnt(" #N ") lgkmcnt(0)\n\ts_barrier" ::: "memory")
__device__ __forceinline__ void qkt(f32x16& p0, f32x16& p1, const char* Kslot, const bf16x8* qr, const f32x16& negm, int r32, int hi) {
    const char* kb = Kslot + hi * 1024 + r32 * 16;
#pragma unroll
    for (int d0 = 0; d0 < 4; ++d0) {
        const bf16x8 b0 = *reinterpret_cast<const bf16x8*>(kb + d0 * 2048);
        const bf16x8 b1 = *reinterpret_cast<const bf16x8*>(kb + d0 * 2048 + 512);
        if (d0 == 0) { p0 = __builtin_amdgcn_mfma_f32_32x32x16_bf16(b0, qr[0], negm, 0, 0, 0); p1 = __builtin_amdgcn_mfma_f32_32x32x16_bf16(b1, qr[0], negm, 0, 0, 0); }
        else { p0 = __builtin_amdgcn_mfma_f32_32x32x16_bf16(b0, qr[d0], p0, 0, 0, 0); p1 = __builtin_amdgcn_mfma_f32_32x32x16_bf16(b1, qr[d0], p1, 0, 0, 0); } }
}
typedef __attribute__((address_space(3))) const char* lds_cptr;
typedef short v4i16_t __attribute__((ext_vector_type(4)));
__device__ __forceinline__ void kload8(bf16x8* kf, lds_cptr kp) {
    kf[0] = *(const __attribute__((address_space(3))) bf16x8*)(kp);        kf[1] = *(const __attribute__((address_space(3))) bf16x8*)(kp + 512);
    kf[2] = *(const __attribute__((address_space(3))) bf16x8*)(kp + 2048); kf[3] = *(const __attribute__((address_space(3))) bf16x8*)(kp + 2560);
    kf[4] = *(const __attribute__((address_space(3))) bf16x8*)(kp + 4096); kf[5] = *(const __attribute__((address_space(3))) bf16x8*)(kp + 4608);
    kf[6] = *(const __attribute__((address_space(3))) bf16x8*)(kp + 6144); kf[7] = *(const __attribute__((address_space(3))) bf16x8*)(kp + 6656);
}
__device__ __forceinline__ void kload2(bf16x8* kf, lds_cptr kp, int j) { kf[2 * j] = *(const __attribute__((address_space(3))) bf16x8*)(kp + j * 2048); kf[2 * j + 1] = *(const __attribute__((address_space(3))) bf16x8*)(kp + j * 2048 + 512); }
__device__ __forceinline__ s16x4 vtr(lds_cptr p) { return __builtin_bit_cast(s16x4, __builtin_amdgcn_ds_read_tr16_b64_v4i16((__attribute__((address_space(3))) v4i16_t*)p)); }
__device__ __forceinline__ float rowmax(const f32x16& p0, const f32x16& p1) {
    float a = max3f(p0[0], p0[1], p1[0]), b = max3f(p0[2], p0[3], p1[1]); a = max3f(a, p1[2], p1[3]);
#pragma unroll
    for (int r = 4; r < 16; r += 4) { a = max3f(a, p0[r], p0[r + 1]); b = max3f(b, p0[r + 2], p0[r + 3]); a = max3f(a, p1[r], p1[r + 1]); b = max3f(b, p1[r + 2], p1[r + 3]); }
    const float m = max2f(a, b);
    auto rr = __builtin_amdgcn_permlane32_swap(__float_as_uint(m), __float_as_uint(m), false, false);
    return max2f(__uint_as_float(rr[0]), __uint_as_float(rr[1]));
}
__device__ __forceinline__ void pv(f32x16* o, int vb, bf16x8 pa0, bf16x8 pa1, bf16x8 pa2, bf16x8 pa3) {
#pragma unroll
    for (int d0 = 0; d0 < 2; ++d0) { s16x4 lo[4], hi[4];
#pragma unroll
        for (int ks = 0; ks < 4; ++ks) {
            asm volatile("ds_read_b64_tr_b16 %0,%1 offset:%c2" : "=&v"(lo[ks]) : "v"(vb), "i"(d0 * 4096 + ks * 1024) : "memory");
            asm volatile("ds_read_b64_tr_b16 %0,%1 offset:%c2" : "=&v"(hi[ks]) : "v"(vb), "i"(d0 * 4096 + ks * 1024 + 512) : "memory"); }
        asm volatile("s_waitcnt lgkmcnt(0)" ::: "memory"); SBAR();
#define PK(k) (bf16x8){lo[k][0], lo[k][1], lo[k][2], lo[k][3], hi[k][0], hi[k][1], hi[k][2], hi[k][3]}
        o[d0] = __builtin_amdgcn_mfma_f32_32x32x16_bf16(pa0, PK(0), o[d0], 0, 0, 0);
        o[d0] = __builtin_amdgcn_mfma_f32_32x32x16_bf16(pa1, PK(1), o[d0], 0, 0, 0);
        o[d0] = __builtin_amdgcn_mfma_f32_32x32x16_bf16(pa2, PK(2), o[d0], 0, 0, 0);
        o[d0] = __builtin_amdgcn_mfma_f32_32x32x16_bf16(pa3, PK(3), o[d0], 0, 0, 0);
#undef PK
    }
}
#define ATTN_STORE16(p, v) (*(u32x4*)(p) = (v))
template <int THRL> __device__ __forceinline__ void attn_unit(int qb, const bf16* Qh, const bf16* __restrict__ Kh, const bf16* __restrict__ Vh, bf16* Oh, char* shm) {
    const int tid = threadIdx.x; int lane = tid & 63; asm volatile("" : "+v"(lane));
    const int r32 = lane & 31, hi = lane >> 5; const int wid = __builtin_amdgcn_readfirstlane(tid >> 6);
    const int q0 = qb * QB;
    const bf16* Qw = Qh + (long)(q0 + wid * QBLK) * PZ;
    const unsigned lds0 = (unsigned)(uintptr_t)shm;
    float* wsf = (float*)(shm + LDS_WS) + wid * 64;
    const bf16* ksrc = Kh + (long)lane * PZ + wid * 8;
    const bf16* vsrc = Vh + (long)(16 * (wid & 3) + (lane >> 2)) * PV + (wid >> 2) * 32 + (lane & 3) * 8;
    const unsigned kdst = lds0 + LDS_K + wid * 1024, vdst = lds0 + LDS_V + wid * 1024;
#define DMA_K(t, slot) glds16(ksrc + (long)(t) * KVBLK * PZ, (unsigned)__builtin_amdgcn_readfirstlane(kdst + (slot)))
#define DMA_V(t, slot) glds16(vsrc + (long)(t) * KVBLK * PV, (unsigned)__builtin_amdgcn_readfirstlane(vdst + (slot)))
    const int vb0 = (int)(lds0 + LDS_V) + ((lane >> 4) & 1) * 32 + (lane & 3) * 8 + (4 * hi + ((lane & 15) >> 2)) * 64;
    const char* Kbase = shm + LDS_K; bf16x8 kf[8];
    const lds_cptr shm3 = (lds_cptr)shm; const lds_cptr kp0 = shm3 + LDS_K + hi * 1024 + r32 * 16; const lds_cptr vp0 = shm3 + LDS_V + ((lane >> 4) & 1) * 32 + (lane & 3) * 8 + (4 * hi + ((lane & 15) >> 2)) * 64;
    const int NT = (q0 + QB) / KVBLK;
    DMA_K(0, 0); DMA_V(0, 0); DMA_K(1, SLOTB);
    bf16x8 qr[4];
#pragma unroll
    for (int d0 = 0; d0 < 4; ++d0) qr[d0] = *reinterpret_cast<const bf16x8*>(&Qw[(long)r32 * PZ + d0 * 16 + hi * 8]);
    float mhat = 0.f, l_reg = 0.f; f32x16 o[2]; o[0] = f32x16{}; o[1] = f32x16{}; f32x16 negm = f32x16{}; asm volatile("" : "+v"(negm));
    const int qrel = wid * QBLK + r32;
#define CMASK(P0, P1, t) do { int jb_ = (t) - (NT - 4); if (jb_ >= 0) cmask(P0, P1, jb_, qrel, hi); } while (0)
    bool resc = false;
#define START(P0, P1) do { const float rm = rowmax(P0, P1); resc = false; \
    { const float dl = rm; mhat = fadd_s(mhat, dl); \
      _Pragma("unroll") for (int r = 0; r < 16; ++r) { P0[r] = fsub_s(P0[r], dl); P1[r] = fsub_s(P1[r], dl); } \
      _Pragma("unroll") for (int r = 0; r < 16; ++r) negm[r] = -mhat; asm volatile("" : "+v"(negm)); } \
    _Pragma("unroll") for (int r = 0; r < 16; ++r) P0[r] = __builtin_amdgcn_exp2f(P0[r]); } while (0)
#define RESC() do { if (resc) { asm volatile("s_waitcnt lgkmcnt(0)" ::: "memory"); \
      _Pragma("unroll") for (int d_ = 0; d_ < 2; ++d_) _Pragma("unroll") for (int r = 0; r < 16; ++r) o[d_][r] *= wsf[crow(r, hi)]; } } while (0)
    f32x16 pA0, pA1, pB0, pB1;
    int sl_prev = 0, sl_cur = 0, sl_next = SLOTB;
#define ROT() do { sl_prev = sl_cur; sl_cur = sl_next; sl_next = (sl_next == (NSLOT - 1) * SLOTB) ? 0 : sl_next + SLOTB; } while (0)
    DMA_K(2, 2 * SLOTB);
    WAIT_BAR(3);
    qkt(pA0, pA1, Kbase, qr, negm, r32, hi); asm volatile("s_nop 15\n\ts_nop 7" : "+v"(pA0), "+v"(pA1)); CMASK(pA0, pA1, 0);
    START(pA0, pA1);
    _Pragma("unroll") for (int r = 0; r < 16; ++r) pA1[r] = __builtin_amdgcn_exp2f(pA1[r]);
    WAIT_BAR(0);
    DMA_K(3, 0); DMA_V(1, SLOTB);
    ROT();
    kload8(kf, kp0 + sl_cur);
    WAIT_BAR(2);
    s16x4 vlo[8], vhi[8]; u32x4 pw0, pw1, pw2, pw3;
#define PKW(P, B) cvtpk_s(P[B], P[B + 1])
#define PAF(k) __builtin_bit_cast(bf16x8, pw##k)
#define VFR(i) (bf16x8){vlo[i][0], vlo[i][1], vlo[i][2], vlo[i][3], vhi[i][0], vhi[i][1], vhi[i][2], vhi[i][3]}
#define PIN(x) asm volatile("" : "+v"(x))
#define MX3(a, b, c) __builtin_fmaxf(__builtin_fmaxf((a), (b)), (c))
#define GAPA(MF, A0, A1, A2, A3, W0, W1, PW) do { MF; sacc += A0; sacc += A1; sacc += A2; sacc += A3; PIN(sacc); W0; W1; PIN(PW); SBAR(); } while (0)
#define EX(v) __builtin_amdgcn_exp2f(v)
#define GAPB(MF, X, B) do { MF; X[B] = EX(X[B]); X[B + 1] = EX(X[B + 1]); X[B + 2] = EX(X[B + 2]); X[B + 3] = EX(X[B + 3]); PIN(X); SBAR(); } while (0)
#define VRD(i) do { vlo[i] = vtr(vp_ + (((i) >> 2) * 4096 + ((i) & 3) * 1024)); vhi[i] = vtr(vp_ + (((i) >> 2) * 4096 + ((i) & 3) * 1024 + 512)); } while (0)
#define KRD(G, j) do { if (G) { kload2(kf, kp0 + sl_next, j); SBAR(); } } while (0)
#define STEP(C0, C1, P0, P1, t, GK, GV, GL) do { SBAR(); \
    const lds_cptr vp_ = vp0 + sl_prev; \
    VRD(0); SBAR(); float sacc = (P0[0] + P0[1]); \
    GAPA(C0 = __builtin_amdgcn_mfma_f32_32x32x16_bf16(kf[0], qr[0], negm, 0, 0, 0), P0[2], P0[3], P0[4], P0[5],     pw0[0] = PKW(P0, 0), pw0[1] = PKW(P0, 2), pw0); \
    VRD(4); SBAR(); GAPA(C1 = __builtin_amdgcn_mfma_f32_32x32x16_bf16(kf[1], qr[0], negm, 0, 0, 0), P0[6], P0[7], P0[8], P0[9],     pw0[2] = PKW(P0, 4), pw0[3] = PKW(P0, 6), pw0); \
    VRD(1); SBAR(); GAPA(C0 = __builtin_amdgcn_mfma_f32_32x32x16_bf16(kf[2], qr[1], C0, 0, 0, 0),   P0[10], P0[11], P0[12], P0[13], pw1[0] = PKW(P0, 8), pw1[1] = PKW(P0, 10), pw1); \
    VRD(5); SBAR(); GAPA(C1 = __builtin_amdgcn_mfma_f32_32x32x16_bf16(kf[3], qr[1], C1, 0, 0, 0),   P0[14], P0[15], P1[0], P1[1],   pw1[2] = PKW(P0, 12), pw1[3] = PKW(P0, 14), pw1); \
    VRD(2); SBAR(); GAPA(C0 = __builtin_amdgcn_mfma_f32_32x32x16_bf16(kf[4], qr[2], C0, 0, 0, 0),   P1[2], P1[3], P1[4], P1[5],     pw2[0] = PKW(P1, 0), pw2[1] = PKW(P1, 2), pw2); \
    VRD(6); SBAR(); GAPA(C1 = __builtin_amdgcn_mfma_f32_32x32x16_bf16(kf[5], qr[2], C1, 0, 0, 0),   P1[6], P1[7], P1[8], P1[9],     pw2[2] = PKW(P1, 4), pw2[3] = PKW(P1, 6), pw2); \
    VRD(3); SBAR(); GAPA(C0 = __builtin_amdgcn_mfma_f32_32x32x16_bf16(kf[6], qr[3], C0, 0, 0, 0),   P1[10], P1[11], P1[12], P1[13], pw3[0] = PKW(P1, 8), pw3[1] = PKW(P1, 10), pw3); \
    VRD(7); SBAR(); GAPA(C1 = __builtin_amdgcn_mfma_f32_32x32x16_bf16(kf[7], qr[3], C1, 0, 0, 0),   P1[14], P1[15], 0.f, 0.f,       pw3[2] = PKW(P1, 12), pw3[3] = PKW(P1, 14), pw3); \
    l_reg += sacc; \
    if (GK) { DMA_K((t) + 3, sl_cur); } if (GV) { DMA_V((t) + 1, sl_next); } \
    CMASK(C0, C1, t); \
    { float a = MX3(C0[0], C0[1], C1[0]), b = MX3(C0[2], C0[3], C1[1]); a = MX3(a, C1[2], C1[3]); \
      _Pragma("unroll") for (int r = 4; r < 16; r += 4) { a = MX3(a, C0[r], C0[r + 1]); b = MX3(b, C0[r + 2], C0[r + 3]); a = MX3(a, C1[r], C1[r + 1]); b = MX3(b, C1[r + 2], C1[r + 3]); } \
      float rm = __builtin_fmaxf(a, b); { auto rr = __builtin_amdgcn_permlane32_swap(__float_as_uint(rm), __float_as_uint(rm), false, false); rm = __builtin_fmaxf(__uint_as_float(rr[0]), __uint_as_float(rr[1])); } \
      resc = false; \
      if (__builtin_expect(__any(rm > (float)THRL), 0)) { const float dl = __builtin_fmaxf(rm, 0.f); mhat += dl; \
        _Pragma("unroll") for (int r = 0; r < 16; ++r) { C0[r] -= dl; C1[r] -= dl; } \
        _Pragma("unroll") for (int r = 0; r < 16; ++r) negm[r] = -mhat; asm volatile("" : "+v"(negm)); \
        const float f = __builtin_amdgcn_exp2f(-dl); l_reg *= f; if (hi == 0) wsf[r32] = f; resc = true; } } \
    SBAR(); \
    GAPB(o[0] = __builtin_amdgcn_mfma_f32_32x32x16_bf16(PAF(0), VFR(0), o[0], 0, 0, 0), C0, 0); \
    GAPB(o[1] = __builtin_amdgcn_mfma_f32_32x32x16_bf16(PAF(0), VFR(4), o[1], 0, 0, 0), C0, 4); \
    KRD(GL, 0); GAPB(o[0] = __builtin_amdgcn_mfma_f32_32x32x16_bf16(PAF(1), VFR(1), o[0], 0, 0, 0), C0, 8); \
    KRD(GL, 1); GAPB(o[1] = __builtin_amdgcn_mfma_f32_32x32x16_bf16(PAF(1), VFR(5), o[1], 0, 0, 0), C0, 12); \
    KRD(GL, 2); GAPB(o[0] = __builtin_amdgcn_mfma_f32_32x32x16_bf16(PAF(2), VFR(2), o[0], 0, 0, 0), C1, 0); \
    KRD(GL, 3); GAPB(o[1] = __builtin_amdgcn_mfma_f32_32x32x16_bf16(PAF(2), VFR(6), o[1], 0, 0, 0), C1, 4); \
    GAPB(o[0] = __builtin_amdgcn_mfma_f32_32x32x16_bf16(PAF(3), VFR(3), o[0], 0, 0, 0), C1, 8); \
    GAPB(o[1] = __builtin_amdgcn_mfma_f32_32x32x16_bf16(PAF(3), VFR(7), o[1], 0, 0, 0), C1, 12); \
    } while (0)
    int t = 1;
#undef CMASK
#define CMASK(P0, P1, t) do {} while (0)
    for (; t + 5 < NT; t += 2) {
        STEP(pB0, pB1, pA0, pA1, t, true, true, true);     WAIT_BAR(2); RESC(); ROT();
        STEP(pA0, pA1, pB0, pB1, t + 1, true, true, true); WAIT_BAR(2); RESC(); ROT();
    }
#undef CMASK
#define CMASK(P0, P1, t) do { int jb_ = (t) - (NT - 4); if (jb_ >= 0) cmask(P0, P1, jb_, qrel, hi); } while (0)
#define ENDW(tt) do { if ((tt) + 3 < NT) { WAIT_BAR(2); } else if ((tt) + 2 < NT) { WAIT_BAR(1); } else { WAIT_BAR(0); } } while (0)
    for (; t + 1 < NT; t += 2) {
        STEP(pB0, pB1, pA0, pA1, t, (t + 3 < NT), (t + 1 < NT), (t + 1 < NT));       ENDW(t);     RESC(); ROT();
        STEP(pA0, pA1, pB0, pB1, t + 1, (t + 4 < NT), (t + 2 < NT), (t + 2 < NT));   ENDW(t + 1); RESC(); ROT();
    }
    STEP(pB0, pB1, pA0, pA1, NT - 1, false, false, false); RESC();
    { float sacc = pB0[0] + pB0[1]; _Pragma("unroll") for (int r = 2; r < 16; ++r) sacc += pB0[r]; _Pragma("unroll") for (int r = 0; r < 16; ++r) sacc += pB1[r]; l_reg += sacc;
      pw0 = (u32x4){PKW(pB0, 0), PKW(pB0, 2), PKW(pB0, 4), PKW(pB0, 6)}; pw1 = (u32x4){PKW(pB0, 8), PKW(pB0, 10), PKW(pB0, 12), PKW(pB0, 14)}; pw2 = (u32x4){PKW(pB1, 0), PKW(pB1, 2), PKW(pB1, 4), PKW(pB1, 6)}; pw3 = (u32x4){PKW(pB1, 8), PKW(pB1, 10), PKW(pB1, 12), PKW(pB1, 14)};
      SBAR(); pv(o, vb0 + sl_cur, PAF(0), PAF(1), PAF(2), PAF(3)); }
#undef PKW
#undef PAF
#undef VFR
#undef PIN
#undef MX3
#undef GAPA
#undef GAPB
#undef EX
#undef VRD
#undef KRD
#undef STEP
#undef ENDW
    { auto rr = __builtin_amdgcn_permlane32_swap(__float_as_uint(l_reg), __float_as_uint(l_reg), false, false); l_reg = __uint_as_float(rr[0]) + __uint_as_float(rr[1]); }
    int lane2 = lane; asm volatile("" : "+v"(lane2));
    const int r32e = lane2 & 31, hie = lane2 >> 5;
    if (hie == 0) wsf[32 + r32e] = l_reg; asm volatile("s_waitcnt lgkmcnt(0)" ::: "memory");
    float rli[16];
#pragma unroll
    for (int r = 0; r < 16; ++r) rli[r] = __builtin_amdgcn_rcpf(wsf[32 + crow(r, hie)]);
    bf16* Ow = Oh + (long)(q0 + wid * QBLK) * PO;
    { bf16* stg = (bf16*)(shm + LDS_OST) + wid * 2048;
#pragma unroll
      for (int r = 0; r < 16; ++r) { const int orow = crow(r, hie);
#pragma unroll
        for (int d0 = 0; d0 < 2; ++d0) stg[orow * 64 + d0 * 32 + r32e] = __float2bfloat16(o[d0][r] * rli[r]); }
      asm volatile("s_waitcnt lgkmcnt(0)" ::: "memory");
#pragma unroll
      for (int i = 0; i < 4; ++i) { const int row = i * 8 + (lane2 >> 3), ch = lane2 & 7; const u32x4 v = *(const u32x4*)(stg + row * 64 + ch * 8); ATTN_STORE16(Ow + (long)row * PO + ch * 8, v); } }
    asm volatile("s_waitcnt lgkmcnt(0)\n\ts_barrier" ::: "memory");
#undef DMA_K
#undef DMA_V
#undef CMASK
#undef START
#undef RESC
#undef ROT
}
#undef SBAR
#undef WAIT_BAR
}

#define XB_TMO      128
#define XB_XCNT(j)  (256  + 64 * (j))
#define XB_XSUB(j)  (1280 + 64 * (j))
#define XB_XGEN(j)  (2304 + 64 * (j))
#define XB_TOP      3328
#define XB_TOPGEN   3392
#define XCD_BAR_WORDS 3456
#define XB_SPIN_CAP (1u << 18)
__device__ __forceinline__ unsigned xb_ld(unsigned* p)              { return __hip_atomic_load(p, __ATOMIC_RELAXED, __HIP_MEMORY_SCOPE_AGENT); }
__device__ __forceinline__ unsigned xb_add(unsigned* p, unsigned v) { return __hip_atomic_fetch_add(p, v, __ATOMIC_RELAXED, __HIP_MEMORY_SCOPE_AGENT); }
__device__ __forceinline__ unsigned xb_xcc_id() { return (unsigned)__builtin_amdgcn_s_getreg((3 << 11) | 20) & 0xFu; }
#define XB_SPIN(cond, bar) do { unsigned _sp = 0; while (cond) { __builtin_amdgcn_s_sleep(1); \
    if ((++_sp & 255u) == 0u) { if (xb_ld(&(bar)[XB_TMO])) break; if (_sp > XB_SPIN_CAP) { atomicAdd(&(bar)[XB_TMO], 1u); break; } } } } while (0)
struct XcdBarrier { unsigned* bar; unsigned x; volatile LAS unsigned* st; };
__device__ __forceinline__ XcdBarrier xcd_barrier_post(unsigned* bar, volatile LAS unsigned* st) {
    XcdBarrier b; b.bar = bar; b.x = xb_xcc_id(); b.st = st;
    if (threadIdx.x == 0) (void)xb_add(&bar[XB_XCNT(b.x)], 1u);
    return b;
}
__device__ __forceinline__ void xcd_barrier_complete(unsigned* bar, unsigned x, unsigned& nloc, unsigned& nx) {
    const unsigned G = gridDim.x * gridDim.y * gridDim.z;
    unsigned sum, cnt, mine, sp = 0u;
    for (;;) {
        sum = 0u; cnt = 0u; mine = 0u;
#pragma unroll
        for (unsigned j = 0; j < 16; ++j) { const unsigned c = xb_ld(&bar[XB_XCNT(j)]); sum += c; cnt += (c > 0u) ? 1u : 0u; mine = (j == x) ? c : mine; }
        if (sum == G) break;
        __builtin_amdgcn_s_sleep(1);
        if ((++sp & 255u) == 0u) { if (xb_ld(&bar[XB_TMO])) break; if (sp > XB_SPIN_CAP) { atomicAdd(&bar[XB_TMO], 1u); break; } }
    }
    nloc = mine > 0u ? mine : 1u; nx = cnt > 0u ? cnt : 1u;
}
__device__ __forceinline__ void xcd_barrier(const XcdBarrier& b) {
    asm volatile("s_waitcnt vmcnt(0)" ::: "memory");
    __syncthreads();
    if (threadIdx.x == 0) {
        unsigned* bar = b.bar;
        __builtin_amdgcn_s_waitcnt(0);
        unsigned nloc = b.st[0], nx = b.st[1];
        if (nloc == 0u) { xcd_barrier_complete(bar, b.x, nloc, nx); b.st[0] = nloc; b.st[1] = nx; }
        const unsigned old = xb_add(&bar[XB_XSUB(b.x)], 1u);
        const unsigned gen = old / nloc;
        if (old + 1u == (gen + 1u) * nloc) {
            __builtin_amdgcn_fence(__ATOMIC_RELEASE, "agent");
            asm volatile("s_waitcnt vmcnt(0)" ::: "memory");
            const unsigned og = xb_add(&bar[XB_TOP], 1u);
            const unsigned tg = og / nx;
            if (og + 1u == (tg + 1u) * nx) xb_add(&bar[XB_TOPGEN], 1u);
            else XB_SPIN(xb_ld(&bar[XB_TOPGEN]) == tg, bar);
            __builtin_amdgcn_fence(__ATOMIC_ACQUIRE, "agent");
            xb_add(&bar[XB_XGEN(b.x)], 1u);
            asm volatile("s_waitcnt vmcnt(0)" ::: "memory");
        } else {
            XB_SPIN(xb_ld(&bar[XB_XGEN(b.x)]) == gen, bar);
            __builtin_amdgcn_fence(__ATOMIC_ACQUIRE, "agent");
            asm volatile("s_waitcnt vmcnt(0)" ::: "memory");
        }
    }
    __syncthreads();
}

struct Args {
    const float *x, *meta, *ln0_g, *ln0_b, *w_in, *conv_w, *conv_b, *gate_bias, *lq1, *lk1, *lq2, *lk2, *att_g, *ml_g, *w_att_out, *w_ml_out, *w_o,
                *ln1_g, *ln1_b, *w_router, *b_router, *w_gu, *b_gu, *w_down, *b_down, *ln2_g, *ln2_b;
    float* out; unsigned char* ws; int ph_lo, ph_hi;
};

template <class ColMap>
__device__ __forceinline__ void transpose_item(const float* W, int K, int N, bf16_t* WT, LAS float* scr, int kb, int nb, int lane, ColMap cm) {
    const int k0 = 64 * kb, n0 = 32 * nb;
    const int lc = cm(n0 + (lane & 31));
#pragma unroll 8
    for (int i = 0; i < 32; ++i) { const int kk = 2 * i + (lane >> 5); scr[kk * 33 + (lane & 31)] = W[(size_t)(k0 + kk) * N + lc]; }
    LDS_WAIT(); asm volatile("" ::: "memory");
    const int c = lane & 7;
#pragma unroll
    for (int j = 0; j < 4; ++j) { const int n = (lane >> 3) + 8 * j; const LAS float* s = scr + (8 * c) * 33 + n;
        u32x4 o; o.x = pkbf(s[0 * 33], s[1 * 33]); o.y = pkbf(s[2 * 33], s[3 * 33]); o.z = pkbf(s[4 * 33], s[5 * 33]); o.w = pkbf(s[6 * 33], s[7 * 33]);
        *(u32x4*)(WT + (size_t)(n0 + n) * K + k0 + 8 * c) = o; }
    LDS_WAIT(); asm volatile("" ::: "memory");
}
struct CmIdent { __device__ __forceinline__ int operator()(int p) const { return p; } };
struct CmWin {
    __device__ __forceinline__ int operator()(int P) const {
        if (P < 1024) { const int hb = P >> 6, p = P & 63, wcp = p >> 5, fq = (p & 31) >> 3, n = (p & 7) >> 2, j = p & 3; return hb * 64 + 32 * n + 16 * wcp + 4 * fq + j; }
        if (P < 3584) return P;
        return P + 8;
    }
};
struct CmGu {
    __device__ __forceinline__ int operator()(int P) const { const int pn = P >> 8, s = (P >> 7) & 1, i = P & 127; return 2 * (128 * pn + i) + s; }
};

__global__ void __launch_bounds__(NWAVES * 64, 2) hybrid_fwd(Args a) {
    extern __shared__ __attribute__((aligned(16))) unsigned char lds[];
    LAS unsigned char* L = (LAS unsigned char*)lds;
    const int tid = threadIdx.x, lane = tid & 63, wave = __builtin_amdgcn_readfirstlane(tid >> 6);
    const int G = gridDim.x, blk = blockIdx.x;
    const int gw = blk * NWAVES + wave, NGW = G * NWAVES;
    if (tid < 16) ((LAS unsigned*)(L + MISC_OFF))[tid] = 0u;
    LAS unsigned long long* ptab = (LAS unsigned long long*)(L + MISC_OFF + 64);
    if (tid == 0) {
        ptab[0] = (unsigned long long)a.x; ptab[1] = (unsigned long long)a.meta; ptab[2] = (unsigned long long)a.ln0_g; ptab[3] = (unsigned long long)a.ln0_b; ptab[4] = (unsigned long long)a.w_in;
        ptab[5] = (unsigned long long)a.conv_w; ptab[6] = (unsigned long long)a.conv_b; ptab[7] = (unsigned long long)a.gate_bias; ptab[8] = (unsigned long long)a.lq1; ptab[9] = (unsigned long long)a.lk1;
        ptab[10] = (unsigned long long)a.lq2; ptab[11] = (unsigned long long)a.lk2; ptab[12] = (unsigned long long)a.att_g; ptab[13] = (unsigned long long)a.ml_g; ptab[14] = (unsigned long long)a.w_att_out;
        ptab[15] = (unsigned long long)a.w_ml_out; ptab[16] = (unsigned long long)a.w_o; ptab[17] = (unsigned long long)a.ln1_g; ptab[18] = (unsigned long long)a.ln1_b; ptab[19] = (unsigned long long)a.w_router;
        ptab[20] = (unsigned long long)a.b_router; ptab[21] = (unsigned long long)a.w_gu; ptab[22] = (unsigned long long)a.b_gu; ptab[23] = (unsigned long long)a.w_down; ptab[24] = (unsigned long long)a.b_down;
        ptab[25] = (unsigned long long)a.ln2_g; ptab[26] = (unsigned long long)a.ln2_b; ptab[27] = (unsigned long long)a.out; ptab[28] = (unsigned long long)a.ws;
    }
    asm volatile("s_waitcnt lgkmcnt(0)" ::: "memory");
    __syncthreads();
    asm volatile("" ::: "memory");
#define PF(i) ((const float*)ldptr(ptab, (i)))
#define WSP ((unsigned char*)ldptr(ptab, 28))
#define DOUTP ((unsigned char*)ldptr(ptab, 27))
#define ctl ((unsigned*)(WSP + WS_CTL))
#define WinT ((bf16_t*)(WSP + WS_WIN))
#define WaT ((bf16_t*)(WSP + WS_WA))
#define WmT ((bf16_t*)(WSP + WS_WM))
#define WoT ((bf16_t*)(WSP + WS_WO))
#define ropec ((float*)(WSP + WS_ROPE))
#define ropes (ropec + TT * 32)
#define stats ((float*)(WSP + WS_STATS))
#define gates ((float*)(WSP + WS_GATES))
#define tok_e ((int*)(WSP + WS_TOKE))
#define tok_g ((float*)(WSP + WS_TOKG))
#define hist ((int*)(WSP + WS_HIST))
#define row_off ((int*)(WSP + WS_ROWOFF))
#define row_slot ((int*)(WSP + WS_ROWSLOT))
#define row_gate ((float*)(WSP + WS_ROWGATE))
#define tile_exp ((int*)(WSP + WS_TILEEXP))
#define Hb ((bf16_t*)(WSP + WS_H))
#define Z ((bf16_t*)(WSP + WS_Z))
#define Y ((bf16_t*)(WSP + WS_Y))
#define ACT ((bf16_t*)(WSP + WS_ACT))
#define Qc ((bf16_t*)(WSP + WS_QC))
#define Kc ((bf16_t*)(WSP + WS_KC))
#define Vc ((bf16_t*)(WSP + WS_VC))
#define TMPb ((bf16_t*)(WSP + WS_TMP))
#define MRGb ((bf16_t*)(WSP + WS_MRG))
#define Ob ((bf16_t*)(DOUTP + DO_O))
#define HMb ((bf16_t*)(DOUTP + DO_HM))
#define WguT ((bf16_t*)(DOUTP + DO_WGU))
#define WdnT ((bf16_t*)(DOUTP + DO_WDN))
#if !MK_PER_PHASE
    XcdBarrier bar = xcd_barrier_post(ctl + CW_BAR, (volatile LAS unsigned*)(L + MISC_OFF + 32));
#define GRID_BAR() xcd_barrier(bar)
#else
#define GRID_BAR() do {} while (0)
#endif
    const int lo = a.ph_lo, hi = a.ph_hi;
#define IN(k) (lo <= (k) && (k) < hi)
#define BOTH(k) (IN(k) && IN((k) + 1))

    if (IN(0)) REPLOOP(0) {
        {   LAS float* scr = (LAS float*)(L + wave * 16384);
            constexpr int I_IN = 16 * (NZP / 32), I_A = 8 * 32, I_O = 16 * 32;
            constexpr int NIT = I_IN + 2 * I_A + I_O;
            for (int it = gw; it < NIT; it += NGW) {
                int r = it;
                if (r < I_IN) { transpose_item(PF(4), 1024, NIN, WinT, scr, r / (NZP / 32), r % (NZP / 32), lane, CmWin()); continue; } r -= I_IN;
                if (r < I_A) { transpose_item(PF(14), 512, 1024, WaT, scr, r / 32, r % 32, lane, CmIdent()); continue; } r -= I_A;
                if (r < I_A) { transpose_item(PF(15), 512, 1024, WmT, scr, r / 32, r % 32, lane, CmIdent()); continue; } r -= I_A;
                transpose_item(PF(16), 1024, 1024, WoT, scr, r / 32, r % 32, lane, CmIdent());
            }
        }
        for (int i = blk * 512 + tid; i < TT * 32; i += G * 512) {
            const int t = i >> 5, f = i & 31;
            const double inv = exp2(-(double)f * (13.287712379549449 / 32.0));
            const double rev = (double)t * inv * 0.15915494309189535;
            const float fr = (float)(rev - floor(rev));
            ropec[i] = __builtin_amdgcn_cosf(fr); ropes[i] = __builtin_amdgcn_sinf(fr);
        }
        __syncthreads();
        LAS float* wg = (LAS float*)L;
        for (int i = tid; i < 8 * 1024; i += 512) { const int gc = i >> 10, k = i & 1023; wg[i] = PF(4)[(size_t)k * NIN + 3584 + gc]; }
        __syncthreads();
        for (int row = gw; row < MROWS; row += NGW) {
            const int b = row / TT, t = row - b * TT;
            const float* xr = (t < NMETA) ? PF(1) + (size_t)t * DM : PF(0) + ((size_t)b * SEQ + (t - NMETA)) * DM;
            f32x4 v[4]; float s = 0.f;
#pragma unroll
            for (int j = 0; j < 4; ++j) { v[j] = *(const f32x4*)(xr + 4 * lane + 256 * j); s += (v[j][0] + v[j][1]) + (v[j][2] + v[j][3]); }
            const float mean = wave_sum(s) * (1.f / DM); float s2 = 0.f;
#pragma unroll
            for (int j = 0; j < 4; ++j) { const f32x4 d = v[j] - mean; s2 += (d[0] * d[0] + d[1] * d[1]) + (d[2] * d[2] + d[3] * d[3]); }
            const float rstd = 1.0f / sqrtf(wave_sum(s2) * (1.f / DM) + LN_EPS);
            if (lane == 0) { stats[2 * row] = mean; stats[2 * row + 1] = rstd; }
            float gp[8];
#pragma unroll
            for (int q = 0; q < 8; ++q) gp[q] = 0.f;
#pragma unroll
            for (int j = 0; j < 4; ++j) {
                const f32x4 gg = *(const f32x4*)(PF(2) + 4 * lane + 256 * j), bb = *(const f32x4*)(PF(3) + 4 * lane + 256 * j);
                const f32x4 hv = (v[j] - mean) * rstd * gg + bb;
                u32x2 w; w.x = pkbf(hv[0], hv[1]); w.y = pkbf(hv[2], hv[3]);
                *(u32x2*)(Hb + (size_t)row * DM + 4 * lane + 256 * j) = w;
#pragma unroll
                for (int q = 0; q < 8; ++q) { const f32x4 wv = *(const LAS f32x4*)(wg + q * 1024 + 4 * lane + 256 * j); gp[q] += (hv[0] * wv[0] + hv[1] * wv[1]) + (hv[2] * wv[2] + hv[3] * wv[3]); }
            }
#pragma unroll
            for (int q = 0; q < 8; ++q) gp[q] = wave_sum(gp[q]);
            if (lane < 8) {
                float gsel = gp[0];
#pragma unroll
                for (int q = 1; q < 8; ++q) gsel = (lane == q) ? gp[q] : gsel;
                float gv = gsel + PF(7)[lane];
                if (lane >= 4) gv = (gv >= 0.f) ? -log1pf(expf(-gv)) : gv - log1pf(expf(gv));
                gates[(size_t)row * 8 + lane] = gv;
            }
        }
        __syncthreads();
        if (BOTH(0) || rep_ + 1 < REP_0) GRID_BAR();
    }

    if (IN(1)) REPLOOP(1) {
        pg8::Gemm g{Hb, WinT, DM, DM, NZP / 256, nullptr, nullptr, 0};
        pg8::StaticOrder S; S.init(MROWS / 256, NZP / 256, G, blk);
        pg8::EpiZ E{Z, Qc, Kc, Vc, ropec, ropes};
        pg8::gemm_phase<0, pg8::EpiZ>(L, g, S, E);
        if (BOTH(1) || rep_ + 1 < REP_1) GRID_BAR();
    }

    if (IN(2)) {
        REPLOOP(2B) {
            constexpr int PQ = 136;
            LAS bf16_t* Qs = (LAS bf16_t*)L;
            LAS bf16_t* Ks = Qs + 128 * PQ;
            LAS bf16_t* VTs = Ks + 128 * PQ;
            LAS bf16_t* Cs = VTs + 144 * PQ;
            LAS float* fv = (LAS float*)(Cs + 144 * PQ);
            LAS float* v_a = fv;
            LAS float* v_M = fv + 128;
            LAS float* v_b = fv + 256;
            LAS float* v_w = fv + 384;
            LAS float* v_sc = fv + 512;
            LAS float* cw = fv + 528;
            const float* convw = PF(5); const float* convb = PF(6); const float* mlg = PF(13); const float* gatesp = gates;
            bf16_t* Zp = Z;
            for (int u = blk; u < NB * 4; u += G) {
                const int b = u >> 2, h = u & 3;
                __syncthreads();
                for (int i = tid; i < 5 * 256; i += 512) { const int j = i >> 8, c = i & 255; const int ch = (c < 128) ? (h * 128 + c) : (512 + h * 128 + (c - 128));
                    cw[i] = (j < 4) ? convw[j * 1024 + ch] : convb[ch]; }
                for (int i = tid; i < 144 * PQ; i += 512) { const int rr = i / PQ; VTs[i] = (rr == 128) ? (bf16_t)0x3f80 : (bf16_t)0; Cs[i] = 0; }
                if (tid == 0) v_sc[0] = 0.f;
                f32x4 Cst[9];
#pragma unroll
                for (int jt = 0; jt < 9; ++jt) Cst[jt] = (f32x4){0.f, 0.f, 0.f, 0.f};
                bf16_t* Zb = Zp + (size_t)b * TT * NZ;
                const int fr = lane & 15, quad = lane >> 4;
                float gml[8];
#pragma unroll
                for (int jt = 0; jt < 8; ++jt) gml[jt] = mlg[h * 128 + 16 * jt + fr];
                for (int c = 0; c < 33; ++c) {
                    const int t0 = c * 128;
                    __syncthreads();
                    if (wave == 0) {
                        const float m_old0 = v_sc[0];
                        float x0, x1, i0, i1;
                        { const int ta = t0 + 2 * lane, tb = ta + 1;
                          x0 = (ta < TT) ? ld_agent_f(gatesp + (size_t)(b * TT + ta) * 8 + 4 + h) : 0.f; i0 = (ta < TT) ? ld_agent_f(gatesp + (size_t)(b * TT + ta) * 8 + h) : -1e30f;
                          x1 = (tb < TT) ? ld_agent_f(gatesp + (size_t)(b * TT + tb) * 8 + 4 + h) : 0.f; i1 = (tb < TT) ? ld_agent_f(gatesp + (size_t)(b * TT + tb) * 8 + h) : -1e30f; }
                        float sacc = x0 + x1;
#pragma unroll
                        for (int o = 1; o < 64; o <<= 1) { const float tv = __shfl_up(sacc, o); if (lane >= o) sacc += tv; }
                        const float ex = sacc - (x0 + x1);
                        const float b0 = ex + x0, b1 = b0 + x1;
                        const float a0 = i0 - b0, a1 = i1 - b1;
                        float mx = fmaxf(a0, a1);
#pragma unroll
                        for (int o = 1; o < 64; o <<= 1) { const float tv = __shfl_up(mx, o); if (lane >= o) mx = fmaxf(mx, tv); }
                        float exm = __shfl_up(mx, 1); if (lane == 0) exm = -INFINITY;
                        const float M0 = fmaxf(fmaxf(m_old0, exm), a0), M1 = fmaxf(M0, a1);
                        const float Ml = __shfl(M1, 63);
                        v_b[2 * lane] = b0; v_b[2 * lane + 1] = b1; v_a[2 * lane] = a0; v_a[2 * lane + 1] = a1; v_M[2 * lane] = M0; v_M[2 * lane + 1] = M1;
                        v_w[2 * lane] = (t0 + 2 * lane < TT) ? __expf(a0 - Ml) : 0.f; v_w[2 * lane + 1] = (t0 + 2 * lane + 1 < TT) ? __expf(a1 - Ml) : 0.f;
                        if (lane == 63) v_sc[1] = M1;
                    }
#pragma unroll 2
                    for (int i = 0; i < 4; ++i) {
                        const int p = tid + 512 * i, s = p >> 4, dg = p & 15;
                        const int t = t0 + s;
                        float qv[8], kv[8];
#pragma unroll
                        for (int e = 0; e < 8; ++e) { qv[e] = cw[4 * 256 + dg * 8 + e]; kv[e] = cw[4 * 256 + 128 + dg * 8 + e]; }
#pragma unroll
                        for (int j = 0; j < 4; ++j) {
                            const int tj = t - 3 + j;
                            if (tj >= 0 && tj < TT) {
                                const u32x4 zq = *(const u32x4*)(Zb + (size_t)tj * NZ + ZMQ + h * 128 + dg * 8);
                                const u32x4 zk = *(const u32x4*)(Zb + (size_t)tj * NZ + ZMK + h * 128 + dg * 8);
                                const LAS float* wq = cw + j * 256 + dg * 8; const LAS float* wk = wq + 128;
                                qv[0] += wq[0] * bflo(zq.x); qv[1] += wq[1] * bfhi(zq.x); qv[2] += wq[2] * bflo(zq.y); qv[3] += wq[3] * bfhi(zq.y);
                                qv[4] += wq[4] * bflo(zq.z); qv[5] += wq[5] * bfhi(zq.z); qv[6] += wq[6] * bflo(zq.w); qv[7] += wq[7] * bfhi(zq.w);
                                kv[0] += wk[0] * bflo(zk.x); kv[1] += wk[1] * bfhi(zk.x); kv[2] += wk[2] * bflo(zk.y); kv[3] += wk[3] * bfhi(zk.y);
                                kv[4] += wk[4] * bflo(zk.z); kv[5] += wk[5] * bfhi(zk.z); kv[6] += wk[6] * bflo(zk.w); kv[7] += wk[7] * bfhi(zk.w);
                            }
                        }
                        const bool live = (t < TT);
#pragma unroll
                        for (int e = 0; e < 8; ++e) { qv[e] = live ? qv[e] * sigmoidf_(qv[e]) : 0.f; kv[e] = live ? kv[e] * sigmoidf_(kv[e]) * 0.08838834764831845f : 0.f; }
                        u32x4 wq4, wk4; wq4.x = pkbf(qv[0], qv[1]); wq4.y = pkbf(qv[2], qv[3]); wq4.z = pkbf(qv[4], qv[5]); wq4.w = pkbf(qv[6], qv[7]);
                        wk4.x = pkbf(kv[0], kv[1]); wk4.y = pkbf(kv[2], kv[3]); wk4.z = pkbf(kv[4], kv[5]); wk4.w = pkbf(kv[6], kv[7]);
                        *(LAS u32x4*)(Qs + s * PQ + dg * 8) = wq4; *(LAS u32x4*)(Ks + s * PQ + dg * 8) = wk4;
                        u32x4 zv = (u32x4){0u, 0u, 0u, 0u};
                        if (live) zv = *(const u32x4*)(Zb + (size_t)t * NZ + ZMV + h * 128 + dg * 8);
                        VTs[(dg * 8 + 0) * PQ + s] = (bf16_t)(zv.x & 0xffffu); VTs[(dg * 8 + 1) * PQ + s] = (bf16_t)(zv.x >> 16);
                        VTs[(dg * 8 + 2) * PQ + s] = (bf16_t)(zv.y & 0xffffu); VTs[(dg * 8 + 3) * PQ + s] = (bf16_t)(zv.y >> 16);
                        VTs[(dg * 8 + 4) * PQ + s] = (bf16_t)(zv.z & 0xffffu); VTs[(dg * 8 + 5) * PQ + s] = (bf16_t)(zv.z >> 16);
                        VTs[(dg * 8 + 6) * PQ + s] = (bf16_t)(zv.w & 0xffffu); VTs[(dg * 8 + 7) * PQ + s] = (bf16_t)(zv.w >> 16);
                    }
                    __syncthreads();
                    const float Mlast = v_sc[1], m_old = v_sc[0];
                    f32x4 St[8], n1[9];
#pragma unroll
                    for (int j = 0; j < 8; ++j) St[j] = (f32x4){0.f, 0.f, 0.f, 0.f};
#pragma unroll
                    for (int jt = 0; jt < 9; ++jt) n1[jt] = (f32x4){0.f, 0.f, 0.f, 0.f};
                    {
                        bf16x8 af[4];
#pragma unroll
                        for (int kk = 0; kk < 4; ++kk) af[kk] = *(const LAS bf16x8*)(Qs + (16 * wave + fr) * PQ + kk * 32 + quad * 8);
#pragma unroll
                        for (int j = 0; j < 8; ++j) if (j <= wave) {
#pragma unroll
                            for (int kk = 0; kk < 4; ++kk) { const bf16x8 bfv = *(const LAS bf16x8*)(Ks + (16 * j + fr) * PQ + kk * 32 + quad * 8);
                                St[j] = __builtin_amdgcn_mfma_f32_16x16x32_bf16(af[kk], bfv, St[j], 0, 0, 0); }
                        }
#pragma unroll
                        for (int jt = 0; jt < 9; ++jt)
#pragma unroll
                            for (int kk = 0; kk < 4; ++kk) { const bf16x8 bc = *(const LAS bf16x8*)(Cs + (16 * jt + fr) * PQ + kk * 32 + quad * 8);
                                n1[jt] = __builtin_amdgcn_mfma_f32_16x16x32_bf16(af[kk], bc, n1[jt], 0, 0, 0); }
                    }
                    __syncthreads();
                    {
                        float Ms[4];
#pragma unroll
                        for (int jj = 0; jj < 4; ++jj) Ms[jj] = v_M[16 * wave + 4 * quad + jj];
#pragma unroll
                        for (int j = 0; j < 8; ++j) {
                            const int r = 16 * j + fr; const float ar = v_a[r];
#pragma unroll
                            for (int jj = 0; jj < 4; ++jj) { const int s = 16 * wave + 4 * quad + jj;
                                const float w = (j <= wave && r <= s) ? St[j][jj] * __expf(ar - Ms[jj]) : 0.f;
                                Qs[s * PQ + r] = (bf16_t)(pkbf(w, 0.f) & 0xffffu); }
                        }
                    }
                    __syncthreads();
                    float hv[8][4];
                    {
                        f32x4 n2[9];
#pragma unroll
                        for (int jt = 0; jt < 9; ++jt) n2[jt] = (f32x4){0.f, 0.f, 0.f, 0.f};
#pragma unroll
                        for (int kk = 0; kk < 4; ++kk) {
                            const bf16x8 as_ = *(const LAS bf16x8*)(Qs + (16 * wave + fr) * PQ + kk * 32 + quad * 8);
#pragma unroll
                            for (int jt = 0; jt < 9; ++jt) { const bf16x8 bvv = *(const LAS bf16x8*)(VTs + (16 * jt + fr) * PQ + kk * 32 + quad * 8);
                                n2[jt] = __builtin_amdgcn_mfma_f32_16x16x32_bf16(as_, bvv, n2[jt], 0, 0, 0); }
                        }
#pragma unroll
                        for (int jj = 0; jj < 4; ++jj) {
                            const int s = 16 * wave + 4 * quad + jj;
                            const float Ms = v_M[s]; const float winter = __expf(m_old - Ms);
                            float den = winter * n1[8][jj] + n2[8][jj];
                            den = __shfl(den, lane & 48);
                            const float ms = v_b[s] + Ms;
                            const float rd = 1.0f / fmaxf(fabsf(den), __expf(-ms));
                            float ss = 0.f;
#pragma unroll
                            for (int jt = 0; jt < 8; ++jt) { const float x = (winter * n1[jt][jj] + n2[jt][jj]) * rd; hv[jt][jj] = x; ss += x * x; }
                            ss = row_sum16(ss);
                            const float rs = 1.0f / sqrtf(ss * (1.f / 128.f) + LN_EPS);
#pragma unroll
                            for (int jt = 0; jt < 8; ++jt) hv[jt][jj] *= rs * gml[jt];
                        }
                    }
                    __syncthreads();
#pragma unroll
                    for (int jt = 0; jt < 8; ++jt)
#pragma unroll
                        for (int jj = 0; jj < 4; ++jj) Qs[(16 * wave + 4 * quad + jj) * PQ + 16 * jt + fr] = (bf16_t)(pkbf(hv[jt][jj], 0.f) & 0xffffu);
                    {
                        const float w_old = __expf(m_old - Mlast);
#pragma unroll
                        for (int jt = 0; jt < 9; ++jt) Cst[jt] = Cst[jt] * w_old;
#pragma unroll
                        for (int kk = 0; kk < 4; ++kk) {
                            const int rb = 32 * kk + 8 * quad;
                            const LAS bf16_t* kp = Ks + (rb + (fr >> 2)) * PQ + 16 * wave + 4 * (fr & 3);
                            const attn_body::s16x4 lo = attn_body::vtr((attn_body::lds_cptr)kp), hi4 = attn_body::vtr((attn_body::lds_cptr)(kp + 4 * PQ));
                            const f32x4 w0 = *(const LAS f32x4*)(v_w + rb), w1 = *(const LAS f32x4*)(v_w + rb + 4);
                            float kf[8];
#pragma unroll
                            for (int q = 0; q < 4; ++q) { kf[q] = __uint_as_float(((unsigned)(unsigned short)lo[q]) << 16) * w0[q]; kf[4 + q] = __uint_as_float(((unsigned)(unsigned short)hi4[q]) << 16) * w1[q]; }
                            u32x4 kw; kw.x = pkbf(kf[0], kf[1]); kw.y = pkbf(kf[2], kf[3]); kw.z = pkbf(kf[4], kf[5]); kw.w = pkbf(kf[6], kf[7]);
                            const bf16x8 bk = __builtin_bit_cast(bf16x8, kw);
#pragma unroll
                            for (int jt = 0; jt < 9; ++jt) { const bf16x8 av = *(const LAS bf16x8*)(VTs + (16 * jt + fr) * PQ + kk * 32 + quad * 8);
                                Cst[jt] = __builtin_amdgcn_mfma_f32_16x16x32_bf16(av, bk, Cst[jt], 0, 0, 0); }
                        }
#pragma unroll
                        for (int jt = 0; jt < 9; ++jt)
#pragma unroll
                            for (int jj = 0; jj < 4; ++jj) Cs[(16 * jt + 4 * quad + jj) * PQ + 16 * wave + fr] = (bf16_t)(pkbf(Cst[jt][jj], 0.f) & 0xffffu);
                        if (tid == 0) v_sc[0] = v_b[127] + Mlast;
                    }
                    __syncthreads();
#pragma unroll
                    for (int i = 0; i < 4; ++i) {
                        const int p = tid + 512 * i, s = p >> 4, dg = p & 15, t = t0 + s;
                        if (t < TT) {
                            const u32x4 hw = *(const LAS u32x4*)(Qs + s * PQ + dg * 8);
                            bf16_t* zr = Zb + (size_t)t * NZ + h * 128 + dg * 8;
                            const u32x4 mw = *(const u32x4*)(zr + ZMO);
                            u32x4 wy;
                            wy.x = pkbf(sigmoidf_(bflo(mw.x)) * bflo(hw.x), sigmoidf_(bfhi(mw.x)) * bfhi(hw.x)); wy.y = pkbf(sigmoidf_(bflo(mw.y)) * bflo(hw.y), sigmoidf_(bfhi(mw.y)) * bfhi(hw.y));
                            wy.z = pkbf(sigmoidf_(bflo(mw.z)) * bflo(hw.z), sigmoidf_(bfhi(mw.z)) * bfhi(hw.z)); wy.w = pkbf(sigmoidf_(bflo(mw.w)) * bflo(hw.w), sigmoidf_(bfhi(mw.w)) * bfhi(hw.w));
                            *(u32x4*)(zr + ZMV) = wy;
                        }
                    }
                }
            }
        }
        __syncthreads();
        REPLOOP(2A) {
            LAS int* tkt = (LAS int*)(L + MISC_OFF + 16);
            bf16_t* Qcp = Qc; bf16_t* Kcp = Kc; bf16_t* Vcp = Vc; bf16_t* Obp = Ob; unsigned* tctr = ctl + CW_TICKET + 64 * rep_;
            for (;;) {
                __syncthreads();
                if (tid == 0) *tkt = (int)__hip_atomic_fetch_add(tctr, 1u, RLX_AGENT);
                __syncthreads();
                const int Lidx = __builtin_amdgcn_readfirstlane(*tkt);
                if (Lidx >= NB * 16 * 17) break;
                const int bvh = Lidx & 255, qb = 16 - (Lidx >> 8);
                const int b = bvh >> 4, vh = bvh & 15, hm = vh >> 1, vhalf = vh & 1, h = hm >> 1;
                attn_body::attn_unit<8>(qb, (const attn_body::bf16*)(Qcp + (size_t)(b * 8 + hm) * TT * 64), (const attn_body::bf16*)(Kcp + (size_t)(b * 8 + hm) * TT * 64),
                                        (const attn_body::bf16*)(Vcp + (size_t)(b * 4 + h) * TT * 128 + vhalf * 64), (attn_body::bf16*)(Obp + (size_t)b * OROWS * 1024 + vh * 64), (char*)lds);
            }
        }
        __syncthreads();
        if (BOTH(2)) GRID_BAR();
    }

    if (IN(3)) REPLOOP(3) {
        float lam;
        { const float p1 = wave_sum(PF(8)[lane] * PF(9)[lane]), p2 = wave_sum(PF(10)[lane] * PF(11)[lane]); lam = expf(p1) - expf(p2) + LAMBDA_INIT; }
        const int hd = lane >> 4, e0 = (lane & 15) * 8;
        float ga[8];
#pragma unroll
        for (int e = 0; e < 8; ++e) ga[e] = PF(12)[e0 + e] * (1.0f - LAMBDA_INIT);
        const bf16_t* Obp = Ob; bf16_t* Zp = Z;
        for (int row = gw; row < MROWS; row += NGW) {
            const int b = row / TT, t = row - b * TT;
            const bf16_t* orow = Obp + ((size_t)b * OROWS + t) * 1024 + hd * 256 + e0;
            const u32x4 w0 = *(const u32x4*)orow, w1 = *(const u32x4*)(orow + 128);
            float o[8];
            o[0] = bflo(w0.x) - lam * bflo(w1.x); o[1] = bfhi(w0.x) - lam * bfhi(w1.x); o[2] = bflo(w0.y) - lam * bflo(w1.y); o[3] = bfhi(w0.y) - lam * bfhi(w1.y);
            o[4] = bflo(w0.z) - lam * bflo(w1.z); o[5] = bfhi(w0.z) - lam * bfhi(w1.z); o[6] = bflo(w0.w) - lam * bflo(w1.w); o[7] = bfhi(w0.w) - lam * bfhi(w1.w);
            float ss = 0.f;
#pragma unroll
            for (int e = 0; e < 8; ++e) ss += o[e] * o[e];
            ss = row_sum16(ss);
            const float rs = 1.0f / sqrtf(ss * (1.f / 128.f) + LN_EPS);
            u32x4 wo; wo.x = pkbf(o[0] * rs * ga[0], o[1] * rs * ga[1]); wo.y = pkbf(o[2] * rs * ga[2], o[3] * rs * ga[3]); wo.z = pkbf(o[4] * rs * ga[4], o[5] * rs * ga[5]); wo.w = pkbf(o[6] * rs * ga[6], o[7] * rs * ga[7]);
            *(u32x4*)(Zp + (size_t)row * NZ + ZYC + hd * 128 + e0) = wo;
        }
        if (BOTH(3) || rep_ + 1 < REP_3) GRID_BAR();
    }

    if (IN(4)) REPLOOP(4) {
        {   LAS float* scr = (LAS float*)(L + wave * 16384);
            constexpr int I_GU = 16 * 64, I_DN = 16 * 32;
            for (int it = gw; it < NE * (I_GU + I_DN); it += NGW) {
                const int e = it / (I_GU + I_DN); int r = it - e * (I_GU + I_DN);
                if (r < I_GU) transpose_item(PF(21) + (size_t)e * 1024 * 2048, 1024, 2048, WguT + (size_t)e * 2048 * 1024, scr, r / 64, r % 64, lane, CmGu());
                else { r -= I_GU; transpose_item(PF(23) + (size_t)e * 1024 * 1024, 1024, 1024, WdnT + (size_t)e * 1024 * 1024, scr, r / 32, r % 32, lane, CmIdent()); }
            }
        }
        __syncthreads();
        {   pg8::Gemm g{Z + ZYC, WaT, NZ, 512, 4, nullptr, nullptr, 0};
            pg8::StaticOrder S; S.init(MROWS / 256, 4, G, blk);
            pg8::EpiGate<false> E{Z, TMPb, MRGb};
            pg8::gemm_phase<0, pg8::EpiGate<false>>(L, g, S, E); }
        {   pg8::Gemm g{Z + ZMV, WmT, NZ, 512, 4, nullptr, nullptr, 0};
            pg8::StaticOrder S; S.init(MROWS / 256, 4, G, blk);
            pg8::EpiGate<true> E{Z, TMPb, MRGb};
            pg8::gemm_phase<0, pg8::EpiGate<true>>(L, g, S, E); }
        if (BOTH(4) || rep_ + 1 < REP_4) GRID_BAR();
    }

    if (IN(5)) REPLOOP(5) {
        pg8::Gemm g{MRGb, WoT, DM, 1024, 4, nullptr, nullptr, 0};
        pg8::StaticOrder S; S.init(MROWS / 256, 4, G, blk);
        pg8::EpiPre1 E{(float*)(Z + ZGA), PF(0), PF(1), stats, PF(2), PF(3)};
        pg8::gemm_phase<0, pg8::EpiPre1>(L, g, S, E);
        if (BOTH(5) || rep_ + 1 < REP_5) GRID_BAR();
    }

    constexpr int NPART = 256, RPP = MROWS / NPART;
    static_assert(NPART * RPP == MROWS, "partitions");
    if (IN(6)) REPLOOP(6) {
        LAS float* wrT = (LAS float*)L;
        LAS int* hcnt = (LAS int*)(L + 131072);
        { const float* wr = PF(19); for (int i = tid; i < 32 * 1024; i += 512) { const int k = i >> 5, e = i & 31; wrT[e * 1024 + k] = wr[i]; } }
        const float* P1 = (const float*)(Z + ZGA);
        f32x4 gg[4], bb[4];
        { const float* g1 = PF(17); const float* b1 = PF(18);
#pragma unroll
          for (int j = 0; j < 4; ++j) { gg[j] = *(const f32x4*)(g1 + 4 * lane + 256 * j); bb[j] = *(const f32x4*)(b1 + 4 * lane + 256 * j); } }
        const float brt = PF(20)[(lane >> 1) & 31];
        bf16_t* Hbp = Hb; int* tokE = tok_e; float* tokG = tok_g; int* histp = hist;
        for (int part = blk; part < NPART; part += G) {
            __syncthreads();
            if (tid < 32) hcnt[tid] = 0;
            __syncthreads();
            const int rbeg = part * RPP, rend = rbeg + RPP;
            constexpr int RPW = (RPP + NWAVES - 1) / NWAVES;
            const int wbeg = rbeg + wave * RPW, wend = (wbeg + RPW < rend) ? wbeg + RPW : rend;
            for (int row = wbeg; row < wend; row += 2) {
                const bool two = (row + 1 < wend);
                const int row1 = two ? row + 1 : row;
                const float* pr0 = P1 + (size_t)row * (NZ / 2); const float* pr1 = P1 + (size_t)row1 * (NZ / 2);
                f32x4 v0[4], v1[4]; float s0 = 0.f, s1 = 0.f;
#pragma unroll
                for (int j = 0; j < 4; ++j) { v0[j] = *(const f32x4*)(pr0 + 4 * lane + 256 * j); v1[j] = *(const f32x4*)(pr1 + 4 * lane + 256 * j); }
#pragma unroll
                for (int j = 0; j < 4; ++j) { s0 += (v0[j][0] + v0[j][1]) + (v0[j][2] + v0[j][3]); s1 += (v1[j][0] + v1[j][1]) + (v1[j][2] + v1[j][3]); }
                const float mean0 = wave_sum(s0) * (1.f / DM), mean1 = wave_sum(s1) * (1.f / DM); float q0 = 0.f, q1 = 0.f;
#pragma unroll
                for (int j = 0; j < 4; ++j) { const f32x4 d0 = v0[j] - mean0, d1 = v1[j] - mean1;
                    q0 += (d0[0] * d0[0] + d0[1] * d0[1]) + (d0[2] * d0[2] + d0[3] * d0[3]); q1 += (d1[0] * d1[0] + d1[1] * d1[1]) + (d1[2] * d1[2] + d1[3] * d1[3]); }
                const float rstd0 = 1.0f / sqrtf(wave_sum(q0) * (1.f / DM) + LN_EPS), rstd1 = 1.0f / sqrtf(wave_sum(q1) * (1.f / DM) + LN_EPS);
#pragma unroll
                for (int j = 0; j < 4; ++j) {
                    v0[j] = (v0[j] - mean0) * rstd0 * gg[j] + bb[j]; v1[j] = (v1[j] - mean1) * rstd1 * gg[j] + bb[j];
                    u32x2 w; w.x = pkbf(v0[j][0], v0[j][1]); w.y = pkbf(v0[j][2], v0[j][3]);
                    *(u32x2*)(Hbp + (size_t)row * DM + 4 * lane + 256 * j) = w;
                    if (two) { w.x = pkbf(v1[j][0], v1[j][1]); w.y = pkbf(v1[j][2], v1[j][3]); *(u32x2*)(Hbp + (size_t)row1 * DM + 4 * lane + 256 * j) = w; }
                }
                float p0[32], p1[32];
#pragma unroll
                for (int e = 0; e < 32; ++e) {
                    float a0 = 0.f, a1 = 0.f;
#pragma unroll
                    for (int j = 0; j < 4; ++j) { const f32x4 wv = *(const LAS f32x4*)(wrT + e * 1024 + 4 * lane + 256 * j);
                        a0 += (v0[j][0] * wv[0] + v0[j][1] * wv[1]) + (v0[j][2] * wv[2] + v0[j][3] * wv[3]);
                        a1 += (v1[j][0] * wv[0] + v1[j][1] * wv[1]) + (v1[j][2] * wv[2] + v1[j][3] * wv[3]); }
                    p0[e] = a0; p1[e] = a1;
                }
                float lg0 = xreduce32(p0, lane) + brt, lg1 = xreduce32(p1, lane) + brt;
#pragma unroll
                for (int rr = 0; rr < 2; ++rr) {
                    float lg = rr ? lg1 : lg0; const int rw = rr ? row1 : row;
                    float tv[4]; int ti[4];
#pragma unroll
                    for (int k = 0; k < 4; ++k) {
                        const float mx = wave_max(lg);
                        const unsigned long long bal = __ballot(lg == mx);
                        const int idx = (__ffsll((long long)bal) - 1) >> 1;
                        tv[k] = mx; ti[k] = idx;
                        if ((lane >> 1) == idx) lg = -INFINITY;
                    }
                    const float e1 = __expf(tv[1] - tv[0]), e2 = __expf(tv[2] - tv[0]), e3 = __expf(tv[3] - tv[0]);
                    const float inv = 1.0f / (1.0f + e1 + e2 + e3);
                    if (lane < 4 && (rr == 0 || two)) {
                        const int idx = (lane == 0) ? ti[0] : (lane == 1) ? ti[1] : (lane == 2) ? ti[2] : ti[3];
                        const float gv = ((lane == 0) ? 1.0f : (lane == 1) ? e1 : (lane == 2) ? e2 : e3) * inv;
                        tokE[(size_t)rw * 4 + lane] = idx; tokG[(size_t)rw * 4 + lane] = gv;
                        atomicAdd((int*)&hcnt[idx], 1);
                    }
                }
            }
            __syncthreads();
            if (tid < 32) histp[part * 32 + tid] = hcnt[tid];
        }
        if (BOTH(6) || rep_ + 1 < REP_6) GRID_BAR();
    }

    if (IN(7)) REPLOOP(7) {
        LAS int* cnt_s = (LAS int*)L; LAS int* base_s = cnt_s + 32; LAS int* pst_s = cnt_s + 64;
        LAS int* ptot = cnt_s + 128; LAS int* pbase = ptot + 512;
        LAS int* ccnt = pbase + 512;
        LAS int* ent = ccnt + 1024; LAS int* lrank = ent + RPP * 4 + 64;
        int* rowOff = row_off; int* rowSlot = row_slot; float* rowGate = row_gate; const int* histp = hist; const int* tokE = tok_e; const float* tokG = tok_g;
        for (int part = blk; part < NPART; part += G) {
            __syncthreads();
            { const int e = tid & 31, q = tid >> 5; int tot = 0, bs = 0;
#pragma unroll 4
              for (int b2 = q * 16; b2 < q * 16 + 16; ++b2) { const int v = ld_agent_i(histp + b2 * 32 + e); tot += v; bs += (b2 < part) ? v : 0; }
              ptot[q * 32 + e] = tot; pbase[q * 32 + e] = bs; }
            const int rbeg = part * RPP, n4 = RPP * 4;
            for (int i = tid; i < n4; i += 512) ent[i] = ld_agent_i(tokE + (size_t)rbeg * 4 + i);
            __syncthreads();
            if (tid < 32) { int tot = 0, bs = 0;
#pragma unroll
                for (int q = 0; q < 16; ++q) { tot += ptot[q * 32 + tid]; bs += pbase[q * 32 + tid]; }
                cnt_s[tid] = tot; base_s[tid] = bs; }
            constexpr int NCH = (RPP * 4 + 63) / 64;
            for (int c = wave; c < NCH; c += NWAVES) {
                const int i = 64 * c + lane; const int my = (i < n4) ? ent[i] : -1; int lr = 0;
#pragma unroll 4
                for (int e = 0; e < 32; ++e) { const unsigned long long b = __ballot(my == e);
                    if (lane == e) ccnt[c * 32 + e] = __popcll(b);
                    if (my == e) lr = __popcll(b & ((1ull << lane) - 1ull)); }
                if (i < n4) lrank[i] = lr;
            }
            __syncthreads();
            if (tid == 0) { int p = 0; for (int e = 0; e < 32; ++e) { pst_s[e] = p; p += (cnt_s[e] + 255) & ~255; } pst_s[32] = p; }
            __syncthreads();
            if (tid < 32) { int run = pst_s[tid] + base_s[tid];
                for (int c = 0; c < NCH; ++c) { const int tmp = ccnt[c * 32 + tid]; ccnt[c * 32 + tid] = run; run += tmp; } }
            __syncthreads();
            for (int i = tid; i < n4; i += 512) { const int e = ent[i]; const int pos = ccnt[(i >> 6) * 32 + e] + lrank[i];
                rowOff[pos] = (rbeg + (i >> 2)) * (DM * 2); rowSlot[pos] = rbeg * 4 + i; rowGate[pos] = ld_agent_f(tokG + (size_t)rbeg * 4 + i); }
            if (part < 32) { const int e = part; for (int r = pst_s[e] + cnt_s[e] + tid; r < pst_s[e + 1]; r += 512) { rowOff[r] = 0; rowSlot[r] = MROWS * 4; rowGate[r] = 0.f; } }
            if (part == 0) { const int nT = pst_s[32] >> 8; int* te = tile_exp;
                for (int t = tid; t < nT; t += 512) { int e = 0; while (e < 31 && t * 256 >= pst_s[e + 1]) ++e; te[t] = e; }
                if (tid == 0) __hip_atomic_store((int*)(ctl + CW_NT), nT, RLX_AGENT); }
        }
        __syncthreads();
        if (BOTH(7) || rep_ + 1 < REP_7) GRID_BAR();
    }

    {
        int nT = 0, TPC = 0;
        if (lo < 12 && hi > 8) { nT = __builtin_amdgcn_readfirstlane(ld_agent_i((const int*)(ctl + CW_NT))); TPC = (nT + 1) >> 1; }
        if (IN(8)) REPLOOP(8) {
            pg8::Gemm g{Hb, WguT, DM, DM, 8, row_off, tile_exp, 0};
            pg8::StaticOrder S; S.init(TPC, 8, G, blk);
            pg8::EpiAct E{ACT, PF(22), tile_exp, 0};
            pg8::gemm_phase<1, pg8::EpiAct>(L, g, S, E);
            if (BOTH(8) || rep_ + 1 < REP_8) GRID_BAR();
        }
        if (IN(9)) REPLOOP(9) {
            pg8::Gemm g{ACT, WdnT, FF, FF, 4, nullptr, tile_exp, 0};
            pg8::StaticOrder S; S.init(TPC, 4, G, blk);
            pg8::EpiDown E{Y, PF(24), tile_exp, row_slot, row_gate, 0};
            pg8::gemm_phase<2, pg8::EpiDown>(L, g, S, E);
            if (BOTH(9) || rep_ + 1 < REP_9) GRID_BAR();
        }
        if (IN(10)) REPLOOP(10) {
            pg8::Gemm g{Hb, WguT, DM, DM, 8, row_off, tile_exp, TPC};
            pg8::StaticOrder S; S.init(nT - TPC, 8, G, blk);
            pg8::EpiAct E{ACT, PF(22), tile_exp, TPC};
            pg8::gemm_phase<1, pg8::EpiAct>(L, g, S, E);
            if (BOTH(10) || rep_ + 1 < REP_10) GRID_BAR();
        }
        if (IN(11)) REPLOOP(11) {
            pg8::Gemm g{ACT, WdnT, FF, FF, 4, nullptr, tile_exp, TPC};
            pg8::StaticOrder S; S.init(nT - TPC, 4, G, blk);
            pg8::EpiDown E{Y, PF(24), tile_exp, row_slot, row_gate, TPC};
            pg8::gemm_phase<2, pg8::EpiDown>(L, g, S, E);
            if (BOTH(11) || rep_ + 1 < REP_11) GRID_BAR();
        }
    }

    if (IN(12)) REPLOOP(12) {
        for (int row = gw; row < MROWS; row += NGW) {
            const int b = row / TT, t = row - b * TT;
            if (t < NMETA) continue;
            f32x4 v[4]; float s = 0.f;
#pragma unroll
            for (int j = 0; j < 4; ++j) {
                const u32x2 hw = *(const u32x2*)(Hb + (size_t)row * DM + 4 * lane + 256 * j);
                f32x4 acc = (f32x4){bflo(hw.x), bfhi(hw.x), bflo(hw.y), bfhi(hw.y)} * DN_ALPHA;
#pragma unroll
                for (int k = 0; k < 4; ++k) { const u32x2 yw = *(const u32x2*)(Y + ((size_t)row * 4 + k) * DM + 4 * lane + 256 * j);
                    acc += (f32x4){bflo(yw.x), bfhi(yw.x), bflo(yw.y), bfhi(yw.y)}; }
                v[j] = acc; s += (acc[0] + acc[1]) + (acc[2] + acc[3]);
            }
            const float mean = wave_sum(s) * (1.f / DM); float s2 = 0.f;
#pragma unroll
            for (int j = 0; j < 4; ++j) { const f32x4 d = v[j] - mean; s2 += (d[0] * d[0] + d[1] * d[1]) + (d[2] * d[2] + d[3] * d[3]); }
            const float rstd = 1.0f / sqrtf(wave_sum(s2) * (1.f / DM) + LN_EPS);
            float* orow = (float*)DOUTP + ((size_t)b * SEQ + (t - NMETA)) * DM;
#pragma unroll
            for (int j = 0; j < 4; ++j) {
                const f32x4 gg = *(const f32x4*)(PF(25) + 4 * lane + 256 * j), bb = *(const f32x4*)(PF(26) + 4 * lane + 256 * j);
                *(f32x4*)(orow + 4 * lane + 256 * j) = (v[j] - mean) * rstd * gg + bb;
            }
        }
    }
#undef IN
#undef BOTH
#undef GRID_BAR
}

constexpr int N_PHASES = 13;
extern "C" void kernel_launch(void* const* d_in, const int* in_sizes, int n_in, void* d_out, int out_size, void* d_ws, size_t ws_size, hipStream_t stream) {
    static int grid = 0;
    if (grid == 0) {
        if (n_in != 27 || ws_size < WS_END) { fprintf(stderr, "kernel_launch: unexpected n_in %d / ws_size %zu\n", n_in, ws_size); grid = -1; return; }
        int dev = 0, cus = 0;
        if (hipGetDevice(&dev) != hipSuccess || hipDeviceGetAttribute(&cus, hipDeviceAttributeMultiprocessorCount, dev) != hipSuccess) { grid = -1; return; }
        if (hipFuncSetAttribute((const void*)hybrid_fwd, hipFuncAttributeMaxDynamicSharedMemorySize, LDS_BYTES) != hipSuccess) { fprintf(stderr, "kernel_launch: hipFuncSetAttribute failed\n"); grid = -1; return; }
        int per_cu = 0;
        (void)hipOccupancyMaxActiveBlocksPerMultiprocessor(&per_cu, (const void*)hybrid_fwd, NWAVES * 64, LDS_BYTES);
        (void)hipGetLastError();
        grid = cus > 0 ? cus : 256;
    }
    if (grid < 0) return;
    (void)hipMemsetAsync((char*)d_ws + WS_CTL, 0, CTL_ZERO_BYTES, stream);
    Args a{};
    const float** fp = (const float**)&a;
    for (int i = 0; i < 27; ++i) fp[i] = (const float*)d_in[i];
    a.out = (float*)d_out; a.ws = (unsigned char*)d_ws;
#if MK_PER_PHASE
    for (int p = 0; p < N_PHASES; ++p) { a.ph_lo = p; a.ph_hi = p + 1; hipLaunchKernelGGL(hybrid_fwd, dim3(grid), dim3(NWAVES * 64), LDS_BYTES, stream, a); }
#else
    a.ph_lo = 0; a.ph_hi = N_PHASES;
    hipLaunchKernelGGL(hybrid_fwd, dim3(grid), dim3(NWAVES * 64), LDS_BYTES, stream, a);
#endif
}
```

```cpp
#include <hip/hip_runtime.h>
#include <hip/hip_bf16.h>
#include <cstdio>
#include <cstdint>
#include <cmath>

#ifndef MK_PER_PHASE
#define MK_PER_PHASE 0
#endif

#ifndef REP_ALL
#define REP_ALL 1
#endif
#ifndef REP_0
#define REP_0 REP_ALL
#endif
#ifndef REP_1
#define REP_1 REP_ALL
#endif
#ifndef REP_2A
#define REP_2A REP_ALL
#endif
#ifndef REP_2B
#define REP_2B REP_ALL
#endif
#ifndef REP_3
#define REP_3 REP_ALL
#endif
#ifndef REP_4
#define REP_4 REP_ALL
#endif
#ifndef REP_5
#define REP_5 REP_ALL
#endif
#ifndef REP_6
#define REP_6 REP_ALL
#endif
#ifndef REP_7
#define REP_7 REP_ALL
#endif
#ifndef REP_8
#define REP_8 REP_ALL
#endif
#ifndef REP_9
#define REP_9 REP_ALL
#endif
#ifndef REP_10
#define REP_10 REP_ALL
#endif
#ifndef REP_11
#define REP_11 REP_ALL
#endif
#ifndef REP_12
#define REP_12 REP_ALL
#endif
#define REPLOOP(k) _Pragma("unroll 1") for (int rep_ = 0; rep_ < REP_##k; ++rep_)
#define LAS __attribute__((address_space(3)))
#define GAS __attribute__((address_space(1)))
typedef unsigned short bf16_t;
typedef short bf16x8 __attribute__((ext_vector_type(8)));
typedef float f32x4 __attribute__((ext_vector_type(4)));
typedef float f32x2 __attribute__((ext_vector_type(2)));
typedef unsigned u32x4 __attribute__((ext_vector_type(4)));
typedef unsigned u32x2 __attribute__((ext_vector_type(2)));
typedef __bf16 bf16x2_t __attribute__((ext_vector_type(2)));
#define RLX_AGENT __ATOMIC_RELAXED, __HIP_MEMORY_SCOPE_AGENT

constexpr int NB = 16, SEQ = 4096, NMETA = 16, TT = SEQ + NMETA  , MROWS = NB * TT  , DM = 1024;
constexpr int NREAL = NB * SEQ;
constexpr int NZP = 5632;
constexpr int NZ = 4096;
constexpr int ZMQ = 0, ZMK = 512, ZMV = 1024, ZMO = 1536, ZGA = 2048, ZGM = 3072;
constexpr int ZYC = 0;
constexpr int NIN = 5640;
constexpr int NE = 32, FF = 1024;
constexpr int OROWS = 4352;
constexpr float LN_EPS = 1e-5f;
constexpr float DN_ALPHA = 1.189207115002721f;
constexpr float LAMBDA_INIT = 0.2f;
constexpr float ATT_C2 = 0.125f * 1.4426950408889634f;

constexpr size_t MiB = 1u << 20;
constexpr size_t WS_CTL = 0, CTL_ZERO_BYTES = 1 * MiB;
constexpr size_t WS_WIN = 2 * MiB;
constexpr size_t WS_WA = 13 * MiB;
constexpr size_t WS_WM = 14 * MiB;
constexpr size_t WS_WO = 15 * MiB;
constexpr size_t WS_ROPE = 17 * MiB;
constexpr size_t WS_STATS = 19 * MiB;
constexpr size_t WS_GATES = 20 * MiB;
constexpr size_t WS_TOKE = 23 * MiB;
constexpr size_t WS_TOKG = 24 * MiB + 512 * 1024;
constexpr size_t WS_HIST = 26 * MiB;
constexpr size_t WS_ROWOFF = 27 * MiB;
constexpr size_t WS_ROWSLOT = 28 * MiB + 512 * 1024;
constexpr size_t WS_ROWGATE = 30 * MiB;
constexpr size_t WS_TILEEXP = 31 * MiB + 512 * 1024;
constexpr size_t WS_H = 32 * MiB;
constexpr size_t WS_Z = 162 * MiB;
constexpr size_t WS_Y = WS_Z;
constexpr size_t WS_ACT = WS_Z + 516 * MiB;
constexpr size_t WS_QC = 680 * MiB;
constexpr size_t WS_KC = 745 * MiB;
constexpr size_t WS_VC = 810 * MiB;
constexpr size_t WS_TMP = 680 * MiB;
constexpr size_t WS_MRG = 810 * MiB;
constexpr size_t WS_END = 1024 * MiB;
constexpr size_t WS_O = 875 * MiB;
constexpr size_t DO_WGU = 0;
constexpr size_t DO_WDN = 128 * MiB;
constexpr int CW_TMO = 0, CW_NT = 64, CW_TICKET = 128  , CW_BAR = 4096;

constexpr int LDS_BYTES = 163840;
constexpr int MISC_OFF = 163840 - 512;
constexpr int NWAVES = 8;

__device__ __forceinline__ unsigned pkbf(float lo, float hi) { f32x2 v = {lo, hi}; bf16x2_t b = __builtin_convertvector(v, bf16x2_t); return __builtin_bit_cast(unsigned, b); }
__device__ __forceinline__ float bflo(unsigned w) { return __uint_as_float(w << 16); }
__device__ __forceinline__ float bfhi(unsigned w) { return __uint_as_float(w & 0xffff0000u); }
__device__ __forceinline__ float sigmoidf_(float x) { return __builtin_amdgcn_rcpf(1.0f + __expf(-x)); }
template <int CTRL> __device__ __forceinline__ float dppf(float v) { return __builtin_bit_cast(float, __builtin_amdgcn_update_dpp(0, __builtin_bit_cast(int, v), CTRL, 0xF, 0xF, true)); }
__device__ __forceinline__ float rdlane(float v, int l) { return __builtin_bit_cast(float, __builtin_amdgcn_readlane(__builtin_bit_cast(int, v), l)); }
__device__ __forceinline__ float row_sum16(float v) { v += dppf<0xB1>(v); v += dppf<0x4E>(v); v += dppf<0x141>(v); v += dppf<0x140>(v); return v; }
__device__ __forceinline__ float wave_sum(float v) { v = row_sum16(v); return (rdlane(v, 0) + rdlane(v, 16)) + (rdlane(v, 32) + rdlane(v, 48)); }
__device__ __forceinline__ float wave_max(float v) {
    v = fmaxf(v, dppf<0xB1>(v)); v = fmaxf(v, dppf<0x4E>(v)); v = fmaxf(v, dppf<0x141>(v)); v = fmaxf(v, dppf<0x140>(v));
    return fmaxf(fmaxf(rdlane(v, 0), rdlane(v, 16)), fmaxf(rdlane(v, 32), rdlane(v, 48)));
}
__device__ __forceinline__ float xreduce32(float (&p)[32], int lane) {
    float a[16], b[8], c[4], d[2];
#pragma unroll
    for (int i = 0; i < 16; ++i) { auto r = __builtin_amdgcn_permlane32_swap(__float_as_uint(p[i]), __float_as_uint(p[16 + i]), false, false); a[i] = __uint_as_float(r[0]) + __uint_as_float(r[1]); }
#pragma unroll
    for (int i = 0; i < 8; ++i) { auto r = __builtin_amdgcn_permlane16_swap(__float_as_uint(a[i]), __float_as_uint(a[8 + i]), false, false); b[i] = __uint_as_float(r[0]) + __uint_as_float(r[1]); }
    const bool b3 = (lane & 8) != 0, b2 = (lane & 4) != 0, b1 = (lane & 2) != 0;
#pragma unroll
    for (int i = 0; i < 4; ++i) { const float keep = b3 ? b[4 + i] : b[i], send = b3 ? b[i] : b[4 + i]; c[i] = keep + dppf<0x128>(send); }
#pragma unroll
    for (int i = 0; i < 2; ++i) { const float keep = b2 ? c[2 + i] : c[i], send = b2 ? c[i] : c[2 + i]; d[i] = keep + dppf<0x141>(send); }
    const float keep = b1 ? d[1] : d[0], send = b1 ? d[0] : d[1];
    float r = keep + dppf<0x4E>(send);
    r += dppf<0xB1>(r);
    return r;
}
__device__ __forceinline__ int ld_agent_i(const int* p) { return __hip_atomic_load(p, RLX_AGENT); }
__device__ __forceinline__ float ld_agent_f(const float* p) { return __hip_atomic_load(p, RLX_AGENT); }
#define LDS_WAIT() asm volatile("s_waitcnt lgkmcnt(0)" ::: "memory")
__device__ __forceinline__ int row_of(int b, int t) { return (t < NMETA) ? NREAL + b * NMETA + t : b * SEQ + (t - NMETA); }
__device__ __forceinline__ void bt_of(int row, int& b, int& t) { if (row < NREAL) { b = row >> 12; t = (row & (SEQ - 1)) + NMETA; } else { const int m = row - NREAL; b = m >> 4; t = m & (NMETA - 1); } }
__device__ __forceinline__ const void* ldptr(LAS const unsigned long long* t, int i) { const unsigned long long v = t[i];
    const unsigned lo = (unsigned)__builtin_amdgcn_readfirstlane((int)(unsigned)v), hi = (unsigned)__builtin_amdgcn_readfirstlane((int)(unsigned)(v >> 32));
    return (const void*)(const GAS void*)(((unsigned long long)hi << 32) | lo); }

namespace pg8 {
constexpr int BM = 256, BK = 64, HALF = 128, HTB = HALF * BK * 2, STAGE_BYTES = 8 * HTB, NXCD = 8, WGM = 8;
__host__ __device__ __forceinline__ int lds_byte(int r, int c) { const int st = (r >> 4) * 2 + (c >> 5), rr = r & 15, cc = c & 31, ob = rr * 64 + cc * 2; return st * 1024 + (ob ^ (((ob >> 9) & 1) << 5)); }
__host__ __device__ __forceinline__ void stage_rc(int b, int& R, int& C) { const int st = b / 1024, sb = b % 1024, swz = sb ^ (((sb >> 9) & 1) << 5); R = (st >> 1) * 16 + swz / 64; C = (st & 1) * 32 + (swz % 64) / 2; }
__host__ __device__ __forceinline__ int perm32(int rho) { const int n = rho >> 4, i = rho & 15; return 8 * (i >> 2) + 4 * n + (i & 3); }

struct Unit { int pm, pn; };
struct Gemm { const bf16_t* A; const bf16_t* Bt; int lda, K, nN; const int* row_off; const int* tile_exp; int pm0; };
struct StaticOrder {
    int nM, nN, nwg, G, c;
    __device__ __forceinline__ void init(int nM_, int nN_, int G_, int c_) { nM = nM_; nN = nN_; nwg = nM * nN; G = G_; c = c_; }
    __device__ __forceinline__ bool next(int i, Unit& u) const {
        const long L = (long)i * G + c; if (L >= nwg) return false;
        int wgid = (int)L; { const int q = nwg / NXCD, r = nwg % NXCD, xcd = wgid % NXCD, off = wgid / NXCD; wgid = (xcd < r ? xcd * (q + 1) : r * (q + 1) + (xcd - r) * q) + off; }
        const int nig = WGM * nN, gid = wgid / nig, fm = gid * WGM, gsz = (nM - fm) < WGM ? (nM - fm) : WGM;
        u.pm = fm + ((wgid % nig) % gsz); u.pn = (wgid % nig) / gsz; return true;
    }
};

template <int MODE, class Epi>
__device__ __forceinline__ void gemm_phase(LAS unsigned char* lds, const Gemm g, const StaticOrder& S, const Epi& E) {
    const int tid = threadIdx.x, wid = __builtin_amdgcn_readfirstlane(tid >> 6), lane = tid & 63, wr = wid >> 2, wc = wid & 3, fr = lane & 15, fq = lane >> 4;
    const int K = g.K, nt = K / BK;
    unsigned voffA[2], voffB[2]; int Rst[2], Cst[2];
#pragma unroll
    for (int i = 0; i < 2; ++i) { int R, C; stage_rc(tid * 16 + i * 8192, R, C); const int Rb = Epi::PERM ? ((R & ~31) + perm32(R & 31)) : R;
        voffA[i] = (unsigned)(R * g.lda + C) * 2u; voffB[i] = (unsigned)(Rb * K + C) * 2u; Rst[i] = R; Cst[i] = C * 2; }
    const size_t kstep = (size_t)(BK * 2);
    const size_t hstepA = (size_t)HALF * g.lda * 2, hstepB = (size_t)HALF * K * 2;
    const size_t tstepA = 2 * hstepA, tstepB = 2 * hstepB;
    const unsigned ldsw = (unsigned)wid * 1024u;
    const int aoff = lds_byte(wr * 64 + fr, fq * 8), boff = lds_byte(wc * 32 + fr, fq * 8);
    unsigned vC[2][2] = {{0u, 0u}, {0u, 0u}}, vN[2][2] = {{0u, 0u}, {0u, 0u}};
#define PG8_SA(b, h) (((b) * 2 + (h)) * HTB)
#define PG8_SB(b, h) ((4 + (b) * 2 + (h)) * HTB)
#define PG8_STAGE_B(bufoff, gbase) do { _Pragma("unroll") for (int _i = 0; _i < 2; ++_i) \
        __builtin_amdgcn_global_load_lds((const unsigned*)((const char*)(gbase) + voffB[_i]), (LAS unsigned*)(lds + (bufoff) + ldsw + _i * 8192), 16, 0, 0); } while (0)
#define PG8_STAGE_A(bufoff, gbase, h, nx) do { _Pragma("unroll") for (int _i = 0; _i < 2; ++_i) { \
        const char* _p = (MODE == 1) ? ((const char*)(gbase) + ((nx) ? vN[h][_i] : vC[h][_i])) : ((const char*)(gbase) + (h) * hstepA + voffA[_i]); \
        __builtin_amdgcn_global_load_lds((const unsigned*)_p, (LAS unsigned*)(lds + (bufoff) + ldsw + _i * 8192), 16, 0, 0); } } while (0)
#define PG8_LDA(dst, b, h) do { _Pragma("unroll") for (int m = 0; m < 4; ++m) _Pragma("unroll") for (int k = 0; k < 2; ++k) dst[m][k] = *(const LAS bf16x8*)(lds + PG8_SA(b, h) + aoff + m * 2048 + k * 1024); } while (0)
#define PG8_LDB(dst, b, h) do { _Pragma("unroll") for (int n = 0; n < 2; ++n) _Pragma("unroll") for (int k = 0; k < 2; ++k) dst[n][k] = *(const LAS bf16x8*)(lds + PG8_SB(b, h) + boff + n * 2048 + k * 1024); } while (0)
#define PG8_MMA(ai, bj, At, Bt) do { __builtin_amdgcn_s_setprio(1); _Pragma("unroll") for (int m = 0; m < 4; ++m) _Pragma("unroll") for (int n = 0; n < 2; ++n) _Pragma("unroll") for (int k = 0; k < 2; ++k) \
        acc[ai][bj][m][n] = __builtin_amdgcn_mfma_f32_16x16x32_bf16(Bt[n][k], At[m][k], acc[ai][bj][m][n], 0, 0, 0); __builtin_amdgcn_s_setprio(0); } while (0)
#define PG8_WAIT_V(n) asm volatile("s_waitcnt vmcnt(" #n ")" ::: "memory")
#define PG8_WAIT_L(n) asm volatile("s_waitcnt lgkmcnt(" #n ")" ::: "memory")
#define PG8_BAR __builtin_amdgcn_s_barrier()
#define PG8_SCHED __builtin_amdgcn_sched_barrier(0)
#define PG8_ABASE(u) ((MODE == 1) ? (const char*)g.A : (const char*)g.A + (size_t)(u).pm * tstepA)
#define PG8_BBASE(u) ((MODE == 0) ? (const char*)g.Bt + (size_t)(u).pn * tstepB : (const char*)g.Bt + ((size_t)__builtin_amdgcn_readfirstlane(ld_agent_i(g.tile_exp + g.pm0 + (u).pm)) * g.nN + (u).pn) * tstepB)
#define PG8_GATHER(dst, u) do { if (MODE == 1) { _Pragma("unroll") for (int _h = 0; _h < 2; ++_h) _Pragma("unroll") for (int _i = 0; _i < 2; ++_i) \
        dst[_h][_i] = (unsigned)ld_agent_i(g.row_off + (size_t)(g.pm0 + (u).pm) * BM + _h * HALF + Rst[_i]) + (unsigned)Cst[_i]; } } while (0)
    Unit cur, nxt; int ui = 0;
    if (!S.next(0, cur)) return;
    f32x4 acc[2][2][4][2];
#pragma unroll
    for (int a = 0; a < 2; ++a)
#pragma unroll
        for (int b = 0; b < 2; ++b)
#pragma unroll
            for (int m = 0; m < 4; ++m)
#pragma unroll
                for (int n = 0; n < 2; ++n) acc[a][b][m][n] = (f32x4){0.f, 0.f, 0.f, 0.f};
    bf16x8 At[4][2], B0[2][2], B1[2][2];
    const char* cA = PG8_ABASE(cur); const char* cB = PG8_BBASE(cur);
    PG8_GATHER(vC, cur);
    PG8_STAGE_B(PG8_SB(0, 0), cB); PG8_STAGE_B(PG8_SB(0, 1), cB + hstepB); PG8_STAGE_A(PG8_SA(0, 0), cA, 0, false); PG8_STAGE_A(PG8_SA(0, 1), cA, 1, false);
    if (wr == 1) PG8_BAR;
    PG8_WAIT_V(2); PG8_BAR;
    PG8_STAGE_B(PG8_SB(1, 0), cB + kstep); PG8_STAGE_A(PG8_SA(1, 0), cA + kstep, 0, false); PG8_STAGE_B(PG8_SB(1, 1), cB + hstepB + kstep);
    PG8_WAIT_V(6); PG8_BAR;
    for (;;) {
        const bool has_next = S.next(ui + 1, nxt);
        const char* nA = has_next ? PG8_ABASE(nxt) : cA; const char* nB = has_next ? PG8_BBASE(nxt) : cB;
        if (MODE == 1) { if (has_next) { PG8_GATHER(vN, nxt); } else {
#pragma unroll
            for (int _h = 0; _h < 2; ++_h)
#pragma unroll
                for (int _i = 0; _i < 2; ++_i) vN[_h][_i] = vC[_h][_i]; } }
        for (int t = 0; t < nt; t += 2) {
            const bool last = (t == nt - 2);
            const char* a1 = cA + (size_t)(t + 1) * kstep;
            const char* a2 = last ? nA : cA + (size_t)(t + 2) * kstep; const char* b2 = last ? nB : cB + (size_t)(t + 2) * kstep;
            const char* a3 = a2 + kstep; const char* b3 = b2 + kstep;
            PG8_LDB(B0, 0, 0); PG8_LDB(B1, 0, 1); PG8_SCHED; PG8_LDA(At, 0, 0); PG8_STAGE_A(PG8_SA(1, 1), a1, 1, false);
            PG8_WAIT_V(8); PG8_WAIT_L(0); PG8_BAR; PG8_MMA(0, 0, At, B0); PG8_MMA(0, 1, At, B1); PG8_BAR; PG8_SCHED;
            PG8_LDA(At, 0, 1); PG8_STAGE_B(PG8_SB(0, 0), b2); PG8_STAGE_B(PG8_SB(0, 1), b2 + hstepB); PG8_STAGE_A(PG8_SA(0, 0), a2, 0, last);
            PG8_WAIT_V(8); PG8_WAIT_L(0); PG8_BAR; PG8_MMA(1, 0, At, B0); PG8_MMA(1, 1, At, B1); PG8_BAR; PG8_SCHED;
            PG8_LDB(B0, 1, 0); PG8_LDB(B1, 1, 1); PG8_SCHED; PG8_LDA(At, 1, 0); PG8_STAGE_A(PG8_SA(0, 1), a2, 1, last);
            PG8_WAIT_V(8); PG8_WAIT_L(0); PG8_BAR; PG8_MMA(0, 0, At, B0); PG8_MMA(0, 1, At, B1); PG8_BAR; PG8_SCHED;
            PG8_LDA(At, 1, 1); PG8_STAGE_B(PG8_SB(1, 0), b3); PG8_STAGE_B(PG8_SB(1, 1), b3 + hstepB); PG8_STAGE_A(PG8_SA(1, 0), a3, 0, last);
            PG8_WAIT_V(8); PG8_WAIT_L(0); PG8_BAR; PG8_MMA(1, 0, At, B0); PG8_MMA(1, 1, At, B1); PG8_BAR; PG8_SCHED;
        }
        if (wr == 0) PG8_BAR;
        E(acc, cur, wr, wc, fr, fq);
        if (!has_next) break;
#pragma unroll
        for (int a = 0; a < 2; ++a)
#pragma unroll
            for (int b = 0; b < 2; ++b)
#pragma unroll
                for (int m = 0; m < 4; ++m)
#pragma unroll
                    for (int n = 0; n < 2; ++n) acc[a][b][m][n] = (f32x4){0.f, 0.f, 0.f, 0.f};
        cur = nxt; cA = nA; cB = nB; ++ui;
        if (MODE == 1) {
#pragma unroll
            for (int _h = 0; _h < 2; ++_h)
#pragma unroll
                for (int _i = 0; _i < 2; ++_i) vC[_h][_i] = vN[_h][_i]; }
        if (wr == 1) PG8_BAR;
    }
    PG8_WAIT_V(0);
    PG8_BAR;
#undef PG8_SA
#undef PG8_SB
#undef PG8_STAGE_A
#undef PG8_STAGE_B
#undef PG8_LDA
#undef PG8_LDB
#undef PG8_MMA
#undef PG8_WAIT_V
#undef PG8_WAIT_L
#undef PG8_BAR
#undef PG8_SCHED
#undef PG8_ABASE
#undef PG8_BBASE
#undef PG8_GATHER
}

struct EpiZ {
    static constexpr bool PERM = true;
    bf16_t* Z; bf16_t* Qc; bf16_t* Kc; bf16_t* Vc; const float* ropec; const float* ropes;
    __device__ __forceinline__ void operator()(const f32x4 (&acc)[2][2][4][2], const Unit& u, int wr, int wc, int fr, int fq) const {
        const int row0 = u.pm * BM + wr * 64 + fr;
        if (u.pn < 4) {
            const float sc = (u.pn < 2) ? ATT_C2 : 1.0f;
            bf16_t* base = (u.pn < 2) ? Qc : Kc;
            const int dl = 16 * (wc & 1) + 4 * fq;
#pragma unroll
            for (int ai = 0; ai < 2; ++ai)
#pragma unroll
                for (int m = 0; m < 4; ++m) {
                    const int row = row0 + ai * HALF + m * 16; int b, t; bt_of(row, b, t);
                    const f32x4 c = *(const f32x4*)(ropec + t * 32 + dl) * sc, s = *(const f32x4*)(ropes + t * 32 + dl) * sc;
#pragma unroll
                    for (int bj = 0; bj < 2; ++bj) {
                        const int hm = 4 * (u.pn & 1) + 2 * bj + (wc >> 1);
                        const f32x4 x1 = acc[ai][bj][m][0], x2 = acc[ai][bj][m][1];
                        const f32x4 o1 = x1 * c - x2 * s, o2 = x2 * c + x1 * s;
                        bf16_t* p = base + ((size_t)(b * 8 + hm) * TT + t) * 64 + dl;
                        u32x2 w1, w2; w1.x = pkbf(o1[0], o1[1]); w1.y = pkbf(o1[2], o1[3]); w2.x = pkbf(o2[0], o2[1]); w2.y = pkbf(o2[2], o2[3]);
                        *(u32x2*)p = w1; *(u32x2*)(p + 32) = w2;
                    }
                }
        } else if (u.pn < 6) {
            const int e0 = wc * 32 + 8 * fq;
#pragma unroll
            for (int ai = 0; ai < 2; ++ai)
#pragma unroll
                for (int m = 0; m < 4; ++m) {
                    const int row = row0 + ai * HALF + m * 16; int b, t; bt_of(row, b, t);
#pragma unroll
                    for (int bj = 0; bj < 2; ++bj) { const int h = (u.pn - 4) * 2 + bj; const f32x4 v0 = acc[ai][bj][m][0], v1 = acc[ai][bj][m][1];
                        u32x4 w; w.x = pkbf(v0[0], v0[1]); w.y = pkbf(v0[2], v0[3]); w.z = pkbf(v1[0], v1[1]); w.w = pkbf(v1[2], v1[3]);
                        *(u32x4*)(Vc + ((size_t)(b * 4 + h) * TT + t) * 128 + e0) = w; }
                }
        } else {
            const int col0 = (u.pn - 6) * BM + wc * 32 + 8 * fq;
#pragma unroll
            for (int ai = 0; ai < 2; ++ai)
#pragma unroll
                for (int m = 0; m < 4; ++m) {
                    bf16_t* rowp = Z + (size_t)(row0 + ai * HALF + m * 16) * NZ + col0;
#pragma unroll
                    for (int bj = 0; bj < 2; ++bj) { const f32x4 v0 = acc[ai][bj][m][0], v1 = acc[ai][bj][m][1];
                        u32x4 w; w.x = pkbf(v0[0], v0[1]); w.y = pkbf(v0[2], v0[3]); w.z = pkbf(v1[0], v1[1]); w.w = pkbf(v1[2], v1[3]);
                        *(u32x4*)(rowp + bj * HALF) = w; }
                }
        }
    }
};
template <bool SECOND> struct EpiGate {
    static constexpr bool PERM = true;
    bf16_t* Z; bf16_t* TMP; bf16_t* MRG;
    __device__ __forceinline__ void operator()(const f32x4 (&acc)[2][2][4][2], const Unit& u, int wr, int wc, int fr, int fq) const {
        const int row0 = u.pm * BM + wr * 64 + fr, col0 = u.pn * BM + wc * 32 + 8 * fq;
#pragma unroll
        for (int ai = 0; ai < 2; ++ai)
#pragma unroll
            for (int m = 0; m < 4; ++m) {
                bf16_t* rowp = Z + (size_t)(row0 + ai * HALF + m * 16) * NZ + col0; bf16_t* tmpp = TMP + (size_t)(row0 + ai * HALF + m * 16) * DM + col0; bf16_t* mrgp = MRG + (size_t)(row0 + ai * HALF + m * 16) * DM + col0;
#pragma unroll
                for (int bj = 0; bj < 2; ++bj) {
                    const u32x4 gw = *(const u32x4*)(rowp + (SECOND ? ZGM : ZGA) + bj * HALF);
                    const f32x4 v0 = acc[ai][bj][m][0], v1 = acc[ai][bj][m][1];
                    float o[8];
                    o[0] = sigmoidf_(bflo(gw.x)) * v0[0]; o[1] = sigmoidf_(bfhi(gw.x)) * v0[1]; o[2] = sigmoidf_(bflo(gw.y)) * v0[2]; o[3] = sigmoidf_(bfhi(gw.y)) * v0[3];
                    o[4] = sigmoidf_(bflo(gw.z)) * v1[0]; o[5] = sigmoidf_(bfhi(gw.z)) * v1[1]; o[6] = sigmoidf_(bflo(gw.w)) * v1[2]; o[7] = sigmoidf_(bfhi(gw.w)) * v1[3];
                    if (SECOND) { const u32x4 tw = *(const u32x4*)(tmpp + bj * HALF);
                        o[0] += bflo(tw.x); o[1] += bfhi(tw.x); o[2] += bflo(tw.y); o[3] += bfhi(tw.y); o[4] += bflo(tw.z); o[5] += bfhi(tw.z); o[6] += bflo(tw.w); o[7] += bfhi(tw.w); }
                    u32x4 w; w.x = pkbf(o[0], o[1]); w.y = pkbf(o[2], o[3]); w.z = pkbf(o[4], o[5]); w.w = pkbf(o[6], o[7]);
                    if (SECOND) *(u32x4*)(mrgp + bj * HALF) = w; else *(u32x4*)(tmpp + bj * HALF) = w;
                }
            }
    }
};
struct EpiPre1 {
    static constexpr bool PERM = false;
    float* P1; const float* x; const float* meta; const float* stats; const float* g0; const float* b0;
    __device__ __forceinline__ void operator()(const f32x4 (&acc)[2][2][4][2], const Unit& u, int wr, int wc, int fr, int fq) const {
        const int row0 = u.pm * BM + wr * 64 + fr, col0 = u.pn * BM + wc * 32 + 4 * fq;
        f32x4 gv[2][2], bv[2][2];
#pragma unroll
        for (int bj = 0; bj < 2; ++bj)
#pragma unroll
            for (int n = 0; n < 2; ++n) { gv[bj][n] = *(const f32x4*)(g0 + col0 + bj * HALF + n * 16); bv[bj][n] = *(const f32x4*)(b0 + col0 + bj * HALF + n * 16); }
#pragma unroll
        for (int ai = 0; ai < 2; ++ai)
#pragma unroll
            for (int m = 0; m < 4; ++m) {
                const int row = row0 + ai * HALF + m * 16;
                const float* xr = x + (size_t)row * DM;
                const float mean = ld_agent_f(stats + 2 * row), rstd = ld_agent_f(stats + 2 * row + 1);
                float* orow = P1 + (size_t)row * (NZ / 2) + col0;
#pragma unroll
                for (int bj = 0; bj < 2; ++bj)
#pragma unroll
                    for (int n = 0; n < 2; ++n) { const f32x4 xv = *(const f32x4*)(xr + col0 + bj * HALF + n * 16);
                        const f32x4 hv = (xv - mean) * rstd * gv[bj][n] + bv[bj][n];
                        *(f32x4*)(orow + bj * HALF + n * 16) = hv * DN_ALPHA + acc[ai][bj][m][n]; }
            }
    }
};
struct EpiAct {
    static constexpr bool PERM = true;
    bf16_t* ACT; const float* b_gu; const int* tile_exp; int pm0;
    __device__ __forceinline__ void operator()(const f32x4 (&acc)[2][2][4][2], const Unit& u, int wr, int wc, int fr, int fq) const {
        const int e = __builtin_amdgcn_readfirstlane(ld_agent_i(tile_exp + pm0 + u.pm));
        const int ac0 = u.pn * HALF + wc * 32 + 8 * fq;
        const float* bp = b_gu + (size_t)e * 2 * FF + 2 * ac0;
        float bg[8], bl[8];
#pragma unroll
        for (int q = 0; q < 4; ++q) { const f32x4 v = *(const f32x4*)(bp + 4 * q); bg[2 * q] = v[0]; bl[2 * q] = v[1]; bg[2 * q + 1] = v[2]; bl[2 * q + 1] = v[3]; }
        const int row0 = u.pm * BM + wr * 64 + fr;
#pragma unroll
        for (int ai = 0; ai < 2; ++ai)
#pragma unroll
            for (int m = 0; m < 4; ++m) {
                float o[8];
#pragma unroll
                for (int j = 0; j < 8; ++j) {
                    float gl = acc[ai][0][m][j >> 2][j & 3] + bg[j], li = acc[ai][1][m][j >> 2][j & 3] + bl[j];
                    gl = fminf(gl, 7.0f); li = fminf(fmaxf(li, -7.0f), 7.0f);
                    o[j] = gl * sigmoidf_(1.702f * gl) * (li + 1.0f);
                }
                u32x4 w; w.x = pkbf(o[0], o[1]); w.y = pkbf(o[2], o[3]); w.z = pkbf(o[4], o[5]); w.w = pkbf(o[6], o[7]);
                *(u32x4*)(ACT + (size_t)(row0 + ai * HALF + m * 16) * FF + ac0) = w;
            }
    }
};
struct EpiDown {
    static constexpr bool PERM = true;
    bf16_t* Y; const float* b_down; const int* tile_exp; const int* row_slot; const float* row_gate; int pm0;
    __device__ __forceinline__ void operator()(const f32x4 (&acc)[2][2][4][2], const Unit& u, int wr, int wc, int fr, int fq) const {
        const int e = __builtin_amdgcn_readfirstlane(ld_agent_i(tile_exp + pm0 + u.pm));
        const int col0 = u.pn * BM + wc * 32 + 8 * fq;
        f32x4 bv[2][2];
#pragma unroll
        for (int bj = 0; bj < 2; ++bj)
#pragma unroll
            for (int n = 0; n < 2; ++n) bv[bj][n] = *(const f32x4*)(b_down + (size_t)e * DM + col0 + bj * HALF + 4 * n);
        const int r0 = (pm0 + u.pm) * BM + wr * 64 + fr;
#pragma unroll
        for (int ai = 0; ai < 2; ++ai)
#pragma unroll
            for (int m = 0; m < 4; ++m) {
                const int r = r0 + ai * HALF + m * 16;
                const int slot = ld_agent_i(row_slot + r); const float gt = ld_agent_f(row_gate + r);
                bf16_t* rowp = Y + (size_t)slot * DM + col0;
#pragma unroll
                for (int bj = 0; bj < 2; ++bj) { const f32x4 v0 = (acc[ai][bj][m][0] + bv[bj][0]) * gt, v1 = (acc[ai][bj][m][1] + bv[bj][1]) * gt;
                    u32x4 w; w.x = pkbf(v0[0], v0[1]); w.y = pkbf(v0[2], v0[3]); w.z = pkbf(v1[0], v1[1]); w.w = pkbf(v1[2], v1[3]);
                    *(u32x4*)(rowp + bj * HALF) = w; }
            }
    }
};
}

namespace attn_body {
using bf16 = __hip_bfloat16;
using s16x4 = __attribute__((ext_vector_type(4))) short;
using f32x16 = __attribute__((ext_vector_type(16))) float;
constexpr int D = 64, PZ = 64, PV = 128, PO = 1024;
constexpr int NW = 8, QBLK = 32, QB = QBLK * NW, KVBLK = 64;
__device__ __forceinline__ int crow(int r, int hi) { return (r & 3) + 8 * (r >> 2) + 4 * hi; }
#define SBAR() __builtin_amdgcn_sched_barrier(0)
__device__ __forceinline__ void cmask(f32x16& p0, f32x16& p1, int jb, int qrel, int hi) {
    const float NEG = -INFINITY; const int d = qrel - 64 * jb - 4 * hi;
#pragma unroll
    for (int r = 0; r < 16; ++r) { const int c = (r & 3) + 8 * (r >> 2); if (c > d) p0[r] = NEG; if (c + 32 > d) p1[r] = NEG; }
}
constexpr int NSLOT = 3, SLOTB = 8192;
constexpr int LDS_K = 0, LDS_V = NSLOT * SLOTB, LDS_WS = 2 * NSLOT * SLOTB, LDS_OST = LDS_WS + NW * 64 * 4, LDS_BYTES_A = LDS_OST + NW * 4096;
__device__ __forceinline__ void glds16(const void* gsrc, unsigned lds_dst) { unsigned keep;
    asm volatile("s_mov_b32 %0, m0\n\ts_mov_b32 m0, %2\n\ts_nop 0\n\tglobal_load_lds_dwordx4 %1, off\n\ts_mov_b32 m0, %0" : "=&s"(keep) : "v"(gsrc), "s"(lds_dst) : "memory"); }
__device__ __forceinline__ float max3f(float a, float b, float c) { float r; asm("v_max3_f32 %0, %1, %2, %3" : "=v"(r) : "v"(a), "v"(b), "v"(c)); return r; }
__device__ __forceinline__ float max2f(float a, float b) { float r; asm("v_max_f32_e32 %0, %1, %2" : "=v"(r) : "v"(a), "v"(b)); return r; }
__device__ __forceinline__ float fadd_s(float a, float b) { float r; asm("v_add_f32_e32 %0, %1, %2" : "=v"(r) : "v"(a), "v"(b)); return r; }
__device__ __forceinline__ float fsub_s(float a, float b) { float r; asm("v_sub_f32_e32 %0, %1, %2" : "=v"(r) : "v"(a), "v"(b)); return r; }
__device__ __forceinline__ unsigned cvtpk_s(float lo, float hi) { return pkbf(lo, hi); }
#define WAIT_BAR(N) asm volatile("s_waitcnt vmcnt(" #N ") lgkmcnt(0)\n\ts_barrier" ::: "memory")
__device__ __forceinline__ void qkt(f32x16& p0, f32x16& p1, const char* Kslot, const bf16x8* qr, const f32x16& negm, int r32, int hi) {
    const char* kb = Kslot + hi * 1024 + r32 * 16;
#pragma unroll
    for (int d0 = 0; d0 < 4; ++d0) {
        const bf16x8 b0 = *reinterpret_cast<const bf16x8*>(kb + d0 * 2048);
        const bf16x8 b1 = *reinterpret_cast<const bf16x8*>(kb + d0 * 2048 + 512);
        if (d0 == 0) { p0 = __builtin_amdgcn_mfma_f32_32x32x16_bf16(b0, qr[0], negm, 0, 0, 0); p1 = __builtin_amdgcn_mfma_f32_32x32x16_bf16(b1, qr[0], negm, 0, 0, 0); }
        else { p0 = __builtin_amdgcn_mfma_f32_32x32x16_bf16(b0, qr[d0], p0, 0, 0, 0); p1 = __builtin_amdgcn_mfma_f32_32x32x16_bf16(b1, qr[d0], p1, 0, 0, 0); } }
}
typedef __attribute__((address_space(3))) const char* lds_cptr;
typedef short v4i16_t __attribute__((ext_vector_type(4)));
__device__ __forceinline__ void kload8(bf16x8* kf, lds_cptr kp) {
    kf[0] = *(const __attribute__((address_space(3))) bf16x8*)(kp);        kf[1] = *(const __attribute__((address_space(3))) bf16x8*)(kp + 512);
    kf[2] = *(const __attribute__((address_space(3))) bf16x8*)(kp + 2048); kf[3] = *(const __attribute__((address_space(3))) bf16x8*)(kp + 2560);
    kf[4] = *(const __attribute__((address_space(3))) bf16x8*)(kp + 4096); kf[5] = *(const __attribute__((address_space(3))) bf16x8*)(kp + 4608);
    kf[6] = *(const __attribute__((address_space(3))) bf16x8*)(kp + 6144); kf[7] = *(const __attribute__((address_space(3))) bf16x8*)(kp + 6656);
}
__device__ __forceinline__ void kload2(bf16x8* kf, lds_cptr kp, int j) { kf[2 * j] = *(const __attribute__((address_space(3))) bf16x8*)(kp + j * 2048); kf[2 * j + 1] = *(const __attribute__((address_space(3))) bf16x8*)(kp + j * 2048 + 512); }
__device__ __forceinline__ s16x4 vtr(lds_cptr p) { return __builtin_bit_cast(s16x4, __builtin_amdgcn_ds_read_tr16_b64_v4i16((__attribute__((address_space(3))) v4i16_t*)p)); }
__device__ __forceinline__ float rowmax(const f32x16& p0, const f32x16& p1) {
    float a = max3f(p0[0], p0[1], p1[0]), b = max3f(p0[2], p0[3], p1[1]); a = max3f(a, p1[2], p1[3]);
#pragma unroll
    for (int r = 4; r < 16; r += 4) { a = max3f(a, p0[r], p0[r + 1]); b = max3f(b, p0[r + 2], p0[r + 3]); a = max3f(a, p1[r], p1[r + 1]); b = max3f(b, p1[r + 2], p1[r + 3]); }
    const float m = max2f(a, b);
    auto rr = __builtin_amdgcn_permlane32_swap(__float_as_uint(m), __float_as_uint(m), false, false);
    return max2f(__uint_as_float(rr[0]), __uint_as_float(rr[1]));
}
__device__ __forceinline__ void pv(f32x16* o, int vb, bf16x8 pa0, bf16x8 pa1, bf16x8 pa2, bf16x8 pa3) {
#pragma unroll
    for (int d0 = 0; d0 < 2; ++d0) { s16x4 lo[4], hi[4];
#pragma unroll
        for (int ks = 0; ks < 4; ++ks) {
            asm volatile("ds_read_b64_tr_b16 %0,%1 offset:%c2" : "=&v"(lo[ks]) : "v"(vb), "i"(d0 * 4096 + ks * 1024) : "memory");
            asm volatile("ds_read_b64_tr_b16 %0,%1 offset:%c2" : "=&v"(hi[ks]) : "v"(vb), "i"(d0 * 4096 + ks * 1024 + 512) : "memory"); }
        asm volatile("s_waitcnt lgkmcnt(0)" ::: "memory"); SBAR();
#define PK(k) (bf16x8){lo[k][0], lo[k][1], lo[k][2], lo[k][3], hi[k][0], hi[k][1], hi[k][2], hi[k][3]}
        o[d0] = __builtin_amdgcn_mfma_f32_32x32x16_bf16(pa0, PK(0), o[d0], 0, 0, 0);
        o[d0] = __builtin_amdgcn_mfma_f32_32x32x16_bf16(pa1, PK(1), o[d0], 0, 0, 0);
        o[d0] = __builtin_amdgcn_mfma_f32_32x32x16_bf16(pa2, PK(2), o[d0], 0, 0, 0);
        o[d0] = __builtin_amdgcn_mfma_f32_32x32x16_bf16(pa3, PK(3), o[d0], 0, 0, 0);
#undef PK
    }
}
#define ATTN_STORE16(p, v) (*(u32x4*)(p) = (v))
template <int THRL> __device__ __forceinline__ void attn_unit(int qb, const bf16* Qh, const bf16* __restrict__ Kh, const bf16* __restrict__ Vh, bf16* Oh, char* shm) {
    const int tid = threadIdx.x; int lane = tid & 63; asm volatile("" : "+v"(lane));
    const int r32 = lane & 31, hi = lane >> 5; const int wid = __builtin_amdgcn_readfirstlane(tid >> 6);
    const int q0 = qb * QB;
    const bf16* Qw = Qh + (long)(q0 + wid * QBLK) * PZ;
    const unsigned lds0 = (unsigned)(uintptr_t)shm;
    float* wsf = (float*)(shm + LDS_WS) + wid * 64;
    const bf16* ksrc = Kh + (long)lane * PZ + wid * 8;
    const bf16* vsrc = Vh + (long)(16 * (wid & 3) + (lane >> 2)) * PV + (wid >> 2) * 32 + (lane & 3) * 8;
    const unsigned kdst = lds0 + LDS_K + wid * 1024, vdst = lds0 + LDS_V + wid * 1024;
#define DMA_K(t, slot) glds16(ksrc + (long)(t) * KVBLK * PZ, (unsigned)__builtin_amdgcn_readfirstlane(kdst + (slot)))
#define DMA_V(t, slot) glds16(vsrc + (long)(t) * KVBLK * PV, (unsigned)__builtin_amdgcn_readfirstlane(vdst + (slot)))
    const int vb0 = (int)(lds0 + LDS_V) + ((lane >> 4) & 1) * 32 + (lane & 3) * 8 + (4 * hi + ((lane & 15) >> 2)) * 64;
    const char* Kbase = shm + LDS_K; bf16x8 kf[8];
    const lds_cptr shm3 = (lds_cptr)shm; const lds_cptr kp0 = shm3 + LDS_K + hi * 1024 + r32 * 16; const lds_cptr vp0 = shm3 + LDS_V + ((lane >> 4) & 1) * 32 + (lane & 3) * 8 + (4 * hi + ((lane & 15) >> 2)) * 64;
    const int NT = (q0 + QB) / KVBLK;
    DMA_K(0, 0); DMA_V(0, 0); DMA_K(1, SLOTB);
    bf16x8 qr[4];
#pragma unroll
    for (int d0 = 0; d0 < 4; ++d0) qr[d0] = *reinterpret_cast<const bf16x8*>(&Qw[(long)r32 * PZ + d0 * 16 + hi * 8]);
    float mhat = 0.f, l_reg = 0.f; f32x16 o[2]; o[0] = f32x16{}; o[1] = f32x16{}; f32x16 negm = f32x16{}; asm volatile("" : "+v"(negm));
    const int qrel = wid * QBLK + r32;
#define CMASK(P0, P1, t) do { int jb_ = (t) - (NT - 4); if (jb_ >= 0) cmask(P0, P1, jb_, qrel, hi); } while (0)
    bool resc = false;
#define START(P0, P1) do { const float rm = rowmax(P0, P1); resc = false; \
    { const float dl = rm; mhat = fadd_s(mhat, dl); \
      _Pragma("unroll") for (int r = 0; r < 16; ++r) { P0[r] = fsub_s(P0[r], dl); P1[r] = fsub_s(P1[r], dl); } \
      _Pragma("unroll") for (int r = 0; r < 16; ++r) negm[r] = -mhat; asm volatile("" : "+v"(negm)); } \
    _Pragma("unroll") for (int r = 0; r < 16; ++r) P0[r] = __builtin_amdgcn_exp2f(P0[r]); } while (0)
#define RESC() do { if (resc) { asm volatile("s_waitcnt lgkmcnt(0)" ::: "memory"); \
      _Pragma("unroll") for (int d_ = 0; d_ < 2; ++d_) _Pragma("unroll") for (int r = 0; r < 16; ++r) o[d_][r] *= wsf[crow(r, hi)]; } } while (0)
    f32x16 pA0, pA1, pB0, pB1;
    int sl_prev = 0, sl_cur = 0, sl_next = SLOTB;
#define ROT() do { sl_prev = sl_cur; sl_cur = sl_next; sl_next = (sl_next == (NSLOT - 1) * SLOTB) ? 0 : sl_next + SLOTB; } while (0)
    DMA_K(2, 2 * SLOTB);
    WAIT_BAR(3);
    qkt(pA0, pA1, Kbase, qr, negm, r32, hi); asm volatile("s_nop 15\n\ts_nop 7" : "+v"(pA0), "+v"(pA1)); CMASK(pA0, pA1, 0);
    START(pA0, pA1);
    _Pragma("unroll") for (int r = 0; r < 16; ++r) pA1[r] = __builtin_amdgcn_exp2f(pA1[r]);
    WAIT_BAR(0);
    DMA_K(3, 0); DMA_V(1, SLOTB);
    ROT();
    kload8(kf, kp0 + sl_cur);
    WAIT_BAR(2);
    s16x4 vlo[8], vhi[8]; u32x4 pw0, pw1, pw2, pw3;
#define PKW(P, B) cvtpk_s(P[B], P[B + 1])
#define PAF(k) __builtin_bit_cast(bf16x8, pw##k)
#define VFR(i) (bf16x8){vlo[i][0], vlo[i][1], vlo[i][2], vlo[i][3], vhi[i][0], vhi[i][1], vhi[i][2], vhi[i][3]}
#define PIN(x) asm volatile("" : "+v"(x))
#define MX3(a, b, c) __builtin_fmaxf(__builtin_fmaxf((a), (b)), (c))
#define GAPA(MF, A0, A1, A2, A3, W0, W1, PW) do { MF; sacc += A0; sacc += A1; sacc += A2; sacc += A3; PIN(sacc); W0; W1; PIN(PW); SBAR(); } while (0)
#define EX(v) __builtin_amdgcn_exp2f(v)
#define GAPB(MF, X, B) do { MF; X[B] = EX(X[B]); X[B + 1] = EX(X[B + 1]); X[B + 2] = EX(X[B + 2]); X[B + 3] = EX(X[B + 3]); PIN(X); SBAR(); } while (0)
#define VRD(i) do { vlo[i] = vtr(vp_ + (((i) >> 2) * 4096 + ((i) & 3) * 1024)); vhi[i] = vtr(vp_ + (((i) >> 2) * 4096 + ((i) & 3) * 1024 + 512)); } while (0)
#define KRD(G, j) do { if (G) { kload2(kf, kp0 + sl_next, j); SBAR(); } } while (0)
#define STEP(C0, C1, P0, P1, t, GK, GV, GL) do { SBAR(); \
    const lds_cptr vp_ = vp0 + sl_prev; \
    VRD(0); SBAR(); float sacc = (P0[0] + P0[1]); \
    GAPA(C0 = __builtin_amdgcn_mfma_f32_32x32x16_bf16(kf[0], qr[0], negm, 0, 0, 0), P0[2], P0[3], P0[4], P0[5],     pw0[0] = PKW(P0, 0), pw0[1] = PKW(P0, 2), pw0); \
    VRD(4); SBAR(); GAPA(C1 = __builtin_amdgcn_mfma_f32_32x32x16_bf16(kf[1], qr[0], negm, 0, 0, 0), P0[6], P0[7], P0[8], P0[9],     pw0[2] = PKW(P0, 4), pw0[3] = PKW(P0, 6), pw0); \
    VRD(1); SBAR(); GAPA(C0 = __builtin_amdgcn_mfma_f32_32x32x16_bf16(kf[2], qr[1], C0, 0, 0, 0),   P0[10], P0[11], P0[12], P0[13], pw1[0] = PKW(P0, 8), pw1[1] = PKW(P0, 10), pw1); \
    VRD(5); SBAR(); GAPA(C1 = __builtin_amdgcn_mfma_f32_32x32x16_bf16(kf[3], qr[1], C1, 0, 0, 0),   P0[14], P0[15], P1[0], P1[1],   pw1[2] = PKW(P0, 12), pw1[3] = PKW(P0, 14), pw1); \
    VRD(2); SBAR(); GAPA(C0 = __builtin_amdgcn_mfma_f32_32x32x16_bf16(kf[4], qr[2], C0, 0, 0, 0),   P1[2], P1[3], P1[4], P1[5],     pw2[0] = PKW(P1, 0), pw2[1] = PKW(P1, 2), pw2); \
    VRD(6); SBAR(); GAPA(C1 = __builtin_amdgcn_mfma_f32_32x32x16_bf16(kf[5], qr[2], C1, 0, 0, 0),   P1[6], P1[7], P1[8], P1[9],     pw2[2] = PKW(P1, 4), pw2[3] = PKW(P1, 6), pw2); \
    VRD(3); SBAR(); GAPA(C0 = __builtin_amdgcn_mfma_f32_32x32x16_bf16(kf[6], qr[3], C0, 0, 0, 0),   P1[10], P1[11], P1[12], P1[13], pw3[0] = PKW(P1, 8), pw3[1] = PKW(P1, 10), pw3); \
    VRD(7); SBAR(); GAPA(C1 = __builtin_amdgcn_mfma_f32_32x32x16_bf16(kf[7], qr[3], C1, 0, 0, 0),   P1[14], P1[15], 0.f, 0.f,       pw3[2] = PKW(P1, 12), pw3[3] = PKW(P1, 14), pw3); \
    l_reg += sacc; \
    if (GK) { DMA_K((t) + 3, sl_cur); } if (GV) { DMA_V((t) + 1, sl_next); } \
    CMASK(C0, C1, t); \
    { float a = MX3(C0[0], C0[1], C1[0]), b = MX3(C0[2], C0[3], C1[1]); a = MX3(a, C1[2], C1[3]); \
      _Pragma("unroll") for (int r = 4; r < 16; r += 4) { a = MX3(a, C0[r], C0[r + 1]); b = MX3(b, C0[r + 2], C0[r + 3]); a = MX3(a, C1[r], C1[r + 1]); b = MX3(b, C1[r + 2], C1[r + 3]); } \
      float rm = __builtin_fmaxf(a, b); { auto rr = __builtin_amdgcn_permlane32_swap(__float_as_uint(rm), __float_as_uint(rm), false, false); rm = __builtin_fmaxf(__uint_as_float(rr[0]), __uint_as_float(rr[1])); } \
      resc = false; \
      if (__builtin_expect(__any(rm > (float)THRL), 0)) { const float dl = __builtin_fmaxf(rm, 0.f); mhat += dl; \
        _Pragma("unroll") for (int r = 0; r < 16; ++r) { C0[r] -= dl; C1[r] -= dl; } \
        _Pragma("unroll") for (int r = 0; r < 16; ++r) negm[r] = -mhat; asm volatile("" : "+v"(negm)); \
        const float f = __builtin_amdgcn_exp2f(-dl); l_reg *= f; if (hi == 0) wsf[r32] = f; resc = true; } } \
    SBAR(); \
    GAPB(o[0] = __builtin_amdgcn_mfma_f32_32x32x16_bf16(PAF(0), VFR(0), o[0], 0, 0, 0), C0, 0); \
    GAPB(o[1] = __builtin_amdgcn_mfma_f32_32x32x16_bf16(PAF(0), VFR(4), o[1], 0, 0, 0), C0, 4); \
    KRD(GL, 0); GAPB(o[0] = __builtin_amdgcn_mfma_f32_32x32x16_bf16(PAF(1), VFR(1), o[0], 0, 0, 0), C0, 8); \
    KRD(GL, 1); GAPB(o[1] = __builtin_amdgcn_mfma_f32_32x32x16_bf16(PAF(1), VFR(5), o[1], 0, 0, 0), C0, 12); \
    KRD(GL, 2); GAPB(o[0] = __builtin_amdgcn_mfma_f32_32x32x16_bf16(PAF(2), VFR(2), o[0], 0, 0, 0), C1, 0); \
    KRD(GL, 3); GAPB(o[1] = __builtin_amdgcn_mfma_f32_32x32x16_bf16(PAF(2), VFR(6), o[1], 0, 0, 0), C1, 4); \
    GAPB(o[0] = __builtin_amdgcn_mfma_f32_32x32x16_bf16(PAF(3), VFR(3), o[0], 0, 0, 0), C1, 8); \
    GAPB(o[1] = __builtin_amdgcn_mfma_f32_32x32x16_bf16(PAF(3), VFR(7), o[1], 0, 0, 0), C1, 12); \
    } while (0)
    int t = 1;
#undef CMASK
#define CMASK(P0, P1, t) do {} while (0)
    for (; t + 5 < NT; t += 2) {
        STEP(pB0, pB1, pA0, pA1, t, true, true, true);     WAIT_BAR(2); RESC(); ROT();
        STEP(pA0, pA1, pB0, pB1, t + 1, true, true, true); WAIT_BAR(2); RESC(); ROT();
    }
#undef CMASK
#define CMASK(P0, P1, t) do { int jb_ = (t) - (NT - 4); if (jb_ >= 0) cmask(P0, P1, jb_, qrel, hi); } while (0)
#define ENDW(tt) do { if ((tt) + 3 < NT) { WAIT_BAR(2); } else if ((tt) + 2 < NT) { WAIT_BAR(1); } else { WAIT_BAR(0); } } while (0)
    for (; t + 1 < NT; t += 2) {
        STEP(pB0, pB1, pA0, pA1, t, (t + 3 < NT), (t + 1 < NT), (t + 1 < NT));       ENDW(t);     RESC(); ROT();
        STEP(pA0, pA1, pB0, pB1, t + 1, (t + 4 < NT), (t + 2 < NT), (t + 2 < NT));   ENDW(t + 1); RESC(); ROT();
    }
    STEP(pB0, pB1, pA0, pA1, NT - 1, false, false, false); RESC();
    { float sacc = pB0[0] + pB0[1]; _Pragma("unroll") for (int r = 2; r < 16; ++r) sacc += pB0[r]; _Pragma("unroll") for (int r = 0; r < 16; ++r) sacc += pB1[r]; l_reg += sacc;
      pw0 = (u32x4){PKW(pB0, 0), PKW(pB0, 2), PKW(pB0, 4), PKW(pB0, 6)}; pw1 = (u32x4){PKW(pB0, 8), PKW(pB0, 10), PKW(pB0, 12), PKW(pB0, 14)}; pw2 = (u32x4){PKW(pB1, 0), PKW(pB1, 2), PKW(pB1, 4), PKW(pB1, 6)}; pw3 = (u32x4){PKW(pB1, 8), PKW(pB1, 10), PKW(pB1, 12), PKW(pB1, 14)};
      SBAR(); pv(o, vb0 + sl_cur, PAF(0), PAF(1), PAF(2), PAF(3)); }
#undef PKW
#undef PAF
#undef VFR
#undef PIN
#undef MX3
#undef GAPA
#undef GAPB
#undef EX
#undef VRD
#undef KRD
#undef STEP
#undef ENDW
    { auto rr = __builtin_amdgcn_permlane32_swap(__float_as_uint(l_reg), __float_as_uint(l_reg), false, false); l_reg = __uint_as_float(rr[0]) + __uint_as_float(rr[1]); }
    int lane2 = lane; asm volatile("" : "+v"(lane2));
    const int r32e = lane2 & 31, hie = lane2 >> 5;
    if (hie == 0) wsf[32 + r32e] = l_reg; asm volatile("s_waitcnt lgkmcnt(0)" ::: "memory");
    float rli[16];
#pragma unroll
    for (int r = 0; r < 16; ++r) rli[r] = __builtin_amdgcn_rcpf(wsf[32 + crow(r, hie)]);
    bf16* Ow = Oh + (long)(q0 + wid * QBLK) * PO;
    { bf16* stg = (bf16*)(shm + LDS_OST) + wid * 2048;
#pragma unroll
      for (int r = 0; r < 16; ++r) { const int orow = crow(r, hie);
#pragma unroll
        for (int d0 = 0; d0 < 2; ++d0) stg[orow * 64 + d0 * 32 + r32e] = __float2bfloat16(o[d0][r] * rli[r]); }
      asm volatile("s_waitcnt lgkmcnt(0)" ::: "memory");
#pragma unroll
      for (int i = 0; i < 4; ++i) { const int row = i * 8 + (lane2 >> 3), ch = lane2 & 7; const u32x4 v = *(const u32x4*)(stg + row * 64 + ch * 8); ATTN_STORE16(Ow + (long)row * PO + ch * 8, v); } }
    asm volatile("s_waitcnt lgkmcnt(0)\n\ts_barrier" ::: "memory");
#undef DMA_K
#undef DMA_V
#undef CMASK
#undef START
#undef RESC
#undef ROT
}

constexpr int A2_SLOT = 24576, A2_K = 0, A2_V = 8192, A2_WS = 4 * A2_SLOT, A2_OST = 0, A2_BYTES = A2_WS + NW * 256;
template <int THRL> __device__ __forceinline__ void attn2_unit(int qb, const bf16* Qh, const bf16* __restrict__ Kh, const bf16* __restrict__ Vh, bf16* Oh, char* shm) {
    const int tid = threadIdx.x; int lane = tid & 63; asm volatile("" : "+v"(lane));
    const int r32 = lane & 31, hi = lane >> 5; const int wid = __builtin_amdgcn_readfirstlane(tid >> 6);
    const int q0 = qb * QB;
    const bf16* Qw = Qh + (long)(q0 + wid * QBLK) * PZ;
    const unsigned lds0 = (unsigned)(uintptr_t)shm;
    float* wsf = (float*)(shm + A2_WS) + wid * 64;
    bf16x8 qr[4];
#pragma unroll
    for (int d0 = 0; d0 < 4; ++d0) qr[d0] = *reinterpret_cast<const bf16x8*>(&Qw[(long)r32 * PZ + d0 * 16 + hi * 8]);
    const bf16* ksrc = Kh + (long)lane * PZ + wid * 8;
    const bf16* vsrc = Vh + (long)(16 * (wid & 3) + (lane >> 2)) * PV + (wid >> 2) * 32 + (lane & 3) * 8;
    const unsigned kdst = lds0 + A2_K + wid * 1024, vdst = lds0 + A2_V + wid * 1024;
#define A2_DMA(t, sl) do { glds16(ksrc + (long)(t) * KVBLK * PZ, (unsigned)__builtin_amdgcn_readfirstlane(kdst + (sl) * A2_SLOT)); \
        glds16(vsrc + (long)(t) * KVBLK * PV, (unsigned)__builtin_amdgcn_readfirstlane(vdst + (sl) * A2_SLOT)); \
        glds16(vsrc + (long)(t) * KVBLK * PV + 64, (unsigned)__builtin_amdgcn_readfirstlane(vdst + (sl) * A2_SLOT + 8192)); } while (0)
#define A2_WAITB(more) do { if (more) asm volatile("s_waitcnt vmcnt(3)\n\ts_barrier" ::: "memory"); else asm volatile("s_waitcnt vmcnt(0)\n\ts_barrier" ::: "memory"); } while (0)
    const int NT = (q0 + QB) / KVBLK;
    A2_DMA(0, 0); A2_DMA(1, 1);
    asm volatile("" : "+v"(qr[0]), "+v"(qr[1]), "+v"(qr[2]), "+v"(qr[3]));
    const lds_cptr shm3 = (lds_cptr)shm;
    const lds_cptr kp0 = shm3 + A2_K + hi * 1024 + r32 * 16;
    const lds_cptr vp0 = shm3 + A2_V + ((lane >> 4) & 1) * 32 + (lane & 3) * 8 + (4 * hi + ((lane & 15) >> 2)) * 64;
    float mhat = 0.f, l_reg = 0.f; f32x16 o[4]; o[0] = f32x16{}; o[1] = f32x16{}; o[2] = f32x16{}; o[3] = f32x16{}; f32x16 negm = f32x16{};
    const int qrel = wid * QBLK + r32;
    if (wid >= 4) A2_WAITB(true);
    for (int t = 0; t < NT; ++t) {
        A2_WAITB(t + 1 < NT);
        if (t + 2 < NT) A2_DMA(t + 2, (t + 2) & 3);
        const int slot = t & 3;
        const lds_cptr kp = kp0 + slot * A2_SLOT; const lds_cptr vp = vp0 + slot * A2_SLOT;
        f32x16 p0, p1;
        {   bf16x8 kb[8];
#pragma unroll
            for (int d0 = 0; d0 < 4; ++d0) { kb[2 * d0] = *(const __attribute__((address_space(3))) bf16x8*)(kp + d0 * 2048); kb[2 * d0 + 1] = *(const __attribute__((address_space(3))) bf16x8*)(kp + d0 * 2048 + 512); }
            __builtin_amdgcn_sched_barrier(0);
            p0 = __builtin_amdgcn_mfma_f32_32x32x16_bf16(kb[0], qr[0], negm, 0, 0, 0); p1 = __builtin_amdgcn_mfma_f32_32x32x16_bf16(kb[1], qr[0], negm, 0, 0, 0);
#pragma unroll
            for (int d0 = 1; d0 < 4; ++d0) { p0 = __builtin_amdgcn_mfma_f32_32x32x16_bf16(kb[2 * d0], qr[d0], p0, 0, 0, 0); p1 = __builtin_amdgcn_mfma_f32_32x32x16_bf16(kb[2 * d0 + 1], qr[d0], p1, 0, 0, 0); }
        }
        { const int jb = t - (NT - 4); if (jb >= 0) cmask(p0, p1, jb, qrel, hi); }
        float rm;
        { float a = fmaxf(fmaxf(p0[0], p0[1]), p1[0]), b = fmaxf(fmaxf(p0[2], p0[3]), p1[1]); a = fmaxf(fmaxf(a, p1[2]), p1[3]);
#pragma unroll
          for (int r = 4; r < 16; r += 4) { a = fmaxf(fmaxf(a, p0[r]), p0[r + 1]); b = fmaxf(fmaxf(b, p0[r + 2]), p0[r + 3]); a = fmaxf(fmaxf(a, p1[r]), p1[r + 1]); b = fmaxf(fmaxf(b, p1[r + 2]), p1[r + 3]); }
          rm = fmaxf(a, b); auto rr = __builtin_amdgcn_permlane32_swap(__float_as_uint(rm), __float_as_uint(rm), false, false); rm = fmaxf(__uint_as_float(rr[0]), __uint_as_float(rr[1])); }
        if (t == 0 || __any(rm > (float)THRL)) {
            const float dl = (t == 0) ? rm : fmaxf(rm, 0.f); mhat += dl;
#pragma unroll
            for (int r = 0; r < 16; ++r) { p0[r] -= dl; p1[r] -= dl; negm[r] = -mhat; }
            const float f = __builtin_amdgcn_exp2f(-dl); l_reg *= f;
            if (t > 0) {
                if (hi == 0) wsf[r32] = f;
                asm volatile("s_waitcnt lgkmcnt(0)" ::: "memory");
#pragma unroll
                for (int r = 0; r < 16; ++r) { const float fr_ = wsf[crow(r, hi)];
#pragma unroll
                    for (int d_ = 0; d_ < 4; ++d_) o[d_][r] *= fr_; }
                asm volatile("s_waitcnt lgkmcnt(0)" ::: "memory");
            }
        }
        float sacc = 0.f;
#pragma unroll
        for (int r = 0; r < 16; ++r) { p0[r] = __builtin_amdgcn_exp2f(p0[r]); p1[r] = __builtin_amdgcn_exp2f(p1[r]); sacc += p0[r] + p1[r]; }
        l_reg += sacc;
        u32x4 pw[4];
        pw[0] = (u32x4){pkbf(p0[0], p0[1]), pkbf(p0[2], p0[3]), pkbf(p0[4], p0[5]), pkbf(p0[6], p0[7])};
        pw[1] = (u32x4){pkbf(p0[8], p0[9]), pkbf(p0[10], p0[11]), pkbf(p0[12], p0[13]), pkbf(p0[14], p0[15])};
        pw[2] = (u32x4){pkbf(p1[0], p1[1]), pkbf(p1[2], p1[3]), pkbf(p1[4], p1[5]), pkbf(p1[6], p1[7])};
        pw[3] = (u32x4){pkbf(p1[8], p1[9]), pkbf(p1[10], p1[11]), pkbf(p1[12], p1[13]), pkbf(p1[14], p1[15])};
        asm volatile("" : "+v"(pw[0]), "+v"(pw[1]), "+v"(pw[2]), "+v"(pw[3]));
        A2_WAITB(t + 1 < NT);
        {   s16x4 vlo[2][4], vhh[2][4];
#pragma unroll
            for (int d0 = 0; d0 < 4; ++d0) { vlo[0][d0] = vtr(vp + d0 * 4096); vhh[0][d0] = vtr(vp + d0 * 4096 + 512); }
            __builtin_amdgcn_sched_barrier(0);
#pragma unroll
            for (int ks = 0; ks < 4; ++ks) {
                if (ks + 1 < 4) {
#pragma unroll
                    for (int d0 = 0; d0 < 4; ++d0) { vlo[(ks + 1) & 1][d0] = vtr(vp + d0 * 4096 + (ks + 1) * 1024); vhh[(ks + 1) & 1][d0] = vtr(vp + d0 * 4096 + (ks + 1) * 1024 + 512); }
                }
                __builtin_amdgcn_sched_barrier(0);
#pragma unroll
                for (int d0 = 0; d0 < 4; ++d0) {
                    const s16x4 lo = vlo[ks & 1][d0], hh = vhh[ks & 1][d0];
                    const bf16x8 vf = (bf16x8){lo[0], lo[1], lo[2], lo[3], hh[0], hh[1], hh[2], hh[3]};
                    o[d0] = __builtin_amdgcn_mfma_f32_32x32x16_bf16(__builtin_bit_cast(bf16x8, pw[ks]), vf, o[d0], 0, 0, 0);
                }
                __builtin_amdgcn_sched_barrier(0);
            }
        }
    }
    if (wid < 4) A2_WAITB(false);
    asm volatile("s_waitcnt lgkmcnt(0)\n\ts_barrier" ::: "memory");
    { auto rr = __builtin_amdgcn_permlane32_swap(__float_as_uint(l_reg), __float_as_uint(l_reg), false, false); l_reg = __uint_as_float(rr[0]) + __uint_as_float(rr[1]); }
    if (hi == 0) wsf[32 + r32] = l_reg;
    asm volatile("s_waitcnt lgkmcnt(0)" ::: "memory");
    bf16* stg = (bf16*)(shm + A2_OST) + wid * 4096;
#pragma unroll
    for (int r = 0; r < 16; ++r) { const int orow = crow(r, hi); const float rl = __builtin_amdgcn_rcpf(wsf[32 + orow]);
#pragma unroll
        for (int d0 = 0; d0 < 4; ++d0) stg[orow * 128 + d0 * 32 + r32] = __float2bfloat16(o[d0][r] * rl); }
    asm volatile("s_waitcnt lgkmcnt(0)" ::: "memory");
    bf16* Ow = Oh + (long)(q0 + wid * QBLK) * PO;
#pragma unroll
    for (int i = 0; i < 8; ++i) { const int row = i * 4 + (lane >> 4), ch = lane & 15; const u32x4 v = *(const u32x4*)(stg + row * 128 + ch * 8); *(u32x4*)(Ow + (long)row * PO + ch * 8) = v; }
    asm volatile("s_waitcnt lgkmcnt(0)\n\ts_barrier" ::: "memory");
#undef A2_DMA
#undef A2_WAITB
}
#undef SBAR
#undef WAIT_BAR
}

#define XB_TMO      128
#define XB_XCNT(j)  (256  + 64 * (j))
#define XB_XSUB(j)  (1280 + 64 * (j))
#define XB_XGEN(j)  (2304 + 64 * (j))
#define XB_TOP      3328
#define XB_TOPGEN   3392
#define XCD_BAR_WORDS 3456
#define XB_SPIN_CAP (1u << 18)
__device__ __forceinline__ unsigned xb_ld(unsigned* p)              { return __hip_atomic_load(p, __ATOMIC_RELAXED, __HIP_MEMORY_SCOPE_AGENT); }
__device__ __forceinline__ unsigned xb_add(unsigned* p, unsigned v) { return __hip_atomic_fetch_add(p, v, __ATOMIC_RELAXED, __HIP_MEMORY_SCOPE_AGENT); }
__device__ __forceinline__ unsigned xb_xcc_id() { return (unsigned)__builtin_amdgcn_s_getreg((3 << 11) | 20) & 0xFu; }
#define XB_SPIN(cond, bar) do { unsigned _sp = 0; while (cond) { __builtin_amdgcn_s_sleep(1); \
    if ((++_sp & 255u) == 0u) { if (xb_ld(&(bar)[XB_TMO])) break; if (_sp > XB_SPIN_CAP) { atomicAdd(&(bar)[XB_TMO], 1u); break; } } } } while (0)
struct XcdBarrier { unsigned* bar; unsigned x; volatile LAS unsigned* st; };
__device__ __forceinline__ XcdBarrier xcd_barrier_post(unsigned* bar, volatile LAS unsigned* st) {
    XcdBarrier b; b.bar = bar; b.x = xb_xcc_id(); b.st = st;
    if (threadIdx.x == 0) (void)xb_add(&bar[XB_XCNT(b.x)], 1u);
    return b;
}
__device__ __forceinline__ void xcd_barrier_complete(unsigned* bar, unsigned x, unsigned& nloc, unsigned& nx) {
    const unsigned G = gridDim.x * gridDim.y * gridDim.z;
    unsigned sum, cnt, mine, sp = 0u;
    for (;;) {
        sum = 0u; cnt = 0u; mine = 0u;
#pragma unroll
        for (unsigned j = 0; j < 16; ++j) { const unsigned c = xb_ld(&bar[XB_XCNT(j)]); sum += c; cnt += (c > 0u) ? 1u : 0u; mine = (j == x) ? c : mine; }
        if (sum == G) break;
        __builtin_amdgcn_s_sleep(1);
        if ((++sp & 255u) == 0u) { if (xb_ld(&bar[XB_TMO])) break; if (sp > XB_SPIN_CAP) { atomicAdd(&bar[XB_TMO], 1u); break; } }
    }
    nloc = mine > 0u ? mine : 1u; nx = cnt > 0u ? cnt : 1u;
}
__device__ __forceinline__ void xcd_barrier(const XcdBarrier& b) {
    asm volatile("s_waitcnt vmcnt(0)" ::: "memory");
    __syncthreads();
    if (threadIdx.x == 0) {
        unsigned* bar = b.bar;
        __builtin_amdgcn_s_waitcnt(0);
        unsigned nloc = b.st[0], nx = b.st[1];
        if (nloc == 0u) { xcd_barrier_complete(bar, b.x, nloc, nx); b.st[0] = nloc; b.st[1] = nx; }
        const unsigned old = xb_add(&bar[XB_XSUB(b.x)], 1u);
        const unsigned gen = old / nloc;
        if (old + 1u == (gen + 1u) * nloc) {
            __builtin_amdgcn_fence(__ATOMIC_RELEASE, "agent");
            asm volatile("s_waitcnt vmcnt(0)" ::: "memory");
            const unsigned og = xb_add(&bar[XB_TOP], 1u);
            const unsigned tg = og / nx;
            if (og + 1u == (tg + 1u) * nx) xb_add(&bar[XB_TOPGEN], 1u);
            else XB_SPIN(xb_ld(&bar[XB_TOPGEN]) == tg, bar);
            __builtin_amdgcn_fence(__ATOMIC_ACQUIRE, "agent");
            xb_add(&bar[XB_XGEN(b.x)], 1u);
            asm volatile("s_waitcnt vmcnt(0)" ::: "memory");
        } else {
            XB_SPIN(xb_ld(&bar[XB_XGEN(b.x)]) == gen, bar);
            __builtin_amdgcn_fence(__ATOMIC_ACQUIRE, "agent");
            asm volatile("s_waitcnt vmcnt(0)" ::: "memory");
        }
    }
    __syncthreads();
}

struct Args {
    const float *x, *meta, *ln0_g, *ln0_b, *w_in, *conv_w, *conv_b, *gate_bias, *lq1, *lk1, *lq2, *lk2, *att_g, *ml_g, *w_att_out, *w_ml_out, *w_o,
                *ln1_g, *ln1_b, *w_router, *b_router, *w_gu, *b_gu, *w_down, *b_down, *ln2_g, *ln2_b;
    float* out; unsigned char* ws; int ph_lo, ph_hi;
};

template <class ColMap>
__device__ __forceinline__ void transpose_item(const float* W, int K, int N, bf16_t* WT, LAS float* scr, int kb, int nb, int lane, ColMap cm) {
    const int k0 = 64 * kb, n0 = 32 * nb;
    const int lc = cm(n0 + (lane & 31));
    float tv[32];
    const float* wp = W + (size_t)(k0 + (lane >> 5)) * N + lc;
#pragma unroll
    for (int i = 0; i < 32; ++i) tv[i] = wp[(size_t)(2 * i) * N];
#pragma unroll
    for (int i = 0; i < 32; ++i) { const int kk = 2 * i + (lane >> 5); scr[kk * 33 + (lane & 31)] = tv[i]; }
    LDS_WAIT(); asm volatile("" ::: "memory");
    const int c = lane & 7;
#pragma unroll
    for (int j = 0; j < 4; ++j) { const int n = (lane >> 3) + 8 * j; const LAS float* s = scr + (8 * c) * 33 + n;
        u32x4 o; o.x = pkbf(s[0 * 33], s[1 * 33]); o.y = pkbf(s[2 * 33], s[3 * 33]); o.z = pkbf(s[4 * 33], s[5 * 33]); o.w = pkbf(s[6 * 33], s[7 * 33]);
        *(u32x4*)(WT + (size_t)(n0 + n) * K + k0 + 8 * c) = o; }
    LDS_WAIT(); asm volatile("" ::: "memory");
}
struct CmIdent { __device__ __forceinline__ int operator()(int p) const { return p; } };
struct CmWin {
    __device__ __forceinline__ int operator()(int P) const {
        if (P < 1024) { const int hb = P >> 6, p = P & 63, wcp = p >> 5, fq = (p & 31) >> 3, n = (p & 7) >> 2, j = p & 3; return hb * 64 + 32 * n + 16 * wcp + 4 * fq + j; }
        if (P < 3584) return P;
        return P + 8;
    }
};
struct CmGu {
    __device__ __forceinline__ int operator()(int P) const { const int pn = P >> 8, s = (P >> 7) & 1, i = P & 127; return 2 * (128 * pn + i) + s; }
};

__global__ void __launch_bounds__(NWAVES * 64, 2) hybrid_fwd(Args a) {
    extern __shared__ __attribute__((aligned(16))) unsigned char lds[];
    LAS unsigned char* L = (LAS unsigned char*)lds;
    const int tid = threadIdx.x, lane = tid & 63, wave = __builtin_amdgcn_readfirstlane(tid >> 6);
    const int G = gridDim.x, blk = blockIdx.x;
    const int gw = blk * NWAVES + wave, NGW = G * NWAVES;
    if (tid < 16) ((LAS unsigned*)(L + MISC_OFF))[tid] = 0u;
    LAS unsigned long long* ptab = (LAS unsigned long long*)(L + MISC_OFF + 64);
    if (tid == 0) {
        ptab[0] = (unsigned long long)a.x; ptab[1] = (unsigned long long)a.meta; ptab[2] = (unsigned long long)a.ln0_g; ptab[3] = (unsigned long long)a.ln0_b; ptab[4] = (unsigned long long)a.w_in;
        ptab[5] = (unsigned long long)a.conv_w; ptab[6] = (unsigned long long)a.conv_b; ptab[7] = (unsigned long long)a.gate_bias; ptab[8] = (unsigned long long)a.lq1; ptab[9] = (unsigned long long)a.lk1;
        ptab[10] = (unsigned long long)a.lq2; ptab[11] = (unsigned long long)a.lk2; ptab[12] = (unsigned long long)a.att_g; ptab[13] = (unsigned long long)a.ml_g; ptab[14] = (unsigned long long)a.w_att_out;
        ptab[15] = (unsigned long long)a.w_ml_out; ptab[16] = (unsigned long long)a.w_o; ptab[17] = (unsigned long long)a.ln1_g; ptab[18] = (unsigned long long)a.ln1_b; ptab[19] = (unsigned long long)a.w_router;
        ptab[20] = (unsigned long long)a.b_router; ptab[21] = (unsigned long long)a.w_gu; ptab[22] = (unsigned long long)a.b_gu; ptab[23] = (unsigned long long)a.w_down; ptab[24] = (unsigned long long)a.b_down;
        ptab[25] = (unsigned long long)a.ln2_g; ptab[26] = (unsigned long long)a.ln2_b; ptab[27] = (unsigned long long)a.out; ptab[28] = (unsigned long long)a.ws;
    }
    asm volatile("s_waitcnt lgkmcnt(0)" ::: "memory");
    __syncthreads();
    asm volatile("" ::: "memory");
#define PF(i) ((const float*)ldptr(ptab, (i)))
#define WSP ((unsigned char*)ldptr(ptab, 28))
#define DOUTP ((unsigned char*)ldptr(ptab, 27))
#define ctl ((unsigned*)(WSP + WS_CTL))
#define WinT ((bf16_t*)(WSP + WS_WIN))
#define WaT ((bf16_t*)(WSP + WS_WA))
#define WmT ((bf16_t*)(WSP + WS_WM))
#define WoT ((bf16_t*)(WSP + WS_WO))
#define ropec ((float*)(WSP + WS_ROPE))
#define ropes (ropec + TT * 32)
#define stats ((float*)(WSP + WS_STATS))
#define gates ((float*)(WSP + WS_GATES))
#define tok_e ((int*)(WSP + WS_TOKE))
#define tok_g ((float*)(WSP + WS_TOKG))
#define hist ((int*)(WSP + WS_HIST))
#define row_off ((int*)(WSP + WS_ROWOFF))
#define row_slot ((int*)(WSP + WS_ROWSLOT))
#define row_gate ((float*)(WSP + WS_ROWGATE))
#define tile_exp ((int*)(WSP + WS_TILEEXP))
#define Hb ((bf16_t*)(WSP + WS_H))
#define Z ((bf16_t*)(WSP + WS_Z))
#define Y ((bf16_t*)(WSP + WS_Y))
#define ACT ((bf16_t*)(WSP + WS_ACT))
#define Qc ((bf16_t*)(WSP + WS_QC))
#define Kc ((bf16_t*)(WSP + WS_KC))
#define Vc ((bf16_t*)(WSP + WS_VC))
#define TMPb ((bf16_t*)(WSP + WS_TMP))
#define MRGb ((bf16_t*)(WSP + WS_MRG))
#define Ob ((bf16_t*)(WSP + WS_O))
#define WguT ((bf16_t*)(DOUTP + DO_WGU))
#define WdnT ((bf16_t*)(DOUTP + DO_WDN))
#if !MK_PER_PHASE
    XcdBarrier bar = xcd_barrier_post(ctl + CW_BAR, (volatile LAS unsigned*)(L + MISC_OFF + 32));
#define GRID_BAR() xcd_barrier(bar)
#else
#define GRID_BAR() do {} while (0)
#endif
    const int lo = a.ph_lo, hi = a.ph_hi;
#define IN(k) (lo <= (k) && (k) < hi)
#define BOTH(k) (IN(k) && IN((k) + 1))

    if (IN(0)) REPLOOP(0) {
        {   LAS float* scr = (LAS float*)(L + wave * 16384);
            constexpr int I_IN = 16 * (NZP / 32), I_A = 8 * 32, I_O = 16 * 32;
            constexpr int NIT = I_IN + 2 * I_A + I_O;
            for (int it = gw; it < NIT; it += NGW) {
                int r = it;
                if (r < I_IN) { transpose_item(PF(4), 1024, NIN, WinT, scr, r / (NZP / 32), r % (NZP / 32), lane, CmWin()); continue; } r -= I_IN;
                if (r < I_A) { transpose_item(PF(14), 512, 1024, WaT, scr, r / 32, r % 32, lane, CmIdent()); continue; } r -= I_A;
                if (r < I_A) { transpose_item(PF(15), 512, 1024, WmT, scr, r / 32, r % 32, lane, CmIdent()); continue; } r -= I_A;
                transpose_item(PF(16), 1024, 1024, WoT, scr, r / 32, r % 32, lane, CmIdent());
            }
        }
        for (int i = blk * 512 + tid; i < TT * 32; i += G * 512) {
            const int t = i >> 5, f = i & 31;
            const double inv = exp2(-(double)f * (13.287712379549449 / 32.0));
            const double rev = (double)t * inv * 0.15915494309189535;
            const float fr = (float)(rev - floor(rev));
            ropec[i] = __builtin_amdgcn_cosf(fr); ropes[i] = __builtin_amdgcn_sinf(fr);
        }
        __syncthreads();
        LAS float* wg = (LAS float*)L;
        for (int i = tid; i < 8 * 1024; i += 512) { const int gc = i >> 10, k = i & 1023; wg[i] = PF(4)[(size_t)k * NIN + 3584 + gc]; }
        __syncthreads();
        for (int row = gw; row < MROWS; row += NGW) {
            const float* xr = (row < NREAL) ? PF(0) + (size_t)row * DM : PF(1) + (size_t)((row - NREAL) & (NMETA - 1)) * DM;
            f32x4 v[4]; float s = 0.f;
#pragma unroll
            for (int j = 0; j < 4; ++j) { v[j] = *(const f32x4*)(xr + 4 * lane + 256 * j); s += (v[j][0] + v[j][1]) + (v[j][2] + v[j][3]); }
            const float mean = wave_sum(s) * (1.f / DM); float s2 = 0.f;
#pragma unroll
            for (int j = 0; j < 4; ++j) { const f32x4 d = v[j] - mean; s2 += (d[0] * d[0] + d[1] * d[1]) + (d[2] * d[2] + d[3] * d[3]); }
            const float rstd = 1.0f / sqrtf(wave_sum(s2) * (1.f / DM) + LN_EPS);
            if (lane == 0) { stats[2 * row] = mean; stats[2 * row + 1] = rstd; }
            float gp[8];
#pragma unroll
            for (int q = 0; q < 8; ++q) gp[q] = 0.f;
#pragma unroll
            for (int j = 0; j < 4; ++j) {
                const f32x4 gg = *(const f32x4*)(PF(2) + 4 * lane + 256 * j), bb = *(const f32x4*)(PF(3) + 4 * lane + 256 * j);
                const f32x4 hv = (v[j] - mean) * rstd * gg + bb;
                u32x2 w; w.x = pkbf(hv[0], hv[1]); w.y = pkbf(hv[2], hv[3]);
                *(u32x2*)(Hb + (size_t)row * DM + 4 * lane + 256 * j) = w;
#pragma unroll
                for (int q = 0; q < 8; ++q) { const f32x4 wv = *(const LAS f32x4*)(wg + q * 1024 + 4 * lane + 256 * j); gp[q] += (hv[0] * wv[0] + hv[1] * wv[1]) + (hv[2] * wv[2] + hv[3] * wv[3]); }
            }
#pragma unroll
            for (int q = 0; q < 8; ++q) gp[q] = wave_sum(gp[q]);
            if (lane < 8) {
                float gsel = gp[0];
#pragma unroll
                for (int q = 1; q < 8; ++q) gsel = (lane == q) ? gp[q] : gsel;
                float gv = gsel + PF(7)[lane];
                if (lane >= 4) gv = (gv >= 0.f) ? -log1pf(expf(-gv)) : gv - log1pf(expf(gv));
                gates[(size_t)row * 8 + lane] = gv;
            }
        }
        __syncthreads();
        if (BOTH(0) || rep_ + 1 < REP_0) GRID_BAR();
    }

    if (IN(1)) REPLOOP(1) {
        pg8::Gemm g{Hb, WinT, DM, DM, NZP / 256, nullptr, nullptr, 0};
        pg8::StaticOrder S; S.init(MROWS / 256, NZP / 256, G, blk);
        pg8::EpiZ E{Z, Qc, Kc, Vc, ropec, ropes};
        pg8::gemm_phase<0, pg8::EpiZ>(L, g, S, E);
        if (BOTH(1) || rep_ + 1 < REP_1) GRID_BAR();
    }

    if (IN(2)) {
        REPLOOP(2B) {
            constexpr int PQ = 136;
            LAS bf16_t* Qs = (LAS bf16_t*)L;
            LAS bf16_t* Ks = Qs + 128 * PQ;
            LAS bf16_t* VTs = Ks + 128 * PQ;
            LAS bf16_t* Cs = VTs + 144 * PQ;
            LAS float* fv = (LAS float*)(Cs + 144 * PQ);
            LAS float* v_a = fv;
            LAS float* v_M = fv + 128;
            LAS float* v_b = fv + 256;
            LAS float* v_w = fv + 384;
            LAS float* v_sc = fv + 512;
            LAS float* cw = fv + 528;
            const float* convw = PF(5); const float* convb = PF(6); const float* mlg = PF(13); const float* gatesp = gates;
            bf16_t* Zp = Z;
            for (int u = blk; u < NB * 4; u += G) {
                const int b = u >> 2, h = u & 3;
                __syncthreads();
                for (int i = tid; i < 5 * 256; i += 512) { const int j = i >> 8, c = i & 255; const int ch = (c < 128) ? (h * 128 + c) : (512 + h * 128 + (c - 128));
                    cw[i] = (j < 4) ? convw[j * 1024 + ch] : convb[ch]; }
                for (int i = tid; i < 144 * PQ; i += 512) { const int rr = i / PQ; VTs[i] = (rr == 128) ? (bf16_t)0x3f80 : (bf16_t)0; Cs[i] = 0; }
                if (tid == 0) v_sc[0] = 0.f;
                f32x4 Cst[9];
#pragma unroll
                for (int jt = 0; jt < 9; ++jt) Cst[jt] = (f32x4){0.f, 0.f, 0.f, 0.f};
                const int fr = lane & 15, quad = lane >> 4;
                float gml[8];
#pragma unroll
                for (int jt = 0; jt < 8; ++jt) gml[jt] = mlg[h * 128 + 16 * jt + fr];
                for (int c = 0; c < 33; ++c) {
                    const int t0 = c * 128;
                    __syncthreads();
                    if (wave == 0) {
                        const float m_old0 = v_sc[0];
                        float x0, x1, i0, i1;
                        { const int ta = t0 + 2 * lane, tb = ta + 1;
                          x0 = (ta < TT) ? ld_agent_f(gatesp + (size_t)row_of(b, ta) * 8 + 4 + h) : 0.f; i0 = (ta < TT) ? ld_agent_f(gatesp + (size_t)row_of(b, ta) * 8 + h) : -1e30f;
                          x1 = (tb < TT) ? ld_agent_f(gatesp + (size_t)row_of(b, tb) * 8 + 4 + h) : 0.f; i1 = (tb < TT) ? ld_agent_f(gatesp + (size_t)row_of(b, tb) * 8 + h) : -1e30f; }
                        float sacc = x0 + x1;
#pragma unroll
                        for (int o = 1; o < 64; o <<= 1) { const float tv = __shfl_up(sacc, o); if (lane >= o) sacc += tv; }
                        const float ex = sacc - (x0 + x1);
                        const float b0 = ex + x0, b1 = b0 + x1;
                        const float a0 = i0 - b0, a1 = i1 - b1;
                        float mx = fmaxf(a0, a1);
#pragma unroll
                        for (int o = 1; o < 64; o <<= 1) { const float tv = __shfl_up(mx, o); if (lane >= o) mx = fmaxf(mx, tv); }
                        float exm = __shfl_up(mx, 1); if (lane == 0) exm = -INFINITY;
                        const float M0 = fmaxf(fmaxf(m_old0, exm), a0), M1 = fmaxf(M0, a1);
                        const float Ml = __shfl(M1, 63);
                        v_b[2 * lane] = b0; v_b[2 * lane + 1] = b1; v_a[2 * lane] = a0; v_a[2 * lane + 1] = a1; v_M[2 * lane] = M0; v_M[2 * lane + 1] = M1;
                        v_w[2 * lane] = (t0 + 2 * lane < TT) ? __expf(a0 - Ml) : 0.f; v_w[2 * lane + 1] = (t0 + 2 * lane + 1 < TT) ? __expf(a1 - Ml) : 0.f;
                        if (lane == 63) v_sc[1] = M1;
                    }
#pragma unroll 2
                    for (int i = 0; i < 4; ++i) {
                        const int p = tid + 512 * i, s = p >> 4, dg = p & 15;
                        const int t = t0 + s;
                        float qv[8], kv[8];
#pragma unroll
                        for (int e = 0; e < 8; ++e) { qv[e] = cw[4 * 256 + dg * 8 + e]; kv[e] = cw[4 * 256 + 128 + dg * 8 + e]; }
#pragma unroll
                        for (int j = 0; j < 4; ++j) {
                            const int tj = t - 3 + j;
                            if (tj >= 0 && tj < TT) {
                                const bf16_t* zr = Zp + (size_t)row_of(b, tj) * NZ + h * 128 + dg * 8;
                                const u32x4 zq = *(const u32x4*)(zr + ZMQ);
                                const u32x4 zk = *(const u32x4*)(zr + ZMK);
                                const LAS float* wq = cw + j * 256 + dg * 8; const LAS float* wk = wq + 128;
                                qv[0] += wq[0] * bflo(zq.x); qv[1] += wq[1] * bfhi(zq.x); qv[2] += wq[2] * bflo(zq.y); qv[3] += wq[3] * bfhi(zq.y);
                                qv[4] += wq[4] * bflo(zq.z); qv[5] += wq[5] * bfhi(zq.z); qv[6] += wq[6] * bflo(zq.w); qv[7] += wq[7] * bfhi(zq.w);
                                kv[0] += wk[0] * bflo(zk.x); kv[1] += wk[1] * bfhi(zk.x); kv[2] += wk[2] * bflo(zk.y); kv[3] += wk[3] * bfhi(zk.y);
                                kv[4] += wk[4] * bflo(zk.z); kv[5] += wk[5] * bfhi(zk.z); kv[6] += wk[6] * bflo(zk.w); kv[7] += wk[7] * bfhi(zk.w);
                            }
                        }
                        const bool live = (t < TT);
#pragma unroll
                        for (int e = 0; e < 8; ++e) { qv[e] = live ? qv[e] * sigmoidf_(qv[e]) : 0.f; kv[e] = live ? kv[e] * sigmoidf_(kv[e]) * 0.08838834764831845f : 0.f; }
                        u32x4 wq4, wk4; wq4.x = pkbf(qv[0], qv[1]); wq4.y = pkbf(qv[2], qv[3]); wq4.z = pkbf(qv[4], qv[5]); wq4.w = pkbf(qv[6], qv[7]);
                        wk4.x = pkbf(kv[0], kv[1]); wk4.y = pkbf(kv[2], kv[3]); wk4.z = pkbf(kv[4], kv[5]); wk4.w = pkbf(kv[6], kv[7]);
                        *(LAS u32x4*)(Qs + s * PQ + dg * 8) = wq4; *(LAS u32x4*)(Ks + s * PQ + dg * 8) = wk4;
                        u32x4 zv = (u32x4){0u, 0u, 0u, 0u};
                        if (live) zv = *(const u32x4*)(Zp + (size_t)row_of(b, t) * NZ + ZMV + h * 128 + dg * 8);
                        VTs[(dg * 8 + 0) * PQ + s] = (bf16_t)(zv.x & 0xffffu); VTs[(dg * 8 + 1) * PQ + s] = (bf16_t)(zv.x >> 16);
                        VTs[(dg * 8 + 2) * PQ + s] = (bf16_t)(zv.y & 0xffffu); VTs[(dg * 8 + 3) * PQ + s] = (bf16_t)(zv.y >> 16);
                        VTs[(dg * 8 + 4) * PQ + s] = (bf16_t)(zv.z & 0xffffu); VTs[(dg * 8 + 5) * PQ + s] = (bf16_t)(zv.z >> 16);
                        VTs[(dg * 8 + 6) * PQ + s] = (bf16_t)(zv.w & 0xffffu); VTs[(dg * 8 + 7) * PQ + s] = (bf16_t)(zv.w >> 16);
                    }
                    __syncthreads();
                    const float Mlast = v_sc[1], m_old = v_sc[0];
                    f32x4 St[8], n1[9];
#pragma unroll
                    for (int j = 0; j < 8; ++j) St[j] = (f32x4){0.f, 0.f, 0.f, 0.f};
#pragma unroll
                    for (int jt = 0; jt < 9; ++jt) n1[jt] = (f32x4){0.f, 0.f, 0.f, 0.f};
                    {
                        bf16x8 af[4];
#pragma unroll
                        for (int kk = 0; kk < 4; ++kk) af[kk] = *(const LAS bf16x8*)(Qs + (16 * wave + fr) * PQ + kk * 32 + quad * 8);
#pragma unroll
                        for (int j = 0; j < 8; ++j) if (j <= wave) {
#pragma unroll
                            for (int kk = 0; kk < 4; ++kk) { const bf16x8 bfv = *(const LAS bf16x8*)(Ks + (16 * j + fr) * PQ + kk * 32 + quad * 8);
                                St[j] = __builtin_amdgcn_mfma_f32_16x16x32_bf16(af[kk], bfv, St[j], 0, 0, 0); }
                        }
#pragma unroll
                        for (int jt = 0; jt < 9; ++jt)
#pragma unroll
                            for (int kk = 0; kk < 4; ++kk) { const bf16x8 bc = *(const LAS bf16x8*)(Cs + (16 * jt + fr) * PQ + kk * 32 + quad * 8);
                                n1[jt] = __builtin_amdgcn_mfma_f32_16x16x32_bf16(af[kk], bc, n1[jt], 0, 0, 0); }
                    }
                    __syncthreads();
                    {
                        float Ms[4];
#pragma unroll
                        for (int jj = 0; jj < 4; ++jj) Ms[jj] = v_M[16 * wave + 4 * quad + jj];
#pragma unroll
                        for (int j = 0; j < 8; ++j) {
                            const int r = 16 * j + fr; const float ar = v_a[r];
#pragma unroll
                            for (int jj = 0; jj < 4; ++jj) { const int s = 16 * wave + 4 * quad + jj;
                                const float w = (j <= wave && r <= s) ? St[j][jj] * __expf(ar - Ms[jj]) : 0.f;
                                Qs[s * PQ + r] = (bf16_t)(pkbf(w, 0.f) & 0xffffu); }
                        }
                    }
                    __syncthreads();
                    float hv[8][4];
                    {
                        f32x4 n2[9];
#pragma unroll
                        for (int jt = 0; jt < 9; ++jt) n2[jt] = (f32x4){0.f, 0.f, 0.f, 0.f};
#pragma unroll
                        for (int kk = 0; kk < 4; ++kk) {
                            const bf16x8 as_ = *(const LAS bf16x8*)(Qs + (16 * wave + fr) * PQ + kk * 32 + quad * 8);
#pragma unroll
                            for (int jt = 0; jt < 9; ++jt) { const bf16x8 bvv = *(const LAS bf16x8*)(VTs + (16 * jt + fr) * PQ + kk * 32 + quad * 8);
                                n2[jt] = __builtin_amdgcn_mfma_f32_16x16x32_bf16(as_, bvv, n2[jt], 0, 0, 0); }
                        }
#pragma unroll
                        for (int jj = 0; jj < 4; ++jj) {
                            const int s = 16 * wave + 4 * quad + jj;
                            const float Ms = v_M[s]; const float winter = __expf(m_old - Ms);
                            float den = winter * n1[8][jj] + n2[8][jj];
                            den = __shfl(den, lane & 48);
                            const float ms = v_b[s] + Ms;
                            const float rd = 1.0f / fmaxf(fabsf(den), __expf(-ms));
                            float ss = 0.f;
#pragma unroll
                            for (int jt = 0; jt < 8; ++jt) { const float x = (winter * n1[jt][jj] + n2[jt][jj]) * rd; hv[jt][jj] = x; ss += x * x; }
                            ss = row_sum16(ss);
                            const float rs = 1.0f / sqrtf(ss * (1.f / 128.f) + LN_EPS);
#pragma unroll
                            for (int jt = 0; jt < 8; ++jt) hv[jt][jj] *= rs * gml[jt];
                        }
                    }
                    __syncthreads();
#pragma unroll
                    for (int jt = 0; jt < 8; ++jt)
#pragma unroll
                        for (int jj = 0; jj < 4; ++jj) Qs[(16 * wave + 4 * quad + jj) * PQ + 16 * jt + fr] = (bf16_t)(pkbf(hv[jt][jj], 0.f) & 0xffffu);
                    {
                        const float w_old = __expf(m_old - Mlast);
#pragma unroll
                        for (int jt = 0; jt < 9; ++jt) Cst[jt] = Cst[jt] * w_old;
#pragma unroll
                        for (int kk = 0; kk < 4; ++kk) {
                            const int rb = 32 * kk + 8 * quad;
                            const LAS bf16_t* kp = Ks + (rb + (fr >> 2)) * PQ + 16 * wave + 4 * (fr & 3);
                            const attn_body::s16x4 lo = attn_body::vtr((attn_body::lds_cptr)kp), hi4 = attn_body::vtr((attn_body::lds_cptr)(kp + 4 * PQ));
                            const f32x4 w0 = *(const LAS f32x4*)(v_w + rb), w1 = *(const LAS f32x4*)(v_w + rb + 4);
                            float kf[8];
#pragma unroll
                            for (int q = 0; q < 4; ++q) { kf[q] = __uint_as_float(((unsigned)(unsigned short)lo[q]) << 16) * w0[q]; kf[4 + q] = __uint_as_float(((unsigned)(unsigned short)hi4[q]) << 16) * w1[q]; }
                            u32x4 kw; kw.x = pkbf(kf[0], kf[1]); kw.y = pkbf(kf[2], kf[3]); kw.z = pkbf(kf[4], kf[5]); kw.w = pkbf(kf[6], kf[7]);
                            const bf16x8 bk = __builtin_bit_cast(bf16x8, kw);
#pragma unroll
                            for (int jt = 0; jt < 9; ++jt) { const bf16x8 av = *(const LAS bf16x8*)(VTs + (16 * jt + fr) * PQ + kk * 32 + quad * 8);
                                Cst[jt] = __builtin_amdgcn_mfma_f32_16x16x32_bf16(av, bk, Cst[jt], 0, 0, 0); }
                        }
#pragma unroll
                        for (int jt = 0; jt < 9; ++jt)
#pragma unroll
                            for (int jj = 0; jj < 4; ++jj) Cs[(16 * jt + 4 * quad + jj) * PQ + 16 * wave + fr] = (bf16_t)(pkbf(Cst[jt][jj], 0.f) & 0xffffu);
                        if (tid == 0) v_sc[0] = v_b[127] + Mlast;
                    }
                    __syncthreads();
#pragma unroll
                    for (int i = 0; i < 4; ++i) {
                        const int p = tid + 512 * i, s = p >> 4, dg = p & 15, t = t0 + s;
                        if (t >= NMETA && t < TT) {
                            const u32x4 hw = *(const LAS u32x4*)(Qs + s * PQ + dg * 8);
                            bf16_t* zr = Zp + (size_t)row_of(b, t) * NZ + h * 128 + dg * 8;
                            const u32x4 mw = *(const u32x4*)(zr + ZMO);
                            u32x4 wy;
                            wy.x = pkbf(sigmoidf_(bflo(mw.x)) * bflo(hw.x), sigmoidf_(bfhi(mw.x)) * bfhi(hw.x)); wy.y = pkbf(sigmoidf_(bflo(mw.y)) * bflo(hw.y), sigmoidf_(bfhi(mw.y)) * bfhi(hw.y));
                            wy.z = pkbf(sigmoidf_(bflo(mw.z)) * bflo(hw.z), sigmoidf_(bfhi(mw.z)) * bfhi(hw.z)); wy.w = pkbf(sigmoidf_(bflo(mw.w)) * bflo(hw.w), sigmoidf_(bfhi(mw.w)) * bfhi(hw.w));
                            *(u32x4*)(zr + ZMV) = wy;
                        }
                    }
                }
            }
        }
        __syncthreads();
        REPLOOP(2A) {
            LAS int* tkt = (LAS int*)(L + MISC_OFF + 16);
            bf16_t* Qcp = Qc; bf16_t* Kcp = Kc; bf16_t* Vcp = Vc; bf16_t* Obp = Ob; unsigned* tctr = ctl + CW_TICKET + 64 * rep_;
            const float* wgu = PF(21); const float* wdn = PF(23); bf16_t* WguTp = WguT; bf16_t* WdnTp = WdnT;
            constexpr int NATT = NB * 8 * 17, NJOB = NE * 16;
            for (;;) {
                __syncthreads();
                if (tid == 0) *tkt = (int)__hip_atomic_fetch_add(tctr, 1u, RLX_AGENT);
                __syncthreads();
                const int T = __builtin_amdgcn_readfirstlane(*tkt);
                if (T >= NATT + NJOB) break;
                int Lidx;
                { const int q = T / 5, r = T - q * 5;
                  if (q < NJOB) {
                      if (r == 4) {
                          const int e = q >> 4, kb = q & 15; LAS float* scr = (LAS float*)(L + wave * 16384);
                          for (int it = wave; it < 96; it += NWAVES) {
                              if (it < 64) transpose_item(wgu + (size_t)e * 1024 * 2048, 1024, 2048, WguTp + (size_t)e * 2048 * 1024, scr, kb, it, lane, CmGu());
                              else transpose_item(wdn + (size_t)e * 1024 * 1024, 1024, 1024, WdnTp + (size_t)e * 1024 * 1024, scr, kb, it - 64, lane, CmIdent());
                          }
                          continue;
                      }
                      Lidx = q * 4 + r;
                  } else Lidx = T - NJOB; }
                const int bhm = Lidx & 127, qb = 16 - (Lidx >> 7);
                const int b = bhm >> 3, hm = bhm & 7, h = hm >> 1;
                attn_body::attn2_unit<8>(qb, (const attn_body::bf16*)(Qcp + (size_t)(b * 8 + hm) * TT * 64), (const attn_body::bf16*)(Kcp + (size_t)(b * 8 + hm) * TT * 64),
                                         (const attn_body::bf16*)(Vcp + (size_t)(b * 4 + h) * TT * 128), (attn_body::bf16*)(Obp + (size_t)b * OROWS * 1024 + hm * 128), (char*)lds);
            }
        }
        __syncthreads();
        if (BOTH(2)) GRID_BAR();
    }

    if (IN(3)) REPLOOP(3) {
        float lam;
        { const float p1 = wave_sum(PF(8)[lane] * PF(9)[lane]), p2 = wave_sum(PF(10)[lane] * PF(11)[lane]); lam = expf(p1) - expf(p2) + LAMBDA_INIT; }
        const int hd = lane >> 4, e0 = (lane & 15) * 8;
        float ga[8];
#pragma unroll
        for (int e = 0; e < 8; ++e) ga[e] = PF(12)[e0 + e] * (1.0f - LAMBDA_INIT);
        const bf16_t* Obp = Ob; bf16_t* Zp = Z;
        for (int row = gw; row < NREAL; row += NGW) {
            const int b = row >> 12, t = (row & (SEQ - 1)) + NMETA;
            const bf16_t* orow = Obp + ((size_t)b * OROWS + t) * 1024 + hd * 256 + e0;
            const u32x4 w0 = *(const u32x4*)orow, w1 = *(const u32x4*)(orow + 128);
            float o[8];
            o[0] = bflo(w0.x) - lam * bflo(w1.x); o[1] = bfhi(w0.x) - lam * bfhi(w1.x); o[2] = bflo(w0.y) - lam * bflo(w1.y); o[3] = bfhi(w0.y) - lam * bfhi(w1.y);
            o[4] = bflo(w0.z) - lam * bflo(w1.z); o[5] = bfhi(w0.z) - lam * bfhi(w1.z); o[6] = bflo(w0.w) - lam * bflo(w1.w); o[7] = bfhi(w0.w) - lam * bfhi(w1.w);
            float ss = 0.f;
#pragma unroll
            for (int e = 0; e < 8; ++e) ss += o[e] * o[e];
            ss = row_sum16(ss);
            const float rs = 1.0f / sqrtf(ss * (1.f / 128.f) + LN_EPS);
            u32x4 wo; wo.x = pkbf(o[0] * rs * ga[0], o[1] * rs * ga[1]); wo.y = pkbf(o[2] * rs * ga[2], o[3] * rs * ga[3]); wo.z = pkbf(o[4] * rs * ga[4], o[5] * rs * ga[5]); wo.w = pkbf(o[6] * rs * ga[6], o[7] * rs * ga[7]);
            *(u32x4*)(Zp + (size_t)row * NZ + ZYC + hd * 128 + e0) = wo;
        }
        if (BOTH(3) || rep_ + 1 < REP_3) GRID_BAR();
    }

    if (IN(4)) REPLOOP(4) {
        {   pg8::Gemm g{Z + ZYC, WaT, NZ, 512, 4, nullptr, nullptr, 0};
            pg8::StaticOrder S; S.init(NREAL / 256, 4, G, blk);
            pg8::EpiGate<false> E{Z, TMPb, MRGb};
            pg8::gemm_phase<0, pg8::EpiGate<false>>(L, g, S, E); }
        {   pg8::Gemm g{Z + ZMV, WmT, NZ, 512, 4, nullptr, nullptr, 0};
            pg8::StaticOrder S; S.init(NREAL / 256, 4, G, blk);
            pg8::EpiGate<true> E{Z, TMPb, MRGb};
            pg8::gemm_phase<0, pg8::EpiGate<true>>(L, g, S, E); }
        if (BOTH(4) || rep_ + 1 < REP_4) GRID_BAR();
    }

    if (IN(5)) REPLOOP(5) {
        pg8::Gemm g{MRGb, WoT, DM, 1024, 4, nullptr, nullptr, 0};
        pg8::StaticOrder S; S.init(NREAL / 256, 4, G, blk);
        pg8::EpiPre1 E{(float*)(Z + ZGA), PF(0), PF(1), stats, PF(2), PF(3)};
        pg8::gemm_phase<0, pg8::EpiPre1>(L, g, S, E);
        if (BOTH(5) || rep_ + 1 < REP_5) GRID_BAR();
    }

    constexpr int NPART = 256, RPP = NREAL / NPART;
    static_assert(NPART * RPP == NREAL, "partitions");
    if (IN(6)) REPLOOP(6) {
        LAS float* wrT = (LAS float*)L;
        LAS int* hcnt = (LAS int*)(L + 131072);
        { const float* wr = PF(19); for (int i = tid; i < 32 * 1024; i += 512) { const int k = i >> 5, e = i & 31; wrT[e * 1024 + k] = wr[i]; } }
        const float* P1 = (const float*)(Z + ZGA);
        f32x4 gg[4], bb[4];
        { const float* g1 = PF(17); const float* b1 = PF(18);
#pragma unroll
          for (int j = 0; j < 4; ++j) { gg[j] = *(const f32x4*)(g1 + 4 * lane + 256 * j); bb[j] = *(const f32x4*)(b1 + 4 * lane + 256 * j); } }
        const float brt = PF(20)[(lane >> 1) & 31];
        bf16_t* Hbp = Hb; int* tokE = tok_e; float* tokG = tok_g; int* histp = hist;
        for (int part = blk; part < NPART; part += G) {
            __syncthreads();
            if (tid < 32) hcnt[tid] = 0;
            __syncthreads();
            const int rbeg = part * RPP, rend = rbeg + RPP;
            constexpr int RPW = (RPP + NWAVES - 1) / NWAVES;
            const int wbeg = rbeg + wave * RPW, wend = (wbeg + RPW < rend) ? wbeg + RPW : rend;
            for (int row = wbeg; row < wend; row += 2) {
                const bool two = (row + 1 < wend);
                const int row1 = two ? row + 1 : row;
                const float* pr0 = P1 + (size_t)row * (NZ / 2); const float* pr1 = P1 + (size_t)row1 * (NZ / 2);
                f32x4 v0[4], v1[4]; float s0 = 0.f, s1 = 0.f;
#pragma unroll
                for (int j = 0; j < 4; ++j) { v0[j] = *(const f32x4*)(pr0 + 4 * lane + 256 * j); v1[j] = *(const f32x4*)(pr1 + 4 * lane + 256 * j); }
#pragma unroll
                for (int j = 0; j < 4; ++j) { s0 += (v0[j][0] + v0[j][1]) + (v0[j][2] + v0[j][3]); s1 += (v1[j][0] + v1[j][1]) + (v1[j][2] + v1[j][3]); }
                const float mean0 = wave_sum(s0) * (1.f / DM), mean1 = wave_sum(s1) * (1.f / DM); float q0 = 0.f, q1 = 0.f;
#pragma unroll
                for (int j = 0; j < 4; ++j) { const f32x4 d0 = v0[j] - mean0, d1 = v1[j] - mean1;
                    q0 += (d0[0] * d0[0] + d0[1] * d0[1]) + (d0[2] * d0[2] + d0[3] * d0[3]); q1 += (d1[0] * d1[0] + d1[1] * d1[1]) + (d1[2] * d1[2] + d1[3] * d1[3]); }
                const float rstd0 = 1.0f / sqrtf(wave_sum(q0) * (1.f / DM) + LN_EPS), rstd1 = 1.0f / sqrtf(wave_sum(q1) * (1.f / DM) + LN_EPS);
#pragma unroll
                for (int j = 0; j < 4; ++j) {
                    v0[j] = (v0[j] - mean0) * rstd0 * gg[j] + bb[j]; v1[j] = (v1[j] - mean1) * rstd1 * gg[j] + bb[j];
                    u32x2 w; w.x = pkbf(v0[j][0], v0[j][1]); w.y = pkbf(v0[j][2], v0[j][3]);
                    *(u32x2*)(Hbp + (size_t)row * DM + 4 * lane + 256 * j) = w;
                    if (two) { w.x = pkbf(v1[j][0], v1[j][1]); w.y = pkbf(v1[j][2], v1[j][3]); *(u32x2*)(Hbp + (size_t)row1 * DM + 4 * lane + 256 * j) = w; }
                }
                float p0[32], p1[32];
#pragma unroll
                for (int e = 0; e < 32; ++e) {
                    float a0 = 0.f, a1 = 0.f;
#pragma unroll
                    for (int j = 0; j < 4; ++j) { const f32x4 wv = *(const LAS f32x4*)(wrT + e * 1024 + 4 * lane + 256 * j);
                        a0 += (v0[j][0] * wv[0] + v0[j][1] * wv[1]) + (v0[j][2] * wv[2] + v0[j][3] * wv[3]);
                        a1 += (v1[j][0] * wv[0] + v1[j][1] * wv[1]) + (v1[j][2] * wv[2] + v1[j][3] * wv[3]); }
                    p0[e] = a0; p1[e] = a1;
                }
                float lg0 = xreduce32(p0, lane) + brt, lg1 = xreduce32(p1, lane) + brt;
#pragma unroll
                for (int rr = 0; rr < 2; ++rr) {
                    float lg = rr ? lg1 : lg0; const int rw = rr ? row1 : row;
                    float tv[4]; int ti[4];
#pragma unroll
                    for (int k = 0; k < 4; ++k) {
                        const float mx = wave_max(lg);
                        const unsigned long long bal = __ballot(lg == mx);
                        const int idx = (__ffsll((long long)bal) - 1) >> 1;
                        tv[k] = mx; ti[k] = idx;
                        if ((lane >> 1) == idx) lg = -INFINITY;
                    }
                    const float e1 = __expf(tv[1] - tv[0]), e2 = __expf(tv[2] - tv[0]), e3 = __expf(tv[3] - tv[0]);
                    const float inv = 1.0f / (1.0f + e1 + e2 + e3);
                    if (lane < 4 && (rr == 0 || two)) {
                        const int idx = (lane == 0) ? ti[0] : (lane == 1) ? ti[1] : (lane == 2) ? ti[2] : ti[3];
                        const float gv = ((lane == 0) ? 1.0f : (lane == 1) ? e1 : (lane == 2) ? e2 : e3) * inv;
                        tokE[(size_t)rw * 4 + lane] = idx; tokG[(size_t)rw * 4 + lane] = gv;
                        atomicAdd((int*)&hcnt[idx], 1);
                    }
                }
            }
            __syncthreads();
            if (tid < 32) histp[part * 32 + tid] = hcnt[tid];
        }
        if (BOTH(6) || rep_ + 1 < REP_6) GRID_BAR();
    }

    if (IN(7)) REPLOOP(7) {
        LAS int* cnt_s = (LAS int*)L; LAS int* base_s = cnt_s + 32; LAS int* pst_s = cnt_s + 64;
        LAS int* ptot = cnt_s + 128; LAS int* pbase = ptot + 512;
        LAS int* ccnt = pbase + 512;
        LAS int* ent = ccnt + 1024; LAS int* lrank = ent + RPP * 4 + 64;
        int* rowOff = row_off; int* rowSlot = row_slot; float* rowGate = row_gate; const int* histp = hist; const int* tokE = tok_e; const float* tokG = tok_g;
        for (int part = blk; part < NPART; part += G) {
            __syncthreads();
            { const int e = tid & 31, q = tid >> 5; int tot = 0, bs = 0;
#pragma unroll 4
              for (int b2 = q * 16; b2 < q * 16 + 16; ++b2) { const int v = ld_agent_i(histp + b2 * 32 + e); tot += v; bs += (b2 < part) ? v : 0; }
              ptot[q * 32 + e] = tot; pbase[q * 32 + e] = bs; }
            const int rbeg = part * RPP, n4 = RPP * 4;
            for (int i = tid; i < n4; i += 512) ent[i] = ld_agent_i(tokE + (size_t)rbeg * 4 + i);
            __syncthreads();
            if (tid < 32) { int tot = 0, bs = 0;
#pragma unroll
                for (int q = 0; q < 16; ++q) { tot += ptot[q * 32 + tid]; bs += pbase[q * 32 + tid]; }
                cnt_s[tid] = tot; base_s[tid] = bs; }
            constexpr int NCH = (RPP * 4 + 63) / 64;
            for (int c = wave; c < NCH; c += NWAVES) {
                const int i = 64 * c + lane; const int my = (i < n4) ? ent[i] : -1; int lr = 0;
#pragma unroll 4
                for (int e = 0; e < 32; ++e) { const unsigned long long b = __ballot(my == e);
                    if (lane == e) ccnt[c * 32 + e] = __popcll(b);
                    if (my == e) lr = __popcll(b & ((1ull << lane) - 1ull)); }
                if (i < n4) lrank[i] = lr;
            }
            __syncthreads();
            if (tid == 0) { int p = 0; for (int e = 0; e < 32; ++e) { pst_s[e] = p; p += (cnt_s[e] + 255) & ~255; } pst_s[32] = p; }
            __syncthreads();
            if (tid < 32) { int run = pst_s[tid] + base_s[tid];
                for (int c = 0; c < NCH; ++c) { const int tmp = ccnt[c * 32 + tid]; ccnt[c * 32 + tid] = run; run += tmp; } }
            __syncthreads();
            for (int i = tid; i < n4; i += 512) { const int e = ent[i]; const int pos = ccnt[(i >> 6) * 32 + e] + lrank[i];
                rowOff[pos] = (rbeg + (i >> 2)) * (DM * 2); rowSlot[pos] = rbeg * 4 + i; rowGate[pos] = ld_agent_f(tokG + (size_t)rbeg * 4 + i); }
            if (part < 32) { const int e = part; for (int r = pst_s[e] + cnt_s[e] + tid; r < pst_s[e + 1]; r += 512) { rowOff[r] = 0; rowSlot[r] = NREAL * 4; rowGate[r] = 0.f; } }
            if (part == 0) { const int nT = pst_s[32] >> 8; int* te = tile_exp;
                for (int t = tid; t < nT; t += 512) { int e = 0; while (e < 31 && t * 256 >= pst_s[e + 1]) ++e; te[t] = e; }
                if (tid == 0) __hip_atomic_store((int*)(ctl + CW_NT), nT, RLX_AGENT); }
        }
        __syncthreads();
        if (BOTH(7) || rep_ + 1 < REP_7) GRID_BAR();
    }

    {
        int nT = 0, TPC = 0;
        if (lo < 12 && hi > 8) { nT = __builtin_amdgcn_readfirstlane(ld_agent_i((const int*)(ctl + CW_NT))); TPC = (nT > 512) ? 512 : nT; }
        if (IN(8)) REPLOOP(8) {
            pg8::Gemm g{Hb, WguT, DM, DM, 8, row_off, tile_exp, 0};
            pg8::StaticOrder S; S.init(TPC, 8, G, blk);
            pg8::EpiAct E{ACT, PF(22), tile_exp, 0};
            pg8::gemm_phase<1, pg8::EpiAct>(L, g, S, E);
            if (BOTH(8) || rep_ + 1 < REP_8) GRID_BAR();
        }
        if (IN(9)) REPLOOP(9) {
            pg8::Gemm g{ACT, WdnT, FF, FF, 4, nullptr, tile_exp, 0};
            pg8::StaticOrder S; S.init(TPC, 4, G, blk);
            pg8::EpiDown E{Y, PF(24), tile_exp, row_slot, row_gate, 0};
            pg8::gemm_phase<2, pg8::EpiDown>(L, g, S, E);
            if (BOTH(9) || rep_ + 1 < REP_9) GRID_BAR();
        }
        if (IN(10)) REPLOOP(10) {
            pg8::Gemm g{Hb, WguT, DM, DM, 8, row_off, tile_exp, TPC};
            pg8::StaticOrder S; S.init(nT - TPC, 8, G, blk);
            pg8::EpiAct E{ACT, PF(22), tile_exp, TPC};
            pg8::gemm_phase<1, pg8::EpiAct>(L, g, S, E);
            if (BOTH(10) || rep_ + 1 < REP_10) GRID_BAR();
        }
        if (IN(11)) REPLOOP(11) {
            pg8::Gemm g{ACT, WdnT, FF, FF, 4, nullptr, tile_exp, TPC};
            pg8::StaticOrder S; S.init(nT - TPC, 4, G, blk);
            pg8::EpiDown E{Y, PF(24), tile_exp, row_slot, row_gate, TPC};
            pg8::gemm_phase<2, pg8::EpiDown>(L, g, S, E);
            if (BOTH(11) || rep_ + 1 < REP_11) GRID_BAR();
        }
    }

    if (IN(12)) REPLOOP(12) {
        for (int row = gw; row < NREAL; row += NGW) {
            f32x4 v[4]; float s = 0.f;
#pragma unroll
            for (int j = 0; j < 4; ++j) {
                const u32x2 hw = *(const u32x2*)(Hb + (size_t)row * DM + 4 * lane + 256 * j);
                f32x4 acc = (f32x4){bflo(hw.x), bfhi(hw.x), bflo(hw.y), bfhi(hw.y)} * DN_ALPHA;
#pragma unroll
                for (int k = 0; k < 4; ++k) { const u32x2 yw = *(const u32x2*)(Y + ((size_t)row * 4 + k) * DM + 4 * lane + 256 * j);
                    acc += (f32x4){bflo(yw.x), bfhi(yw.x), bflo(yw.y), bfhi(yw.y)}; }
                v[j] = acc; s += (acc[0] + acc[1]) + (acc[2] + acc[3]);
            }
            const float mean = wave_sum(s) * (1.f / DM); float s2 = 0.f;
#pragma unroll
            for (int j = 0; j < 4; ++j) { const f32x4 d = v[j] - mean; s2 += (d[0] * d[0] + d[1] * d[1]) + (d[2] * d[2] + d[3] * d[3]); }
            const float rstd = 1.0f / sqrtf(wave_sum(s2) * (1.f / DM) + LN_EPS);
            float* orow = (float*)DOUTP + (size_t)row * DM;
#pragma unroll
            for (int j = 0; j < 4; ++j) {
                const f32x4 gg = *(const f32x4*)(PF(25) + 4 * lane + 256 * j), bb = *(const f32x4*)(PF(26) + 4 * lane + 256 * j);
                *(f32x4*)(orow + 4 * lane + 256 * j) = (v[j] - mean) * rstd * gg + bb;
            }
        }
    }
#undef IN
#undef BOTH
#undef GRID_BAR
}

constexpr int N_PHASES = 13;
extern "C" void kernel_launch(void* const* d_in, const int* in_sizes, int n_in, void* d_out, int out_size, void* d_ws, size_t ws_size, hipStream_t stream) {
    static int grid = 0;
    if (grid == 0) {
        if (n_in != 27 || ws_size < WS_END) { fprintf(stderr, "kernel_launch: unexpected n_in %d / ws_size %zu\n", n_in, ws_size); grid = -1; return; }
        int dev = 0, cus = 0;
        if (hipGetDevice(&dev) != hipSuccess || hipDeviceGetAttribute(&cus, hipDeviceAttributeMultiprocessorCount, dev) != hipSuccess) { grid = -1; return; }
        if (hipFuncSetAttribute((const void*)hybrid_fwd, hipFuncAttributeMaxDynamicSharedMemorySize, LDS_BYTES) != hipSuccess) { fprintf(stderr, "kernel_launch: hipFuncSetAttribute failed\n"); grid = -1; return; }
        int per_cu = 0;
        (void)hipOccupancyMaxActiveBlocksPerMultiprocessor(&per_cu, (const void*)hybrid_fwd, NWAVES * 64, LDS_BYTES);
        (void)hipGetLastError();
        grid = cus > 0 ? cus : 256;
    }
    if (grid < 0) return;
    (void)hipMemsetAsync((char*)d_ws + WS_CTL, 0, CTL_ZERO_BYTES, stream);
    Args a{};
    const float** fp = (const float**)&a;
    for (int i = 0; i < 27; ++i) fp[i] = (const float*)d_in[i];
    a.out = (float*)d_out; a.ws = (unsigned char*)d_ws;
#if MK_PER_PHASE
    for (int p = 0; p < N_PHASES; ++p) { a.ph_lo = p; a.ph_hi = p + 1; hipLaunchKernelGGL(hybrid_fwd, dim3(grid), dim3(NWAVES * 64), LDS_BYTES, stream, a); }
#else
    a.ph_lo = 0; a.ph_hi = N_PHASES;
    hipLaunchKernelGGL(hybrid_fwd, dim3(grid), dim3(NWAVES * 64), LDS_BYTES, stream, a);
#endif
}
```

```cpp
#include <hip/hip_runtime.h>
#include <hip/hip_bf16.h>
#include <cstdio>
#include <cstdint>
#include <cmath>

#ifndef MK_PER_PHASE
#define MK_PER_PHASE 0
#endif

#ifndef REP_ALL
#define REP_ALL 1
#endif
#ifndef REP_0
#define REP_0 REP_ALL
#endif
#ifndef REP_1
#define REP_1 REP_ALL
#endif
#ifndef REP_2A
#define REP_2A REP_ALL
#endif
#ifndef REP_2B
#define REP_2B REP_ALL
#endif
#ifndef REP_3
#define REP_3 REP_ALL
#endif
#ifndef REP_4
#define REP_4 REP_ALL
#endif
#ifndef REP_5
#define REP_5 REP_ALL
#endif
#ifndef REP_6
#define REP_6 REP_ALL
#endif
#ifndef REP_7
#define REP_7 REP_ALL
#endif
#ifndef REP_8
#define REP_8 REP_ALL
#endif
#ifndef REP_9
#define REP_9 REP_ALL
#endif
#ifndef REP_10
#define REP_10 REP_ALL
#endif
#ifndef REP_11
#define REP_11 REP_ALL
#endif
#ifndef REP_12
#define REP_12 REP_ALL
#endif
#define REPLOOP(k) _Pragma("unroll 1") for (int rep_ = 0; rep_ < REP_##k; ++rep_)
#ifndef MK_PROBE
#define MK_PROBE 0
#endif
#ifndef MK_PROBE_K
#define MK_PROBE_K 2
#define MK_PROBE_DIV 10.0f
#endif
#define LAS __attribute__((address_space(3)))
#define GAS __attribute__((address_space(1)))
typedef unsigned short bf16_t;
typedef short bf16x8 __attribute__((ext_vector_type(8)));
typedef float f32x4 __attribute__((ext_vector_type(4)));
typedef float f32x2 __attribute__((ext_vector_type(2)));
typedef unsigned u32x4 __attribute__((ext_vector_type(4)));
typedef unsigned u32x2 __attribute__((ext_vector_type(2)));
typedef __bf16 bf16x2_t __attribute__((ext_vector_type(2)));
#define RLX_AGENT __ATOMIC_RELAXED, __HIP_MEMORY_SCOPE_AGENT

constexpr int NB = 16, SEQ = 4096, NMETA = 16, TT = SEQ + NMETA  , MROWS = NB * TT  , DM = 1024;
constexpr int NREAL = NB * SEQ;
constexpr int NZP = 5632;
constexpr int NZ = 2080;
constexpr int ZMQ = 0, ZMK = 512, ZMV = 1024, ZMO = 1536, ZGA = 2048, ZGM = 3072;
constexpr int ZYC = 0;
constexpr int NIN = 5640;
constexpr int NE = 32, FF = 1024;
constexpr int OROWS = 4352;
constexpr float LN_EPS = 1e-5f;
constexpr float DN_ALPHA = 1.189207115002721f;
constexpr float LAMBDA_INIT = 0.2f;
constexpr float ATT_C2 = 0.125f * 1.4426950408889634f;

constexpr size_t MiB = 1u << 20;
constexpr size_t WS_CTL = 0, CTL_ZERO_BYTES = 32768;
constexpr size_t WS_WIN = 2 * MiB;
constexpr size_t WS_WA = 13 * MiB;
constexpr size_t WS_WM = 14 * MiB;
constexpr size_t WS_WO = 15 * MiB;
constexpr size_t WS_ROPE = 17 * MiB;
constexpr size_t WS_STATS = 19 * MiB;
constexpr size_t WS_GATES = 20 * MiB;
constexpr size_t WS_TOKE = 23 * MiB;
constexpr size_t WS_TOKG = 24 * MiB + 512 * 1024;
constexpr size_t WS_HIST = 26 * MiB;
constexpr size_t WS_ROWOFF = 27 * MiB;
constexpr size_t WS_ROWSLOT = 28 * MiB + 512 * 1024;
constexpr size_t WS_ROWGATE = 30 * MiB;
constexpr size_t WS_TILEEXP = 31 * MiB + 512 * 1024;
constexpr size_t WS_H = 32 * MiB;
constexpr size_t WS_Z = 162 * MiB;
constexpr size_t WS_Y = WS_Z;
constexpr size_t WS_ACT = WS_Z + 516 * MiB;
constexpr size_t WS_GF = 424 * MiB;
constexpr size_t WS_QC = 686 * MiB;
constexpr size_t WS_KC = 751 * MiB;
constexpr size_t WS_VC = 816 * MiB;
constexpr size_t WS_TMP = 686 * MiB;
constexpr size_t WS_MRG = 816 * MiB;
constexpr size_t WS_O = 882 * MiB;
constexpr size_t WS_END = 1024 * MiB;
constexpr size_t DO_WGU = 0;
constexpr size_t DO_WDN = 128 * MiB;
constexpr int CW_TMO = 0, CW_NT = 64, CW_TICKET = 128  , CW_PROBE = 1024, CW_BAR = 4096;

constexpr int LDS_BYTES = 163840;
constexpr int MISC_OFF = 163840 - 512;
constexpr int NWAVES = 8;

__device__ __forceinline__ unsigned pkbf(float lo, float hi) { f32x2 v = {lo, hi}; bf16x2_t b = __builtin_convertvector(v, bf16x2_t); return __builtin_bit_cast(unsigned, b); }
__device__ __forceinline__ float bflo(unsigned w) { return __uint_as_float(w << 16); }
__device__ __forceinline__ float bfhi(unsigned w) { return __uint_as_float(w & 0xffff0000u); }
__device__ __forceinline__ float sigmoidf_(float x) { return __builtin_amdgcn_rcpf(1.0f + __expf(-x)); }
template <int CTRL> __device__ __forceinline__ float dppf(float v) { return __builtin_bit_cast(float, __builtin_amdgcn_update_dpp(0, __builtin_bit_cast(int, v), CTRL, 0xF, 0xF, true)); }
__device__ __forceinline__ float rdlane(float v, int l) { return __builtin_bit_cast(float, __builtin_amdgcn_readlane(__builtin_bit_cast(int, v), l)); }
__device__ __forceinline__ float row_sum16(float v) { v += dppf<0xB1>(v); v += dppf<0x4E>(v); v += dppf<0x141>(v); v += dppf<0x140>(v); return v; }
__device__ __forceinline__ float wave_sum(float v) { v = row_sum16(v); return (rdlane(v, 0) + rdlane(v, 16)) + (rdlane(v, 32) + rdlane(v, 48)); }
__device__ __forceinline__ float wave_max(float v) {
    v = fmaxf(v, dppf<0xB1>(v)); v = fmaxf(v, dppf<0x4E>(v)); v = fmaxf(v, dppf<0x141>(v)); v = fmaxf(v, dppf<0x140>(v));
    return fmaxf(fmaxf(rdlane(v, 0), rdlane(v, 16)), fmaxf(rdlane(v, 32), rdlane(v, 48)));
}
__device__ __forceinline__ float xreduce32(float (&p)[32], int lane) {
    float a[16], b[8], c[4], d[2];
#pragma unroll
    for (int i = 0; i < 16; ++i) { auto r = __builtin_amdgcn_permlane32_swap(__float_as_uint(p[i]), __float_as_uint(p[16 + i]), false, false); a[i] = __uint_as_float(r[0]) + __uint_as_float(r[1]); }
#pragma unroll
    for (int i = 0; i < 8; ++i) { auto r = __builtin_amdgcn_permlane16_swap(__float_as_uint(a[i]), __float_as_uint(a[8 + i]), false, false); b[i] = __uint_as_float(r[0]) + __uint_as_float(r[1]); }
    const bool b3 = (lane & 8) != 0, b2 = (lane & 4) != 0, b1 = (lane & 2) != 0;
#pragma unroll
    for (int i = 0; i < 4; ++i) { const float keep = b3 ? b[4 + i] : b[i], send = b3 ? b[i] : b[4 + i]; c[i] = keep + dppf<0x128>(send); }
#pragma unroll
    for (int i = 0; i < 2; ++i) { const float keep = b2 ? c[2 + i] : c[i], send = b2 ? c[i] : c[2 + i]; d[i] = keep + dppf<0x141>(send); }
    const float keep = b1 ? d[1] : d[0], send = b1 ? d[0] : d[1];
    float r = keep + dppf<0x4E>(send);
    r += dppf<0xB1>(r);
    return r;
}
__device__ __forceinline__ int ld_agent_i(const int* p) { return __hip_atomic_load(p, RLX_AGENT); }
__device__ __forceinline__ float ld_agent_f(const float* p) { return __hip_atomic_load(p, RLX_AGENT); }
#define LDS_WAIT() asm volatile("s_waitcnt lgkmcnt(0)" ::: "memory")
template <int CTRL, int RMASK> __device__ __forceinline__ float dpp_old(float old, float v) { return __builtin_bit_cast(float, __builtin_amdgcn_update_dpp(__builtin_bit_cast(int, old), __builtin_bit_cast(int, v), CTRL, RMASK, 0xF, false)); }
__device__ __forceinline__ float wave_scan_add(float v) {
    v += dpp_old<0x111, 0xF>(0.f, v); v += dpp_old<0x112, 0xF>(0.f, v); v += dpp_old<0x114, 0xF>(0.f, v); v += dpp_old<0x118, 0xF>(0.f, v);
    v += dpp_old<0x142, 0xA>(0.f, v); v += dpp_old<0x143, 0xC>(0.f, v); return v; }
__device__ __forceinline__ float wave_scan_max(float v) {
    const float ninf = -INFINITY;
    v = fmaxf(v, dpp_old<0x111, 0xF>(ninf, v)); v = fmaxf(v, dpp_old<0x112, 0xF>(ninf, v)); v = fmaxf(v, dpp_old<0x114, 0xF>(ninf, v)); v = fmaxf(v, dpp_old<0x118, 0xF>(ninf, v));
    v = fmaxf(v, dpp_old<0x142, 0xA>(ninf, v)); v = fmaxf(v, dpp_old<0x143, 0xC>(ninf, v)); return v; }
__device__ __forceinline__ int row_of(int b, int t) { return (t < NMETA) ? NREAL + b * NMETA + t : b * SEQ + (t - NMETA); }
__device__ __forceinline__ void bt_of(int row, int& b, int& t) { if (row < NREAL) { b = row >> 12; t = (row & (SEQ - 1)) + NMETA; } else { const int m = row - NREAL; b = m >> 4; t = m & (NMETA - 1); } }
__device__ __forceinline__ const void* ldptr(LAS const unsigned long long* t, int i) { const unsigned long long v = t[i];
    const unsigned lo = (unsigned)__builtin_amdgcn_readfirstlane((int)(unsigned)v), hi = (unsigned)__builtin_amdgcn_readfirstlane((int)(unsigned)(v >> 32));
    return (const void*)(const GAS void*)(((unsigned long long)hi << 32) | lo); }

namespace pg8 {
constexpr int BM = 256, BK = 64, HALF = 128, HTB = HALF * BK * 2, STAGE_BYTES = 8 * HTB, NXCD = 8, WGM = 8;
__host__ __device__ __forceinline__ int lds_byte(int r, int c) { const int st = (r >> 4) * 2 + (c >> 5), rr = r & 15, cc = c & 31, ob = rr * 64 + cc * 2; return st * 1024 + (ob ^ (((ob >> 9) & 1) << 5)); }
__host__ __device__ __forceinline__ void stage_rc(int b, int& R, int& C) { const int st = b / 1024, sb = b % 1024, swz = sb ^ (((sb >> 9) & 1) << 5); R = (st >> 1) * 16 + swz / 64; C = (st & 1) * 32 + (swz % 64) / 2; }
__host__ __device__ __forceinline__ int perm32(int rho) { const int n = rho >> 4, i = rho & 15; return 8 * (i >> 2) + 4 * n + (i & 3); }

struct Unit { int pm, pn, e; };
struct Gemm { const bf16_t* A; const bf16_t* Bt; int lda, K, nN; const int* row_off; const int* tile_exp; int pm0; };
struct StaticOrder {
    int nM, nN, nwg, G, c;
    __device__ __forceinline__ void init(int nM_, int nN_, int G_, int c_) { nM = nM_; nN = nN_; nwg = nM * nN; G = G_; c = c_; }
    __device__ __forceinline__ bool next(int i, Unit& u) const {
        const long L = (long)i * G + c; if (L >= nwg) return false;
        int wgid = (int)L; { const int q = nwg / NXCD, r = nwg % NXCD, xcd = wgid % NXCD, off = wgid / NXCD; wgid = (xcd < r ? xcd * (q + 1) : r * (q + 1) + (xcd - r) * q) + off; }
        const int nig = WGM * nN, gid = wgid / nig, fm = gid * WGM, gsz = (nM - fm) < WGM ? (nM - fm) : WGM;
        u.pm = fm + ((wgid % nig) % gsz); u.pn = (wgid % nig) / gsz; u.e = 0; return true;
    }
};

template <int MODE, class Epi, bool MID = false>
__device__ __forceinline__ void gemm_phase(LAS unsigned char* lds, const Gemm g, const StaticOrder& S, const Epi& E) {
    const int tid = threadIdx.x, wid = __builtin_amdgcn_readfirstlane(tid >> 6), lane = tid & 63, wr = wid >> 2, wc = wid & 3, fr = lane & 15, fq = lane >> 4;
    const int K = g.K, nt = K / BK;
    unsigned voffA[2], voffB[2]; int Rst[2], Cst[2];
#pragma unroll
    for (int i = 0; i < 2; ++i) { int R, C; stage_rc(tid * 16 + i * 8192, R, C); const int Rb = Epi::PERM ? ((R & ~31) + perm32(R & 31)) : R;
        voffA[i] = (unsigned)(R * g.lda + C) * 2u; voffB[i] = (unsigned)(Rb * K + C) * 2u; Rst[i] = R; Cst[i] = C * 2; }
    const size_t kstep = (size_t)(BK * 2);
    const size_t hstepA = (size_t)HALF * g.lda * 2, hstepB = (size_t)HALF * K * 2;
    const size_t tstepA = 2 * hstepA, tstepB = 2 * hstepB;
    const unsigned ldsw = (unsigned)wid * 1024u;
    const int aoff = lds_byte(wr * 64 + fr, fq * 8), boff = lds_byte(wc * 32 + fr, fq * 8);
    unsigned vC[2][2] = {{0u, 0u}, {0u, 0u}}, vN[2][2] = {{0u, 0u}, {0u, 0u}};
#define PG8_SA(b, h) (((b) * 2 + (h)) * HTB)
#define PG8_SB(b, h) ((4 + (b) * 2 + (h)) * HTB)
#define PG8_STAGE_B(bufoff, gbase) do { _Pragma("unroll") for (int _i = 0; _i < 2; ++_i) \
        __builtin_amdgcn_global_load_lds((const unsigned*)((const char*)(gbase) + voffB[_i]), (LAS unsigned*)(lds + (bufoff) + ldsw + _i * 8192), 16, 0, 0); } while (0)
#define PG8_STAGE_A(bufoff, gbase, h, nx) do { _Pragma("unroll") for (int _i = 0; _i < 2; ++_i) { \
        const char* _p = (MODE == 1) ? ((const char*)(gbase) + ((nx) ? vN[h][_i] : vC[h][_i])) : ((const char*)(gbase) + (h) * hstepA + voffA[_i]); \
        __builtin_amdgcn_global_load_lds((const unsigned*)_p, (LAS unsigned*)(lds + (bufoff) + ldsw + _i * 8192), 16, 0, 0); } } while (0)
#define PG8_LDA(dst, b, h) do { _Pragma("unroll") for (int m = 0; m < 4; ++m) _Pragma("unroll") for (int k = 0; k < 2; ++k) dst[m][k] = *(const LAS bf16x8*)(lds + PG8_SA(b, h) + aoff + m * 2048 + k * 1024); } while (0)
#define PG8_LDB(dst, b, h) do { _Pragma("unroll") for (int n = 0; n < 2; ++n) _Pragma("unroll") for (int k = 0; k < 2; ++k) dst[n][k] = *(const LAS bf16x8*)(lds + PG8_SB(b, h) + boff + n * 2048 + k * 1024); } while (0)
#define PG8_MMA(ai, bj, At, Bt) do { __builtin_amdgcn_s_setprio(1); _Pragma("unroll") for (int m = 0; m < 4; ++m) _Pragma("unroll") for (int n = 0; n < 2; ++n) _Pragma("unroll") for (int k = 0; k < 2; ++k) \
        acc[ai][bj][m][n] = __builtin_amdgcn_mfma_f32_16x16x32_bf16(Bt[n][k], At[m][k], acc[ai][bj][m][n], 0, 0, 0); __builtin_amdgcn_s_setprio(0); } while (0)
#define PG8_WAIT_V(n) asm volatile("s_waitcnt vmcnt(" #n ")" ::: "memory")
#define PG8_WAIT_L(n) asm volatile("s_waitcnt lgkmcnt(" #n ")" ::: "memory")
#define PG8_BAR __builtin_amdgcn_s_barrier()
#define PG8_SCHED __builtin_amdgcn_sched_barrier(0)
#define PG8_ABASE(u) ((MODE == 1) ? (const char*)g.A : (const char*)g.A + (size_t)(u).pm * tstepA)
#define PG8_BBASE(u) ((MODE == 0) ? (const char*)g.Bt + (size_t)(u).pn * tstepB : (const char*)g.Bt + ((size_t)((u).e = __builtin_amdgcn_readfirstlane(ld_agent_i(g.tile_exp + g.pm0 + (u).pm))) * g.nN + (u).pn) * tstepB)
#define PG8_GATHER(dst, u) do { if (MODE == 1) { _Pragma("unroll") for (int _h = 0; _h < 2; ++_h) _Pragma("unroll") for (int _i = 0; _i < 2; ++_i) \
        dst[_h][_i] = (unsigned)ld_agent_i(g.row_off + (size_t)(g.pm0 + (u).pm) * BM + _h * HALF + Rst[_i]) + (unsigned)Cst[_i]; } } while (0)
    Unit cur, nxt; int ui = 0;
    if (!S.next(0, cur)) return;
    f32x4 acc[2][2][4][2];
#pragma unroll
    for (int a = 0; a < 2; ++a)
#pragma unroll
        for (int b = 0; b < 2; ++b)
#pragma unroll
            for (int m = 0; m < 4; ++m)
#pragma unroll
                for (int n = 0; n < 2; ++n) acc[a][b][m][n] = (f32x4){0.f, 0.f, 0.f, 0.f};
    bf16x8 At[4][2], B0[2][2], B1[2][2];
    const char* cA = PG8_ABASE(cur); const char* cB = PG8_BBASE(cur);
    PG8_GATHER(vC, cur);
    PG8_STAGE_B(PG8_SB(0, 0), cB); PG8_STAGE_B(PG8_SB(0, 1), cB + hstepB); PG8_STAGE_A(PG8_SA(0, 0), cA, 0, false); PG8_STAGE_A(PG8_SA(0, 1), cA, 1, false);
    if (wr == 1) PG8_BAR;
    PG8_WAIT_V(2); PG8_BAR;
    PG8_STAGE_B(PG8_SB(1, 0), cB + kstep); PG8_STAGE_A(PG8_SA(1, 0), cA + kstep, 0, false); PG8_STAGE_B(PG8_SB(1, 1), cB + hstepB + kstep);
    PG8_WAIT_V(6); PG8_BAR;
    for (;;) {
        const bool has_next = S.next(ui + 1, nxt);
        const char* nA = has_next ? PG8_ABASE(nxt) : cA; const char* nB = has_next ? PG8_BBASE(nxt) : cB;
        if (MODE == 1) { if (has_next) { PG8_GATHER(vN, nxt); } else {
#pragma unroll
            for (int _h = 0; _h < 2; ++_h)
#pragma unroll
                for (int _i = 0; _i < 2; ++_i) vN[_h][_i] = vC[_h][_i]; } }
        for (int t = 0; t < nt; t += 2) {
            if constexpr (MID) { if (t == nt / 2) { if (wr == 0) PG8_BAR; E.mid(acc, cur, wr, wc, fr, fq); if (wr == 1) PG8_BAR; } }
            const bool last = (t == nt - 2);
            const char* a1 = cA + (size_t)(t + 1) * kstep;
            const char* a2 = last ? nA : cA + (size_t)(t + 2) * kstep; const char* b2 = last ? nB : cB + (size_t)(t + 2) * kstep;
            const char* a3 = a2 + kstep; const char* b3 = b2 + kstep;
            PG8_LDB(B0, 0, 0); PG8_LDB(B1, 0, 1); PG8_SCHED; PG8_LDA(At, 0, 0); PG8_STAGE_A(PG8_SA(1, 1), a1, 1, false);
            PG8_WAIT_V(8); PG8_WAIT_L(0); PG8_BAR; PG8_MMA(0, 0, At, B0); PG8_MMA(0, 1, At, B1); PG8_BAR; PG8_SCHED;
            PG8_LDA(At, 0, 1); PG8_STAGE_B(PG8_SB(0, 0), b2); PG8_STAGE_B(PG8_SB(0, 1), b2 + hstepB); PG8_STAGE_A(PG8_SA(0, 0), a2, 0, last);
            PG8_WAIT_V(8); PG8_WAIT_L(0); PG8_BAR; PG8_MMA(1, 0, At, B0); PG8_MMA(1, 1, At, B1); PG8_BAR; PG8_SCHED;
            PG8_LDB(B0, 1, 0); PG8_LDB(B1, 1, 1); PG8_SCHED; PG8_LDA(At, 1, 0); PG8_STAGE_A(PG8_SA(0, 1), a2, 1, last);
            PG8_WAIT_V(8); PG8_WAIT_L(0); PG8_BAR; PG8_MMA(0, 0, At, B0); PG8_MMA(0, 1, At, B1); PG8_BAR; PG8_SCHED;
            PG8_LDA(At, 1, 1); PG8_STAGE_B(PG8_SB(1, 0), b3); PG8_STAGE_B(PG8_SB(1, 1), b3 + hstepB); PG8_STAGE_A(PG8_SA(1, 0), a3, 0, last);
            PG8_WAIT_V(8); PG8_WAIT_L(0); PG8_BAR; PG8_MMA(1, 0, At, B0); PG8_MMA(1, 1, At, B1); PG8_BAR; PG8_SCHED;
        }
        if (wr == 0) PG8_BAR;
        E(acc, cur, wr, wc, fr, fq);
        if (!has_next) break;
#pragma unroll
        for (int a = 0; a < 2; ++a)
#pragma unroll
            for (int b = 0; b < 2; ++b)
#pragma unroll
                for (int m = 0; m < 4; ++m)
#pragma unroll
                    for (int n = 0; n < 2; ++n) acc[a][b][m][n] = (f32x4){0.f, 0.f, 0.f, 0.f};
        cur = nxt; cA = nA; cB = nB; ++ui;
        if (MODE == 1) {
#pragma unroll
            for (int _h = 0; _h < 2; ++_h)
#pragma unroll
                for (int _i = 0; _i < 2; ++_i) vC[_h][_i] = vN[_h][_i]; }
        if (wr == 1) PG8_BAR;
    }
    PG8_WAIT_V(0);
    PG8_BAR;
#undef PG8_SA
#undef PG8_SB
#undef PG8_STAGE_A
#undef PG8_STAGE_B
#undef PG8_LDA
#undef PG8_LDB
#undef PG8_MMA
#undef PG8_WAIT_V
#undef PG8_WAIT_L
#undef PG8_BAR
#undef PG8_SCHED
#undef PG8_ABASE
#undef PG8_BBASE
#undef PG8_GATHER
}

struct EpiZ {
    static constexpr bool PERM = true;
    bf16_t* Z; bf16_t* Qc; bf16_t* Kc; bf16_t* Vc; const float* ropec; const float* ropes; bf16_t* GF;
    __device__ __forceinline__ void operator()(const f32x4 (&acc)[2][2][4][2], const Unit& u, int wr, int wc, int fr, int fq) const {
        const int row0 = u.pm * BM + wr * 64 + fr;
        if (u.pn < 4) {
            const float sc = (u.pn < 2) ? ATT_C2 : 1.0f;
            bf16_t* base = (u.pn < 2) ? Qc : Kc;
            const int dl = 16 * (wc & 1) + 4 * fq;
#pragma unroll
            for (int ai = 0; ai < 2; ++ai)
#pragma unroll
                for (int m = 0; m < 4; ++m) {
                    const int row = row0 + ai * HALF + m * 16; int b, t; bt_of(row, b, t);
                    const f32x4 c = *(const f32x4*)(ropec + t * 32 + dl) * sc, s = *(const f32x4*)(ropes + t * 32 + dl) * sc;
#pragma unroll
                    for (int bj = 0; bj < 2; ++bj) {
                        const int hm = 4 * (u.pn & 1) + 2 * bj + (wc >> 1);
                        const f32x4 x1 = acc[ai][bj][m][0], x2 = acc[ai][bj][m][1];
                        const f32x4 o1 = x1 * c - x2 * s, o2 = x2 * c + x1 * s;
                        bf16_t* p = base + ((size_t)(b * 8 + hm) * TT + t) * 64 + dl;
                        u32x2 w1, w2; w1.x = pkbf(o1[0], o1[1]); w1.y = pkbf(o1[2], o1[3]); w2.x = pkbf(o2[0], o2[1]); w2.y = pkbf(o2[2], o2[3]);
                        *(u32x2*)p = w1; *(u32x2*)(p + 32) = w2;
                    }
                }
        } else if (u.pn < 6) {
            const int e0 = wc * 32 + 8 * fq;
#pragma unroll
            for (int ai = 0; ai < 2; ++ai)
#pragma unroll
                for (int m = 0; m < 4; ++m) {
                    const int row = row0 + ai * HALF + m * 16; int b, t; bt_of(row, b, t);
#pragma unroll
                    for (int bj = 0; bj < 2; ++bj) { const int h = (u.pn - 4) * 2 + bj; const f32x4 v0 = acc[ai][bj][m][0], v1 = acc[ai][bj][m][1];
                        u32x4 w; w.x = pkbf(v0[0], v0[1]); w.y = pkbf(v0[2], v0[3]); w.z = pkbf(v1[0], v1[1]); w.w = pkbf(v1[2], v1[3]);
                        *(u32x4*)(Vc + ((size_t)(b * 4 + h) * TT + t) * 128 + e0) = w; }
                }
        } else if (u.pn < 14) {
            const int col0 = (u.pn - 6) * BM + wc * 32 + 8 * fq;
#pragma unroll
            for (int ai = 0; ai < 2; ++ai)
#pragma unroll
                for (int m = 0; m < 4; ++m) {
                    bf16_t* rowp = Z + (size_t)(row0 + ai * HALF + m * 16) * NZ + col0;
#pragma unroll
                    for (int bj = 0; bj < 2; ++bj) { const f32x4 v0 = acc[ai][bj][m][0], v1 = acc[ai][bj][m][1];
                        u32x4 w; w.x = pkbf(v0[0], v0[1]); w.y = pkbf(v0[2], v0[3]); w.z = pkbf(v1[0], v1[1]); w.w = pkbf(v1[2], v1[3]);
                        *(u32x4*)(rowp + bj * HALF) = w; }
                }
        } else if (u.pm < NREAL / BM) {
            const int gi = (u.pn - 14) >> 2, pn4 = (u.pn - 14) & 3;
            u32x4* gp = (u32x4*)GF + ((((size_t)(gi * (NREAL / BM) + u.pm) * 4 + pn4) * 8 + (wr * 4 + wc)) * 16) * 64 + (fq * 16 + fr);
#pragma unroll
            for (int ai = 0; ai < 2; ++ai)
#pragma unroll
                for (int bj = 0; bj < 2; ++bj)
#pragma unroll
                    for (int m = 0; m < 4; ++m) { const f32x4 v0 = acc[ai][bj][m][0], v1 = acc[ai][bj][m][1];
                        u32x4 w; w.x = pkbf(sigmoidf_(v0[0]), sigmoidf_(v0[1])); w.y = pkbf(sigmoidf_(v0[2]), sigmoidf_(v0[3])); w.z = pkbf(sigmoidf_(v1[0]), sigmoidf_(v1[1])); w.w = pkbf(sigmoidf_(v1[2]), sigmoidf_(v1[3]));
                        gp[((ai * 2 + bj) * 4 + m) * 64] = w; }
        }
    }
};
template <bool SECOND> struct EpiGate {
    static constexpr bool PERM = true;
    bf16_t* Z; bf16_t* TMP; bf16_t* MRG;
    __device__ __forceinline__ void operator()(const f32x4 (&acc)[2][2][4][2], const Unit& u, int wr, int wc, int fr, int fq) const {
        const int row0 = u.pm * BM + wr * 64 + fr, col0 = u.pn * BM + wc * 32 + 8 * fq;
#pragma unroll
        for (int ai = 0; ai < 2; ++ai)
#pragma unroll
            for (int m = 0; m < 4; ++m) {
                bf16_t* rowp = Z + (size_t)(row0 + ai * HALF + m * 16) * NZ + col0; bf16_t* tmpp = TMP + (size_t)(row0 + ai * HALF + m * 16) * DM + col0; bf16_t* mrgp = MRG + (size_t)(row0 + ai * HALF + m * 16) * DM + col0;
#pragma unroll
                for (int bj = 0; bj < 2; ++bj) {
                    const u32x4 gw = *(const u32x4*)(rowp + (SECOND ? ZGM : ZGA) + bj * HALF);
                    const f32x4 v0 = acc[ai][bj][m][0], v1 = acc[ai][bj][m][1];
                    float o[8];
                    o[0] = sigmoidf_(bflo(gw.x)) * v0[0]; o[1] = sigmoidf_(bfhi(gw.x)) * v0[1]; o[2] = sigmoidf_(bflo(gw.y)) * v0[2]; o[3] = sigmoidf_(bfhi(gw.y)) * v0[3];
                    o[4] = sigmoidf_(bflo(gw.z)) * v1[0]; o[5] = sigmoidf_(bfhi(gw.z)) * v1[1]; o[6] = sigmoidf_(bflo(gw.w)) * v1[2]; o[7] = sigmoidf_(bfhi(gw.w)) * v1[3];
                    if (SECOND) { const u32x4 tw = *(const u32x4*)(tmpp + bj * HALF);
                        o[0] += bflo(tw.x); o[1] += bfhi(tw.x); o[2] += bflo(tw.y); o[3] += bfhi(tw.y); o[4] += bflo(tw.z); o[5] += bfhi(tw.z); o[6] += bflo(tw.w); o[7] += bfhi(tw.w); }
                    u32x4 w; w.x = pkbf(o[0], o[1]); w.y = pkbf(o[2], o[3]); w.z = pkbf(o[4], o[5]); w.w = pkbf(o[6], o[7]);
                    if (SECOND) *(u32x4*)(mrgp + bj * HALF) = w; else *(u32x4*)(tmpp + bj * HALF) = w;
                }
            }
    }
};
struct EpiGateFused {
    static constexpr bool PERM = true;
    const bf16_t* GF; bf16_t* MRG;
    __device__ __forceinline__ void mid(f32x4 (&acc)[2][2][4][2], const Unit& u, int wr, int wc, int fr, int fq) const {
        asm volatile("" : "+v"(fr), "+v"(fq));
        const u32x4* ga = (const u32x4*)GF + ((((size_t)u.pm * 4 + u.pn) * 8 + (wr * 4 + wc)) * 16) * 64 + (fq * 16 + fr);
        const u32x4* gm = ga + (size_t)(NREAL / BM) * 4 * 8 * 16 * 64;
#pragma unroll
        for (int q = 0; q < 16; ++q) {
            const int ai = q >> 3, bj = (q >> 2) & 1, m = q & 3;
            const u32x4 a = ga[q * 64], b = gm[q * 64];
            float r[8];
#define EG_R(a_, m_) ((a_) * __builtin_amdgcn_rcpf(m_))
            r[0] = EG_R(bflo(a.x), bflo(b.x)); r[1] = EG_R(bfhi(a.x), bfhi(b.x)); r[2] = EG_R(bflo(a.y), bflo(b.y)); r[3] = EG_R(bfhi(a.y), bfhi(b.y));
            r[4] = EG_R(bflo(a.z), bflo(b.z)); r[5] = EG_R(bfhi(a.z), bfhi(b.z)); r[6] = EG_R(bflo(a.w), bflo(b.w)); r[7] = EG_R(bfhi(a.w), bfhi(b.w));
#undef EG_R
            acc[ai][bj][m][0] = acc[ai][bj][m][0] * (f32x4){r[0], r[1], r[2], r[3]}; acc[ai][bj][m][1] = acc[ai][bj][m][1] * (f32x4){r[4], r[5], r[6], r[7]};
            asm volatile("" : "+v"(acc[ai][bj][m][0]), "+v"(acc[ai][bj][m][1]));
            if ((q & 7) == 7) asm volatile("" ::: "memory");
        }
    }
    __device__ __forceinline__ void operator()(const f32x4 (&acc)[2][2][4][2], const Unit& u, int wr, int wc, int fr, int fq) const {
        const int row0 = u.pm * BM + wr * 64 + fr, col0 = u.pn * BM + wc * 32 + 8 * fq;
        const u32x4* gm = (const u32x4*)GF + (size_t)(NREAL / BM) * 4 * 8 * 16 * 64 + ((((size_t)u.pm * 4 + u.pn) * 8 + (wr * 4 + wc)) * 16) * 64 + (fq * 16 + fr);
#pragma unroll
        for (int ai = 0; ai < 2; ++ai)
#pragma unroll
            for (int m = 0; m < 4; ++m) {
                bf16_t* mrgp = MRG + (size_t)(row0 + ai * HALF + m * 16) * DM + col0;
#pragma unroll
                for (int bj = 0; bj < 2; ++bj) {
                    const u32x4 g = gm[((ai * 2 + bj) * 4 + m) * 64];
                    const f32x4 v0 = acc[ai][bj][m][0], v1 = acc[ai][bj][m][1];
                    u32x4 w; w.x = pkbf(bflo(g.x) * v0[0], bfhi(g.x) * v0[1]); w.y = pkbf(bflo(g.y) * v0[2], bfhi(g.y) * v0[3]);
                    w.z = pkbf(bflo(g.z) * v1[0], bfhi(g.z) * v1[1]); w.w = pkbf(bflo(g.w) * v1[2], bfhi(g.w) * v1[3]);
                    *(u32x4*)(mrgp + bj * HALF) = w;
                }
            }
    }
};
struct EpiStoreBf16 {
    static constexpr bool PERM = true;
    bf16_t* O; int ldc;
    __device__ __forceinline__ void operator()(const f32x4 (&acc)[2][2][4][2], const Unit& u, int wr, int wc, int fr, int fq) const {
        const int row0 = u.pm * BM + wr * 64 + fr, col0 = u.pn * BM + wc * 32 + 8 * fq;
#pragma unroll
        for (int ai = 0; ai < 2; ++ai)
#pragma unroll
            for (int m = 0; m < 4; ++m) { bf16_t* rowp = O + (size_t)(row0 + ai * HALF + m * 16) * ldc + col0;
#pragma unroll
                for (int bj = 0; bj < 2; ++bj) { const f32x4 v0 = acc[ai][bj][m][0], v1 = acc[ai][bj][m][1];
                    u32x4 w; w.x = pkbf(v0[0], v0[1]); w.y = pkbf(v0[2], v0[3]); w.z = pkbf(v1[0], v1[1]); w.w = pkbf(v1[2], v1[3]);
                    *(u32x4*)(rowp + bj * HALF) = w; } }
    }
};
struct EpiPre1 {
    static constexpr bool PERM = false;
    float* P1; const float* x; const float* meta; const float* stats; const float* g0; const float* b0;
    __device__ __forceinline__ void operator()(const f32x4 (&acc)[2][2][4][2], const Unit& u, int wr, int wc, int fr, int fq) const {
        const int row0 = u.pm * BM + wr * 64 + fr, col0 = u.pn * BM + wc * 32 + 4 * fq;
        f32x4 gv[2][2], bv[2][2];
#pragma unroll
        for (int bj = 0; bj < 2; ++bj)
#pragma unroll
            for (int n = 0; n < 2; ++n) { gv[bj][n] = *(const f32x4*)(g0 + col0 + bj * HALF + n * 16); bv[bj][n] = *(const f32x4*)(b0 + col0 + bj * HALF + n * 16); }
#pragma unroll
        for (int ai = 0; ai < 2; ++ai)
#pragma unroll
            for (int m = 0; m < 4; ++m) {
                const int row = row0 + ai * HALF + m * 16;
                const float* xr = x + (size_t)row * DM;
                const float mean = ld_agent_f(stats + 2 * row), rstd = ld_agent_f(stats + 2 * row + 1);
                float* orow = P1 + (size_t)row * (NZ / 2) + col0;
#pragma unroll
                for (int bj = 0; bj < 2; ++bj)
#pragma unroll
                    for (int n = 0; n < 2; ++n) { const f32x4 xv = *(const f32x4*)(xr + col0 + bj * HALF + n * 16);
                        const f32x4 hv = (xv - mean) * rstd * gv[bj][n] + bv[bj][n];
                        *(f32x4*)(orow + bj * HALF + n * 16) = hv * DN_ALPHA + acc[ai][bj][m][n]; }
            }
    }
};
struct EpiAct {
    static constexpr bool PERM = true;
    bf16_t* ACT; const float* b_gu; const int* tile_exp; int pm0;
    __device__ __forceinline__ void operator()(const f32x4 (&acc)[2][2][4][2], const Unit& u, int wr, int wc, int fr, int fq) const {
        const int e = u.e;
        const int ac0 = u.pn * HALF + wc * 32 + 8 * fq;
        const float* bp = b_gu + (size_t)e * 2 * FF + 2 * ac0;
        float bg[8], bl[8];
#pragma unroll
        for (int q = 0; q < 4; ++q) { const f32x4 v = *(const f32x4*)(bp + 4 * q); bg[2 * q] = v[0]; bl[2 * q] = v[1]; bg[2 * q + 1] = v[2]; bl[2 * q + 1] = v[3]; }
        const int row0 = u.pm * BM + wr * 64 + fr;
#pragma unroll
        for (int ai = 0; ai < 2; ++ai)
#pragma unroll
            for (int m = 0; m < 4; ++m) {
                float o[8];
#pragma unroll
                for (int j = 0; j < 8; ++j) {
                    float gl = acc[ai][0][m][j >> 2][j & 3] + bg[j], li = acc[ai][1][m][j >> 2][j & 3] + bl[j];
                    gl = fminf(gl, 7.0f); li = fminf(fmaxf(li, -7.0f), 7.0f);
                    o[j] = gl * sigmoidf_(1.702f * gl) * (li + 1.0f);
                }
                u32x4 w; w.x = pkbf(o[0], o[1]); w.y = pkbf(o[2], o[3]); w.z = pkbf(o[4], o[5]); w.w = pkbf(o[6], o[7]);
                *(u32x4*)(ACT + (size_t)(row0 + ai * HALF + m * 16) * FF + ac0) = w;
            }
    }
};
struct EpiDown {
    static constexpr bool PERM = true;
    bf16_t* Y; const float* b_down; const int* tile_exp; const int* row_slot; const float* row_gate; int pm0;
    __device__ __forceinline__ void operator()(const f32x4 (&acc)[2][2][4][2], const Unit& u, int wr, int wc, int fr, int fq) const {
        const int e = u.e;
        const int col0 = u.pn * BM + wc * 32 + 8 * fq;
        f32x4 bv[2][2];
#pragma unroll
        for (int bj = 0; bj < 2; ++bj)
#pragma unroll
            for (int n = 0; n < 2; ++n) bv[bj][n] = *(const f32x4*)(b_down + (size_t)e * DM + col0 + bj * HALF + 4 * n);
        const int r0 = (pm0 + u.pm) * BM + wr * 64 + fr;
#pragma unroll
        for (int ai = 0; ai < 2; ++ai)
#pragma unroll
            for (int m = 0; m < 4; ++m) {
                const int r = r0 + ai * HALF + m * 16;
                const int slot = row_slot[r]; const float gt = row_gate[r];
                bf16_t* rowp = Y + (size_t)slot * DM + col0;
#pragma unroll
                for (int bj = 0; bj < 2; ++bj) { const f32x4 v0 = (acc[ai][bj][m][0] + bv[bj][0]) * gt, v1 = (acc[ai][bj][m][1] + bv[bj][1]) * gt;
                    u32x4 w; w.x = pkbf(v0[0], v0[1]); w.y = pkbf(v0[2], v0[3]); w.z = pkbf(v1[0], v1[1]); w.w = pkbf(v1[2], v1[3]);
                    *(u32x4*)(rowp + bj * HALF) = w; }
            }
    }
};
}

namespace attn_body {
using bf16 = __hip_bfloat16;
using s16x4 = __attribute__((ext_vector_type(4))) short;
using f32x16 = __attribute__((ext_vector_type(16))) float;
constexpr int D = 64, PZ = 64, PV = 128, PO = 1024;
constexpr int NW = 8, QBLK = 32, QB = QBLK * NW, KVBLK = 64;
__device__ __forceinline__ int crow(int r, int hi) { return (r & 3) + 8 * (r >> 2) + 4 * hi; }
#define SBAR() __builtin_amdgcn_sched_barrier(0)
__device__ __forceinline__ void cmask(f32x16& p0, f32x16& p1, int jb, int qrel, int hi) {
    const float NEG = -INFINITY; const int d = qrel - 64 * jb - 4 * hi;
#pragma unroll
    for (int r = 0; r < 16; ++r) { const int c = (r & 3) + 8 * (r >> 2); if (c > d) p0[r] = NEG; if (c + 32 > d) p1[r] = NEG; }
}
constexpr int NSLOT = 3, SLOTB = 8192;
constexpr int LDS_K = 0, LDS_V = NSLOT * SLOTB, LDS_WS = 2 * NSLOT * SLOTB, LDS_OST = LDS_WS + NW * 64 * 4, LDS_BYTES_A = LDS_OST + NW * 4096;
__device__ __forceinline__ void glds16(const void* gsrc, unsigned lds_dst) { unsigned keep;
    asm volatile("s_mov_b32 %0, m0\n\ts_mov_b32 m0, %2\n\ts_nop 0\n\tglobal_load_lds_dwordx4 %1, off\n\ts_mov_b32 m0, %0" : "=&s"(keep) : "v"(gsrc), "s"(lds_dst) : "memory"); }
__device__ __forceinline__ float max3f(float a, float b, float c) { float r; asm("v_max3_f32 %0, %1, %2, %3" : "=v"(r) : "v"(a), "v"(b), "v"(c)); return r; }
__device__ __forceinline__ float max2f(float a, float b) { float r; asm("v_max_f32_e32 %0, %1, %2" : "=v"(r) : "v"(a), "v"(b)); return r; }
__device__ __forceinline__ float fadd_s(float a, float b) { float r; asm("v_add_f32_e32 %0, %1, %2" : "=v"(r) : "v"(a), "v"(b)); return r; }
__device__ __forceinline__ float fsub_s(float a, float b) { float r; asm("v_sub_f32_e32 %0, %1, %2" : "=v"(r) : "v"(a), "v"(b)); return r; }
__device__ __forceinline__ unsigned cvtpk_s(float lo, float hi) { return pkbf(lo, hi); }
#define WAIT_BAR(N) asm volatile("s_waitcnt vmcnt(" #N ") lgkmcnt(0)\n\ts_barrier" ::: "memory")
__device__ __forceinline__ void qkt(f32x16& p0, f32x16& p1, const char* Kslot, const bf16x8* qr, const f32x16& negm, int r32, int hi) {
    const char* kb = Kslot + hi * 1024 + r32 * 16;
#pragma unroll
    for (int d0 = 0; d0 < 4; ++d0) {
        const bf16x8 b0 = *reinterpret_cast<const bf16x8*>(kb + d0 * 2048);
        const bf16x8 b1 = *reinterpret_cast<const bf16x8*>(kb + d0 * 2048 + 512);
        if (d0 == 0) { p0 = __builtin_amdgcn_mfma_f32_32x32x16_bf16(b0, qr[0], negm, 0, 0, 0); p1 = __builtin_amdgcn_mfma_f32_32x32x16_bf16(b1, qr[0], negm, 0, 0, 0); }
        else { p0 = __builtin_amdgcn_mfma_f32_32x32x16_bf16(b0, qr[d0], p0, 0, 0, 0); p1 = __builtin_amdgcn_mfma_f32_32x32x16_bf16(b1, qr[d0], p1, 0, 0, 0); } }
}
typedef __attribute__((address_space(3))) const char* lds_cptr;
typedef short v4i16_t __attribute__((ext_vector_type(4)));
__device__ __forceinline__ void kload8(bf16x8* kf, lds_cptr kp) {
    kf[0] = *(const __attribute__((address_space(3))) bf16x8*)(kp);        kf[1] = *(const __attribute__((address_space(3))) bf16x8*)(kp + 512);
    kf[2] = *(const __attribute__((address_space(3))) bf16x8*)(kp + 2048); kf[3] = *(const __attribute__((address_space(3))) bf16x8*)(kp + 2560);
    kf[4] = *(const __attribute__((address_space(3))) bf16x8*)(kp + 4096); kf[5] = *(const __attribute__((address_space(3))) bf16x8*)(kp + 4608);
    kf[6] = *(const __attribute__((address_space(3))) bf16x8*)(kp + 6144); kf[7] = *(const __attribute__((address_space(3))) bf16x8*)(kp + 6656);
}
__device__ __forceinline__ void kload2(bf16x8* kf, lds_cptr kp, int j) { kf[2 * j] = *(const __attribute__((address_space(3))) bf16x8*)(kp + j * 2048); kf[2 * j + 1] = *(const __attribute__((address_space(3))) bf16x8*)(kp + j * 2048 + 512); }
__device__ __forceinline__ s16x4 vtr(lds_cptr p) { return __builtin_bit_cast(s16x4, __builtin_amdgcn_ds_read_tr16_b64_v4i16((__attribute__((address_space(3))) v4i16_t*)p)); }
__device__ __forceinline__ float rowmax(const f32x16& p0, const f32x16& p1) {
    float a = max3f(p0[0], p0[1], p1[0]), b = max3f(p0[2], p0[3], p1[1]); a = max3f(a, p1[2], p1[3]);
#pragma unroll
    for (int r = 4; r < 16; r += 4) { a = max3f(a, p0[r], p0[r + 1]); b = max3f(b, p0[r + 2], p0[r + 3]); a = max3f(a, p1[r], p1[r + 1]); b = max3f(b, p1[r + 2], p1[r + 3]); }
    const float m = max2f(a, b);
    auto rr = __builtin_amdgcn_permlane32_swap(__float_as_uint(m), __float_as_uint(m), false, false);
    return max2f(__uint_as_float(rr[0]), __uint_as_float(rr[1]));
}
__device__ __forceinline__ void pv(f32x16* o, int vb, bf16x8 pa0, bf16x8 pa1, bf16x8 pa2, bf16x8 pa3) {
#pragma unroll
    for (int d0 = 0; d0 < 2; ++d0) { s16x4 lo[4], hi[4];
#pragma unroll
        for (int ks = 0; ks < 4; ++ks) {
            asm volatile("ds_read_b64_tr_b16 %0,%1 offset:%c2" : "=&v"(lo[ks]) : "v"(vb), "i"(d0 * 4096 + ks * 1024) : "memory");
            asm volatile("ds_read_b64_tr_b16 %0,%1 offset:%c2" : "=&v"(hi[ks]) : "v"(vb), "i"(d0 * 4096 + ks * 1024 + 512) : "memory"); }
        asm volatile("s_waitcnt lgkmcnt(0)" ::: "memory"); SBAR();
#define PK(k) (bf16x8){lo[k][0], lo[k][1], lo[k][2], lo[k][3], hi[k][0], hi[k][1], hi[k][2], hi[k][3]}
        o[d0] = __builtin_amdgcn_mfma_f32_32x32x16_bf16(pa0, PK(0), o[d0], 0, 0, 0);
        o[d0] = __builtin_amdgcn_mfma_f32_32x32x16_bf16(pa1, PK(1), o[d0], 0, 0, 0);
        o[d0] = __builtin_amdgcn_mfma_f32_32x32x16_bf16(pa2, PK(2), o[d0], 0, 0, 0);
        o[d0] = __builtin_amdgcn_mfma_f32_32x32x16_bf16(pa3, PK(3), o[d0], 0, 0, 0);
#undef PK
    }
}
#define ATTN_STORE16(p, v) (*(u32x4*)(p) = (v))
template <int THRL> __device__ __forceinline__ void attn_unit(int qb, const bf16* Qh, const bf16* __restrict__ Kh, const bf16* __restrict__ Vh, bf16* Oh, char* shm) {
    const int tid = threadIdx.x; int lane = tid & 63; asm volatile("" : "+v"(lane));
    const int r32 = lane & 31, hi = lane >> 5; const int wid = __builtin_amdgcn_readfirstlane(tid >> 6);
    const int q0 = qb * QB;
    const bf16* Qw = Qh + (long)(q0 + wid * QBLK) * PZ;
    const unsigned lds0 = (unsigned)(uintptr_t)shm;
    float* wsf = (float*)(shm + LDS_WS) + wid * 64;
    const bf16* ksrc = Kh + (long)lane * PZ + wid * 8;
    const bf16* vsrc = Vh + (long)(16 * (wid & 3) + (lane >> 2)) * PV + (wid >> 2) * 32 + (lane & 3) * 8;
    const unsigned kdst = lds0 + LDS_K + wid * 1024, vdst = lds0 + LDS_V + wid * 1024;
#define DMA_K(t, slot) glds16(ksrc + (long)(t) * KVBLK * PZ, (unsigned)__builtin_amdgcn_readfirstlane(kdst + (slot)))
#define DMA_V(t, slot) glds16(vsrc + (long)(t) * KVBLK * PV, (unsigned)__builtin_amdgcn_readfirstlane(vdst + (slot)))
    const int vb0 = (int)(lds0 + LDS_V) + ((lane >> 4) & 1) * 32 + (lane & 3) * 8 + (4 * hi + ((lane & 15) >> 2)) * 64;
    const char* Kbase = shm + LDS_K; bf16x8 kf[8];
    const lds_cptr shm3 = (lds_cptr)shm; const lds_cptr kp0 = shm3 + LDS_K + hi * 1024 + r32 * 16; const lds_cptr vp0 = shm3 + LDS_V + ((lane >> 4) & 1) * 32 + (lane & 3) * 8 + (4 * hi + ((lane & 15) >> 2)) * 64;
    const int NT = (q0 + QB) / KVBLK;
    DMA_K(0, 0); DMA_V(0, 0); DMA_K(1, SLOTB);
    bf16x8 qr[4];
#pragma unroll
    for (int d0 = 0; d0 < 4; ++d0) qr[d0] = *reinterpret_cast<const bf16x8*>(&Qw[(long)r32 * PZ + d0 * 16 + hi * 8]);
    float mhat = 0.f, l_reg = 0.f; f32x16 o[2]; o[0] = f32x16{}; o[1] = f32x16{}; f32x16 negm = f32x16{}; asm volatile("" : "+v"(negm));
    const int qrel = wid * QBLK + r32;
#define CMASK(P0, P1, t) do { int jb_ = (t) - (NT - 4); if (jb_ >= 0) cmask(P0, P1, jb_, qrel, hi); } while (0)
    bool resc = false;
#define START(P0, P1) do { const float rm = rowmax(P0, P1); resc = false; \
    { const float dl = rm; mhat = fadd_s(mhat, dl); \
      _Pragma("unroll") for (int r = 0; r < 16; ++r) { P0[r] = fsub_s(P0[r], dl); P1[r] = fsub_s(P1[r], dl); } \
      _Pragma("unroll") for (int r = 0; r < 16; ++r) negm[r] = -mhat; asm volatile("" : "+v"(negm)); } \
    _Pragma("unroll") for (int r = 0; r < 16; ++r) P0[r] = __builtin_amdgcn_exp2f(P0[r]); } while (0)
#define RESC() do { if (resc) { asm volatile("s_waitcnt lgkmcnt(0)" ::: "memory"); \
      _Pragma("unroll") for (int d_ = 0; d_ < 2; ++d_) _Pragma("unroll") for (int r = 0; r < 16; ++r) o[d_][r] *= wsf[crow(r, hi)]; } } while (0)
    f32x16 pA0, pA1, pB0, pB1;
    int sl_prev = 0, sl_cur = 0, sl_next = SLOTB;
#define ROT() do { sl_prev = sl_cur; sl_cur = sl_next; sl_next = (sl_next == (NSLOT - 1) * SLOTB) ? 0 : sl_next + SLOTB; } while (0)
    DMA_K(2, 2 * SLOTB);
    WAIT_BAR(3);
    qkt(pA0, pA1, Kbase, qr, negm, r32, hi); asm volatile("s_nop 15\n\ts_nop 7" : "+v"(pA0), "+v"(pA1)); CMASK(pA0, pA1, 0);
    START(pA0, pA1);
    _Pragma("unroll") for (int r = 0; r < 16; ++r) pA1[r] = __builtin_amdgcn_exp2f(pA1[r]);
    WAIT_BAR(0);
    DMA_K(3, 0); DMA_V(1, SLOTB);
    ROT();
    kload8(kf, kp0 + sl_cur);
    WAIT_BAR(2);
    s16x4 vlo[8], vhi[8]; u32x4 pw0, pw1, pw2, pw3;
#define PKW(P, B) cvtpk_s(P[B], P[B + 1])
#define PAF(k) __builtin_bit_cast(bf16x8, pw##k)
#define VFR(i) (bf16x8){vlo[i][0], vlo[i][1], vlo[i][2], vlo[i][3], vhi[i][0], vhi[i][1], vhi[i][2], vhi[i][3]}
#define PIN(x) asm volatile("" : "+v"(x))
#define MX3(a, b, c) __builtin_fmaxf(__builtin_fmaxf((a), (b)), (c))
#define GAPA(MF, A0, A1, A2, A3, W0, W1, PW) do { MF; sacc += A0; sacc += A1; sacc += A2; sacc += A3; PIN(sacc); W0; W1; PIN(PW); SBAR(); } while (0)
#define EX(v) __builtin_amdgcn_exp2f(v)
#define GAPB(MF, X, B) do { MF; X[B] = EX(X[B]); X[B + 1] = EX(X[B + 1]); X[B + 2] = EX(X[B + 2]); X[B + 3] = EX(X[B + 3]); PIN(X); SBAR(); } while (0)
#define VRD(i) do { vlo[i] = vtr(vp_ + (((i) >> 2) * 4096 + ((i) & 3) * 1024)); vhi[i] = vtr(vp_ + (((i) >> 2) * 4096 + ((i) & 3) * 1024 + 512)); } while (0)
#define KRD(G, j) do { if (G) { kload2(kf, kp0 + sl_next, j); SBAR(); } } while (0)
#define STEP(C0, C1, P0, P1, t, GK, GV, GL) do { SBAR(); \
    const lds_cptr vp_ = vp0 + sl_prev; \
    VRD(0); SBAR(); float sacc = (P0[0] + P0[1]); \
    GAPA(C0 = __builtin_amdgcn_mfma_f32_32x32x16_bf16(kf[0], qr[0], negm, 0, 0, 0), P0[2], P0[3], P0[4], P0[5],     pw0[0] = PKW(P0, 0), pw0[1] = PKW(P0, 2), pw0); \
    VRD(4); SBAR(); GAPA(C1 = __builtin_amdgcn_mfma_f32_32x32x16_bf16(kf[1], qr[0], negm, 0, 0, 0), P0[6], P0[7], P0[8], P0[9],     pw0[2] = PKW(P0, 4), pw0[3] = PKW(P0, 6), pw0); \
    VRD(1); SBAR(); GAPA(C0 = __builtin_amdgcn_mfma_f32_32x32x16_bf16(kf[2], qr[1], C0, 0, 0, 0),   P0[10], P0[11], P0[12], P0[13], pw1[0] = PKW(P0, 8), pw1[1] = PKW(P0, 10), pw1); \
    VRD(5); SBAR(); GAPA(C1 = __builtin_amdgcn_mfma_f32_32x32x16_bf16(kf[3], qr[1], C1, 0, 0, 0),   P0[14], P0[15], P1[0], P1[1],   pw1[2] = PKW(P0, 12), pw1[3] = PKW(P0, 14), pw1); \
    VRD(2); SBAR(); GAPA(C0 = __builtin_amdgcn_mfma_f32_32x32x16_bf16(kf[4], qr[2], C0, 0, 0, 0),   P1[2], P1[3], P1[4], P1[5],     pw2[0] = PKW(P1, 0), pw2[1] = PKW(P1, 2), pw2); \
    VRD(6); SBAR(); GAPA(C1 = __builtin_amdgcn_mfma_f32_32x32x16_bf16(kf[5], qr[2], C1, 0, 0, 0),   P1[6], P1[7], P1[8], P1[9],     pw2[2] = PKW(P1, 4), pw2[3] = PKW(P1, 6), pw2); \
    VRD(3); SBAR(); GAPA(C0 = __builtin_amdgcn_mfma_f32_32x32x16_bf16(kf[6], qr[3], C0, 0, 0, 0),   P1[10], P1[11], P1[12], P1[13], pw3[0] = PKW(P1, 8), pw3[1] = PKW(P1, 10), pw3); \
    VRD(7); SBAR(); GAPA(C1 = __builtin_amdgcn_mfma_f32_32x32x16_bf16(kf[7], qr[3], C1, 0, 0, 0),   P1[14], P1[15], 0.f, 0.f,       pw3[2] = PKW(P1, 12), pw3[3] = PKW(P1, 14), pw3); \
    l_reg += sacc; \
    if (GK) { DMA_K((t) + 3, sl_cur); } if (GV) { DMA_V((t) + 1, sl_next); } \
    CMASK(C0, C1, t); \
    { float a = MX3(C0[0], C0[1], C1[0]), b = MX3(C0[2], C0[3], C1[1]); a = MX3(a, C1[2], C1[3]); \
      _Pragma("unroll") for (int r = 4; r < 16; r += 4) { a = MX3(a, C0[r], C0[r + 1]); b = MX3(b, C0[r + 2], C0[r + 3]); a = MX3(a, C1[r], C1[r + 1]); b = MX3(b, C1[r + 2], C1[r + 3]); } \
      float rm = __builtin_fmaxf(a, b); { auto rr = __builtin_amdgcn_permlane32_swap(__float_as_uint(rm), __float_as_uint(rm), false, false); rm = __builtin_fmaxf(__uint_as_float(rr[0]), __uint_as_float(rr[1])); } \
      resc = false; \
      if (__builtin_expect(__any(rm > (float)THRL), 0)) { const float dl = __builtin_fmaxf(rm, 0.f); mhat += dl; \
        _Pragma("unroll") for (int r = 0; r < 16; ++r) { C0[r] -= dl; C1[r] -= dl; } \
        _Pragma("unroll") for (int r = 0; r < 16; ++r) negm[r] = -mhat; asm volatile("" : "+v"(negm)); \
        const float f = __builtin_amdgcn_exp2f(-dl); l_reg *= f; if (hi == 0) wsf[r32] = f; resc = true; } } \
    SBAR(); \
    GAPB(o[0] = __builtin_amdgcn_mfma_f32_32x32x16_bf16(PAF(0), VFR(0), o[0], 0, 0, 0), C0, 0); \
    GAPB(o[1] = __builtin_amdgcn_mfma_f32_32x32x16_bf16(PAF(0), VFR(4), o[1], 0, 0, 0), C0, 4); \
    KRD(GL, 0); GAPB(o[0] = __builtin_amdgcn_mfma_f32_32x32x16_bf16(PAF(1), VFR(1), o[0], 0, 0, 0), C0, 8); \
    KRD(GL, 1); GAPB(o[1] = __builtin_amdgcn_mfma_f32_32x32x16_bf16(PAF(1), VFR(5), o[1], 0, 0, 0), C0, 12); \
    KRD(GL, 2); GAPB(o[0] = __builtin_amdgcn_mfma_f32_32x32x16_bf16(PAF(2), VFR(2), o[0], 0, 0, 0), C1, 0); \
    KRD(GL, 3); GAPB(o[1] = __builtin_amdgcn_mfma_f32_32x32x16_bf16(PAF(2), VFR(6), o[1], 0, 0, 0), C1, 4); \
    GAPB(o[0] = __builtin_amdgcn_mfma_f32_32x32x16_bf16(PAF(3), VFR(3), o[0], 0, 0, 0), C1, 8); \
    GAPB(o[1] = __builtin_amdgcn_mfma_f32_32x32x16_bf16(PAF(3), VFR(7), o[1], 0, 0, 0), C1, 12); \
    } while (0)
    int t = 1;
#undef CMASK
#define CMASK(P0, P1, t) do {} while (0)
    for (; t + 5 < NT; t += 2) {
        STEP(pB0, pB1, pA0, pA1, t, true, true, true);     WAIT_BAR(2); RESC(); ROT();
        STEP(pA0, pA1, pB0, pB1, t + 1, true, true, true); WAIT_BAR(2); RESC(); ROT();
    }
#undef CMASK
#define CMASK(P0, P1, t) do { int jb_ = (t) - (NT - 4); if (jb_ >= 0) cmask(P0, P1, jb_, qrel, hi); } while (0)
#define ENDW(tt) do { if ((tt) + 3 < NT) { WAIT_BAR(2); } else if ((tt) + 2 < NT) { WAIT_BAR(1); } else { WAIT_BAR(0); } } while (0)
    for (; t + 1 < NT; t += 2) {
        STEP(pB0, pB1, pA0, pA1, t, (t + 3 < NT), (t + 1 < NT), (t + 1 < NT));       ENDW(t);     RESC(); ROT();
        STEP(pA0, pA1, pB0, pB1, t + 1, (t + 4 < NT), (t + 2 < NT), (t + 2 < NT));   ENDW(t + 1); RESC(); ROT();
    }
    STEP(pB0, pB1, pA0, pA1, NT - 1, false, false, false); RESC();
    { float sacc = pB0[0] + pB0[1]; _Pragma("unroll") for (int r = 2; r < 16; ++r) sacc += pB0[r]; _Pragma("unroll") for (int r = 0; r < 16; ++r) sacc += pB1[r]; l_reg += sacc;
      pw0 = (u32x4){PKW(pB0, 0), PKW(pB0, 2), PKW(pB0, 4), PKW(pB0, 6)}; pw1 = (u32x4){PKW(pB0, 8), PKW(pB0, 10), PKW(pB0, 12), PKW(pB0, 14)}; pw2 = (u32x4){PKW(pB1, 0), PKW(pB1, 2), PKW(pB1, 4), PKW(pB1, 6)}; pw3 = (u32x4){PKW(pB1, 8), PKW(pB1, 10), PKW(pB1, 12), PKW(pB1, 14)};
      SBAR(); pv(o, vb0 + sl_cur, PAF(0), PAF(1), PAF(2), PAF(3)); }
#undef PKW
#undef PAF
#undef VFR
#undef PIN
#undef MX3
#undef GAPA
#undef GAPB
#undef EX
#undef VRD
#undef KRD
#undef STEP
#undef ENDW
    { auto rr = __builtin_amdgcn_permlane32_swap(__float_as_uint(l_reg), __float_as_uint(l_reg), false, false); l_reg = __uint_as_float(rr[0]) + __uint_as_float(rr[1]); }
    int lane2 = lane; asm volatile("" : "+v"(lane2));
    const int r32e = lane2 & 31, hie = lane2 >> 5;
    if (hie == 0) wsf[32 + r32e] = l_reg; asm volatile("s_waitcnt lgkmcnt(0)" ::: "memory");
    float rli[16];
#pragma unroll
    for (int r = 0; r < 16; ++r) rli[r] = __builtin_amdgcn_rcpf(wsf[32 + crow(r, hie)]);
    bf16* Ow = Oh + (long)(q0 + wid * QBLK) * PO;
    { bf16* stg = (bf16*)(shm + LDS_OST) + wid * 2048;
#pragma unroll
      for (int r = 0; r < 16; ++r) { const int orow = crow(r, hie);
#pragma unroll
        for (int d0 = 0; d0 < 2; ++d0) stg[orow * 64 + d0 * 32 + r32e] = __float2bfloat16(o[d0][r] * rli[r]); }
      asm volatile("s_waitcnt lgkmcnt(0)" ::: "memory");
#pragma unroll
      for (int i = 0; i < 4; ++i) { const int row = i * 8 + (lane2 >> 3), ch = lane2 & 7; const u32x4 v = *(const u32x4*)(stg + row * 64 + ch * 8); ATTN_STORE16(Ow + (long)row * PO + ch * 8, v); } }
    asm volatile("s_waitcnt lgkmcnt(0)\n\ts_barrier" ::: "memory");
#undef DMA_K
#undef DMA_V
#undef CMASK
#undef START
#undef RESC
#undef ROT
}

constexpr int A2_SLOT = 24576, A2_K = 0, A2_V = 8192, A2_WS = 4 * A2_SLOT, A2_OST = 0, A2_BYTES = A2_WS + NW * 256;
template <int THRL> __device__ __forceinline__ void attn2_unit(int qb, const bf16* Qh, const bf16* __restrict__ Kh, const bf16* __restrict__ Vh, bf16* Oh, char* shm, unsigned* prb = nullptr) {
    const int tid = threadIdx.x; int lane = tid & 63; asm volatile("" : "+v"(lane));
    const int r32 = lane & 31, hi = lane >> 5; const int wid = __builtin_amdgcn_readfirstlane(tid >> 6);
    const int q0 = qb * QB;
    const bf16* Qw = Qh + (long)(q0 + wid * QBLK) * PZ;
    const unsigned lds0 = (unsigned)(uintptr_t)shm;
    float* wsf = (float*)(shm + A2_WS) + wid * 64;
    bf16x8 qr[4];
#pragma unroll
    for (int d0 = 0; d0 < 4; ++d0) qr[d0] = *reinterpret_cast<const bf16x8*>(&Qw[(long)r32 * PZ + d0 * 16 + hi * 8]);
    const bf16* ksrc = Kh + (long)lane * PZ + wid * 8;
    const bf16* vsrc = Vh + (long)(16 * (wid & 3) + (lane >> 2)) * PV + (wid >> 2) * 32 + (lane & 3) * 8;
    const unsigned kdst = lds0 + A2_K + wid * 1024, vdst = lds0 + A2_V + wid * 1024;
#define A2_DMA(t, sl) do { glds16(ksrc + (long)(t) * KVBLK * PZ, (unsigned)__builtin_amdgcn_readfirstlane(kdst + (sl) * A2_SLOT)); \
        glds16(vsrc + (long)(t) * KVBLK * PV, (unsigned)__builtin_amdgcn_readfirstlane(vdst + (sl) * A2_SLOT)); \
        glds16(vsrc + (long)(t) * KVBLK * PV + 64, (unsigned)__builtin_amdgcn_readfirstlane(vdst + (sl) * A2_SLOT + 8192)); } while (0)
#define A2_WAITB(n1, n2) do { if (n2) asm volatile("s_waitcnt vmcnt(6)\n\ts_barrier" ::: "memory"); else if (n1) asm volatile("s_waitcnt vmcnt(3)\n\ts_barrier" ::: "memory"); else asm volatile("s_waitcnt vmcnt(0)\n\ts_barrier" ::: "memory"); } while (0)
    const int NT = (q0 + QB) / KVBLK;
    A2_DMA(0, 0); A2_DMA(1, 1); A2_DMA(2, 2);
    asm volatile("" : "+v"(qr[0]), "+v"(qr[1]), "+v"(qr[2]), "+v"(qr[3]));
    const lds_cptr shm3 = (lds_cptr)shm;
    const lds_cptr kp0 = shm3 + A2_K + hi * 1024 + r32 * 16;
    const lds_cptr vp0 = shm3 + A2_V + ((lane >> 4) & 1) * 32 + (lane & 3) * 8 + (4 * hi + ((lane & 15) >> 2)) * 64;
    float mhat = 0.f, l_reg = 0.f; f32x16 o[4]; o[0] = f32x16{}; o[1] = f32x16{}; o[2] = f32x16{}; o[3] = f32x16{}; f32x16 negm = f32x16{};
    const int qrel = wid * QBLK + r32;
#if MK_PROBE
    const unsigned long long pt0 = __builtin_amdgcn_s_memrealtime();
#endif
    for (int t = 0; t < NT; ++t) {
        A2_WAITB(t + 1 < NT, t + 2 < NT);
        if (t + 3 < NT) A2_DMA(t + 3, (t + 3) & 3);
        const int slot = t & 3;
        const lds_cptr kp = kp0 + slot * A2_SLOT; const lds_cptr vp = vp0 + slot * A2_SLOT;
        f32x16 p0, p1;
        {   bf16x8 kb[8];
#pragma unroll
            for (int d0 = 0; d0 < 4; ++d0) { kb[2 * d0] = *(const __attribute__((address_space(3))) bf16x8*)(kp + d0 * 2048); kb[2 * d0 + 1] = *(const __attribute__((address_space(3))) bf16x8*)(kp + d0 * 2048 + 512); }
            __builtin_amdgcn_sched_barrier(0);
            p0 = __builtin_amdgcn_mfma_f32_32x32x16_bf16(kb[0], qr[0], negm, 0, 0, 0); p1 = __builtin_amdgcn_mfma_f32_32x32x16_bf16(kb[1], qr[0], negm, 0, 0, 0);
#pragma unroll
            for (int d0 = 1; d0 < 4; ++d0) { p0 = __builtin_amdgcn_mfma_f32_32x32x16_bf16(kb[2 * d0], qr[d0], p0, 0, 0, 0); p1 = __builtin_amdgcn_mfma_f32_32x32x16_bf16(kb[2 * d0 + 1], qr[d0], p1, 0, 0, 0); }
        }
        { const int jb = t - (NT - 4); if (jb >= 0) cmask(p0, p1, jb, qrel, hi); }
        float rm;
        { float a = fmaxf(fmaxf(p0[0], p0[1]), p1[0]), b = fmaxf(fmaxf(p0[2], p0[3]), p1[1]); a = fmaxf(fmaxf(a, p1[2]), p1[3]);
#pragma unroll
          for (int r = 4; r < 16; r += 4) { a = fmaxf(fmaxf(a, p0[r]), p0[r + 1]); b = fmaxf(fmaxf(b, p0[r + 2]), p0[r + 3]); a = fmaxf(fmaxf(a, p1[r]), p1[r + 1]); b = fmaxf(fmaxf(b, p1[r + 2]), p1[r + 3]); }
          rm = fmaxf(a, b); auto rr = __builtin_amdgcn_permlane32_swap(__float_as_uint(rm), __float_as_uint(rm), false, false); rm = fmaxf(__uint_as_float(rr[0]), __uint_as_float(rr[1])); }
        if (t == 0 || __any(rm > (float)THRL)) {
            const float dl = (t == 0) ? rm : fmaxf(rm, 0.f); mhat += dl;
#pragma unroll
            for (int r = 0; r < 16; ++r) { p0[r] -= dl; p1[r] -= dl; negm[r] = -mhat; }
            const float f = __builtin_amdgcn_exp2f(-dl); l_reg *= f;
            if (t > 0) {
                if (hi == 0) wsf[r32] = f;
                asm volatile("s_waitcnt lgkmcnt(0)" ::: "memory");
#pragma unroll
                for (int r = 0; r < 16; ++r) { const float fr_ = wsf[crow(r, hi)];
#pragma unroll
                    for (int d_ = 0; d_ < 4; ++d_) o[d_][r] *= fr_; }
                asm volatile("s_waitcnt lgkmcnt(0)" ::: "memory");
            }
        }
        float sacc = 0.f;
#pragma unroll
        for (int r = 0; r < 16; ++r) { p0[r] = __builtin_amdgcn_exp2f(p0[r]); p1[r] = __builtin_amdgcn_exp2f(p1[r]); sacc += p0[r] + p1[r]; }
        l_reg += sacc;
        u32x4 pw[4];
        pw[0] = (u32x4){pkbf(p0[0], p0[1]), pkbf(p0[2], p0[3]), pkbf(p0[4], p0[5]), pkbf(p0[6], p0[7])};
        pw[1] = (u32x4){pkbf(p0[8], p0[9]), pkbf(p0[10], p0[11]), pkbf(p0[12], p0[13]), pkbf(p0[14], p0[15])};
        pw[2] = (u32x4){pkbf(p1[0], p1[1]), pkbf(p1[2], p1[3]), pkbf(p1[4], p1[5]), pkbf(p1[6], p1[7])};
        pw[3] = (u32x4){pkbf(p1[8], p1[9]), pkbf(p1[10], p1[11]), pkbf(p1[12], p1[13]), pkbf(p1[14], p1[15])};
        asm volatile("" : "+v"(pw[0]), "+v"(pw[1]), "+v"(pw[2]), "+v"(pw[3]));
        {   s16x4 vlo[2][4], vhh[2][4];
#pragma unroll
            for (int d0 = 0; d0 < 4; ++d0) { vlo[0][d0] = vtr(vp + d0 * 4096); vhh[0][d0] = vtr(vp + d0 * 4096 + 512); }
            __builtin_amdgcn_sched_barrier(0);
#pragma unroll
            for (int ks = 0; ks < 4; ++ks) {
                if (ks + 1 < 4) {
#pragma unroll
                    for (int d0 = 0; d0 < 4; ++d0) { vlo[(ks + 1) & 1][d0] = vtr(vp + d0 * 4096 + (ks + 1) * 1024); vhh[(ks + 1) & 1][d0] = vtr(vp + d0 * 4096 + (ks + 1) * 1024 + 512); }
                }
                __builtin_amdgcn_sched_barrier(0);
#pragma unroll
                for (int d0 = 0; d0 < 4; ++d0) {
                    const s16x4 lo = vlo[ks & 1][d0], hh = vhh[ks & 1][d0];
                    const bf16x8 vf = (bf16x8){lo[0], lo[1], lo[2], lo[3], hh[0], hh[1], hh[2], hh[3]};
                    o[d0] = __builtin_amdgcn_mfma_f32_32x32x16_bf16(__builtin_bit_cast(bf16x8, pw[ks]), vf, o[d0], 0, 0, 0);
                }
                __builtin_amdgcn_sched_barrier(0);
            }
        }
    }
#if MK_PROBE
    if (prb && tid == 0) { atomicAdd(prb, (unsigned)(__builtin_amdgcn_s_memrealtime() - pt0)); atomicAdd(prb + 1, (unsigned)NT); }
#endif
    asm volatile("s_waitcnt lgkmcnt(0)\n\ts_barrier" ::: "memory");
    { auto rr = __builtin_amdgcn_permlane32_swap(__float_as_uint(l_reg), __float_as_uint(l_reg), false, false); l_reg = __uint_as_float(rr[0]) + __uint_as_float(rr[1]); }
    if (hi == 0) wsf[32 + r32] = l_reg;
    asm volatile("s_waitcnt lgkmcnt(0)" ::: "memory");
    bf16* stg = (bf16*)(shm + A2_OST) + wid * 4096;
#pragma unroll
    for (int r = 0; r < 16; ++r) { const int orow = crow(r, hi); const float rl = __builtin_amdgcn_rcpf(wsf[32 + orow]);
#pragma unroll
        for (int d0 = 0; d0 < 4; ++d0) stg[orow * 128 + d0 * 32 + r32] = __float2bfloat16(o[d0][r] * rl); }
    asm volatile("s_waitcnt lgkmcnt(0)" ::: "memory");
    bf16* Ow = Oh + (long)(q0 + wid * QBLK) * PO;
#pragma unroll
    for (int i = 0; i < 8; ++i) { const int row = i * 4 + (lane >> 4), ch = lane & 15; const u32x4 v = *(const u32x4*)(stg + row * 128 + ch * 8); *(u32x4*)(Ow + (long)row * PO + ch * 8) = v; }
    asm volatile("s_waitcnt lgkmcnt(0)\n\ts_barrier" ::: "memory");
#undef A2_DMA
#undef A2_WAITB
}

template <int THRL> __device__ __forceinline__ void attn3_unit(int qb, const bf16* Qh, const bf16* __restrict__ Kh, const bf16* __restrict__ Vh, bf16* Oh, char* shm, unsigned* prb = nullptr) {
    const int tid = threadIdx.x; int lane = tid & 63; asm volatile("" : "+v"(lane));
    const int r32 = lane & 31, hi = lane >> 5; const int wid = __builtin_amdgcn_readfirstlane(tid >> 6);
    const int q0 = qb * QB;
    const bf16* Qw = Qh + (long)(q0 + wid * QBLK) * PZ;
    const unsigned lds0 = (unsigned)(uintptr_t)shm;
    float* wsf = (float*)(shm + A2_WS) + wid * 64;
    bf16x8 qr[4];
#pragma unroll
    for (int d0 = 0; d0 < 4; ++d0) qr[d0] = *reinterpret_cast<const bf16x8*>(&Qw[(long)r32 * PZ + d0 * 16 + hi * 8]);
    const bf16* ksrc = Kh + (long)lane * PZ + wid * 8;
    const bf16* vsrc = Vh + (long)(16 * (wid & 3) + (lane >> 2)) * PV + (wid >> 2) * 32 + (lane & 3) * 8;
    const unsigned kdst = lds0 + A2_K + wid * 1024, vdst = lds0 + A2_V + wid * 1024;
#define A3_DMA(t, sl) do { glds16(ksrc + (long)(t) * KVBLK * PZ, (unsigned)__builtin_amdgcn_readfirstlane(kdst + (sl) * A2_SLOT)); \
        glds16(vsrc + (long)(t) * KVBLK * PV, (unsigned)__builtin_amdgcn_readfirstlane(vdst + (sl) * A2_SLOT)); \
        glds16(vsrc + (long)(t) * KVBLK * PV + 64, (unsigned)__builtin_amdgcn_readfirstlane(vdst + (sl) * A2_SLOT + 8192)); } while (0)
#define A3_SB() __builtin_amdgcn_sched_barrier(0)
#define A3_MFMA(A_, B_, C_) __builtin_amdgcn_mfma_f32_32x32x16_bf16((A_), (B_), (C_), 0, 0, 0)
#define A3_KLD(D0) (*(const __attribute__((address_space(3))) bf16x8*)(kpn + (D0) * 2048))
#define A3_KLD2(D0) (*(const __attribute__((address_space(3))) bf16x8*)(kpn + (D0) * 2048 + 512))
#define A3_VLD(BUF, KS) do { _Pragma("unroll") for (int d_ = 0; d_ < 4; ++d_) { vlo[BUF][d_] = vtr(vp + d_ * 4096 + (KS) * 1024); vhh[BUF][d_] = vtr(vp + d_ * 4096 + (KS) * 1024 + 512); } } while (0)
#define A3_VF(BUF, D0) ((bf16x8){vlo[BUF][D0][0], vlo[BUF][D0][1], vlo[BUF][D0][2], vlo[BUF][D0][3], vhh[BUF][D0][0], vhh[BUF][D0][1], vhh[BUF][D0][2], vhh[BUF][D0][3]})
#define A3_EXP2(P, I) do { P[2 * (I)] = __builtin_amdgcn_exp2f(P[2 * (I)]); P[2 * (I) + 1] = __builtin_amdgcn_exp2f(P[2 * (I) + 1]); sacc += P[2 * (I)] + P[2 * (I) + 1]; } while (0)
#define A3_ROWMAX(P0, P1, RM) do { float a_ = fmaxf(fmaxf(P0[0], P0[1]), P1[0]), b_ = fmaxf(fmaxf(P0[2], P0[3]), P1[1]); a_ = fmaxf(fmaxf(a_, P1[2]), P1[3]); \
        _Pragma("unroll") for (int r_ = 4; r_ < 16; r_ += 4) { a_ = fmaxf(fmaxf(a_, P0[r_]), P0[r_ + 1]); b_ = fmaxf(fmaxf(b_, P0[r_ + 2]), P0[r_ + 3]); a_ = fmaxf(fmaxf(a_, P1[r_]), P1[r_ + 1]); b_ = fmaxf(fmaxf(b_, P1[r_ + 2]), P1[r_ + 3]); } \
        RM = fmaxf(a_, b_); auto rr_ = __builtin_amdgcn_permlane32_swap(__float_as_uint(RM), __float_as_uint(RM), false, false); RM = fmaxf(__uint_as_float(rr_[0]), __uint_as_float(rr_[1])); } while (0)
    const int NT = (q0 + QB) / KVBLK;
    A3_DMA(0, 0); A3_DMA(1, 1); A3_DMA(2, 2);
    asm volatile("" : "+v"(qr[0]), "+v"(qr[1]), "+v"(qr[2]), "+v"(qr[3]));
    const lds_cptr shm3 = (lds_cptr)shm;
    const lds_cptr kp0 = shm3 + A2_K + hi * 1024 + r32 * 16;
    const lds_cptr vp0 = shm3 + A2_V + ((lane >> 4) & 1) * 32 + (lane & 3) * 8 + (4 * hi + ((lane & 15) >> 2)) * 64;
    float mhat = 0.f, l_reg = 0.f; f32x16 o[4]; o[0] = f32x16{}; o[1] = f32x16{}; o[2] = f32x16{}; o[3] = f32x16{}; f32x16 negm = f32x16{};
    const int qrel = wid * QBLK + r32;
    f32x16 p0, p1; float rm;
    asm volatile("s_waitcnt vmcnt(6)\n\ts_barrier" ::: "memory");
    {   const lds_cptr kpn = kp0;
        p0 = A3_MFMA(A3_KLD(0), qr[0], negm); p1 = A3_MFMA(A3_KLD2(0), qr[0], negm);
#pragma unroll
        for (int d0 = 1; d0 < 4; ++d0) { p0 = A3_MFMA(A3_KLD(d0), qr[d0], p0); p1 = A3_MFMA(A3_KLD2(d0), qr[d0], p1); }
        if (NT == 4) cmask(p0, p1, 0, qrel, hi);
        A3_ROWMAX(p0, p1, rm);
        mhat = rm;
#pragma unroll
        for (int r = 0; r < 16; ++r) { p0[r] -= rm; p1[r] -= rm; negm[r] = -mhat; }
        rm = 0.f;
    }
#if MK_PROBE
    const unsigned long long pt0 = __builtin_amdgcn_s_memrealtime();
#endif
    for (int t = 0; t < NT; ++t) {
        if (t + 2 < NT) asm volatile("s_waitcnt vmcnt(3)\n\ts_barrier" ::: "memory"); else asm volatile("s_waitcnt vmcnt(0)\n\ts_barrier" ::: "memory");
        if (t + 3 < NT) A3_DMA(t + 3, (t + 3) & 3);
        const lds_cptr kpn = kp0 + ((t + 1) & 3) * A2_SLOT; const lds_cptr vp = vp0 + (t & 3) * A2_SLOT;
        if (__any(rm > (float)THRL)) {
            const float dl = fmaxf(rm, 0.f); mhat += dl;
#pragma unroll
            for (int r = 0; r < 16; ++r) { p0[r] -= dl; p1[r] -= dl; negm[r] = -mhat; }
            const float f = __builtin_amdgcn_exp2f(-dl); l_reg *= f;
            if (hi == 0) wsf[r32] = f;
            asm volatile("s_waitcnt lgkmcnt(0)" ::: "memory");
#pragma unroll
            for (int r = 0; r < 16; ++r) { const float fr_ = wsf[crow(r, hi)];
#pragma unroll
                for (int d_ = 0; d_ < 4; ++d_) o[d_][r] *= fr_; }
            asm volatile("s_waitcnt lgkmcnt(0)" ::: "memory");
        }
        float sacc = 0.f; f32x16 n0, n1; u32x4 pw0, pw1, pw2, pw3; s16x4 vlo[2][4], vhh[2][4];
        {   bf16x8 ka0 = A3_KLD(0), ka1 = A3_KLD2(0), ka2 = A3_KLD(1), ka3 = A3_KLD2(1);
            A3_VLD(0, 0);
            A3_SB();
            n0 = A3_MFMA(ka0, qr[0], negm); A3_EXP2(p0, 0); A3_SB();
            n1 = A3_MFMA(ka1, qr[0], negm); A3_EXP2(p0, 1); A3_SB();
            bf16x8 kb0 = A3_KLD(2), kb1 = A3_KLD2(2), kb2 = A3_KLD(3), kb3 = A3_KLD2(3);
            n0 = A3_MFMA(ka2, qr[1], n0); A3_EXP2(p0, 2); A3_SB();
            n1 = A3_MFMA(ka3, qr[1], n1); A3_EXP2(p0, 3); pw0 = (u32x4){pkbf(p0[0], p0[1]), pkbf(p0[2], p0[3]), pkbf(p0[4], p0[5]), pkbf(p0[6], p0[7])}; A3_SB();
            n0 = A3_MFMA(kb0, qr[2], n0); A3_EXP2(p0, 4); A3_SB();
            n1 = A3_MFMA(kb1, qr[2], n1); A3_EXP2(p0, 5); A3_SB();
            n0 = A3_MFMA(kb2, qr[3], n0); A3_EXP2(p0, 6); A3_SB();
            n1 = A3_MFMA(kb3, qr[3], n1); A3_EXP2(p0, 7); pw1 = (u32x4){pkbf(p0[8], p0[9]), pkbf(p0[10], p0[11]), pkbf(p0[12], p0[13]), pkbf(p0[14], p0[15])}; A3_SB();
        }
        A3_VLD(1, 1); A3_SB();
        o[0] = A3_MFMA(__builtin_bit_cast(bf16x8, pw0), A3_VF(0, 0), o[0]); A3_EXP2(p1, 0); A3_SB();
        o[1] = A3_MFMA(__builtin_bit_cast(bf16x8, pw0), A3_VF(0, 1), o[1]); A3_EXP2(p1, 1); A3_SB();
        o[2] = A3_MFMA(__builtin_bit_cast(bf16x8, pw0), A3_VF(0, 2), o[2]); A3_EXP2(p1, 2); A3_SB();
        o[3] = A3_MFMA(__builtin_bit_cast(bf16x8, pw0), A3_VF(0, 3), o[3]); A3_EXP2(p1, 3); pw2 = (u32x4){pkbf(p1[0], p1[1]), pkbf(p1[2], p1[3]), pkbf(p1[4], p1[5]), pkbf(p1[6], p1[7])}; A3_SB();
        A3_VLD(0, 2); A3_SB();
        o[0] = A3_MFMA(__builtin_bit_cast(bf16x8, pw1), A3_VF(1, 0), o[0]); A3_EXP2(p1, 4); A3_SB();
        o[1] = A3_MFMA(__builtin_bit_cast(bf16x8, pw1), A3_VF(1, 1), o[1]); A3_EXP2(p1, 5); A3_SB();
        o[2] = A3_MFMA(__builtin_bit_cast(bf16x8, pw1), A3_VF(1, 2), o[2]); A3_EXP2(p1, 6); A3_SB();
        o[3] = A3_MFMA(__builtin_bit_cast(bf16x8, pw1), A3_VF(1, 3), o[3]); A3_EXP2(p1, 7); pw3 = (u32x4){pkbf(p1[8], p1[9]), pkbf(p1[10], p1[11]), pkbf(p1[12], p1[13]), pkbf(p1[14], p1[15])}; A3_SB();
        l_reg += sacc;
        A3_VLD(1, 3); A3_SB();
        { const int jb = (t + 1) - (NT - 4); if (jb >= 0 && t + 1 < NT) cmask(n0, n1, jb, qrel, hi); }
        o[0] = A3_MFMA(__builtin_bit_cast(bf16x8, pw2), A3_VF(0, 0), o[0]);
        o[1] = A3_MFMA(__builtin_bit_cast(bf16x8, pw2), A3_VF(0, 1), o[1]);
        o[2] = A3_MFMA(__builtin_bit_cast(bf16x8, pw2), A3_VF(0, 2), o[2]);
        o[3] = A3_MFMA(__builtin_bit_cast(bf16x8, pw2), A3_VF(0, 3), o[3]); A3_SB();
        o[0] = A3_MFMA(__builtin_bit_cast(bf16x8, pw3), A3_VF(1, 0), o[0]);
        o[1] = A3_MFMA(__builtin_bit_cast(bf16x8, pw3), A3_VF(1, 1), o[1]);
        o[2] = A3_MFMA(__builtin_bit_cast(bf16x8, pw3), A3_VF(1, 2), o[2]);
        o[3] = A3_MFMA(__builtin_bit_cast(bf16x8, pw3), A3_VF(1, 3), o[3]);
        A3_ROWMAX(n0, n1, rm);
        p0 = n0; p1 = n1;
        A3_SB();
    }
#if MK_PROBE
    if (prb && tid == 0) { atomicAdd(prb, (unsigned)(__builtin_amdgcn_s_memrealtime() - pt0)); atomicAdd(prb + 1, (unsigned)NT); }
#endif
    asm volatile("s_waitcnt lgkmcnt(0)\n\ts_barrier" ::: "memory");
    { auto rr = __builtin_amdgcn_permlane32_swap(__float_as_uint(l_reg), __float_as_uint(l_reg), false, false); l_reg = __uint_as_float(rr[0]) + __uint_as_float(rr[1]); }
    if (hi == 0) wsf[32 + r32] = l_reg;
    asm volatile("s_waitcnt lgkmcnt(0)" ::: "memory");
    bf16* stg = (bf16*)(shm + A2_OST) + wid * 4096;
#pragma unroll
    for (int r = 0; r < 16; ++r) { const int orow = crow(r, hi); const float rl = __builtin_amdgcn_rcpf(wsf[32 + orow]);
#pragma unroll
        for (int d0 = 0; d0 < 4; ++d0) stg[orow * 128 + d0 * 32 + r32] = __float2bfloat16(o[d0][r] * rl); }
    asm volatile("s_waitcnt lgkmcnt(0)" ::: "memory");
    bf16* Ow = Oh + (long)(q0 + wid * QBLK) * PO;
#pragma unroll
    for (int i = 0; i < 8; ++i) { const int row = i * 4 + (lane >> 4), ch = lane & 15; const u32x4 v = *(const u32x4*)(stg + row * 128 + ch * 8); *(u32x4*)(Ow + (long)row * PO + ch * 8) = v; }
    asm volatile("s_waitcnt lgkmcnt(0)\n\ts_barrier" ::: "memory");
#undef A3_DMA
#undef A3_SB
#undef A3_MFMA
#undef A3_KLD
#undef A3_KLD2
#undef A3_VLD
#undef A3_VF
#undef A3_EXP2
#undef A3_ROWMAX
}
template <int THRL> __device__ __forceinline__ void attn4_unit(int qb, const bf16* Qh0, const bf16* __restrict__ Kh0, long mapstride, const bf16* __restrict__ Vh, bf16_t* YCb_, int yrow0, int ycol0, float lam, const float* gvec, u32x4* park, char* shm) {
#pragma unroll 1
  for (int mp = 0; mp < 2; ++mp) {
    const bf16* Qh = Qh0 + mp * mapstride; const bf16* Kh = Kh0 + mp * mapstride;
    const int tid = threadIdx.x; int lane = tid & 63; asm volatile("" : "+v"(lane));
    const int r32 = lane & 31, hi = lane >> 5; const int wid = __builtin_amdgcn_readfirstlane(tid >> 6);
    const int q0 = qb * QB + NMETA;
    const bf16* Qw = Qh + (long)(q0 + wid * QBLK) * PZ;
    const unsigned lds0 = (unsigned)(uintptr_t)shm;
    float* wsf = (float*)(shm + A2_WS) + wid * 64;
    bf16x8 qr[4];
#pragma unroll
    for (int d0 = 0; d0 < 4; ++d0) qr[d0] = *reinterpret_cast<const bf16x8*>(&Qw[(long)r32 * PZ + d0 * 16 + hi * 8]);
    const bf16* ksrc = Kh + (long)lane * PZ + wid * 8;
    const bf16* vsrc = Vh + (long)(16 * (wid & 3) + (lane >> 2)) * PV + (wid >> 2) * 32 + (lane & 3) * 8;
    const unsigned kdst = lds0 + A2_K + wid * 1024, vdst = lds0 + A2_V + wid * 1024;
#define A3_DMA(t, sl) do { glds16(ksrc + (long)(t) * KVBLK * PZ, (unsigned)__builtin_amdgcn_readfirstlane(kdst + (sl) * A2_SLOT)); \
        glds16(vsrc + (long)(t) * KVBLK * PV, (unsigned)__builtin_amdgcn_readfirstlane(vdst + (sl) * A2_SLOT)); \
        glds16(vsrc + (long)(t) * KVBLK * PV + 64, (unsigned)__builtin_amdgcn_readfirstlane(vdst + (sl) * A2_SLOT + 8192)); } while (0)
#define A3_SB() __builtin_amdgcn_sched_barrier(0)
#define A3_MFMA(A_, B_, C_) __builtin_amdgcn_mfma_f32_32x32x16_bf16((A_), (B_), (C_), 0, 0, 0)
#define A3_KLD(D0) (*(const __attribute__((address_space(3))) bf16x8*)(kpn + (D0) * 2048))
#define A3_KLD2(D0) (*(const __attribute__((address_space(3))) bf16x8*)(kpn + (D0) * 2048 + 512))
#define A3_VLD(BUF, KS) do { _Pragma("unroll") for (int d_ = 0; d_ < 4; ++d_) { vlo[BUF][d_] = vtr(vp + d_ * 4096 + (KS) * 1024); vhh[BUF][d_] = vtr(vp + d_ * 4096 + (KS) * 1024 + 512); } } while (0)
#define A3_VF(BUF, D0) ((bf16x8){vlo[BUF][D0][0], vlo[BUF][D0][1], vlo[BUF][D0][2], vlo[BUF][D0][3], vhh[BUF][D0][0], vhh[BUF][D0][1], vhh[BUF][D0][2], vhh[BUF][D0][3]})
#define A3_EXP2(P, I) do { P[2 * (I)] = __builtin_amdgcn_exp2f(P[2 * (I)]); P[2 * (I) + 1] = __builtin_amdgcn_exp2f(P[2 * (I) + 1]); sacc += P[2 * (I)] + P[2 * (I) + 1]; } while (0)
#define A3_ROWMAX(P0, P1, RM) do { float a_ = fmaxf(fmaxf(P0[0], P0[1]), P1[0]), b_ = fmaxf(fmaxf(P0[2], P0[3]), P1[1]); a_ = fmaxf(fmaxf(a_, P1[2]), P1[3]); \
        _Pragma("unroll") for (int r_ = 4; r_ < 16; r_ += 4) { a_ = fmaxf(fmaxf(a_, P0[r_]), P0[r_ + 1]); b_ = fmaxf(fmaxf(b_, P0[r_ + 2]), P0[r_ + 3]); a_ = fmaxf(fmaxf(a_, P1[r_]), P1[r_ + 1]); b_ = fmaxf(fmaxf(b_, P1[r_ + 2]), P1[r_ + 3]); } \
        RM = fmaxf(a_, b_); auto rr_ = __builtin_amdgcn_permlane32_swap(__float_as_uint(RM), __float_as_uint(RM), false, false); RM = fmaxf(__uint_as_float(rr_[0]), __uint_as_float(rr_[1])); } while (0)
    const int NT = 4 * qb + 5;
    const int qrel16 = wid * QBLK + r32 + NMETA;
    A3_DMA(0, 0); A3_DMA(1, 1); A3_DMA(2, 2);
    asm volatile("" : "+v"(qr[0]), "+v"(qr[1]), "+v"(qr[2]), "+v"(qr[3]));
    const lds_cptr shm3 = (lds_cptr)shm;
    const lds_cptr kp0 = shm3 + A2_K + hi * 1024 + r32 * 16;
    const lds_cptr vp0 = shm3 + A2_V + ((lane >> 4) & 1) * 32 + (lane & 3) * 8 + (4 * hi + ((lane & 15) >> 2)) * 64;
    float mhat = 0.f, l_reg = 0.f; f32x16 o[4]; o[0] = f32x16{}; o[1] = f32x16{}; o[2] = f32x16{}; o[3] = f32x16{}; f32x16 negm = f32x16{};
    const int qrel = wid * QBLK + r32;
    f32x16 p0, p1; float rm;
    asm volatile("s_waitcnt vmcnt(6)\n\ts_barrier" ::: "memory");
    {   const lds_cptr kpn = kp0;
        p0 = A3_MFMA(A3_KLD(0), qr[0], negm); p1 = A3_MFMA(A3_KLD2(0), qr[0], negm);
#pragma unroll
        for (int d0 = 1; d0 < 4; ++d0) { p0 = A3_MFMA(A3_KLD(d0), qr[d0], p0); p1 = A3_MFMA(A3_KLD2(d0), qr[d0], p1); }
        if (qb == 0) cmask(p0, p1, 0, qrel16, hi);
        A3_ROWMAX(p0, p1, rm);
        mhat = rm;
#pragma unroll
        for (int r = 0; r < 16; ++r) { p0[r] -= rm; p1[r] -= rm; negm[r] = -mhat; }
        rm = 0.f;
    }
    for (int t = 0; t < NT; ++t) {
        if (t + 2 < NT) asm volatile("s_waitcnt vmcnt(3)\n\ts_barrier" ::: "memory"); else asm volatile("s_waitcnt vmcnt(0)\n\ts_barrier" ::: "memory");
        if (t + 3 < NT) A3_DMA(t + 3, (t + 3) & 3);
        const lds_cptr kpn = kp0 + ((t + 1) & 3) * A2_SLOT; const lds_cptr vp = vp0 + (t & 3) * A2_SLOT;
        if (__any(rm > (float)THRL)) {
            const float dl = fmaxf(rm, 0.f); mhat += dl;
#pragma unroll
            for (int r = 0; r < 16; ++r) { p0[r] -= dl; p1[r] -= dl; negm[r] = -mhat; }
            const float f = __builtin_amdgcn_exp2f(-dl); l_reg *= f;
            if (hi == 0) wsf[r32] = f;
            asm volatile("s_waitcnt lgkmcnt(0)" ::: "memory");
#pragma unroll
            for (int r = 0; r < 16; ++r) { const float fr_ = wsf[crow(r, hi)];
#pragma unroll
                for (int d_ = 0; d_ < 4; ++d_) o[d_][r] *= fr_; }
            asm volatile("s_waitcnt lgkmcnt(0)" ::: "memory");
        }
        float sacc = 0.f; f32x16 n0, n1; u32x4 pw0, pw1, pw2, pw3; s16x4 vlo[2][4], vhh[2][4];
        {   bf16x8 ka0 = A3_KLD(0), ka1 = A3_KLD2(0), ka2 = A3_KLD(1), ka3 = A3_KLD2(1);
            A3_VLD(0, 0);
            A3_SB();
            n0 = A3_MFMA(ka0, qr[0], negm); A3_EXP2(p0, 0); A3_SB();
            n1 = A3_MFMA(ka1, qr[0], negm); A3_EXP2(p0, 1); A3_SB();
            bf16x8 kb0 = A3_KLD(2), kb1 = A3_KLD2(2), kb2 = A3_KLD(3), kb3 = A3_KLD2(3);
            n0 = A3_MFMA(ka2, qr[1], n0); A3_EXP2(p0, 2); A3_SB();
            n1 = A3_MFMA(ka3, qr[1], n1); A3_EXP2(p0, 3); pw0 = (u32x4){pkbf(p0[0], p0[1]), pkbf(p0[2], p0[3]), pkbf(p0[4], p0[5]), pkbf(p0[6], p0[7])}; A3_SB();
            n0 = A3_MFMA(kb0, qr[2], n0); A3_EXP2(p0, 4); A3_SB();
            n1 = A3_MFMA(kb1, qr[2], n1); A3_EXP2(p0, 5); A3_SB();
            n0 = A3_MFMA(kb2, qr[3], n0); A3_EXP2(p0, 6); A3_SB();
            n1 = A3_MFMA(kb3, qr[3], n1); A3_EXP2(p0, 7); pw1 = (u32x4){pkbf(p0[8], p0[9]), pkbf(p0[10], p0[11]), pkbf(p0[12], p0[13]), pkbf(p0[14], p0[15])}; A3_SB();
        }
        A3_VLD(1, 1); A3_SB();
        o[0] = A3_MFMA(__builtin_bit_cast(bf16x8, pw0), A3_VF(0, 0), o[0]); A3_EXP2(p1, 0); A3_SB();
        o[1] = A3_MFMA(__builtin_bit_cast(bf16x8, pw0), A3_VF(0, 1), o[1]); A3_EXP2(p1, 1); A3_SB();
        o[2] = A3_MFMA(__builtin_bit_cast(bf16x8, pw0), A3_VF(0, 2), o[2]); A3_EXP2(p1, 2); A3_SB();
        o[3] = A3_MFMA(__builtin_bit_cast(bf16x8, pw0), A3_VF(0, 3), o[3]); A3_EXP2(p1, 3); pw2 = (u32x4){pkbf(p1[0], p1[1]), pkbf(p1[2], p1[3]), pkbf(p1[4], p1[5]), pkbf(p1[6], p1[7])}; A3_SB();
        A3_VLD(0, 2); A3_SB();
        o[0] = A3_MFMA(__builtin_bit_cast(bf16x8, pw1), A3_VF(1, 0), o[0]); A3_EXP2(p1, 4); A3_SB();
        o[1] = A3_MFMA(__builtin_bit_cast(bf16x8, pw1), A3_VF(1, 1), o[1]); A3_EXP2(p1, 5); A3_SB();
        o[2] = A3_MFMA(__builtin_bit_cast(bf16x8, pw1), A3_VF(1, 2), o[2]); A3_EXP2(p1, 6); A3_SB();
        o[3] = A3_MFMA(__builtin_bit_cast(bf16x8, pw1), A3_VF(1, 3), o[3]); A3_EXP2(p1, 7); pw3 = (u32x4){pkbf(p1[8], p1[9]), pkbf(p1[10], p1[11]), pkbf(p1[12], p1[13]), pkbf(p1[14], p1[15])}; A3_SB();
        l_reg += sacc;
        A3_VLD(1, 3); A3_SB();
        { const int jb = (t + 1) - 4 * qb; if (jb >= 0 && t + 1 < NT) cmask(n0, n1, jb, qrel16, hi); }
        o[0] = A3_MFMA(__builtin_bit_cast(bf16x8, pw2), A3_VF(0, 0), o[0]);
        o[1] = A3_MFMA(__builtin_bit_cast(bf16x8, pw2), A3_VF(0, 1), o[1]);
        o[2] = A3_MFMA(__builtin_bit_cast(bf16x8, pw2), A3_VF(0, 2), o[2]);
        o[3] = A3_MFMA(__builtin_bit_cast(bf16x8, pw2), A3_VF(0, 3), o[3]); A3_SB();
        o[0] = A3_MFMA(__builtin_bit_cast(bf16x8, pw3), A3_VF(1, 0), o[0]);
        o[1] = A3_MFMA(__builtin_bit_cast(bf16x8, pw3), A3_VF(1, 1), o[1]);
        o[2] = A3_MFMA(__builtin_bit_cast(bf16x8, pw3), A3_VF(1, 2), o[2]);
        o[3] = A3_MFMA(__builtin_bit_cast(bf16x8, pw3), A3_VF(1, 3), o[3]);
        A3_ROWMAX(n0, n1, rm);
        p0 = n0; p1 = n1;
        A3_SB();
    }
    asm volatile("s_waitcnt lgkmcnt(0)\n\ts_barrier" ::: "memory");
    { auto rr = __builtin_amdgcn_permlane32_swap(__float_as_uint(l_reg), __float_as_uint(l_reg), false, false); l_reg = __uint_as_float(rr[0]) + __uint_as_float(rr[1]); }
    if (hi == 0) wsf[32 + r32] = l_reg;
    asm volatile("s_waitcnt lgkmcnt(0)" ::: "memory");
    float rl[16];
#pragma unroll
    for (int r = 0; r < 16; ++r) rl[r] = __builtin_amdgcn_rcpf(wsf[32 + crow(r, hi)]);
    if (mp == 0) {
#pragma unroll
        for (int d0 = 0; d0 < 4; ++d0)
#pragma unroll
            for (int q4 = 0; q4 < 2; ++q4) { u32x4 w;
                w.x = pkbf(o[d0][8 * q4 + 0] * rl[8 * q4 + 0], o[d0][8 * q4 + 1] * rl[8 * q4 + 1]); w.y = pkbf(o[d0][8 * q4 + 2] * rl[8 * q4 + 2], o[d0][8 * q4 + 3] * rl[8 * q4 + 3]);
                w.z = pkbf(o[d0][8 * q4 + 4] * rl[8 * q4 + 4], o[d0][8 * q4 + 5] * rl[8 * q4 + 5]); w.w = pkbf(o[d0][8 * q4 + 6] * rl[8 * q4 + 6], o[d0][8 * q4 + 7] * rl[8 * q4 + 7]);
                park[d0 * 2 + q4] = w; }
    } else {
        float ss[16];
#pragma unroll
        for (int r = 0; r < 16; ++r) ss[r] = 0.f;
#pragma unroll
        for (int d0 = 0; d0 < 4; ++d0)
#pragma unroll
            for (int q4 = 0; q4 < 2; ++q4) { const u32x4 w = park[d0 * 2 + q4];
                const float a_[8] = {bflo(w.x), bfhi(w.x), bflo(w.y), bfhi(w.y), bflo(w.z), bfhi(w.z), bflo(w.w), bfhi(w.w)};
#pragma unroll
                for (int e = 0; e < 8; ++e) { const int r = 8 * q4 + e; const float y = a_[e] - lam * (o[d0][r] * rl[r]); o[d0][r] = y; ss[r] += y * y; } }
        const f32x4 g4 = (f32x4){gvec[r32], gvec[32 + r32], gvec[64 + r32], gvec[96 + r32]} * (1.0f - LAMBDA_INIT);
#pragma unroll
        for (int r = 0; r < 16; ++r) {
            float v = row_sum16(ss[r]);
            auto rr = __builtin_amdgcn_permlane16_swap(__float_as_uint(v), __float_as_uint(v), false, false); v = __uint_as_float(rr[0]) + __uint_as_float(rr[1]);
            ss[r] = 1.0f / sqrtf(v * (1.f / 128.f) + LN_EPS);
        }
        bf16* stg = (bf16*)(shm + A2_OST) + wid * 4096;
#pragma unroll
        for (int r = 0; r < 16; ++r) { const int orow = crow(r, hi);
#pragma unroll
            for (int d0 = 0; d0 < 4; ++d0) stg[orow * 128 + d0 * 32 + r32] = __float2bfloat16(o[d0][r] * ss[r] * g4[d0]); }
        asm volatile("s_waitcnt lgkmcnt(0)" ::: "memory");
#pragma unroll
        for (int i = 0; i < 8; ++i) { const int row = i * 4 + (lane >> 4), ch = lane & 15; const int tq = q0 + wid * QBLK + row;
            if (tq >= NMETA && tq < TT) { const u32x4 v = *(const u32x4*)(stg + row * 128 + ch * 8); *(u32x4*)(YCb_ + (size_t)(yrow0 + tq - NMETA) * DM + ycol0 + ch * 8) = v; } }
    }
    asm volatile("s_waitcnt lgkmcnt(0)\n\ts_barrier" ::: "memory");
#undef A3_DMA
#undef A3_SB
#undef A3_MFMA
#undef A3_KLD
#undef A3_KLD2
#undef A3_VLD
#undef A3_VF
#undef A3_EXP2
#undef A3_ROWMAX
  }
}
#undef SBAR
#undef WAIT_BAR
}

#define XB_TMO      128
#define XB_XCNT(j)  (256  + 64 * (j))
#define XB_XSUB(j)  (1280 + 64 * (j))
#define XB_XGEN(j)  (2304 + 64 * (j))
#define XB_TOP      3328
#define XB_TOPGEN   3392
#define XCD_BAR_WORDS 3456
#define XB_SPIN_CAP (1u << 18)
__device__ __forceinline__ unsigned xb_ld(unsigned* p)              { return __hip_atomic_load(p, __ATOMIC_RELAXED, __HIP_MEMORY_SCOPE_AGENT); }
__device__ __forceinline__ unsigned xb_add(unsigned* p, unsigned v) { return __hip_atomic_fetch_add(p, v, __ATOMIC_RELAXED, __HIP_MEMORY_SCOPE_AGENT); }
__device__ __forceinline__ unsigned xb_xcc_id() { return (unsigned)__builtin_amdgcn_s_getreg((3 << 11) | 20) & 0xFu; }
#define XB_SPIN(cond, bar) do { unsigned _sp = 0; while (cond) { __builtin_amdgcn_s_sleep(1); \
    if ((++_sp & 255u) == 0u) { if (xb_ld(&(bar)[XB_TMO])) break; if (_sp > XB_SPIN_CAP) { atomicAdd(&(bar)[XB_TMO], 1u); break; } } } } while (0)
struct XcdBarrier { unsigned* bar; unsigned x; volatile LAS unsigned* st; };
__device__ __forceinline__ XcdBarrier xcd_barrier_post(unsigned* bar, volatile LAS unsigned* st) {
    XcdBarrier b; b.bar = bar; b.x = xb_xcc_id(); b.st = st;
    if (threadIdx.x == 0) (void)xb_add(&bar[XB_XCNT(b.x)], 1u);
    return b;
}
__device__ __forceinline__ void xcd_barrier_complete(unsigned* bar, unsigned x, unsigned& nloc, unsigned& nx) {
    const unsigned G = gridDim.x * gridDim.y * gridDim.z;
    unsigned sum, cnt, mine, sp = 0u;
    for (;;) {
        sum = 0u; cnt = 0u; mine = 0u;
#pragma unroll
        for (unsigned j = 0; j < 16; ++j) { const unsigned c = xb_ld(&bar[XB_XCNT(j)]); sum += c; cnt += (c > 0u) ? 1u : 0u; mine = (j == x) ? c : mine; }
        if (sum == G) break;
        __builtin_amdgcn_s_sleep(1);
        if ((++sp & 255u) == 0u) { if (xb_ld(&bar[XB_TMO])) break; if (sp > XB_SPIN_CAP) { atomicAdd(&bar[XB_TMO], 1u); break; } }
    }
    nloc = mine > 0u ? mine : 1u; nx = cnt > 0u ? cnt : 1u;
}
__device__ __forceinline__ void xcd_barrier(const XcdBarrier& b) {
    asm volatile("s_waitcnt vmcnt(0)" ::: "memory");
    __syncthreads();
    if (threadIdx.x == 0) {
        unsigned* bar = b.bar;
        __builtin_amdgcn_s_waitcnt(0);
        unsigned nloc = b.st[0], nx = b.st[1];
        if (nloc == 0u) { xcd_barrier_complete(bar, b.x, nloc, nx); b.st[0] = nloc; b.st[1] = nx; }
        const unsigned old = xb_add(&bar[XB_XSUB(b.x)], 1u);
        const unsigned gen = old / nloc;
        if (old + 1u == (gen + 1u) * nloc) {
            __builtin_amdgcn_fence(__ATOMIC_RELEASE, "agent");
            asm volatile("s_waitcnt vmcnt(0)" ::: "memory");
            const unsigned og = xb_add(&bar[XB_TOP], 1u);
            const unsigned tg = og / nx;
            if (og + 1u == (tg + 1u) * nx) xb_add(&bar[XB_TOPGEN], 1u);
            else XB_SPIN(xb_ld(&bar[XB_TOPGEN]) == tg, bar);
            __builtin_amdgcn_fence(__ATOMIC_ACQUIRE, "agent");
            xb_add(&bar[XB_XGEN(b.x)], 1u);
            asm volatile("s_waitcnt vmcnt(0)" ::: "memory");
        } else {
            XB_SPIN(xb_ld(&bar[XB_XGEN(b.x)]) == gen, bar);
            __builtin_amdgcn_fence(__ATOMIC_ACQUIRE, "agent");
            asm volatile("s_waitcnt vmcnt(0)" ::: "memory");
        }
    }
    __syncthreads();
}

struct Args {
    const float *x, *meta, *ln0_g, *ln0_b, *w_in, *conv_w, *conv_b, *gate_bias, *lq1, *lk1, *lq2, *lk2, *att_g, *ml_g, *w_att_out, *w_ml_out, *w_o,
                *ln1_g, *ln1_b, *w_router, *b_router, *w_gu, *b_gu, *w_down, *b_down, *ln2_g, *ln2_b;
    float* out; unsigned char* ws; int ph_lo, ph_hi;
};

template <class ColMap>
__device__ __forceinline__ void transpose_item(const float* W, int K, int N, bf16_t* WT, LAS float* scr, int kb, int nb, int lane, ColMap cm, int ldw = 0) {
    if (ldw == 0) ldw = K;
    const int k0 = 64 * kb, n0 = 32 * nb;
    const int lc = cm(n0 + (lane & 31));
    float tv[32];
    const float* wp = W + (size_t)(k0 + (lane >> 5)) * N + lc;
#pragma unroll
    for (int i = 0; i < 32; ++i) tv[i] = wp[(size_t)(2 * i) * N];
#pragma unroll
    for (int i = 0; i < 32; ++i) { const int kk = 2 * i + (lane >> 5); scr[kk * 33 + (lane & 31)] = tv[i]; }
    LDS_WAIT(); asm volatile("" ::: "memory");
    const int c = lane & 7;
#pragma unroll
    for (int j = 0; j < 4; ++j) { const int n = (lane >> 3) + 8 * j; const LAS float* s = scr + (8 * c) * 33 + n;
        u32x4 o; o.x = pkbf(s[0 * 33], s[1 * 33]); o.y = pkbf(s[2 * 33], s[3 * 33]); o.z = pkbf(s[4 * 33], s[5 * 33]); o.w = pkbf(s[6 * 33], s[7 * 33]);
        *(u32x4*)(WT + (size_t)(n0 + n) * ldw + k0 + 8 * c) = o; }
    LDS_WAIT(); asm volatile("" ::: "memory");
}
template <class ColMap>
__device__ __forceinline__ void transpose_item2(const float* W, int K, int N, bf16_t* WT, LAS float* scr, int kb, int nb, int lane, ColMap cm) {
    const int k0 = 64 * kb, n0 = 32 * nb;
    const int lc0 = cm(n0 + (lane & 31)), lc1 = cm(n0 + 32 + (lane & 31));
    float ta[32], tb[32];
    const float* wp = W + (size_t)(k0 + (lane >> 5)) * N;
#pragma unroll
    for (int i = 0; i < 32; ++i) { ta[i] = wp[(size_t)(2 * i) * N + lc0]; tb[i] = wp[(size_t)(2 * i) * N + lc1]; }
    LAS float* scr2 = scr + 64 * 33;
#pragma unroll
    for (int i = 0; i < 32; ++i) { const int kk = 2 * i + (lane >> 5); scr[kk * 33 + (lane & 31)] = ta[i]; scr2[kk * 33 + (lane & 31)] = tb[i]; }
    LDS_WAIT(); asm volatile("" ::: "memory");
    const int c = lane & 7;
#pragma unroll
    for (int h2 = 0; h2 < 2; ++h2) { const LAS float* sb = h2 ? scr2 : scr;
#pragma unroll
        for (int j = 0; j < 4; ++j) { const int n = (lane >> 3) + 8 * j; const LAS float* sp = sb + (8 * c) * 33 + n;
            u32x4 o; o.x = pkbf(sp[0 * 33], sp[1 * 33]); o.y = pkbf(sp[2 * 33], sp[3 * 33]); o.z = pkbf(sp[4 * 33], sp[5 * 33]); o.w = pkbf(sp[6 * 33], sp[7 * 33]);
            *(u32x4*)(WT + (size_t)(n0 + 32 * h2 + n) * K + k0 + 8 * c) = o; } }
    LDS_WAIT(); asm volatile("" ::: "memory");
}
template <class InvMap>
__device__ __forceinline__ void transpose_tile64(const float* W, int N, bf16_t* WT, int ldw, LAS unsigned char* scr, int k0, int c0, int lane, InvMap inv) {
    constexpr int TP = 136;
    asm volatile("" : "+v"(lane));
    const float* wp = W + (size_t)(k0 + (lane >> 4)) * N + c0 + (lane & 15) * 4;
#pragma unroll
    for (int hf = 0; hf < 2; ++hf) {
        f32x4 tv[8];
#pragma unroll
        for (int i = 0; i < 8; ++i) tv[i] = *(const f32x4*)(wp + (size_t)(4 * (8 * hf + i)) * N);
#pragma unroll
        for (int i = 0; i < 8; ++i) { u32x2 w; w.x = pkbf(tv[i][0], tv[i][1]); w.y = pkbf(tv[i][2], tv[i][3]);
            *(LAS u32x2*)(scr + ((lane >> 4) + 4 * (8 * hf + i)) * TP + (lane & 15) * 8) = w; }
        asm volatile("" ::: "memory");
    }
    LDS_WAIT(); asm volatile("" ::: "memory");
    const int g = lane >> 4, p = lane & 15;
#pragma unroll
    for (int it = 0; it < 8; ++it) {
        const int cq = it & 3, kq = (it >> 2) * 4 + g;
        const LAS unsigned char* a = scr + (8 * kq + (p >> 2)) * TP + (16 * cq + 4 * (p & 3)) * 2;
        const attn_body::s16x4 lo = attn_body::vtr((attn_body::lds_cptr)a), hi4 = attn_body::vtr((attn_body::lds_cptr)(a + 4 * TP));
        u32x4 o; o.x = (unsigned)(unsigned short)lo[0] | ((unsigned)(unsigned short)lo[1] << 16); o.y = (unsigned)(unsigned short)lo[2] | ((unsigned)(unsigned short)lo[3] << 16);
        o.z = (unsigned)(unsigned short)hi4[0] | ((unsigned)(unsigned short)hi4[1] << 16); o.w = (unsigned)(unsigned short)hi4[2] | ((unsigned)(unsigned short)hi4[3] << 16);
        *(u32x4*)(WT + (size_t)inv(c0 + 16 * cq + p) * ldw + k0 + 8 * kq) = o;
    }
    LDS_WAIT(); asm volatile("" ::: "memory");
}
struct InvIdent { __device__ __forceinline__ int operator()(int c) const { return c; } };
struct InvGu {
    __device__ __forceinline__ int operator()(int c) const { const int sgl = c & 1, idx = c >> 1; return 256 * (idx >> 7) + 128 * sgl + (idx & 127); } };
struct CmIdent { __device__ __forceinline__ int operator()(int p) const { return p; } };
struct CmWin {
    __device__ __forceinline__ int operator()(int P) const {
        if (P < 1024) { const int hb = P >> 6, p = P & 63, wcp = p >> 5, fq = (p & 31) >> 3, n = (p & 7) >> 2, j = p & 3; return hb * 64 + 32 * n + 16 * wcp + 4 * fq + j; }
        if (P < 3584) return P;
        return P + 8;
    }
};
struct CmGu {
    __device__ __forceinline__ int operator()(int P) const { const int pn = P >> 8, s = (P >> 7) & 1, i = P & 127; return 2 * (128 * pn + i) + s; }
};

__global__ void __launch_bounds__(NWAVES * 64, 2) hybrid_fwd(Args a) {
    extern __shared__ __attribute__((aligned(16))) unsigned char lds[];
    LAS unsigned char* L = (LAS unsigned char*)lds;
    const int tid = threadIdx.x, lane = tid & 63, wave = __builtin_amdgcn_readfirstlane(tid >> 6);
    const int G = gridDim.x, blk = blockIdx.x;
    const int gw = blk * NWAVES + wave, NGW = G * NWAVES;
    if (tid < 16) ((LAS unsigned*)(L + MISC_OFF))[tid] = 0u;
    LAS unsigned long long* ptab = (LAS unsigned long long*)(L + MISC_OFF + 64);
    if (tid == 0) {
        ptab[0] = (unsigned long long)a.x; ptab[1] = (unsigned long long)a.meta; ptab[2] = (unsigned long long)a.ln0_g; ptab[3] = (unsigned long long)a.ln0_b; ptab[4] = (unsigned long long)a.w_in;
        ptab[5] = (unsigned long long)a.conv_w; ptab[6] = (unsigned long long)a.conv_b; ptab[7] = (unsigned long long)a.gate_bias; ptab[8] = (unsigned long long)a.lq1; ptab[9] = (unsigned long long)a.lk1;
        ptab[10] = (unsigned long long)a.lq2; ptab[11] = (unsigned long long)a.lk2; ptab[12] = (unsigned long long)a.att_g; ptab[13] = (unsigned long long)a.ml_g; ptab[14] = (unsigned long long)a.w_att_out;
        ptab[15] = (unsigned long long)a.w_ml_out; ptab[16] = (unsigned long long)a.w_o; ptab[17] = (unsigned long long)a.ln1_g; ptab[18] = (unsigned long long)a.ln1_b; ptab[19] = (unsigned long long)a.w_router;
        ptab[20] = (unsigned long long)a.b_router; ptab[21] = (unsigned long long)a.w_gu; ptab[22] = (unsigned long long)a.b_gu; ptab[23] = (unsigned long long)a.w_down; ptab[24] = (unsigned long long)a.b_down;
        ptab[25] = (unsigned long long)a.ln2_g; ptab[26] = (unsigned long long)a.ln2_b; ptab[27] = (unsigned long long)a.out; ptab[28] = (unsigned long long)a.ws;
    }
    asm volatile("s_waitcnt lgkmcnt(0)" ::: "memory");
    __syncthreads();
    asm volatile("" ::: "memory");
#define PF(i) ((const float*)ldptr(ptab, (i)))
#define WSP ((unsigned char*)ldptr(ptab, 28))
#define DOUTP ((unsigned char*)ldptr(ptab, 27))
#define ctl ((unsigned*)(WSP + WS_CTL))
#define WinT ((bf16_t*)(WSP + WS_WIN))
#define WaT ((bf16_t*)(WSP + WS_WA))
#define WmT ((bf16_t*)(WSP + WS_WM))
#define WoT ((bf16_t*)(WSP + WS_WO))
#define ropec ((float*)(WSP + WS_ROPE))
#define ropes (ropec + TT * 32)
#define stats ((float*)(WSP + WS_STATS))
#define gates ((float*)(WSP + WS_GATES))
#define tok_e ((int*)(WSP + WS_TOKE))
#define tok_g ((float*)(WSP + WS_TOKG))
#define hist ((int*)(WSP + WS_HIST))
#define row_off ((int*)(WSP + WS_ROWOFF))
#define row_slot ((int*)(WSP + WS_ROWSLOT))
#define row_gate ((float*)(WSP + WS_ROWGATE))
#define tile_exp ((int*)(WSP + WS_TILEEXP))
#define Hb ((bf16_t*)(WSP + WS_H))
#define Z ((bf16_t*)(WSP + WS_Z))
#define Y ((bf16_t*)(WSP + WS_Y))
#define ACT ((bf16_t*)(WSP + WS_ACT))
#define Qc ((bf16_t*)(WSP + WS_QC))
#define Kc ((bf16_t*)(WSP + WS_KC))
#define Vc ((bf16_t*)(WSP + WS_VC))
#define TMPb ((bf16_t*)(WSP + WS_TMP))
#define MRGb ((bf16_t*)(WSP + WS_MRG))
#define GFb ((bf16_t*)(WSP + WS_GF))
#define YCb ((bf16_t*)(WSP + WS_H))
#define Ob ((bf16_t*)(WSP + WS_O))
#define WguT ((bf16_t*)(DOUTP + DO_WGU))
#define WdnT ((bf16_t*)(DOUTP + DO_WDN))
#if !MK_PER_PHASE
    XcdBarrier bar = xcd_barrier_post(ctl + CW_BAR, (volatile LAS unsigned*)(L + MISC_OFF + 32));
#define GRID_BAR() xcd_barrier(bar)
#else
#define GRID_BAR() do {} while (0)
#endif
    const int lo = a.ph_lo, hi = a.ph_hi;
#if MK_PROBE == 2
    LAS unsigned* pdur = (LAS unsigned*)(L + MISC_OFF + 320);
    if (blk == 0 && tid == 0) { pdur[30] = (unsigned)__builtin_amdgcn_s_memrealtime(); pdur[31] = pdur[30]; pdur[29] = pdur[30]; for (int q_ = 16; q_ < 29; ++q_) pdur[q_] = 0u; }
#define PSTAMP(k) do { if (blk == 0 && tid == 0) { const unsigned now_ = (unsigned)__builtin_amdgcn_s_memrealtime(); pdur[k] = now_ - pdur[30]; pdur[30] = now_; } } while (0)
#define CSTAMP(k) do { if (blk == 0 && tid == 0) { const unsigned now_ = (unsigned)__builtin_amdgcn_s_memrealtime(); pdur[16 + (k)] += now_ - pdur[31]; pdur[31] = now_; } } while (0)
#else
#define PSTAMP(k) do {} while (0)
#define CSTAMP(k) do {} while (0)
#endif
#define IN(k) (lo <= (k) && (k) < hi)
#define BOTH(k) (IN(k) && IN((k) + 1))

    if (IN(0)) REPLOOP(0) {
        {   LAS float* scr = (LAS float*)(L + wave * 16384);
            constexpr int I_IN = 16 * (NZP / 32), I_A = 8 * 32, I_O = 16 * 32;
            constexpr int NIT = I_IN + 2 * I_A + I_O;
            for (int it = gw; it < NIT; it += NGW) {
                int r = it;
                if (r < I_IN) { transpose_item(PF(4), 1024, NIN, WinT, scr, r / (NZP / 32), r % (NZP / 32), lane, CmWin()); continue; } r -= I_IN;
                if (r < I_A) { transpose_item(PF(14), 512, 1024, WaT, scr, r / 32, r % 32, lane, CmIdent(), 1024); continue; } r -= I_A;
                if (r < I_A) { transpose_item(PF(15), 512, 1024, WaT + 512, scr, r / 32, r % 32, lane, CmIdent(), 1024); continue; } r -= I_A;
                transpose_item(PF(16), 1024, 1024, WoT, scr, r / 32, r % 32, lane, CmIdent());
            }
        }
        for (int i = blk * 512 + tid; i < TT * 32; i += G * 512) {
            const int t = i >> 5, f = i & 31;
            const double inv = exp2(-(double)f * (13.287712379549449 / 32.0));
            const double rev = (double)t * inv * 0.15915494309189535;
            const float fr = (float)(rev - floor(rev));
            ropec[i] = __builtin_amdgcn_cosf(fr); ropes[i] = __builtin_amdgcn_sinf(fr);
        }
        __syncthreads();
        LAS float* wg = (LAS float*)L;
        for (int i = tid; i < 8 * 1024; i += 512) { const int gc = i >> 10, k = i & 1023; wg[i] = PF(4)[(size_t)k * NIN + 3584 + gc]; }
        __syncthreads();
        {
            const float* xin = PF(0); const float* metap = PF(1); const float* gbias = PF(7);
            const float* g0p = PF(2); const float* b0p = PF(3);
            bf16_t* Hbp = Hb; float* statsp = stats; float* gatesp = gates;
            const int q_of_lane = (lane >> 1) & 7, r_of_lane = lane >> 4;
            const float gb = gbias[q_of_lane];
            for (int base = gw * 4; base < MROWS; base += NGW * 4) {
                f32x4 v[4][4]; float sm[4];
#pragma unroll
                for (int r = 0; r < 4; ++r) { const int row = (base + r < MROWS) ? base + r : MROWS - 1;
                    const float* xr = (row < NREAL) ? xin + (size_t)row * DM : metap + (size_t)((row - NREAL) & (NMETA - 1)) * DM;
#pragma unroll
                    for (int j = 0; j < 4; ++j) v[r][j] = *(const f32x4*)(xr + 4 * lane + 256 * j); }
#pragma unroll
                for (int r = 0; r < 4; ++r) { float s = 0.f;
#pragma unroll
                    for (int j = 0; j < 4; ++j) s += (v[r][j][0] + v[r][j][1]) + (v[r][j][2] + v[r][j][3]);
                    sm[r] = s; }
                float mean[4], rstd[4];
#pragma unroll
                for (int r = 0; r < 4; ++r) mean[r] = wave_sum(sm[r]) * (1.f / DM);
#pragma unroll
                for (int r = 0; r < 4; ++r) { float s2 = 0.f;
#pragma unroll
                    for (int j = 0; j < 4; ++j) { const f32x4 d = v[r][j] - mean[r]; s2 += (d[0] * d[0] + d[1] * d[1]) + (d[2] * d[2] + d[3] * d[3]); }
                    sm[r] = s2; }
#pragma unroll
                for (int r = 0; r < 4; ++r) rstd[r] = 1.0f / sqrtf(wave_sum(sm[r]) * (1.f / DM) + LN_EPS);
                float gp[32];
#pragma unroll
                for (int q = 0; q < 32; ++q) gp[q] = 0.f;
#pragma unroll
                for (int j = 0; j < 4; ++j) {
                    const f32x4 ggj = *(const f32x4*)(g0p + 4 * lane + 256 * j), bbj = *(const f32x4*)(b0p + 4 * lane + 256 * j);
#pragma unroll
                    for (int r = 0; r < 4; ++r) { v[r][j] = (v[r][j] - mean[r]) * rstd[r] * ggj + bbj;
                        if (base + r < MROWS) { u32x2 w; w.x = pkbf(v[r][j][0], v[r][j][1]); w.y = pkbf(v[r][j][2], v[r][j][3]); *(u32x2*)(Hbp + (size_t)(base + r) * DM + 4 * lane + 256 * j) = w; } }
#pragma unroll
                    for (int q = 0; q < 8; ++q) { const f32x4 wv = *(const LAS f32x4*)(wg + q * 1024 + 4 * lane + 256 * j);
#pragma unroll
                        for (int r = 0; r < 4; ++r) gp[r * 8 + q] += (v[r][j][0] * wv[0] + v[r][j][1] * wv[1]) + (v[r][j][2] * wv[2] + v[r][j][3] * wv[3]); }
                }
                const float gsum = xreduce32(gp, lane);
                const int rowl = base + r_of_lane;
                if (rowl < MROWS) {
                    if ((lane & 1) == 0) { float gv = gsum + gb;
                        if (q_of_lane >= 4) gv = (gv >= 0.f) ? -log1pf(expf(-gv)) : gv - log1pf(expf(gv));
                        gatesp[(size_t)rowl * 8 + q_of_lane] = gv; }
                    if ((lane & 15) == 0) { const float mr = (r_of_lane == 0) ? mean[0] : (r_of_lane == 1) ? mean[1] : (r_of_lane == 2) ? mean[2] : mean[3];
                        const float rr = (r_of_lane == 0) ? rstd[0] : (r_of_lane == 1) ? rstd[1] : (r_of_lane == 2) ? rstd[2] : rstd[3];
                        statsp[2 * rowl] = mr; statsp[2 * rowl + 1] = rr; }
                }
            }
        }
        __syncthreads();
        if (BOTH(0) || rep_ + 1 < REP_0) GRID_BAR();
    }
    PSTAMP(0);

    if (IN(1)) REPLOOP(1) {
        pg8::Gemm g{Hb, WinT, DM, DM, NZP / 256, nullptr, nullptr, 0};
        pg8::StaticOrder S; S.init(MROWS / 256, NZP / 256, G, blk);
        pg8::EpiZ E{Z, Qc, Kc, Vc, ropec, ropes, GFb};
        pg8::gemm_phase<0, pg8::EpiZ>(L, g, S, E);
        if (BOTH(1) || rep_ + 1 < REP_1) GRID_BAR();
    }
    PSTAMP(1);

    if (IN(2)) {
        REPLOOP(2B) {
            constexpr int PQ = 136;
            LAS bf16_t* Qs = (LAS bf16_t*)L;
            LAS bf16_t* Ks = Qs + 128 * PQ;
            LAS bf16_t* VTs = Ks + 128 * PQ;
            LAS bf16_t* Cs = VTs + 144 * PQ;
            LAS float* fv = (LAS float*)(Cs + 144 * PQ);
            LAS float* v_a = fv;
            LAS float* v_M = fv + 128;
            LAS float* v_b = fv + 256;
            LAS float* v_w = fv + 384;
            LAS float* v_sc = fv + 512;
            LAS float* cw = fv + 528;
            const float* convw = PF(5); const float* convb = PF(6); const float* mlg = PF(13); const float* gatesp = gates;
            bf16_t* Zp = Z; bf16_t* YCp = YCb;
            for (int u = blk; u < NB * 4; u += G) {
                const int b = u >> 2, h = u & 3;
                __syncthreads();
                for (int i = tid; i < 5 * 256; i += 512) { const int j = i >> 8, c = i & 255; const int ch = (c < 128) ? (h * 128 + c) : (512 + h * 128 + (c - 128));
                    cw[i] = (j < 4) ? convw[j * 1024 + ch] : convb[ch]; }
                for (int i = tid; i < 144 * PQ; i += 512) { const int rr = i / PQ; VTs[i] = (rr == 128) ? (bf16_t)0x3f80 : (bf16_t)0; Cs[i] = 0; }
                if (tid == 0) v_sc[0] = 0.f;
                f32x4 Cst[9];
#pragma unroll
                for (int jt = 0; jt < 9; ++jt) Cst[jt] = (f32x4){0.f, 0.f, 0.f, 0.f};
                LAS float* gml_s = cw + 1280 + 384;
                int tid_o = tid; asm volatile("" : "+v"(tid_o));
#define ML_IDX() int tq_ = tid_o; asm volatile("" : "+v"(tq_)); const int dg = tq_ & 15, s0 = (tq_ >> 4) * 4, fr = tq_ & 15, quad = (tq_ >> 4) & 3; (void)dg; (void)s0; (void)fr; (void)quad;
                LAS bf16_t* halo = (LAS bf16_t*)(cw + 1280);
                for (int i = tid_o; i < 2 * 3 * 128; i += 512) halo[i] = 0;
                if (tid_o < 128) gml_s[tid_o] = mlg[h * 128 + tid_o];
                u32x4 rq[4], rk[4], rv[4]; float gx0 = 0.f, gx1 = 0.f, gi0 = -1e30f, gi1 = -1e30f;
#define ML_LBAR() asm volatile("s_waitcnt lgkmcnt(0)\n\ts_barrier" ::: "memory")
#define ML_LOADRAW(tc0) do { \
                    _Pragma("unroll") for (int i_ = 0; i_ < 4; ++i_) { const int t_ = (tc0) + s0 + i_; rq[i_] = (u32x4){0u, 0u, 0u, 0u}; rk[i_] = rq[i_]; rv[i_] = rq[i_]; \
                        if (t_ < TT) { const bf16_t* zr_ = Zp + (size_t)row_of(b, t_) * NZ + h * 128 + dg * 8; rq[i_] = *(const u32x4*)(zr_ + ZMQ); rk[i_] = *(const u32x4*)(zr_ + ZMK); rv[i_] = *(const u32x4*)(zr_ + ZMV); } } \
                    if (wave == 0) { const int ta_ = (tc0) + 2 * lane, tb_ = ta_ + 1; \
                        gx0 = (ta_ < TT) ? ld_agent_f(gatesp + (size_t)row_of(b, ta_) * 8 + 4 + h) : 0.f; gi0 = (ta_ < TT) ? ld_agent_f(gatesp + (size_t)row_of(b, ta_) * 8 + h) : -1e30f; \
                        gx1 = (tb_ < TT) ? ld_agent_f(gatesp + (size_t)row_of(b, tb_) * 8 + 4 + h) : 0.f; gi1 = (tb_ < TT) ? ld_agent_f(gatesp + (size_t)row_of(b, tb_) * 8 + h) : -1e30f; } } while (0)
                { ML_IDX(); ML_LOADRAW(0); }
                for (int c = 0; c < 33; ++c) {
                    const int t0 = c * 128;
                    ML_LBAR(); CSTAMP(0);
                    if (wave == 0) {
                        const float m_old0 = v_sc[0];
                        const float x0 = gx0, x1 = gx1, i0 = gi0, i1 = gi1;
                        const float sacc = wave_scan_add(x0 + x1);
                        const float ex = sacc - (x0 + x1);
                        const float b0 = ex + x0, b1 = b0 + x1;
                        const float a0 = i0 - b0, a1 = i1 - b1;
                        const float mx = wave_scan_max(fmaxf(a0, a1));
                        float exm = __shfl_up(mx, 1); if (lane == 0) exm = -INFINITY;
                        const float M0 = fmaxf(fmaxf(m_old0, exm), a0), M1 = fmaxf(M0, a1);
                        const float Ml = __shfl(M1, 63);
                        v_b[2 * lane] = b0; v_b[2 * lane + 1] = b1; v_a[2 * lane] = a0; v_a[2 * lane + 1] = a1; v_M[2 * lane] = M0; v_M[2 * lane + 1] = M1;
                        v_w[2 * lane] = (t0 + 2 * lane < TT) ? __expf(a0 - Ml) : 0.f; v_w[2 * lane + 1] = (t0 + 2 * lane + 1 < TT) ? __expf(a1 - Ml) : 0.f;
                        if (lane == 63) v_sc[1] = M1;
                    }
                    { ML_IDX();
#pragma unroll
                    for (int i = 0; i < 4; ++i) { *(LAS u32x4*)(Qs + (s0 + i) * PQ + dg * 8) = rq[i]; *(LAS u32x4*)(Ks + (s0 + i) * PQ + dg * 8) = rk[i]; }
#pragma unroll
                    for (int w2 = 0; w2 < 4; ++w2) {
                        const unsigned a0_ = rv[0][w2], a1_ = rv[1][w2], a2_ = rv[2][w2], a3_ = rv[3][w2];
                        u32x2 lo2, hi2; lo2.x = (a0_ & 0xffffu) | (a1_ << 16); lo2.y = (a2_ & 0xffffu) | (a3_ << 16);
                        hi2.x = (a0_ >> 16) | (a1_ & 0xffff0000u); hi2.y = (a2_ >> 16) | (a3_ & 0xffff0000u);
                        *(LAS u32x2*)(VTs + (dg * 8 + 2 * w2) * PQ + s0) = lo2; *(LAS u32x2*)(VTs + (dg * 8 + 2 * w2 + 1) * PQ + s0) = hi2;
                    } }
                    ML_LBAR(); CSTAMP(1);
                    {   ML_IDX();
                        u32x4 hq[3], hk[3];
#pragma unroll
                        for (int i = 0; i < 3; ++i) {
                            if (s0 > 0) { hq[i] = *(const LAS u32x4*)(Qs + (s0 - 3 + i) * PQ + dg * 8); hk[i] = *(const LAS u32x4*)(Ks + (s0 - 3 + i) * PQ + dg * 8); }
                            else { hq[i] = *(const LAS u32x4*)(halo + i * 128 + dg * 8); hk[i] = *(const LAS u32x4*)(halo + 384 + i * 128 + dg * 8); }
                        }
                        asm volatile("s_waitcnt lgkmcnt(0)" ::: "memory");
                        ML_LBAR(); CSTAMP(2);
                        u32x4 cq[4], ck[4];
#pragma unroll
                        for (int w2 = 0; w2 < 4; ++w2) {
                            int dgo = dg; asm volatile("" : "+v"(dgo));
                            f32x2 xq[7], xk[7];
#pragma unroll
                            for (int r = 0; r < 7; ++r) { const unsigned uq = (r < 3) ? hq[r < 3 ? r : 0][w2] : rq[r >= 3 ? r - 3 : 0][w2], uk = (r < 3) ? hk[r < 3 ? r : 0][w2] : rk[r >= 3 ? r - 3 : 0][w2];
                                xq[r] = (f32x2){bflo(uq), bfhi(uq)}; xk[r] = (f32x2){bflo(uk), bfhi(uk)}; }
                            const LAS f32x2* wp = (const LAS f32x2*)(cw + dgo * 8 + 2 * w2);
                            f32x2 wq[4], wk[4];
#pragma unroll
                            for (int j = 0; j < 4; ++j) { wq[j] = wp[j * 128]; wk[j] = wp[j * 128 + 64]; }
                            const f32x2 bq = wp[4 * 128], bk = wp[4 * 128 + 64];
#pragma unroll
                            for (int i = 0; i < 4; ++i) {
                                f32x2 aq = bq, ak = bk;
#pragma unroll
                                for (int j = 0; j < 4; ++j) { aq += wq[j] * xq[i + j]; ak += wk[j] * xk[i + j]; }
                                const bool live = (t0 + s0 + i < TT);
                                const float q0 = live ? aq[0] * sigmoidf_(aq[0]) : 0.f, q1 = live ? aq[1] * sigmoidf_(aq[1]) : 0.f;
                                const float k0 = live ? ak[0] * sigmoidf_(ak[0]) * 0.08838834764831845f : 0.f, k1 = live ? ak[1] * sigmoidf_(ak[1]) * 0.08838834764831845f : 0.f;
                                cq[i][w2] = pkbf(q0, q1); ck[i][w2] = pkbf(k0, k1);
                            }
                        }
#pragma unroll
                        for (int i = 0; i < 4; ++i) { *(LAS u32x4*)(Qs + (s0 + i) * PQ + dg * 8) = cq[i]; *(LAS u32x4*)(Ks + (s0 + i) * PQ + dg * 8) = ck[i]; }
                    if (s0 == 124) {
#pragma unroll
                        for (int i = 0; i < 3; ++i) { *(LAS u32x4*)(halo + i * 128 + dg * 8) = rq[i + 1]; *(LAS u32x4*)(halo + 384 + i * 128 + dg * 8) = rk[i + 1]; }
                    }
                    if (c + 1 < 33) ML_LOADRAW(t0 + 128);
                    }
                    ML_LBAR(); CSTAMP(3);
                    const float Mlast = v_sc[1], m_old = v_sc[0];
                    f32x4 St[8];
#pragma unroll
                    for (int j = 0; j < 8; ++j) St[j] = (f32x4){0.f, 0.f, 0.f, 0.f};
                    {   ML_IDX();
                        bf16x8 af[4];
#pragma unroll
                        for (int kk = 0; kk < 4; ++kk) af[kk] = *(const LAS bf16x8*)(Qs + (16 * wave + fr) * PQ + kk * 32 + quad * 8);
#pragma unroll
                        for (int j = 0; j < 8; ++j) if (j <= wave) {
#pragma unroll
                            for (int kk = 0; kk < 4; ++kk) { const bf16x8 bfv = *(const LAS bf16x8*)(Ks + (16 * j + fr) * PQ + kk * 32 + quad * 8);
                                St[j] = __builtin_amdgcn_mfma_f32_16x16x32_bf16(af[kk], bfv, St[j], 0, 0, 0); }
                        }
                    }
                    {   ML_IDX();
                        const float w_old = __expf(m_old - Mlast);
#pragma unroll
                        for (int jt = 0; jt < 9; ++jt) Cst[jt] = Cst[jt] * w_old;
#pragma unroll
                        for (int kk = 0; kk < 4; ++kk) {
                            const int rb = 32 * kk + 8 * quad;
                            const LAS bf16_t* kp = Ks + (rb + (fr >> 2)) * PQ + 16 * wave + 4 * (fr & 3);
                            const attn_body::s16x4 lo = attn_body::vtr((attn_body::lds_cptr)kp), hi4 = attn_body::vtr((attn_body::lds_cptr)(kp + 4 * PQ));
                            const f32x4 w0 = *(const LAS f32x4*)(v_w + rb), w1 = *(const LAS f32x4*)(v_w + rb + 4);
                            float kf[8];
#pragma unroll
                            for (int q = 0; q < 4; ++q) { kf[q] = __uint_as_float(((unsigned)(unsigned short)lo[q]) << 16) * w0[q]; kf[4 + q] = __uint_as_float(((unsigned)(unsigned short)hi4[q]) << 16) * w1[q]; }
                            u32x4 kw; kw.x = pkbf(kf[0], kf[1]); kw.y = pkbf(kf[2], kf[3]); kw.z = pkbf(kf[4], kf[5]); kw.w = pkbf(kf[6], kf[7]);
                            const bf16x8 bk = __builtin_bit_cast(bf16x8, kw);
#pragma unroll
                            for (int jt = 0; jt < 9; ++jt) { const bf16x8 av = *(const LAS bf16x8*)(VTs + (16 * jt + fr) * PQ + kk * 32 + quad * 8);
                                Cst[jt] = __builtin_amdgcn_mfma_f32_16x16x32_bf16(av, bk, Cst[jt], 0, 0, 0); }
                        }
                    }
                    ML_LBAR(); CSTAMP(4);
                    {   ML_IDX();
                        float Ms[4];
#pragma unroll
                        for (int jj = 0; jj < 4; ++jj) Ms[jj] = v_M[16 * wave + 4 * quad + jj];
#pragma unroll
                        for (int j = 0; j < 8; ++j) {
                            const int r = 16 * j + fr; const float ar = v_a[r];
#pragma unroll
                            for (int jj = 0; jj < 4; ++jj) { const int sx = 16 * wave + 4 * quad + jj;
                                const float w = (j <= wave && r <= sx) ? St[j][jj] * __expf(ar - Ms[jj]) : 0.f;
                                Ks[sx * PQ + r] = (bf16_t)(pkbf(w, 0.f) & 0xffffu); }
                        }
                    }
                    ML_LBAR(); CSTAMP(5);
                    float hv[8][4];
                    {   ML_IDX();
                        bf16x8 af[4], as_[4];
#pragma unroll
                        for (int kk = 0; kk < 4; ++kk) { af[kk] = *(const LAS bf16x8*)(Qs + (16 * wave + fr) * PQ + kk * 32 + quad * 8); as_[kk] = *(const LAS bf16x8*)(Ks + (16 * wave + fr) * PQ + kk * 32 + quad * 8); }
                        float winter[4], rd[4], ssq[4];
                        {   f32x4 n1 = (f32x4){0.f, 0.f, 0.f, 0.f}, n2 = n1;
#pragma unroll
                            for (int kk = 0; kk < 4; ++kk) { const bf16x8 bc = *(const LAS bf16x8*)(Cs + (128 + fr) * PQ + kk * 32 + quad * 8); const bf16x8 bvv = *(const LAS bf16x8*)(VTs + (128 + fr) * PQ + kk * 32 + quad * 8);
                                n1 = __builtin_amdgcn_mfma_f32_16x16x32_bf16(af[kk], bc, n1, 0, 0, 0); n2 = __builtin_amdgcn_mfma_f32_16x16x32_bf16(as_[kk], bvv, n2, 0, 0, 0); }
#pragma unroll
                            for (int jj = 0; jj < 4; ++jj) { const int sx = 16 * wave + 4 * quad + jj; const float Ms = v_M[sx]; winter[jj] = __expf(m_old - Ms);
                                float den = winter[jj] * n1[jj] + n2[jj];
                                den = __shfl(den, lane & 48);
                                rd[jj] = 1.0f / fmaxf(fabsf(den), __expf(-(v_b[sx] + Ms))); ssq[jj] = 0.f; }
                        }
#pragma unroll
                        for (int g2 = 0; g2 < 2; ++g2) {
                            f32x4 n1[4], n2[4];
#pragma unroll
                            for (int q = 0; q < 4; ++q) { n1[q] = (f32x4){0.f, 0.f, 0.f, 0.f}; n2[q] = n1[q]; }
#pragma unroll
                            for (int kk = 0; kk < 4; ++kk)
#pragma unroll
                                for (int q = 0; q < 4; ++q) { const int jt = 4 * g2 + q;
                                    const bf16x8 bc = *(const LAS bf16x8*)(Cs + (16 * jt + fr) * PQ + kk * 32 + quad * 8); const bf16x8 bvv = *(const LAS bf16x8*)(VTs + (16 * jt + fr) * PQ + kk * 32 + quad * 8);
                                    n1[q] = __builtin_amdgcn_mfma_f32_16x16x32_bf16(af[kk], bc, n1[q], 0, 0, 0); n2[q] = __builtin_amdgcn_mfma_f32_16x16x32_bf16(as_[kk], bvv, n2[q], 0, 0, 0); }
#pragma unroll
                            for (int q = 0; q < 4; ++q)
#pragma unroll
                                for (int jj = 0; jj < 4; ++jj) { const float x = (winter[jj] * n1[q][jj] + n2[q][jj]) * rd[jj]; hv[4 * g2 + q][jj] = x; ssq[jj] += x * x; }
                        }
#pragma unroll
                        for (int jj = 0; jj < 4; ++jj) { const float rs = 1.0f / sqrtf(row_sum16(ssq[jj]) * (1.f / 128.f) + LN_EPS);
#pragma unroll
                            for (int jt = 0; jt < 8; ++jt) hv[jt][jj] *= rs * gml_s[16 * jt + fr]; }
                    }
                    ML_LBAR(); CSTAMP(6);
                    u32x4 rmo[4];
                    { ML_IDX();
#pragma unroll
                    for (int i = 0; i < 4; ++i) { const int t = t0 + s0 + i; rmo[i] = (u32x4){0u, 0u, 0u, 0u};
                        if (t >= NMETA && t < TT) rmo[i] = *(const u32x4*)(Zp + (size_t)row_of(b, t) * NZ + ZMO + h * 128 + dg * 8); }
#pragma unroll
                    for (int jt = 0; jt < 8; ++jt)
#pragma unroll
                        for (int jj = 0; jj < 4; ++jj) Qs[(16 * wave + 4 * quad + jj) * PQ + 16 * jt + fr] = (bf16_t)(pkbf(hv[jt][jj], 0.f) & 0xffffu);
#pragma unroll
                    for (int jt = 0; jt < 9; ++jt)
#pragma unroll
                        for (int jj = 0; jj < 4; ++jj) Cs[(16 * jt + 4 * quad + jj) * PQ + 16 * wave + fr] = (bf16_t)(pkbf(Cst[jt][jj], 0.f) & 0xffffu);
                    if (tid == 0) v_sc[0] = v_b[127] + Mlast;
                    }
                    ML_LBAR(); CSTAMP(7);
                    { ML_IDX();
#pragma unroll
                    for (int i = 0; i < 4; ++i) {
                        const int s = s0 + i, t = t0 + s;
                        if (t >= NMETA && t < TT) {
                            const u32x4 hw = *(const LAS u32x4*)(Qs + s * PQ + dg * 8);
                            const u32x4 mw = rmo[i];
                            u32x4 wy;
                            wy.x = pkbf(sigmoidf_(bflo(mw.x)) * bflo(hw.x), sigmoidf_(bfhi(mw.x)) * bfhi(hw.x)); wy.y = pkbf(sigmoidf_(bflo(mw.y)) * bflo(hw.y), sigmoidf_(bfhi(mw.y)) * bfhi(hw.y));
                            wy.z = pkbf(sigmoidf_(bflo(mw.z)) * bflo(hw.z), sigmoidf_(bfhi(mw.z)) * bfhi(hw.z)); wy.w = pkbf(sigmoidf_(bflo(mw.w)) * bflo(hw.w), sigmoidf_(bfhi(mw.w)) * bfhi(hw.w));
                            *(u32x4*)(YCp + (size_t)row_of(b, t) * DM + 512 + h * 128 + dg * 8) = wy;
                        }
                    } }
                }
            }
        }
#undef ML_LOADRAW
#undef ML_LBAR
#undef ML_IDX
        PSTAMP(13);
        __syncthreads();
        REPLOOP(2A) {
            LAS int* tkt = (LAS int*)(L + MISC_OFF + 16);
            bf16_t* Qcp = Qc; bf16_t* Kcp = Kc; bf16_t* Vcp = Vc; bf16_t* YCp2 = YCb; unsigned* tctr = ctl + CW_TICKET + 64 * rep_;
            const float* attg = PF(12); unsigned char* parkb = WSP + WS_O;
            float lam;
            { const float p1 = wave_sum(PF(8)[lane] * PF(9)[lane]), p2 = wave_sum(PF(10)[lane] * PF(11)[lane]); lam = expf(p1) - expf(p2) + LAMBDA_INIT; }
            const float* wgu = PF(21); const float* wdn = PF(23); bf16_t* WguTp = WguT; bf16_t* WdnTp = WdnT;
            constexpr int NATT = NB * 4 * 16, NJOB = NE * 16;
            int nextT = 0;
            if (tid == 0) nextT = (int)__hip_atomic_fetch_add(tctr, 1u, RLX_AGENT);
            for (;;) {
                __syncthreads();
                if (tid == 0) { *tkt = nextT; nextT = (int)__hip_atomic_fetch_add(tctr, 1u, RLX_AGENT); }
                __syncthreads();
                const int T = __builtin_amdgcn_readfirstlane(*tkt);
                if (T >= NATT + NJOB) break;
                int Lidx;
                { const int q = T / 3, r = T - q * 3;
                  if (q < NJOB) {
                      if (r == 2) {
                          const int e = q >> 4, kb = q & 15; LAS unsigned char* scr = L + wave * 17408;
                          for (int it = wave; it < 48; it += NWAVES) {
                              if (it < 32) transpose_tile64(wgu + (size_t)e * 1024 * 2048, 2048, WguTp + (size_t)e * 2048 * 1024, 1024, scr, 64 * kb, 64 * it, lane, InvGu());
                              else transpose_tile64(wdn + (size_t)e * 1024 * 1024, 1024, WdnTp + (size_t)e * 1024 * 1024, 1024, scr, 64 * kb, 64 * (it - 32), lane, InvIdent());
                          }
                          continue;
                      }
                      Lidx = q * 2 + r;
                  } else Lidx = T - NJOB; }
                const int bh = Lidx & 63, qb = 15 - (Lidx >> 6);
                const int b = bh >> 2, h = bh & 3;
                int tid_p = tid; asm volatile("" : "+v"(tid_p));
                u32x4* parkp = (u32x4*)parkb + ((size_t)blk * 512 + tid_p) * 8;
                attn_body::attn4_unit<8>(qb, (const attn_body::bf16*)(Qcp + (size_t)(b * 8 + 2 * h) * TT * 64), (const attn_body::bf16*)(Kcp + (size_t)(b * 8 + 2 * h) * TT * 64), (long)TT * 64,
                                         (const attn_body::bf16*)(Vcp + (size_t)(b * 4 + h) * TT * 128), YCp2, b * SEQ, h * 128, lam, attg, parkp, (char*)lds);
            }
        }
        __syncthreads();
        if (BOTH(2)) GRID_BAR();
    }
    PSTAMP(2);

    PSTAMP(3);

    if (IN(4)) REPLOOP(4) {
        {   pg8::Gemm g{YCb, WaT, DM, 1024, 4, nullptr, nullptr, 0};
            pg8::StaticOrder S; S.init(NREAL / 256, 4, G, blk);
            pg8::EpiGateFused E{GFb, MRGb};
            pg8::gemm_phase<0, pg8::EpiGateFused, true>(L, g, S, E); }
        if (BOTH(4) || rep_ + 1 < REP_4) GRID_BAR();
    }
    PSTAMP(4);

    if (IN(5)) REPLOOP(5) {
        pg8::Gemm g{MRGb, WoT, DM, 1024, 4, nullptr, nullptr, 0};
        pg8::StaticOrder S; S.init(NREAL / 256, 4, G, blk);
        pg8::EpiStoreBf16 E{TMPb, DM};
        pg8::gemm_phase<0, pg8::EpiStoreBf16>(L, g, S, E);
        if (BOTH(5) || rep_ + 1 < REP_5) GRID_BAR();
    }
    PSTAMP(5);

    constexpr int NPART = 256, RPP = NREAL / NPART;
    static_assert(NPART * RPP == NREAL, "partitions");
    if (IN(6)) REPLOOP(6) {
        LAS float* wrT = (LAS float*)L;
        LAS int* hcnt = (LAS int*)(L + 131072);
        { const float* wr = PF(19);
          for (int i = tid; i < 8 * 1024; i += 512) { const int k = i & 1023, q4 = i >> 10; const f32x4 v = *(const f32x4*)(wr + k * 32 + 4 * q4);
              wrT[(4 * q4 + 0) * 1024 + k] = v[0]; wrT[(4 * q4 + 1) * 1024 + k] = v[1]; wrT[(4 * q4 + 2) * 1024 + k] = v[2]; wrT[(4 * q4 + 3) * 1024 + k] = v[3]; } }
        const float* xin = PF(0); const float* g0p = PF(2); const float* b0p = PF(3); const float* statsp = stats; const bf16_t* mixp = TMPb;
        const float* g1p = PF(17); const float* b1p = PF(18);
        const float brt = PF(20)[(lane >> 1) & 31];
        bf16_t* Hbp = Hb; int* tokE = tok_e; float* tokG = tok_g; int* histp = hist;
        for (int part = blk; part < NPART; part += G) {
            __syncthreads();
            if (tid < 32) hcnt[tid] = 0;
            __syncthreads();
            const int rbeg = part * RPP, rend = rbeg + RPP;
            constexpr int RPW = (RPP + NWAVES - 1) / NWAVES;
            const int wbeg = rbeg + wave * RPW, wend = (wbeg + RPW < rend) ? wbeg + RPW : rend;
            for (int row = wbeg; row < wend; row += 2) {
                int lane_o = lane; asm volatile("" : "+v"(lane_o));
                const bool two = (row + 1 < wend);
                const int row1 = two ? row + 1 : row;
                const float m0_ = ld_agent_f(statsp + 2 * row), r0_ = ld_agent_f(statsp + 2 * row + 1), m1_ = ld_agent_f(statsp + 2 * row1), r1_ = ld_agent_f(statsp + 2 * row1 + 1);
                f32x4 v0[4], v1[4]; float s0 = 0.f, s1 = 0.f;
#pragma unroll
                for (int j = 0; j < 4; ++j) { v0[j] = *(const f32x4*)(xin + (size_t)row * DM + 4 * lane_o + 256 * j); v1[j] = *(const f32x4*)(xin + (size_t)row1 * DM + 4 * lane_o + 256 * j); }
#pragma unroll
                for (int j = 0; j < 4; ++j) {
                    const u32x2 x0 = *(const u32x2*)(mixp + (size_t)row * DM + 4 * lane_o + 256 * j), x1 = *(const u32x2*)(mixp + (size_t)row1 * DM + 4 * lane_o + 256 * j);
                    const f32x4 g0v = *(const f32x4*)(g0p + 4 * lane_o + 256 * j), b0v = *(const f32x4*)(b0p + 4 * lane_o + 256 * j);
                    v0[j] = ((v0[j] - m0_) * r0_ * g0v + b0v) * DN_ALPHA + (f32x4){bflo(x0.x), bfhi(x0.x), bflo(x0.y), bfhi(x0.y)};
                    v1[j] = ((v1[j] - m1_) * r1_ * g0v + b0v) * DN_ALPHA + (f32x4){bflo(x1.x), bfhi(x1.x), bflo(x1.y), bfhi(x1.y)};
                }
#pragma unroll
                for (int j = 0; j < 4; ++j) { s0 += (v0[j][0] + v0[j][1]) + (v0[j][2] + v0[j][3]); s1 += (v1[j][0] + v1[j][1]) + (v1[j][2] + v1[j][3]); }
                const float mean0 = wave_sum(s0) * (1.f / DM), mean1 = wave_sum(s1) * (1.f / DM); float q0 = 0.f, q1 = 0.f;
#pragma unroll
                for (int j = 0; j < 4; ++j) { const f32x4 d0 = v0[j] - mean0, d1 = v1[j] - mean1;
                    q0 += (d0[0] * d0[0] + d0[1] * d0[1]) + (d0[2] * d0[2] + d0[3] * d0[3]); q1 += (d1[0] * d1[0] + d1[1] * d1[1]) + (d1[2] * d1[2] + d1[3] * d1[3]); }
                const float rstd0 = 1.0f / sqrtf(wave_sum(q0) * (1.f / DM) + LN_EPS), rstd1 = 1.0f / sqrtf(wave_sum(q1) * (1.f / DM) + LN_EPS);
#pragma unroll
                for (int j = 0; j < 4; ++j) {
                    const f32x4 ggj = *(const f32x4*)(g1p + 4 * lane_o + 256 * j), bbj = *(const f32x4*)(b1p + 4 * lane_o + 256 * j);
                    v0[j] = (v0[j] - mean0) * rstd0 * ggj + bbj; v1[j] = (v1[j] - mean1) * rstd1 * ggj + bbj;
                    u32x2 w; w.x = pkbf(v0[j][0], v0[j][1]); w.y = pkbf(v0[j][2], v0[j][3]);
                    *(u32x2*)(Hbp + (size_t)row * DM + 4 * lane_o + 256 * j) = w;
                    if (two) { w.x = pkbf(v1[j][0], v1[j][1]); w.y = pkbf(v1[j][2], v1[j][3]); *(u32x2*)(Hbp + (size_t)row1 * DM + 4 * lane_o + 256 * j) = w; }
                }
                float p0[32], p1[32];
#pragma unroll
                for (int e = 0; e < 32; ++e) {
                    f32x2 a0 = (f32x2){0.f, 0.f}, a1 = a0;
#pragma unroll
                    for (int j = 0; j < 4; ++j) { const f32x4 wv = *(const LAS f32x4*)(wrT + e * 1024 + 4 * lane_o + 256 * j);
                        const f32x2 wl = (f32x2){wv[0], wv[1]}, wh = (f32x2){wv[2], wv[3]};
                        a0 += (f32x2){v0[j][0], v0[j][1]} * wl; a0 += (f32x2){v0[j][2], v0[j][3]} * wh;
                        a1 += (f32x2){v1[j][0], v1[j][1]} * wl; a1 += (f32x2){v1[j][2], v1[j][3]} * wh; }
                    p0[e] = a0[0] + a0[1]; p1[e] = a1[0] + a1[1];
                    if ((e & 3) == 3) __builtin_amdgcn_sched_barrier(0);
                }
                float lg0 = xreduce32(p0, lane_o) + brt, lg1 = xreduce32(p1, lane_o) + brt;
#pragma unroll
                for (int rr = 0; rr < 2; ++rr) {
                    float lg = rr ? lg1 : lg0; const int rw = rr ? row1 : row;
                    float tv[4]; int ti[4];
#pragma unroll
                    for (int k = 0; k < 4; ++k) {
                        const float mx = wave_max(lg);
                        const unsigned long long bal = __ballot(lg == mx);
                        const int idx = (__ffsll((long long)bal) - 1) >> 1;
                        tv[k] = mx; ti[k] = idx;
                        if ((lane_o >> 1) == idx) lg = -INFINITY;
                    }
                    const float e1 = __expf(tv[1] - tv[0]), e2 = __expf(tv[2] - tv[0]), e3 = __expf(tv[3] - tv[0]);
                    const float inv = 1.0f / (1.0f + e1 + e2 + e3);
                    if (lane_o < 4 && (rr == 0 || two)) {
                        const int idx = (lane_o == 0) ? ti[0] : (lane_o == 1) ? ti[1] : (lane_o == 2) ? ti[2] : ti[3];
                        const float gv = ((lane_o == 0) ? 1.0f : (lane_o == 1) ? e1 : (lane_o == 2) ? e2 : e3) * inv;
                        tokE[(size_t)rw * 4 + lane_o] = idx; tokG[(size_t)rw * 4 + lane_o] = gv;
                        atomicAdd((int*)&hcnt[idx], 1);
                    }
                }
            }
            __syncthreads();
            if (tid < 32) histp[part * 32 + tid] = hcnt[tid];
        }
        if (BOTH(6) || rep_ + 1 < REP_6) GRID_BAR();
    }
    PSTAMP(6);

    if (IN(7)) REPLOOP(7) {
        LAS int* cnt_s = (LAS int*)L; LAS int* base_s = cnt_s + 32; LAS int* pst_s = cnt_s + 64;
        LAS int* ptot = cnt_s + 128; LAS int* pbase = ptot + 512;
        LAS int* ccnt = pbase + 512;
        LAS int* ent = ccnt + 1024; LAS int* lrank = ent + RPP * 4 + 64;
        int* rowOff = row_off; int* rowSlot = row_slot; float* rowGate = row_gate; const int* histp = hist; const int* tokE = tok_e; const float* tokG = tok_g;
        for (int part = blk; part < NPART; part += G) {
            __syncthreads();
            { const int e = tid & 31, q = tid >> 5; int tot = 0, bs = 0;
#pragma unroll 4
              for (int b2 = q * 16; b2 < q * 16 + 16; ++b2) { const int v = ld_agent_i(histp + b2 * 32 + e); tot += v; bs += (b2 < part) ? v : 0; }
              ptot[q * 32 + e] = tot; pbase[q * 32 + e] = bs; }
            const int rbeg = part * RPP, n4 = RPP * 4;
            for (int i = tid; i < n4; i += 512) ent[i] = ld_agent_i(tokE + (size_t)rbeg * 4 + i);
            __syncthreads();
            if (tid < 32) { int tot = 0, bs = 0;
#pragma unroll
                for (int q = 0; q < 16; ++q) { tot += ptot[q * 32 + tid]; bs += pbase[q * 32 + tid]; }
                cnt_s[tid] = tot; base_s[tid] = bs; }
            constexpr int NCH = (RPP * 4 + 63) / 64;
            for (int c = wave; c < NCH; c += NWAVES) {
                const int i = 64 * c + lane; const int my = (i < n4) ? ent[i] : -1; int lr = 0;
#pragma unroll 4
                for (int e = 0; e < 32; ++e) { const unsigned long long b = __ballot(my == e);
                    if (lane == e) ccnt[c * 32 + e] = __popcll(b);
                    if (my == e) lr = __popcll(b & ((1ull << lane) - 1ull)); }
                if (i < n4) lrank[i] = lr;
            }
            __syncthreads();
            if (tid == 0) { int p = 0; for (int e = 0; e < 32; ++e) { pst_s[e] = p; p += (cnt_s[e] + 255) & ~255; } pst_s[32] = p; }
            __syncthreads();
            if (tid < 32) { int run = pst_s[tid] + base_s[tid];
                for (int c = 0; c < NCH; ++c) { const int tmp = ccnt[c * 32 + tid]; ccnt[c * 32 + tid] = run; run += tmp; } }
            __syncthreads();
            for (int i = tid; i < n4; i += 512) { const int e = ent[i]; const int pos = ccnt[(i >> 6) * 32 + e] + lrank[i];
                rowOff[pos] = (rbeg + (i >> 2)) * (DM * 2); rowSlot[pos] = rbeg * 4 + i; rowGate[pos] = ld_agent_f(tokG + (size_t)rbeg * 4 + i); }
            if (part < 32) { const int e = part; for (int r = pst_s[e] + cnt_s[e] + tid; r < pst_s[e + 1]; r += 512) { rowOff[r] = 0; rowSlot[r] = NREAL * 4; rowGate[r] = 0.f; } }
            if (part == 0) { const int nT = pst_s[32] >> 8; int* te = tile_exp;
                for (int t = tid; t < nT; t += 512) { int e = 0; while (e < 31 && t * 256 >= pst_s[e + 1]) ++e; te[t] = e; }
                if (tid == 0) __hip_atomic_store((int*)(ctl + CW_NT), nT, RLX_AGENT); }
        }
        __syncthreads();
        if (BOTH(7) || rep_ + 1 < REP_7) GRID_BAR();
    }
    PSTAMP(7);

    {
        int nT = 0, TPC = 0;
        if (lo < 12 && hi > 8) { nT = __builtin_amdgcn_readfirstlane(ld_agent_i((const int*)(ctl + CW_NT))); TPC = (nT > 512) ? 512 : nT; }
        if (IN(8)) REPLOOP(8) {
            pg8::Gemm g{Hb, WguT, DM, DM, 8, row_off, tile_exp, 0};
            pg8::StaticOrder S; S.init(TPC, 8, G, blk);
            pg8::EpiAct E{ACT, PF(22), tile_exp, 0};
            pg8::gemm_phase<1, pg8::EpiAct>(L, g, S, E);
            if (BOTH(8) || rep_ + 1 < REP_8) GRID_BAR();
        }
        PSTAMP(8);
        if (IN(9)) REPLOOP(9) {
            pg8::Gemm g{ACT, WdnT, FF, FF, 4, nullptr, tile_exp, 0};
            pg8::StaticOrder S; S.init(TPC, 4, G, blk);
            pg8::EpiDown E{Y, PF(24), tile_exp, row_slot, row_gate, 0};
            pg8::gemm_phase<2, pg8::EpiDown>(L, g, S, E);
            if (BOTH(9) || rep_ + 1 < REP_9) GRID_BAR();
        }
        PSTAMP(9);
        if (IN(10)) REPLOOP(10) {
            pg8::Gemm g{Hb, WguT, DM, DM, 8, row_off, tile_exp, TPC};
            pg8::StaticOrder S; S.init(nT - TPC, 8, G, blk);
            pg8::EpiAct E{ACT, PF(22), tile_exp, TPC};
            pg8::gemm_phase<1, pg8::EpiAct>(L, g, S, E);
            if (BOTH(10) || rep_ + 1 < REP_10) GRID_BAR();
        }
        PSTAMP(10);
        if (IN(11)) REPLOOP(11) {
            pg8::Gemm g{ACT, WdnT, FF, FF, 4, nullptr, tile_exp, TPC};
            pg8::StaticOrder S; S.init(nT - TPC, 4, G, blk);
            pg8::EpiDown E{Y, PF(24), tile_exp, row_slot, row_gate, TPC};
            pg8::gemm_phase<2, pg8::EpiDown>(L, g, S, E);
            if (BOTH(11) || rep_ + 1 < REP_11) GRID_BAR();
        }
        PSTAMP(11);
    }

    if (IN(12)) REPLOOP(12) {
        for (int row = gw; row < NREAL; row += NGW) {
            f32x4 v[4]; float s = 0.f;
#pragma unroll
            for (int j = 0; j < 4; ++j) {
                const u32x2 hw = *(const u32x2*)(Hb + (size_t)row * DM + 4 * lane + 256 * j);
                f32x4 acc = (f32x4){bflo(hw.x), bfhi(hw.x), bflo(hw.y), bfhi(hw.y)} * DN_ALPHA;
#pragma unroll
                for (int k = 0; k < 4; ++k) { const u32x2 yw = *(const u32x2*)(Y + ((size_t)row * 4 + k) * DM + 4 * lane + 256 * j);
                    acc += (f32x4){bflo(yw.x), bfhi(yw.x), bflo(yw.y), bfhi(yw.y)}; }
                v[j] = acc; s += (acc[0] + acc[1]) + (acc[2] + acc[3]);
            }
            const float mean = wave_sum(s) * (1.f / DM); float s2 = 0.f;
#pragma unroll
            for (int j = 0; j < 4; ++j) { const f32x4 d = v[j] - mean; s2 += (d[0] * d[0] + d[1] * d[1]) + (d[2] * d[2] + d[3] * d[3]); }
            const float rstd = 1.0f / sqrtf(wave_sum(s2) * (1.f / DM) + LN_EPS);
            float* orow = (float*)DOUTP + (size_t)row * DM;
#pragma unroll
            for (int j = 0; j < 4; ++j) {
                const f32x4 gg = *(const f32x4*)(PF(25) + 4 * lane + 256 * j), bb = *(const f32x4*)(PF(26) + 4 * lane + 256 * j);
                *(f32x4*)(orow + 4 * lane + 256 * j) = (v[j] - mean) * rstd * gg + bb;
            }
        }
#if MK_PROBE == 2
        __syncthreads();
        PSTAMP(12);
        if (blk == 0 && tid == 0) pdur[14] = pdur[30] - pdur[29];
        if (blk == 0 && tid == 0) { asm volatile("s_waitcnt vmcnt(0)" ::: "memory"); ((float*)DOUTP)[0] += (float)pdur[MK_PROBE_K] * (0.01f / MK_PROBE_DIV); }
#elif MK_PROBE
        __syncthreads();
        if (blk == 0 && tid == 0) { const unsigned cyc = __hip_atomic_load(ctl + CW_PROBE, RLX_AGENT), st = __hip_atomic_load(ctl + CW_PROBE + 1, RLX_AGENT);
            asm volatile("s_waitcnt vmcnt(0)" ::: "memory"); ((float*)DOUTP)[0] += (float)cyc / (float)(st ? st : 1u); }
#endif
    }
#undef IN
#undef BOTH
#undef GRID_BAR
}

constexpr int N_PHASES = 13;
extern "C" void kernel_launch(void* const* d_in, const int* in_sizes, int n_in, void* d_out, int out_size, void* d_ws, size_t ws_size, hipStream_t stream) {
    static int grid = 0;
    if (grid == 0) {
        if (n_in != 27 || ws_size < WS_END) { fprintf(stderr, "kernel_launch: unexpected n_in %d / ws_size %zu\n", n_in, ws_size); grid = -1; return; }
        int dev = 0, cus = 0;
        if (hipGetDevice(&dev) != hipSuccess || hipDeviceGetAttribute(&cus, hipDeviceAttributeMultiprocessorCount, dev) != hipSuccess) { grid = -1; return; }
        if (hipFuncSetAttribute((const void*)hybrid_fwd, hipFuncAttributeMaxDynamicSharedMemorySize, LDS_BYTES) != hipSuccess) { fprintf(stderr, "kernel_launch: hipFuncSetAttribute failed\n"); grid = -1; return; }
        int per_cu = 0;
        (void)hipOccupancyMaxActiveBlocksPerMultiprocessor(&per_cu, (const void*)hybrid_fwd, NWAVES * 64, LDS_BYTES);
        (void)hipGetLastError();
        grid = cus > 0 ? cus : 256;
    }
    if (grid < 0) return;
    (void)hipMemsetAsync((char*)d_ws + WS_CTL, 0, CTL_ZERO_BYTES, stream);
    Args a{};
    const float** fp = (const float**)&a;
    for (int i = 0; i < 27; ++i) fp[i] = (const float*)d_in[i];
    a.out = (float*)d_out; a.ws = (unsigned char*)d_ws;
#if MK_PER_PHASE
    for (int p = 0; p < N_PHASES; ++p) { a.ph_lo = p; a.ph_hi = p + 1; hipLaunchKernelGGL(hybrid_fwd, dim3(grid), dim3(NWAVES * 64), LDS_BYTES, stream, a); }
#else
    a.ph_lo = 0; a.ph_hi = N_PHASES;
    hipLaunchKernelGGL(hybrid_fwd, dim3(grid), dim3(NWAVES * 64), LDS_BYTES, stream, a);
#endif
}
```

```cpp
#include <hip/hip_runtime.h>
#include <hip/hip_bf16.h>
#include <cstdio>
#include <cstdint>
#include <cmath>

#ifndef MK_PER_PHASE
#define MK_PER_PHASE 0
#endif

#ifndef REP_ALL
#define REP_ALL 1
#endif
#ifndef REP_0
#define REP_0 REP_ALL
#endif
#ifndef REP_1
#define REP_1 REP_ALL
#endif
#ifndef REP_2A
#define REP_2A REP_ALL
#endif
#ifndef REP_2B
#define REP_2B REP_ALL
#endif
#ifndef REP_3
#define REP_3 REP_ALL
#endif
#ifndef REP_4
#define REP_4 REP_ALL
#endif
#ifndef REP_5
#define REP_5 REP_ALL
#endif
#ifndef REP_6
#define REP_6 REP_ALL
#endif
#ifndef REP_7
#define REP_7 REP_ALL
#endif
#ifndef REP_8
#define REP_8 REP_ALL
#endif
#ifndef REP_9
#define REP_9 REP_ALL
#endif
#ifndef REP_10
#define REP_10 REP_ALL
#endif
#ifndef REP_11
#define REP_11 REP_ALL
#endif
#ifndef REP_12
#define REP_12 REP_ALL
#endif
#define REPLOOP(k) _Pragma("unroll 1") for (int rep_ = 0; rep_ < REP_##k; ++rep_)
#ifndef MK_PROBE
#define MK_PROBE 0
#endif
#ifndef MK_PROBE_K
#define MK_PROBE_K 2
#define MK_PROBE_DIV 10.0f
#endif
#define LAS __attribute__((address_space(3)))
#define GAS __attribute__((address_space(1)))
typedef unsigned short bf16_t;
typedef short bf16x8 __attribute__((ext_vector_type(8)));
typedef float f32x4 __attribute__((ext_vector_type(4)));
typedef float f32x2 __attribute__((ext_vector_type(2)));
typedef unsigned u32x4 __attribute__((ext_vector_type(4)));
typedef unsigned u32x2 __attribute__((ext_vector_type(2)));
typedef __bf16 bf16x2_t __attribute__((ext_vector_type(2)));
#define RLX_AGENT __ATOMIC_RELAXED, __HIP_MEMORY_SCOPE_AGENT

constexpr int NB = 16, SEQ = 4096, NMETA = 16, TT = SEQ + NMETA  , MROWS = NB * TT  , DM = 1024;
constexpr int NREAL = NB * SEQ;
constexpr int NZP = 5632;
constexpr int NZ = 2080;
constexpr int ZMQ = 0, ZMK = 512, ZMV = 1024, ZMO = 1536, ZGA = 2048, ZGM = 3072;
constexpr int ZYC = 0;
constexpr int NIN = 5640;
constexpr int NE = 32, FF = 1024;
constexpr int OROWS = 4352;
constexpr float LN_EPS = 1e-5f;
constexpr float DN_ALPHA = 1.189207115002721f;
constexpr float LAMBDA_INIT = 0.2f;
constexpr float ATT_C2 = 0.125f * 1.4426950408889634f;

constexpr size_t MiB = 1u << 20;
constexpr size_t WS_CTL = 0, CTL_ZERO_BYTES = 32768;
constexpr size_t WS_WIN = 2 * MiB;
constexpr size_t WS_WA = 13 * MiB;
constexpr size_t WS_WM = 14 * MiB;
constexpr size_t WS_WO = 15 * MiB;
constexpr size_t WS_ROPE = 17 * MiB;
constexpr size_t WS_STATS = 19 * MiB;
constexpr size_t WS_GATES = 20 * MiB;
constexpr size_t WS_TOKE = 23 * MiB;
constexpr size_t WS_TOKG = 24 * MiB + 512 * 1024;
constexpr size_t WS_HIST = 26 * MiB;
constexpr size_t WS_ROWOFF = 27 * MiB;
constexpr size_t WS_ROWSLOT = 28 * MiB + 512 * 1024;
constexpr size_t WS_ROWGATE = 30 * MiB;
constexpr size_t WS_TILEEXP = 31 * MiB + 512 * 1024;
constexpr size_t WS_H = 32 * MiB;
constexpr size_t WS_Z = 162 * MiB;
constexpr size_t WS_Y = WS_Z;
constexpr size_t WS_ACT = WS_Z + 516 * MiB;
constexpr size_t WS_GF = 424 * MiB;
constexpr size_t WS_QC = 686 * MiB;
constexpr size_t WS_KC = 751 * MiB;
constexpr size_t WS_VC = 816 * MiB;
constexpr size_t WS_TMP = 686 * MiB;
constexpr size_t WS_MRG = 816 * MiB;
constexpr size_t WS_O = 882 * MiB;
constexpr size_t WS_END = 1024 * MiB;
constexpr size_t DO_WGU = 0;
constexpr size_t DO_WDN = 128 * MiB;
constexpr int CW_TMO = 0, CW_NT = 64, CW_TICKET = 128  , CW_PROBE = 1024, CW_BAR = 4096;

constexpr int LDS_BYTES = 163840;
constexpr int MISC_OFF = 163840 - 512;
constexpr int NWAVES = 8;

__device__ __forceinline__ unsigned pkbf(float lo, float hi) { f32x2 v = {lo, hi}; bf16x2_t b = __builtin_convertvector(v, bf16x2_t); return __builtin_bit_cast(unsigned, b); }
__device__ __forceinline__ float bflo(unsigned w) { return __uint_as_float(w << 16); }
__device__ __forceinline__ float bfhi(unsigned w) { return __uint_as_float(w & 0xffff0000u); }
__device__ __forceinline__ float sigmoidf_(float x) { return __builtin_amdgcn_rcpf(1.0f + __expf(-x)); }
template <int CTRL> __device__ __forceinline__ float dppf(float v) { return __builtin_bit_cast(float, __builtin_amdgcn_update_dpp(0, __builtin_bit_cast(int, v), CTRL, 0xF, 0xF, true)); }
__device__ __forceinline__ float rdlane(float v, int l) { return __builtin_bit_cast(float, __builtin_amdgcn_readlane(__builtin_bit_cast(int, v), l)); }
__device__ __forceinline__ float row_sum16(float v) { v += dppf<0xB1>(v); v += dppf<0x4E>(v); v += dppf<0x141>(v); v += dppf<0x140>(v); return v; }
__device__ __forceinline__ float wave_sum(float v) { v = row_sum16(v); return (rdlane(v, 0) + rdlane(v, 16)) + (rdlane(v, 32) + rdlane(v, 48)); }
__device__ __forceinline__ float wave_max(float v) {
    v = fmaxf(v, dppf<0xB1>(v)); v = fmaxf(v, dppf<0x4E>(v)); v = fmaxf(v, dppf<0x141>(v)); v = fmaxf(v, dppf<0x140>(v));
    return fmaxf(fmaxf(rdlane(v, 0), rdlane(v, 16)), fmaxf(rdlane(v, 32), rdlane(v, 48)));
}
__device__ __forceinline__ float xreduce32(float (&p)[32], int lane) {
    float a[16], b[8], c[4], d[2];
#pragma unroll
    for (int i = 0; i < 16; ++i) { auto r = __builtin_amdgcn_permlane32_swap(__float_as_uint(p[i]), __float_as_uint(p[16 + i]), false, false); a[i] = __uint_as_float(r[0]) + __uint_as_float(r[1]); }
#pragma unroll
    for (int i = 0; i < 8; ++i) { auto r = __builtin_amdgcn_permlane16_swap(__float_as_uint(a[i]), __float_as_uint(a[8 + i]), false, false); b[i] = __uint_as_float(r[0]) + __uint_as_float(r[1]); }
    const bool b3 = (lane & 8) != 0, b2 = (lane & 4) != 0, b1 = (lane & 2) != 0;
#pragma unroll
    for (int i = 0; i < 4; ++i) { const float keep = b3 ? b[4 + i] : b[i], send = b3 ? b[i] : b[4 + i]; c[i] = keep + dppf<0x128>(send); }
#pragma unroll
    for (int i = 0; i < 2; ++i) { const float keep = b2 ? c[2 + i] : c[i], send = b2 ? c[i] : c[2 + i]; d[i] = keep + dppf<0x141>(send); }
    const float keep = b1 ? d[1] : d[0], send = b1 ? d[0] : d[1];
    float r = keep + dppf<0x4E>(send);
    r += dppf<0xB1>(r);
    return r;
}
__device__ __forceinline__ int ld_agent_i(const int* p) { return __hip_atomic_load(p, RLX_AGENT); }
__device__ __forceinline__ float ld_agent_f(const float* p) { return __hip_atomic_load(p, RLX_AGENT); }
#define LDS_WAIT() asm volatile("s_waitcnt lgkmcnt(0)" ::: "memory")
template <int CTRL, int RMASK> __device__ __forceinline__ float dpp_old(float old, float v) { return __builtin_bit_cast(float, __builtin_amdgcn_update_dpp(__builtin_bit_cast(int, old), __builtin_bit_cast(int, v), CTRL, RMASK, 0xF, false)); }
__device__ __forceinline__ float wave_scan_add(float v) {
    v += dpp_old<0x111, 0xF>(0.f, v); v += dpp_old<0x112, 0xF>(0.f, v); v += dpp_old<0x114, 0xF>(0.f, v); v += dpp_old<0x118, 0xF>(0.f, v);
    v += dpp_old<0x142, 0xA>(0.f, v); v += dpp_old<0x143, 0xC>(0.f, v); return v; }
__device__ __forceinline__ float wave_scan_max(float v) {
    const float ninf = -INFINITY;
    v = fmaxf(v, dpp_old<0x111, 0xF>(ninf, v)); v = fmaxf(v, dpp_old<0x112, 0xF>(ninf, v)); v = fmaxf(v, dpp_old<0x114, 0xF>(ninf, v)); v = fmaxf(v, dpp_old<0x118, 0xF>(ninf, v));
    v = fmaxf(v, dpp_old<0x142, 0xA>(ninf, v)); v = fmaxf(v, dpp_old<0x143, 0xC>(ninf, v)); return v; }
__device__ __forceinline__ int row_of(int b, int t) { return (t < NMETA) ? NREAL + b * NMETA + t : b * SEQ + (t - NMETA); }
__device__ __forceinline__ void bt_of(int row, int& b, int& t) { if (row < NREAL) { b = row >> 12; t = (row & (SEQ - 1)) + NMETA; } else { const int m = row - NREAL; b = m >> 4; t = m & (NMETA - 1); } }
__device__ __forceinline__ const void* ldptr(LAS const unsigned long long* t, int i) { const unsigned long long v = t[i];
    const unsigned lo = (unsigned)__builtin_amdgcn_readfirstlane((int)(unsigned)v), hi = (unsigned)__builtin_amdgcn_readfirstlane((int)(unsigned)(v >> 32));
    return (const void*)(const GAS void*)(((unsigned long long)hi << 32) | lo); }

namespace pg8 {
constexpr int BM = 256, BK = 64, HALF = 128, HTB = HALF * BK * 2, STAGE_BYTES = 8 * HTB, NXCD = 8, WGM = 8;
__host__ __device__ __forceinline__ int lds_byte(int r, int c) { const int st = (r >> 4) * 2 + (c >> 5), rr = r & 15, cc = c & 31, ob = rr * 64 + cc * 2; return st * 1024 + (ob ^ (((ob >> 9) & 1) << 5)); }
__host__ __device__ __forceinline__ void stage_rc(int b, int& R, int& C) { const int st = b / 1024, sb = b % 1024, swz = sb ^ (((sb >> 9) & 1) << 5); R = (st >> 1) * 16 + swz / 64; C = (st & 1) * 32 + (swz % 64) / 2; }
__host__ __device__ __forceinline__ int perm32(int rho) { const int n = rho >> 4, i = rho & 15; return 8 * (i >> 2) + 4 * n + (i & 3); }

struct Unit { int pm, pn, e; };
struct Gemm { const bf16_t* A; const bf16_t* Bt; int lda, K, nN; const int* row_off; const int* tile_exp; int pm0; };
struct StaticOrder {
    int nM, nN, nwg, G, c;
    __device__ __forceinline__ void init(int nM_, int nN_, int G_, int c_) { nM = nM_; nN = nN_; nwg = nM * nN; G = G_; c = c_; }
    __device__ __forceinline__ bool next(int i, Unit& u) const {
        const long L = (long)i * G + c; if (L >= nwg) return false;
        int wgid = (int)L; { const int q = nwg / NXCD, r = nwg % NXCD, xcd = wgid % NXCD, off = wgid / NXCD; wgid = (xcd < r ? xcd * (q + 1) : r * (q + 1) + (xcd - r) * q) + off; }
        const int nig = WGM * nN, gid = wgid / nig, fm = gid * WGM, gsz = (nM - fm) < WGM ? (nM - fm) : WGM;
        u.pm = fm + ((wgid % nig) % gsz); u.pn = (wgid % nig) / gsz; u.e = 0; return true;
    }
};

template <int MODE, class Epi, bool MID = false>
__device__ __forceinline__ void gemm_phase(LAS unsigned char* lds, const Gemm g, const StaticOrder& S, const Epi& E) {
    const int tid = threadIdx.x, wid = __builtin_amdgcn_readfirstlane(tid >> 6), lane = tid & 63, wr = wid >> 2, wc = wid & 3, fr = lane & 15, fq = lane >> 4;
    const int K = g.K, nt = K / BK;
    unsigned voffA[2], voffB[2]; int Rst[2], Cst[2];
#pragma unroll
    for (int i = 0; i < 2; ++i) { int R, C; stage_rc(tid * 16 + i * 8192, R, C); const int Rb = Epi::PERM ? ((R & ~31) + perm32(R & 31)) : R;
        voffA[i] = (unsigned)(R * g.lda + C) * 2u; voffB[i] = (unsigned)(Rb * K + C) * 2u; Rst[i] = R; Cst[i] = C * 2; }
    const size_t kstep = (size_t)(BK * 2);
    const size_t hstepA = (size_t)HALF * g.lda * 2, hstepB = (size_t)HALF * K * 2;
    const size_t tstepA = 2 * hstepA, tstepB = 2 * hstepB;
    const unsigned ldsw = (unsigned)wid * 1024u;
    const int aoff = lds_byte(wr * 64 + fr, fq * 8), boff = lds_byte(wc * 32 + fr, fq * 8);
    unsigned vC[2][2] = {{0u, 0u}, {0u, 0u}}, vN[2][2] = {{0u, 0u}, {0u, 0u}};
#define PG8_SA(b, h) (((b) * 2 + (h)) * HTB)
#define PG8_SB(b, h) ((4 + (b) * 2 + (h)) * HTB)
#define PG8_STAGE_B(bufoff, gbase) do { _Pragma("unroll") for (int _i = 0; _i < 2; ++_i) \
        __builtin_amdgcn_global_load_lds((const unsigned*)((const char*)(gbase) + voffB[_i]), (LAS unsigned*)(lds + (bufoff) + ldsw + _i * 8192), 16, 0, 0); } while (0)
#define PG8_STAGE_A(bufoff, gbase, h, nx) do { _Pragma("unroll") for (int _i = 0; _i < 2; ++_i) { \
        const char* _p = (MODE == 1) ? ((const char*)(gbase) + ((nx) ? vN[h][_i] : vC[h][_i])) : ((const char*)(gbase) + (h) * hstepA + voffA[_i]); \
        __builtin_amdgcn_global_load_lds((const unsigned*)_p, (LAS unsigned*)(lds + (bufoff) + ldsw + _i * 8192), 16, 0, 0); } } while (0)
#define PG8_LDA(dst, b, h) do { _Pragma("unroll") for (int m = 0; m < 4; ++m) _Pragma("unroll") for (int k = 0; k < 2; ++k) dst[m][k] = *(const LAS bf16x8*)(lds + PG8_SA(b, h) + aoff + m * 2048 + k * 1024); } while (0)
#define PG8_LDB(dst, b, h) do { _Pragma("unroll") for (int n = 0; n < 2; ++n) _Pragma("unroll") for (int k = 0; k < 2; ++k) dst[n][k] = *(const LAS bf16x8*)(lds + PG8_SB(b, h) + boff + n * 2048 + k * 1024); } while (0)
#define PG8_MMA(ai, bj, At, Bt) do { __builtin_amdgcn_s_setprio(1); _Pragma("unroll") for (int m = 0; m < 4; ++m) _Pragma("unroll") for (int n = 0; n < 2; ++n) _Pragma("unroll") for (int k = 0; k < 2; ++k) \
        acc[ai][bj][m][n] = __builtin_amdgcn_mfma_f32_16x16x32_bf16(Bt[n][k], At[m][k], acc[ai][bj][m][n], 0, 0, 0); __builtin_amdgcn_s_setprio(0); } while (0)
#define PG8_WAIT_V(n) asm volatile("s_waitcnt vmcnt(" #n ")" ::: "memory")
#define PG8_WAIT_L(n) asm volatile("s_waitcnt lgkmcnt(" #n ")" ::: "memory")
#define PG8_BAR __builtin_amdgcn_s_barrier()
#define PG8_SCHED __builtin_amdgcn_sched_barrier(0)
#define PG8_ABASE(u) ((MODE == 1) ? (const char*)g.A : (const char*)g.A + (size_t)(u).pm * tstepA)
#define PG8_BBASE(u) ((MODE == 0) ? (const char*)g.Bt + (size_t)(u).pn * tstepB : (const char*)g.Bt + ((size_t)((u).e = __builtin_amdgcn_readfirstlane(ld_agent_i(g.tile_exp + g.pm0 + (u).pm))) * g.nN + (u).pn) * tstepB)
#define PG8_GATHER(dst, u) do { if (MODE == 1) { _Pragma("unroll") for (int _h = 0; _h < 2; ++_h) _Pragma("unroll") for (int _i = 0; _i < 2; ++_i) \
        dst[_h][_i] = (unsigned)ld_agent_i(g.row_off + (size_t)(g.pm0 + (u).pm) * BM + _h * HALF + Rst[_i]) + (unsigned)Cst[_i]; } } while (0)
    Unit cur, nxt; int ui = 0;
    if (!S.next(0, cur)) return;
    f32x4 acc[2][2][4][2];
#pragma unroll
    for (int a = 0; a < 2; ++a)
#pragma unroll
        for (int b = 0; b < 2; ++b)
#pragma unroll
            for (int m = 0; m < 4; ++m)
#pragma unroll
                for (int n = 0; n < 2; ++n) acc[a][b][m][n] = (f32x4){0.f, 0.f, 0.f, 0.f};
    bf16x8 At[4][2], B0[2][2], B1[2][2];
    const char* cA = PG8_ABASE(cur); const char* cB = PG8_BBASE(cur);
    PG8_GATHER(vC, cur);
    PG8_STAGE_B(PG8_SB(0, 0), cB); PG8_STAGE_B(PG8_SB(0, 1), cB + hstepB); PG8_STAGE_A(PG8_SA(0, 0), cA, 0, false); PG8_STAGE_A(PG8_SA(0, 1), cA, 1, false);
    if (wr == 1) PG8_BAR;
    PG8_WAIT_V(2); PG8_BAR;
    PG8_STAGE_B(PG8_SB(1, 0), cB + kstep); PG8_STAGE_A(PG8_SA(1, 0), cA + kstep, 0, false); PG8_STAGE_B(PG8_SB(1, 1), cB + hstepB + kstep);
    PG8_WAIT_V(6); PG8_BAR;
    for (;;) {
        const bool has_next = S.next(ui + 1, nxt);
        const char* nA = has_next ? PG8_ABASE(nxt) : cA; const char* nB = has_next ? PG8_BBASE(nxt) : cB;
        if (MODE == 1) { if (has_next) { PG8_GATHER(vN, nxt); } else {
#pragma unroll
            for (int _h = 0; _h < 2; ++_h)
#pragma unroll
                for (int _i = 0; _i < 2; ++_i) vN[_h][_i] = vC[_h][_i]; } }
        for (int t = 0; t < nt; t += 2) {
            if constexpr (MID) { if (t == nt / 2) { if (wr == 0) PG8_BAR; E.mid(acc, cur, wr, wc, fr, fq); if (wr == 1) PG8_BAR; } }
            const bool last = (t == nt - 2);
            const char* a1 = cA + (size_t)(t + 1) * kstep;
            const char* a2 = last ? nA : cA + (size_t)(t + 2) * kstep; const char* b2 = last ? nB : cB + (size_t)(t + 2) * kstep;
            const char* a3 = a2 + kstep; const char* b3 = b2 + kstep;
            PG8_LDB(B0, 0, 0); PG8_LDB(B1, 0, 1); PG8_SCHED; PG8_LDA(At, 0, 0); PG8_STAGE_A(PG8_SA(1, 1), a1, 1, false);
            PG8_WAIT_V(8); PG8_WAIT_L(0); PG8_BAR; PG8_MMA(0, 0, At, B0); PG8_MMA(0, 1, At, B1); PG8_BAR; PG8_SCHED;
            PG8_LDA(At, 0, 1); PG8_STAGE_B(PG8_SB(0, 0), b2); PG8_STAGE_B(PG8_SB(0, 1), b2 + hstepB); PG8_STAGE_A(PG8_SA(0, 0), a2, 0, last);
            PG8_WAIT_V(8); PG8_WAIT_L(0); PG8_BAR; PG8_MMA(1, 0, At, B0); PG8_MMA(1, 1, At, B1); PG8_BAR; PG8_SCHED;
            PG8_LDB(B0, 1, 0); PG8_LDB(B1, 1, 1); PG8_SCHED; PG8_LDA(At, 1, 0); PG8_STAGE_A(PG8_SA(0, 1), a2, 1, last);
            PG8_WAIT_V(8); PG8_WAIT_L(0); PG8_BAR; PG8_MMA(0, 0, At, B0); PG8_MMA(0, 1, At, B1); PG8_BAR; PG8_SCHED;
            PG8_LDA(At, 1, 1); PG8_STAGE_B(PG8_SB(1, 0), b3); PG8_STAGE_B(PG8_SB(1, 1), b3 + hstepB); PG8_STAGE_A(PG8_SA(1, 0), a3, 0, last);
            PG8_WAIT_V(8); PG8_WAIT_L(0); PG8_BAR; PG8_MMA(1, 0, At, B0); PG8_MMA(1, 1, At, B1); PG8_BAR; PG8_SCHED;
        }
        if (wr == 0) PG8_BAR;
        E(acc, cur, wr, wc, fr, fq);
        if (!has_next) break;
#pragma unroll
        for (int a = 0; a < 2; ++a)
#pragma unroll
            for (int b = 0; b < 2; ++b)
#pragma unroll
                for (int m = 0; m < 4; ++m)
#pragma unroll
                    for (int n = 0; n < 2; ++n) acc[a][b][m][n] = (f32x4){0.f, 0.f, 0.f, 0.f};
        cur = nxt; cA = nA; cB = nB; ++ui;
        if (MODE == 1) {
#pragma unroll
            for (int _h = 0; _h < 2; ++_h)
#pragma unroll
                for (int _i = 0; _i < 2; ++_i) vC[_h][_i] = vN[_h][_i]; }
        if (wr == 1) PG8_BAR;
    }
    PG8_WAIT_V(0);
    PG8_BAR;
#undef PG8_SA
#undef PG8_SB
#undef PG8_STAGE_A
#undef PG8_STAGE_B
#undef PG8_LDA
#undef PG8_LDB
#undef PG8_MMA
#undef PG8_WAIT_V
#undef PG8_WAIT_L
#undef PG8_BAR
#undef PG8_SCHED
#undef PG8_ABASE
#undef PG8_BBASE
#undef PG8_GATHER
}

struct EpiZ {
    static constexpr bool PERM = true;
    bf16_t* Z; bf16_t* Qc; bf16_t* Kc; bf16_t* Vc; const float* ropec; const float* ropes; bf16_t* GF;
    __device__ __forceinline__ void operator()(const f32x4 (&acc)[2][2][4][2], const Unit& u, int wr, int wc, int fr, int fq) const {
        const int row0 = u.pm * BM + wr * 64 + fr;
        if (u.pn < 4) {
            const float sc = (u.pn < 2) ? ATT_C2 : 1.0f;
            bf16_t* base = (u.pn < 2) ? Qc : Kc;
            const int dl = 16 * (wc & 1) + 4 * fq;
#pragma unroll
            for (int ai = 0; ai < 2; ++ai)
#pragma unroll
                for (int m = 0; m < 4; ++m) {
                    const int row = row0 + ai * HALF + m * 16; int b, t; bt_of(row, b, t);
                    const f32x4 c = *(const f32x4*)(ropec + t * 32 + dl) * sc, s = *(const f32x4*)(ropes + t * 32 + dl) * sc;
#pragma unroll
                    for (int bj = 0; bj < 2; ++bj) {
                        const int hm = 4 * (u.pn & 1) + 2 * bj + (wc >> 1);
                        const f32x4 x1 = acc[ai][bj][m][0], x2 = acc[ai][bj][m][1];
                        const f32x4 o1 = x1 * c - x2 * s, o2 = x2 * c + x1 * s;
                        bf16_t* p = base + ((size_t)(b * 8 + hm) * TT + t) * 64 + dl;
                        u32x2 w1, w2; w1.x = pkbf(o1[0], o1[1]); w1.y = pkbf(o1[2], o1[3]); w2.x = pkbf(o2[0], o2[1]); w2.y = pkbf(o2[2], o2[3]);
                        *(u32x2*)p = w1; *(u32x2*)(p + 32) = w2;
                    }
                }
        } else if (u.pn < 6) {
            const int e0 = wc * 32 + 8 * fq;
#pragma unroll
            for (int ai = 0; ai < 2; ++ai)
#pragma unroll
                for (int m = 0; m < 4; ++m) {
                    const int row = row0 + ai * HALF + m * 16; int b, t; bt_of(row, b, t);
#pragma unroll
                    for (int bj = 0; bj < 2; ++bj) { const int h = (u.pn - 4) * 2 + bj; const f32x4 v0 = acc[ai][bj][m][0], v1 = acc[ai][bj][m][1];
                        u32x4 w; w.x = pkbf(v0[0], v0[1]); w.y = pkbf(v0[2], v0[3]); w.z = pkbf(v1[0], v1[1]); w.w = pkbf(v1[2], v1[3]);
                        *(u32x4*)(Vc + ((size_t)(b * 4 + h) * TT + t) * 128 + e0) = w; }
                }
        } else if (u.pn < 14) {
            const int col0 = (u.pn - 6) * BM + wc * 32 + 8 * fq;
#pragma unroll
            for (int ai = 0; ai < 2; ++ai)
#pragma unroll
                for (int m = 0; m < 4; ++m) {
                    bf16_t* rowp = Z + (size_t)(row0 + ai * HALF + m * 16) * NZ + col0;
#pragma unroll
                    for (int bj = 0; bj < 2; ++bj) { const f32x4 v0 = acc[ai][bj][m][0], v1 = acc[ai][bj][m][1];
                        u32x4 w; w.x = pkbf(v0[0], v0[1]); w.y = pkbf(v0[2], v0[3]); w.z = pkbf(v1[0], v1[1]); w.w = pkbf(v1[2], v1[3]);
                        *(u32x4*)(rowp + bj * HALF) = w; }
                }
        } else if (u.pm < NREAL / BM) {
            const int gi = (u.pn - 14) >> 2, pn4 = (u.pn - 14) & 3;
            u32x4* gp = (u32x4*)GF + ((((size_t)(gi * (NREAL / BM) + u.pm) * 4 + pn4) * 8 + (wr * 4 + wc)) * 16) * 64 + (fq * 16 + fr);
#pragma unroll
            for (int ai = 0; ai < 2; ++ai)
#pragma unroll
                for (int bj = 0; bj < 2; ++bj)
#pragma unroll
                    for (int m = 0; m < 4; ++m) { const f32x4 v0 = acc[ai][bj][m][0], v1 = acc[ai][bj][m][1];
                        u32x4 w; w.x = pkbf(sigmoidf_(v0[0]), sigmoidf_(v0[1])); w.y = pkbf(sigmoidf_(v0[2]), sigmoidf_(v0[3])); w.z = pkbf(sigmoidf_(v1[0]), sigmoidf_(v1[1])); w.w = pkbf(sigmoidf_(v1[2]), sigmoidf_(v1[3]));
                        gp[((ai * 2 + bj) * 4 + m) * 64] = w; }
        }
    }
};
template <bool SECOND> struct EpiGate {
    static constexpr bool PERM = true;
    bf16_t* Z; bf16_t* TMP; bf16_t* MRG;
    __device__ __forceinline__ void operator()(const f32x4 (&acc)[2][2][4][2], const Unit& u, int wr, int wc, int fr, int fq) const {
        const int row0 = u.pm * BM + wr * 64 + fr, col0 = u.pn * BM + wc * 32 + 8 * fq;
#pragma unroll
        for (int ai = 0; ai < 2; ++ai)
#pragma unroll
            for (int m = 0; m < 4; ++m) {
                bf16_t* rowp = Z + (size_t)(row0 + ai * HALF + m * 16) * NZ + col0; bf16_t* tmpp = TMP + (size_t)(row0 + ai * HALF + m * 16) * DM + col0; bf16_t* mrgp = MRG + (size_t)(row0 + ai * HALF + m * 16) * DM + col0;
#pragma unroll
                for (int bj = 0; bj < 2; ++bj) {
                    const u32x4 gw = *(const u32x4*)(rowp + (SECOND ? ZGM : ZGA) + bj * HALF);
                    const f32x4 v0 = acc[ai][bj][m][0], v1 = acc[ai][bj][m][1];
                    float o[8];
                    o[0] = sigmoidf_(bflo(gw.x)) * v0[0]; o[1] = sigmoidf_(bfhi(gw.x)) * v0[1]; o[2] = sigmoidf_(bflo(gw.y)) * v0[2]; o[3] = sigmoidf_(bfhi(gw.y)) * v0[3];
                    o[4] = sigmoidf_(bflo(gw.z)) * v1[0]; o[5] = sigmoidf_(bfhi(gw.z)) * v1[1]; o[6] = sigmoidf_(bflo(gw.w)) * v1[2]; o[7] = sigmoidf_(bfhi(gw.w)) * v1[3];
                    if (SECOND) { const u32x4 tw = *(const u32x4*)(tmpp + bj * HALF);
                        o[0] += bflo(tw.x); o[1] += bfhi(tw.x); o[2] += bflo(tw.y); o[3] += bfhi(tw.y); o[4] += bflo(tw.z); o[5] += bfhi(tw.z); o[6] += bflo(tw.w); o[7] += bfhi(tw.w); }
                    u32x4 w; w.x = pkbf(o[0], o[1]); w.y = pkbf(o[2], o[3]); w.z = pkbf(o[4], o[5]); w.w = pkbf(o[6], o[7]);
                    if (SECOND) *(u32x4*)(mrgp + bj * HALF) = w; else *(u32x4*)(tmpp + bj * HALF) = w;
                }
            }
    }
};
struct EpiGateFused {
    static constexpr bool PERM = true;
    const bf16_t* GF; bf16_t* MRG;
    __device__ __forceinline__ void mid(f32x4 (&acc)[2][2][4][2], const Unit& u, int wr, int wc, int fr, int fq) const {
        asm volatile("" : "+v"(fr), "+v"(fq));
        const u32x4* ga = (const u32x4*)GF + ((((size_t)u.pm * 4 + u.pn) * 8 + (wr * 4 + wc)) * 16) * 64 + (fq * 16 + fr);
        const u32x4* gm = ga + (size_t)(NREAL / BM) * 4 * 8 * 16 * 64;
#pragma unroll
        for (int q = 0; q < 16; ++q) {
            const int ai = q >> 3, bj = (q >> 2) & 1, m = q & 3;
            const u32x4 a = ga[q * 64], b = gm[q * 64];
            float r[8];
#define EG_R(a_, m_) ((a_) * __builtin_amdgcn_rcpf(m_))
            r[0] = EG_R(bflo(a.x), bflo(b.x)); r[1] = EG_R(bfhi(a.x), bfhi(b.x)); r[2] = EG_R(bflo(a.y), bflo(b.y)); r[3] = EG_R(bfhi(a.y), bfhi(b.y));
            r[4] = EG_R(bflo(a.z), bflo(b.z)); r[5] = EG_R(bfhi(a.z), bfhi(b.z)); r[6] = EG_R(bflo(a.w), bflo(b.w)); r[7] = EG_R(bfhi(a.w), bfhi(b.w));
#undef EG_R
            acc[ai][bj][m][0] = acc[ai][bj][m][0] * (f32x4){r[0], r[1], r[2], r[3]}; acc[ai][bj][m][1] = acc[ai][bj][m][1] * (f32x4){r[4], r[5], r[6], r[7]};
            asm volatile("" : "+v"(acc[ai][bj][m][0]), "+v"(acc[ai][bj][m][1]));
            if ((q & 7) == 7) asm volatile("" ::: "memory");
        }
    }
    __device__ __forceinline__ void operator()(const f32x4 (&acc)[2][2][4][2], const Unit& u, int wr, int wc, int fr, int fq) const {
        const int row0 = u.pm * BM + wr * 64 + fr, col0 = u.pn * BM + wc * 32 + 8 * fq;
        const u32x4* gm = (const u32x4*)GF + (size_t)(NREAL / BM) * 4 * 8 * 16 * 64 + ((((size_t)u.pm * 4 + u.pn) * 8 + (wr * 4 + wc)) * 16) * 64 + (fq * 16 + fr);
#pragma unroll
        for (int ai = 0; ai < 2; ++ai)
#pragma unroll
            for (int m = 0; m < 4; ++m) {
                bf16_t* mrgp = MRG + (size_t)(row0 + ai * HALF + m * 16) * DM + col0;
#pragma unroll
                for (int bj = 0; bj < 2; ++bj) {
                    const u32x4 g = gm[((ai * 2 + bj) * 4 + m) * 64];
                    const f32x4 v0 = acc[ai][bj][m][0], v1 = acc[ai][bj][m][1];
                    u32x4 w; w.x = pkbf(bflo(g.x) * v0[0], bfhi(g.x) * v0[1]); w.y = pkbf(bflo(g.y) * v0[2], bfhi(g.y) * v0[3]);
                    w.z = pkbf(bflo(g.z) * v1[0], bfhi(g.z) * v1[1]); w.w = pkbf(bflo(g.w) * v1[2], bfhi(g.w) * v1[3]);
                    *(u32x4*)(mrgp + bj * HALF) = w;
                }
            }
    }
};
struct EpiStoreBf16 {
    static constexpr bool PERM = true;
    bf16_t* O; int ldc;
    __device__ __forceinline__ void operator()(const f32x4 (&acc)[2][2][4][2], const Unit& u, int wr, int wc, int fr, int fq) const {
        const int row0 = u.pm * BM + wr * 64 + fr, col0 = u.pn * BM + wc * 32 + 8 * fq;
#pragma unroll
        for (int ai = 0; ai < 2; ++ai)
#pragma unroll
            for (int m = 0; m < 4; ++m) { bf16_t* rowp = O + (size_t)(row0 + ai * HALF + m * 16) * ldc + col0;
#pragma unroll
                for (int bj = 0; bj < 2; ++bj) { const f32x4 v0 = acc[ai][bj][m][0], v1 = acc[ai][bj][m][1];
                    u32x4 w; w.x = pkbf(v0[0], v0[1]); w.y = pkbf(v0[2], v0[3]); w.z = pkbf(v1[0], v1[1]); w.w = pkbf(v1[2], v1[3]);
                    *(u32x4*)(rowp + bj * HALF) = w; } }
    }
};
struct EpiPre1 {
    static constexpr bool PERM = false;
    float* P1; const float* x; const float* meta; const float* stats; const float* g0; const float* b0;
    __device__ __forceinline__ void operator()(const f32x4 (&acc)[2][2][4][2], const Unit& u, int wr, int wc, int fr, int fq) const {
        const int row0 = u.pm * BM + wr * 64 + fr, col0 = u.pn * BM + wc * 32 + 4 * fq;
        f32x4 gv[2][2], bv[2][2];
#pragma unroll
        for (int bj = 0; bj < 2; ++bj)
#pragma unroll
            for (int n = 0; n < 2; ++n) { gv[bj][n] = *(const f32x4*)(g0 + col0 + bj * HALF + n * 16); bv[bj][n] = *(const f32x4*)(b0 + col0 + bj * HALF + n * 16); }
#pragma unroll
        for (int ai = 0; ai < 2; ++ai)
#pragma unroll
            for (int m = 0; m < 4; ++m) {
                const int row = row0 + ai * HALF + m * 16;
                const float* xr = x + (size_t)row * DM;
                const float mean = ld_agent_f(stats + 2 * row), rstd = ld_agent_f(stats + 2 * row + 1);
                float* orow = P1 + (size_t)row * (NZ / 2) + col0;
#pragma unroll
                for (int bj = 0; bj < 2; ++bj)
#pragma unroll
                    for (int n = 0; n < 2; ++n) { const f32x4 xv = *(const f32x4*)(xr + col0 + bj * HALF + n * 16);
                        const f32x4 hv = (xv - mean) * rstd * gv[bj][n] + bv[bj][n];
                        *(f32x4*)(orow + bj * HALF + n * 16) = hv * DN_ALPHA + acc[ai][bj][m][n]; }
            }
    }
};
struct EpiAct {
    static constexpr bool PERM = true;
    bf16_t* ACT; const float* b_gu; const int* tile_exp; int pm0;
    __device__ __forceinline__ void operator()(const f32x4 (&acc)[2][2][4][2], const Unit& u, int wr, int wc, int fr, int fq) const {
        const int e = u.e;
        const int ac0 = u.pn * HALF + wc * 32 + 8 * fq;
        const float* bp = b_gu + (size_t)e * 2 * FF + 2 * ac0;
        f32x2 bg[4], bl[4];
#pragma unroll
        for (int q = 0; q < 4; ++q) { const f32x4 v0 = *(const f32x4*)(bp + 4 * q); bg[q] = (f32x2){v0[0], v0[2]}; bl[q] = (f32x2){v0[1], v0[3]}; }
        const int row0 = u.pm * BM + wr * 64 + fr;
#pragma unroll
        for (int ai = 0; ai < 2; ++ai)
#pragma unroll
            for (int m = 0; m < 4; ++m) {
                float o[8];
#pragma unroll
                for (int q = 0; q < 4; ++q) {
                    const f32x4 ag = acc[ai][0][m][q >> 1], al = acc[ai][1][m][q >> 1];
                    f32x2 gl = (f32x2){ag[2 * (q & 1)], ag[2 * (q & 1) + 1]} + bg[q], li = (f32x2){al[2 * (q & 1)], al[2 * (q & 1) + 1]} + bl[q];
                    gl = (f32x2){fminf(gl[0], 7.0f), fminf(gl[1], 7.0f)}; li = (f32x2){fminf(fmaxf(li[0], -7.0f), 7.0f), fminf(fmaxf(li[1], -7.0f), 7.0f)};
                    const f32x2 tt = gl * (-1.702f * 1.4426950408889634f);
                    const f32x2 den = (f32x2){__builtin_amdgcn_exp2f(tt[0]), __builtin_amdgcn_exp2f(tt[1])} + 1.0f;
                    const f32x2 sg = (f32x2){__builtin_amdgcn_rcpf(den[0]), __builtin_amdgcn_rcpf(den[1])};
                    const f32x2 r = (gl * sg) * (li + 1.0f);
                    o[2 * q] = r[0]; o[2 * q + 1] = r[1];
                }
                u32x4 w; w.x = pkbf(o[0], o[1]); w.y = pkbf(o[2], o[3]); w.z = pkbf(o[4], o[5]); w.w = pkbf(o[6], o[7]);
                *(u32x4*)(ACT + (size_t)(row0 + ai * HALF + m * 16) * FF + ac0) = w;
            }
    }
};
struct EpiDown {
    static constexpr bool PERM = true;
    bf16_t* Y; const float* b_down; const int* tile_exp; const int* row_slot; const float* row_gate; int pm0;
    __device__ __forceinline__ void operator()(const f32x4 (&acc)[2][2][4][2], const Unit& u, int wr, int wc, int fr, int fq) const {
        const int e = u.e;
        const int col0 = u.pn * BM + wc * 32 + 8 * fq;
        f32x4 bv[2][2];
#pragma unroll
        for (int bj = 0; bj < 2; ++bj)
#pragma unroll
            for (int n = 0; n < 2; ++n) bv[bj][n] = *(const f32x4*)(b_down + (size_t)e * DM + col0 + bj * HALF + 4 * n);
        const int r0 = (pm0 + u.pm) * BM + wr * 64 + fr;
#pragma unroll
        for (int ai = 0; ai < 2; ++ai)
#pragma unroll
            for (int m = 0; m < 4; ++m) {
                const int r = r0 + ai * HALF + m * 16;
                const int slot = row_slot[r]; const float gt = row_gate[r];
                bf16_t* rowp = Y + (size_t)slot * DM + col0;
#pragma unroll
                for (int bj = 0; bj < 2; ++bj) { const f32x4 v0 = (acc[ai][bj][m][0] + bv[bj][0]) * gt, v1 = (acc[ai][bj][m][1] + bv[bj][1]) * gt;
                    u32x4 w; w.x = pkbf(v0[0], v0[1]); w.y = pkbf(v0[2], v0[3]); w.z = pkbf(v1[0], v1[1]); w.w = pkbf(v1[2], v1[3]);
                    *(u32x4*)(rowp + bj * HALF) = w; }
            }
    }
};
}

namespace attn_body {
using bf16 = __hip_bfloat16;
using s16x4 = __attribute__((ext_vector_type(4))) short;
using f32x16 = __attribute__((ext_vector_type(16))) float;
constexpr int D = 64, PZ = 64, PV = 128, PO = 1024;
constexpr int NW = 8, QBLK = 32, QB = QBLK * NW, KVBLK = 64;
__device__ __forceinline__ int crow(int r, int hi) { return (r & 3) + 8 * (r >> 2) + 4 * hi; }
#define SBAR() __builtin_amdgcn_sched_barrier(0)
__device__ __forceinline__ void cmask(f32x16& p0, f32x16& p1, int jb, int qrel, int hi) {
    const float NEG = -INFINITY; const int d = qrel - 64 * jb - 4 * hi;
#pragma unroll
    for (int r = 0; r < 16; ++r) { const int c = (r & 3) + 8 * (r >> 2); if (c > d) p0[r] = NEG; if (c + 32 > d) p1[r] = NEG; }
}
constexpr int NSLOT = 3, SLOTB = 8192;
constexpr int LDS_K = 0, LDS_V = NSLOT * SLOTB, LDS_WS = 2 * NSLOT * SLOTB, LDS_OST = LDS_WS + NW * 64 * 4, LDS_BYTES_A = LDS_OST + NW * 4096;
__device__ __forceinline__ void glds16(const void* gsrc, unsigned lds_dst) { unsigned keep;
    asm volatile("s_mov_b32 %0, m0\n\ts_mov_b32 m0, %2\n\ts_nop 0\n\tglobal_load_lds_dwordx4 %1, off\n\ts_mov_b32 m0, %0" : "=&s"(keep) : "v"(gsrc), "s"(lds_dst) : "memory"); }
__device__ __forceinline__ float max3f(float a, float b, float c) { float r; asm("v_max3_f32 %0, %1, %2, %3" : "=v"(r) : "v"(a), "v"(b), "v"(c)); return r; }
__device__ __forceinline__ float max2f(float a, float b) { float r; asm("v_max_f32_e32 %0, %1, %2" : "=v"(r) : "v"(a), "v"(b)); return r; }
__device__ __forceinline__ float fadd_s(float a, float b) { float r; asm("v_add_f32_e32 %0, %1, %2" : "=v"(r) : "v"(a), "v"(b)); return r; }
__device__ __forceinline__ float fsub_s(float a, float b) { float r; asm("v_sub_f32_e32 %0, %1, %2" : "=v"(r) : "v"(a), "v"(b)); return r; }
__device__ __forceinline__ unsigned cvtpk_s(float lo, float hi) { return pkbf(lo, hi); }
#define WAIT_BAR(N) asm volatile("s_waitcnt vmcnt(" #N ") lgkmcnt(0)\n\ts_barrier" ::: "memory")
__device__ __forceinline__ void qkt(f32x16& p0, f32x16& p1, const char* Kslot, const bf16x8* qr, const f32x16& negm, int r32, int hi) {
    const char* kb = Kslot + hi * 1024 + r32 * 16;
#pragma unroll
    for (int d0 = 0; d0 < 4; ++d0) {
        const bf16x8 b0 = *reinterpret_cast<const bf16x8*>(kb + d0 * 2048);
        const bf16x8 b1 = *reinterpret_cast<const bf16x8*>(kb + d0 * 2048 + 512);
        if (d0 == 0) { p0 = __builtin_amdgcn_mfma_f32_32x32x16_bf16(b0, qr[0], negm, 0, 0, 0); p1 = __builtin_amdgcn_mfma_f32_32x32x16_bf16(b1, qr[0], negm, 0, 0, 0); }
        else { p0 = __builtin_amdgcn_mfma_f32_32x32x16_bf16(b0, qr[d0], p0, 0, 0, 0); p1 = __builtin_amdgcn_mfma_f32_32x32x16_bf16(b1, qr[d0], p1, 0, 0, 0); } }
}
typedef __attribute__((address_space(3))) const char* lds_cptr;
typedef short v4i16_t __attribute__((ext_vector_type(4)));
__device__ __forceinline__ void kload8(bf16x8* kf, lds_cptr kp) {
    kf[0] = *(const __attribute__((address_space(3))) bf16x8*)(kp);        kf[1] = *(const __attribute__((address_space(3))) bf16x8*)(kp + 512);
    kf[2] = *(const __attribute__((address_space(3))) bf16x8*)(kp + 2048); kf[3] = *(const __attribute__((address_space(3))) bf16x8*)(kp + 2560);
    kf[4] = *(const __attribute__((address_space(3))) bf16x8*)(kp + 4096); kf[5] = *(const __attribute__((address_space(3))) bf16x8*)(kp + 4608);
    kf[6] = *(const __attribute__((address_space(3))) bf16x8*)(kp + 6144); kf[7] = *(const __attribute__((address_space(3))) bf16x8*)(kp + 6656);
}
__device__ __forceinline__ void kload2(bf16x8* kf, lds_cptr kp, int j) { kf[2 * j] = *(const __attribute__((address_space(3))) bf16x8*)(kp + j * 2048); kf[2 * j + 1] = *(const __attribute__((address_space(3))) bf16x8*)(kp + j * 2048 + 512); }
__device__ __forceinline__ s16x4 vtr(lds_cptr p) { return __builtin_bit_cast(s16x4, __builtin_amdgcn_ds_read_tr16_b64_v4i16((__attribute__((address_space(3))) v4i16_t*)p)); }
__device__ __forceinline__ float rowmax(const f32x16& p0, const f32x16& p1) {
    float a = max3f(p0[0], p0[1], p1[0]), b = max3f(p0[2], p0[3], p1[1]); a = max3f(a, p1[2], p1[3]);
#pragma unroll
    for (int r = 4; r < 16; r += 4) { a = max3f(a, p0[r], p0[r + 1]); b = max3f(b, p0[r + 2], p0[r + 3]); a = max3f(a, p1[r], p1[r + 1]); b = max3f(b, p1[r + 2], p1[r + 3]); }
    const float m = max2f(a, b);
    auto rr = __builtin_amdgcn_permlane32_swap(__float_as_uint(m), __float_as_uint(m), false, false);
    return max2f(__uint_as_float(rr[0]), __uint_as_float(rr[1]));
}
__device__ __forceinline__ void pv(f32x16* o, int vb, bf16x8 pa0, bf16x8 pa1, bf16x8 pa2, bf16x8 pa3) {
#pragma unroll
    for (int d0 = 0; d0 < 2; ++d0) { s16x4 lo[4], hi[4];
#pragma unroll
        for (int ks = 0; ks < 4; ++ks) {
            asm volatile("ds_read_b64_tr_b16 %0,%1 offset:%c2" : "=&v"(lo[ks]) : "v"(vb), "i"(d0 * 4096 + ks * 1024) : "memory");
            asm volatile("ds_read_b64_tr_b16 %0,%1 offset:%c2" : "=&v"(hi[ks]) : "v"(vb), "i"(d0 * 4096 + ks * 1024 + 512) : "memory"); }
        asm volatile("s_waitcnt lgkmcnt(0)" ::: "memory"); SBAR();
#define PK(k) (bf16x8){lo[k][0], lo[k][1], lo[k][2], lo[k][3], hi[k][0], hi[k][1], hi[k][2], hi[k][3]}
        o[d0] = __builtin_amdgcn_mfma_f32_32x32x16_bf16(pa0, PK(0), o[d0], 0, 0, 0);
        o[d0] = __builtin_amdgcn_mfma_f32_32x32x16_bf16(pa1, PK(1), o[d0], 0, 0, 0);
        o[d0] = __builtin_amdgcn_mfma_f32_32x32x16_bf16(pa2, PK(2), o[d0], 0, 0, 0);
        o[d0] = __builtin_amdgcn_mfma_f32_32x32x16_bf16(pa3, PK(3), o[d0], 0, 0, 0);
#undef PK
    }
}
#define ATTN_STORE16(p, v) (*(u32x4*)(p) = (v))
template <int THRL> __device__ __forceinline__ void attn_unit(int qb, const bf16* Qh, const bf16* __restrict__ Kh, const bf16* __restrict__ Vh, bf16* Oh, char* shm) {
    const int tid = threadIdx.x; int lane = tid & 63; asm volatile("" : "+v"(lane));
    const int r32 = lane & 31, hi = lane >> 5; const int wid = __builtin_amdgcn_readfirstlane(tid >> 6);
    const int q0 = qb * QB;
    const bf16* Qw = Qh + (long)(q0 + wid * QBLK) * PZ;
    const unsigned lds0 = (unsigned)(uintptr_t)shm;
    float* wsf = (float*)(shm + LDS_WS) + wid * 64;
    const bf16* ksrc = Kh + (long)lane * PZ + wid * 8;
    const bf16* vsrc = Vh + (long)(16 * (wid & 3) + (lane >> 2)) * PV + (wid >> 2) * 32 + (lane & 3) * 8;
    const unsigned kdst = lds0 + LDS_K + wid * 1024, vdst = lds0 + LDS_V + wid * 1024;
#define DMA_K(t, slot) glds16(ksrc + (long)(t) * KVBLK * PZ, (unsigned)__builtin_amdgcn_readfirstlane(kdst + (slot)))
#define DMA_V(t, slot) glds16(vsrc + (long)(t) * KVBLK * PV, (unsigned)__builtin_amdgcn_readfirstlane(vdst + (slot)))
    const int vb0 = (int)(lds0 + LDS_V) + ((lane >> 4) & 1) * 32 + (lane & 3) * 8 + (4 * hi + ((lane & 15) >> 2)) * 64;
    const char* Kbase = shm + LDS_K; bf16x8 kf[8];
    const lds_cptr shm3 = (lds_cptr)shm; const lds_cptr kp0 = shm3 + LDS_K + hi * 1024 + r32 * 16; const lds_cptr vp0 = shm3 + LDS_V + ((lane >> 4) & 1) * 32 + (lane & 3) * 8 + (4 * hi + ((lane & 15) >> 2)) * 64;
    const int NT = (q0 + QB) / KVBLK;
    DMA_K(0, 0); DMA_V(0, 0); DMA_K(1, SLOTB);
    bf16x8 qr[4];
#pragma unroll
    for (int d0 = 0; d0 < 4; ++d0) qr[d0] = *reinterpret_cast<const bf16x8*>(&Qw[(long)r32 * PZ + d0 * 16 + hi * 8]);
    float mhat = 0.f, l_reg = 0.f; f32x16 o[2]; o[0] = f32x16{}; o[1] = f32x16{}; f32x16 negm = f32x16{}; asm volatile("" : "+v"(negm));
    const int qrel = wid * QBLK + r32;
#define CMASK(P0, P1, t) do { int jb_ = (t) - (NT - 4); if (jb_ >= 0) cmask(P0, P1, jb_, qrel, hi); } while (0)
    bool resc = false;
#define START(P0, P1) do { const float rm = rowmax(P0, P1); resc = false; \
    { const float dl = rm; mhat = fadd_s(mhat, dl); \
      _Pragma("unroll") for (int r = 0; r < 16; ++r) { P0[r] = fsub_s(P0[r], dl); P1[r] = fsub_s(P1[r], dl); } \
      _Pragma("unroll") for (int r = 0; r < 16; ++r) negm[r] = -mhat; asm volatile("" : "+v"(negm)); } \
    _Pragma("unroll") for (int r = 0; r < 16; ++r) P0[r] = __builtin_amdgcn_exp2f(P0[r]); } while (0)
#define RESC() do { if (resc) { asm volatile("s_waitcnt lgkmcnt(0)" ::: "memory"); \
      _Pragma("unroll") for (int d_ = 0; d_ < 2; ++d_) _Pragma("unroll") for (int r = 0; r < 16; ++r) o[d_][r] *= wsf[crow(r, hi)]; } } while (0)
    f32x16 pA0, pA1, pB0, pB1;
    int sl_prev = 0, sl_cur = 0, sl_next = SLOTB;
#define ROT() do { sl_prev = sl_cur; sl_cur = sl_next; sl_next = (sl_next == (NSLOT - 1) * SLOTB) ? 0 : sl_next + SLOTB; } while (0)
    DMA_K(2, 2 * SLOTB);
    WAIT_BAR(3);
    qkt(pA0, pA1, Kbase, qr, negm, r32, hi); asm volatile("s_nop 15\n\ts_nop 7" : "+v"(pA0), "+v"(pA1)); CMASK(pA0, pA1, 0);
    START(pA0, pA1);
    _Pragma("unroll") for (int r = 0; r < 16; ++r) pA1[r] = __builtin_amdgcn_exp2f(pA1[r]);
    WAIT_BAR(0);
    DMA_K(3, 0); DMA_V(1, SLOTB);
    ROT();
    kload8(kf, kp0 + sl_cur);
    WAIT_BAR(2);
    s16x4 vlo[8], vhi[8]; u32x4 pw0, pw1, pw2, pw3;
#define PKW(P, B) cvtpk_s(P[B], P[B + 1])
#define PAF(k) __builtin_bit_cast(bf16x8, pw##k)
#define VFR(i) (bf16x8){vlo[i][0], vlo[i][1], vlo[i][2], vlo[i][3], vhi[i][0], vhi[i][1], vhi[i][2], vhi[i][3]}
#define PIN(x) asm volatile("" : "+v"(x))
#define MX3(a, b, c) __builtin_fmaxf(__builtin_fmaxf((a), (b)), (c))
#define GAPA(MF, A0, A1, A2, A3, W0, W1, PW) do { MF; sacc += A0; sacc += A1; sacc += A2; sacc += A3; PIN(sacc); W0; W1; PIN(PW); SBAR(); } while (0)
#define EX(v) __builtin_amdgcn_exp2f(v)
#define GAPB(MF, X, B) do { MF; X[B] = EX(X[B]); X[B + 1] = EX(X[B + 1]); X[B + 2] = EX(X[B + 2]); X[B + 3] = EX(X[B + 3]); PIN(X); SBAR(); } while (0)
#define VRD(i) do { vlo[i] = vtr(vp_ + (((i) >> 2) * 4096 + ((i) & 3) * 1024)); vhi[i] = vtr(vp_ + (((i) >> 2) * 4096 + ((i) & 3) * 1024 + 512)); } while (0)
#define KRD(G, j) do { if (G) { kload2(kf, kp0 + sl_next, j); SBAR(); } } while (0)
#define STEP(C0, C1, P0, P1, t, GK, GV, GL) do { SBAR(); \
    const lds_cptr vp_ = vp0 + sl_prev; \
    VRD(0); SBAR(); float sacc = (P0[0] + P0[1]); \
    GAPA(C0 = __builtin_amdgcn_mfma_f32_32x32x16_bf16(kf[0], qr[0], negm, 0, 0, 0), P0[2], P0[3], P0[4], P0[5],     pw0[0] = PKW(P0, 0), pw0[1] = PKW(P0, 2), pw0); \
    VRD(4); SBAR(); GAPA(C1 = __builtin_amdgcn_mfma_f32_32x32x16_bf16(kf[1], qr[0], negm, 0, 0, 0), P0[6], P0[7], P0[8], P0[9],     pw0[2] = PKW(P0, 4), pw0[3] = PKW(P0, 6), pw0); \
    VRD(1); SBAR(); GAPA(C0 = __builtin_amdgcn_mfma_f32_32x32x16_bf16(kf[2], qr[1], C0, 0, 0, 0),   P0[10], P0[11], P0[12], P0[13], pw1[0] = PKW(P0, 8), pw1[1] = PKW(P0, 10), pw1); \
    VRD(5); SBAR(); GAPA(C1 = __builtin_amdgcn_mfma_f32_32x32x16_bf16(kf[3], qr[1], C1, 0, 0, 0),   P0[14], P0[15], P1[0], P1[1],   pw1[2] = PKW(P0, 12), pw1[3] = PKW(P0, 14), pw1); \
    VRD(2); SBAR(); GAPA(C0 = __builtin_amdgcn_mfma_f32_32x32x16_bf16(kf[4], qr[2], C0, 0, 0, 0),   P1[2], P1[3], P1[4], P1[5],     pw2[0] = PKW(P1, 0), pw2[1] = PKW(P1, 2), pw2); \
    VRD(6); SBAR(); GAPA(C1 = __builtin_amdgcn_mfma_f32_32x32x16_bf16(kf[5], qr[2], C1, 0, 0, 0),   P1[6], P1[7], P1[8], P1[9],     pw2[2] = PKW(P1, 4), pw2[3] = PKW(P1, 6), pw2); \
    VRD(3); SBAR(); GAPA(C0 = __builtin_amdgcn_mfma_f32_32x32x16_bf16(kf[6], qr[3], C0, 0, 0, 0),   P1[10], P1[11], P1[12], P1[13], pw3[0] = PKW(P1, 8), pw3[1] = PKW(P1, 10), pw3); \
    VRD(7); SBAR(); GAPA(C1 = __builtin_amdgcn_mfma_f32_32x32x16_bf16(kf[7], qr[3], C1, 0, 0, 0),   P1[14], P1[15], 0.f, 0.f,       pw3[2] = PKW(P1, 12), pw3[3] = PKW(P1, 14), pw3); \
    l_reg += sacc; \
    if (GK) { DMA_K((t) + 3, sl_cur); } if (GV) { DMA_V((t) + 1, sl_next); } \
    CMASK(C0, C1, t); \
    { float a = MX3(C0[0], C0[1], C1[0]), b = MX3(C0[2], C0[3], C1[1]); a = MX3(a, C1[2], C1[3]); \
      _Pragma("unroll") for (int r = 4; r < 16; r += 4) { a = MX3(a, C0[r], C0[r + 1]); b = MX3(b, C0[r + 2], C0[r + 3]); a = MX3(a, C1[r], C1[r + 1]); b = MX3(b, C1[r + 2], C1[r + 3]); } \
      float rm = __builtin_fmaxf(a, b); { auto rr = __builtin_amdgcn_permlane32_swap(__float_as_uint(rm), __float_as_uint(rm), false, false); rm = __builtin_fmaxf(__uint_as_float(rr[0]), __uint_as_float(rr[1])); } \
      resc = false; \
      if (__builtin_expect(__any(rm > (float)THRL), 0)) { const float dl = __builtin_fmaxf(rm, 0.f); mhat += dl; \
        _Pragma("unroll") for (int r = 0; r < 16; ++r) { C0[r] -= dl; C1[r] -= dl; } \
        _Pragma("unroll") for (int r = 0; r < 16; ++r) negm[r] = -mhat; asm volatile("" : "+v"(negm)); \
        const float f = __builtin_amdgcn_exp2f(-dl); l_reg *= f; if (hi == 0) wsf[r32] = f; resc = true; } } \
    SBAR(); \
    GAPB(o[0] = __builtin_amdgcn_mfma_f32_32x32x16_bf16(PAF(0), VFR(0), o[0], 0, 0, 0), C0, 0); \
    GAPB(o[1] = __builtin_amdgcn_mfma_f32_32x32x16_bf16(PAF(0), VFR(4), o[1], 0, 0, 0), C0, 4); \
    KRD(GL, 0); GAPB(o[0] = __builtin_amdgcn_mfma_f32_32x32x16_bf16(PAF(1), VFR(1), o[0], 0, 0, 0), C0, 8); \
    KRD(GL, 1); GAPB(o[1] = __builtin_amdgcn_mfma_f32_32x32x16_bf16(PAF(1), VFR(5), o[1], 0, 0, 0), C0, 12); \
    KRD(GL, 2); GAPB(o[0] = __builtin_amdgcn_mfma_f32_32x32x16_bf16(PAF(2), VFR(2), o[0], 0, 0, 0), C1, 0); \
    KRD(GL, 3); GAPB(o[1] = __builtin_amdgcn_mfma_f32_32x32x16_bf16(PAF(2), VFR(6), o[1], 0, 0, 0), C1, 4); \
    GAPB(o[0] = __builtin_amdgcn_mfma_f32_32x32x16_bf16(PAF(3), VFR(3), o[0], 0, 0, 0), C1, 8); \
    GAPB(o[1] = __builtin_amdgcn_mfma_f32_32x32x16_bf16(PAF(3), VFR(7), o[1], 0, 0, 0), C1, 12); \
    } while (0)
    int t = 1;
#undef CMASK
#define CMASK(P0, P1, t) do {} while (0)
    for (; t + 5 < NT; t += 2) {
        STEP(pB0, pB1, pA0, pA1, t, true, true, true);     WAIT_BAR(2); RESC(); ROT();
        STEP(pA0, pA1, pB0, pB1, t + 1, true, true, true); WAIT_BAR(2); RESC(); ROT();
    }
#undef CMASK
#define CMASK(P0, P1, t) do { int jb_ = (t) - (NT - 4); if (jb_ >= 0) cmask(P0, P1, jb_, qrel, hi); } while (0)
#define ENDW(tt) do { if ((tt) + 3 < NT) { WAIT_BAR(2); } else if ((tt) + 2 < NT) { WAIT_BAR(1); } else { WAIT_BAR(0); } } while (0)
    for (; t + 1 < NT; t += 2) {
        STEP(pB0, pB1, pA0, pA1, t, (t + 3 < NT), (t + 1 < NT), (t + 1 < NT));       ENDW(t);     RESC(); ROT();
        STEP(pA0, pA1, pB0, pB1, t + 1, (t + 4 < NT), (t + 2 < NT), (t + 2 < NT));   ENDW(t + 1); RESC(); ROT();
    }
    STEP(pB0, pB1, pA0, pA1, NT - 1, false, false, false); RESC();
    { float sacc = pB0[0] + pB0[1]; _Pragma("unroll") for (int r = 2; r < 16; ++r) sacc += pB0[r]; _Pragma("unroll") for (int r = 0; r < 16; ++r) sacc += pB1[r]; l_reg += sacc;
      pw0 = (u32x4){PKW(pB0, 0), PKW(pB0, 2), PKW(pB0, 4), PKW(pB0, 6)}; pw1 = (u32x4){PKW(pB0, 8), PKW(pB0, 10), PKW(pB0, 12), PKW(pB0, 14)}; pw2 = (u32x4){PKW(pB1, 0), PKW(pB1, 2), PKW(pB1, 4), PKW(pB1, 6)}; pw3 = (u32x4){PKW(pB1, 8), PKW(pB1, 10), PKW(pB1, 12), PKW(pB1, 14)};
      SBAR(); pv(o, vb0 + sl_cur, PAF(0), PAF(1), PAF(2), PAF(3)); }
#undef PKW
#undef PAF
#undef VFR
#undef PIN
#undef MX3
#undef GAPA
#undef GAPB
#undef EX
#undef VRD
#undef KRD
#undef STEP
#undef ENDW
    { auto rr = __builtin_amdgcn_permlane32_swap(__float_as_uint(l_reg), __float_as_uint(l_reg), false, false); l_reg = __uint_as_float(rr[0]) + __uint_as_float(rr[1]); }
    int lane2 = lane; asm volatile("" : "+v"(lane2));
    const int r32e = lane2 & 31, hie = lane2 >> 5;
    if (hie == 0) wsf[32 + r32e] = l_reg; asm volatile("s_waitcnt lgkmcnt(0)" ::: "memory");
    float rli[16];
#pragma unroll
    for (int r = 0; r < 16; ++r) rli[r] = __builtin_amdgcn_rcpf(wsf[32 + crow(r, hie)]);
    bf16* Ow = Oh + (long)(q0 + wid * QBLK) * PO;
    { bf16* stg = (bf16*)(shm + LDS_OST) + wid * 2048;
#pragma unroll
      for (int r = 0; r < 16; ++r) { const int orow = crow(r, hie);
#pragma unroll
        for (int d0 = 0; d0 < 2; ++d0) stg[orow * 64 + d0 * 32 + r32e] = __float2bfloat16(o[d0][r] * rli[r]); }
      asm volatile("s_waitcnt lgkmcnt(0)" ::: "memory");
#pragma unroll
      for (int i = 0; i < 4; ++i) { const int row = i * 8 + (lane2 >> 3), ch = lane2 & 7; const u32x4 v = *(const u32x4*)(stg + row * 64 + ch * 8); ATTN_STORE16(Ow + (long)row * PO + ch * 8, v); } }
    asm volatile("s_waitcnt lgkmcnt(0)\n\ts_barrier" ::: "memory");
#undef DMA_K
#undef DMA_V
#undef CMASK
#undef START
#undef RESC
#undef ROT
}

constexpr int A2_SLOT = 24576, A2_K = 0, A2_V = 8192, A2_WS = 4 * A2_SLOT, A2_OST = 0, A2_BYTES = A2_WS + NW * 256;
template <int THRL> __device__ __forceinline__ void attn2_unit(int qb, const bf16* Qh, const bf16* __restrict__ Kh, const bf16* __restrict__ Vh, bf16* Oh, char* shm, unsigned* prb = nullptr) {
    const int tid = threadIdx.x; int lane = tid & 63; asm volatile("" : "+v"(lane));
    const int r32 = lane & 31, hi = lane >> 5; const int wid = __builtin_amdgcn_readfirstlane(tid >> 6);
    const int q0 = qb * QB;
    const bf16* Qw = Qh + (long)(q0 + wid * QBLK) * PZ;
    const unsigned lds0 = (unsigned)(uintptr_t)shm;
    float* wsf = (float*)(shm + A2_WS) + wid * 64;
    bf16x8 qr[4];
#pragma unroll
    for (int d0 = 0; d0 < 4; ++d0) qr[d0] = *reinterpret_cast<const bf16x8*>(&Qw[(long)r32 * PZ + d0 * 16 + hi * 8]);
    const bf16* ksrc = Kh + (long)lane * PZ + wid * 8;
    const bf16* vsrc = Vh + (long)(16 * (wid & 3) + (lane >> 2)) * PV + (wid >> 2) * 32 + (lane & 3) * 8;
    const unsigned kdst = lds0 + A2_K + wid * 1024, vdst = lds0 + A2_V + wid * 1024;
#define A2_DMA(t, sl) do { glds16(ksrc + (long)(t) * KVBLK * PZ, (unsigned)__builtin_amdgcn_readfirstlane(kdst + (sl) * A2_SLOT)); \
        glds16(vsrc + (long)(t) * KVBLK * PV, (unsigned)__builtin_amdgcn_readfirstlane(vdst + (sl) * A2_SLOT)); \
        glds16(vsrc + (long)(t) * KVBLK * PV + 64, (unsigned)__builtin_amdgcn_readfirstlane(vdst + (sl) * A2_SLOT + 8192)); } while (0)
#define A2_WAITB(n1, n2) do { if (n2) asm volatile("s_waitcnt vmcnt(6)\n\ts_barrier" ::: "memory"); else if (n1) asm volatile("s_waitcnt vmcnt(3)\n\ts_barrier" ::: "memory"); else asm volatile("s_waitcnt vmcnt(0)\n\ts_barrier" ::: "memory"); } while (0)
    const int NT = (q0 + QB) / KVBLK;
    A2_DMA(0, 0); A2_DMA(1, 1); A2_DMA(2, 2);
    asm volatile("" : "+v"(qr[0]), "+v"(qr[1]), "+v"(qr[2]), "+v"(qr[3]));
    const lds_cptr shm3 = (lds_cptr)shm;
    const lds_cptr kp0 = shm3 + A2_K + hi * 1024 + r32 * 16;
    const lds_cptr vp0 = shm3 + A2_V + ((lane >> 4) & 1) * 32 + (lane & 3) * 8 + (4 * hi + ((lane & 15) >> 2)) * 64;
    float mhat = 0.f, l_reg = 0.f; f32x16 o[4]; o[0] = f32x16{}; o[1] = f32x16{}; o[2] = f32x16{}; o[3] = f32x16{}; f32x16 negm = f32x16{};
    const int qrel = wid * QBLK + r32;
#if MK_PROBE
    const unsigned long long pt0 = __builtin_amdgcn_s_memrealtime();
#endif
    for (int t = 0; t < NT; ++t) {
        A2_WAITB(t + 1 < NT, t + 2 < NT);
        if (t + 3 < NT) A2_DMA(t + 3, (t + 3) & 3);
        const int slot = t & 3;
        const lds_cptr kp = kp0 + slot * A2_SLOT; const lds_cptr vp = vp0 + slot * A2_SLOT;
        f32x16 p0, p1;
        {   bf16x8 kb[8];
#pragma unroll
            for (int d0 = 0; d0 < 4; ++d0) { kb[2 * d0] = *(const __attribute__((address_space(3))) bf16x8*)(kp + d0 * 2048); kb[2 * d0 + 1] = *(const __attribute__((address_space(3))) bf16x8*)(kp + d0 * 2048 + 512); }
            __builtin_amdgcn_sched_barrier(0);
            p0 = __builtin_amdgcn_mfma_f32_32x32x16_bf16(kb[0], qr[0], negm, 0, 0, 0); p1 = __builtin_amdgcn_mfma_f32_32x32x16_bf16(kb[1], qr[0], negm, 0, 0, 0);
#pragma unroll
            for (int d0 = 1; d0 < 4; ++d0) { p0 = __builtin_amdgcn_mfma_f32_32x32x16_bf16(kb[2 * d0], qr[d0], p0, 0, 0, 0); p1 = __builtin_amdgcn_mfma_f32_32x32x16_bf16(kb[2 * d0 + 1], qr[d0], p1, 0, 0, 0); }
        }
        { const int jb = t - (NT - 4); if (jb >= 0) cmask(p0, p1, jb, qrel, hi); }
        float rm;
        { float a = fmaxf(fmaxf(p0[0], p0[1]), p1[0]), b = fmaxf(fmaxf(p0[2], p0[3]), p1[1]); a = fmaxf(fmaxf(a, p1[2]), p1[3]);
#pragma unroll
          for (int r = 4; r < 16; r += 4) { a = fmaxf(fmaxf(a, p0[r]), p0[r + 1]); b = fmaxf(fmaxf(b, p0[r + 2]), p0[r + 3]); a = fmaxf(fmaxf(a, p1[r]), p1[r + 1]); b = fmaxf(fmaxf(b, p1[r + 2]), p1[r + 3]); }
          rm = fmaxf(a, b); auto rr = __builtin_amdgcn_permlane32_swap(__float_as_uint(rm), __float_as_uint(rm), false, false); rm = fmaxf(__uint_as_float(rr[0]), __uint_as_float(rr[1])); }
        if (t == 0 || __any(rm > (float)THRL)) {
            const float dl = (t == 0) ? rm : fmaxf(rm, 0.f); mhat += dl;
#pragma unroll
            for (int r = 0; r < 16; ++r) { p0[r] -= dl; p1[r] -= dl; negm[r] = -mhat; }
            const float f = __builtin_amdgcn_exp2f(-dl); l_reg *= f;
            if (t > 0) {
                if (hi == 0) wsf[r32] = f;
                asm volatile("s_waitcnt lgkmcnt(0)" ::: "memory");
#pragma unroll
                for (int r = 0; r < 16; ++r) { const float fr_ = wsf[crow(r, hi)];
#pragma unroll
                    for (int d_ = 0; d_ < 4; ++d_) o[d_][r] *= fr_; }
                asm volatile("s_waitcnt lgkmcnt(0)" ::: "memory");
            }
        }
        float sacc = 0.f;
#pragma unroll
        for (int r = 0; r < 16; ++r) { p0[r] = __builtin_amdgcn_exp2f(p0[r]); p1[r] = __builtin_amdgcn_exp2f(p1[r]); sacc += p0[r] + p1[r]; }
        l_reg += sacc;
        u32x4 pw[4];
        pw[0] = (u32x4){pkbf(p0[0], p0[1]), pkbf(p0[2], p0[3]), pkbf(p0[4], p0[5]), pkbf(p0[6], p0[7])};
        pw[1] = (u32x4){pkbf(p0[8], p0[9]), pkbf(p0[10], p0[11]), pkbf(p0[12], p0[13]), pkbf(p0[14], p0[15])};
        pw[2] = (u32x4){pkbf(p1[0], p1[1]), pkbf(p1[2], p1[3]), pkbf(p1[4], p1[5]), pkbf(p1[6], p1[7])};
        pw[3] = (u32x4){pkbf(p1[8], p1[9]), pkbf(p1[10], p1[11]), pkbf(p1[12], p1[13]), pkbf(p1[14], p1[15])};
        asm volatile("" : "+v"(pw[0]), "+v"(pw[1]), "+v"(pw[2]), "+v"(pw[3]));
        {   s16x4 vlo[2][4], vhh[2][4];
#pragma unroll
            for (int d0 = 0; d0 < 4; ++d0) { vlo[0][d0] = vtr(vp + d0 * 4096); vhh[0][d0] = vtr(vp + d0 * 4096 + 512); }
            __builtin_amdgcn_sched_barrier(0);
#pragma unroll
            for (int ks = 0; ks < 4; ++ks) {
                if (ks + 1 < 4) {
#pragma unroll
                    for (int d0 = 0; d0 < 4; ++d0) { vlo[(ks + 1) & 1][d0] = vtr(vp + d0 * 4096 + (ks + 1) * 1024); vhh[(ks + 1) & 1][d0] = vtr(vp + d0 * 4096 + (ks + 1) * 1024 + 512); }
                }
                __builtin_amdgcn_sched_barrier(0);
#pragma unroll
                for (int d0 = 0; d0 < 4; ++d0) {
                    const s16x4 lo = vlo[ks & 1][d0], hh = vhh[ks & 1][d0];
                    const bf16x8 vf = (bf16x8){lo[0], lo[1], lo[2], lo[3], hh[0], hh[1], hh[2], hh[3]};
                    o[d0] = __builtin_amdgcn_mfma_f32_32x32x16_bf16(__builtin_bit_cast(bf16x8, pw[ks]), vf, o[d0], 0, 0, 0);
                }
                __builtin_amdgcn_sched_barrier(0);
            }
        }
    }
#if MK_PROBE
    if (prb && tid == 0) { atomicAdd(prb, (unsigned)(__builtin_amdgcn_s_memrealtime() - pt0)); atomicAdd(prb + 1, (unsigned)NT); }
#endif
    asm volatile("s_waitcnt lgkmcnt(0)\n\ts_barrier" ::: "memory");
    { auto rr = __builtin_amdgcn_permlane32_swap(__float_as_uint(l_reg), __float_as_uint(l_reg), false, false); l_reg = __uint_as_float(rr[0]) + __uint_as_float(rr[1]); }
    if (hi == 0) wsf[32 + r32] = l_reg;
    asm volatile("s_waitcnt lgkmcnt(0)" ::: "memory");
    bf16* stg = (bf16*)(shm + A2_OST) + wid * 4096;
#pragma unroll
    for (int r = 0; r < 16; ++r) { const int orow = crow(r, hi); const float rl = __builtin_amdgcn_rcpf(wsf[32 + orow]);
#pragma unroll
        for (int d0 = 0; d0 < 4; ++d0) stg[orow * 128 + d0 * 32 + r32] = __float2bfloat16(o[d0][r] * rl); }
    asm volatile("s_waitcnt lgkmcnt(0)" ::: "memory");
    bf16* Ow = Oh + (long)(q0 + wid * QBLK) * PO;
#pragma unroll
    for (int i = 0; i < 8; ++i) { const int row = i * 4 + (lane >> 4), ch = lane & 15; const u32x4 v = *(const u32x4*)(stg + row * 128 + ch * 8); *(u32x4*)(Ow + (long)row * PO + ch * 8) = v; }
    asm volatile("s_waitcnt lgkmcnt(0)\n\ts_barrier" ::: "memory");
#undef A2_DMA
#undef A2_WAITB
}

template <int THRL> __device__ __forceinline__ void attn3_unit(int qb, const bf16* Qh, const bf16* __restrict__ Kh, const bf16* __restrict__ Vh, bf16* Oh, char* shm, unsigned* prb = nullptr) {
    const int tid = threadIdx.x; int lane = tid & 63; asm volatile("" : "+v"(lane));
    const int r32 = lane & 31, hi = lane >> 5; const int wid = __builtin_amdgcn_readfirstlane(tid >> 6);
    const int q0 = qb * QB;
    const bf16* Qw = Qh + (long)(q0 + wid * QBLK) * PZ;
    const unsigned lds0 = (unsigned)(uintptr_t)shm;
    float* wsf = (float*)(shm + A2_WS) + wid * 64;
    bf16x8 qr[4];
#pragma unroll
    for (int d0 = 0; d0 < 4; ++d0) qr[d0] = *reinterpret_cast<const bf16x8*>(&Qw[(long)r32 * PZ + d0 * 16 + hi * 8]);
    const bf16* ksrc = Kh + (long)lane * PZ + wid * 8;
    const bf16* vsrc = Vh + (long)(16 * (wid & 3) + (lane >> 2)) * PV + (wid >> 2) * 32 + (lane & 3) * 8;
    const unsigned kdst = lds0 + A2_K + wid * 1024, vdst = lds0 + A2_V + wid * 1024;
#define A3_DMA(t, sl) do { glds16(ksrc + (long)(t) * KVBLK * PZ, (unsigned)__builtin_amdgcn_readfirstlane(kdst + (sl) * A2_SLOT)); \
        glds16(vsrc + (long)(t) * KVBLK * PV, (unsigned)__builtin_amdgcn_readfirstlane(vdst + (sl) * A2_SLOT)); \
        glds16(vsrc + (long)(t) * KVBLK * PV + 64, (unsigned)__builtin_amdgcn_readfirstlane(vdst + (sl) * A2_SLOT + 8192)); } while (0)
#define A3_SB() __builtin_amdgcn_sched_barrier(0)
#define A3_MFMA(A_, B_, C_) __builtin_amdgcn_mfma_f32_32x32x16_bf16((A_), (B_), (C_), 0, 0, 0)
#define A3_KLD(D0) (*(const __attribute__((address_space(3))) bf16x8*)(kpn + (D0) * 2048))
#define A3_KLD2(D0) (*(const __attribute__((address_space(3))) bf16x8*)(kpn + (D0) * 2048 + 512))
#define A3_VLD(BUF, KS) do { _Pragma("unroll") for (int d_ = 0; d_ < 4; ++d_) { vlo[BUF][d_] = vtr(vp + d_ * 4096 + (KS) * 1024); vhh[BUF][d_] = vtr(vp + d_ * 4096 + (KS) * 1024 + 512); } } while (0)
#define A3_VF(BUF, D0) ((bf16x8){vlo[BUF][D0][0], vlo[BUF][D0][1], vlo[BUF][D0][2], vlo[BUF][D0][3], vhh[BUF][D0][0], vhh[BUF][D0][1], vhh[BUF][D0][2], vhh[BUF][D0][3]})
#define A3_EXP2(P, I) do { P[2 * (I)] = __builtin_amdgcn_exp2f(P[2 * (I)]); P[2 * (I) + 1] = __builtin_amdgcn_exp2f(P[2 * (I) + 1]); sacc += P[2 * (I)] + P[2 * (I) + 1]; } while (0)
#define A3_ROWMAX(P0, P1, RM) do { float a_ = fmaxf(fmaxf(P0[0], P0[1]), P1[0]), b_ = fmaxf(fmaxf(P0[2], P0[3]), P1[1]); a_ = fmaxf(fmaxf(a_, P1[2]), P1[3]); \
        _Pragma("unroll") for (int r_ = 4; r_ < 16; r_ += 4) { a_ = fmaxf(fmaxf(a_, P0[r_]), P0[r_ + 1]); b_ = fmaxf(fmaxf(b_, P0[r_ + 2]), P0[r_ + 3]); a_ = fmaxf(fmaxf(a_, P1[r_]), P1[r_ + 1]); b_ = fmaxf(fmaxf(b_, P1[r_ + 2]), P1[r_ + 3]); } \
        RM = fmaxf(a_, b_); auto rr_ = __builtin_amdgcn_permlane32_swap(__float_as_uint(RM), __float_as_uint(RM), false, false); RM = fmaxf(__uint_as_float(rr_[0]), __uint_as_float(rr_[1])); } while (0)
    const int NT = (q0 + QB) / KVBLK;
    A3_DMA(0, 0); A3_DMA(1, 1); A3_DMA(2, 2);
    asm volatile("" : "+v"(qr[0]), "+v"(qr[1]), "+v"(qr[2]), "+v"(qr[3]));
    const lds_cptr shm3 = (lds_cptr)shm;
    const lds_cptr kp0 = shm3 + A2_K + hi * 1024 + r32 * 16;
    const lds_cptr vp0 = shm3 + A2_V + ((lane >> 4) & 1) * 32 + (lane & 3) * 8 + (4 * hi + ((lane & 15) >> 2)) * 64;
    float mhat = 0.f, l_reg = 0.f; f32x16 o[4]; o[0] = f32x16{}; o[1] = f32x16{}; o[2] = f32x16{}; o[3] = f32x16{}; f32x16 negm = f32x16{};
    const int qrel = wid * QBLK + r32;
    f32x16 p0, p1; float rm;
    asm volatile("s_waitcnt vmcnt(6)\n\ts_barrier" ::: "memory");
    {   const lds_cptr kpn = kp0;
        p0 = A3_MFMA(A3_KLD(0), qr[0], negm); p1 = A3_MFMA(A3_KLD2(0), qr[0], negm);
#pragma unroll
        for (int d0 = 1; d0 < 4; ++d0) { p0 = A3_MFMA(A3_KLD(d0), qr[d0], p0); p1 = A3_MFMA(A3_KLD2(d0), qr[d0], p1); }
        if (NT == 4) cmask(p0, p1, 0, qrel, hi);
        A3_ROWMAX(p0, p1, rm);
        mhat = rm;
#pragma unroll
        for (int r = 0; r < 16; ++r) { p0[r] -= rm; p1[r] -= rm; negm[r] = -mhat; }
        rm = 0.f;
    }
#if MK_PROBE
    const unsigned long long pt0 = __builtin_amdgcn_s_memrealtime();
#endif
    for (int t = 0; t < NT; ++t) {
        if (t + 2 < NT) asm volatile("s_waitcnt vmcnt(3)\n\ts_barrier" ::: "memory"); else asm volatile("s_waitcnt vmcnt(0)\n\ts_barrier" ::: "memory");
        if (t + 3 < NT) A3_DMA(t + 3, (t + 3) & 3);
        const lds_cptr kpn = kp0 + ((t + 1) & 3) * A2_SLOT; const lds_cptr vp = vp0 + (t & 3) * A2_SLOT;
        if (__any(rm > (float)THRL)) {
            const float dl = fmaxf(rm, 0.f); mhat += dl;
#pragma unroll
            for (int r = 0; r < 16; ++r) { p0[r] -= dl; p1[r] -= dl; negm[r] = -mhat; }
            const float f = __builtin_amdgcn_exp2f(-dl); l_reg *= f;
            if (hi == 0) wsf[r32] = f;
            asm volatile("s_waitcnt lgkmcnt(0)" ::: "memory");
#pragma unroll
            for (int r = 0; r < 16; ++r) { const float fr_ = wsf[crow(r, hi)];
#pragma unroll
                for (int d_ = 0; d_ < 4; ++d_) o[d_][r] *= fr_; }
            asm volatile("s_waitcnt lgkmcnt(0)" ::: "memory");
        }
        float sacc = 0.f; f32x16 n0, n1; u32x4 pw0, pw1, pw2, pw3; s16x4 vlo[2][4], vhh[2][4];
        {   bf16x8 ka0 = A3_KLD(0), ka1 = A3_KLD2(0), ka2 = A3_KLD(1), ka3 = A3_KLD2(1);
            A3_VLD(0, 0);
            A3_SB();
            n0 = A3_MFMA(ka0, qr[0], negm); A3_EXP2(p0, 0); A3_SB();
            n1 = A3_MFMA(ka1, qr[0], negm); A3_EXP2(p0, 1); A3_SB();
            bf16x8 kb0 = A3_KLD(2), kb1 = A3_KLD2(2), kb2 = A3_KLD(3), kb3 = A3_KLD2(3);
            n0 = A3_MFMA(ka2, qr[1], n0); A3_EXP2(p0, 2); A3_SB();
            n1 = A3_MFMA(ka3, qr[1], n1); A3_EXP2(p0, 3); pw0 = (u32x4){pkbf(p0[0], p0[1]), pkbf(p0[2], p0[3]), pkbf(p0[4], p0[5]), pkbf(p0[6], p0[7])}; A3_SB();
            n0 = A3_MFMA(kb0, qr[2], n0); A3_EXP2(p0, 4); A3_SB();
            n1 = A3_MFMA(kb1, qr[2], n1); A3_EXP2(p0, 5); A3_SB();
            n0 = A3_MFMA(kb2, qr[3], n0); A3_EXP2(p0, 6); A3_SB();
            n1 = A3_MFMA(kb3, qr[3], n1); A3_EXP2(p0, 7); pw1 = (u32x4){pkbf(p0[8], p0[9]), pkbf(p0[10], p0[11]), pkbf(p0[12], p0[13]), pkbf(p0[14], p0[15])}; A3_SB();
        }
        A3_VLD(1, 1); A3_SB();
        o[0] = A3_MFMA(__builtin_bit_cast(bf16x8, pw0), A3_VF(0, 0), o[0]); A3_EXP2(p1, 0); A3_SB();
        o[1] = A3_MFMA(__builtin_bit_cast(bf16x8, pw0), A3_VF(0, 1), o[1]); A3_EXP2(p1, 1); A3_SB();
        o[2] = A3_MFMA(__builtin_bit_cast(bf16x8, pw0), A3_VF(0, 2), o[2]); A3_EXP2(p1, 2); A3_SB();
        o[3] = A3_MFMA(__builtin_bit_cast(bf16x8, pw0), A3_VF(0, 3), o[3]); A3_EXP2(p1, 3); pw2 = (u32x4){pkbf(p1[0], p1[1]), pkbf(p1[2], p1[3]), pkbf(p1[4], p1[5]), pkbf(p1[6], p1[7])}; A3_SB();
        A3_VLD(0, 2); A3_SB();
        o[0] = A3_MFMA(__builtin_bit_cast(bf16x8, pw1), A3_VF(1, 0), o[0]); A3_EXP2(p1, 4); A3_SB();
        o[1] = A3_MFMA(__builtin_bit_cast(bf16x8, pw1), A3_VF(1, 1), o[1]); A3_EXP2(p1, 5); A3_SB();
        o[2] = A3_MFMA(__builtin_bit_cast(bf16x8, pw1), A3_VF(1, 2), o[2]); A3_EXP2(p1, 6); A3_SB();
        o[3] = A3_MFMA(__builtin_bit_cast(bf16x8, pw1), A3_VF(1, 3), o[3]); A3_EXP2(p1, 7); pw3 = (u32x4){pkbf(p1[8], p1[9]), pkbf(p1[10], p1[11]), pkbf(p1[12], p1[13]), pkbf(p1[14], p1[15])}; A3_SB();
        l_reg += sacc;
        A3_VLD(1, 3); A3_SB();
        { const int jb = (t + 1) - (NT - 4); if (jb >= 0 && t + 1 < NT) cmask(n0, n1, jb, qrel, hi); }
        o[0] = A3_MFMA(__builtin_bit_cast(bf16x8, pw2), A3_VF(0, 0), o[0]);
        o[1] = A3_MFMA(__builtin_bit_cast(bf16x8, pw2), A3_VF(0, 1), o[1]);
        o[2] = A3_MFMA(__builtin_bit_cast(bf16x8, pw2), A3_VF(0, 2), o[2]);
        o[3] = A3_MFMA(__builtin_bit_cast(bf16x8, pw2), A3_VF(0, 3), o[3]); A3_SB();
        o[0] = A3_MFMA(__builtin_bit_cast(bf16x8, pw3), A3_VF(1, 0), o[0]);
        o[1] = A3_MFMA(__builtin_bit_cast(bf16x8, pw3), A3_VF(1, 1), o[1]);
        o[2] = A3_MFMA(__builtin_bit_cast(bf16x8, pw3), A3_VF(1, 2), o[2]);
        o[3] = A3_MFMA(__builtin_bit_cast(bf16x8, pw3), A3_VF(1, 3), o[3]);
        A3_ROWMAX(n0, n1, rm);
        p0 = n0; p1 = n1;
        A3_SB();
    }
#if MK_PROBE
    if (prb && tid == 0) { atomicAdd(prb, (unsigned)(__builtin_amdgcn_s_memrealtime() - pt0)); atomicAdd(prb + 1, (unsigned)NT); }
#endif
    asm volatile("s_waitcnt lgkmcnt(0)\n\ts_barrier" ::: "memory");
    { auto rr = __builtin_amdgcn_permlane32_swap(__float_as_uint(l_reg), __float_as_uint(l_reg), false, false); l_reg = __uint_as_float(rr[0]) + __uint_as_float(rr[1]); }
    if (hi == 0) wsf[32 + r32] = l_reg;
    asm volatile("s_waitcnt lgkmcnt(0)" ::: "memory");
    bf16* stg = (bf16*)(shm + A2_OST) + wid * 4096;
#pragma unroll
    for (int r = 0; r < 16; ++r) { const int orow = crow(r, hi); const float rl = __builtin_amdgcn_rcpf(wsf[32 + orow]);
#pragma unroll
        for (int d0 = 0; d0 < 4; ++d0) stg[orow * 128 + d0 * 32 + r32] = __float2bfloat16(o[d0][r] * rl); }
    asm volatile("s_waitcnt lgkmcnt(0)" ::: "memory");
    bf16* Ow = Oh + (long)(q0 + wid * QBLK) * PO;
#pragma unroll
    for (int i = 0; i < 8; ++i) { const int row = i * 4 + (lane >> 4), ch = lane & 15; const u32x4 v = *(const u32x4*)(stg + row * 128 + ch * 8); *(u32x4*)(Ow + (long)row * PO + ch * 8) = v; }
    asm volatile("s_waitcnt lgkmcnt(0)\n\ts_barrier" ::: "memory");
#undef A3_DMA
#undef A3_SB
#undef A3_MFMA
#undef A3_KLD
#undef A3_KLD2
#undef A3_VLD
#undef A3_VF
#undef A3_EXP2
#undef A3_ROWMAX
}
template <int THRL> __device__ __forceinline__ void attn4_unit(int qb, const bf16* Qh0, const bf16* __restrict__ Kh0, long mapstride, const bf16* __restrict__ Vh, bf16_t* YCb_, int yrow0, int ycol0, float lam, const float* gvec, u32x4* park, char* shm) {
#pragma unroll 1
  for (int mp = 0; mp < 2; ++mp) {
    const bf16* Qh = Qh0 + mp * mapstride; const bf16* Kh = Kh0 + mp * mapstride;
    const int tid = threadIdx.x; int lane = tid & 63; asm volatile("" : "+v"(lane));
    const int r32 = lane & 31, hi = lane >> 5; const int wid = __builtin_amdgcn_readfirstlane(tid >> 6);
    const int q0 = qb * QB + NMETA;
    const bf16* Qw = Qh + (long)(q0 + wid * QBLK) * PZ;
    const unsigned lds0 = (unsigned)(uintptr_t)shm;
    float* wsf = (float*)(shm + A2_WS) + wid * 64;
    bf16x8 qr[4];
#pragma unroll
    for (int d0 = 0; d0 < 4; ++d0) qr[d0] = *reinterpret_cast<const bf16x8*>(&Qw[(long)r32 * PZ + d0 * 16 + hi * 8]);
    const bf16* ksrc = Kh + (long)lane * PZ + wid * 8;
    const bf16* vsrc = Vh + (long)(16 * (wid & 3) + (lane >> 2)) * PV + (wid >> 2) * 32 + (lane & 3) * 8;
    const unsigned kdst = lds0 + A2_K + wid * 1024, vdst = lds0 + A2_V + wid * 1024;
#define A3_DMA(t, sl) do { glds16(ksrc + (long)(t) * KVBLK * PZ, (unsigned)__builtin_amdgcn_readfirstlane(kdst + (sl) * A2_SLOT)); \
        glds16(vsrc + (long)(t) * KVBLK * PV, (unsigned)__builtin_amdgcn_readfirstlane(vdst + (sl) * A2_SLOT)); \
        glds16(vsrc + (long)(t) * KVBLK * PV + 64, (unsigned)__builtin_amdgcn_readfirstlane(vdst + (sl) * A2_SLOT + 8192)); } while (0)
#define A3_SB() __builtin_amdgcn_sched_barrier(0)
#define A3_MFMA(A_, B_, C_) __builtin_amdgcn_mfma_f32_32x32x16_bf16((A_), (B_), (C_), 0, 0, 0)
#define A3_KLD(D0) (*(const __attribute__((address_space(3))) bf16x8*)(kpn + (D0) * 2048))
#define A3_KLD2(D0) (*(const __attribute__((address_space(3))) bf16x8*)(kpn + (D0) * 2048 + 512))
#define A3_VLD(BUF, KS) do { _Pragma("unroll") for (int d_ = 0; d_ < 4; ++d_) { vlo[BUF][d_] = vtr(vp + d_ * 4096 + (KS) * 1024); vhh[BUF][d_] = vtr(vp + d_ * 4096 + (KS) * 1024 + 512); } } while (0)
#define A3_VF(BUF, D0) ((bf16x8){vlo[BUF][D0][0], vlo[BUF][D0][1], vlo[BUF][D0][2], vlo[BUF][D0][3], vhh[BUF][D0][0], vhh[BUF][D0][1], vhh[BUF][D0][2], vhh[BUF][D0][3]})
#define A3_EXP2(P, I) do { P[2 * (I)] = __builtin_amdgcn_exp2f(P[2 * (I)]); P[2 * (I) + 1] = __builtin_amdgcn_exp2f(P[2 * (I) + 1]); sacc += P[2 * (I)] + P[2 * (I) + 1]; } while (0)
#define A3_ROWMAX(P0, P1, RM) do { float a_ = fmaxf(fmaxf(P0[0], P0[1]), P1[0]), b_ = fmaxf(fmaxf(P0[2], P0[3]), P1[1]); a_ = fmaxf(fmaxf(a_, P1[2]), P1[3]); \
        _Pragma("unroll") for (int r_ = 4; r_ < 16; r_ += 4) { a_ = fmaxf(fmaxf(a_, P0[r_]), P0[r_ + 1]); b_ = fmaxf(fmaxf(b_, P0[r_ + 2]), P0[r_ + 3]); a_ = fmaxf(fmaxf(a_, P1[r_]), P1[r_ + 1]); b_ = fmaxf(fmaxf(b_, P1[r_ + 2]), P1[r_ + 3]); } \
        RM = fmaxf(a_, b_); auto rr_ = __builtin_amdgcn_permlane32_swap(__float_as_uint(RM), __float_as_uint(RM), false, false); RM = fmaxf(__uint_as_float(rr_[0]), __uint_as_float(rr_[1])); } while (0)
    const int NT = 4 * qb + 5;
    const int qrel16 = wid * QBLK + r32 + NMETA;
    A3_DMA(0, 0); A3_DMA(1, 1); A3_DMA(2, 2);
    asm volatile("" : "+v"(qr[0]), "+v"(qr[1]), "+v"(qr[2]), "+v"(qr[3]));
    const lds_cptr shm3 = (lds_cptr)shm;
    const lds_cptr kp0 = shm3 + A2_K + hi * 1024 + r32 * 16;
    const lds_cptr vp0 = shm3 + A2_V + ((lane >> 4) & 1) * 32 + (lane & 3) * 8 + (4 * hi + ((lane & 15) >> 2)) * 64;
    float mhat = 0.f, l_reg = 0.f; f32x16 o[4]; o[0] = f32x16{}; o[1] = f32x16{}; o[2] = f32x16{}; o[3] = f32x16{}; f32x16 negm = f32x16{};
    const int qrel = wid * QBLK + r32;
    f32x16 p0, p1; float rm;
    asm volatile("s_waitcnt vmcnt(6)\n\ts_barrier" ::: "memory");
    {   const lds_cptr kpn = kp0;
        p0 = A3_MFMA(A3_KLD(0), qr[0], negm); p1 = A3_MFMA(A3_KLD2(0), qr[0], negm);
#pragma unroll
        for (int d0 = 1; d0 < 4; ++d0) { p0 = A3_MFMA(A3_KLD(d0), qr[d0], p0); p1 = A3_MFMA(A3_KLD2(d0), qr[d0], p1); }
        if (qb == 0) cmask(p0, p1, 0, qrel16, hi);
        A3_ROWMAX(p0, p1, rm);
        mhat = rm;
#pragma unroll
        for (int r = 0; r < 16; ++r) { p0[r] -= rm; p1[r] -= rm; negm[r] = -mhat; }
        rm = 0.f;
    }
    for (int t = 0; t < NT; ++t) {
        if (t + 2 < NT) asm volatile("s_waitcnt vmcnt(3)\n\ts_barrier" ::: "memory"); else asm volatile("s_waitcnt vmcnt(0)\n\ts_barrier" ::: "memory");
        if (t + 3 < NT) A3_DMA(t + 3, (t + 3) & 3);
        const lds_cptr kpn = kp0 + ((t + 1) & 3) * A2_SLOT; const lds_cptr vp = vp0 + (t & 3) * A2_SLOT;
        if (__any(rm > (float)THRL)) {
            const float dl = fmaxf(rm, 0.f); mhat += dl;
#pragma unroll
            for (int r = 0; r < 16; ++r) { p0[r] -= dl; p1[r] -= dl; negm[r] = -mhat; }
            const float f = __builtin_amdgcn_exp2f(-dl); l_reg *= f;
            if (hi == 0) wsf[r32] = f;
            asm volatile("s_waitcnt lgkmcnt(0)" ::: "memory");
#pragma unroll
            for (int r = 0; r < 16; ++r) { const float fr_ = wsf[crow(r, hi)];
#pragma unroll
                for (int d_ = 0; d_ < 4; ++d_) o[d_][r] *= fr_; }
            asm volatile("s_waitcnt lgkmcnt(0)" ::: "memory");
        }
        float sacc = 0.f; f32x16 n0, n1; u32x4 pw0, pw1, pw2, pw3; s16x4 vlo[2][4], vhh[2][4];
        {   bf16x8 ka0 = A3_KLD(0), ka1 = A3_KLD2(0), ka2 = A3_KLD(1), ka3 = A3_KLD2(1);
            A3_VLD(0, 0);
            A3_SB();
            n0 = A3_MFMA(ka0, qr[0], negm); A3_EXP2(p0, 0); A3_SB();
            n1 = A3_MFMA(ka1, qr[0], negm); A3_EXP2(p0, 1); A3_SB();
            bf16x8 kb0 = A3_KLD(2), kb1 = A3_KLD2(2), kb2 = A3_KLD(3), kb3 = A3_KLD2(3);
            n0 = A3_MFMA(ka2, qr[1], n0); A3_EXP2(p0, 2); A3_SB();
            n1 = A3_MFMA(ka3, qr[1], n1); A3_EXP2(p0, 3); pw0 = (u32x4){pkbf(p0[0], p0[1]), pkbf(p0[2], p0[3]), pkbf(p0[4], p0[5]), pkbf(p0[6], p0[7])}; A3_SB();
            n0 = A3_MFMA(kb0, qr[2], n0); A3_EXP2(p0, 4); A3_SB();
            n1 = A3_MFMA(kb1, qr[2], n1); A3_EXP2(p0, 5); A3_SB();
            n0 = A3_MFMA(kb2, qr[3], n0); A3_EXP2(p0, 6); A3_SB();
            n1 = A3_MFMA(kb3, qr[3], n1); A3_EXP2(p0, 7); pw1 = (u32x4){pkbf(p0[8], p0[9]), pkbf(p0[10], p0[11]), pkbf(p0[12], p0[13]), pkbf(p0[14], p0[15])}; A3_SB();
        }
        A3_VLD(1, 1); A3_SB();
        o[0] = A3_MFMA(__builtin_bit_cast(bf16x8, pw0), A3_VF(0, 0), o[0]); A3_EXP2(p1, 0); A3_SB();
        o[1] = A3_MFMA(__builtin_bit_cast(bf16x8, pw0), A3_VF(0, 1), o[1]); A3_EXP2(p1, 1); A3_SB();
        o[2] = A3_MFMA(__builtin_bit_cast(bf16x8, pw0), A3_VF(0, 2), o[2]); A3_EXP2(p1, 2); A3_SB();
        o[3] = A3_MFMA(__builtin_bit_cast(bf16x8, pw0), A3_VF(0, 3), o[3]); A3_EXP2(p1, 3); pw2 = (u32x4){pkbf(p1[0], p1[1]), pkbf(p1[2], p1[3]), pkbf(p1[4], p1[5]), pkbf(p1[6], p1[7])}; A3_SB();
        A3_VLD(0, 2); A3_SB();
        o[0] = A3_MFMA(__builtin_bit_cast(bf16x8, pw1), A3_VF(1, 0), o[0]); A3_EXP2(p1, 4); A3_SB();
        o[1] = A3_MFMA(__builtin_bit_cast(bf16x8, pw1), A3_VF(1, 1), o[1]); A3_EXP2(p1, 5); A3_SB();
        o[2] = A3_MFMA(__builtin_bit_cast(bf16x8, pw1), A3_VF(1, 2), o[2]); A3_EXP2(p1, 6); A3_SB();
        o[3] = A3_MFMA(__builtin_bit_cast(bf16x8, pw1), A3_VF(1, 3), o[3]); A3_EXP2(p1, 7); pw3 = (u32x4){pkbf(p1[8], p1[9]), pkbf(p1[10], p1[11]), pkbf(p1[12], p1[13]), pkbf(p1[14], p1[15])}; A3_SB();
        l_reg += sacc;
        A3_VLD(1, 3); A3_SB();
        { const int jb = (t + 1) - 4 * qb; if (jb >= 0 && t + 1 < NT) cmask(n0, n1, jb, qrel16, hi); }
        o[0] = A3_MFMA(__builtin_bit_cast(bf16x8, pw2), A3_VF(0, 0), o[0]);
        o[1] = A3_MFMA(__builtin_bit_cast(bf16x8, pw2), A3_VF(0, 1), o[1]);
        o[2] = A3_MFMA(__builtin_bit_cast(bf16x8, pw2), A3_VF(0, 2), o[2]);
        o[3] = A3_MFMA(__builtin_bit_cast(bf16x8, pw2), A3_VF(0, 3), o[3]); A3_SB();
        o[0] = A3_MFMA(__builtin_bit_cast(bf16x8, pw3), A3_VF(1, 0), o[0]);
        o[1] = A3_MFMA(__builtin_bit_cast(bf16x8, pw3), A3_VF(1, 1), o[1]);
        o[2] = A3_MFMA(__builtin_bit_cast(bf16x8, pw3), A3_VF(1, 2), o[2]);
        o[3] = A3_MFMA(__builtin_bit_cast(bf16x8, pw3), A3_VF(1, 3), o[3]);
        A3_ROWMAX(n0, n1, rm);
        p0 = n0; p1 = n1;
        A3_SB();
    }
    asm volatile("s_waitcnt lgkmcnt(0)\n\ts_barrier" ::: "memory");
    { auto rr = __builtin_amdgcn_permlane32_swap(__float_as_uint(l_reg), __float_as_uint(l_reg), false, false); l_reg = __uint_as_float(rr[0]) + __uint_as_float(rr[1]); }
    if (hi == 0) wsf[32 + r32] = l_reg;
    asm volatile("s_waitcnt lgkmcnt(0)" ::: "memory");
    float rl[16];
#pragma unroll
    for (int r = 0; r < 16; ++r) rl[r] = __builtin_amdgcn_rcpf(wsf[32 + crow(r, hi)]);
    if (mp == 0) {
#pragma unroll
        for (int d0 = 0; d0 < 4; ++d0)
#pragma unroll
            for (int q4 = 0; q4 < 2; ++q4) { u32x4 w;
                w.x = pkbf(o[d0][8 * q4 + 0] * rl[8 * q4 + 0], o[d0][8 * q4 + 1] * rl[8 * q4 + 1]); w.y = pkbf(o[d0][8 * q4 + 2] * rl[8 * q4 + 2], o[d0][8 * q4 + 3] * rl[8 * q4 + 3]);
                w.z = pkbf(o[d0][8 * q4 + 4] * rl[8 * q4 + 4], o[d0][8 * q4 + 5] * rl[8 * q4 + 5]); w.w = pkbf(o[d0][8 * q4 + 6] * rl[8 * q4 + 6], o[d0][8 * q4 + 7] * rl[8 * q4 + 7]);
                park[d0 * 2 + q4] = w; }
    } else {
        float ss[16];
#pragma unroll
        for (int r = 0; r < 16; ++r) ss[r] = 0.f;
#pragma unroll
        for (int d0 = 0; d0 < 4; ++d0)
#pragma unroll
            for (int q4 = 0; q4 < 2; ++q4) { const u32x4 w = park[d0 * 2 + q4];
                const float a_[8] = {bflo(w.x), bfhi(w.x), bflo(w.y), bfhi(w.y), bflo(w.z), bfhi(w.z), bflo(w.w), bfhi(w.w)};
#pragma unroll
                for (int e = 0; e < 8; ++e) { const int r = 8 * q4 + e; const float y = a_[e] - lam * (o[d0][r] * rl[r]); o[d0][r] = y; ss[r] += y * y; } }
        const f32x4 g4 = (f32x4){gvec[r32], gvec[32 + r32], gvec[64 + r32], gvec[96 + r32]} * (1.0f - LAMBDA_INIT);
#pragma unroll
        for (int r = 0; r < 16; ++r) {
            float v = row_sum16(ss[r]);
            auto rr = __builtin_amdgcn_permlane16_swap(__float_as_uint(v), __float_as_uint(v), false, false); v = __uint_as_float(rr[0]) + __uint_as_float(rr[1]);
            ss[r] = 1.0f / sqrtf(v * (1.f / 128.f) + LN_EPS);
        }
        bf16* stg = (bf16*)(shm + A2_OST) + wid * 4096;
#pragma unroll
        for (int r = 0; r < 16; ++r) { const int orow = crow(r, hi);
#pragma unroll
            for (int d0 = 0; d0 < 4; ++d0) stg[orow * 128 + d0 * 32 + r32] = __float2bfloat16(o[d0][r] * ss[r] * g4[d0]); }
        asm volatile("s_waitcnt lgkmcnt(0)" ::: "memory");
#pragma unroll
        for (int i = 0; i < 8; ++i) { const int row = i * 4 + (lane >> 4), ch = lane & 15; const int tq = q0 + wid * QBLK + row;
            if (tq >= NMETA && tq < TT) { const u32x4 v = *(const u32x4*)(stg + row * 128 + ch * 8); *(u32x4*)(YCb_ + (size_t)(yrow0 + tq - NMETA) * DM + ycol0 + ch * 8) = v; } }
    }
    asm volatile("s_waitcnt lgkmcnt(0)\n\ts_barrier" ::: "memory");
#undef A3_DMA
#undef A3_SB
#undef A3_MFMA
#undef A3_KLD
#undef A3_KLD2
#undef A3_VLD
#undef A3_VF
#undef A3_EXP2
#undef A3_ROWMAX
  }
}
#undef SBAR
#undef WAIT_BAR
}

#define XB_TMO      128
#define XB_XCNT(j)  (256  + 64 * (j))
#define XB_XSUB(j)  (1280 + 64 * (j))
#define XB_XGEN(j)  (2304 + 64 * (j))
#define XB_TOP      3328
#define XB_TOPGEN   3392
#define XCD_BAR_WORDS 3456
#define XB_SPIN_CAP (1u << 18)
__device__ __forceinline__ unsigned xb_ld(unsigned* p)              { return __hip_atomic_load(p, __ATOMIC_RELAXED, __HIP_MEMORY_SCOPE_AGENT); }
__device__ __forceinline__ unsigned xb_add(unsigned* p, unsigned v) { return __hip_atomic_fetch_add(p, v, __ATOMIC_RELAXED, __HIP_MEMORY_SCOPE_AGENT); }
__device__ __forceinline__ unsigned xb_xcc_id() { return (unsigned)__builtin_amdgcn_s_getreg((3 << 11) | 20) & 0xFu; }
#define XB_SPIN(cond, bar) do { unsigned _sp = 0; while (cond) { __builtin_amdgcn_s_sleep(1); \
    if ((++_sp & 255u) == 0u) { if (xb_ld(&(bar)[XB_TMO])) break; if (_sp > XB_SPIN_CAP) { atomicAdd(&(bar)[XB_TMO], 1u); break; } } } } while (0)
struct XcdBarrier { unsigned* bar; unsigned x; volatile LAS unsigned* st; };
__device__ __forceinline__ XcdBarrier xcd_barrier_post(unsigned* bar, volatile LAS unsigned* st) {
    XcdBarrier b; b.bar = bar; b.x = xb_xcc_id(); b.st = st;
    if (threadIdx.x == 0) (void)xb_add(&bar[XB_XCNT(b.x)], 1u);
    return b;
}
__device__ __forceinline__ void xcd_barrier_complete(unsigned* bar, unsigned x, unsigned& nloc, unsigned& nx) {
    const unsigned G = gridDim.x * gridDim.y * gridDim.z;
    unsigned sum, cnt, mine, sp = 0u;
    for (;;) {
        sum = 0u; cnt = 0u; mine = 0u;
#pragma unroll
        for (unsigned j = 0; j < 16; ++j) { const unsigned c = xb_ld(&bar[XB_XCNT(j)]); sum += c; cnt += (c > 0u) ? 1u : 0u; mine = (j == x) ? c : mine; }
        if (sum == G) break;
        __builtin_amdgcn_s_sleep(1);
        if ((++sp & 255u) == 0u) { if (xb_ld(&bar[XB_TMO])) break; if (sp > XB_SPIN_CAP) { atomicAdd(&bar[XB_TMO], 1u); break; } }
    }
    nloc = mine > 0u ? mine : 1u; nx = cnt > 0u ? cnt : 1u;
}
__device__ __forceinline__ void xcd_barrier(const XcdBarrier& b) {
    asm volatile("s_waitcnt vmcnt(0)" ::: "memory");
    __syncthreads();
    if (threadIdx.x == 0) {
        unsigned* bar = b.bar;
        __builtin_amdgcn_s_waitcnt(0);
        unsigned nloc = b.st[0], nx = b.st[1];
        if (nloc == 0u) { xcd_barrier_complete(bar, b.x, nloc, nx); b.st[0] = nloc; b.st[1] = nx; }
        const unsigned old = xb_add(&bar[XB_XSUB(b.x)], 1u);
        const unsigned gen = old / nloc;
        if (old + 1u == (gen + 1u) * nloc) {
            __builtin_amdgcn_fence(__ATOMIC_RELEASE, "agent");
            asm volatile("s_waitcnt vmcnt(0)" ::: "memory");
            const unsigned og = xb_add(&bar[XB_TOP], 1u);
            const unsigned tg = og / nx;
            if (og + 1u == (tg + 1u) * nx) xb_add(&bar[XB_TOPGEN], 1u);
            else XB_SPIN(xb_ld(&bar[XB_TOPGEN]) == tg, bar);
            __builtin_amdgcn_fence(__ATOMIC_ACQUIRE, "agent");
            xb_add(&bar[XB_XGEN(b.x)], 1u);
            asm volatile("s_waitcnt vmcnt(0)" ::: "memory");
        } else {
            XB_SPIN(xb_ld(&bar[XB_XGEN(b.x)]) == gen, bar);
            __builtin_amdgcn_fence(__ATOMIC_ACQUIRE, "agent");
            asm volatile("s_waitcnt vmcnt(0)" ::: "memory");
        }
    }
    __syncthreads();
}

struct Args {
    const float *x, *meta, *ln0_g, *ln0_b, *w_in, *conv_w, *conv_b, *gate_bias, *lq1, *lk1, *lq2, *lk2, *att_g, *ml_g, *w_att_out, *w_ml_out, *w_o,
                *ln1_g, *ln1_b, *w_router, *b_router, *w_gu, *b_gu, *w_down, *b_down, *ln2_g, *ln2_b;
    float* out; unsigned char* ws; int ph_lo, ph_hi;
};

template <class ColMap>
__device__ __forceinline__ void transpose_item(const float* W, int K, int N, bf16_t* WT, LAS float* scr, int kb, int nb, int lane, ColMap cm, int ldw = 0) {
    if (ldw == 0) ldw = K;
    const int k0 = 64 * kb, n0 = 32 * nb;
    const int lc = cm(n0 + (lane & 31));
    float tv[32];
    const float* wp = W + (size_t)(k0 + (lane >> 5)) * N + lc;
#pragma unroll
    for (int i = 0; i < 32; ++i) tv[i] = wp[(size_t)(2 * i) * N];
#pragma unroll
    for (int i = 0; i < 32; ++i) { const int kk = 2 * i + (lane >> 5); scr[kk * 33 + (lane & 31)] = tv[i]; }
    LDS_WAIT(); asm volatile("" ::: "memory");
    const int c = lane & 7;
#pragma unroll
    for (int j = 0; j < 4; ++j) { const int n = (lane >> 3) + 8 * j; const LAS float* s = scr + (8 * c) * 33 + n;
        u32x4 o; o.x = pkbf(s[0 * 33], s[1 * 33]); o.y = pkbf(s[2 * 33], s[3 * 33]); o.z = pkbf(s[4 * 33], s[5 * 33]); o.w = pkbf(s[6 * 33], s[7 * 33]);
        *(u32x4*)(WT + (size_t)(n0 + n) * ldw + k0 + 8 * c) = o; }
    LDS_WAIT(); asm volatile("" ::: "memory");
}
template <class ColMap>
__device__ __forceinline__ void transpose_item2(const float* W, int K, int N, bf16_t* WT, LAS float* scr, int kb, int nb, int lane, ColMap cm) {
    const int k0 = 64 * kb, n0 = 32 * nb;
    const int lc0 = cm(n0 + (lane & 31)), lc1 = cm(n0 + 32 + (lane & 31));
    float ta[32], tb[32];
    const float* wp = W + (size_t)(k0 + (lane >> 5)) * N;
#pragma unroll
    for (int i = 0; i < 32; ++i) { ta[i] = wp[(size_t)(2 * i) * N + lc0]; tb[i] = wp[(size_t)(2 * i) * N + lc1]; }
    LAS float* scr2 = scr + 64 * 33;
#pragma unroll
    for (int i = 0; i < 32; ++i) { const int kk = 2 * i + (lane >> 5); scr[kk * 33 + (lane & 31)] = ta[i]; scr2[kk * 33 + (lane & 31)] = tb[i]; }
    LDS_WAIT(); asm volatile("" ::: "memory");
    const int c = lane & 7;
#pragma unroll
    for (int h2 = 0; h2 < 2; ++h2) { const LAS float* sb = h2 ? scr2 : scr;
#pragma unroll
        for (int j = 0; j < 4; ++j) { const int n = (lane >> 3) + 8 * j; const LAS float* sp = sb + (8 * c) * 33 + n;
            u32x4 o; o.x = pkbf(sp[0 * 33], sp[1 * 33]); o.y = pkbf(sp[2 * 33], sp[3 * 33]); o.z = pkbf(sp[4 * 33], sp[5 * 33]); o.w = pkbf(sp[6 * 33], sp[7 * 33]);
            *(u32x4*)(WT + (size_t)(n0 + 32 * h2 + n) * K + k0 + 8 * c) = o; } }
    LDS_WAIT(); asm volatile("" ::: "memory");
}
template <class InvMap>
__device__ __forceinline__ void transpose_tile64(const float* W, int N, bf16_t* WT, int ldw, LAS unsigned char* scr, int k0, int c0, int lane, InvMap inv) {
    constexpr int TP = 136;
    asm volatile("" : "+v"(lane));
    const float* wp = W + (size_t)(k0 + (lane >> 4)) * N + c0 + (lane & 15) * 4;
#pragma unroll
    for (int hf = 0; hf < 2; ++hf) {
        f32x4 tv[8];
#pragma unroll
        for (int i = 0; i < 8; ++i) tv[i] = *(const f32x4*)(wp + (size_t)(4 * (8 * hf + i)) * N);
#pragma unroll
        for (int i = 0; i < 8; ++i) { u32x2 w; w.x = pkbf(tv[i][0], tv[i][1]); w.y = pkbf(tv[i][2], tv[i][3]);
            *(LAS u32x2*)(scr + ((lane >> 4) + 4 * (8 * hf + i)) * TP + (lane & 15) * 8) = w; }
        asm volatile("" ::: "memory");
    }
    LDS_WAIT(); asm volatile("" ::: "memory");
    const int g = lane >> 4, p = lane & 15;
#pragma unroll
    for (int it = 0; it < 8; ++it) {
        const int cq = it & 3, kq = (it >> 2) * 4 + g;
        const LAS unsigned char* a = scr + (8 * kq + (p >> 2)) * TP + (16 * cq + 4 * (p & 3)) * 2;
        const attn_body::s16x4 lo = attn_body::vtr((attn_body::lds_cptr)a), hi4 = attn_body::vtr((attn_body::lds_cptr)(a + 4 * TP));
        u32x4 o; o.x = (unsigned)(unsigned short)lo[0] | ((unsigned)(unsigned short)lo[1] << 16); o.y = (unsigned)(unsigned short)lo[2] | ((unsigned)(unsigned short)lo[3] << 16);
        o.z = (unsigned)(unsigned short)hi4[0] | ((unsigned)(unsigned short)hi4[1] << 16); o.w = (unsigned)(unsigned short)hi4[2] | ((unsigned)(unsigned short)hi4[3] << 16);
        *(u32x4*)(WT + (size_t)inv(c0 + 16 * cq + p) * ldw + k0 + 8 * kq) = o;
    }
    LDS_WAIT(); asm volatile("" ::: "memory");
}
struct InvIdent { __device__ __forceinline__ int operator()(int c) const { return c; } };
struct InvGu {
    __device__ __forceinline__ int operator()(int c) const { const int sgl = c & 1, idx = c >> 1; return 256 * (idx >> 7) + 128 * sgl + (idx & 127); } };
struct CmIdent { __device__ __forceinline__ int operator()(int p) const { return p; } };
struct CmWin {
    __device__ __forceinline__ int operator()(int P) const {
        if (P < 1024) { const int hb = P >> 6, p = P & 63, wcp = p >> 5, fq = (p & 31) >> 3, n = (p & 7) >> 2, j = p & 3; return hb * 64 + 32 * n + 16 * wcp + 4 * fq + j; }
        if (P < 3584) return P;
        return P + 8;
    }
};
struct CmGu {
    __device__ __forceinline__ int operator()(int P) const { const int pn = P >> 8, s = (P >> 7) & 1, i = P & 127; return 2 * (128 * pn + i) + s; }
};

__global__ void __launch_bounds__(NWAVES * 64, 2) hybrid_fwd(Args a) {
    extern __shared__ __attribute__((aligned(16))) unsigned char lds[];
    LAS unsigned char* L = (LAS unsigned char*)lds;
    const int tid = threadIdx.x, lane = tid & 63, wave = __builtin_amdgcn_readfirstlane(tid >> 6);
    const int G = gridDim.x, blk = blockIdx.x;
    const int gw = blk * NWAVES + wave, NGW = G * NWAVES;
    if (tid < 16) ((LAS unsigned*)(L + MISC_OFF))[tid] = 0u;
    LAS unsigned long long* ptab = (LAS unsigned long long*)(L + MISC_OFF + 64);
    if (tid == 0) {
        ptab[0] = (unsigned long long)a.x; ptab[1] = (unsigned long long)a.meta; ptab[2] = (unsigned long long)a.ln0_g; ptab[3] = (unsigned long long)a.ln0_b; ptab[4] = (unsigned long long)a.w_in;
        ptab[5] = (unsigned long long)a.conv_w; ptab[6] = (unsigned long long)a.conv_b; ptab[7] = (unsigned long long)a.gate_bias; ptab[8] = (unsigned long long)a.lq1; ptab[9] = (unsigned long long)a.lk1;
        ptab[10] = (unsigned long long)a.lq2; ptab[11] = (unsigned long long)a.lk2; ptab[12] = (unsigned long long)a.att_g; ptab[13] = (unsigned long long)a.ml_g; ptab[14] = (unsigned long long)a.w_att_out;
        ptab[15] = (unsigned long long)a.w_ml_out; ptab[16] = (unsigned long long)a.w_o; ptab[17] = (unsigned long long)a.ln1_g; ptab[18] = (unsigned long long)a.ln1_b; ptab[19] = (unsigned long long)a.w_router;
        ptab[20] = (unsigned long long)a.b_router; ptab[21] = (unsigned long long)a.w_gu; ptab[22] = (unsigned long long)a.b_gu; ptab[23] = (unsigned long long)a.w_down; ptab[24] = (unsigned long long)a.b_down;
        ptab[25] = (unsigned long long)a.ln2_g; ptab[26] = (unsigned long long)a.ln2_b; ptab[27] = (unsigned long long)a.out; ptab[28] = (unsigned long long)a.ws;
    }
    asm volatile("s_waitcnt lgkmcnt(0)" ::: "memory");
    __syncthreads();
    asm volatile("" ::: "memory");
#define PF(i) ((const float*)ldptr(ptab, (i)))
#define WSP ((unsigned char*)ldptr(ptab, 28))
#define DOUTP ((unsigned char*)ldptr(ptab, 27))
#define ctl ((unsigned*)(WSP + WS_CTL))
#define WinT ((bf16_t*)(WSP + WS_WIN))
#define WaT ((bf16_t*)(WSP + WS_WA))
#define WmT ((bf16_t*)(WSP + WS_WM))
#define WoT ((bf16_t*)(WSP + WS_WO))
#define ropec ((float*)(WSP + WS_ROPE))
#define ropes (ropec + TT * 32)
#define stats ((float*)(WSP + WS_STATS))
#define gates ((float*)(WSP + WS_GATES))
#define tok_e ((int*)(WSP + WS_TOKE))
#define tok_g ((float*)(WSP + WS_TOKG))
#define hist ((int*)(WSP + WS_HIST))
#define row_off ((int*)(WSP + WS_ROWOFF))
#define row_slot ((int*)(WSP + WS_ROWSLOT))
#define row_gate ((float*)(WSP + WS_ROWGATE))
#define tile_exp ((int*)(WSP + WS_TILEEXP))
#define Hb ((bf16_t*)(WSP + WS_H))
#define Z ((bf16_t*)(WSP + WS_Z))
#define Y ((bf16_t*)(WSP + WS_Y))
#define ACT ((bf16_t*)(WSP + WS_ACT))
#define Qc ((bf16_t*)(WSP + WS_QC))
#define Kc ((bf16_t*)(WSP + WS_KC))
#define Vc ((bf16_t*)(WSP + WS_VC))
#define TMPb ((bf16_t*)(WSP + WS_TMP))
#define MRGb ((bf16_t*)(WSP + WS_MRG))
#define GFb ((bf16_t*)(WSP + WS_GF))
#define YCb ((bf16_t*)(WSP + WS_H))
#define Ob ((bf16_t*)(WSP + WS_O))
#define WguT ((bf16_t*)(DOUTP + DO_WGU))
#define WdnT ((bf16_t*)(DOUTP + DO_WDN))
#if !MK_PER_PHASE
    XcdBarrier bar = xcd_barrier_post(ctl + CW_BAR, (volatile LAS unsigned*)(L + MISC_OFF + 32));
#define GRID_BAR() xcd_barrier(bar)
#else
#define GRID_BAR() do {} while (0)
#endif
    const int lo = a.ph_lo, hi = a.ph_hi;
#if MK_PROBE == 2
    LAS unsigned* pdur = (LAS unsigned*)(L + MISC_OFF + 320);
    if (blk == 0 && tid == 0) { pdur[30] = (unsigned)__builtin_amdgcn_s_memrealtime(); pdur[31] = pdur[30]; pdur[29] = pdur[30]; for (int q_ = 16; q_ < 29; ++q_) pdur[q_] = 0u; }
#define PSTAMP(k) do { if (blk == 0 && tid == 0) { const unsigned now_ = (unsigned)__builtin_amdgcn_s_memrealtime(); pdur[k] = now_ - pdur[30]; pdur[30] = now_; } } while (0)
#define CSTAMP(k) do { if (blk == 0 && tid == 0) { const unsigned now_ = (unsigned)__builtin_amdgcn_s_memrealtime(); pdur[16 + (k)] += now_ - pdur[31]; pdur[31] = now_; } } while (0)
#else
#define PSTAMP(k) do {} while (0)
#define CSTAMP(k) do {} while (0)
#endif
#define IN(k) (lo <= (k) && (k) < hi)
#define BOTH(k) (IN(k) && IN((k) + 1))

    if (IN(0)) REPLOOP(0) {
        {   LAS float* scr = (LAS float*)(L + wave * 16384);
            constexpr int I_IN = 16 * (NZP / 32), I_A = 8 * 32, I_O = 16 * 32;
            constexpr int NIT = I_IN + 2 * I_A + I_O;
            for (int it = gw; it < NIT; it += NGW) {
                int r = it;
                if (r < I_IN) { transpose_item(PF(4), 1024, NIN, WinT, scr, r / (NZP / 32), r % (NZP / 32), lane, CmWin()); continue; } r -= I_IN;
                if (r < I_A) { transpose_item(PF(14), 512, 1024, WaT, scr, r / 32, r % 32, lane, CmIdent(), 1024); continue; } r -= I_A;
                if (r < I_A) { transpose_item(PF(15), 512, 1024, WaT + 512, scr, r / 32, r % 32, lane, CmIdent(), 1024); continue; } r -= I_A;
                transpose_item(PF(16), 1024, 1024, WoT, scr, r / 32, r % 32, lane, CmIdent());
            }
        }
        for (int i = blk * 512 + tid; i < TT * 32; i += G * 512) {
            const int t = i >> 5, f = i & 31;
            const double inv = exp2(-(double)f * (13.287712379549449 / 32.0));
            const double rev = (double)t * inv * 0.15915494309189535;
            const float fr = (float)(rev - floor(rev));
            ropec[i] = __builtin_amdgcn_cosf(fr); ropes[i] = __builtin_amdgcn_sinf(fr);
        }
        __syncthreads();
        LAS float* wg = (LAS float*)L;
        for (int i = tid; i < 8 * 1024; i += 512) { const int gc = i >> 10, k = i & 1023; wg[i] = PF(4)[(size_t)k * NIN + 3584 + gc]; }
        __syncthreads();
        {
            const float* xin = PF(0); const float* metap = PF(1); const float* gbias = PF(7);
            const float* g0p = PF(2); const float* b0p = PF(3);
            bf16_t* Hbp = Hb; float* statsp = stats; float* gatesp = gates;
            const int q_of_lane = (lane >> 1) & 7, r_of_lane = lane >> 4;
            const float gb = gbias[q_of_lane];
            for (int base = gw * 4; base < MROWS; base += NGW * 4) {
                f32x4 v[4][4]; float sm[4];
#pragma unroll
                for (int r = 0; r < 4; ++r) { const int row = (base + r < MROWS) ? base + r : MROWS - 1;
                    const float* xr = (row < NREAL) ? xin + (size_t)row * DM : metap + (size_t)((row - NREAL) & (NMETA - 1)) * DM;
#pragma unroll
                    for (int j = 0; j < 4; ++j) v[r][j] = *(const f32x4*)(xr + 4 * lane + 256 * j); }
#pragma unroll
                for (int r = 0; r < 4; ++r) { float s = 0.f;
#pragma unroll
                    for (int j = 0; j < 4; ++j) s += (v[r][j][0] + v[r][j][1]) + (v[r][j][2] + v[r][j][3]);
                    sm[r] = s; }
                float mean[4], rstd[4];
#pragma unroll
                for (int r = 0; r < 4; ++r) mean[r] = wave_sum(sm[r]) * (1.f / DM);
#pragma unroll
                for (int r = 0; r < 4; ++r) { float s2 = 0.f;
#pragma unroll
                    for (int j = 0; j < 4; ++j) { const f32x4 d = v[r][j] - mean[r]; s2 += (d[0] * d[0] + d[1] * d[1]) + (d[2] * d[2] + d[3] * d[3]); }
                    sm[r] = s2; }
#pragma unroll
                for (int r = 0; r < 4; ++r) rstd[r] = 1.0f / sqrtf(wave_sum(sm[r]) * (1.f / DM) + LN_EPS);
                float gp[32];
#pragma unroll
                for (int q = 0; q < 32; ++q) gp[q] = 0.f;
#pragma unroll
                for (int j = 0; j < 4; ++j) {
                    const f32x4 ggj = *(const f32x4*)(g0p + 4 * lane + 256 * j), bbj = *(const f32x4*)(b0p + 4 * lane + 256 * j);
#pragma unroll
                    for (int r = 0; r < 4; ++r) { v[r][j] = (v[r][j] - mean[r]) * rstd[r] * ggj + bbj;
                        if (base + r < MROWS) { u32x2 w; w.x = pkbf(v[r][j][0], v[r][j][1]); w.y = pkbf(v[r][j][2], v[r][j][3]); *(u32x2*)(Hbp + (size_t)(base + r) * DM + 4 * lane + 256 * j) = w; } }
#pragma unroll
                    for (int q = 0; q < 8; ++q) { const f32x4 wv = *(const LAS f32x4*)(wg + q * 1024 + 4 * lane + 256 * j);
#pragma unroll
                        for (int r = 0; r < 4; ++r) gp[r * 8 + q] += (v[r][j][0] * wv[0] + v[r][j][1] * wv[1]) + (v[r][j][2] * wv[2] + v[r][j][3] * wv[3]); }
                }
                const float gsum = xreduce32(gp, lane);
                const int rowl = base + r_of_lane;
                if (rowl < MROWS) {
                    if ((lane & 1) == 0) { float gv = gsum + gb;
                        if (q_of_lane >= 4) gv = (gv >= 0.f) ? -log1pf(expf(-gv)) : gv - log1pf(expf(gv));
                        gatesp[(size_t)rowl * 8 + q_of_lane] = gv; }
                    if ((lane & 15) == 0) { const float mr = (r_of_lane == 0) ? mean[0] : (r_of_lane == 1) ? mean[1] : (r_of_lane == 2) ? mean[2] : mean[3];
                        const float rr = (r_of_lane == 0) ? rstd[0] : (r_of_lane == 1) ? rstd[1] : (r_of_lane == 2) ? rstd[2] : rstd[3];
                        statsp[2 * rowl] = mr; statsp[2 * rowl + 1] = rr; }
                }
            }
        }
        __syncthreads();
        if (BOTH(0) || rep_ + 1 < REP_0) GRID_BAR();
    }
    PSTAMP(0);

    if (IN(1)) REPLOOP(1) {
        pg8::Gemm g{Hb, WinT, DM, DM, NZP / 256, nullptr, nullptr, 0};
        pg8::StaticOrder S; S.init(MROWS / 256, NZP / 256, G, blk);
        pg8::EpiZ E{Z, Qc, Kc, Vc, ropec, ropes, GFb};
        pg8::gemm_phase<0, pg8::EpiZ>(L, g, S, E);
        if (BOTH(1) || rep_ + 1 < REP_1) GRID_BAR();
    }
    PSTAMP(1);

    if (IN(2)) {
        REPLOOP(2B) {
            constexpr int PQ = 136;
            LAS bf16_t* Qs = (LAS bf16_t*)L;
            LAS bf16_t* Ks = Qs + 128 * PQ;
            LAS bf16_t* VTs = Ks + 128 * PQ;
            LAS bf16_t* Cs = VTs + 144 * PQ;
            LAS float* fv = (LAS float*)(Cs + 144 * PQ);
            LAS float* v_a = fv;
            LAS float* v_M = fv + 128;
            LAS float* v_b = fv + 256;
            LAS float* v_w = fv + 384;
            LAS float* v_sc = fv + 512;
            LAS float* cw = fv + 528;
            const float* convw = PF(5); const float* convb = PF(6); const float* mlg = PF(13); const float* gatesp = gates;
            bf16_t* Zp = Z; bf16_t* YCp = YCb;
            for (int u = blk; u < NB * 4; u += G) {
                const int b = u >> 2, h = u & 3;
                __syncthreads();
                for (int i = tid; i < 5 * 256; i += 512) { const int j = i >> 8, c = i & 255; const int ch = (c < 128) ? (h * 128 + c) : (512 + h * 128 + (c - 128));
                    cw[i] = (j < 4) ? convw[j * 1024 + ch] : convb[ch]; }
                for (int i = tid; i < 144 * PQ; i += 512) { const int rr = i / PQ; VTs[i] = (rr == 128) ? (bf16_t)0x3f80 : (bf16_t)0; Cs[i] = 0; }
                if (tid == 0) v_sc[0] = 0.f;
                f32x4 Cst[9];
#pragma unroll
                for (int jt = 0; jt < 9; ++jt) Cst[jt] = (f32x4){0.f, 0.f, 0.f, 0.f};
                LAS float* gml_s = cw + 1280 + 384;
                int tid_o = tid; asm volatile("" : "+v"(tid_o));
#define ML_IDX() int tq_ = tid_o; asm volatile("" : "+v"(tq_)); const int dg = tq_ & 15, s0 = (tq_ >> 4) * 4, fr = tq_ & 15, quad = (tq_ >> 4) & 3; (void)dg; (void)s0; (void)fr; (void)quad;
                LAS bf16_t* halo = (LAS bf16_t*)(cw + 1280);
                for (int i = tid_o; i < 2 * 3 * 128; i += 512) halo[i] = 0;
                if (tid_o < 128) gml_s[tid_o] = mlg[h * 128 + tid_o];
                u32x4 rq[4], rk[4], rv[4]; float gx0 = 0.f, gx1 = 0.f, gi0 = -1e30f, gi1 = -1e30f;
#define ML_LBAR() asm volatile("s_waitcnt lgkmcnt(0)\n\ts_barrier" ::: "memory")
#define ML_LOADRAW(tc0) do { \
                    _Pragma("unroll") for (int i_ = 0; i_ < 4; ++i_) { const int t_ = (tc0) + s0 + i_; rq[i_] = (u32x4){0u, 0u, 0u, 0u}; rk[i_] = rq[i_]; rv[i_] = rq[i_]; \
                        if (t_ < TT) { const bf16_t* zr_ = Zp + (size_t)row_of(b, t_) * NZ + h * 128 + dg * 8; rq[i_] = *(const u32x4*)(zr_ + ZMQ); rk[i_] = *(const u32x4*)(zr_ + ZMK); rv[i_] = *(const u32x4*)(zr_ + ZMV); } } \
                    if (wave == 0) { const int ta_ = (tc0) + 2 * lane, tb_ = ta_ + 1; \
                        gx0 = (ta_ < TT) ? ld_agent_f(gatesp + (size_t)row_of(b, ta_) * 8 + 4 + h) : 0.f; gi0 = (ta_ < TT) ? ld_agent_f(gatesp + (size_t)row_of(b, ta_) * 8 + h) : -1e30f; \
                        gx1 = (tb_ < TT) ? ld_agent_f(gatesp + (size_t)row_of(b, tb_) * 8 + 4 + h) : 0.f; gi1 = (tb_ < TT) ? ld_agent_f(gatesp + (size_t)row_of(b, tb_) * 8 + h) : -1e30f; } } while (0)
                { ML_IDX(); ML_LOADRAW(0); }
                for (int c = 0; c < 33; ++c) {
                    const int t0 = c * 128;
                    ML_LBAR(); CSTAMP(0);
                    if (wave == 0) {
                        const float m_old0 = v_sc[0];
                        const float x0 = gx0, x1 = gx1, i0 = gi0, i1 = gi1;
                        const float sacc = wave_scan_add(x0 + x1);
                        const float ex = sacc - (x0 + x1);
                        const float b0 = ex + x0, b1 = b0 + x1;
                        const float a0 = i0 - b0, a1 = i1 - b1;
                        const float mx = wave_scan_max(fmaxf(a0, a1));
                        float exm = __shfl_up(mx, 1); if (lane == 0) exm = -INFINITY;
                        const float M0 = fmaxf(fmaxf(m_old0, exm), a0), M1 = fmaxf(M0, a1);
                        const float Ml = __shfl(M1, 63);
                        v_b[2 * lane] = b0; v_b[2 * lane + 1] = b1; v_a[2 * lane] = a0; v_a[2 * lane + 1] = a1; v_M[2 * lane] = M0; v_M[2 * lane + 1] = M1;
                        v_w[2 * lane] = (t0 + 2 * lane < TT) ? __expf(a0 - Ml) : 0.f; v_w[2 * lane + 1] = (t0 + 2 * lane + 1 < TT) ? __expf(a1 - Ml) : 0.f;
                        if (lane == 63) v_sc[1] = M1;
                    }
                    { ML_IDX();
#pragma unroll
                    for (int i = 0; i < 4; ++i) { *(LAS u32x4*)(Qs + (s0 + i) * PQ + dg * 8) = rq[i]; *(LAS u32x4*)(Ks + (s0 + i) * PQ + dg * 8) = rk[i]; }
#pragma unroll
                    for (int w2 = 0; w2 < 4; ++w2) {
                        const unsigned a0_ = rv[0][w2], a1_ = rv[1][w2], a2_ = rv[2][w2], a3_ = rv[3][w2];
                        u32x2 lo2, hi2; lo2.x = (a0_ & 0xffffu) | (a1_ << 16); lo2.y = (a2_ & 0xffffu) | (a3_ << 16);
                        hi2.x = (a0_ >> 16) | (a1_ & 0xffff0000u); hi2.y = (a2_ >> 16) | (a3_ & 0xffff0000u);
                        *(LAS u32x2*)(VTs + (dg * 8 + 2 * w2) * PQ + s0) = lo2; *(LAS u32x2*)(VTs + (dg * 8 + 2 * w2 + 1) * PQ + s0) = hi2;
                    } }
                    ML_LBAR(); CSTAMP(1);
                    {   ML_IDX();
                        u32x4 hq[3], hk[3];
#pragma unroll
                        for (int i = 0; i < 3; ++i) {
                            if (s0 > 0) { hq[i] = *(const LAS u32x4*)(Qs + (s0 - 3 + i) * PQ + dg * 8); hk[i] = *(const LAS u32x4*)(Ks + (s0 - 3 + i) * PQ + dg * 8); }
                            else { hq[i] = *(const LAS u32x4*)(halo + i * 128 + dg * 8); hk[i] = *(const LAS u32x4*)(halo + 384 + i * 128 + dg * 8); }
                        }
                        asm volatile("s_waitcnt lgkmcnt(0)" ::: "memory");
                        ML_LBAR(); CSTAMP(2);
                        u32x4 cq[4], ck[4];
#pragma unroll
                        for (int w2 = 0; w2 < 4; ++w2) {
                            int dgo = dg; asm volatile("" : "+v"(dgo));
                            f32x2 xq[7], xk[7];
#pragma unroll
                            for (int r = 0; r < 7; ++r) { const unsigned uq = (r < 3) ? hq[r < 3 ? r : 0][w2] : rq[r >= 3 ? r - 3 : 0][w2], uk = (r < 3) ? hk[r < 3 ? r : 0][w2] : rk[r >= 3 ? r - 3 : 0][w2];
                                xq[r] = (f32x2){bflo(uq), bfhi(uq)}; xk[r] = (f32x2){bflo(uk), bfhi(uk)}; }
                            const LAS f32x2* wp = (const LAS f32x2*)(cw + dgo * 8 + 2 * w2);
                            f32x2 wq[4], wk[4];
#pragma unroll
                            for (int j = 0; j < 4; ++j) { wq[j] = wp[j * 128]; wk[j] = wp[j * 128 + 64]; }
                            const f32x2 bq = wp[4 * 128], bk = wp[4 * 128 + 64];
#pragma unroll
                            for (int i = 0; i < 4; ++i) {
                                f32x2 aq = bq, ak = bk;
#pragma unroll
                                for (int j = 0; j < 4; ++j) { aq += wq[j] * xq[i + j]; ak += wk[j] * xk[i + j]; }
                                const bool live = (t0 + s0 + i < TT);
                                const float q0 = live ? aq[0] * sigmoidf_(aq[0]) : 0.f, q1 = live ? aq[1] * sigmoidf_(aq[1]) : 0.f;
                                const float k0 = live ? ak[0] * sigmoidf_(ak[0]) * 0.08838834764831845f : 0.f, k1 = live ? ak[1] * sigmoidf_(ak[1]) * 0.08838834764831845f : 0.f;
                                cq[i][w2] = pkbf(q0, q1); ck[i][w2] = pkbf(k0, k1);
                            }
                        }
#pragma unroll
                        for (int i = 0; i < 4; ++i) { *(LAS u32x4*)(Qs + (s0 + i) * PQ + dg * 8) = cq[i]; *(LAS u32x4*)(Ks + (s0 + i) * PQ + dg * 8) = ck[i]; }
                    if (s0 == 124) {
#pragma unroll
                        for (int i = 0; i < 3; ++i) { *(LAS u32x4*)(halo + i * 128 + dg * 8) = rq[i + 1]; *(LAS u32x4*)(halo + 384 + i * 128 + dg * 8) = rk[i + 1]; }
                    }
                    if (c + 1 < 33) ML_LOADRAW(t0 + 128);
                    }
                    ML_LBAR(); CSTAMP(3);
                    const float Mlast = v_sc[1], m_old = v_sc[0];
                    f32x4 St[8];
#pragma unroll
                    for (int j = 0; j < 8; ++j) St[j] = (f32x4){0.f, 0.f, 0.f, 0.f};
                    {   ML_IDX();
                        bf16x8 af[4];
#pragma unroll
                        for (int kk = 0; kk < 4; ++kk) af[kk] = *(const LAS bf16x8*)(Qs + (16 * wave + fr) * PQ + kk * 32 + quad * 8);
#pragma unroll
                        for (int j = 0; j < 8; ++j) if (j <= wave) {
#pragma unroll
                            for (int kk = 0; kk < 4; ++kk) { const bf16x8 bfv = *(const LAS bf16x8*)(Ks + (16 * j + fr) * PQ + kk * 32 + quad * 8);
                                St[j] = __builtin_amdgcn_mfma_f32_16x16x32_bf16(af[kk], bfv, St[j], 0, 0, 0); }
                        }
                    }
                    {   ML_IDX();
                        const float w_old = __expf(m_old - Mlast);
#pragma unroll
                        for (int jt = 0; jt < 9; ++jt) Cst[jt] = Cst[jt] * w_old;
#pragma unroll
                        for (int kk = 0; kk < 4; ++kk) {
                            const int rb = 32 * kk + 8 * quad;
                            const LAS bf16_t* kp = Ks + (rb + (fr >> 2)) * PQ + 16 * wave + 4 * (fr & 3);
                            const attn_body::s16x4 lo = attn_body::vtr((attn_body::lds_cptr)kp), hi4 = attn_body::vtr((attn_body::lds_cptr)(kp + 4 * PQ));
                            const f32x4 w0 = *(const LAS f32x4*)(v_w + rb), w1 = *(const LAS f32x4*)(v_w + rb + 4);
                            float kf[8];
#pragma unroll
                            for (int q = 0; q < 4; ++q) { kf[q] = __uint_as_float(((unsigned)(unsigned short)lo[q]) << 16) * w0[q]; kf[4 + q] = __uint_as_float(((unsigned)(unsigned short)hi4[q]) << 16) * w1[q]; }
                            u32x4 kw; kw.x = pkbf(kf[0], kf[1]); kw.y = pkbf(kf[2], kf[3]); kw.z = pkbf(kf[4], kf[5]); kw.w = pkbf(kf[6], kf[7]);
                            const bf16x8 bk = __builtin_bit_cast(bf16x8, kw);
#pragma unroll
                            for (int jt = 0; jt < 9; ++jt) { const bf16x8 av = *(const LAS bf16x8*)(VTs + (16 * jt + fr) * PQ + kk * 32 + quad * 8);
                                Cst[jt] = __builtin_amdgcn_mfma_f32_16x16x32_bf16(av, bk, Cst[jt], 0, 0, 0); }
                        }
                    }
                    ML_LBAR(); CSTAMP(4);
                    {   ML_IDX();
                        float Ms[4];
#pragma unroll
                        for (int jj = 0; jj < 4; ++jj) Ms[jj] = v_M[16 * wave + 4 * quad + jj];
#pragma unroll
                        for (int j = 0; j < 8; ++j) {
                            const int r = 16 * j + fr; const float ar = v_a[r];
#pragma unroll
                            for (int jj = 0; jj < 4; ++jj) { const int sx = 16 * wave + 4 * quad + jj;
                                const float w = (j <= wave && r <= sx) ? St[j][jj] * __expf(ar - Ms[jj]) : 0.f;
                                Ks[sx * PQ + r] = (bf16_t)(pkbf(w, 0.f) & 0xffffu); }
                        }
                    }
                    ML_LBAR(); CSTAMP(5);
                    float hv[8][4];
                    {   ML_IDX();
                        bf16x8 af[4], as_[4];
#pragma unroll
                        for (int kk = 0; kk < 4; ++kk) { af[kk] = *(const LAS bf16x8*)(Qs + (16 * wave + fr) * PQ + kk * 32 + quad * 8); as_[kk] = *(const LAS bf16x8*)(Ks + (16 * wave + fr) * PQ + kk * 32 + quad * 8); }
                        float winter[4], rd[4], ssq[4];
                        {   f32x4 n1 = (f32x4){0.f, 0.f, 0.f, 0.f}, n2 = n1;
#pragma unroll
                            for (int kk = 0; kk < 4; ++kk) { const bf16x8 bc = *(const LAS bf16x8*)(Cs + (128 + fr) * PQ + kk * 32 + quad * 8); const bf16x8 bvv = *(const LAS bf16x8*)(VTs + (128 + fr) * PQ + kk * 32 + quad * 8);
                                n1 = __builtin_amdgcn_mfma_f32_16x16x32_bf16(af[kk], bc, n1, 0, 0, 0); n2 = __builtin_amdgcn_mfma_f32_16x16x32_bf16(as_[kk], bvv, n2, 0, 0, 0); }
#pragma unroll
                            for (int jj = 0; jj < 4; ++jj) { const int sx = 16 * wave + 4 * quad + jj; const float Ms = v_M[sx]; winter[jj] = __expf(m_old - Ms);
                                float den = winter[jj] * n1[jj] + n2[jj];
                                den = __shfl(den, lane & 48);
                                rd[jj] = 1.0f / fmaxf(fabsf(den), __expf(-(v_b[sx] + Ms))); ssq[jj] = 0.f; }
                        }
#pragma unroll
                        for (int g2 = 0; g2 < 2; ++g2) {
                            f32x4 n1[4], n2[4];
#pragma unroll
                            for (int q = 0; q < 4; ++q) { n1[q] = (f32x4){0.f, 0.f, 0.f, 0.f}; n2[q] = n1[q]; }
#pragma unroll
                            for (int kk = 0; kk < 4; ++kk)
#pragma unroll
                                for (int q = 0; q < 4; ++q) { const int jt = 4 * g2 + q;
                                    const bf16x8 bc = *(const LAS bf16x8*)(Cs + (16 * jt + fr) * PQ + kk * 32 + quad * 8); const bf16x8 bvv = *(const LAS bf16x8*)(VTs + (16 * jt + fr) * PQ + kk * 32 + quad * 8);
                                    n1[q] = __builtin_amdgcn_mfma_f32_16x16x32_bf16(af[kk], bc, n1[q], 0, 0, 0); n2[q] = __builtin_amdgcn_mfma_f32_16x16x32_bf16(as_[kk], bvv, n2[q], 0, 0, 0); }
#pragma unroll
                            for (int q = 0; q < 4; ++q)
#pragma unroll
                                for (int jj = 0; jj < 4; ++jj) { const float x = (winter[jj] * n1[q][jj] + n2[q][jj]) * rd[jj]; hv[4 * g2 + q][jj] = x; ssq[jj] += x * x; }
                        }
#pragma unroll
                        for (int jj = 0; jj < 4; ++jj) { const float rs = 1.0f / sqrtf(row_sum16(ssq[jj]) * (1.f / 128.f) + LN_EPS);
#pragma unroll
                            for (int jt = 0; jt < 8; ++jt) hv[jt][jj] *= rs * gml_s[16 * jt + fr]; }
                    }
                    ML_LBAR(); CSTAMP(6);
                    u32x4 rmo[4];
                    { ML_IDX();
#pragma unroll
                    for (int i = 0; i < 4; ++i) { const int t = t0 + s0 + i; rmo[i] = (u32x4){0u, 0u, 0u, 0u};
                        if (t >= NMETA && t < TT) rmo[i] = *(const u32x4*)(Zp + (size_t)row_of(b, t) * NZ + ZMO + h * 128 + dg * 8); }
#pragma unroll
                    for (int jt = 0; jt < 8; ++jt)
#pragma unroll
                        for (int jj = 0; jj < 4; ++jj) Qs[(16 * wave + 4 * quad + jj) * PQ + 16 * jt + fr] = (bf16_t)(pkbf(hv[jt][jj], 0.f) & 0xffffu);
#pragma unroll
                    for (int jt = 0; jt < 9; ++jt)
#pragma unroll
                        for (int jj = 0; jj < 4; ++jj) Cs[(16 * jt + 4 * quad + jj) * PQ + 16 * wave + fr] = (bf16_t)(pkbf(Cst[jt][jj], 0.f) & 0xffffu);
                    if (tid == 0) v_sc[0] = v_b[127] + Mlast;
                    }
                    ML_LBAR(); CSTAMP(7);
                    { ML_IDX();
#pragma unroll
                    for (int i = 0; i < 4; ++i) {
                        const int s = s0 + i, t = t0 + s;
                        if (t >= NMETA && t < TT) {
                            const u32x4 hw = *(const LAS u32x4*)(Qs + s * PQ + dg * 8);
                            const u32x4 mw = rmo[i];
                            u32x4 wy;
                            wy.x = pkbf(sigmoidf_(bflo(mw.x)) * bflo(hw.x), sigmoidf_(bfhi(mw.x)) * bfhi(hw.x)); wy.y = pkbf(sigmoidf_(bflo(mw.y)) * bflo(hw.y), sigmoidf_(bfhi(mw.y)) * bfhi(hw.y));
                            wy.z = pkbf(sigmoidf_(bflo(mw.z)) * bflo(hw.z), sigmoidf_(bfhi(mw.z)) * bfhi(hw.z)); wy.w = pkbf(sigmoidf_(bflo(mw.w)) * bflo(hw.w), sigmoidf_(bfhi(mw.w)) * bfhi(hw.w));
                            *(u32x4*)(YCp + (size_t)row_of(b, t) * DM + 512 + h * 128 + dg * 8) = wy;
                        }
                    } }
                }
            }
        }
#undef ML_LOADRAW
#undef ML_LBAR
#undef ML_IDX
        PSTAMP(13);
        __syncthreads();
        REPLOOP(2A) {
            LAS int* tkt = (LAS int*)(L + MISC_OFF + 16);
            bf16_t* Qcp = Qc; bf16_t* Kcp = Kc; bf16_t* Vcp = Vc; bf16_t* YCp2 = YCb; unsigned* tctr = ctl + CW_TICKET + 64 * rep_;
            const float* attg = PF(12); unsigned char* parkb = WSP + WS_O;
            float lam;
            { const float p1 = wave_sum(PF(8)[lane] * PF(9)[lane]), p2 = wave_sum(PF(10)[lane] * PF(11)[lane]); lam = expf(p1) - expf(p2) + LAMBDA_INIT; }
            const float* wgu = PF(21); const float* wdn = PF(23); bf16_t* WguTp = WguT; bf16_t* WdnTp = WdnT;
            constexpr int NATT = NB * 4 * 16, NJOB = NE * 16;
            int nextT = 0;
            if (tid == 0) nextT = (int)__hip_atomic_fetch_add(tctr, 1u, RLX_AGENT);
            for (;;) {
                __syncthreads();
                if (tid == 0) { *tkt = nextT; nextT = (int)__hip_atomic_fetch_add(tctr, 1u, RLX_AGENT); }
                __syncthreads();
                const int T = __builtin_amdgcn_readfirstlane(*tkt);
                if (T >= NATT + NJOB) break;
                int Lidx;
                { const int q = T / 3, r = T - q * 3;
                  if (q < NJOB) {
                      if (r == 2) {
                          const int e = q >> 4, kb = q & 15; LAS unsigned char* scr = L + wave * 17408;
                          for (int it = wave; it < 48; it += NWAVES) {
                              if (it < 32) transpose_tile64(wgu + (size_t)e * 1024 * 2048, 2048, WguTp + (size_t)e * 2048 * 1024, 1024, scr, 64 * kb, 64 * it, lane, InvGu());
                              else transpose_tile64(wdn + (size_t)e * 1024 * 1024, 1024, WdnTp + (size_t)e * 1024 * 1024, 1024, scr, 64 * kb, 64 * (it - 32), lane, InvIdent());
                          }
                          continue;
                      }
                      Lidx = q * 2 + r;
                  } else Lidx = T - NJOB; }
                const int bh = Lidx & 63, qb = 15 - (Lidx >> 6);
                const int b = bh >> 2, h = bh & 3;
                int tid_p = tid; asm volatile("" : "+v"(tid_p));
                u32x4* parkp = (u32x4*)parkb + ((size_t)blk * 512 + tid_p) * 8;
                attn_body::attn4_unit<8>(qb, (const attn_body::bf16*)(Qcp + (size_t)(b * 8 + 2 * h) * TT * 64), (const attn_body::bf16*)(Kcp + (size_t)(b * 8 + 2 * h) * TT * 64), (long)TT * 64,
                                         (const attn_body::bf16*)(Vcp + (size_t)(b * 4 + h) * TT * 128), YCp2, b * SEQ, h * 128, lam, attg, parkp, (char*)lds);
            }
        }
        __syncthreads();
        if (BOTH(2)) GRID_BAR();
    }
    PSTAMP(2);

    PSTAMP(3);

    if (IN(4)) REPLOOP(4) {
        {   pg8::Gemm g{YCb, WaT, DM, 1024, 4, nullptr, nullptr, 0};
            pg8::StaticOrder S; S.init(NREAL / 256, 4, G, blk);
            pg8::EpiGateFused E{GFb, MRGb};
            pg8::gemm_phase<0, pg8::EpiGateFused, true>(L, g, S, E); }
        if (BOTH(4) || rep_ + 1 < REP_4) GRID_BAR();
    }
    PSTAMP(4);

    if (IN(5)) REPLOOP(5) {
        pg8::Gemm g{MRGb, WoT, DM, 1024, 4, nullptr, nullptr, 0};
        pg8::StaticOrder S; S.init(NREAL / 256, 4, G, blk);
        pg8::EpiStoreBf16 E{TMPb, DM};
        pg8::gemm_phase<0, pg8::EpiStoreBf16>(L, g, S, E);
        if (BOTH(5) || rep_ + 1 < REP_5) GRID_BAR();
    }
    PSTAMP(5);

    constexpr int NPART = 256, RPP = NREAL / NPART;
    static_assert(NPART * RPP == NREAL, "partitions");
    if (IN(6)) REPLOOP(6) {
        LAS float* wrT = (LAS float*)L;
        LAS int* hcnt = (LAS int*)(L + 131072);
        { const float* wr = PF(19);
          for (int i = tid; i < 8 * 1024; i += 512) { const int k = i & 1023, q4 = i >> 10; const f32x4 v = *(const f32x4*)(wr + k * 32 + 4 * q4);
              wrT[(4 * q4 + 0) * 1024 + k] = v[0]; wrT[(4 * q4 + 1) * 1024 + k] = v[1]; wrT[(4 * q4 + 2) * 1024 + k] = v[2]; wrT[(4 * q4 + 3) * 1024 + k] = v[3]; } }
        const float* xin = PF(0); const float* g0p = PF(2); const float* b0p = PF(3); const float* statsp = stats; const bf16_t* mixp = TMPb;
        const float* g1p = PF(17); const float* b1p = PF(18);
        const float brt = PF(20)[(lane >> 1) & 31];
        bf16_t* Hbp = Hb; int* tokE = tok_e; float* tokG = tok_g; int* histp = hist;
        for (int part = blk; part < NPART; part += G) {
            __syncthreads();
            if (tid < 32) hcnt[tid] = 0;
            __syncthreads();
            const int rbeg = part * RPP, rend = rbeg + RPP;
            constexpr int RPW = (RPP + NWAVES - 1) / NWAVES;
            const int wbeg = rbeg + wave * RPW, wend = (wbeg + RPW < rend) ? wbeg + RPW : rend;
            for (int row = wbeg; row < wend; row += 2) {
                int lane_o = lane; asm volatile("" : "+v"(lane_o));
                const bool two = (row + 1 < wend);
                const int row1 = two ? row + 1 : row;
                const float m0_ = ld_agent_f(statsp + 2 * row), r0_ = ld_agent_f(statsp + 2 * row + 1), m1_ = ld_agent_f(statsp + 2 * row1), r1_ = ld_agent_f(statsp + 2 * row1 + 1);
                f32x4 v0[4], v1[4]; float s0 = 0.f, s1 = 0.f;
#pragma unroll
                for (int j = 0; j < 4; ++j) { v0[j] = *(const f32x4*)(xin + (size_t)row * DM + 4 * lane_o + 256 * j); v1[j] = *(const f32x4*)(xin + (size_t)row1 * DM + 4 * lane_o + 256 * j); }
#pragma unroll
                for (int j = 0; j < 4; ++j) {
                    const u32x2 x0 = *(const u32x2*)(mixp + (size_t)row * DM + 4 * lane_o + 256 * j), x1 = *(const u32x2*)(mixp + (size_t)row1 * DM + 4 * lane_o + 256 * j);
                    const f32x4 g0v = *(const f32x4*)(g0p + 4 * lane_o + 256 * j), b0v = *(const f32x4*)(b0p + 4 * lane_o + 256 * j);
                    v0[j] = ((v0[j] - m0_) * r0_ * g0v + b0v) * DN_ALPHA + (f32x4){bflo(x0.x), bfhi(x0.x), bflo(x0.y), bfhi(x0.y)};
                    v1[j] = ((v1[j] - m1_) * r1_ * g0v + b0v) * DN_ALPHA + (f32x4){bflo(x1.x), bfhi(x1.x), bflo(x1.y), bfhi(x1.y)};
                }
#pragma unroll
                for (int j = 0; j < 4; ++j) { s0 += (v0[j][0] + v0[j][1]) + (v0[j][2] + v0[j][3]); s1 += (v1[j][0] + v1[j][1]) + (v1[j][2] + v1[j][3]); }
                const float mean0 = wave_sum(s0) * (1.f / DM), mean1 = wave_sum(s1) * (1.f / DM); float q0 = 0.f, q1 = 0.f;
#pragma unroll
                for (int j = 0; j < 4; ++j) { const f32x4 d0 = v0[j] - mean0, d1 = v1[j] - mean1;
                    q0 += (d0[0] * d0[0] + d0[1] * d0[1]) + (d0[2] * d0[2] + d0[3] * d0[3]); q1 += (d1[0] * d1[0] + d1[1] * d1[1]) + (d1[2] * d1[2] + d1[3] * d1[3]); }
                const float rstd0 = 1.0f / sqrtf(wave_sum(q0) * (1.f / DM) + LN_EPS), rstd1 = 1.0f / sqrtf(wave_sum(q1) * (1.f / DM) + LN_EPS);
#pragma unroll
                for (int j = 0; j < 4; ++j) {
                    const f32x4 ggj = *(const f32x4*)(g1p + 4 * lane_o + 256 * j), bbj = *(const f32x4*)(b1p + 4 * lane_o + 256 * j);
                    v0[j] = (v0[j] - mean0) * rstd0 * ggj + bbj; v1[j] = (v1[j] - mean1) * rstd1 * ggj + bbj;
                    u32x2 w; w.x = pkbf(v0[j][0], v0[j][1]); w.y = pkbf(v0[j][2], v0[j][3]);
                    *(u32x2*)(Hbp + (size_t)row * DM + 4 * lane_o + 256 * j) = w;
                    if (two) { w.x = pkbf(v1[j][0], v1[j][1]); w.y = pkbf(v1[j][2], v1[j][3]); *(u32x2*)(Hbp + (size_t)row1 * DM + 4 * lane_o + 256 * j) = w; }
                }
                float p0[32], p1[32];
#pragma unroll
                for (int e = 0; e < 32; ++e) {
                    f32x2 a0 = (f32x2){0.f, 0.f}, a1 = a0;
#pragma unroll
                    for (int j = 0; j < 4; ++j) { const f32x4 wv = *(const LAS f32x4*)(wrT + e * 1024 + 4 * lane_o + 256 * j);
                        const f32x2 wl = (f32x2){wv[0], wv[1]}, wh = (f32x2){wv[2], wv[3]};
                        a0 += (f32x2){v0[j][0], v0[j][1]} * wl; a0 += (f32x2){v0[j][2], v0[j][3]} * wh;
                        a1 += (f32x2){v1[j][0], v1[j][1]} * wl; a1 += (f32x2){v1[j][2], v1[j][3]} * wh; }
                    p0[e] = a0[0] + a0[1]; p1[e] = a1[0] + a1[1];
                    if ((e & 3) == 3) __builtin_amdgcn_sched_barrier(0);
                }
                float lg0 = xreduce32(p0, lane_o) + brt, lg1 = xreduce32(p1, lane_o) + brt;
#pragma unroll
                for (int rr = 0; rr < 2; ++rr) {
                    float lg = rr ? lg1 : lg0; const int rw = rr ? row1 : row;
                    float tv[4]; int ti[4];
#pragma unroll
                    for (int k = 0; k < 4; ++k) {
                        const float mx = wave_max(lg);
                        const unsigned long long bal = __ballot(lg == mx);
                        const int idx = (__ffsll((long long)bal) - 1) >> 1;
                        tv[k] = mx; ti[k] = idx;
                        if ((lane_o >> 1) == idx) lg = -INFINITY;
                    }
                    const float e1 = __expf(tv[1] - tv[0]), e2 = __expf(tv[2] - tv[0]), e3 = __expf(tv[3] - tv[0]);
                    const float inv = 1.0f / (1.0f + e1 + e2 + e3);
                    if (lane_o < 4 && (rr == 0 || two)) {
                        const int idx = (lane_o == 0) ? ti[0] : (lane_o == 1) ? ti[1] : (lane_o == 2) ? ti[2] : ti[3];
                        const float gv = ((lane_o == 0) ? 1.0f : (lane_o == 1) ? e1 : (lane_o == 2) ? e2 : e3) * inv;
                        tokE[(size_t)rw * 4 + lane_o] = idx; tokG[(size_t)rw * 4 + lane_o] = gv;
                        atomicAdd((int*)&hcnt[idx], 1);
                    }
                }
            }
            __syncthreads();
            if (tid < 32) histp[part * 32 + tid] = hcnt[tid];
        }
        if (BOTH(6) || rep_ + 1 < REP_6) GRID_BAR();
    }
    PSTAMP(6);

    if (IN(7)) REPLOOP(7) {
        LAS int* cnt_s = (LAS int*)L; LAS int* base_s = cnt_s + 32; LAS int* pst_s = cnt_s + 64;
        LAS int* ptot = cnt_s + 128; LAS int* pbase = ptot + 512;
        LAS int* ccnt = pbase + 512;
        LAS int* ent = ccnt + 1024; LAS int* lrank = ent + RPP * 4 + 64;
        int* rowOff = row_off; int* rowSlot = row_slot; float* rowGate = row_gate; const int* histp = hist; const int* tokE = tok_e; const float* tokG = tok_g;
        for (int part = blk; part < NPART; part += G) {
            __syncthreads();
            { const int e = tid & 31, q = tid >> 5; int tot = 0, bs = 0;
#pragma unroll 4
              for (int b2 = q * 16; b2 < q * 16 + 16; ++b2) { const int v = ld_agent_i(histp + b2 * 32 + e); tot += v; bs += (b2 < part) ? v : 0; }
              ptot[q * 32 + e] = tot; pbase[q * 32 + e] = bs; }
            const int rbeg = part * RPP, n4 = RPP * 4;
            for (int i = tid; i < n4; i += 512) ent[i] = ld_agent_i(tokE + (size_t)rbeg * 4 + i);
            __syncthreads();
            if (tid < 32) { int tot = 0, bs = 0;
#pragma unroll
                for (int q = 0; q < 16; ++q) { tot += ptot[q * 32 + tid]; bs += pbase[q * 32 + tid]; }
                cnt_s[tid] = tot; base_s[tid] = bs; }
            constexpr int NCH = (RPP * 4 + 63) / 64;
            for (int c = wave; c < NCH; c += NWAVES) {
                const int i = 64 * c + lane; const int my = (i < n4) ? ent[i] : -1; int lr = 0;
#pragma unroll 4
                for (int e = 0; e < 32; ++e) { const unsigned long long b = __ballot(my == e);
                    if (lane == e) ccnt[c * 32 + e] = __popcll(b);
                    if (my == e) lr = __popcll(b & ((1ull << lane) - 1ull)); }
                if (i < n4) lrank[i] = lr;
            }
            __syncthreads();
            if (tid == 0) { int p = 0; for (int e = 0; e < 32; ++e) { pst_s[e] = p; p += (cnt_s[e] + 255) & ~255; } pst_s[32] = p; }
            __syncthreads();
            if (tid < 32) { int run = pst_s[tid] + base_s[tid];
                for (int c = 0; c < NCH; ++c) { const int tmp = ccnt[c * 32 + tid]; ccnt[c * 32 + tid] = run; run += tmp; } }
            __syncthreads();
            for (int i = tid; i < n4; i += 512) { const int e = ent[i]; const int pos = ccnt[(i >> 6) * 32 + e] + lrank[i];
                rowOff[pos] = (rbeg + (i >> 2)) * (DM * 2); rowSlot[pos] = rbeg * 4 + i; rowGate[pos] = ld_agent_f(tokG + (size_t)rbeg * 4 + i); }
            if (part < 32) { const int e = part; for (int r = pst_s[e] + cnt_s[e] + tid; r < pst_s[e + 1]; r += 512) { rowOff[r] = 0; rowSlot[r] = NREAL * 4; rowGate[r] = 0.f; } }
            if (part == 0) { const int nT = pst_s[32] >> 8; int* te = tile_exp;
                for (int t = tid; t < nT; t += 512) { int e = 0; while (e < 31 && t * 256 >= pst_s[e + 1]) ++e; te[t] = e; }
                if (tid == 0) __hip_atomic_store((int*)(ctl + CW_NT), nT, RLX_AGENT); }
        }
        __syncthreads();
        if (BOTH(7) || rep_ + 1 < REP_7) GRID_BAR();
    }
    PSTAMP(7);

    {
        int nT = 0, TPC = 0;
        if (lo < 12 && hi > 8) { nT = __builtin_amdgcn_readfirstlane(ld_agent_i((const int*)(ctl + CW_NT))); TPC = (nT > 512) ? 512 : nT; }
        if (IN(8)) REPLOOP(8) {
            pg8::Gemm g{Hb, WguT, DM, DM, 8, row_off, tile_exp, 0};
            pg8::StaticOrder S; S.init(TPC, 8, G, blk);
            pg8::EpiAct E{ACT, PF(22), tile_exp, 0};
            pg8::gemm_phase<1, pg8::EpiAct>(L, g, S, E);
            if (BOTH(8) || rep_ + 1 < REP_8) GRID_BAR();
        }
        PSTAMP(8);
        if (IN(9)) REPLOOP(9) {
            pg8::Gemm g{ACT, WdnT, FF, FF, 4, nullptr, tile_exp, 0};
            pg8::StaticOrder S; S.init(TPC, 4, G, blk);
            pg8::EpiDown E{Y, PF(24), tile_exp, row_slot, row_gate, 0};
            pg8::gemm_phase<2, pg8::EpiDown>(L, g, S, E);
            if (BOTH(9) || rep_ + 1 < REP_9) GRID_BAR();
        }
        PSTAMP(9);
        if (IN(10)) REPLOOP(10) {
            pg8::Gemm g{Hb, WguT, DM, DM, 8, row_off, tile_exp, TPC};
            pg8::StaticOrder S; S.init(nT - TPC, 8, G, blk);
            pg8::EpiAct E{ACT, PF(22), tile_exp, TPC};
            pg8::gemm_phase<1, pg8::EpiAct>(L, g, S, E);
            if (BOTH(10) || rep_ + 1 < REP_10) GRID_BAR();
        }
        PSTAMP(10);
        if (IN(11)) REPLOOP(11) {
            pg8::Gemm g{ACT, WdnT, FF, FF, 4, nullptr, tile_exp, TPC};
            pg8::StaticOrder S; S.init(nT - TPC, 4, G, blk);
            pg8::EpiDown E{Y, PF(24), tile_exp, row_slot, row_gate, TPC};
            pg8::gemm_phase<2, pg8::EpiDown>(L, g, S, E);
            if (BOTH(11) || rep_ + 1 < REP_11) GRID_BAR();
        }
        PSTAMP(11);
    }

    if (IN(12)) REPLOOP(12) {
        for (int row = gw; row < NREAL; row += NGW) {
            f32x4 v[4]; float s = 0.f;
#pragma unroll
            for (int j = 0; j < 4; ++j) {
                const u32x2 hw = *(const u32x2*)(Hb + (size_t)row * DM + 4 * lane + 256 * j);
                f32x4 acc = (f32x4){bflo(hw.x), bfhi(hw.x), bflo(hw.y), bfhi(hw.y)} * DN_ALPHA;
#pragma unroll
                for (int k = 0; k < 4; ++k) { const u32x2 yw = *(const u32x2*)(Y + ((size_t)row * 4 + k) * DM + 4 * lane + 256 * j);
                    acc += (f32x4){bflo(yw.x), bfhi(yw.x), bflo(yw.y), bfhi(yw.y)}; }
                v[j] = acc; s += (acc[0] + acc[1]) + (acc[2] + acc[3]);
            }
            const float mean = wave_sum(s) * (1.f / DM); float s2 = 0.f;
#pragma unroll
            for (int j = 0; j < 4; ++j) { const f32x4 d = v[j] - mean; s2 += (d[0] * d[0] + d[1] * d[1]) + (d[2] * d[2] + d[3] * d[3]); }
            const float rstd = 1.0f / sqrtf(wave_sum(s2) * (1.f / DM) + LN_EPS);
            float* orow = (float*)DOUTP + (size_t)row * DM;
#pragma unroll
            for (int j = 0; j < 4; ++j) {
                const f32x4 gg = *(const f32x4*)(PF(25) + 4 * lane + 256 * j), bb = *(const f32x4*)(PF(26) + 4 * lane + 256 * j);
                *(f32x4*)(orow + 4 * lane + 256 * j) = (v[j] - mean) * rstd * gg + bb;
            }
        }
#if MK_PROBE == 2
        __syncthreads();
        PSTAMP(12);
        if (blk == 0 && tid == 0) pdur[14] = pdur[30] - pdur[29];
        if (blk == 0 && tid == 0) { asm volatile("s_waitcnt vmcnt(0)" ::: "memory"); ((float*)DOUTP)[0] += (float)pdur[MK_PROBE_K] * (0.01f / MK_PROBE_DIV); }
#elif MK_PROBE
        __syncthreads();
        if (blk == 0 && tid == 0) { const unsigned cyc = __hip_atomic_load(ctl + CW_PROBE, RLX_AGENT), st = __hip_atomic_load(ctl + CW_PROBE + 1, RLX_AGENT);
            asm volatile("s_waitcnt vmcnt(0)" ::: "memory"); ((float*)DOUTP)[0] += (float)cyc / (float)(st ? st : 1u); }
#endif
    }
#undef IN
#undef BOTH
#undef GRID_BAR
}

constexpr int N_PHASES = 13;
extern "C" void kernel_launch(void* const* d_in, const int* in_sizes, int n_in, void* d_out, int out_size, void* d_ws, size_t ws_size, hipStream_t stream) {
    static int grid = 0;
    if (grid == 0) {
        if (n_in != 27 || ws_size < WS_END) { fprintf(stderr, "kernel_launch: unexpected n_in %d / ws_size %zu\n", n_in, ws_size); grid = -1; return; }
        int dev = 0, cus = 0;
        if (hipGetDevice(&dev) != hipSuccess || hipDeviceGetAttribute(&cus, hipDeviceAttributeMultiprocessorCount, dev) != hipSuccess) { grid = -1; return; }
        if (hipFuncSetAttribute((const void*)hybrid_fwd, hipFuncAttributeMaxDynamicSharedMemorySize, LDS_BYTES) != hipSuccess) { fprintf(stderr, "kernel_launch: hipFuncSetAttribute failed\n"); grid = -1; return; }
        int per_cu = 0;
        (void)hipOccupancyMaxActiveBlocksPerMultiprocessor(&per_cu, (const void*)hybrid_fwd, NWAVES * 64, LDS_BYTES);
        (void)hipGetLastError();
        grid = cus > 0 ? cus : 256;
    }
    if (grid < 0) return;
    (void)hipMemsetAsync((char*)d_ws + WS_CTL, 0, CTL_ZERO_BYTES, stream);
    Args a{};
    const float** fp = (const float**)&a;
    for (int i = 0; i < 27; ++i) fp[i] = (const float*)d_in[i];
    a.out = (float*)d_out; a.ws = (unsigned char*)d_ws;
#if MK_PER_PHASE
    for (int p = 0; p < N_PHASES; ++p) { a.ph_lo = p; a.ph_hi = p + 1; hipLaunchKernelGGL(hybrid_fwd, dim3(grid), dim3(NWAVES * 64), LDS_BYTES, stream, a); }
#else
    a.ph_lo = 0; a.ph_hi = N_PHASES;
    hipLaunchKernelGGL(hybrid_fwd, dim3(grid), dim3(NWAVES * 64), LDS_BYTES, stream, a);
#endif
}
```

```cpp
#include <hip/hip_runtime.h>
#include <hip/hip_bf16.h>
#include <cstdio>
#include <cstdint>
#include <cmath>

#ifndef MK_PER_PHASE
#define MK_PER_PHASE 0
#endif

#ifndef REP_ALL
#define REP_ALL 1
#endif
#ifndef REP_0
#define REP_0 REP_ALL
#endif
#ifndef REP_1
#define REP_1 REP_ALL
#endif
#ifndef REP_2A
#define REP_2A REP_ALL
#endif
#ifndef REP_2B
#define REP_2B REP_ALL
#endif
#ifndef REP_3
#define REP_3 REP_ALL
#endif
#ifndef REP_4
#define REP_4 REP_ALL
#endif
#ifndef REP_5
#define REP_5 REP_ALL
#endif
#ifndef REP_6
#define REP_6 REP_ALL
#endif
#ifndef REP_7
#define REP_7 REP_ALL
#endif
#ifndef REP_8
#define REP_8 REP_ALL
#endif
#ifndef REP_9
#define REP_9 REP_ALL
#endif
#ifndef REP_10
#define REP_10 REP_ALL
#endif
#ifndef REP_11
#define REP_11 REP_ALL
#endif
#ifndef REP_12
#define REP_12 REP_ALL
#endif
#define REPLOOP(k) _Pragma("unroll 1") for (int rep_ = 0; rep_ < REP_##k; ++rep_)
#ifndef MK_PROBE
#define MK_PROBE 0
#endif
#ifndef MK_PROBE_K
#define MK_PROBE_K 2
#define MK_PROBE_DIV 10.0f
#endif
#define LAS __attribute__((address_space(3)))
#define GAS __attribute__((address_space(1)))
typedef unsigned short bf16_t;
typedef short bf16x8 __attribute__((ext_vector_type(8)));
typedef float f32x4 __attribute__((ext_vector_type(4)));
typedef float f32x2 __attribute__((ext_vector_type(2)));
typedef unsigned u32x4 __attribute__((ext_vector_type(4)));
typedef unsigned u32x2 __attribute__((ext_vector_type(2)));
typedef __bf16 bf16x2_t __attribute__((ext_vector_type(2)));
#define RLX_AGENT __ATOMIC_RELAXED, __HIP_MEMORY_SCOPE_AGENT

constexpr int NB = 16, SEQ = 4096, NMETA = 16, TT = SEQ + NMETA  , MROWS = NB * TT  , DM = 1024;
constexpr int NREAL = NB * SEQ;
constexpr int NZP = 5632;
constexpr int NZ = 2080;
constexpr int ZMQ = 0, ZMK = 512, ZMV = 1024, ZMO = 1536, ZGA = 2048, ZGM = 3072;
constexpr int ZYC = 0;
constexpr int NIN = 5640;
constexpr int NE = 32, FF = 1024;
constexpr int OROWS = 4352;
constexpr float LN_EPS = 1e-5f;
constexpr float DN_ALPHA = 1.189207115002721f;
constexpr float LAMBDA_INIT = 0.2f;
constexpr float FP8_SA1 = 16.0f, FP8_SB1 = 512.0f;
constexpr float ATT_C2 = 0.125f * 1.4426950408889634f;

constexpr size_t MiB = 1u << 20;
constexpr size_t WS_CTL = 0, CTL_ZERO_BYTES = 32768;
constexpr size_t WS_WIN = 2 * MiB;
constexpr size_t WS_WA = 13 * MiB;
constexpr size_t WS_WM = 14 * MiB;
constexpr size_t WS_WO = 15 * MiB;
constexpr size_t WS_ROPE = 17 * MiB;
constexpr size_t WS_STATS = 19 * MiB;
constexpr size_t WS_GATES = 20 * MiB;
constexpr size_t WS_TOKE = 23 * MiB;
constexpr size_t WS_TOKG = 24 * MiB + 512 * 1024;
constexpr size_t WS_HIST = 26 * MiB;
constexpr size_t WS_ROWOFF = 27 * MiB;
constexpr size_t WS_ROWSLOT = 28 * MiB + 512 * 1024;
constexpr size_t WS_ROWGATE = 30 * MiB;
constexpr size_t WS_TILEEXP = 31 * MiB + 512 * 1024;
constexpr size_t WS_H = 32 * MiB;
constexpr size_t WS_Z = 162 * MiB;
constexpr size_t WS_Y = WS_Z;
constexpr size_t WS_ACT = WS_Z + 516 * MiB;
constexpr size_t WS_GF = 424 * MiB;
constexpr size_t WS_QC = 686 * MiB;
constexpr size_t WS_KC = 751 * MiB;
constexpr size_t WS_VC = 816 * MiB;
constexpr size_t WS_TMP = 686 * MiB;
constexpr size_t WS_MRG = 816 * MiB;
constexpr size_t WS_O = 882 * MiB;
constexpr size_t WS_H8 = 952 * MiB;
constexpr size_t WS_END = 1024 * MiB;
constexpr size_t DO_WGU = 0;
constexpr size_t DO_WDN = 128 * MiB;
constexpr int CW_TMO = 0, CW_NT = 64, CW_TICKET = 128  , CW_PROBE = 1024, CW_BAR = 4096;

constexpr int LDS_BYTES = 163840;
constexpr int MISC_OFF = 163840 - 512;
constexpr int NWAVES = 8;

__device__ __forceinline__ unsigned pkbf(float lo, float hi) { f32x2 v = {lo, hi}; bf16x2_t b = __builtin_convertvector(v, bf16x2_t); return __builtin_bit_cast(unsigned, b); }
__device__ __forceinline__ float bflo(unsigned w) { return __uint_as_float(w << 16); }
__device__ __forceinline__ float bfhi(unsigned w) { return __uint_as_float(w & 0xffff0000u); }
__device__ __forceinline__ float sigmoidf_(float x) { return __builtin_amdgcn_rcpf(1.0f + __expf(-x)); }
template <int CTRL> __device__ __forceinline__ float dppf(float v) { return __builtin_bit_cast(float, __builtin_amdgcn_update_dpp(0, __builtin_bit_cast(int, v), CTRL, 0xF, 0xF, true)); }
__device__ __forceinline__ float rdlane(float v, int l) { return __builtin_bit_cast(float, __builtin_amdgcn_readlane(__builtin_bit_cast(int, v), l)); }
__device__ __forceinline__ float row_sum16(float v) { v += dppf<0xB1>(v); v += dppf<0x4E>(v); v += dppf<0x141>(v); v += dppf<0x140>(v); return v; }
__device__ __forceinline__ float wave_sum(float v) { v = row_sum16(v); return (rdlane(v, 0) + rdlane(v, 16)) + (rdlane(v, 32) + rdlane(v, 48)); }
__device__ __forceinline__ float wave_max(float v) {
    v = fmaxf(v, dppf<0xB1>(v)); v = fmaxf(v, dppf<0x4E>(v)); v = fmaxf(v, dppf<0x141>(v)); v = fmaxf(v, dppf<0x140>(v));
    return fmaxf(fmaxf(rdlane(v, 0), rdlane(v, 16)), fmaxf(rdlane(v, 32), rdlane(v, 48)));
}
__device__ __forceinline__ float xreduce32(float (&p)[32], int lane) {
    float a[16], b[8], c[4], d[2];
#pragma unroll
    for (int i = 0; i < 16; ++i) { auto r = __builtin_amdgcn_permlane32_swap(__float_as_uint(p[i]), __float_as_uint(p[16 + i]), false, false); a[i] = __uint_as_float(r[0]) + __uint_as_float(r[1]); }
#pragma unroll
    for (int i = 0; i < 8; ++i) { auto r = __builtin_amdgcn_permlane16_swap(__float_as_uint(a[i]), __float_as_uint(a[8 + i]), false, false); b[i] = __uint_as_float(r[0]) + __uint_as_float(r[1]); }
    const bool b3 = (lane & 8) != 0, b2 = (lane & 4) != 0, b1 = (lane & 2) != 0;
#pragma unroll
    for (int i = 0; i < 4; ++i) { const float keep = b3 ? b[4 + i] : b[i], send = b3 ? b[i] : b[4 + i]; c[i] = keep + dppf<0x128>(send); }
#pragma unroll
    for (int i = 0; i < 2; ++i) { const float keep = b2 ? c[2 + i] : c[i], send = b2 ? c[i] : c[2 + i]; d[i] = keep + dppf<0x141>(send); }
    const float keep = b1 ? d[1] : d[0], send = b1 ? d[0] : d[1];
    float r = keep + dppf<0x4E>(send);
    r += dppf<0xB1>(r);
    return r;
}
__device__ __forceinline__ int ld_agent_i(const int* p) { return __hip_atomic_load(p, RLX_AGENT); }
__device__ __forceinline__ float ld_agent_f(const float* p) { return __hip_atomic_load(p, RLX_AGENT); }
#define LDS_WAIT() asm volatile("s_waitcnt lgkmcnt(0)" ::: "memory")
template <int CTRL, int RMASK> __device__ __forceinline__ float dpp_old(float old, float v) { return __builtin_bit_cast(float, __builtin_amdgcn_update_dpp(__builtin_bit_cast(int, old), __builtin_bit_cast(int, v), CTRL, RMASK, 0xF, false)); }
__device__ __forceinline__ float wave_scan_add(float v) {
    v += dpp_old<0x111, 0xF>(0.f, v); v += dpp_old<0x112, 0xF>(0.f, v); v += dpp_old<0x114, 0xF>(0.f, v); v += dpp_old<0x118, 0xF>(0.f, v);
    v += dpp_old<0x142, 0xA>(0.f, v); v += dpp_old<0x143, 0xC>(0.f, v); return v; }
__device__ __forceinline__ float wave_scan_max(float v) {
    const float ninf = -INFINITY;
    v = fmaxf(v, dpp_old<0x111, 0xF>(ninf, v)); v = fmaxf(v, dpp_old<0x112, 0xF>(ninf, v)); v = fmaxf(v, dpp_old<0x114, 0xF>(ninf, v)); v = fmaxf(v, dpp_old<0x118, 0xF>(ninf, v));
    v = fmaxf(v, dpp_old<0x142, 0xA>(ninf, v)); v = fmaxf(v, dpp_old<0x143, 0xC>(ninf, v)); return v; }
__device__ __forceinline__ int row_of(int b, int t) { return (t < NMETA) ? NREAL + b * NMETA + t : b * SEQ + (t - NMETA); }
__device__ __forceinline__ void bt_of(int row, int& b, int& t) { if (row < NREAL) { b = row >> 12; t = (row & (SEQ - 1)) + NMETA; } else { const int m = row - NREAL; b = m >> 4; t = m & (NMETA - 1); } }
__device__ __forceinline__ unsigned pkfp8x4(float a, float b, float c, float d) {
    a = fminf(fmaxf(a, -448.f), 448.f); b = fminf(fmaxf(b, -448.f), 448.f); c = fminf(fmaxf(c, -448.f), 448.f); d = fminf(fmaxf(d, -448.f), 448.f);
    int w = 0; w = __builtin_amdgcn_cvt_pk_fp8_f32(a, b, w, false); w = __builtin_amdgcn_cvt_pk_fp8_f32(c, d, w, true); return (unsigned)w; }
__device__ __forceinline__ const void* ldptr(LAS const unsigned long long* t, int i) { const unsigned long long v = t[i];
    const unsigned lo = (unsigned)__builtin_amdgcn_readfirstlane((int)(unsigned)v), hi = (unsigned)__builtin_amdgcn_readfirstlane((int)(unsigned)(v >> 32));
    return (const void*)(const GAS void*)(((unsigned long long)hi << 32) | lo); }

namespace pg8 {
constexpr int BM = 256, BK = 64, HALF = 128, HTB = HALF * BK * 2, STAGE_BYTES = 8 * HTB, NXCD = 8, WGM = 8;
__host__ __device__ __forceinline__ int lds_byte(int r, int c) { const int st = (r >> 4) * 2 + (c >> 5), rr = r & 15, cc = c & 31, ob = rr * 64 + cc * 2; return st * 1024 + (ob ^ (((ob >> 9) & 1) << 5)); }
__host__ __device__ __forceinline__ void stage_rc(int b, int& R, int& C) { const int st = b / 1024, sb = b % 1024, swz = sb ^ (((sb >> 9) & 1) << 5); R = (st >> 1) * 16 + swz / 64; C = (st & 1) * 32 + (swz % 64) / 2; }
__host__ __device__ __forceinline__ int perm32(int rho) { const int n = rho >> 4, i = rho & 15; return 8 * (i >> 2) + 4 * n + (i & 3); }

struct Unit { int pm, pn, e; };
struct Gemm { const bf16_t* A; const bf16_t* Bt; int lda, K, nN; const int* row_off; const int* tile_exp; int pm0; };
struct StaticOrder {
    int nM, nN, nwg, G, c;
    __device__ __forceinline__ void init(int nM_, int nN_, int G_, int c_) { nM = nM_; nN = nN_; nwg = nM * nN; G = G_; c = c_; }
    __device__ __forceinline__ bool next(int i, Unit& u) const {
        const long L = (long)i * G + c; if (L >= nwg) return false;
        int wgid = (int)L; { const int q = nwg / NXCD, r = nwg % NXCD, xcd = wgid % NXCD, off = wgid / NXCD; wgid = (xcd < r ? xcd * (q + 1) : r * (q + 1) + (xcd - r) * q) + off; }
        const int nig = WGM * nN, gid = wgid / nig, fm = gid * WGM, gsz = (nM - fm) < WGM ? (nM - fm) : WGM;
        u.pm = fm + ((wgid % nig) % gsz); u.pn = (wgid % nig) / gsz; u.e = 0; return true;
    }
};

template <int MODE, class Epi, bool MID = false, bool FP8 = false>
__device__ __forceinline__ void gemm_phase(LAS unsigned char* lds, const Gemm g, const StaticOrder& S, const Epi& E) {
    const int tid = threadIdx.x, wid = __builtin_amdgcn_readfirstlane(tid >> 6), lane = tid & 63, wr = wid >> 2, wc = wid & 3, fr = lane & 15, fq = lane >> 4;
    const int K = g.K, nt = K / BK;
    unsigned voffA[2], voffB[2];
#pragma unroll
    for (int i = 0; i < 2; ++i) { int R, C; stage_rc(tid * 16 + i * 8192, R, C); const int Rb = Epi::PERM ? ((R & ~31) + perm32(R & 31)) : R;
        voffA[i] = (unsigned)(R * g.lda + C) * 2u; voffB[i] = (unsigned)(Rb * K + C) * 2u; }
    const size_t kstep = (size_t)(BK * 2);
    const size_t hstepA = (size_t)HALF * g.lda * 2, hstepB = (size_t)HALF * K * 2;
    const size_t tstepA = 2 * hstepA, tstepB = 2 * hstepB;
    const unsigned ldsw = (unsigned)wid * 1024u;
    LAS unsigned char* pa = lds + lds_byte(wr * 64 + fr, fq * 8); LAS unsigned char* pb = lds + 4 * HTB + lds_byte(wc * 32 + fr, fq * 8);
    asm volatile("" : "+v"(pa), "+v"(pb));
    unsigned vC[2][2] = {{0u, 0u}, {0u, 0u}};
    constexpr int GOFF = 8 * HTB;
#define PG8_SA(b, h) (((b) * 2 + (h)) * HTB)
#define PG8_SB(b, h) ((4 + (b) * 2 + (h)) * HTB)
#define PG8_STAGE_B(bufoff, gbase) do { _Pragma("unroll") for (int _i = 0; _i < 2; ++_i) { unsigned vb_ = voffB[_i]; asm volatile("" : "+v"(vb_)); \
        __builtin_amdgcn_global_load_lds((const unsigned*)((const char*)(gbase) + vb_), (LAS unsigned*)(lds + (bufoff) + ldsw + _i * 8192), 16, 0, 0); } } while (0)
#define PG8_STAGE_A(bufoff, gbase, h) do { _Pragma("unroll") for (int _i = 0; _i < 2; ++_i) { unsigned va_ = (MODE == 1) ? vC[h][_i] : voffA[_i]; if (MODE != 1) asm volatile("" : "+v"(va_)); \
        const char* _p = (MODE == 1) ? ((const char*)(gbase) + va_) : ((const char*)(gbase) + (h) * hstepA + va_); \
        __builtin_amdgcn_global_load_lds((const unsigned*)_p, (LAS unsigned*)(lds + (bufoff) + ldsw + _i * 8192), 16, 0, 0); } } while (0)
#define PG8_LD8(dst, cnt, base) do { _Pragma("unroll") for (int q_ = 0; q_ < (cnt); ++q_) { const pg8_v4i lo_ = *(const LAS pg8_v4i*)((base) + q_ * 2048), hi_ = *(const LAS pg8_v4i*)((base) + q_ * 2048 + 1024); \
        dst[q_] = __builtin_shufflevector(lo_, hi_, 0, 1, 2, 3, 4, 5, 6, 7); } } while (0)
#define PG8_LDA(dst, b, h) do { if constexpr (FP8) { PG8_LD8(dst##8, 4, pa + PG8_SA(b, h)); } else { _Pragma("unroll") for (int m = 0; m < 4; ++m) _Pragma("unroll") for (int k = 0; k < 2; ++k) dst[m][k] = *(const LAS bf16x8*)(pa + PG8_SA(b, h) + m * 2048 + k * 1024); } } while (0)
#define PG8_LDB(dst, b, h) do { if constexpr (FP8) { PG8_LD8(dst##8, 2, pb + PG8_SA(b, h)); } else { _Pragma("unroll") for (int n = 0; n < 2; ++n) _Pragma("unroll") for (int k = 0; k < 2; ++k) dst[n][k] = *(const LAS bf16x8*)(pb + PG8_SA(b, h) + n * 2048 + k * 1024); } } while (0)
#define PG8_MMA(ai, bj, At, Bt) do { __builtin_amdgcn_s_setprio(1); _Pragma("unroll") for (int m = 0; m < 4; ++m) _Pragma("unroll") for (int n = 0; n < 2; ++n) { \
        if constexpr (FP8) {   \
            acc[ai][bj][m][n] = __builtin_amdgcn_mfma_scale_f32_16x16x128_f8f6f4(Bt##8[n], At##8[m], acc[ai][bj][m][n], 0, 0, 0, 0x7f7f7f7f, 0, 0x7f7f7f7f); \
        } else { _Pragma("unroll") for (int k = 0; k < 2; ++k) acc[ai][bj][m][n] = __builtin_amdgcn_mfma_f32_16x16x32_bf16(Bt[n][k], At[m][k], acc[ai][bj][m][n], 0, 0, 0); } } \
        __builtin_amdgcn_s_setprio(0); } while (0)
#define PG8_WAIT_V(n) asm volatile("s_waitcnt vmcnt(" #n ")" ::: "memory")
#define PG8_WAIT_L(n) asm volatile("s_waitcnt lgkmcnt(" #n ")" ::: "memory")
#define PG8_BAR __builtin_amdgcn_s_barrier()
#define PG8_SCHED __builtin_amdgcn_sched_barrier(0)
#define PG8_ABASE(u) ((MODE == 1) ? (const char*)g.A : (const char*)g.A + (size_t)(u).pm * tstepA)
#define PG8_BBASE(u) ((MODE == 0) ? (const char*)g.Bt + (size_t)(u).pn * tstepB : (const char*)g.Bt + ((size_t)((u).e = __builtin_amdgcn_readfirstlane(ld_agent_i(g.tile_exp + g.pm0 + (u).pm))) * g.nN + (u).pn) * tstepB)
#define PG8_GATHER(dst, u) do { if (MODE == 1) { int tq_ = tid; asm volatile("" : "+v"(tq_)); _Pragma("unroll") for (int _i = 0; _i < 2; ++_i) { int R_, C_; stage_rc(tq_ * 16 + _i * 8192, R_, C_); \
        _Pragma("unroll") for (int _h = 0; _h < 2; ++_h) dst[_h][_i] = (unsigned)ld_agent_i(g.row_off + (size_t)(g.pm0 + (u).pm) * BM + _h * HALF + R_) + (unsigned)(C_ * 2); } } } while (0)
#define PG8_GATHER_DMA(u) do { if (MODE == 1) { int tq_ = tid; asm volatile("" : "+v"(tq_)); _Pragma("unroll") for (int _i = 0; _i < 2; ++_i) { int R_, C_; stage_rc(tq_ * 16 + _i * 8192, R_, C_); \
        _Pragma("unroll") for (int _h = 0; _h < 2; ++_h) __builtin_amdgcn_global_load_lds((const unsigned*)(g.row_off + (size_t)(g.pm0 + (u).pm) * BM + _h * HALF + R_), (LAS unsigned*)(lds + GOFF + (_h * 2 + _i) * 2048 + wid * 256), 4, 0, 0); } } } while (0)
#define PG8_GATHER_LDS(dst) do { if (MODE == 1) { int tq_ = tid; asm volatile("" : "+v"(tq_)); _Pragma("unroll") for (int _i = 0; _i < 2; ++_i) { int R_, C_; stage_rc(tq_ * 16 + _i * 8192, R_, C_); \
        _Pragma("unroll") for (int _h = 0; _h < 2; ++_h) dst[_h][_i] = *(const LAS unsigned*)(lds + GOFF + (_h * 2 + _i) * 2048 + tq_ * 4) + (unsigned)(C_ * 2); } } } while (0)
    Unit cur, nxt; int ui = 0;
    if (!S.next(0, cur)) return;
    f32x4 acc[2][2][4][2];
#pragma unroll
    for (int a = 0; a < 2; ++a)
#pragma unroll
        for (int b = 0; b < 2; ++b)
#pragma unroll
            for (int m = 0; m < 4; ++m)
#pragma unroll
                for (int n = 0; n < 2; ++n) acc[a][b][m][n] = (f32x4){0.f, 0.f, 0.f, 0.f};
    bf16x8 At[4][2], B0[2][2], B1[2][2];
    typedef int pg8_v8i __attribute__((ext_vector_type(8))); typedef int pg8_v4i __attribute__((ext_vector_type(4)));
    pg8_v8i At8[4], B08[2], B18[2];
    const char* cA = PG8_ABASE(cur); const char* cB = PG8_BBASE(cur);
    PG8_GATHER(vC, cur);
    PG8_STAGE_B(PG8_SB(0, 0), cB); PG8_STAGE_B(PG8_SB(0, 1), cB + hstepB); PG8_STAGE_A(PG8_SA(0, 0), cA, 0); PG8_STAGE_A(PG8_SA(0, 1), cA, 1);
    if (wr == 1) PG8_BAR;
    PG8_WAIT_V(2); PG8_BAR;
    PG8_STAGE_B(PG8_SB(1, 0), cB + kstep); PG8_STAGE_A(PG8_SA(1, 0), cA + kstep, 0); PG8_STAGE_B(PG8_SB(1, 1), cB + hstepB + kstep);
    PG8_WAIT_V(6); PG8_BAR;
    for (;;) {
        const bool has_next = S.next(ui + 1, nxt);
        const char* nA = has_next ? PG8_ABASE(nxt) : cA; const char* nB = has_next ? PG8_BBASE(nxt) : cB;
        if (has_next) PG8_GATHER_DMA(nxt);
#pragma unroll 1
        for (int t = 0; t < nt; t += 2) {
            if constexpr (MID) { if (t == nt / 2) { if (wr == 0) PG8_BAR; E.mid(acc, cur, wr, wc, fr, fq); if (wr == 1) PG8_BAR; } }
            const bool last = (t == nt - 2);
            const char* a1 = cA + (size_t)(t + 1) * kstep;
            const char* a2 = last ? nA : cA + (size_t)(t + 2) * kstep; const char* b2 = last ? nB : cB + (size_t)(t + 2) * kstep;
            const char* a3 = a2 + kstep; const char* b3 = b2 + kstep;
            PG8_LDB(B0, 0, 0); PG8_LDB(B1, 0, 1); PG8_SCHED; PG8_LDA(At, 0, 0); PG8_STAGE_A(PG8_SA(1, 1), a1, 1);
            if (MODE == 1) { if (last && has_next) PG8_GATHER_LDS(vC); }
            PG8_WAIT_V(8); PG8_WAIT_L(0); PG8_BAR; PG8_MMA(0, 0, At, B0); PG8_MMA(0, 1, At, B1); PG8_BAR; PG8_SCHED;
            PG8_LDA(At, 0, 1); PG8_STAGE_B(PG8_SB(0, 0), b2); PG8_STAGE_B(PG8_SB(0, 1), b2 + hstepB); PG8_STAGE_A(PG8_SA(0, 0), a2, 0);
            PG8_WAIT_V(8); PG8_WAIT_L(0); PG8_BAR; PG8_MMA(1, 0, At, B0); PG8_MMA(1, 1, At, B1); PG8_BAR; PG8_SCHED;
            PG8_LDB(B0, 1, 0); PG8_LDB(B1, 1, 1); PG8_SCHED; PG8_LDA(At, 1, 0); PG8_STAGE_A(PG8_SA(0, 1), a2, 1);
            PG8_WAIT_V(8); PG8_WAIT_L(0); PG8_BAR; PG8_MMA(0, 0, At, B0); PG8_MMA(0, 1, At, B1); PG8_BAR; PG8_SCHED;
            PG8_LDA(At, 1, 1); PG8_STAGE_B(PG8_SB(1, 0), b3); PG8_STAGE_B(PG8_SB(1, 1), b3 + hstepB); PG8_STAGE_A(PG8_SA(1, 0), a3, 0);
            PG8_WAIT_V(8); PG8_WAIT_L(0); PG8_BAR; PG8_MMA(1, 0, At, B0); PG8_MMA(1, 1, At, B1); PG8_BAR; PG8_SCHED;
        }
        if (wr == 0) PG8_BAR;
        E(acc, cur, wr, wc, fr, fq);
        if (!has_next) break;
#pragma unroll
        for (int a = 0; a < 2; ++a)
#pragma unroll
            for (int b = 0; b < 2; ++b)
#pragma unroll
                for (int m = 0; m < 4; ++m)
#pragma unroll
                    for (int n = 0; n < 2; ++n) acc[a][b][m][n] = (f32x4){0.f, 0.f, 0.f, 0.f};
        cur = nxt; cA = nA; cB = nB; ++ui;
        if (wr == 1) PG8_BAR;
    }
    PG8_WAIT_V(0);
    PG8_BAR;
#undef PG8_SA
#undef PG8_SB
#undef PG8_STAGE_A
#undef PG8_STAGE_B
#undef PG8_LD8
#undef PG8_LDA
#undef PG8_LDB
#undef PG8_MMA
#undef PG8_WAIT_V
#undef PG8_WAIT_L
#undef PG8_BAR
#undef PG8_SCHED
#undef PG8_ABASE
#undef PG8_BBASE
#undef PG8_GATHER
#undef PG8_GATHER_DMA
#undef PG8_GATHER_LDS
}

struct EpiZ {
    static constexpr bool PERM = true;
    bf16_t* Z; bf16_t* Qc; bf16_t* Kc; bf16_t* Vc; const float* ropec; const float* ropes; bf16_t* GF;
    __device__ __forceinline__ void operator()(const f32x4 (&acc)[2][2][4][2], const Unit& u, int wr, int wc, int fr, int fq) const {
        const int row0 = u.pm * BM + wr * 64 + fr;
        if (u.pn < 4) {
            const float sc = (u.pn < 2) ? ATT_C2 : 1.0f;
            bf16_t* base = (u.pn < 2) ? Qc : Kc;
            const int dl = 16 * (wc & 1) + 4 * fq;
#pragma unroll
            for (int ai = 0; ai < 2; ++ai)
#pragma unroll
                for (int m = 0; m < 4; ++m) {
                    const int row = row0 + ai * HALF + m * 16; int b, t; bt_of(row, b, t);
                    const f32x4 c = *(const f32x4*)(ropec + t * 32 + dl) * sc, s = *(const f32x4*)(ropes + t * 32 + dl) * sc;
#pragma unroll
                    for (int bj = 0; bj < 2; ++bj) {
                        const int hm = 4 * (u.pn & 1) + 2 * bj + (wc >> 1);
                        const f32x4 x1 = acc[ai][bj][m][0], x2 = acc[ai][bj][m][1];
                        const f32x4 o1 = x1 * c - x2 * s, o2 = x2 * c + x1 * s;
                        bf16_t* p = base + ((size_t)(b * 8 + hm) * TT + t) * 64 + dl;
                        u32x2 w1, w2; w1.x = pkbf(o1[0], o1[1]); w1.y = pkbf(o1[2], o1[3]); w2.x = pkbf(o2[0], o2[1]); w2.y = pkbf(o2[2], o2[3]);
                        *(u32x2*)p = w1; *(u32x2*)(p + 32) = w2;
                    }
                }
        } else if (u.pn < 6) {
            const int e0 = wc * 32 + 8 * fq;
#pragma unroll
            for (int ai = 0; ai < 2; ++ai)
#pragma unroll
                for (int m = 0; m < 4; ++m) {
                    const int row = row0 + ai * HALF + m * 16; int b, t; bt_of(row, b, t);
#pragma unroll
                    for (int bj = 0; bj < 2; ++bj) { const int h = (u.pn - 4) * 2 + bj; const f32x4 v0 = acc[ai][bj][m][0], v1 = acc[ai][bj][m][1];
                        u32x4 w; w.x = pkbf(v0[0], v0[1]); w.y = pkbf(v0[2], v0[3]); w.z = pkbf(v1[0], v1[1]); w.w = pkbf(v1[2], v1[3]);
                        *(u32x4*)(Vc + ((size_t)(b * 4 + h) * TT + t) * 128 + e0) = w; }
                }
        } else if (u.pn < 14) {
            const int col0 = (u.pn - 6) * BM + wc * 32 + 8 * fq;
#pragma unroll
            for (int ai = 0; ai < 2; ++ai)
#pragma unroll
                for (int m = 0; m < 4; ++m) {
                    bf16_t* rowp = Z + (size_t)(row0 + ai * HALF + m * 16) * NZ + col0;
#pragma unroll
                    for (int bj = 0; bj < 2; ++bj) { const f32x4 v0 = acc[ai][bj][m][0], v1 = acc[ai][bj][m][1];
                        u32x4 w; w.x = pkbf(v0[0], v0[1]); w.y = pkbf(v0[2], v0[3]); w.z = pkbf(v1[0], v1[1]); w.w = pkbf(v1[2], v1[3]);
                        *(u32x4*)(rowp + bj * HALF) = w; }
                }
        } else if (u.pm < NREAL / BM) {
            const int gi = (u.pn - 14) >> 2, pn4 = (u.pn - 14) & 3;
            u32x4* gp = (u32x4*)GF + ((((size_t)(gi * (NREAL / BM) + u.pm) * 4 + pn4) * 8 + (wr * 4 + wc)) * 16) * 64 + (fq * 16 + fr);
#pragma unroll
            for (int ai = 0; ai < 2; ++ai)
#pragma unroll
                for (int bj = 0; bj < 2; ++bj)
#pragma unroll
                    for (int m = 0; m < 4; ++m) { const f32x4 v0 = acc[ai][bj][m][0], v1 = acc[ai][bj][m][1];
                        u32x4 w; w.x = pkbf(sigmoidf_(v0[0]), sigmoidf_(v0[1])); w.y = pkbf(sigmoidf_(v0[2]), sigmoidf_(v0[3])); w.z = pkbf(sigmoidf_(v1[0]), sigmoidf_(v1[1])); w.w = pkbf(sigmoidf_(v1[2]), sigmoidf_(v1[3]));
                        gp[((ai * 2 + bj) * 4 + m) * 64] = w; }
        }
    }
};
template <bool SECOND> struct EpiGate {
    static constexpr bool PERM = true;
    bf16_t* Z; bf16_t* TMP; bf16_t* MRG;
    __device__ __forceinline__ void operator()(const f32x4 (&acc)[2][2][4][2], const Unit& u, int wr, int wc, int fr, int fq) const {
        const int row0 = u.pm * BM + wr * 64 + fr, col0 = u.pn * BM + wc * 32 + 8 * fq;
#pragma unroll
        for (int ai = 0; ai < 2; ++ai)
#pragma unroll
            for (int m = 0; m < 4; ++m) {
                bf16_t* rowp = Z + (size_t)(row0 + ai * HALF + m * 16) * NZ + col0; bf16_t* tmpp = TMP + (size_t)(row0 + ai * HALF + m * 16) * DM + col0; bf16_t* mrgp = MRG + (size_t)(row0 + ai * HALF + m * 16) * DM + col0;
#pragma unroll
                for (int bj = 0; bj < 2; ++bj) {
                    const u32x4 gw = *(const u32x4*)(rowp + (SECOND ? ZGM : ZGA) + bj * HALF);
                    const f32x4 v0 = acc[ai][bj][m][0], v1 = acc[ai][bj][m][1];
                    float o[8];
                    o[0] = sigmoidf_(bflo(gw.x)) * v0[0]; o[1] = sigmoidf_(bfhi(gw.x)) * v0[1]; o[2] = sigmoidf_(bflo(gw.y)) * v0[2]; o[3] = sigmoidf_(bfhi(gw.y)) * v0[3];
                    o[4] = sigmoidf_(bflo(gw.z)) * v1[0]; o[5] = sigmoidf_(bfhi(gw.z)) * v1[1]; o[6] = sigmoidf_(bflo(gw.w)) * v1[2]; o[7] = sigmoidf_(bfhi(gw.w)) * v1[3];
                    if (SECOND) { const u32x4 tw = *(const u32x4*)(tmpp + bj * HALF);
                        o[0] += bflo(tw.x); o[1] += bfhi(tw.x); o[2] += bflo(tw.y); o[3] += bfhi(tw.y); o[4] += bflo(tw.z); o[5] += bfhi(tw.z); o[6] += bflo(tw.w); o[7] += bfhi(tw.w); }
                    u32x4 w; w.x = pkbf(o[0], o[1]); w.y = pkbf(o[2], o[3]); w.z = pkbf(o[4], o[5]); w.w = pkbf(o[6], o[7]);
                    if (SECOND) *(u32x4*)(mrgp + bj * HALF) = w; else *(u32x4*)(tmpp + bj * HALF) = w;
                }
            }
    }
};
struct EpiGateFused {
    static constexpr bool PERM = true;
    const bf16_t* GF; bf16_t* MRG;
    __device__ __forceinline__ void mid(f32x4 (&acc)[2][2][4][2], const Unit& u, int wr, int wc, int fr, int fq) const {
        asm volatile("" : "+v"(fr), "+v"(fq));
        const u32x4* ga = (const u32x4*)GF + ((((size_t)u.pm * 4 + u.pn) * 8 + (wr * 4 + wc)) * 16) * 64 + (fq * 16 + fr);
        const u32x4* gm = ga + (size_t)(NREAL / BM) * 4 * 8 * 16 * 64;
#pragma unroll
        for (int q = 0; q < 16; ++q) {
            const int ai = q >> 3, bj = (q >> 2) & 1, m = q & 3;
            const u32x4 a = ga[q * 64], b = gm[q * 64];
            float r[8];
#define EG_R(a_, m_) ((a_) * __builtin_amdgcn_rcpf(m_))
            r[0] = EG_R(bflo(a.x), bflo(b.x)); r[1] = EG_R(bfhi(a.x), bfhi(b.x)); r[2] = EG_R(bflo(a.y), bflo(b.y)); r[3] = EG_R(bfhi(a.y), bfhi(b.y));
            r[4] = EG_R(bflo(a.z), bflo(b.z)); r[5] = EG_R(bfhi(a.z), bfhi(b.z)); r[6] = EG_R(bflo(a.w), bflo(b.w)); r[7] = EG_R(bfhi(a.w), bfhi(b.w));
#undef EG_R
            acc[ai][bj][m][0] = acc[ai][bj][m][0] * (f32x4){r[0], r[1], r[2], r[3]}; acc[ai][bj][m][1] = acc[ai][bj][m][1] * (f32x4){r[4], r[5], r[6], r[7]};
            asm volatile("" : "+v"(acc[ai][bj][m][0]), "+v"(acc[ai][bj][m][1]));
            if ((q & 7) == 7) asm volatile("" ::: "memory");
        }
    }
    __device__ __forceinline__ void operator()(const f32x4 (&acc)[2][2][4][2], const Unit& u, int wr, int wc, int fr, int fq) const {
        const int row0 = u.pm * BM + wr * 64 + fr, col0 = u.pn * BM + wc * 32 + 8 * fq;
        const u32x4* gm = (const u32x4*)GF + (size_t)(NREAL / BM) * 4 * 8 * 16 * 64 + ((((size_t)u.pm * 4 + u.pn) * 8 + (wr * 4 + wc)) * 16) * 64 + (fq * 16 + fr);
#pragma unroll
        for (int ai = 0; ai < 2; ++ai)
#pragma unroll
            for (int m = 0; m < 4; ++m) {
                bf16_t* mrgp = MRG + (size_t)(row0 + ai * HALF + m * 16) * DM + col0;
#pragma unroll
                for (int bj = 0; bj < 2; ++bj) {
                    const u32x4 g = gm[((ai * 2 + bj) * 4 + m) * 64];
                    const f32x4 v0 = acc[ai][bj][m][0], v1 = acc[ai][bj][m][1];
                    u32x4 w; w.x = pkbf(bflo(g.x) * v0[0], bfhi(g.x) * v0[1]); w.y = pkbf(bflo(g.y) * v0[2], bfhi(g.y) * v0[3]);
                    w.z = pkbf(bflo(g.z) * v1[0], bfhi(g.z) * v1[1]); w.w = pkbf(bflo(g.w) * v1[2], bfhi(g.w) * v1[3]);
                    *(u32x4*)(mrgp + bj * HALF) = w;
                }
            }
    }
};
struct EpiStoreBf16 {
    static constexpr bool PERM = true;
    bf16_t* O; int ldc;
    __device__ __forceinline__ void operator()(const f32x4 (&acc)[2][2][4][2], const Unit& u, int wr, int wc, int fr, int fq) const {
        const int row0 = u.pm * BM + wr * 64 + fr, col0 = u.pn * BM + wc * 32 + 8 * fq;
#pragma unroll
        for (int ai = 0; ai < 2; ++ai)
#pragma unroll
            for (int m = 0; m < 4; ++m) { bf16_t* rowp = O + (size_t)(row0 + ai * HALF + m * 16) * ldc + col0;
#pragma unroll
                for (int bj = 0; bj < 2; ++bj) { const f32x4 v0 = acc[ai][bj][m][0], v1 = acc[ai][bj][m][1];
                    u32x4 w; w.x = pkbf(v0[0], v0[1]); w.y = pkbf(v0[2], v0[3]); w.z = pkbf(v1[0], v1[1]); w.w = pkbf(v1[2], v1[3]);
                    *(u32x4*)(rowp + bj * HALF) = w; } }
    }
};
struct EpiPre1 {
    static constexpr bool PERM = false;
    float* P1; const float* x; const float* meta; const float* stats; const float* g0; const float* b0;
    __device__ __forceinline__ void operator()(const f32x4 (&acc)[2][2][4][2], const Unit& u, int wr, int wc, int fr, int fq) const {
        const int row0 = u.pm * BM + wr * 64 + fr, col0 = u.pn * BM + wc * 32 + 4 * fq;
        f32x4 gv[2][2], bv[2][2];
#pragma unroll
        for (int bj = 0; bj < 2; ++bj)
#pragma unroll
            for (int n = 0; n < 2; ++n) { gv[bj][n] = *(const f32x4*)(g0 + col0 + bj * HALF + n * 16); bv[bj][n] = *(const f32x4*)(b0 + col0 + bj * HALF + n * 16); }
#pragma unroll
        for (int ai = 0; ai < 2; ++ai)
#pragma unroll
            for (int m = 0; m < 4; ++m) {
                const int row = row0 + ai * HALF + m * 16;
                const float* xr = x + (size_t)row * DM;
                const float mean = ld_agent_f(stats + 2 * row), rstd = ld_agent_f(stats + 2 * row + 1);
                float* orow = P1 + (size_t)row * (NZ / 2) + col0;
#pragma unroll
                for (int bj = 0; bj < 2; ++bj)
#pragma unroll
                    for (int n = 0; n < 2; ++n) { const f32x4 xv = *(const f32x4*)(xr + col0 + bj * HALF + n * 16);
                        const f32x4 hv = (xv - mean) * rstd * gv[bj][n] + bv[bj][n];
                        *(f32x4*)(orow + bj * HALF + n * 16) = hv * DN_ALPHA + acc[ai][bj][m][n]; }
            }
    }
};
struct EpiAct {
    static constexpr bool PERM = true;
    bf16_t* ACT; const float* b_gu; const int* tile_exp; int pm0; float ascale;
    __device__ __forceinline__ void operator()(const f32x4 (&acc)[2][2][4][2], const Unit& u, int wr, int wc, int fr, int fq) const {
        const int e = u.e;
        const int ac0 = u.pn * HALF + wc * 32 + 8 * fq;
        const float* bp = b_gu + (size_t)e * 2 * FF + 2 * ac0;
        f32x2 bg[4], bl[4];
#pragma unroll
        for (int q = 0; q < 4; ++q) { const f32x4 v0 = *(const f32x4*)(bp + 4 * q); bg[q] = (f32x2){v0[0], v0[2]}; bl[q] = (f32x2){v0[1], v0[3]}; }
        const int row0 = u.pm * BM + wr * 64 + fr;
#pragma unroll
        for (int ai = 0; ai < 2; ++ai)
#pragma unroll
            for (int m = 0; m < 4; ++m) {
                float o[8];
#pragma unroll
                for (int q = 0; q < 4; ++q) {
                    const f32x4 ag = acc[ai][0][m][q >> 1], al = acc[ai][1][m][q >> 1];
                    f32x2 gl = (f32x2){ag[2 * (q & 1)], ag[2 * (q & 1) + 1]} * ascale + bg[q], li = (f32x2){al[2 * (q & 1)], al[2 * (q & 1) + 1]} * ascale + bl[q];
                    gl = (f32x2){fminf(gl[0], 7.0f), fminf(gl[1], 7.0f)}; li = (f32x2){fminf(fmaxf(li[0], -7.0f), 7.0f), fminf(fmaxf(li[1], -7.0f), 7.0f)};
                    const f32x2 tt = gl * (-1.702f * 1.4426950408889634f);
                    const f32x2 den = (f32x2){__builtin_amdgcn_exp2f(tt[0]), __builtin_amdgcn_exp2f(tt[1])} + 1.0f;
                    const f32x2 sg = (f32x2){__builtin_amdgcn_rcpf(den[0]), __builtin_amdgcn_rcpf(den[1])};
                    const f32x2 r = (gl * sg) * (li + 1.0f);
                    o[2 * q] = r[0]; o[2 * q + 1] = r[1];
                }
                u32x4 w; w.x = pkbf(o[0], o[1]); w.y = pkbf(o[2], o[3]); w.z = pkbf(o[4], o[5]); w.w = pkbf(o[6], o[7]);
                *(u32x4*)(ACT + (size_t)(row0 + ai * HALF + m * 16) * FF + ac0) = w;
            }
    }
};
struct EpiDown {
    static constexpr bool PERM = true;
    bf16_t* Y; const float* b_down; const int* tile_exp; const int* row_slot; const float* row_gate; int pm0;
    __device__ __forceinline__ void operator()(const f32x4 (&acc)[2][2][4][2], const Unit& u, int wr, int wc, int fr, int fq) const {
        const int e = u.e;
        const int col0 = u.pn * BM + wc * 32 + 8 * fq;
        f32x4 bv[2][2];
#pragma unroll
        for (int bj = 0; bj < 2; ++bj)
#pragma unroll
            for (int n = 0; n < 2; ++n) bv[bj][n] = *(const f32x4*)(b_down + (size_t)e * DM + col0 + bj * HALF + 4 * n);
        const int r0 = (pm0 + u.pm) * BM + wr * 64 + fr;
#pragma unroll
        for (int ai = 0; ai < 2; ++ai)
#pragma unroll
            for (int m = 0; m < 4; ++m) {
                const int r = r0 + ai * HALF + m * 16;
                const int slot = row_slot[r]; const float gt = row_gate[r];
                bf16_t* rowp = Y + (size_t)slot * DM + col0;
#pragma unroll
                for (int bj = 0; bj < 2; ++bj) { const f32x4 v0 = (acc[ai][bj][m][0] + bv[bj][0]) * gt, v1 = (acc[ai][bj][m][1] + bv[bj][1]) * gt;
                    u32x4 w; w.x = pkbf(v0[0], v0[1]); w.y = pkbf(v0[2], v0[3]); w.z = pkbf(v1[0], v1[1]); w.w = pkbf(v1[2], v1[3]);
                    *(u32x4*)(rowp + bj * HALF) = w; }
            }
    }
};
}

namespace attn_body {
using bf16 = __hip_bfloat16;
using s16x4 = __attribute__((ext_vector_type(4))) short;
using f32x16 = __attribute__((ext_vector_type(16))) float;
constexpr int D = 64, PZ = 64, PV = 128, PO = 1024;
constexpr int NW = 8, QBLK = 32, QB = QBLK * NW, KVBLK = 64;
__device__ __forceinline__ int crow(int r, int hi) { return (r & 3) + 8 * (r >> 2) + 4 * hi; }
#define SBAR() __builtin_amdgcn_sched_barrier(0)
__device__ __forceinline__ void cmask(f32x16& p0, f32x16& p1, int jb, int qrel, int hi) {
    const float NEG = -INFINITY; const int d = qrel - 64 * jb - 4 * hi;
#pragma unroll
    for (int r = 0; r < 16; ++r) { const int c = (r & 3) + 8 * (r >> 2); if (c > d) p0[r] = NEG; if (c + 32 > d) p1[r] = NEG; }
}
constexpr int NSLOT = 3, SLOTB = 8192;
constexpr int LDS_K = 0, LDS_V = NSLOT * SLOTB, LDS_WS = 2 * NSLOT * SLOTB, LDS_OST = LDS_WS + NW * 64 * 4, LDS_BYTES_A = LDS_OST + NW * 4096;
__device__ __forceinline__ void glds16(const void* gsrc, unsigned lds_dst) { unsigned keep;
    asm volatile("s_mov_b32 %0, m0\n\ts_mov_b32 m0, %2\n\ts_nop 0\n\tglobal_load_lds_dwordx4 %1, off\n\ts_mov_b32 m0, %0" : "=&s"(keep) : "v"(gsrc), "s"(lds_dst) : "memory"); }
__device__ __forceinline__ float max3f(float a, float b, float c) { float r; asm("v_max3_f32 %0, %1, %2, %3" : "=v"(r) : "v"(a), "v"(b), "v"(c)); return r; }
__device__ __forceinline__ float max2f(float a, float b) { float r; asm("v_max_f32_e32 %0, %1, %2" : "=v"(r) : "v"(a), "v"(b)); return r; }
__device__ __forceinline__ float fadd_s(float a, float b) { float r; asm("v_add_f32_e32 %0, %1, %2" : "=v"(r) : "v"(a), "v"(b)); return r; }
__device__ __forceinline__ float fsub_s(float a, float b) { float r; asm("v_sub_f32_e32 %0, %1, %2" : "=v"(r) : "v"(a), "v"(b)); return r; }
__device__ __forceinline__ unsigned cvtpk_s(float lo, float hi) { return pkbf(lo, hi); }
#define WAIT_BAR(N) asm volatile("s_waitcnt vmcnt(" #N ") lgkmcnt(0)\n\ts_barrier" ::: "memory")
__device__ __forceinline__ void qkt(f32x16& p0, f32x16& p1, const char* Kslot, const bf16x8* qr, const f32x16& negm, int r32, int hi) {
    const char* kb = Kslot + hi * 1024 + r32 * 16;
#pragma unroll
    for (int d0 = 0; d0 < 4; ++d0) {
        const bf16x8 b0 = *reinterpret_cast<const bf16x8*>(kb + d0 * 2048);
        const bf16x8 b1 = *reinterpret_cast<const bf16x8*>(kb + d0 * 2048 + 512);
        if (d0 == 0) { p0 = __builtin_amdgcn_mfma_f32_32x32x16_bf16(b0, qr[0], negm, 0, 0, 0); p1 = __builtin_amdgcn_mfma_f32_32x32x16_bf16(b1, qr[0], negm, 0, 0, 0); }
        else { p0 = __builtin_amdgcn_mfma_f32_32x32x16_bf16(b0, qr[d0], p0, 0, 0, 0); p1 = __builtin_amdgcn_mfma_f32_32x32x16_bf16(b1, qr[d0], p1, 0, 0, 0); } }
}
typedef __attribute__((address_space(3))) const char* lds_cptr;
typedef short v4i16_t __attribute__((ext_vector_type(4)));
__device__ __forceinline__ void kload8(bf16x8* kf, lds_cptr kp) {
    kf[0] = *(const __attribute__((address_space(3))) bf16x8*)(kp);        kf[1] = *(const __attribute__((address_space(3))) bf16x8*)(kp + 512);
    kf[2] = *(const __attribute__((address_space(3))) bf16x8*)(kp + 2048); kf[3] = *(const __attribute__((address_space(3))) bf16x8*)(kp + 2560);
    kf[4] = *(const __attribute__((address_space(3))) bf16x8*)(kp + 4096); kf[5] = *(const __attribute__((address_space(3))) bf16x8*)(kp + 4608);
    kf[6] = *(const __attribute__((address_space(3))) bf16x8*)(kp + 6144); kf[7] = *(const __attribute__((address_space(3))) bf16x8*)(kp + 6656);
}
__device__ __forceinline__ void kload2(bf16x8* kf, lds_cptr kp, int j) { kf[2 * j] = *(const __attribute__((address_space(3))) bf16x8*)(kp + j * 2048); kf[2 * j + 1] = *(const __attribute__((address_space(3))) bf16x8*)(kp + j * 2048 + 512); }
__device__ __forceinline__ s16x4 vtr(lds_cptr p) { return __builtin_bit_cast(s16x4, __builtin_amdgcn_ds_read_tr16_b64_v4i16((__attribute__((address_space(3))) v4i16_t*)p)); }
__device__ __forceinline__ float rowmax(const f32x16& p0, const f32x16& p1) {
    float a = max3f(p0[0], p0[1], p1[0]), b = max3f(p0[2], p0[3], p1[1]); a = max3f(a, p1[2], p1[3]);
#pragma unroll
    for (int r = 4; r < 16; r += 4) { a = max3f(a, p0[r], p0[r + 1]); b = max3f(b, p0[r + 2], p0[r + 3]); a = max3f(a, p1[r], p1[r + 1]); b = max3f(b, p1[r + 2], p1[r + 3]); }
    const float m = max2f(a, b);
    auto rr = __builtin_amdgcn_permlane32_swap(__float_as_uint(m), __float_as_uint(m), false, false);
    return max2f(__uint_as_float(rr[0]), __uint_as_float(rr[1]));
}
__device__ __forceinline__ void pv(f32x16* o, int vb, bf16x8 pa0, bf16x8 pa1, bf16x8 pa2, bf16x8 pa3) {
#pragma unroll
    for (int d0 = 0; d0 < 2; ++d0) { s16x4 lo[4], hi[4];
#pragma unroll
        for (int ks = 0; ks < 4; ++ks) {
            asm volatile("ds_read_b64_tr_b16 %0,%1 offset:%c2" : "=&v"(lo[ks]) : "v"(vb), "i"(d0 * 4096 + ks * 1024) : "memory");
            asm volatile("ds_read_b64_tr_b16 %0,%1 offset:%c2" : "=&v"(hi[ks]) : "v"(vb), "i"(d0 * 4096 + ks * 1024 + 512) : "memory"); }
        asm volatile("s_waitcnt lgkmcnt(0)" ::: "memory"); SBAR();
#define PK(k) (bf16x8){lo[k][0], lo[k][1], lo[k][2], lo[k][3], hi[k][0], hi[k][1], hi[k][2], hi[k][3]}
        o[d0] = __builtin_amdgcn_mfma_f32_32x32x16_bf16(pa0, PK(0), o[d0], 0, 0, 0);
        o[d0] = __builtin_amdgcn_mfma_f32_32x32x16_bf16(pa1, PK(1), o[d0], 0, 0, 0);
        o[d0] = __builtin_amdgcn_mfma_f32_32x32x16_bf16(pa2, PK(2), o[d0], 0, 0, 0);
        o[d0] = __builtin_amdgcn_mfma_f32_32x32x16_bf16(pa3, PK(3), o[d0], 0, 0, 0);
#undef PK
    }
}
#define ATTN_STORE16(p, v) (*(u32x4*)(p) = (v))
template <int THRL> __device__ __forceinline__ void attn_unit(int qb, const bf16* Qh, const bf16* __restrict__ Kh, const bf16* __restrict__ Vh, bf16* Oh, char* shm) {
    const int tid = threadIdx.x; int lane = tid & 63; asm volatile("" : "+v"(lane));
    const int r32 = lane & 31, hi = lane >> 5; const int wid = __builtin_amdgcn_readfirstlane(tid >> 6);
    const int q0 = qb * QB;
    const bf16* Qw = Qh + (long)(q0 + wid * QBLK) * PZ;
    const unsigned lds0 = (unsigned)(uintptr_t)shm;
    float* wsf = (float*)(shm + LDS_WS) + wid * 64;
    const bf16* ksrc = Kh + (long)lane * PZ + wid * 8;
    const bf16* vsrc = Vh + (long)(16 * (wid & 3) + (lane >> 2)) * PV + (wid >> 2) * 32 + (lane & 3) * 8;
    const unsigned kdst = lds0 + LDS_K + wid * 1024, vdst = lds0 + LDS_V + wid * 1024;
#define DMA_K(t, slot) glds16(ksrc + (long)(t) * KVBLK * PZ, (unsigned)__builtin_amdgcn_readfirstlane(kdst + (slot)))
#define DMA_V(t, slot) glds16(vsrc + (long)(t) * KVBLK * PV, (unsigned)__builtin_amdgcn_readfirstlane(vdst + (slot)))
    const int vb0 = (int)(lds0 + LDS_V) + ((lane >> 4) & 1) * 32 + (lane & 3) * 8 + (4 * hi + ((lane & 15) >> 2)) * 64;
    const char* Kbase = shm + LDS_K; bf16x8 kf[8];
    const lds_cptr shm3 = (lds_cptr)shm; const lds_cptr kp0 = shm3 + LDS_K + hi * 1024 + r32 * 16; const lds_cptr vp0 = shm3 + LDS_V + ((lane >> 4) & 1) * 32 + (lane & 3) * 8 + (4 * hi + ((lane & 15) >> 2)) * 64;
    const int NT = (q0 + QB) / KVBLK;
    DMA_K(0, 0); DMA_V(0, 0); DMA_K(1, SLOTB);
    bf16x8 qr[4];
#pragma unroll
    for (int d0 = 0; d0 < 4; ++d0) qr[d0] = *reinterpret_cast<const bf16x8*>(&Qw[(long)r32 * PZ + d0 * 16 + hi * 8]);
    float mhat = 0.f, l_reg = 0.f; f32x16 o[2]; o[0] = f32x16{}; o[1] = f32x16{}; f32x16 negm = f32x16{}; asm volatile("" : "+v"(negm));
    const int qrel = wid * QBLK + r32;
#define CMASK(P0, P1, t) do { int jb_ = (t) - (NT - 4); if (jb_ >= 0) cmask(P0, P1, jb_, qrel, hi); } while (0)
    bool resc = false;
#define START(P0, P1) do { const float rm = rowmax(P0, P1); resc = false; \
    { const float dl = rm; mhat = fadd_s(mhat, dl); \
      _Pragma("unroll") for (int r = 0; r < 16; ++r) { P0[r] = fsub_s(P0[r], dl); P1[r] = fsub_s(P1[r], dl); } \
      _Pragma("unroll") for (int r = 0; r < 16; ++r) negm[r] = -mhat; asm volatile("" : "+v"(negm)); } \
    _Pragma("unroll") for (int r = 0; r < 16; ++r) P0[r] = __builtin_amdgcn_exp2f(P0[r]); } while (0)
#define RESC() do { if (resc) { asm volatile("s_waitcnt lgkmcnt(0)" ::: "memory"); \
      _Pragma("unroll") for (int d_ = 0; d_ < 2; ++d_) _Pragma("unroll") for (int r = 0; r < 16; ++r) o[d_][r] *= wsf[crow(r, hi)]; } } while (0)
    f32x16 pA0, pA1, pB0, pB1;
    int sl_prev = 0, sl_cur = 0, sl_next = SLOTB;
#define ROT() do { sl_prev = sl_cur; sl_cur = sl_next; sl_next = (sl_next == (NSLOT - 1) * SLOTB) ? 0 : sl_next + SLOTB; } while (0)
    DMA_K(2, 2 * SLOTB);
    WAIT_BAR(3);
    qkt(pA0, pA1, Kbase, qr, negm, r32, hi); asm volatile("s_nop 15\n\ts_nop 7" : "+v"(pA0), "+v"(pA1)); CMASK(pA0, pA1, 0);
    START(pA0, pA1);
    _Pragma("unroll") for (int r = 0; r < 16; ++r) pA1[r] = __builtin_amdgcn_exp2f(pA1[r]);
    WAIT_BAR(0);
    DMA_K(3, 0); DMA_V(1, SLOTB);
    ROT();
    kload8(kf, kp0 + sl_cur);
    WAIT_BAR(2);
    s16x4 vlo[8], vhi[8]; u32x4 pw0, pw1, pw2, pw3;
#define PKW(P, B) cvtpk_s(P[B], P[B + 1])
#define PAF(k) __builtin_bit_cast(bf16x8, pw##k)
#define VFR(i) (bf16x8){vlo[i][0], vlo[i][1], vlo[i][2], vlo[i][3], vhi[i][0], vhi[i][1], vhi[i][2], vhi[i][3]}
#define PIN(x) asm volatile("" : "+v"(x))
#define MX3(a, b, c) __builtin_fmaxf(__builtin_fmaxf((a), (b)), (c))
#define GAPA(MF, A0, A1, A2, A3, W0, W1, PW) do { MF; sacc += A0; sacc += A1; sacc += A2; sacc += A3; PIN(sacc); W0; W1; PIN(PW); SBAR(); } while (0)
#define EX(v) __builtin_amdgcn_exp2f(v)
#define GAPB(MF, X, B) do { MF; X[B] = EX(X[B]); X[B + 1] = EX(X[B + 1]); X[B + 2] = EX(X[B + 2]); X[B + 3] = EX(X[B + 3]); PIN(X); SBAR(); } while (0)
#define VRD(i) do { vlo[i] = vtr(vp_ + (((i) >> 2) * 4096 + ((i) & 3) * 1024)); vhi[i] = vtr(vp_ + (((i) >> 2) * 4096 + ((i) & 3) * 1024 + 512)); } while (0)
#define KRD(G, j) do { if (G) { kload2(kf, kp0 + sl_next, j); SBAR(); } } while (0)
#define STEP(C0, C1, P0, P1, t, GK, GV, GL) do { SBAR(); \
    const lds_cptr vp_ = vp0 + sl_prev; \
    VRD(0); SBAR(); float sacc = (P0[0] + P0[1]); \
    GAPA(C0 = __builtin_amdgcn_mfma_f32_32x32x16_bf16(kf[0], qr[0], negm, 0, 0, 0), P0[2], P0[3], P0[4], P0[5],     pw0[0] = PKW(P0, 0), pw0[1] = PKW(P0, 2), pw0); \
    VRD(4); SBAR(); GAPA(C1 = __builtin_amdgcn_mfma_f32_32x32x16_bf16(kf[1], qr[0], negm, 0, 0, 0), P0[6], P0[7], P0[8], P0[9],     pw0[2] = PKW(P0, 4), pw0[3] = PKW(P0, 6), pw0); \
    VRD(1); SBAR(); GAPA(C0 = __builtin_amdgcn_mfma_f32_32x32x16_bf16(kf[2], qr[1], C0, 0, 0, 0),   P0[10], P0[11], P0[12], P0[13], pw1[0] = PKW(P0, 8), pw1[1] = PKW(P0, 10), pw1); \
    VRD(5); SBAR(); GAPA(C1 = __builtin_amdgcn_mfma_f32_32x32x16_bf16(kf[3], qr[1], C1, 0, 0, 0),   P0[14], P0[15], P1[0], P1[1],   pw1[2] = PKW(P0, 12), pw1[3] = PKW(P0, 14), pw1); \
    VRD(2); SBAR(); GAPA(C0 = __builtin_amdgcn_mfma_f32_32x32x16_bf16(kf[4], qr[2], C0, 0, 0, 0),   P1[2], P1[3], P1[4], P1[5],     pw2[0] = PKW(P1, 0), pw2[1] = PKW(P1, 2), pw2); \
    VRD(6); SBAR(); GAPA(C1 = __builtin_amdgcn_mfma_f32_32x32x16_bf16(kf[5], qr[2], C1, 0, 0, 0),   P1[6], P1[7], P1[8], P1[9],     pw2[2] = PKW(P1, 4), pw2[3] = PKW(P1, 6), pw2); \
    VRD(3); SBAR(); GAPA(C0 = __builtin_amdgcn_mfma_f32_32x32x16_bf16(kf[6], qr[3], C0, 0, 0, 0),   P1[10], P1[11], P1[12], P1[13], pw3[0] = PKW(P1, 8), pw3[1] = PKW(P1, 10), pw3); \
    VRD(7); SBAR(); GAPA(C1 = __builtin_amdgcn_mfma_f32_32x32x16_bf16(kf[7], qr[3], C1, 0, 0, 0),   P1[14], P1[15], 0.f, 0.f,       pw3[2] = PKW(P1, 12), pw3[3] = PKW(P1, 14), pw3); \
    l_reg += sacc; \
    if (GK) { DMA_K((t) + 3, sl_cur); } if (GV) { DMA_V((t) + 1, sl_next); } \
    CMASK(C0, C1, t); \
    { float a = MX3(C0[0], C0[1], C1[0]), b = MX3(C0[2], C0[3], C1[1]); a = MX3(a, C1[2], C1[3]); \
      _Pragma("unroll") for (int r = 4; r < 16; r += 4) { a = MX3(a, C0[r], C0[r + 1]); b = MX3(b, C0[r + 2], C0[r + 3]); a = MX3(a, C1[r], C1[r + 1]); b = MX3(b, C1[r + 2], C1[r + 3]); } \
      float rm = __builtin_fmaxf(a, b); { auto rr = __builtin_amdgcn_permlane32_swap(__float_as_uint(rm), __float_as_uint(rm), false, false); rm = __builtin_fmaxf(__uint_as_float(rr[0]), __uint_as_float(rr[1])); } \
      resc = false; \
      if (__builtin_expect(__any(rm > (float)THRL), 0)) { const float dl = __builtin_fmaxf(rm, 0.f); mhat += dl; \
        _Pragma("unroll") for (int r = 0; r < 16; ++r) { C0[r] -= dl; C1[r] -= dl; } \
        _Pragma("unroll") for (int r = 0; r < 16; ++r) negm[r] = -mhat; asm volatile("" : "+v"(negm)); \
        const float f = __builtin_amdgcn_exp2f(-dl); l_reg *= f; if (hi == 0) wsf[r32] = f; resc = true; } } \
    SBAR(); \
    GAPB(o[0] = __builtin_amdgcn_mfma_f32_32x32x16_bf16(PAF(0), VFR(0), o[0], 0, 0, 0), C0, 0); \
    GAPB(o[1] = __builtin_amdgcn_mfma_f32_32x32x16_bf16(PAF(0), VFR(4), o[1], 0, 0, 0), C0, 4); \
    KRD(GL, 0); GAPB(o[0] = __builtin_amdgcn_mfma_f32_32x32x16_bf16(PAF(1), VFR(1), o[0], 0, 0, 0), C0, 8); \
    KRD(GL, 1); GAPB(o[1] = __builtin_amdgcn_mfma_f32_32x32x16_bf16(PAF(1), VFR(5), o[1], 0, 0, 0), C0, 12); \
    KRD(GL, 2); GAPB(o[0] = __builtin_amdgcn_mfma_f32_32x32x16_bf16(PAF(2), VFR(2), o[0], 0, 0, 0), C1, 0); \
    KRD(GL, 3); GAPB(o[1] = __builtin_amdgcn_mfma_f32_32x32x16_bf16(PAF(2), VFR(6), o[1], 0, 0, 0), C1, 4); \
    GAPB(o[0] = __builtin_amdgcn_mfma_f32_32x32x16_bf16(PAF(3), VFR(3), o[0], 0, 0, 0), C1, 8); \
    GAPB(o[1] = __builtin_amdgcn_mfma_f32_32x32x16_bf16(PAF(3), VFR(7), o[1], 0, 0, 0), C1, 12); \
    } while (0)
    int t = 1;
#undef CMASK
#define CMASK(P0, P1, t) do {} while (0)
    for (; t + 5 < NT; t += 2) {
        STEP(pB0, pB1, pA0, pA1, t, true, true, true);     WAIT_BAR(2); RESC(); ROT();
        STEP(pA0, pA1, pB0, pB1, t + 1, true, true, true); WAIT_BAR(2); RESC(); ROT();
    }
#undef CMASK
#define CMASK(P0, P1, t) do { int jb_ = (t) - (NT - 4); if (jb_ >= 0) cmask(P0, P1, jb_, qrel, hi); } while (0)
#define ENDW(tt) do { if ((tt) + 3 < NT) { WAIT_BAR(2); } else if ((tt) + 2 < NT) { WAIT_BAR(1); } else { WAIT_BAR(0); } } while (0)
    for (; t + 1 < NT; t += 2) {
        STEP(pB0, pB1, pA0, pA1, t, (t + 3 < NT), (t + 1 < NT), (t + 1 < NT));       ENDW(t);     RESC(); ROT();
        STEP(pA0, pA1, pB0, pB1, t + 1, (t + 4 < NT), (t + 2 < NT), (t + 2 < NT));   ENDW(t + 1); RESC(); ROT();
    }
    STEP(pB0, pB1, pA0, pA1, NT - 1, false, false, false); RESC();
    { float sacc = pB0[0] + pB0[1]; _Pragma("unroll") for (int r = 2; r < 16; ++r) sacc += pB0[r]; _Pragma("unroll") for (int r = 0; r < 16; ++r) sacc += pB1[r]; l_reg += sacc;
      pw0 = (u32x4){PKW(pB0, 0), PKW(pB0, 2), PKW(pB0, 4), PKW(pB0, 6)}; pw1 = (u32x4){PKW(pB0, 8), PKW(pB0, 10), PKW(pB0, 12), PKW(pB0, 14)}; pw2 = (u32x4){PKW(pB1, 0), PKW(pB1, 2), PKW(pB1, 4), PKW(pB1, 6)}; pw3 = (u32x4){PKW(pB1, 8), PKW(pB1, 10), PKW(pB1, 12), PKW(pB1, 14)};
      SBAR(); pv(o, vb0 + sl_cur, PAF(0), PAF(1), PAF(2), PAF(3)); }
#undef PKW
#undef PAF
#undef VFR
#undef PIN
#undef MX3
#undef GAPA
#undef GAPB
#undef EX
#undef VRD
#undef KRD
#undef STEP
#undef ENDW
    { auto rr = __builtin_amdgcn_permlane32_swap(__float_as_uint(l_reg), __float_as_uint(l_reg), false, false); l_reg = __uint_as_float(rr[0]) + __uint_as_float(rr[1]); }
    int lane2 = lane; asm volatile("" : "+v"(lane2));
    const int r32e = lane2 & 31, hie = lane2 >> 5;
    if (hie == 0) wsf[32 + r32e] = l_reg; asm volatile("s_waitcnt lgkmcnt(0)" ::: "memory");
    float rli[16];
#pragma unroll
    for (int r = 0; r < 16; ++r) rli[r] = __builtin_amdgcn_rcpf(wsf[32 + crow(r, hie)]);
    bf16* Ow = Oh + (long)(q0 + wid * QBLK) * PO;
    { bf16* stg = (bf16*)(shm + LDS_OST) + wid * 2048;
#pragma unroll
      for (int r = 0; r < 16; ++r) { const int orow = crow(r, hie);
#pragma unroll
        for (int d0 = 0; d0 < 2; ++d0) stg[orow * 64 + d0 * 32 + r32e] = __float2bfloat16(o[d0][r] * rli[r]); }
      asm volatile("s_waitcnt lgkmcnt(0)" ::: "memory");
#pragma unroll
      for (int i = 0; i < 4; ++i) { const int row = i * 8 + (lane2 >> 3), ch = lane2 & 7; const u32x4 v = *(const u32x4*)(stg + row * 64 + ch * 8); ATTN_STORE16(Ow + (long)row * PO + ch * 8, v); } }
    asm volatile("s_waitcnt lgkmcnt(0)\n\ts_barrier" ::: "memory");
#undef DMA_K
#undef DMA_V
#undef CMASK
#undef START
#undef RESC
#undef ROT
}

constexpr int A2_SLOT = 24576, A2_K = 0, A2_V = 8192, A2_WS = 4 * A2_SLOT, A2_OST = 0, A2_BYTES = A2_WS + NW * 256;
template <int THRL> __device__ __forceinline__ void attn2_unit(int qb, const bf16* Qh, const bf16* __restrict__ Kh, const bf16* __restrict__ Vh, bf16* Oh, char* shm, unsigned* prb = nullptr) {
    const int tid = threadIdx.x; int lane = tid & 63; asm volatile("" : "+v"(lane));
    const int r32 = lane & 31, hi = lane >> 5; const int wid = __builtin_amdgcn_readfirstlane(tid >> 6);
    const int q0 = qb * QB;
    const bf16* Qw = Qh + (long)(q0 + wid * QBLK) * PZ;
    const unsigned lds0 = (unsigned)(uintptr_t)shm;
    float* wsf = (float*)(shm + A2_WS) + wid * 64;
    bf16x8 qr[4];
#pragma unroll
    for (int d0 = 0; d0 < 4; ++d0) qr[d0] = *reinterpret_cast<const bf16x8*>(&Qw[(long)r32 * PZ + d0 * 16 + hi * 8]);
    const bf16* ksrc = Kh + (long)lane * PZ + wid * 8;
    const bf16* vsrc = Vh + (long)(16 * (wid & 3) + (lane >> 2)) * PV + (wid >> 2) * 32 + (lane & 3) * 8;
    const unsigned kdst = lds0 + A2_K + wid * 1024, vdst = lds0 + A2_V + wid * 1024;
#define A2_DMA(t, sl) do { glds16(ksrc + (long)(t) * KVBLK * PZ, (unsigned)__builtin_amdgcn_readfirstlane(kdst + (sl) * A2_SLOT)); \
        glds16(vsrc + (long)(t) * KVBLK * PV, (unsigned)__builtin_amdgcn_readfirstlane(vdst + (sl) * A2_SLOT)); \
        glds16(vsrc + (long)(t) * KVBLK * PV + 64, (unsigned)__builtin_amdgcn_readfirstlane(vdst + (sl) * A2_SLOT + 8192)); } while (0)
#define A2_WAITB(n1, n2) do { if (n2) asm volatile("s_waitcnt vmcnt(6)\n\ts_barrier" ::: "memory"); else if (n1) asm volatile("s_waitcnt vmcnt(3)\n\ts_barrier" ::: "memory"); else asm volatile("s_waitcnt vmcnt(0)\n\ts_barrier" ::: "memory"); } while (0)
    const int NT = (q0 + QB) / KVBLK;
    A2_DMA(0, 0); A2_DMA(1, 1); A2_DMA(2, 2);
    asm volatile("" : "+v"(qr[0]), "+v"(qr[1]), "+v"(qr[2]), "+v"(qr[3]));
    const lds_cptr shm3 = (lds_cptr)shm;
    const lds_cptr kp0 = shm3 + A2_K + hi * 1024 + r32 * 16;
    const lds_cptr vp0 = shm3 + A2_V + ((lane >> 4) & 1) * 32 + (lane & 3) * 8 + (4 * hi + ((lane & 15) >> 2)) * 64;
    float mhat = 0.f, l_reg = 0.f; f32x16 o[4]; o[0] = f32x16{}; o[1] = f32x16{}; o[2] = f32x16{}; o[3] = f32x16{}; f32x16 negm = f32x16{};
    const int qrel = wid * QBLK + r32;
#if MK_PROBE
    const unsigned long long pt0 = __builtin_amdgcn_s_memrealtime();
#endif
    for (int t = 0; t < NT; ++t) {
        A2_WAITB(t + 1 < NT, t + 2 < NT);
        if (t + 3 < NT) A2_DMA(t + 3, (t + 3) & 3);
        const int slot = t & 3;
        const lds_cptr kp = kp0 + slot * A2_SLOT; const lds_cptr vp = vp0 + slot * A2_SLOT;
        f32x16 p0, p1;
        {   bf16x8 kb[8];
#pragma unroll
            for (int d0 = 0; d0 < 4; ++d0) { kb[2 * d0] = *(const __attribute__((address_space(3))) bf16x8*)(kp + d0 * 2048); kb[2 * d0 + 1] = *(const __attribute__((address_space(3))) bf16x8*)(kp + d0 * 2048 + 512); }
            __builtin_amdgcn_sched_barrier(0);
            p0 = __builtin_amdgcn_mfma_f32_32x32x16_bf16(kb[0], qr[0], negm, 0, 0, 0); p1 = __builtin_amdgcn_mfma_f32_32x32x16_bf16(kb[1], qr[0], negm, 0, 0, 0);
#pragma unroll
            for (int d0 = 1; d0 < 4; ++d0) { p0 = __builtin_amdgcn_mfma_f32_32x32x16_bf16(kb[2 * d0], qr[d0], p0, 0, 0, 0); p1 = __builtin_amdgcn_mfma_f32_32x32x16_bf16(kb[2 * d0 + 1], qr[d0], p1, 0, 0, 0); }
        }
        { const int jb = t - (NT - 4); if (jb >= 0) cmask(p0, p1, jb, qrel, hi); }
        float rm;
        { float a = fmaxf(fmaxf(p0[0], p0[1]), p1[0]), b = fmaxf(fmaxf(p0[2], p0[3]), p1[1]); a = fmaxf(fmaxf(a, p1[2]), p1[3]);
#pragma unroll
          for (int r = 4; r < 16; r += 4) { a = fmaxf(fmaxf(a, p0[r]), p0[r + 1]); b = fmaxf(fmaxf(b, p0[r + 2]), p0[r + 3]); a = fmaxf(fmaxf(a, p1[r]), p1[r + 1]); b = fmaxf(fmaxf(b, p1[r + 2]), p1[r + 3]); }
          rm = fmaxf(a, b); auto rr = __builtin_amdgcn_permlane32_swap(__float_as_uint(rm), __float_as_uint(rm), false, false); rm = fmaxf(__uint_as_float(rr[0]), __uint_as_float(rr[1])); }
        if (t == 0 || __any(rm > (float)THRL)) {
            const float dl = (t == 0) ? rm : fmaxf(rm, 0.f); mhat += dl;
#pragma unroll
            for (int r = 0; r < 16; ++r) { p0[r] -= dl; p1[r] -= dl; negm[r] = -mhat; }
            const float f = __builtin_amdgcn_exp2f(-dl); l_reg *= f;
            if (t > 0) {
                if (hi == 0) wsf[r32] = f;
                asm volatile("s_waitcnt lgkmcnt(0)" ::: "memory");
#pragma unroll
                for (int r = 0; r < 16; ++r) { const float fr_ = wsf[crow(r, hi)];
#pragma unroll
                    for (int d_ = 0; d_ < 4; ++d_) o[d_][r] *= fr_; }
                asm volatile("s_waitcnt lgkmcnt(0)" ::: "memory");
            }
        }
        float sacc = 0.f;
#pragma unroll
        for (int r = 0; r < 16; ++r) { p0[r] = __builtin_amdgcn_exp2f(p0[r]); p1[r] = __builtin_amdgcn_exp2f(p1[r]); sacc += p0[r] + p1[r]; }
        l_reg += sacc;
        u32x4 pw[4];
        pw[0] = (u32x4){pkbf(p0[0], p0[1]), pkbf(p0[2], p0[3]), pkbf(p0[4], p0[5]), pkbf(p0[6], p0[7])};
        pw[1] = (u32x4){pkbf(p0[8], p0[9]), pkbf(p0[10], p0[11]), pkbf(p0[12], p0[13]), pkbf(p0[14], p0[15])};
        pw[2] = (u32x4){pkbf(p1[0], p1[1]), pkbf(p1[2], p1[3]), pkbf(p1[4], p1[5]), pkbf(p1[6], p1[7])};
        pw[3] = (u32x4){pkbf(p1[8], p1[9]), pkbf(p1[10], p1[11]), pkbf(p1[12], p1[13]), pkbf(p1[14], p1[15])};
        asm volatile("" : "+v"(pw[0]), "+v"(pw[1]), "+v"(pw[2]), "+v"(pw[3]));
        {   s16x4 vlo[2][4], vhh[2][4];
#pragma unroll
            for (int d0 = 0; d0 < 4; ++d0) { vlo[0][d0] = vtr(vp + d0 * 4096); vhh[0][d0] = vtr(vp + d0 * 4096 + 512); }
            __builtin_amdgcn_sched_barrier(0);
#pragma unroll
            for (int ks = 0; ks < 4; ++ks) {
                if (ks + 1 < 4) {
#pragma unroll
                    for (int d0 = 0; d0 < 4; ++d0) { vlo[(ks + 1) & 1][d0] = vtr(vp + d0 * 4096 + (ks + 1) * 1024); vhh[(ks + 1) & 1][d0] = vtr(vp + d0 * 4096 + (ks + 1) * 1024 + 512); }
                }
                __builtin_amdgcn_sched_barrier(0);
#pragma unroll
                for (int d0 = 0; d0 < 4; ++d0) {
                    const s16x4 lo = vlo[ks & 1][d0], hh = vhh[ks & 1][d0];
                    const bf16x8 vf = (bf16x8){lo[0], lo[1], lo[2], lo[3], hh[0], hh[1], hh[2], hh[3]};
                    o[d0] = __builtin_amdgcn_mfma_f32_32x32x16_bf16(__builtin_bit_cast(bf16x8, pw[ks]), vf, o[d0], 0, 0, 0);
                }
                __builtin_amdgcn_sched_barrier(0);
            }
        }
    }
#if MK_PROBE
    if (prb && tid == 0) { atomicAdd(prb, (unsigned)(__builtin_amdgcn_s_memrealtime() - pt0)); atomicAdd(prb + 1, (unsigned)NT); }
#endif
    asm volatile("s_waitcnt lgkmcnt(0)\n\ts_barrier" ::: "memory");
    { auto rr = __builtin_amdgcn_permlane32_swap(__float_as_uint(l_reg), __float_as_uint(l_reg), false, false); l_reg = __uint_as_float(rr[0]) + __uint_as_float(rr[1]); }
    if (hi == 0) wsf[32 + r32] = l_reg;
    asm volatile("s_waitcnt lgkmcnt(0)" ::: "memory");
    bf16* stg = (bf16*)(shm + A2_OST) + wid * 4096;
#pragma unroll
    for (int r = 0; r < 16; ++r) { const int orow = crow(r, hi); const float rl = __builtin_amdgcn_rcpf(wsf[32 + orow]);
#pragma unroll
        for (int d0 = 0; d0 < 4; ++d0) stg[orow * 128 + d0 * 32 + r32] = __float2bfloat16(o[d0][r] * rl); }
    asm volatile("s_waitcnt lgkmcnt(0)" ::: "memory");
    bf16* Ow = Oh + (long)(q0 + wid * QBLK) * PO;
#pragma unroll
    for (int i = 0; i < 8; ++i) { const int row = i * 4 + (lane >> 4), ch = lane & 15; const u32x4 v = *(const u32x4*)(stg + row * 128 + ch * 8); *(u32x4*)(Ow + (long)row * PO + ch * 8) = v; }
    asm volatile("s_waitcnt lgkmcnt(0)\n\ts_barrier" ::: "memory");
#undef A2_DMA
#undef A2_WAITB
}

template <int THRL> __device__ __forceinline__ void attn3_unit(int qb, const bf16* Qh, const bf16* __restrict__ Kh, const bf16* __restrict__ Vh, bf16* Oh, char* shm, unsigned* prb = nullptr) {
    const int tid = threadIdx.x; int lane = tid & 63; asm volatile("" : "+v"(lane));
    const int r32 = lane & 31, hi = lane >> 5; const int wid = __builtin_amdgcn_readfirstlane(tid >> 6);
    const int q0 = qb * QB;
    const bf16* Qw = Qh + (long)(q0 + wid * QBLK) * PZ;
    const unsigned lds0 = (unsigned)(uintptr_t)shm;
    float* wsf = (float*)(shm + A2_WS) + wid * 64;
    bf16x8 qr[4];
#pragma unroll
    for (int d0 = 0; d0 < 4; ++d0) qr[d0] = *reinterpret_cast<const bf16x8*>(&Qw[(long)r32 * PZ + d0 * 16 + hi * 8]);
    const bf16* ksrc = Kh + (long)lane * PZ + wid * 8;
    const bf16* vsrc = Vh + (long)(16 * (wid & 3) + (lane >> 2)) * PV + (wid >> 2) * 32 + (lane & 3) * 8;
    const unsigned kdst = lds0 + A2_K + wid * 1024, vdst = lds0 + A2_V + wid * 1024;
#define A3_DMA(t, sl) do { glds16(ksrc + (long)(t) * KVBLK * PZ, (unsigned)__builtin_amdgcn_readfirstlane(kdst + (sl) * A2_SLOT)); \
        glds16(vsrc + (long)(t) * KVBLK * PV, (unsigned)__builtin_amdgcn_readfirstlane(vdst + (sl) * A2_SLOT)); \
        glds16(vsrc + (long)(t) * KVBLK * PV + 64, (unsigned)__builtin_amdgcn_readfirstlane(vdst + (sl) * A2_SLOT + 8192)); } while (0)
#define A3_SB() __builtin_amdgcn_sched_barrier(0)
#define A3_MFMA(A_, B_, C_) __builtin_amdgcn_mfma_f32_32x32x16_bf16((A_), (B_), (C_), 0, 0, 0)
#define A3_KLD(D0) (*(const __attribute__((address_space(3))) bf16x8*)(kpn + (D0) * 2048))
#define A3_KLD2(D0) (*(const __attribute__((address_space(3))) bf16x8*)(kpn + (D0) * 2048 + 512))
#define A3_VLD(BUF, KS) do { _Pragma("unroll") for (int d_ = 0; d_ < 4; ++d_) { vlo[BUF][d_] = vtr(vp + d_ * 4096 + (KS) * 1024); vhh[BUF][d_] = vtr(vp + d_ * 4096 + (KS) * 1024 + 512); } } while (0)
#define A3_VF(BUF, D0) ((bf16x8){vlo[BUF][D0][0], vlo[BUF][D0][1], vlo[BUF][D0][2], vlo[BUF][D0][3], vhh[BUF][D0][0], vhh[BUF][D0][1], vhh[BUF][D0][2], vhh[BUF][D0][3]})
#define A3_EXP2(P, I) do { P[2 * (I)] = __builtin_amdgcn_exp2f(P[2 * (I)]); P[2 * (I) + 1] = __builtin_amdgcn_exp2f(P[2 * (I) + 1]); sacc += P[2 * (I)] + P[2 * (I) + 1]; } while (0)
#define A3_ROWMAX(P0, P1, RM) do { float a_ = fmaxf(fmaxf(P0[0], P0[1]), P1[0]), b_ = fmaxf(fmaxf(P0[2], P0[3]), P1[1]); a_ = fmaxf(fmaxf(a_, P1[2]), P1[3]); \
        _Pragma("unroll") for (int r_ = 4; r_ < 16; r_ += 4) { a_ = fmaxf(fmaxf(a_, P0[r_]), P0[r_ + 1]); b_ = fmaxf(fmaxf(b_, P0[r_ + 2]), P0[r_ + 3]); a_ = fmaxf(fmaxf(a_, P1[r_]), P1[r_ + 1]); b_ = fmaxf(fmaxf(b_, P1[r_ + 2]), P1[r_ + 3]); } \
        RM = fmaxf(a_, b_); auto rr_ = __builtin_amdgcn_permlane32_swap(__float_as_uint(RM), __float_as_uint(RM), false, false); RM = fmaxf(__uint_as_float(rr_[0]), __uint_as_float(rr_[1])); } while (0)
    const int NT = (q0 + QB) / KVBLK;
    A3_DMA(0, 0); A3_DMA(1, 1); A3_DMA(2, 2);
    asm volatile("" : "+v"(qr[0]), "+v"(qr[1]), "+v"(qr[2]), "+v"(qr[3]));
    const lds_cptr shm3 = (lds_cptr)shm;
    const lds_cptr kp0 = shm3 + A2_K + hi * 1024 + r32 * 16;
    const lds_cptr vp0 = shm3 + A2_V + ((lane >> 4) & 1) * 32 + (lane & 3) * 8 + (4 * hi + ((lane & 15) >> 2)) * 64;
    float mhat = 0.f, l_reg = 0.f; f32x16 o[4]; o[0] = f32x16{}; o[1] = f32x16{}; o[2] = f32x16{}; o[3] = f32x16{}; f32x16 negm = f32x16{};
    const int qrel = wid * QBLK + r32;
    f32x16 p0, p1; float rm;
    asm volatile("s_waitcnt vmcnt(6)\n\ts_barrier" ::: "memory");
    {   const lds_cptr kpn = kp0;
        p0 = A3_MFMA(A3_KLD(0), qr[0], negm); p1 = A3_MFMA(A3_KLD2(0), qr[0], negm);
#pragma unroll
        for (int d0 = 1; d0 < 4; ++d0) { p0 = A3_MFMA(A3_KLD(d0), qr[d0], p0); p1 = A3_MFMA(A3_KLD2(d0), qr[d0], p1); }
        if (NT == 4) cmask(p0, p1, 0, qrel, hi);
        A3_ROWMAX(p0, p1, rm);
        mhat = rm;
#pragma unroll
        for (int r = 0; r < 16; ++r) { p0[r] -= rm; p1[r] -= rm; negm[r] = -mhat; }
        rm = 0.f;
    }
#if MK_PROBE
    const unsigned long long pt0 = __builtin_amdgcn_s_memrealtime();
#endif
    for (int t = 0; t < NT; ++t) {
        if (t + 2 < NT) asm volatile("s_waitcnt vmcnt(3)\n\ts_barrier" ::: "memory"); else asm volatile("s_waitcnt vmcnt(0)\n\ts_barrier" ::: "memory");
        if (t + 3 < NT) A3_DMA(t + 3, (t + 3) & 3);
        const lds_cptr kpn = kp0 + ((t + 1) & 3) * A2_SLOT; const lds_cptr vp = vp0 + (t & 3) * A2_SLOT;
        if (__any(rm > (float)THRL)) {
            const float dl = fmaxf(rm, 0.f); mhat += dl;
#pragma unroll
            for (int r = 0; r < 16; ++r) { p0[r] -= dl; p1[r] -= dl; negm[r] = -mhat; }
            const float f = __builtin_amdgcn_exp2f(-dl); l_reg *= f;
            if (hi == 0) wsf[r32] = f;
            asm volatile("s_waitcnt lgkmcnt(0)" ::: "memory");
#pragma unroll
            for (int r = 0; r < 16; ++r) { const float fr_ = wsf[crow(r, hi)];
#pragma unroll
                for (int d_ = 0; d_ < 4; ++d_) o[d_][r] *= fr_; }
            asm volatile("s_waitcnt lgkmcnt(0)" ::: "memory");
        }
        float sacc = 0.f; f32x16 n0, n1; u32x4 pw0, pw1, pw2, pw3; s16x4 vlo[2][4], vhh[2][4];
        {   bf16x8 ka0 = A3_KLD(0), ka1 = A3_KLD2(0), ka2 = A3_KLD(1), ka3 = A3_KLD2(1);
            A3_VLD(0, 0);
            A3_SB();
            n0 = A3_MFMA(ka0, qr[0], negm); A3_EXP2(p0, 0); A3_SB();
            n1 = A3_MFMA(ka1, qr[0], negm); A3_EXP2(p0, 1); A3_SB();
            bf16x8 kb0 = A3_KLD(2), kb1 = A3_KLD2(2), kb2 = A3_KLD(3), kb3 = A3_KLD2(3);
            n0 = A3_MFMA(ka2, qr[1], n0); A3_EXP2(p0, 2); A3_SB();
            n1 = A3_MFMA(ka3, qr[1], n1); A3_EXP2(p0, 3); pw0 = (u32x4){pkbf(p0[0], p0[1]), pkbf(p0[2], p0[3]), pkbf(p0[4], p0[5]), pkbf(p0[6], p0[7])}; A3_SB();
            n0 = A3_MFMA(kb0, qr[2], n0); A3_EXP2(p0, 4); A3_SB();
            n1 = A3_MFMA(kb1, qr[2], n1); A3_EXP2(p0, 5); A3_SB();
            n0 = A3_MFMA(kb2, qr[3], n0); A3_EXP2(p0, 6); A3_SB();
            n1 = A3_MFMA(kb3, qr[3], n1); A3_EXP2(p0, 7); pw1 = (u32x4){pkbf(p0[8], p0[9]), pkbf(p0[10], p0[11]), pkbf(p0[12], p0[13]), pkbf(p0[14], p0[15])}; A3_SB();
        }
        A3_VLD(1, 1); A3_SB();
        o[0] = A3_MFMA(__builtin_bit_cast(bf16x8, pw0), A3_VF(0, 0), o[0]); A3_EXP2(p1, 0); A3_SB();
        o[1] = A3_MFMA(__builtin_bit_cast(bf16x8, pw0), A3_VF(0, 1), o[1]); A3_EXP2(p1, 1); A3_SB();
        o[2] = A3_MFMA(__builtin_bit_cast(bf16x8, pw0), A3_VF(0, 2), o[2]); A3_EXP2(p1, 2); A3_SB();
        o[3] = A3_MFMA(__builtin_bit_cast(bf16x8, pw0), A3_VF(0, 3), o[3]); A3_EXP2(p1, 3); pw2 = (u32x4){pkbf(p1[0], p1[1]), pkbf(p1[2], p1[3]), pkbf(p1[4], p1[5]), pkbf(p1[6], p1[7])}; A3_SB();
        A3_VLD(0, 2); A3_SB();
        o[0] = A3_MFMA(__builtin_bit_cast(bf16x8, pw1), A3_VF(1, 0), o[0]); A3_EXP2(p1, 4); A3_SB();
        o[1] = A3_MFMA(__builtin_bit_cast(bf16x8, pw1), A3_VF(1, 1), o[1]); A3_EXP2(p1, 5); A3_SB();
        o[2] = A3_MFMA(__builtin_bit_cast(bf16x8, pw1), A3_VF(1, 2), o[2]); A3_EXP2(p1, 6); A3_SB();
        o[3] = A3_MFMA(__builtin_bit_cast(bf16x8, pw1), A3_VF(1, 3), o[3]); A3_EXP2(p1, 7); pw3 = (u32x4){pkbf(p1[8], p1[9]), pkbf(p1[10], p1[11]), pkbf(p1[12], p1[13]), pkbf(p1[14], p1[15])}; A3_SB();
        l_reg += sacc;
        A3_VLD(1, 3); A3_SB();
        { const int jb = (t + 1) - (NT - 4); if (jb >= 0 && t + 1 < NT) cmask(n0, n1, jb, qrel, hi); }
        o[0] = A3_MFMA(__builtin_bit_cast(bf16x8, pw2), A3_VF(0, 0), o[0]);
        o[1] = A3_MFMA(__builtin_bit_cast(bf16x8, pw2), A3_VF(0, 1), o[1]);
        o[2] = A3_MFMA(__builtin_bit_cast(bf16x8, pw2), A3_VF(0, 2), o[2]);
        o[3] = A3_MFMA(__builtin_bit_cast(bf16x8, pw2), A3_VF(0, 3), o[3]); A3_SB();
        o[0] = A3_MFMA(__builtin_bit_cast(bf16x8, pw3), A3_VF(1, 0), o[0]);
        o[1] = A3_MFMA(__builtin_bit_cast(bf16x8, pw3), A3_VF(1, 1), o[1]);
        o[2] = A3_MFMA(__builtin_bit_cast(bf16x8, pw3), A3_VF(1, 2), o[2]);
        o[3] = A3_MFMA(__builtin_bit_cast(bf16x8, pw3), A3_VF(1, 3), o[3]);
        A3_ROWMAX(n0, n1, rm);
        p0 = n0; p1 = n1;
        A3_SB();
    }
#if MK_PROBE
    if (prb && tid == 0) { atomicAdd(prb, (unsigned)(__builtin_amdgcn_s_memrealtime() - pt0)); atomicAdd(prb + 1, (unsigned)NT); }
#endif
    asm volatile("s_waitcnt lgkmcnt(0)\n\ts_barrier" ::: "memory");
    { auto rr = __builtin_amdgcn_permlane32_swap(__float_as_uint(l_reg), __float_as_uint(l_reg), false, false); l_reg = __uint_as_float(rr[0]) + __uint_as_float(rr[1]); }
    if (hi == 0) wsf[32 + r32] = l_reg;
    asm volatile("s_waitcnt lgkmcnt(0)" ::: "memory");
    bf16* stg = (bf16*)(shm + A2_OST) + wid * 4096;
#pragma unroll
    for (int r = 0; r < 16; ++r) { const int orow = crow(r, hi); const float rl = __builtin_amdgcn_rcpf(wsf[32 + orow]);
#pragma unroll
        for (int d0 = 0; d0 < 4; ++d0) stg[orow * 128 + d0 * 32 + r32] = __float2bfloat16(o[d0][r] * rl); }
    asm volatile("s_waitcnt lgkmcnt(0)" ::: "memory");
    bf16* Ow = Oh + (long)(q0 + wid * QBLK) * PO;
#pragma unroll
    for (int i = 0; i < 8; ++i) { const int row = i * 4 + (lane >> 4), ch = lane & 15; const u32x4 v = *(const u32x4*)(stg + row * 128 + ch * 8); *(u32x4*)(Ow + (long)row * PO + ch * 8) = v; }
    asm volatile("s_waitcnt lgkmcnt(0)\n\ts_barrier" ::: "memory");
#undef A3_DMA
#undef A3_SB
#undef A3_MFMA
#undef A3_KLD
#undef A3_KLD2
#undef A3_VLD
#undef A3_VF
#undef A3_EXP2
#undef A3_ROWMAX
}
template <int THRL> __device__ __forceinline__ void attn4_unit(int qb, const bf16* Qh0, const bf16* __restrict__ Kh0, long mapstride, const bf16* __restrict__ Vh, bf16_t* YCb_, int yrow0, int ycol0, float lam, const float* gvec, u32x4* park, char* shm) {
#pragma unroll 1
  for (int mp = 0; mp < 2; ++mp) {
    const bf16* Qh = Qh0 + mp * mapstride; const bf16* Kh = Kh0 + mp * mapstride;
    const int tid = threadIdx.x; int lane = tid & 63; asm volatile("" : "+v"(lane));
    const int r32 = lane & 31, hi = lane >> 5; const int wid = __builtin_amdgcn_readfirstlane(tid >> 6);
    const int q0 = qb * QB + NMETA;
    const bf16* Qw = Qh + (long)(q0 + wid * QBLK) * PZ;
    const unsigned lds0 = (unsigned)(uintptr_t)shm;
    float* wsf = (float*)(shm + A2_WS) + wid * 64;
    bf16x8 qr[4];
#pragma unroll
    for (int d0 = 0; d0 < 4; ++d0) qr[d0] = *reinterpret_cast<const bf16x8*>(&Qw[(long)r32 * PZ + d0 * 16 + hi * 8]);
    const bf16* ksrc = Kh + (long)lane * PZ + wid * 8;
    const bf16* vsrc = Vh + (long)(16 * (wid & 3) + (lane >> 2)) * PV + (wid >> 2) * 32 + (lane & 3) * 8;
    const unsigned kdst = lds0 + A2_K + wid * 1024, vdst = lds0 + A2_V + wid * 1024;
#define A3_DMA(t, sl) do { glds16(ksrc + (long)(t) * KVBLK * PZ, (unsigned)__builtin_amdgcn_readfirstlane(kdst + (sl) * A2_SLOT)); \
        glds16(vsrc + (long)(t) * KVBLK * PV, (unsigned)__builtin_amdgcn_readfirstlane(vdst + (sl) * A2_SLOT)); \
        glds16(vsrc + (long)(t) * KVBLK * PV + 64, (unsigned)__builtin_amdgcn_readfirstlane(vdst + (sl) * A2_SLOT + 8192)); } while (0)
#define A3_SB() __builtin_amdgcn_sched_barrier(0)
#define A3_MFMA(A_, B_, C_) __builtin_amdgcn_mfma_f32_32x32x16_bf16((A_), (B_), (C_), 0, 0, 0)
#define A3_KLD(D0) (*(const __attribute__((address_space(3))) bf16x8*)(kpn + (D0) * 2048))
#define A3_KLD2(D0) (*(const __attribute__((address_space(3))) bf16x8*)(kpn + (D0) * 2048 + 512))
#define A3_VLD(BUF, KS) do { _Pragma("unroll") for (int d_ = 0; d_ < 4; ++d_) { vlo[BUF][d_] = vtr(vp + d_ * 4096 + (KS) * 1024); vhh[BUF][d_] = vtr(vp + d_ * 4096 + (KS) * 1024 + 512); } } while (0)
#define A3_VF(BUF, D0) ((bf16x8){vlo[BUF][D0][0], vlo[BUF][D0][1], vlo[BUF][D0][2], vlo[BUF][D0][3], vhh[BUF][D0][0], vhh[BUF][D0][1], vhh[BUF][D0][2], vhh[BUF][D0][3]})
#define A3_EXP2(P, I) do { P[2 * (I)] = __builtin_amdgcn_exp2f(P[2 * (I)]); P[2 * (I) + 1] = __builtin_amdgcn_exp2f(P[2 * (I) + 1]); sacc += P[2 * (I)] + P[2 * (I) + 1]; } while (0)
#define A3_ROWMAX(P0, P1, RM) do { float a_ = fmaxf(fmaxf(P0[0], P0[1]), P1[0]), b_ = fmaxf(fmaxf(P0[2], P0[3]), P1[1]); a_ = fmaxf(fmaxf(a_, P1[2]), P1[3]); \
        _Pragma("unroll") for (int r_ = 4; r_ < 16; r_ += 4) { a_ = fmaxf(fmaxf(a_, P0[r_]), P0[r_ + 1]); b_ = fmaxf(fmaxf(b_, P0[r_ + 2]), P0[r_ + 3]); a_ = fmaxf(fmaxf(a_, P1[r_]), P1[r_ + 1]); b_ = fmaxf(fmaxf(b_, P1[r_ + 2]), P1[r_ + 3]); } \
        RM = fmaxf(a_, b_); auto rr_ = __builtin_amdgcn_permlane32_swap(__float_as_uint(RM), __float_as_uint(RM), false, false); RM = fmaxf(__uint_as_float(rr_[0]), __uint_as_float(rr_[1])); } while (0)
    const int NT = 4 * qb + 5;
    const int qrel16 = wid * QBLK + r32 + NMETA;
    A3_DMA(0, 0); A3_DMA(1, 1); A3_DMA(2, 2);
    asm volatile("" : "+v"(qr[0]), "+v"(qr[1]), "+v"(qr[2]), "+v"(qr[3]));
    const lds_cptr shm3 = (lds_cptr)shm;
    const lds_cptr kp0 = shm3 + A2_K + hi * 1024 + r32 * 16;
    const lds_cptr vp0 = shm3 + A2_V + ((lane >> 4) & 1) * 32 + (lane & 3) * 8 + (4 * hi + ((lane & 15) >> 2)) * 64;
    float mhat = 0.f, l_reg = 0.f; f32x16 o[4]; o[0] = f32x16{}; o[1] = f32x16{}; o[2] = f32x16{}; o[3] = f32x16{}; f32x16 negm = f32x16{};
    const int qrel = wid * QBLK + r32;
    f32x16 p0, p1; float rm;
    asm volatile("s_waitcnt vmcnt(6)\n\ts_barrier" ::: "memory");
    {   const lds_cptr kpn = kp0;
        p0 = A3_MFMA(A3_KLD(0), qr[0], negm); p1 = A3_MFMA(A3_KLD2(0), qr[0], negm);
#pragma unroll
        for (int d0 = 1; d0 < 4; ++d0) { p0 = A3_MFMA(A3_KLD(d0), qr[d0], p0); p1 = A3_MFMA(A3_KLD2(d0), qr[d0], p1); }
        if (qb == 0) cmask(p0, p1, 0, qrel16, hi);
        A3_ROWMAX(p0, p1, rm);
        mhat = rm;
#pragma unroll
        for (int r = 0; r < 16; ++r) { p0[r] -= rm; p1[r] -= rm; negm[r] = -mhat; }
        rm = 0.f;
    }
    for (int t = 0; t < NT; ++t) {
        if (t + 2 < NT) asm volatile("s_waitcnt vmcnt(3)\n\ts_barrier" ::: "memory"); else asm volatile("s_waitcnt vmcnt(0)\n\ts_barrier" ::: "memory");
        if (t + 3 < NT) A3_DMA(t + 3, (t + 3) & 3);
        const lds_cptr kpn = kp0 + ((t + 1) & 3) * A2_SLOT; const lds_cptr vp = vp0 + (t & 3) * A2_SLOT;
        if (__any(rm > (float)THRL)) {
            const float dl = fmaxf(rm, 0.f); mhat += dl;
#pragma unroll
            for (int r = 0; r < 16; ++r) { p0[r] -= dl; p1[r] -= dl; negm[r] = -mhat; }
            const float f = __builtin_amdgcn_exp2f(-dl); l_reg *= f;
            if (hi == 0) wsf[r32] = f;
            asm volatile("s_waitcnt lgkmcnt(0)" ::: "memory");
#pragma unroll
            for (int r = 0; r < 16; ++r) { const float fr_ = wsf[crow(r, hi)];
#pragma unroll
                for (int d_ = 0; d_ < 4; ++d_) o[d_][r] *= fr_; }
            asm volatile("s_waitcnt lgkmcnt(0)" ::: "memory");
        }
        float sacc = 0.f; f32x16 n0, n1; u32x4 pw0, pw1, pw2, pw3; s16x4 vlo[2][4], vhh[2][4];
        {   bf16x8 ka0 = A3_KLD(0), ka1 = A3_KLD2(0), ka2 = A3_KLD(1), ka3 = A3_KLD2(1);
            A3_VLD(0, 0);
            A3_SB();
            n0 = A3_MFMA(ka0, qr[0], negm); A3_EXP2(p0, 0); A3_SB();
            n1 = A3_MFMA(ka1, qr[0], negm); A3_EXP2(p0, 1); A3_SB();
            bf16x8 kb0 = A3_KLD(2), kb1 = A3_KLD2(2), kb2 = A3_KLD(3), kb3 = A3_KLD2(3);
            n0 = A3_MFMA(ka2, qr[1], n0); A3_EXP2(p0, 2); A3_SB();
            n1 = A3_MFMA(ka3, qr[1], n1); A3_EXP2(p0, 3); pw0 = (u32x4){pkbf(p0[0], p0[1]), pkbf(p0[2], p0[3]), pkbf(p0[4], p0[5]), pkbf(p0[6], p0[7])}; A3_SB();
            n0 = A3_MFMA(kb0, qr[2], n0); A3_EXP2(p0, 4); A3_SB();
            n1 = A3_MFMA(kb1, qr[2], n1); A3_EXP2(p0, 5); A3_SB();
            n0 = A3_MFMA(kb2, qr[3], n0); A3_EXP2(p0, 6); A3_SB();
            n1 = A3_MFMA(kb3, qr[3], n1); A3_EXP2(p0, 7); pw1 = (u32x4){pkbf(p0[8], p0[9]), pkbf(p0[10], p0[11]), pkbf(p0[12], p0[13]), pkbf(p0[14], p0[15])}; A3_SB();
        }
        A3_VLD(1, 1); A3_SB();
        o[0] = A3_MFMA(__builtin_bit_cast(bf16x8, pw0), A3_VF(0, 0), o[0]); A3_EXP2(p1, 0); A3_SB();
        o[1] = A3_MFMA(__builtin_bit_cast(bf16x8, pw0), A3_VF(0, 1), o[1]); A3_EXP2(p1, 1); A3_SB();
        o[2] = A3_MFMA(__builtin_bit_cast(bf16x8, pw0), A3_VF(0, 2), o[2]); A3_EXP2(p1, 2); A3_SB();
        o[3] = A3_MFMA(__builtin_bit_cast(bf16x8, pw0), A3_VF(0, 3), o[3]); A3_EXP2(p1, 3); pw2 = (u32x4){pkbf(p1[0], p1[1]), pkbf(p1[2], p1[3]), pkbf(p1[4], p1[5]), pkbf(p1[6], p1[7])}; A3_SB();
        A3_VLD(0, 2); A3_SB();
        o[0] = A3_MFMA(__builtin_bit_cast(bf16x8, pw1), A3_VF(1, 0), o[0]); A3_EXP2(p1, 4); A3_SB();
        o[1] = A3_MFMA(__builtin_bit_cast(bf16x8, pw1), A3_VF(1, 1), o[1]); A3_EXP2(p1, 5); A3_SB();
        o[2] = A3_MFMA(__builtin_bit_cast(bf16x8, pw1), A3_VF(1, 2), o[2]); A3_EXP2(p1, 6); A3_SB();
        o[3] = A3_MFMA(__builtin_bit_cast(bf16x8, pw1), A3_VF(1, 3), o[3]); A3_EXP2(p1, 7); pw3 = (u32x4){pkbf(p1[8], p1[9]), pkbf(p1[10], p1[11]), pkbf(p1[12], p1[13]), pkbf(p1[14], p1[15])}; A3_SB();
        l_reg += sacc;
        A3_VLD(1, 3); A3_SB();
        { const int jb = (t + 1) - 4 * qb; if (jb >= 0 && t + 1 < NT) cmask(n0, n1, jb, qrel16, hi); }
        o[0] = A3_MFMA(__builtin_bit_cast(bf16x8, pw2), A3_VF(0, 0), o[0]);
        o[1] = A3_MFMA(__builtin_bit_cast(bf16x8, pw2), A3_VF(0, 1), o[1]);
        o[2] = A3_MFMA(__builtin_bit_cast(bf16x8, pw2), A3_VF(0, 2), o[2]);
        o[3] = A3_MFMA(__builtin_bit_cast(bf16x8, pw2), A3_VF(0, 3), o[3]); A3_SB();
        o[0] = A3_MFMA(__builtin_bit_cast(bf16x8, pw3), A3_VF(1, 0), o[0]);
        o[1] = A3_MFMA(__builtin_bit_cast(bf16x8, pw3), A3_VF(1, 1), o[1]);
        o[2] = A3_MFMA(__builtin_bit_cast(bf16x8, pw3), A3_VF(1, 2), o[2]);
        o[3] = A3_MFMA(__builtin_bit_cast(bf16x8, pw3), A3_VF(1, 3), o[3]);
        A3_ROWMAX(n0, n1, rm);
        p0 = n0; p1 = n1;
        A3_SB();
    }
    asm volatile("s_waitcnt lgkmcnt(0)\n\ts_barrier" ::: "memory");
    { auto rr = __builtin_amdgcn_permlane32_swap(__float_as_uint(l_reg), __float_as_uint(l_reg), false, false); l_reg = __uint_as_float(rr[0]) + __uint_as_float(rr[1]); }
    if (hi == 0) wsf[32 + r32] = l_reg;
    asm volatile("s_waitcnt lgkmcnt(0)" ::: "memory");
    float rl[16];
#pragma unroll
    for (int r = 0; r < 16; ++r) rl[r] = __builtin_amdgcn_rcpf(wsf[32 + crow(r, hi)]);
    if (mp == 0) {
#pragma unroll
        for (int d0 = 0; d0 < 4; ++d0)
#pragma unroll
            for (int q4 = 0; q4 < 2; ++q4) { u32x4 w;
                w.x = pkbf(o[d0][8 * q4 + 0] * rl[8 * q4 + 0], o[d0][8 * q4 + 1] * rl[8 * q4 + 1]); w.y = pkbf(o[d0][8 * q4 + 2] * rl[8 * q4 + 2], o[d0][8 * q4 + 3] * rl[8 * q4 + 3]);
                w.z = pkbf(o[d0][8 * q4 + 4] * rl[8 * q4 + 4], o[d0][8 * q4 + 5] * rl[8 * q4 + 5]); w.w = pkbf(o[d0][8 * q4 + 6] * rl[8 * q4 + 6], o[d0][8 * q4 + 7] * rl[8 * q4 + 7]);
                park[d0 * 2 + q4] = w; }
    } else {
        float ss[16];
#pragma unroll
        for (int r = 0; r < 16; ++r) ss[r] = 0.f;
#pragma unroll
        for (int d0 = 0; d0 < 4; ++d0)
#pragma unroll
            for (int q4 = 0; q4 < 2; ++q4) { const u32x4 w = park[d0 * 2 + q4];
                const float a_[8] = {bflo(w.x), bfhi(w.x), bflo(w.y), bfhi(w.y), bflo(w.z), bfhi(w.z), bflo(w.w), bfhi(w.w)};
#pragma unroll
                for (int e = 0; e < 8; ++e) { const int r = 8 * q4 + e; const float y = a_[e] - lam * (o[d0][r] * rl[r]); o[d0][r] = y; ss[r] += y * y; } }
        const f32x4 g4 = (f32x4){gvec[r32], gvec[32 + r32], gvec[64 + r32], gvec[96 + r32]} * (1.0f - LAMBDA_INIT);
#pragma unroll
        for (int r = 0; r < 16; ++r) {
            float v = row_sum16(ss[r]);
            auto rr = __builtin_amdgcn_permlane16_swap(__float_as_uint(v), __float_as_uint(v), false, false); v = __uint_as_float(rr[0]) + __uint_as_float(rr[1]);
            ss[r] = 1.0f / sqrtf(v * (1.f / 128.f) + LN_EPS);
        }
        bf16* stg = (bf16*)(shm + A2_OST) + wid * 4096;
#pragma unroll
        for (int r = 0; r < 16; ++r) { const int orow = crow(r, hi);
#pragma unroll
            for (int d0 = 0; d0 < 4; ++d0) stg[orow * 128 + d0 * 32 + r32] = __float2bfloat16(o[d0][r] * ss[r] * g4[d0]); }
        asm volatile("s_waitcnt lgkmcnt(0)" ::: "memory");
#pragma unroll
        for (int i = 0; i < 8; ++i) { const int row = i * 4 + (lane >> 4), ch = lane & 15; const int tq = q0 + wid * QBLK + row;
            if (tq >= NMETA && tq < TT) { const u32x4 v = *(const u32x4*)(stg + row * 128 + ch * 8); *(u32x4*)(YCb_ + (size_t)(yrow0 + tq - NMETA) * DM + ycol0 + ch * 8) = v; } }
    }
    asm volatile("s_waitcnt lgkmcnt(0)\n\ts_barrier" ::: "memory");
#undef A3_DMA
#undef A3_SB
#undef A3_MFMA
#undef A3_KLD
#undef A3_KLD2
#undef A3_VLD
#undef A3_VF
#undef A3_EXP2
#undef A3_ROWMAX
  }
}
#undef SBAR
#undef WAIT_BAR
}

#define XB_TMO      128
#define XB_XCNT(j)  (256  + 64 * (j))
#define XB_XSUB(j)  (1280 + 64 * (j))
#define XB_XGEN(j)  (2304 + 64 * (j))
#define XB_TOP      3328
#define XB_TOPGEN   3392
#define XCD_BAR_WORDS 3456
#define XB_SPIN_CAP (1u << 18)
__device__ __forceinline__ unsigned xb_ld(unsigned* p)              { return __hip_atomic_load(p, __ATOMIC_RELAXED, __HIP_MEMORY_SCOPE_AGENT); }
__device__ __forceinline__ unsigned xb_add(unsigned* p, unsigned v) { return __hip_atomic_fetch_add(p, v, __ATOMIC_RELAXED, __HIP_MEMORY_SCOPE_AGENT); }
__device__ __forceinline__ unsigned xb_xcc_id() { return (unsigned)__builtin_amdgcn_s_getreg((3 << 11) | 20) & 0xFu; }
#define XB_SPIN(cond, bar) do { unsigned _sp = 0; while (cond) { __builtin_amdgcn_s_sleep(1); \
    if ((++_sp & 255u) == 0u) { if (xb_ld(&(bar)[XB_TMO])) break; if (_sp > XB_SPIN_CAP) { atomicAdd(&(bar)[XB_TMO], 1u); break; } } } } while (0)
struct XcdBarrier { unsigned* bar; unsigned x; volatile LAS unsigned* st; };
__device__ __forceinline__ XcdBarrier xcd_barrier_post(unsigned* bar, volatile LAS unsigned* st) {
    XcdBarrier b; b.bar = bar; b.x = xb_xcc_id(); b.st = st;
    if (threadIdx.x == 0) (void)xb_add(&bar[XB_XCNT(b.x)], 1u);
    return b;
}
__device__ __forceinline__ void xcd_barrier_complete(unsigned* bar, unsigned x, unsigned& nloc, unsigned& nx) {
    const unsigned G = gridDim.x * gridDim.y * gridDim.z;
    unsigned sum, cnt, mine, sp = 0u;
    for (;;) {
        sum = 0u; cnt = 0u; mine = 0u;
#pragma unroll
        for (unsigned j = 0; j < 16; ++j) { const unsigned c = xb_ld(&bar[XB_XCNT(j)]); sum += c; cnt += (c > 0u) ? 1u : 0u; mine = (j == x) ? c : mine; }
        if (sum == G) break;
        __builtin_amdgcn_s_sleep(1);
        if ((++sp & 255u) == 0u) { if (xb_ld(&bar[XB_TMO])) break; if (sp > XB_SPIN_CAP) { atomicAdd(&bar[XB_TMO], 1u); break; } }
    }
    nloc = mine > 0u ? mine : 1u; nx = cnt > 0u ? cnt : 1u;
}
__device__ __forceinline__ void xcd_barrier(const XcdBarrier& b) {
    asm volatile("s_waitcnt vmcnt(0)" ::: "memory");
    __syncthreads();
    if (threadIdx.x == 0) {
        unsigned* bar = b.bar;
        __builtin_amdgcn_s_waitcnt(0);
        unsigned nloc = b.st[0], nx = b.st[1];
        if (nloc == 0u) { xcd_barrier_complete(bar, b.x, nloc, nx); b.st[0] = nloc; b.st[1] = nx; }
        const unsigned old = xb_add(&bar[XB_XSUB(b.x)], 1u);
        const unsigned gen = old / nloc;
        if (old + 1u == (gen + 1u) * nloc) {
            __builtin_amdgcn_fence(__ATOMIC_RELEASE, "agent");
            asm volatile("s_waitcnt vmcnt(0)" ::: "memory");
            const unsigned og = xb_add(&bar[XB_TOP], 1u);
            const unsigned tg = og / nx;
            if (og + 1u == (tg + 1u) * nx) xb_add(&bar[XB_TOPGEN], 1u);
            else XB_SPIN(xb_ld(&bar[XB_TOPGEN]) == tg, bar);
            __builtin_amdgcn_fence(__ATOMIC_ACQUIRE, "agent");
            xb_add(&bar[XB_XGEN(b.x)], 1u);
            asm volatile("s_waitcnt vmcnt(0)" ::: "memory");
        } else {
            XB_SPIN(xb_ld(&bar[XB_XGEN(b.x)]) == gen, bar);
            __builtin_amdgcn_fence(__ATOMIC_ACQUIRE, "agent");
            asm volatile("s_waitcnt vmcnt(0)" ::: "memory");
        }
    }
    __syncthreads();
}

struct Args {
    const float *x, *meta, *ln0_g, *ln0_b, *w_in, *conv_w, *conv_b, *gate_bias, *lq1, *lk1, *lq2, *lk2, *att_g, *ml_g, *w_att_out, *w_ml_out, *w_o,
                *ln1_g, *ln1_b, *w_router, *b_router, *w_gu, *b_gu, *w_down, *b_down, *ln2_g, *ln2_b;
    float* out; unsigned char* ws; int ph_lo, ph_hi;
};

template <class ColMap>
__device__ __forceinline__ void transpose_item(const float* W, int K, int N, bf16_t* WT, LAS float* scr, int kb, int nb, int lane, ColMap cm, int ldw = 0) {
    if (ldw == 0) ldw = K;
    const int k0 = 64 * kb, n0 = 32 * nb;
    const int lc = cm(n0 + (lane & 31));
    float tv[32];
    const float* wp = W + (size_t)(k0 + (lane >> 5)) * N + lc;
#pragma unroll
    for (int i = 0; i < 32; ++i) tv[i] = wp[(size_t)(2 * i) * N];
#pragma unroll
    for (int i = 0; i < 32; ++i) { const int kk = 2 * i + (lane >> 5); scr[kk * 33 + (lane & 31)] = tv[i]; }
    LDS_WAIT(); asm volatile("" ::: "memory");
    const int c = lane & 7;
#pragma unroll
    for (int j = 0; j < 4; ++j) { const int n = (lane >> 3) + 8 * j; const LAS float* s = scr + (8 * c) * 33 + n;
        u32x4 o; o.x = pkbf(s[0 * 33], s[1 * 33]); o.y = pkbf(s[2 * 33], s[3 * 33]); o.z = pkbf(s[4 * 33], s[5 * 33]); o.w = pkbf(s[6 * 33], s[7 * 33]);
        *(u32x4*)(WT + (size_t)(n0 + n) * ldw + k0 + 8 * c) = o; }
    LDS_WAIT(); asm volatile("" ::: "memory");
}
template <class ColMap>
__device__ __forceinline__ void transpose_item2(const float* W, int K, int N, bf16_t* WT, LAS float* scr, int kb, int nb, int lane, ColMap cm) {
    const int k0 = 64 * kb, n0 = 32 * nb;
    const int lc0 = cm(n0 + (lane & 31)), lc1 = cm(n0 + 32 + (lane & 31));
    float ta[32], tb[32];
    const float* wp = W + (size_t)(k0 + (lane >> 5)) * N;
#pragma unroll
    for (int i = 0; i < 32; ++i) { ta[i] = wp[(size_t)(2 * i) * N + lc0]; tb[i] = wp[(size_t)(2 * i) * N + lc1]; }
    LAS float* scr2 = scr + 64 * 33;
#pragma unroll
    for (int i = 0; i < 32; ++i) { const int kk = 2 * i + (lane >> 5); scr[kk * 33 + (lane & 31)] = ta[i]; scr2[kk * 33 + (lane & 31)] = tb[i]; }
    LDS_WAIT(); asm volatile("" ::: "memory");
    const int c = lane & 7;
#pragma unroll
    for (int h2 = 0; h2 < 2; ++h2) { const LAS float* sb = h2 ? scr2 : scr;
#pragma unroll
        for (int j = 0; j < 4; ++j) { const int n = (lane >> 3) + 8 * j; const LAS float* sp = sb + (8 * c) * 33 + n;
            u32x4 o; o.x = pkbf(sp[0 * 33], sp[1 * 33]); o.y = pkbf(sp[2 * 33], sp[3 * 33]); o.z = pkbf(sp[4 * 33], sp[5 * 33]); o.w = pkbf(sp[6 * 33], sp[7 * 33]);
            *(u32x4*)(WT + (size_t)(n0 + 32 * h2 + n) * K + k0 + 8 * c) = o; } }
    LDS_WAIT(); asm volatile("" ::: "memory");
}
template <class InvMap>
__device__ __forceinline__ void transpose_tile64(const float* W, int N, bf16_t* WT, int ldw, LAS unsigned char* scr, int k0, int c0, int lane, InvMap inv) {
    constexpr int TP = 136;
    asm volatile("" : "+v"(lane));
    const float* wp = W + (size_t)(k0 + (lane >> 4)) * N + c0 + (lane & 15) * 4;
#pragma unroll
    for (int hf = 0; hf < 2; ++hf) {
        f32x4 tv[8];
#pragma unroll
        for (int i = 0; i < 8; ++i) tv[i] = *(const f32x4*)(wp + (size_t)(4 * (8 * hf + i)) * N);
#pragma unroll
        for (int i = 0; i < 8; ++i) { u32x2 w; w.x = pkbf(tv[i][0], tv[i][1]); w.y = pkbf(tv[i][2], tv[i][3]);
            *(LAS u32x2*)(scr + ((lane >> 4) + 4 * (8 * hf + i)) * TP + (lane & 15) * 8) = w; }
        asm volatile("" ::: "memory");
    }
    LDS_WAIT(); asm volatile("" ::: "memory");
    const int g = lane >> 4, p = lane & 15;
#pragma unroll
    for (int it = 0; it < 8; ++it) {
        const int cq = it & 3, kq = (it >> 2) * 4 + g;
        const LAS unsigned char* a = scr + (8 * kq + (p >> 2)) * TP + (16 * cq + 4 * (p & 3)) * 2;
        const attn_body::s16x4 lo = attn_body::vtr((attn_body::lds_cptr)a), hi4 = attn_body::vtr((attn_body::lds_cptr)(a + 4 * TP));
        u32x4 o; o.x = (unsigned)(unsigned short)lo[0] | ((unsigned)(unsigned short)lo[1] << 16); o.y = (unsigned)(unsigned short)lo[2] | ((unsigned)(unsigned short)lo[3] << 16);
        o.z = (unsigned)(unsigned short)hi4[0] | ((unsigned)(unsigned short)hi4[1] << 16); o.w = (unsigned)(unsigned short)hi4[2] | ((unsigned)(unsigned short)hi4[3] << 16);
        *(u32x4*)(WT + (size_t)inv(c0 + 16 * cq + p) * ldw + k0 + 8 * kq) = o;
    }
    LDS_WAIT(); asm volatile("" ::: "memory");
}
template <class InvMap>
__device__ __forceinline__ void transpose_tile64_fp8(const float* W, int N, unsigned char* WT, int ldw, LAS unsigned char* scr, int k0, int c0, int lane, InvMap inv, float scale) {
    constexpr int TP = 136;
    asm volatile("" : "+v"(lane));
    const float* wp = W + (size_t)(k0 + (lane >> 4)) * N + c0 + (lane & 15) * 4;
#pragma unroll
    for (int hf = 0; hf < 2; ++hf) {
        f32x4 tv[8];
#pragma unroll
        for (int i = 0; i < 8; ++i) tv[i] = *(const f32x4*)(wp + (size_t)(4 * (8 * hf + i)) * N);
#pragma unroll
        for (int i = 0; i < 8; ++i) { u32x2 w; w.x = pkbf(tv[i][0], tv[i][1]); w.y = pkbf(tv[i][2], tv[i][3]);
            *(LAS u32x2*)(scr + ((lane >> 4) + 4 * (8 * hf + i)) * TP + (lane & 15) * 8) = w; }
        asm volatile("" ::: "memory");
    }
    LDS_WAIT(); asm volatile("" ::: "memory");
    const int g = lane >> 4, p = lane & 15;
#pragma unroll
    for (int cq = 0; cq < 4; ++cq) {
        const LAS unsigned char* a = scr + (16 * g + (p >> 2)) * TP + (16 * cq + 4 * (p & 3)) * 2;
        u32x4 o;
#pragma unroll
        for (int q4 = 0; q4 < 4; ++q4) { const attn_body::s16x4 t4 = attn_body::vtr((attn_body::lds_cptr)(a + 4 * q4 * TP));
            o[q4] = pkfp8x4(__uint_as_float(((unsigned)(unsigned short)t4[0]) << 16) * scale, __uint_as_float(((unsigned)(unsigned short)t4[1]) << 16) * scale,
                            __uint_as_float(((unsigned)(unsigned short)t4[2]) << 16) * scale, __uint_as_float(((unsigned)(unsigned short)t4[3]) << 16) * scale); }
        *(u32x4*)(WT + (size_t)inv(c0 + 16 * cq + p) * ldw + k0 + 16 * g) = o;
    }
    LDS_WAIT(); asm volatile("" ::: "memory");
}
struct InvIdent { __device__ __forceinline__ int operator()(int c) const { return c; } };
struct InvGu {
    __device__ __forceinline__ int operator()(int c) const { const int sgl = c & 1, idx = c >> 1; return 256 * (idx >> 7) + 128 * sgl + (idx & 127); } };
struct CmIdent { __device__ __forceinline__ int operator()(int p) const { return p; } };
struct CmWin {
    __device__ __forceinline__ int operator()(int P) const {
        if (P < 1024) { const int hb = P >> 6, p = P & 63, wcp = p >> 5, fq = (p & 31) >> 3, n = (p & 7) >> 2, j = p & 3; return hb * 64 + 32 * n + 16 * wcp + 4 * fq + j; }
        if (P < 3584) return P;
        return P + 8;
    }
};
struct CmGu {
    __device__ __forceinline__ int operator()(int P) const { const int pn = P >> 8, s = (P >> 7) & 1, i = P & 127; return 2 * (128 * pn + i) + s; }
};

__global__ void __launch_bounds__(NWAVES * 64, 2) hybrid_fwd(Args a) {
    extern __shared__ __attribute__((aligned(16))) unsigned char lds[];
    LAS unsigned char* L = (LAS unsigned char*)lds;
    const int tid = threadIdx.x, lane = tid & 63, wave = __builtin_amdgcn_readfirstlane(tid >> 6);
    const int G = gridDim.x, blk = blockIdx.x;
    const int gw = blk * NWAVES + wave, NGW = G * NWAVES;
    if (tid < 16) ((LAS unsigned*)(L + MISC_OFF))[tid] = 0u;
    LAS unsigned long long* ptab = (LAS unsigned long long*)(L + MISC_OFF + 64);
    if (tid == 0) {
        ptab[0] = (unsigned long long)a.x; ptab[1] = (unsigned long long)a.meta; ptab[2] = (unsigned long long)a.ln0_g; ptab[3] = (unsigned long long)a.ln0_b; ptab[4] = (unsigned long long)a.w_in;
        ptab[5] = (unsigned long long)a.conv_w; ptab[6] = (unsigned long long)a.conv_b; ptab[7] = (unsigned long long)a.gate_bias; ptab[8] = (unsigned long long)a.lq1; ptab[9] = (unsigned long long)a.lk1;
        ptab[10] = (unsigned long long)a.lq2; ptab[11] = (unsigned long long)a.lk2; ptab[12] = (unsigned long long)a.att_g; ptab[13] = (unsigned long long)a.ml_g; ptab[14] = (unsigned long long)a.w_att_out;
        ptab[15] = (unsigned long long)a.w_ml_out; ptab[16] = (unsigned long long)a.w_o; ptab[17] = (unsigned long long)a.ln1_g; ptab[18] = (unsigned long long)a.ln1_b; ptab[19] = (unsigned long long)a.w_router;
        ptab[20] = (unsigned long long)a.b_router; ptab[21] = (unsigned long long)a.w_gu; ptab[22] = (unsigned long long)a.b_gu; ptab[23] = (unsigned long long)a.w_down; ptab[24] = (unsigned long long)a.b_down;
        ptab[25] = (unsigned long long)a.ln2_g; ptab[26] = (unsigned long long)a.ln2_b; ptab[27] = (unsigned long long)a.out; ptab[28] = (unsigned long long)a.ws;
    }
    asm volatile("s_waitcnt lgkmcnt(0)" ::: "memory");
    __syncthreads();
    asm volatile("" ::: "memory");
#define PF(i) ((const float*)ldptr(ptab, (i)))
#define WSP ((unsigned char*)ldptr(ptab, 28))
#define DOUTP ((unsigned char*)ldptr(ptab, 27))
#define ctl ((unsigned*)(WSP + WS_CTL))
#define WinT ((bf16_t*)(WSP + WS_WIN))
#define WaT ((bf16_t*)(WSP + WS_WA))
#define WmT ((bf16_t*)(WSP + WS_WM))
#define WoT ((bf16_t*)(WSP + WS_WO))
#define ropec ((float*)(WSP + WS_ROPE))
#define ropes (ropec + TT * 32)
#define stats ((float*)(WSP + WS_STATS))
#define gates ((float*)(WSP + WS_GATES))
#define tok_e ((int*)(WSP + WS_TOKE))
#define tok_g ((float*)(WSP + WS_TOKG))
#define hist ((int*)(WSP + WS_HIST))
#define row_off ((int*)(WSP + WS_ROWOFF))
#define row_slot ((int*)(WSP + WS_ROWSLOT))
#define row_gate ((float*)(WSP + WS_ROWGATE))
#define tile_exp ((int*)(WSP + WS_TILEEXP))
#define Hb ((bf16_t*)(WSP + WS_H))
#define Z ((bf16_t*)(WSP + WS_Z))
#define Y ((bf16_t*)(WSP + WS_Y))
#define ACT ((bf16_t*)(WSP + WS_ACT))
#define Qc ((bf16_t*)(WSP + WS_QC))
#define Kc ((bf16_t*)(WSP + WS_KC))
#define Vc ((bf16_t*)(WSP + WS_VC))
#define TMPb ((bf16_t*)(WSP + WS_TMP))
#define MRGb ((bf16_t*)(WSP + WS_MRG))
#define GFb ((bf16_t*)(WSP + WS_GF))
#define YCb ((bf16_t*)(WSP + WS_H))
#define Ob ((bf16_t*)(WSP + WS_O))
#define WguT ((bf16_t*)(DOUTP + DO_WGU))
#define WdnT ((bf16_t*)(DOUTP + DO_WDN))
#if !MK_PER_PHASE
    XcdBarrier bar = xcd_barrier_post(ctl + CW_BAR, (volatile LAS unsigned*)(L + MISC_OFF + 32));
#define GRID_BAR() xcd_barrier(bar)
#else
#define GRID_BAR() do {} while (0)
#endif
    const int lo = a.ph_lo, hi = a.ph_hi;
#if MK_PROBE == 2
    LAS unsigned* pdur = (LAS unsigned*)(L + MISC_OFF + 320);
    if (blk == 0 && tid == 0) { pdur[30] = (unsigned)__builtin_amdgcn_s_memrealtime(); pdur[31] = pdur[30]; pdur[29] = pdur[30]; for (int q_ = 16; q_ < 29; ++q_) pdur[q_] = 0u; }
#define PSTAMP(k) do { if (blk == 0 && tid == 0) { const unsigned now_ = (unsigned)__builtin_amdgcn_s_memrealtime(); pdur[k] = now_ - pdur[30]; pdur[30] = now_; } } while (0)
#define CSTAMP(k) do { if (blk == 0 && tid == 0) { const unsigned now_ = (unsigned)__builtin_amdgcn_s_memrealtime(); pdur[16 + (k)] += now_ - pdur[31]; pdur[31] = now_; } } while (0)
#else
#define PSTAMP(k) do {} while (0)
#define CSTAMP(k) do {} while (0)
#endif
#define IN(k) (lo <= (k) && (k) < hi)
#define BOTH(k) (IN(k) && IN((k) + 1))

    if (IN(0)) REPLOOP(0) {
        {   LAS float* scr = (LAS float*)(L + wave * 16384);
            constexpr int I_IN = 16 * (NZP / 32), I_A = 8 * 32, I_O = 16 * 32;
            constexpr int NIT = I_IN + 2 * I_A + I_O;
            for (int it = gw; it < NIT; it += NGW) {
                int r = it;
                if (r < I_IN) { transpose_item(PF(4), 1024, NIN, WinT, scr, r / (NZP / 32), r % (NZP / 32), lane, CmWin()); continue; } r -= I_IN;
                if (r < I_A) { transpose_item(PF(14), 512, 1024, WaT, scr, r / 32, r % 32, lane, CmIdent(), 1024); continue; } r -= I_A;
                if (r < I_A) { transpose_item(PF(15), 512, 1024, WaT + 512, scr, r / 32, r % 32, lane, CmIdent(), 1024); continue; } r -= I_A;
                transpose_item(PF(16), 1024, 1024, WoT, scr, r / 32, r % 32, lane, CmIdent());
            }
        }
        for (int i = blk * 512 + tid; i < TT * 32; i += G * 512) {
            const int t = i >> 5, f = i & 31;
            const double inv = exp2(-(double)f * (13.287712379549449 / 32.0));
            const double rev = (double)t * inv * 0.15915494309189535;
            const float fr = (float)(rev - floor(rev));
            ropec[i] = __builtin_amdgcn_cosf(fr); ropes[i] = __builtin_amdgcn_sinf(fr);
        }
        __syncthreads();
        LAS float* wg = (LAS float*)L;
        for (int i = tid; i < 8 * 1024; i += 512) { const int gc = i >> 10, k = i & 1023; wg[i] = PF(4)[(size_t)k * NIN + 3584 + gc]; }
        __syncthreads();
        {
            const float* xin = PF(0); const float* metap = PF(1); const float* gbias = PF(7);
            const float* g0p = PF(2); const float* b0p = PF(3);
            bf16_t* Hbp = Hb; float* statsp = stats; float* gatesp = gates;
            const int q_of_lane = (lane >> 1) & 7, r_of_lane = lane >> 4;
            const float gb = gbias[q_of_lane];
            for (int base = gw * 4; base < MROWS; base += NGW * 4) {
                f32x4 v[4][4]; float sm[4];
#pragma unroll
                for (int r = 0; r < 4; ++r) { const int row = (base + r < MROWS) ? base + r : MROWS - 1;
                    const float* xr = (row < NREAL) ? xin + (size_t)row * DM : metap + (size_t)((row - NREAL) & (NMETA - 1)) * DM;
#pragma unroll
                    for (int j = 0; j < 4; ++j) v[r][j] = *(const f32x4*)(xr + 4 * lane + 256 * j); }
#pragma unroll
                for (int r = 0; r < 4; ++r) { float s = 0.f;
#pragma unroll
                    for (int j = 0; j < 4; ++j) s += (v[r][j][0] + v[r][j][1]) + (v[r][j][2] + v[r][j][3]);
                    sm[r] = s; }
                float mean[4], rstd[4];
#pragma unroll
                for (int r = 0; r < 4; ++r) mean[r] = wave_sum(sm[r]) * (1.f / DM);
#pragma unroll
                for (int r = 0; r < 4; ++r) { float s2 = 0.f;
#pragma unroll
                    for (int j = 0; j < 4; ++j) { const f32x4 d = v[r][j] - mean[r]; s2 += (d[0] * d[0] + d[1] * d[1]) + (d[2] * d[2] + d[3] * d[3]); }
                    sm[r] = s2; }
#pragma unroll
                for (int r = 0; r < 4; ++r) rstd[r] = 1.0f / sqrtf(wave_sum(sm[r]) * (1.f / DM) + LN_EPS);
                float gp[32];
#pragma unroll
                for (int q = 0; q < 32; ++q) gp[q] = 0.f;
#pragma unroll
                for (int j = 0; j < 4; ++j) {
                    const f32x4 ggj = *(const f32x4*)(g0p + 4 * lane + 256 * j), bbj = *(const f32x4*)(b0p + 4 * lane + 256 * j);
#pragma unroll
                    for (int r = 0; r < 4; ++r) { v[r][j] = (v[r][j] - mean[r]) * rstd[r] * ggj + bbj;
                        if (base + r < MROWS) { u32x2 w; w.x = pkbf(v[r][j][0], v[r][j][1]); w.y = pkbf(v[r][j][2], v[r][j][3]); *(u32x2*)(Hbp + (size_t)(base + r) * DM + 4 * lane + 256 * j) = w; } }
#pragma unroll
                    for (int q = 0; q < 8; ++q) { const f32x4 wv = *(const LAS f32x4*)(wg + q * 1024 + 4 * lane + 256 * j);
#pragma unroll
                        for (int r = 0; r < 4; ++r) gp[r * 8 + q] += (v[r][j][0] * wv[0] + v[r][j][1] * wv[1]) + (v[r][j][2] * wv[2] + v[r][j][3] * wv[3]); }
                }
                const float gsum = xreduce32(gp, lane);
                const int rowl = base + r_of_lane;
                if (rowl < MROWS) {
                    if ((lane & 1) == 0) { float gv = gsum + gb;
                        if (q_of_lane >= 4) gv = (gv >= 0.f) ? -log1pf(expf(-gv)) : gv - log1pf(expf(gv));
                        gatesp[(size_t)rowl * 8 + q_of_lane] = gv; }
                    if ((lane & 15) == 0) { const float mr = (r_of_lane == 0) ? mean[0] : (r_of_lane == 1) ? mean[1] : (r_of_lane == 2) ? mean[2] : mean[3];
                        const float rr = (r_of_lane == 0) ? rstd[0] : (r_of_lane == 1) ? rstd[1] : (r_of_lane == 2) ? rstd[2] : rstd[3];
                        statsp[2 * rowl] = mr; statsp[2 * rowl + 1] = rr; }
                }
            }
        }
        __syncthreads();
        if (BOTH(0) || rep_ + 1 < REP_0) GRID_BAR();
    }
    PSTAMP(0);

    if (IN(1)) REPLOOP(1) {
        pg8::Gemm g{Hb, WinT, DM, DM, NZP / 256, nullptr, nullptr, 0};
        pg8::StaticOrder S; S.init(MROWS / 256, NZP / 256, G, blk);
        pg8::EpiZ E{Z, Qc, Kc, Vc, ropec, ropes, GFb};
        pg8::gemm_phase<0, pg8::EpiZ>(L, g, S, E);
        if (BOTH(1) || rep_ + 1 < REP_1) GRID_BAR();
    }
    PSTAMP(1);

    if (IN(2)) {
        REPLOOP(2B) {
            constexpr int PQ = 136;
            LAS bf16_t* Qs = (LAS bf16_t*)L;
            LAS bf16_t* Ks = Qs + 128 * PQ;
            LAS bf16_t* VTs = Ks + 128 * PQ;
            LAS bf16_t* Cs = VTs + 144 * PQ;
            LAS float* fv = (LAS float*)(Cs + 144 * PQ);
            LAS float* v_a = fv;
            LAS float* v_M = fv + 128;
            LAS float* v_b = fv + 256;
            LAS float* v_w = fv + 384;
            LAS float* v_sc = fv + 512;
            LAS float* cw = fv + 528;
            const float* convw = PF(5); const float* convb = PF(6); const float* mlg = PF(13); const float* gatesp = gates;
            bf16_t* Zp = Z; bf16_t* YCp = YCb;
            for (int u = blk; u < NB * 4; u += G) {
                const int b = u >> 2, h = u & 3;
                __syncthreads();
                for (int i = tid; i < 5 * 256; i += 512) { const int j = i >> 8, c = i & 255; const int ch = (c < 128) ? (h * 128 + c) : (512 + h * 128 + (c - 128));
                    cw[i] = (j < 4) ? convw[j * 1024 + ch] : convb[ch]; }
                for (int i = tid; i < 144 * PQ; i += 512) { const int rr = i / PQ; VTs[i] = (rr == 128) ? (bf16_t)0x3f80 : (bf16_t)0; Cs[i] = 0; }
                if (tid == 0) v_sc[0] = 0.f;
                f32x4 Cst[9];
#pragma unroll
                for (int jt = 0; jt < 9; ++jt) Cst[jt] = (f32x4){0.f, 0.f, 0.f, 0.f};
                LAS float* gml_s = cw + 1280 + 384;
                int tid_o = tid; asm volatile("" : "+v"(tid_o));
#define ML_IDX() int tq_ = tid_o; asm volatile("" : "+v"(tq_)); const int dg = tq_ & 15, s0 = (tq_ >> 4) * 4, fr = tq_ & 15, quad = (tq_ >> 4) & 3; (void)dg; (void)s0; (void)fr; (void)quad;
                LAS bf16_t* halo = (LAS bf16_t*)(cw + 1280);
                for (int i = tid_o; i < 2 * 3 * 128; i += 512) halo[i] = 0;
                if (tid_o < 128) gml_s[tid_o] = mlg[h * 128 + tid_o];
                u32x4 rq[4], rk[4], rv[4]; float gx0 = 0.f, gx1 = 0.f, gi0 = -1e30f, gi1 = -1e30f;
#define ML_LBAR() asm volatile("s_waitcnt lgkmcnt(0)\n\ts_barrier" ::: "memory")
#define ML_LOADRAW(tc0) do { \
                    _Pragma("unroll") for (int i_ = 0; i_ < 4; ++i_) { const int t_ = (tc0) + s0 + i_; rq[i_] = (u32x4){0u, 0u, 0u, 0u}; rk[i_] = rq[i_]; rv[i_] = rq[i_]; \
                        if (t_ < TT) { const bf16_t* zr_ = Zp + (size_t)row_of(b, t_) * NZ + h * 128 + dg * 8; rq[i_] = *(const u32x4*)(zr_ + ZMQ); rk[i_] = *(const u32x4*)(zr_ + ZMK); rv[i_] = *(const u32x4*)(zr_ + ZMV); } } \
                    if (wave == 0) { const int ta_ = (tc0) + 2 * lane, tb_ = ta_ + 1; \
                        gx0 = (ta_ < TT) ? ld_agent_f(gatesp + (size_t)row_of(b, ta_) * 8 + 4 + h) : 0.f; gi0 = (ta_ < TT) ? ld_agent_f(gatesp + (size_t)row_of(b, ta_) * 8 + h) : -1e30f; \
                        gx1 = (tb_ < TT) ? ld_agent_f(gatesp + (size_t)row_of(b, tb_) * 8 + 4 + h) : 0.f; gi1 = (tb_ < TT) ? ld_agent_f(gatesp + (size_t)row_of(b, tb_) * 8 + h) : -1e30f; } } while (0)
                { ML_IDX(); ML_LOADRAW(0); }
                for (int c = 0; c < 33; ++c) {
                    const int t0 = c * 128;
                    ML_LBAR(); CSTAMP(0);
                    if (wave == 0) {
                        const float m_old0 = v_sc[0];
                        const float x0 = gx0, x1 = gx1, i0 = gi0, i1 = gi1;
                        const float sacc = wave_scan_add(x0 + x1);
                        const float ex = sacc - (x0 + x1);
                        const float b0 = ex + x0, b1 = b0 + x1;
                        const float a0 = i0 - b0, a1 = i1 - b1;
                        const float mx = wave_scan_max(fmaxf(a0, a1));
                        float exm = __shfl_up(mx, 1); if (lane == 0) exm = -INFINITY;
                        const float M0 = fmaxf(fmaxf(m_old0, exm), a0), M1 = fmaxf(M0, a1);
                        const float Ml = __shfl(M1, 63);
                        v_b[2 * lane] = b0; v_b[2 * lane + 1] = b1; v_a[2 * lane] = a0; v_a[2 * lane + 1] = a1; v_M[2 * lane] = M0; v_M[2 * lane + 1] = M1;
                        v_w[2 * lane] = (t0 + 2 * lane < TT) ? __expf(a0 - Ml) : 0.f; v_w[2 * lane + 1] = (t0 + 2 * lane + 1 < TT) ? __expf(a1 - Ml) : 0.f;
                        if (lane == 63) v_sc[1] = M1;
                    }
                    { ML_IDX();
#pragma unroll
                    for (int i = 0; i < 4; ++i) { *(LAS u32x4*)(Qs + (s0 + i) * PQ + dg * 8) = rq[i]; *(LAS u32x4*)(Ks + (s0 + i) * PQ + dg * 8) = rk[i]; }
#pragma unroll
                    for (int w2 = 0; w2 < 4; ++w2) {
                        const unsigned a0_ = rv[0][w2], a1_ = rv[1][w2], a2_ = rv[2][w2], a3_ = rv[3][w2];
                        u32x2 lo2, hi2; lo2.x = (a0_ & 0xffffu) | (a1_ << 16); lo2.y = (a2_ & 0xffffu) | (a3_ << 16);
                        hi2.x = (a0_ >> 16) | (a1_ & 0xffff0000u); hi2.y = (a2_ >> 16) | (a3_ & 0xffff0000u);
                        *(LAS u32x2*)(VTs + (dg * 8 + 2 * w2) * PQ + s0) = lo2; *(LAS u32x2*)(VTs + (dg * 8 + 2 * w2 + 1) * PQ + s0) = hi2;
                    } }
                    ML_LBAR(); CSTAMP(1);
                    {   ML_IDX();
                        u32x4 hq[3], hk[3];
#pragma unroll
                        for (int i = 0; i < 3; ++i) {
                            if (s0 > 0) { hq[i] = *(const LAS u32x4*)(Qs + (s0 - 3 + i) * PQ + dg * 8); hk[i] = *(const LAS u32x4*)(Ks + (s0 - 3 + i) * PQ + dg * 8); }
                            else { hq[i] = *(const LAS u32x4*)(halo + i * 128 + dg * 8); hk[i] = *(const LAS u32x4*)(halo + 384 + i * 128 + dg * 8); }
                        }
                        asm volatile("s_waitcnt lgkmcnt(0)" ::: "memory");
                        ML_LBAR(); CSTAMP(2);
                        u32x4 cq[4], ck[4];
#pragma unroll
                        for (int w2 = 0; w2 < 4; ++w2) {
                            int dgo = dg; asm volatile("" : "+v"(dgo));
                            f32x2 xq[7], xk[7];
#pragma unroll
                            for (int r = 0; r < 7; ++r) { const unsigned uq = (r < 3) ? hq[r < 3 ? r : 0][w2] : rq[r >= 3 ? r - 3 : 0][w2], uk = (r < 3) ? hk[r < 3 ? r : 0][w2] : rk[r >= 3 ? r - 3 : 0][w2];
                                xq[r] = (f32x2){bflo(uq), bfhi(uq)}; xk[r] = (f32x2){bflo(uk), bfhi(uk)}; }
                            const LAS f32x2* wp = (const LAS f32x2*)(cw + dgo * 8 + 2 * w2);
                            f32x2 wq[4], wk[4];
#pragma unroll
                            for (int j = 0; j < 4; ++j) { wq[j] = wp[j * 128]; wk[j] = wp[j * 128 + 64]; }
                            const f32x2 bq = wp[4 * 128], bk = wp[4 * 128 + 64];
#pragma unroll
                            for (int i = 0; i < 4; ++i) {
                                f32x2 aq = bq, ak = bk;
#pragma unroll
                                for (int j = 0; j < 4; ++j) { aq += wq[j] * xq[i + j]; ak += wk[j] * xk[i + j]; }
                                const bool live = (t0 + s0 + i < TT);
                                const float q0 = live ? aq[0] * sigmoidf_(aq[0]) : 0.f, q1 = live ? aq[1] * sigmoidf_(aq[1]) : 0.f;
                                const float k0 = live ? ak[0] * sigmoidf_(ak[0]) * 0.08838834764831845f : 0.f, k1 = live ? ak[1] * sigmoidf_(ak[1]) * 0.08838834764831845f : 0.f;
                                cq[i][w2] = pkbf(q0, q1); ck[i][w2] = pkbf(k0, k1);
                            }
                        }
#pragma unroll
                        for (int i = 0; i < 4; ++i) { *(LAS u32x4*)(Qs + (s0 + i) * PQ + dg * 8) = cq[i]; *(LAS u32x4*)(Ks + (s0 + i) * PQ + dg * 8) = ck[i]; }
                    if (s0 == 124) {
#pragma unroll
                        for (int i = 0; i < 3; ++i) { *(LAS u32x4*)(halo + i * 128 + dg * 8) = rq[i + 1]; *(LAS u32x4*)(halo + 384 + i * 128 + dg * 8) = rk[i + 1]; }
                    }
                    if (c + 1 < 33) ML_LOADRAW(t0 + 128);
                    }
                    ML_LBAR(); CSTAMP(3);
                    const float Mlast = v_sc[1], m_old = v_sc[0];
                    f32x4 St[8];
#pragma unroll
                    for (int j = 0; j < 8; ++j) St[j] = (f32x4){0.f, 0.f, 0.f, 0.f};
                    {   ML_IDX();
                        bf16x8 af[4];
#pragma unroll
                        for (int kk = 0; kk < 4; ++kk) af[kk] = *(const LAS bf16x8*)(Qs + (16 * wave + fr) * PQ + kk * 32 + quad * 8);
#pragma unroll
                        for (int j = 0; j < 8; ++j) if (j <= wave) {
#pragma unroll
                            for (int kk = 0; kk < 4; ++kk) { const bf16x8 bfv = *(const LAS bf16x8*)(Ks + (16 * j + fr) * PQ + kk * 32 + quad * 8);
                                St[j] = __builtin_amdgcn_mfma_f32_16x16x32_bf16(af[kk], bfv, St[j], 0, 0, 0); }
                        }
                    }
                    {   ML_IDX();
                        const float w_old = __expf(m_old - Mlast);
#pragma unroll
                        for (int jt = 0; jt < 9; ++jt) Cst[jt] = Cst[jt] * w_old;
#pragma unroll
                        for (int kk = 0; kk < 4; ++kk) {
                            const int rb = 32 * kk + 8 * quad;
                            const LAS bf16_t* kp = Ks + (rb + (fr >> 2)) * PQ + 16 * wave + 4 * (fr & 3);
                            const attn_body::s16x4 lo = attn_body::vtr((attn_body::lds_cptr)kp), hi4 = attn_body::vtr((attn_body::lds_cptr)(kp + 4 * PQ));
                            const f32x4 w0 = *(const LAS f32x4*)(v_w + rb), w1 = *(const LAS f32x4*)(v_w + rb + 4);
                            float kf[8];
#pragma unroll
                            for (int q = 0; q < 4; ++q) { kf[q] = __uint_as_float(((unsigned)(unsigned short)lo[q]) << 16) * w0[q]; kf[4 + q] = __uint_as_float(((unsigned)(unsigned short)hi4[q]) << 16) * w1[q]; }
                            u32x4 kw; kw.x = pkbf(kf[0], kf[1]); kw.y = pkbf(kf[2], kf[3]); kw.z = pkbf(kf[4], kf[5]); kw.w = pkbf(kf[6], kf[7]);
                            const bf16x8 bk = __builtin_bit_cast(bf16x8, kw);
#pragma unroll
                            for (int jt = 0; jt < 9; ++jt) { const bf16x8 av = *(const LAS bf16x8*)(VTs + (16 * jt + fr) * PQ + kk * 32 + quad * 8);
                                Cst[jt] = __builtin_amdgcn_mfma_f32_16x16x32_bf16(av, bk, Cst[jt], 0, 0, 0); }
                        }
                    }
                    ML_LBAR(); CSTAMP(4);
                    {   ML_IDX();
                        float Ms[4];
#pragma unroll
                        for (int jj = 0; jj < 4; ++jj) Ms[jj] = v_M[16 * wave + 4 * quad + jj];
#pragma unroll
                        for (int j = 0; j < 8; ++j) {
                            const int r = 16 * j + fr; const float ar = v_a[r];
#pragma unroll
                            for (int jj = 0; jj < 4; ++jj) { const int sx = 16 * wave + 4 * quad + jj;
                                const float w = (j <= wave && r <= sx) ? St[j][jj] * __expf(ar - Ms[jj]) : 0.f;
                                Ks[sx * PQ + r] = (bf16_t)(pkbf(w, 0.f) & 0xffffu); }
                        }
                    }
                    ML_LBAR(); CSTAMP(5);
                    float hv[8][4];
                    {   ML_IDX();
                        bf16x8 af[4], as_[4];
#pragma unroll
                        for (int kk = 0; kk < 4; ++kk) { af[kk] = *(const LAS bf16x8*)(Qs + (16 * wave + fr) * PQ + kk * 32 + quad * 8); as_[kk] = *(const LAS bf16x8*)(Ks + (16 * wave + fr) * PQ + kk * 32 + quad * 8); }
                        float winter[4], rd[4], ssq[4];
                        {   f32x4 n1 = (f32x4){0.f, 0.f, 0.f, 0.f}, n2 = n1;
#pragma unroll
                            for (int kk = 0; kk < 4; ++kk) { const bf16x8 bc = *(const LAS bf16x8*)(Cs + (128 + fr) * PQ + kk * 32 + quad * 8); const bf16x8 bvv = *(const LAS bf16x8*)(VTs + (128 + fr) * PQ + kk * 32 + quad * 8);
                                n1 = __builtin_amdgcn_mfma_f32_16x16x32_bf16(af[kk], bc, n1, 0, 0, 0); n2 = __builtin_amdgcn_mfma_f32_16x16x32_bf16(as_[kk], bvv, n2, 0, 0, 0); }
#pragma unroll
                            for (int jj = 0; jj < 4; ++jj) { const int sx = 16 * wave + 4 * quad + jj; const float Ms = v_M[sx]; winter[jj] = __expf(m_old - Ms);
                                float den = winter[jj] * n1[jj] + n2[jj];
                                den = __shfl(den, lane & 48);
                                rd[jj] = 1.0f / fmaxf(fabsf(den), __expf(-(v_b[sx] + Ms))); ssq[jj] = 0.f; }
                        }
#pragma unroll
                        for (int g2 = 0; g2 < 2; ++g2) {
                            f32x4 n1[4], n2[4];
#pragma unroll
                            for (int q = 0; q < 4; ++q) { n1[q] = (f32x4){0.f, 0.f, 0.f, 0.f}; n2[q] = n1[q]; }
#pragma unroll
                            for (int kk = 0; kk < 4; ++kk)
#pragma unroll
                                for (int q = 0; q < 4; ++q) { const int jt = 4 * g2 + q;
                                    const bf16x8 bc = *(const LAS bf16x8*)(Cs + (16 * jt + fr) * PQ + kk * 32 + quad * 8); const bf16x8 bvv = *(const LAS bf16x8*)(VTs + (16 * jt + fr) * PQ + kk * 32 + quad * 8);
                                    n1[q] = __builtin_amdgcn_mfma_f32_16x16x32_bf16(af[kk], bc, n1[q], 0, 0, 0); n2[q] = __builtin_amdgcn_mfma_f32_16x16x32_bf16(as_[kk], bvv, n2[q], 0, 0, 0); }
#pragma unroll
                            for (int q = 0; q < 4; ++q)
#pragma unroll
                                for (int jj = 0; jj < 4; ++jj) { const float x = (winter[jj] * n1[q][jj] + n2[q][jj]) * rd[jj]; hv[4 * g2 + q][jj] = x; ssq[jj] += x * x; }
                        }
#pragma unroll
                        for (int jj = 0; jj < 4; ++jj) { const float rs = 1.0f / sqrtf(row_sum16(ssq[jj]) * (1.f / 128.f) + LN_EPS);
#pragma unroll
                            for (int jt = 0; jt < 8; ++jt) hv[jt][jj] *= rs * gml_s[16 * jt + fr]; }
                    }
                    ML_LBAR(); CSTAMP(6);
                    u32x4 rmo[4];
                    { ML_IDX();
#pragma unroll
                    for (int i = 0; i < 4; ++i) { const int t = t0 + s0 + i; rmo[i] = (u32x4){0u, 0u, 0u, 0u};
                        if (t >= NMETA && t < TT) rmo[i] = *(const u32x4*)(Zp + (size_t)row_of(b, t) * NZ + ZMO + h * 128 + dg * 8); }
#pragma unroll
                    for (int jt = 0; jt < 8; ++jt)
#pragma unroll
                        for (int jj = 0; jj < 4; ++jj) Qs[(16 * wave + 4 * quad + jj) * PQ + 16 * jt + fr] = (bf16_t)(pkbf(hv[jt][jj], 0.f) & 0xffffu);
#pragma unroll
                    for (int jt = 0; jt < 9; ++jt)
#pragma unroll
                        for (int jj = 0; jj < 4; ++jj) Cs[(16 * jt + 4 * quad + jj) * PQ + 16 * wave + fr] = (bf16_t)(pkbf(Cst[jt][jj], 0.f) & 0xffffu);
                    if (tid == 0) v_sc[0] = v_b[127] + Mlast;
                    }
                    ML_LBAR(); CSTAMP(7);
                    { ML_IDX();
#pragma unroll
                    for (int i = 0; i < 4; ++i) {
                        const int s = s0 + i, t = t0 + s;
                        if (t >= NMETA && t < TT) {
                            const u32x4 hw = *(const LAS u32x4*)(Qs + s * PQ + dg * 8);
                            const u32x4 mw = rmo[i];
                            u32x4 wy;
                            wy.x = pkbf(sigmoidf_(bflo(mw.x)) * bflo(hw.x), sigmoidf_(bfhi(mw.x)) * bfhi(hw.x)); wy.y = pkbf(sigmoidf_(bflo(mw.y)) * bflo(hw.y), sigmoidf_(bfhi(mw.y)) * bfhi(hw.y));
                            wy.z = pkbf(sigmoidf_(bflo(mw.z)) * bflo(hw.z), sigmoidf_(bfhi(mw.z)) * bfhi(hw.z)); wy.w = pkbf(sigmoidf_(bflo(mw.w)) * bflo(hw.w), sigmoidf_(bfhi(mw.w)) * bfhi(hw.w));
                            *(u32x4*)(YCp + (size_t)row_of(b, t) * DM + 512 + h * 128 + dg * 8) = wy;
                        }
                    } }
                }
            }
        }
#undef ML_LOADRAW
#undef ML_LBAR
#undef ML_IDX
        PSTAMP(13);
        __syncthreads();
        REPLOOP(2A) {
            LAS int* tkt = (LAS int*)(L + MISC_OFF + 16);
            bf16_t* Qcp = Qc; bf16_t* Kcp = Kc; bf16_t* Vcp = Vc; bf16_t* YCp2 = YCb; unsigned* tctr = ctl + CW_TICKET + 64 * rep_;
            const float* attg = PF(12); unsigned char* parkb = WSP + WS_O;
            float lam;
            { const float p1 = wave_sum(PF(8)[lane] * PF(9)[lane]), p2 = wave_sum(PF(10)[lane] * PF(11)[lane]); lam = expf(p1) - expf(p2) + LAMBDA_INIT; }
            const float* wgu = PF(21); const float* wdn = PF(23); bf16_t* WguTp = WguT; bf16_t* WdnTp = WdnT;
            constexpr int NATT = NB * 4 * 16, NJOB = NE * 16;
            int nextT = 0;
            if (tid == 0) nextT = (int)__hip_atomic_fetch_add(tctr, 1u, RLX_AGENT);
            for (;;) {
                __syncthreads();
                if (tid == 0) { *tkt = nextT; nextT = (int)__hip_atomic_fetch_add(tctr, 1u, RLX_AGENT); }
                __syncthreads();
                const int T = __builtin_amdgcn_readfirstlane(*tkt);
                if (T >= NATT + NJOB) break;
                int Lidx;
                { const int q = T / 3, r = T - q * 3;
                  if (q < NJOB) {
                      if (r == 2) {
                          const int e = q >> 4, kb = q & 15; LAS unsigned char* scr = L + wave * 17408;
                          for (int it = wave; it < 48; it += NWAVES) {
                              if (it < 32) transpose_tile64_fp8(wgu + (size_t)e * 1024 * 2048, 2048, (unsigned char*)WguTp + (size_t)e * 2048 * 1024, 1024, scr, 64 * kb, 64 * it, lane, InvGu(), FP8_SB1);
                              else transpose_tile64(wdn + (size_t)e * 1024 * 1024, 1024, WdnTp + (size_t)e * 1024 * 1024, 1024, scr, 64 * kb, 64 * (it - 32), lane, InvIdent());
                          }
                          continue;
                      }
                      Lidx = q * 2 + r;
                  } else Lidx = T - NJOB; }
                const int bh = Lidx & 63, qb = 15 - (Lidx >> 6);
                const int b = bh >> 2, h = bh & 3;
                int tid_p = tid; asm volatile("" : "+v"(tid_p));
                u32x4* parkp = (u32x4*)parkb + ((size_t)blk * 512 + tid_p) * 8;
                attn_body::attn4_unit<8>(qb, (const attn_body::bf16*)(Qcp + (size_t)(b * 8 + 2 * h) * TT * 64), (const attn_body::bf16*)(Kcp + (size_t)(b * 8 + 2 * h) * TT * 64), (long)TT * 64,
                                         (const attn_body::bf16*)(Vcp + (size_t)(b * 4 + h) * TT * 128), YCp2, b * SEQ, h * 128, lam, attg, parkp, (char*)lds);
            }
        }
        __syncthreads();
        if (BOTH(2)) GRID_BAR();
    }
    PSTAMP(2);

    PSTAMP(3);

    if (IN(4)) REPLOOP(4) {
        {   pg8::Gemm g{YCb, WaT, DM, 1024, 4, nullptr, nullptr, 0};
            pg8::StaticOrder S; S.init(NREAL / 256, 4, G, blk);
            pg8::EpiGateFused E{GFb, MRGb};
            pg8::gemm_phase<0, pg8::EpiGateFused, true>(L, g, S, E); }
        if (BOTH(4) || rep_ + 1 < REP_4) GRID_BAR();
    }
    PSTAMP(4);

    if (IN(5)) REPLOOP(5) {
        pg8::Gemm g{MRGb, WoT, DM, 1024, 4, nullptr, nullptr, 0};
        pg8::StaticOrder S; S.init(NREAL / 256, 4, G, blk);
        pg8::EpiStoreBf16 E{TMPb, DM};
        pg8::gemm_phase<0, pg8::EpiStoreBf16>(L, g, S, E);
        if (BOTH(5) || rep_ + 1 < REP_5) GRID_BAR();
    }
    PSTAMP(5);

    constexpr int NPART = 256, RPP = NREAL / NPART;
    static_assert(NPART * RPP == NREAL, "partitions");
    if (IN(6)) REPLOOP(6) {
        LAS float* wrT = (LAS float*)L;
        LAS int* hcnt = (LAS int*)(L + 131072);
        { const float* wr = PF(19);
          for (int i = tid; i < 8 * 1024; i += 512) { const int k = i & 1023, q4 = i >> 10; const f32x4 v = *(const f32x4*)(wr + k * 32 + 4 * q4);
              wrT[(4 * q4 + 0) * 1024 + k] = v[0]; wrT[(4 * q4 + 1) * 1024 + k] = v[1]; wrT[(4 * q4 + 2) * 1024 + k] = v[2]; wrT[(4 * q4 + 3) * 1024 + k] = v[3]; } }
        const float* xin = PF(0); const float* g0p = PF(2); const float* b0p = PF(3); const float* statsp = stats; const bf16_t* mixp = TMPb;
        const float* g1p = PF(17); const float* b1p = PF(18);
        const float brt = PF(20)[(lane >> 1) & 31];
        bf16_t* Hbp = Hb; int* tokE = tok_e; float* tokG = tok_g; int* histp = hist; unsigned char* H8p = WSP + WS_H8;
        for (int part = blk; part < NPART; part += G) {
            __syncthreads();
            if (tid < 32) hcnt[tid] = 0;
            __syncthreads();
            const int rbeg = part * RPP, rend = rbeg + RPP;
            constexpr int RPW = (RPP + NWAVES - 1) / NWAVES;
            const int wbeg = rbeg + wave * RPW, wend = (wbeg + RPW < rend) ? wbeg + RPW : rend;
            for (int row = wbeg; row < wend; row += 2) {
                int lane_o = lane; asm volatile("" : "+v"(lane_o));
                const bool two = (row + 1 < wend);
                const int row1 = two ? row + 1 : row;
                const float m0_ = ld_agent_f(statsp + 2 * row), r0_ = ld_agent_f(statsp + 2 * row + 1), m1_ = ld_agent_f(statsp + 2 * row1), r1_ = ld_agent_f(statsp + 2 * row1 + 1);
                f32x4 v0[4], v1[4]; float s0 = 0.f, s1 = 0.f;
#pragma unroll
                for (int j = 0; j < 4; ++j) { v0[j] = *(const f32x4*)(xin + (size_t)row * DM + 4 * lane_o + 256 * j); v1[j] = *(const f32x4*)(xin + (size_t)row1 * DM + 4 * lane_o + 256 * j); }
#pragma unroll
                for (int j = 0; j < 4; ++j) {
                    const u32x2 x0 = *(const u32x2*)(mixp + (size_t)row * DM + 4 * lane_o + 256 * j), x1 = *(const u32x2*)(mixp + (size_t)row1 * DM + 4 * lane_o + 256 * j);
                    const f32x4 g0v = *(const f32x4*)(g0p + 4 * lane_o + 256 * j), b0v = *(const f32x4*)(b0p + 4 * lane_o + 256 * j);
                    v0[j] = ((v0[j] - m0_) * r0_ * g0v + b0v) * DN_ALPHA + (f32x4){bflo(x0.x), bfhi(x0.x), bflo(x0.y), bfhi(x0.y)};
                    v1[j] = ((v1[j] - m1_) * r1_ * g0v + b0v) * DN_ALPHA + (f32x4){bflo(x1.x), bfhi(x1.x), bflo(x1.y), bfhi(x1.y)};
                }
#pragma unroll
                for (int j = 0; j < 4; ++j) { s0 += (v0[j][0] + v0[j][1]) + (v0[j][2] + v0[j][3]); s1 += (v1[j][0] + v1[j][1]) + (v1[j][2] + v1[j][3]); }
                const float mean0 = wave_sum(s0) * (1.f / DM), mean1 = wave_sum(s1) * (1.f / DM); float q0 = 0.f, q1 = 0.f;
#pragma unroll
                for (int j = 0; j < 4; ++j) { const f32x4 d0 = v0[j] - mean0, d1 = v1[j] - mean1;
                    q0 += (d0[0] * d0[0] + d0[1] * d0[1]) + (d0[2] * d0[2] + d0[3] * d0[3]); q1 += (d1[0] * d1[0] + d1[1] * d1[1]) + (d1[2] * d1[2] + d1[3] * d1[3]); }
                const float rstd0 = 1.0f / sqrtf(wave_sum(q0) * (1.f / DM) + LN_EPS), rstd1 = 1.0f / sqrtf(wave_sum(q1) * (1.f / DM) + LN_EPS);
#pragma unroll
                for (int j = 0; j < 4; ++j) {
                    const f32x4 ggj = *(const f32x4*)(g1p + 4 * lane_o + 256 * j), bbj = *(const f32x4*)(b1p + 4 * lane_o + 256 * j);
                    v0[j] = (v0[j] - mean0) * rstd0 * ggj + bbj; v1[j] = (v1[j] - mean1) * rstd1 * ggj + bbj;
                    u32x2 w; w.x = pkbf(v0[j][0], v0[j][1]); w.y = pkbf(v0[j][2], v0[j][3]);
                    *(u32x2*)(Hbp + (size_t)row * DM + 4 * lane_o + 256 * j) = w;
                    *(unsigned*)(H8p + (size_t)row * DM + 4 * lane_o + 256 * j) = pkfp8x4(v0[j][0] * FP8_SA1, v0[j][1] * FP8_SA1, v0[j][2] * FP8_SA1, v0[j][3] * FP8_SA1);
                    if (two) { w.x = pkbf(v1[j][0], v1[j][1]); w.y = pkbf(v1[j][2], v1[j][3]); *(u32x2*)(Hbp + (size_t)row1 * DM + 4 * lane_o + 256 * j) = w;
                        *(unsigned*)(H8p + (size_t)row1 * DM + 4 * lane_o + 256 * j) = pkfp8x4(v1[j][0] * FP8_SA1, v1[j][1] * FP8_SA1, v1[j][2] * FP8_SA1, v1[j][3] * FP8_SA1); }
                }
                float p0[32], p1[32];
#pragma unroll
                for (int e = 0; e < 32; ++e) {
                    f32x2 a0 = (f32x2){0.f, 0.f}, a1 = a0;
#pragma unroll
                    for (int j = 0; j < 4; ++j) { const f32x4 wv = *(const LAS f32x4*)(wrT + e * 1024 + 4 * lane_o + 256 * j);
                        const f32x2 wl = (f32x2){wv[0], wv[1]}, wh = (f32x2){wv[2], wv[3]};
                        a0 += (f32x2){v0[j][0], v0[j][1]} * wl; a0 += (f32x2){v0[j][2], v0[j][3]} * wh;
                        a1 += (f32x2){v1[j][0], v1[j][1]} * wl; a1 += (f32x2){v1[j][2], v1[j][3]} * wh; }
                    p0[e] = a0[0] + a0[1]; p1[e] = a1[0] + a1[1];
                    if ((e & 3) == 3) __builtin_amdgcn_sched_barrier(0);
                }
                float lg0 = xreduce32(p0, lane_o) + brt, lg1 = xreduce32(p1, lane_o) + brt;
#pragma unroll
                for (int rr = 0; rr < 2; ++rr) {
                    float lg = rr ? lg1 : lg0; const int rw = rr ? row1 : row;
                    float tv[4]; int ti[4];
#pragma unroll
                    for (int k = 0; k < 4; ++k) {
                        const float mx = wave_max(lg);
                        const unsigned long long bal = __ballot(lg == mx);
                        const int idx = (__ffsll((long long)bal) - 1) >> 1;
                        tv[k] = mx; ti[k] = idx;
                        if ((lane_o >> 1) == idx) lg = -INFINITY;
                    }
                    const float e1 = __expf(tv[1] - tv[0]), e2 = __expf(tv[2] - tv[0]), e3 = __expf(tv[3] - tv[0]);
                    const float inv = 1.0f / (1.0f + e1 + e2 + e3);
                    if (lane_o < 4 && (rr == 0 || two)) {
                        const int idx = (lane_o == 0) ? ti[0] : (lane_o == 1) ? ti[1] : (lane_o == 2) ? ti[2] : ti[3];
                        const float gv = ((lane_o == 0) ? 1.0f : (lane_o == 1) ? e1 : (lane_o == 2) ? e2 : e3) * inv;
                        tokE[(size_t)rw * 4 + lane_o] = idx; tokG[(size_t)rw * 4 + lane_o] = gv;
                        atomicAdd((int*)&hcnt[idx], 1);
                    }
                }
            }
            __syncthreads();
            if (tid < 32) histp[part * 32 + tid] = hcnt[tid];
        }
        if (BOTH(6) || rep_ + 1 < REP_6) GRID_BAR();
    }
    PSTAMP(6);

    if (IN(7)) REPLOOP(7) {
        LAS int* cnt_s = (LAS int*)L; LAS int* base_s = cnt_s + 32; LAS int* pst_s = cnt_s + 64;
        LAS int* ptot = cnt_s + 128; LAS int* pbase = ptot + 512;
        LAS int* ccnt = pbase + 512;
        LAS int* ent = ccnt + 1024; LAS int* lrank = ent + RPP * 4 + 64;
        int* rowOff = row_off; int* rowSlot = row_slot; float* rowGate = row_gate; const int* histp = hist; const int* tokE = tok_e; const float* tokG = tok_g;
        for (int part = blk; part < NPART; part += G) {
            __syncthreads();
            { const int e = tid & 31, q = tid >> 5; int tot = 0, bs = 0;
#pragma unroll 4
              for (int b2 = q * 16; b2 < q * 16 + 16; ++b2) { const int v = ld_agent_i(histp + b2 * 32 + e); tot += v; bs += (b2 < part) ? v : 0; }
              ptot[q * 32 + e] = tot; pbase[q * 32 + e] = bs; }
            const int rbeg = part * RPP, n4 = RPP * 4;
            for (int i = tid; i < n4; i += 512) ent[i] = ld_agent_i(tokE + (size_t)rbeg * 4 + i);
            __syncthreads();
            if (tid < 32) { int tot = 0, bs = 0;
#pragma unroll
                for (int q = 0; q < 16; ++q) { tot += ptot[q * 32 + tid]; bs += pbase[q * 32 + tid]; }
                cnt_s[tid] = tot; base_s[tid] = bs; }
            constexpr int NCH = (RPP * 4 + 63) / 64;
            for (int c = wave; c < NCH; c += NWAVES) {
                const int i = 64 * c + lane; const int my = (i < n4) ? ent[i] : -1; int lr = 0;
#pragma unroll 4
                for (int e = 0; e < 32; ++e) { const unsigned long long b = __ballot(my == e);
                    if (lane == e) ccnt[c * 32 + e] = __popcll(b);
                    if (my == e) lr = __popcll(b & ((1ull << lane) - 1ull)); }
                if (i < n4) lrank[i] = lr;
            }
            __syncthreads();
            if (tid == 0) { int p = 0; for (int e = 0; e < 32; ++e) { pst_s[e] = p; p += (cnt_s[e] + 255) & ~255; } pst_s[32] = p; }
            __syncthreads();
            if (tid < 32) { int run = pst_s[tid] + base_s[tid];
                for (int c = 0; c < NCH; ++c) { const int tmp = ccnt[c * 32 + tid]; ccnt[c * 32 + tid] = run; run += tmp; } }
            __syncthreads();
            for (int i = tid; i < n4; i += 512) { const int e = ent[i]; const int pos = ccnt[(i >> 6) * 32 + e] + lrank[i];
                rowOff[pos] = (rbeg + (i >> 2)) * DM;        rowSlot[pos] = rbeg * 4 + i; rowGate[pos] = ld_agent_f(tokG + (size_t)rbeg * 4 + i); }
            if (part < 32) { const int e = part; for (int r = pst_s[e] + cnt_s[e] + tid; r < pst_s[e + 1]; r += 512) { rowOff[r] = 0; rowSlot[r] = NREAL * 4; rowGate[r] = 0.f; } }
            if (part == 0) { const int nT = pst_s[32] >> 8; int* te = tile_exp;
                for (int t = tid; t < nT; t += 512) { int e = 0; while (e < 31 && t * 256 >= pst_s[e + 1]) ++e; te[t] = e; }
                if (tid == 0) __hip_atomic_store((int*)(ctl + CW_NT), nT, RLX_AGENT); }
        }
        __syncthreads();
        if (BOTH(7) || rep_ + 1 < REP_7) GRID_BAR();
    }
    PSTAMP(7);

    {
        int nT = 0, TPC = 0;
        if (lo < 12 && hi > 8) { nT = __builtin_amdgcn_readfirstlane(ld_agent_i((const int*)(ctl + CW_NT))); TPC = (nT > 512) ? 512 : nT; }
        if (IN(8)) REPLOOP(8) {
            pg8::Gemm g{(const bf16_t*)(WSP + WS_H8), WguT, DM, DM / 2, 8, row_off, tile_exp, 0};
            pg8::StaticOrder S; S.init(TPC, 8, G, blk);
            pg8::EpiAct E{ACT, PF(22), tile_exp, 0, 1.0f / (FP8_SA1 * FP8_SB1)};
            pg8::gemm_phase<1, pg8::EpiAct, false, true>(L, g, S, E);
            if (BOTH(8) || rep_ + 1 < REP_8) GRID_BAR();
        }
        PSTAMP(8);
        if (IN(9)) REPLOOP(9) {
            pg8::Gemm g{ACT, WdnT, FF, FF, 4, nullptr, tile_exp, 0};
            pg8::StaticOrder S; S.init(TPC, 4, G, blk);
            pg8::EpiDown E{Y, PF(24), tile_exp, row_slot, row_gate, 0};
            pg8::gemm_phase<2, pg8::EpiDown>(L, g, S, E);
            if (BOTH(9) || rep_ + 1 < REP_9) GRID_BAR();
        }
        PSTAMP(9);
        if (IN(10)) REPLOOP(10) {
            pg8::Gemm g{(const bf16_t*)(WSP + WS_H8), WguT, DM, DM / 2, 8, row_off, tile_exp, TPC};
            pg8::StaticOrder S; S.init(nT - TPC, 8, G, blk);
            pg8::EpiAct E{ACT, PF(22), tile_exp, TPC, 1.0f / (FP8_SA1 * FP8_SB1)};
            pg8::gemm_phase<1, pg8::EpiAct, false, true>(L, g, S, E);
            if (BOTH(10) || rep_ + 1 < REP_10) GRID_BAR();
        }
        PSTAMP(10);
        if (IN(11)) REPLOOP(11) {
            pg8::Gemm g{ACT, WdnT, FF, FF, 4, nullptr, tile_exp, TPC};
            pg8::StaticOrder S; S.init(nT - TPC, 4, G, blk);
            pg8::EpiDown E{Y, PF(24), tile_exp, row_slot, row_gate, TPC};
            pg8::gemm_phase<2, pg8::EpiDown>(L, g, S, E);
            if (BOTH(11) || rep_ + 1 < REP_11) GRID_BAR();
        }
        PSTAMP(11);
    }

    if (IN(12)) REPLOOP(12) {
        for (int row = gw; row < NREAL; row += NGW) {
            f32x4 v[4]; float s = 0.f;
#pragma unroll
            for (int j = 0; j < 4; ++j) {
                const u32x2 hw = *(const u32x2*)(Hb + (size_t)row * DM + 4 * lane + 256 * j);
                f32x4 acc = (f32x4){bflo(hw.x), bfhi(hw.x), bflo(hw.y), bfhi(hw.y)} * DN_ALPHA;
#pragma unroll
                for (int k = 0; k < 4; ++k) { const u32x2 yw = *(const u32x2*)(Y + ((size_t)row * 4 + k) * DM + 4 * lane + 256 * j);
                    acc += (f32x4){bflo(yw.x), bfhi(yw.x), bflo(yw.y), bfhi(yw.y)}; }
                v[j] = acc; s += (acc[0] + acc[1]) + (acc[2] + acc[3]);
            }
            const float mean = wave_sum(s) * (1.f / DM); float s2 = 0.f;
#pragma unroll
            for (int j = 0; j < 4; ++j) { const f32x4 d = v[j] - mean; s2 += (d[0] * d[0] + d[1] * d[1]) + (d[2] * d[2] + d[3] * d[3]); }
            const float rstd = 1.0f / sqrtf(wave_sum(s2) * (1.f / DM) + LN_EPS);
            float* orow = (float*)DOUTP + (size_t)row * DM;
#pragma unroll
            for (int j = 0; j < 4; ++j) {
                const f32x4 gg = *(const f32x4*)(PF(25) + 4 * lane + 256 * j), bb = *(const f32x4*)(PF(26) + 4 * lane + 256 * j);
                *(f32x4*)(orow + 4 * lane + 256 * j) = (v[j] - mean) * rstd * gg + bb;
            }
        }
#if MK_PROBE == 2
        __syncthreads();
        PSTAMP(12);
        if (blk == 0 && tid == 0) pdur[14] = pdur[30] - pdur[29];
        if (blk == 0 && tid == 0) { asm volatile("s_waitcnt vmcnt(0)" ::: "memory"); ((float*)DOUTP)[0] += (float)pdur[MK_PROBE_K] * (0.01f / MK_PROBE_DIV); }
#elif MK_PROBE
        __syncthreads();
        if (blk == 0 && tid == 0) { const unsigned cyc = __hip_atomic_load(ctl + CW_PROBE, RLX_AGENT), st = __hip_atomic_load(ctl + CW_PROBE + 1, RLX_AGENT);
            asm volatile("s_waitcnt vmcnt(0)" ::: "memory"); ((float*)DOUTP)[0] += (float)cyc / (float)(st ? st : 1u); }
#endif
    }
#undef IN
#undef BOTH
#undef GRID_BAR
}

constexpr int N_PHASES = 13;
extern "C" void kernel_launch(void* const* d_in, const int* in_sizes, int n_in, void* d_out, int out_size, void* d_ws, size_t ws_size, hipStream_t stream) {
    static int grid = 0;
    if (grid == 0) {
        if (n_in != 27 || ws_size < WS_END) { fprintf(stderr, "kernel_launch: unexpected n_in %d / ws_size %zu\n", n_in, ws_size); grid = -1; return; }
        int dev = 0, cus = 0;
        if (hipGetDevice(&dev) != hipSuccess || hipDeviceGetAttribute(&cus, hipDeviceAttributeMultiprocessorCount, dev) != hipSuccess) { grid = -1; return; }
        if (hipFuncSetAttribute((const void*)hybrid_fwd, hipFuncAttributeMaxDynamicSharedMemorySize, LDS_BYTES) != hipSuccess) { fprintf(stderr, "kernel_launch: hipFuncSetAttribute failed\n"); grid = -1; return; }
        int per_cu = 0;
        (void)hipOccupancyMaxActiveBlocksPerMultiprocessor(&per_cu, (const void*)hybrid_fwd, NWAVES * 64, LDS_BYTES);
        (void)hipGetLastError();
        grid = cus > 0 ? cus : 256;
    }
    if (grid < 0) return;
    (void)hipMemsetAsync((char*)d_ws + WS_CTL, 0, CTL_ZERO_BYTES, stream);
    Args a{};
    const float** fp = (const float**)&a;
    for (int i = 0; i < 27; ++i) fp[i] = (const float*)d_in[i];
    a.out = (float*)d_out; a.ws = (unsigned char*)d_ws;
#if MK_PER_PHASE
    for (int p = 0; p < N_PHASES; ++p) { a.ph_lo = p; a.ph_hi = p + 1; hipLaunchKernelGGL(hybrid_fwd, dim3(grid), dim3(NWAVES * 64), LDS_BYTES, stream, a); }
#else
    a.ph_lo = 0; a.ph_hi = N_PHASES;
    hipLaunchKernelGGL(hybrid_fwd, dim3(grid), dim3(NWAVES * 64), LDS_BYTES, stream, a);
#endif
}
```

```cpp
#include <hip/hip_runtime.h>
#include <hip/hip_bf16.h>
#include <cstdio>
#include <cstdint>
#include <cmath>

#ifndef MK_PER_PHASE
#define MK_PER_PHASE 0
#endif

#ifndef REP_ALL
#define REP_ALL 1
#endif
#ifndef REP_0
#define REP_0 REP_ALL
#endif
#ifndef REP_1
#define REP_1 REP_ALL
#endif
#ifndef REP_2A
#define REP_2A REP_ALL
#endif
#ifndef REP_2B
#define REP_2B REP_ALL
#endif
#ifndef REP_3
#define REP_3 REP_ALL
#endif
#ifndef REP_4
#define REP_4 REP_ALL
#endif
#ifndef REP_5
#define REP_5 REP_ALL
#endif
#ifndef REP_6
#define REP_6 REP_ALL
#endif
#ifndef REP_7
#define REP_7 REP_ALL
#endif
#ifndef REP_8
#define REP_8 REP_ALL
#endif
#ifndef REP_9
#define REP_9 REP_ALL
#endif
#ifndef REP_10
#define REP_10 REP_ALL
#endif
#ifndef REP_11
#define REP_11 REP_ALL
#endif
#ifndef REP_12
#define REP_12 REP_ALL
#endif
#define REPLOOP(k) _Pragma("unroll 1") for (int rep_ = 0; rep_ < REP_##k; ++rep_)
#ifndef MK_PROBE
#define MK_PROBE 0
#endif
#ifndef MK_PROBE_K
#define MK_PROBE_K 2
#define MK_PROBE_DIV 10.0f
#endif
#define LAS __attribute__((address_space(3)))
#define GAS __attribute__((address_space(1)))
typedef unsigned short bf16_t;
typedef short bf16x8 __attribute__((ext_vector_type(8)));
typedef float f32x4 __attribute__((ext_vector_type(4)));
typedef float f32x2 __attribute__((ext_vector_type(2)));
typedef unsigned u32x4 __attribute__((ext_vector_type(4)));
typedef unsigned u32x2 __attribute__((ext_vector_type(2)));
typedef __bf16 bf16x2_t __attribute__((ext_vector_type(2)));
#define RLX_AGENT __ATOMIC_RELAXED, __HIP_MEMORY_SCOPE_AGENT

constexpr int NB = 16, SEQ = 4096, NMETA = 16, TT = SEQ + NMETA  , MROWS = NB * TT  , DM = 1024;
constexpr int NREAL = NB * SEQ;
constexpr int NZP = 5632;
constexpr int NZ = 2080;
constexpr int ZMQ = 0, ZMK = 512, ZMV = 1024, ZMO = 1536, ZGA = 2048, ZGM = 3072;
constexpr int ZYC = 0;
constexpr int NIN = 5640;
constexpr int NE = 32, FF = 1024;
constexpr int OROWS = 4352;
constexpr float LN_EPS = 1e-5f;
constexpr float DN_ALPHA = 1.189207115002721f;
constexpr float LAMBDA_INIT = 0.2f;
constexpr float FP8_SA2 = 8.0f, FP8_SB2 = 512.0f;
constexpr float FP8_SA1 = 16.0f, FP8_SB1 = 512.0f;
constexpr float ATT_C2 = 0.125f * 1.4426950408889634f;

constexpr size_t MiB = 1u << 20;
constexpr size_t WS_CTL = 0, CTL_ZERO_BYTES = 32768;
constexpr size_t WS_WIN = 2 * MiB;
constexpr size_t WS_WA = 13 * MiB;
constexpr size_t WS_WM = 14 * MiB;
constexpr size_t WS_WO = 15 * MiB;
constexpr size_t WS_ROPE = 17 * MiB;
constexpr size_t WS_STATS = 19 * MiB;
constexpr size_t WS_GATES = 20 * MiB;
constexpr size_t WS_TOKE = 23 * MiB;
constexpr size_t WS_TOKG = 24 * MiB + 512 * 1024;
constexpr size_t WS_HIST = 26 * MiB;
constexpr size_t WS_ROWOFF = 27 * MiB;
constexpr size_t WS_ROWSLOT = 28 * MiB + 512 * 1024;
constexpr size_t WS_ROWGATE = 30 * MiB;
constexpr size_t WS_TILEEXP = 31 * MiB + 512 * 1024;
constexpr size_t WS_H = 32 * MiB;
constexpr size_t WS_Z = 162 * MiB;
constexpr size_t WS_Y = WS_Z;
constexpr size_t WS_ACT = WS_Z + 516 * MiB;
constexpr size_t WS_GF = 424 * MiB;
constexpr size_t WS_QC = 686 * MiB;
constexpr size_t WS_KC = 751 * MiB;
constexpr size_t WS_VC = 816 * MiB;
constexpr size_t WS_TMP = 686 * MiB;
constexpr size_t WS_MRG = 816 * MiB;
constexpr size_t WS_O = 882 * MiB;
constexpr size_t WS_H8 = 952 * MiB;
constexpr size_t WS_END = 1024 * MiB;
constexpr size_t DO_WGU = 0;
constexpr size_t DO_WDN = 128 * MiB;
constexpr int CW_TMO = 0, CW_NT = 64, CW_TICKET = 128  , CW_PROBE = 1024, CW_BAR = 4096;

constexpr int LDS_BYTES = 163840;
constexpr int MISC_OFF = 163840 - 512;
constexpr int NWAVES = 8;

__device__ __forceinline__ unsigned pkbf(float lo, float hi) { f32x2 v = {lo, hi}; bf16x2_t b = __builtin_convertvector(v, bf16x2_t); return __builtin_bit_cast(unsigned, b); }
__device__ __forceinline__ float bflo(unsigned w) { return __uint_as_float(w << 16); }
__device__ __forceinline__ float bfhi(unsigned w) { return __uint_as_float(w & 0xffff0000u); }
__device__ __forceinline__ float sigmoidf_(float x) { return __builtin_amdgcn_rcpf(1.0f + __expf(-x)); }
template <int CTRL> __device__ __forceinline__ float dppf(float v) { return __builtin_bit_cast(float, __builtin_amdgcn_update_dpp(0, __builtin_bit_cast(int, v), CTRL, 0xF, 0xF, true)); }
__device__ __forceinline__ float rdlane(float v, int l) { return __builtin_bit_cast(float, __builtin_amdgcn_readlane(__builtin_bit_cast(int, v), l)); }
__device__ __forceinline__ float row_sum16(float v) { v += dppf<0xB1>(v); v += dppf<0x4E>(v); v += dppf<0x141>(v); v += dppf<0x140>(v); return v; }
__device__ __forceinline__ float wave_sum(float v) { v = row_sum16(v); return (rdlane(v, 0) + rdlane(v, 16)) + (rdlane(v, 32) + rdlane(v, 48)); }
__device__ __forceinline__ float wave_max(float v) {
    v = fmaxf(v, dppf<0xB1>(v)); v = fmaxf(v, dppf<0x4E>(v)); v = fmaxf(v, dppf<0x141>(v)); v = fmaxf(v, dppf<0x140>(v));
    return fmaxf(fmaxf(rdlane(v, 0), rdlane(v, 16)), fmaxf(rdlane(v, 32), rdlane(v, 48)));
}
__device__ __forceinline__ float xreduce32(float (&p)[32], int lane) {
    float a[16], b[8], c[4], d[2];
#pragma unroll
    for (int i = 0; i < 16; ++i) { auto r = __builtin_amdgcn_permlane32_swap(__float_as_uint(p[i]), __float_as_uint(p[16 + i]), false, false); a[i] = __uint_as_float(r[0]) + __uint_as_float(r[1]); }
#pragma unroll
    for (int i = 0; i < 8; ++i) { auto r = __builtin_amdgcn_permlane16_swap(__float_as_uint(a[i]), __float_as_uint(a[8 + i]), false, false); b[i] = __uint_as_float(r[0]) + __uint_as_float(r[1]); }
    const bool b3 = (lane & 8) != 0, b2 = (lane & 4) != 0, b1 = (lane & 2) != 0;
#pragma unroll
    for (int i = 0; i < 4; ++i) { const float keep = b3 ? b[4 + i] : b[i], send = b3 ? b[i] : b[4 + i]; c[i] = keep + dppf<0x128>(send); }
#pragma unroll
    for (int i = 0; i < 2; ++i) { const float keep = b2 ? c[2 + i] : c[i], send = b2 ? c[i] : c[2 + i]; d[i] = keep + dppf<0x141>(send); }
    const float keep = b1 ? d[1] : d[0], send = b1 ? d[0] : d[1];
    float r = keep + dppf<0x4E>(send);
    r += dppf<0xB1>(r);
    return r;
}
__device__ __forceinline__ int ld_agent_i(const int* p) { return __hip_atomic_load(p, RLX_AGENT); }
__device__ __forceinline__ float ld_agent_f(const float* p) { return __hip_atomic_load(p, RLX_AGENT); }
#define LDS_WAIT() asm volatile("s_waitcnt lgkmcnt(0)" ::: "memory")
template <int CTRL, int RMASK> __device__ __forceinline__ float dpp_old(float old, float v) { return __builtin_bit_cast(float, __builtin_amdgcn_update_dpp(__builtin_bit_cast(int, old), __builtin_bit_cast(int, v), CTRL, RMASK, 0xF, false)); }
__device__ __forceinline__ float wave_scan_add(float v) {
    v += dpp_old<0x111, 0xF>(0.f, v); v += dpp_old<0x112, 0xF>(0.f, v); v += dpp_old<0x114, 0xF>(0.f, v); v += dpp_old<0x118, 0xF>(0.f, v);
    v += dpp_old<0x142, 0xA>(0.f, v); v += dpp_old<0x143, 0xC>(0.f, v); return v; }
__device__ __forceinline__ float wave_scan_max(float v) {
    const float ninf = -INFINITY;
    v = fmaxf(v, dpp_old<0x111, 0xF>(ninf, v)); v = fmaxf(v, dpp_old<0x112, 0xF>(ninf, v)); v = fmaxf(v, dpp_old<0x114, 0xF>(ninf, v)); v = fmaxf(v, dpp_old<0x118, 0xF>(ninf, v));
    v = fmaxf(v, dpp_old<0x142, 0xA>(ninf, v)); v = fmaxf(v, dpp_old<0x143, 0xC>(ninf, v)); return v; }
__device__ __forceinline__ int row_of(int b, int t) { return (t < NMETA) ? NREAL + b * NMETA + t : b * SEQ + (t - NMETA); }
__device__ __forceinline__ void bt_of(int row, int& b, int& t) { if (row < NREAL) { b = row >> 12; t = (row & (SEQ - 1)) + NMETA; } else { const int m = row - NREAL; b = m >> 4; t = m & (NMETA - 1); } }
__device__ __forceinline__ unsigned pkfp8x4(float a, float b, float c, float d) {
    a = fminf(fmaxf(a, -448.f), 448.f); b = fminf(fmaxf(b, -448.f), 448.f); c = fminf(fmaxf(c, -448.f), 448.f); d = fminf(fmaxf(d, -448.f), 448.f);
    int w = 0; w = __builtin_amdgcn_cvt_pk_fp8_f32(a, b, w, false); w = __builtin_amdgcn_cvt_pk_fp8_f32(c, d, w, true); return (unsigned)w; }
__device__ __forceinline__ const void* ldptr(LAS const unsigned long long* t, int i) { const unsigned long long v = t[i];
    const unsigned lo = (unsigned)__builtin_amdgcn_readfirstlane((int)(unsigned)v), hi = (unsigned)__builtin_amdgcn_readfirstlane((int)(unsigned)(v >> 32));
    return (const void*)(const GAS void*)(((unsigned long long)hi << 32) | lo); }

namespace pg8 {
constexpr int BM = 256, BK = 64, HALF = 128, HTB = HALF * BK * 2, STAGE_BYTES = 8 * HTB, NXCD = 8, WGM = 8;
__host__ __device__ __forceinline__ int lds_byte(int r, int c) { const int st = (r >> 4) * 2 + (c >> 5), rr = r & 15, cc = c & 31, ob = rr * 64 + cc * 2; return st * 1024 + (ob ^ (((ob >> 9) & 1) << 5)); }
__host__ __device__ __forceinline__ void stage_rc(int b, int& R, int& C) { const int st = b / 1024, sb = b % 1024, swz = sb ^ (((sb >> 9) & 1) << 5); R = (st >> 1) * 16 + swz / 64; C = (st & 1) * 32 + (swz % 64) / 2; }
__host__ __device__ __forceinline__ int perm32(int rho) { const int n = rho >> 4, i = rho & 15; return 8 * (i >> 2) + 4 * n + (i & 3); }

struct Unit { int pm, pn, e; };
struct Gemm { const bf16_t* A; const bf16_t* Bt; int lda, K, nN; const int* row_off; const int* tile_exp; int pm0; };
struct StaticOrder {
    int nM, nN, nwg, G, c;
    __device__ __forceinline__ void init(int nM_, int nN_, int G_, int c_) { nM = nM_; nN = nN_; nwg = nM * nN; G = G_; c = c_; }
    __device__ __forceinline__ bool next(int i, Unit& u) const {
        const long L = (long)i * G + c; if (L >= nwg) return false;
        int wgid = (int)L; { const int q = nwg / NXCD, r = nwg % NXCD, xcd = wgid % NXCD, off = wgid / NXCD; wgid = (xcd < r ? xcd * (q + 1) : r * (q + 1) + (xcd - r) * q) + off; }
        const int nig = WGM * nN, gid = wgid / nig, fm = gid * WGM, gsz = (nM - fm) < WGM ? (nM - fm) : WGM;
        u.pm = fm + ((wgid % nig) % gsz); u.pn = (wgid % nig) / gsz; u.e = 0; return true;
    }
};

template <int MODE, class Epi, bool MID = false, bool FP8 = false>
__device__ __forceinline__ void gemm_phase(LAS unsigned char* lds, const Gemm g, const StaticOrder& S, const Epi& E) {
    int tid_ = threadIdx.x; asm volatile("" : "+v"(tid_));
    const int tid = tid_, wid = __builtin_amdgcn_readfirstlane(tid >> 6), lane = tid & 63, wr = wid >> 2, wc = wid & 3, fr = lane & 15, fq = lane >> 4;
    const int K = g.K, nt = K / BK;
    unsigned voffA[2], voffB[2];
#pragma unroll
    for (int i = 0; i < 2; ++i) { int R, C; stage_rc(tid * 16 + i * 8192, R, C); const int Rb = Epi::PERM ? ((R & ~31) + perm32(R & 31)) : R;
        voffA[i] = (unsigned)(R * g.lda + C) * 2u; voffB[i] = (unsigned)(Rb * K + C) * 2u; }
    const size_t kstep = (size_t)(BK * 2);
    const size_t hstepA = (size_t)HALF * g.lda * 2, hstepB = (size_t)HALF * K * 2;
    const size_t tstepA = 2 * hstepA, tstepB = 2 * hstepB;
    const unsigned ldsw = (unsigned)wid * 1024u;
    LAS unsigned char* pa = lds + lds_byte(wr * 64 + fr, fq * 8); LAS unsigned char* pb = lds + 4 * HTB + lds_byte(wc * 32 + fr, fq * 8);
    asm volatile("" : "+v"(pa), "+v"(pb));
    unsigned vC[2][2] = {{0u, 0u}, {0u, 0u}};
    constexpr int GOFF = 8 * HTB;
#define PG8_SA(b, h) (((b) * 2 + (h)) * HTB)
#define PG8_SB(b, h) ((4 + (b) * 2 + (h)) * HTB)
#define PG8_STAGE_B(bufoff, gbase) do { _Pragma("unroll") for (int _i = 0; _i < 2; ++_i) { unsigned vb_ = voffB[_i]; asm volatile("" : "+v"(vb_)); \
        __builtin_amdgcn_global_load_lds((const unsigned*)((const char*)(gbase) + vb_), (LAS unsigned*)(lds + (bufoff) + ldsw + _i * 8192), 16, 0, 0); } } while (0)
#define PG8_STAGE_A(bufoff, gbase, h) do { _Pragma("unroll") for (int _i = 0; _i < 2; ++_i) { unsigned va_ = (MODE == 1) ? vC[h][_i] : voffA[_i]; if (MODE != 1) asm volatile("" : "+v"(va_)); \
        const char* _p = (MODE == 1) ? ((const char*)(gbase) + va_) : ((const char*)(gbase) + (h) * hstepA + va_); \
        __builtin_amdgcn_global_load_lds((const unsigned*)_p, (LAS unsigned*)(lds + (bufoff) + ldsw + _i * 8192), 16, 0, 0); } } while (0)
#define PG8_LD8(dst, cnt, base) do { _Pragma("unroll") for (int q_ = 0; q_ < (cnt); ++q_) { const pg8_v4i lo_ = *(const LAS pg8_v4i*)((base) + q_ * 2048), hi_ = *(const LAS pg8_v4i*)((base) + q_ * 2048 + 1024); \
        dst[q_] = __builtin_shufflevector(lo_, hi_, 0, 1, 2, 3, 4, 5, 6, 7); } } while (0)
#define PG8_LDA(dst, b, h) do { if constexpr (FP8) { PG8_LD8(dst##8, 4, pa + PG8_SA(b, h)); } else { _Pragma("unroll") for (int m = 0; m < 4; ++m) _Pragma("unroll") for (int k = 0; k < 2; ++k) dst[m][k] = *(const LAS bf16x8*)(pa + PG8_SA(b, h) + m * 2048 + k * 1024); } } while (0)
#define PG8_LDB(dst, b, h) do { if constexpr (FP8) { PG8_LD8(dst##8, 2, pb + PG8_SA(b, h)); } else { _Pragma("unroll") for (int n = 0; n < 2; ++n) _Pragma("unroll") for (int k = 0; k < 2; ++k) dst[n][k] = *(const LAS bf16x8*)(pb + PG8_SA(b, h) + n * 2048 + k * 1024); } } while (0)
#define PG8_MMA(ai, bj, At, Bt) do { __builtin_amdgcn_s_setprio(1); _Pragma("unroll") for (int m = 0; m < 4; ++m) _Pragma("unroll") for (int n = 0; n < 2; ++n) { \
        if constexpr (FP8) {   \
            acc[ai][bj][m][n] = __builtin_amdgcn_mfma_scale_f32_16x16x128_f8f6f4(Bt##8[n], At##8[m], acc[ai][bj][m][n], 0, 0, 0, 0x7f7f7f7f, 0, 0x7f7f7f7f); \
        } else { _Pragma("unroll") for (int k = 0; k < 2; ++k) acc[ai][bj][m][n] = __builtin_amdgcn_mfma_f32_16x16x32_bf16(Bt[n][k], At[m][k], acc[ai][bj][m][n], 0, 0, 0); } } \
        __builtin_amdgcn_s_setprio(0); } while (0)
#define PG8_WAIT_V(n) asm volatile("s_waitcnt vmcnt(" #n ")" ::: "memory")
#define PG8_WAIT_L(n) asm volatile("s_waitcnt lgkmcnt(" #n ")" ::: "memory")
#define PG8_BAR __builtin_amdgcn_s_barrier()
#define PG8_SCHED __builtin_amdgcn_sched_barrier(0)
#define PG8_ABASE(u) ((MODE == 1) ? (const char*)g.A : (const char*)g.A + (size_t)(u).pm * tstepA)
#define PG8_BBASE(u) ((MODE == 0) ? (const char*)g.Bt + (size_t)(u).pn * tstepB : (const char*)g.Bt + ((size_t)((u).e = __builtin_amdgcn_readfirstlane(ld_agent_i(g.tile_exp + g.pm0 + (u).pm))) * g.nN + (u).pn) * tstepB)
#define PG8_GATHER(dst, u) do { if (MODE == 1) { int tq_ = tid; asm volatile("" : "+v"(tq_)); _Pragma("unroll") for (int _i = 0; _i < 2; ++_i) { int R_, C_; stage_rc(tq_ * 16 + _i * 8192, R_, C_); \
        _Pragma("unroll") for (int _h = 0; _h < 2; ++_h) dst[_h][_i] = (unsigned)ld_agent_i(g.row_off + (size_t)(g.pm0 + (u).pm) * BM + _h * HALF + R_) + (unsigned)(C_ * 2); } } } while (0)
#define PG8_GATHER_DMA(u) do { if (MODE == 1) { int tq_ = tid; asm volatile("" : "+v"(tq_)); _Pragma("unroll") for (int _i = 0; _i < 2; ++_i) { int R_, C_; stage_rc(tq_ * 16 + _i * 8192, R_, C_); \
        _Pragma("unroll") for (int _h = 0; _h < 2; ++_h) __builtin_amdgcn_global_load_lds((const unsigned*)(g.row_off + (size_t)(g.pm0 + (u).pm) * BM + _h * HALF + R_), (LAS unsigned*)(lds + GOFF + (_h * 2 + _i) * 2048 + wid * 256), 4, 0, 0); } } } while (0)
#define PG8_GATHER_LDS(dst) do { if (MODE == 1) { int tq_ = tid; asm volatile("" : "+v"(tq_)); _Pragma("unroll") for (int _i = 0; _i < 2; ++_i) { int R_, C_; stage_rc(tq_ * 16 + _i * 8192, R_, C_); \
        _Pragma("unroll") for (int _h = 0; _h < 2; ++_h) dst[_h][_i] = *(const LAS unsigned*)(lds + GOFF + (_h * 2 + _i) * 2048 + tq_ * 4) + (unsigned)(C_ * 2); } } } while (0)
    Unit cur, nxt; int ui = 0;
    if (!S.next(0, cur)) return;
    f32x4 acc[2][2][4][2];
#pragma unroll
    for (int a = 0; a < 2; ++a)
#pragma unroll
        for (int b = 0; b < 2; ++b)
#pragma unroll
            for (int m = 0; m < 4; ++m)
#pragma unroll
                for (int n = 0; n < 2; ++n) acc[a][b][m][n] = (f32x4){0.f, 0.f, 0.f, 0.f};
    bf16x8 At[4][2], B0[2][2], B1[2][2];
    typedef int pg8_v8i __attribute__((ext_vector_type(8))); typedef int pg8_v4i __attribute__((ext_vector_type(4)));
    pg8_v8i At8[4], B08[2], B18[2];
    const char* cA = PG8_ABASE(cur); const char* cB = PG8_BBASE(cur);
    PG8_GATHER(vC, cur);
    PG8_STAGE_B(PG8_SB(0, 0), cB); PG8_STAGE_B(PG8_SB(0, 1), cB + hstepB); PG8_STAGE_A(PG8_SA(0, 0), cA, 0); PG8_STAGE_A(PG8_SA(0, 1), cA, 1);
    if (wr == 1) PG8_BAR;
    PG8_WAIT_V(2); PG8_BAR;
    PG8_STAGE_B(PG8_SB(1, 0), cB + kstep); PG8_STAGE_A(PG8_SA(1, 0), cA + kstep, 0); PG8_STAGE_B(PG8_SB(1, 1), cB + hstepB + kstep);
    PG8_WAIT_V(6); PG8_BAR;
    for (;;) {
        const bool has_next = S.next(ui + 1, nxt);
        const char* nA = has_next ? PG8_ABASE(nxt) : cA; const char* nB = has_next ? PG8_BBASE(nxt) : cB;
        if (has_next) PG8_GATHER_DMA(nxt);
#pragma unroll 1
        for (int t = 0; t < nt; t += 2) {
            if constexpr (MID) { if (t == nt / 2) { if (wr == 0) PG8_BAR; E.mid(acc, cur, wr, wc, fr, fq); if (wr == 1) PG8_BAR; } }
            const bool last = (t == nt - 2);
            const char* a1 = cA + (size_t)(t + 1) * kstep;
            const char* a2 = last ? nA : cA + (size_t)(t + 2) * kstep; const char* b2 = last ? nB : cB + (size_t)(t + 2) * kstep;
            const char* a3 = a2 + kstep; const char* b3 = b2 + kstep;
            PG8_LDB(B0, 0, 0); PG8_LDB(B1, 0, 1); PG8_SCHED; PG8_LDA(At, 0, 0); PG8_STAGE_A(PG8_SA(1, 1), a1, 1);
            if (MODE == 1) { if (last && has_next) PG8_GATHER_LDS(vC); }
            PG8_WAIT_V(8); PG8_WAIT_L(0); PG8_BAR; PG8_MMA(0, 0, At, B0); PG8_MMA(0, 1, At, B1); PG8_BAR; PG8_SCHED;
            PG8_LDA(At, 0, 1); PG8_STAGE_B(PG8_SB(0, 0), b2); PG8_STAGE_B(PG8_SB(0, 1), b2 + hstepB); PG8_STAGE_A(PG8_SA(0, 0), a2, 0);
            PG8_WAIT_V(8); PG8_WAIT_L(0); PG8_BAR; PG8_MMA(1, 0, At, B0); PG8_MMA(1, 1, At, B1); PG8_BAR; PG8_SCHED;
            PG8_LDB(B0, 1, 0); PG8_LDB(B1, 1, 1); PG8_SCHED; PG8_LDA(At, 1, 0); PG8_STAGE_A(PG8_SA(0, 1), a2, 1);
            PG8_WAIT_V(8); PG8_WAIT_L(0); PG8_BAR; PG8_MMA(0, 0, At, B0); PG8_MMA(0, 1, At, B1); PG8_BAR; PG8_SCHED;
            PG8_LDA(At, 1, 1); PG8_STAGE_B(PG8_SB(1, 0), b3); PG8_STAGE_B(PG8_SB(1, 1), b3 + hstepB); PG8_STAGE_A(PG8_SA(1, 0), a3, 0);
            PG8_WAIT_V(8); PG8_WAIT_L(0); PG8_BAR; PG8_MMA(1, 0, At, B0); PG8_MMA(1, 1, At, B1); PG8_BAR; PG8_SCHED;
        }
        if (wr == 0) PG8_BAR;
        E(acc, cur, wr, wc, fr, fq);
        if (!has_next) break;
#pragma unroll
        for (int a = 0; a < 2; ++a)
#pragma unroll
            for (int b = 0; b < 2; ++b)
#pragma unroll
                for (int m = 0; m < 4; ++m)
#pragma unroll
                    for (int n = 0; n < 2; ++n) acc[a][b][m][n] = (f32x4){0.f, 0.f, 0.f, 0.f};
        cur = nxt; cA = nA; cB = nB; ++ui;
        if (wr == 1) PG8_BAR;
    }
    PG8_WAIT_V(0);
    PG8_BAR;
#undef PG8_SA
#undef PG8_SB
#undef PG8_STAGE_A
#undef PG8_STAGE_B
#undef PG8_LD8
#undef PG8_LDA
#undef PG8_LDB
#undef PG8_MMA
#undef PG8_WAIT_V
#undef PG8_WAIT_L
#undef PG8_BAR
#undef PG8_SCHED
#undef PG8_ABASE
#undef PG8_BBASE
#undef PG8_GATHER
#undef PG8_GATHER_DMA
#undef PG8_GATHER_LDS
}

struct EpiZ {
    static constexpr bool PERM = true;
    bf16_t* Z; bf16_t* Qc; bf16_t* Kc; bf16_t* Vc; const float* ropec; const float* ropes; bf16_t* GF;
    __device__ __forceinline__ void operator()(const f32x4 (&acc)[2][2][4][2], const Unit& u, int wr, int wc, int fr, int fq) const {
        const int row0 = u.pm * BM + wr * 64 + fr;
        if (u.pn < 4) {
            const float sc = (u.pn < 2) ? ATT_C2 : 1.0f;
            bf16_t* base = (u.pn < 2) ? Qc : Kc;
            const int dl = 16 * (wc & 1) + 4 * fq;
#pragma unroll
            for (int ai = 0; ai < 2; ++ai)
#pragma unroll
                for (int m = 0; m < 4; ++m) {
                    const int row = row0 + ai * HALF + m * 16; int b, t; bt_of(row, b, t);
                    const f32x4 c = *(const f32x4*)(ropec + t * 32 + dl) * sc, s = *(const f32x4*)(ropes + t * 32 + dl) * sc;
#pragma unroll
                    for (int bj = 0; bj < 2; ++bj) {
                        const int hm = 4 * (u.pn & 1) + 2 * bj + (wc >> 1);
                        const f32x4 x1 = acc[ai][bj][m][0], x2 = acc[ai][bj][m][1];
                        const f32x4 o1 = x1 * c - x2 * s, o2 = x2 * c + x1 * s;
                        bf16_t* p = base + ((size_t)(b * 8 + hm) * TT + t) * 64 + dl;
                        u32x2 w1, w2; w1.x = pkbf(o1[0], o1[1]); w1.y = pkbf(o1[2], o1[3]); w2.x = pkbf(o2[0], o2[1]); w2.y = pkbf(o2[2], o2[3]);
                        *(u32x2*)p = w1; *(u32x2*)(p + 32) = w2;
                    }
                }
        } else if (u.pn < 6) {
            const int e0 = wc * 32 + 8 * fq;
#pragma unroll
            for (int ai = 0; ai < 2; ++ai)
#pragma unroll
                for (int m = 0; m < 4; ++m) {
                    const int row = row0 + ai * HALF + m * 16; int b, t; bt_of(row, b, t);
#pragma unroll
                    for (int bj = 0; bj < 2; ++bj) { const int h = (u.pn - 4) * 2 + bj; const f32x4 v0 = acc[ai][bj][m][0], v1 = acc[ai][bj][m][1];
                        u32x4 w; w.x = pkbf(v0[0], v0[1]); w.y = pkbf(v0[2], v0[3]); w.z = pkbf(v1[0], v1[1]); w.w = pkbf(v1[2], v1[3]);
                        *(u32x4*)(Vc + ((size_t)(b * 4 + h) * TT + t) * 128 + e0) = w; }
                }
        } else if (u.pn < 14) {
            const int col0 = (u.pn - 6) * BM + wc * 32 + 8 * fq;
#pragma unroll
            for (int ai = 0; ai < 2; ++ai)
#pragma unroll
                for (int m = 0; m < 4; ++m) {
                    bf16_t* rowp = Z + (size_t)(row0 + ai * HALF + m * 16) * NZ + col0;
#pragma unroll
                    for (int bj = 0; bj < 2; ++bj) { const f32x4 v0 = acc[ai][bj][m][0], v1 = acc[ai][bj][m][1];
                        u32x4 w; w.x = pkbf(v0[0], v0[1]); w.y = pkbf(v0[2], v0[3]); w.z = pkbf(v1[0], v1[1]); w.w = pkbf(v1[2], v1[3]);
                        *(u32x4*)(rowp + bj * HALF) = w; }
                }
        } else if (u.pm < NREAL / BM) {
            const int gi = (u.pn - 14) >> 2, pn4 = (u.pn - 14) & 3;
            u32x4* gp = (u32x4*)GF + ((((size_t)(gi * (NREAL / BM) + u.pm) * 4 + pn4) * 8 + (wr * 4 + wc)) * 16) * 64 + (fq * 16 + fr);
#pragma unroll
            for (int ai = 0; ai < 2; ++ai)
#pragma unroll
                for (int bj = 0; bj < 2; ++bj)
#pragma unroll
                    for (int m = 0; m < 4; ++m) { const f32x4 v0 = acc[ai][bj][m][0], v1 = acc[ai][bj][m][1];
                        u32x4 w; w.x = pkbf(sigmoidf_(v0[0]), sigmoidf_(v0[1])); w.y = pkbf(sigmoidf_(v0[2]), sigmoidf_(v0[3])); w.z = pkbf(sigmoidf_(v1[0]), sigmoidf_(v1[1])); w.w = pkbf(sigmoidf_(v1[2]), sigmoidf_(v1[3]));
                        gp[((ai * 2 + bj) * 4 + m) * 64] = w; }
        }
    }
};
template <bool SECOND> struct EpiGate {
    static constexpr bool PERM = true;
    bf16_t* Z; bf16_t* TMP; bf16_t* MRG;
    __device__ __forceinline__ void operator()(const f32x4 (&acc)[2][2][4][2], const Unit& u, int wr, int wc, int fr, int fq) const {
        const int row0 = u.pm * BM + wr * 64 + fr, col0 = u.pn * BM + wc * 32 + 8 * fq;
#pragma unroll
        for (int ai = 0; ai < 2; ++ai)
#pragma unroll
            for (int m = 0; m < 4; ++m) {
                bf16_t* rowp = Z + (size_t)(row0 + ai * HALF + m * 16) * NZ + col0; bf16_t* tmpp = TMP + (size_t)(row0 + ai * HALF + m * 16) * DM + col0; bf16_t* mrgp = MRG + (size_t)(row0 + ai * HALF + m * 16) * DM + col0;
#pragma unroll
                for (int bj = 0; bj < 2; ++bj) {
                    const u32x4 gw = *(const u32x4*)(rowp + (SECOND ? ZGM : ZGA) + bj * HALF);
                    const f32x4 v0 = acc[ai][bj][m][0], v1 = acc[ai][bj][m][1];
                    float o[8];
                    o[0] = sigmoidf_(bflo(gw.x)) * v0[0]; o[1] = sigmoidf_(bfhi(gw.x)) * v0[1]; o[2] = sigmoidf_(bflo(gw.y)) * v0[2]; o[3] = sigmoidf_(bfhi(gw.y)) * v0[3];
                    o[4] = sigmoidf_(bflo(gw.z)) * v1[0]; o[5] = sigmoidf_(bfhi(gw.z)) * v1[1]; o[6] = sigmoidf_(bflo(gw.w)) * v1[2]; o[7] = sigmoidf_(bfhi(gw.w)) * v1[3];
                    if (SECOND) { const u32x4 tw = *(const u32x4*)(tmpp + bj * HALF);
                        o[0] += bflo(tw.x); o[1] += bfhi(tw.x); o[2] += bflo(tw.y); o[3] += bfhi(tw.y); o[4] += bflo(tw.z); o[5] += bfhi(tw.z); o[6] += bflo(tw.w); o[7] += bfhi(tw.w); }
                    u32x4 w; w.x = pkbf(o[0], o[1]); w.y = pkbf(o[2], o[3]); w.z = pkbf(o[4], o[5]); w.w = pkbf(o[6], o[7]);
                    if (SECOND) *(u32x4*)(mrgp + bj * HALF) = w; else *(u32x4*)(tmpp + bj * HALF) = w;
                }
            }
    }
};
struct EpiGateFused {
    static constexpr bool PERM = true;
    const bf16_t* GF; bf16_t* MRG;
    __device__ __forceinline__ void mid(f32x4 (&acc)[2][2][4][2], const Unit& u, int wr, int wc, int fr, int fq) const {
        asm volatile("" : "+v"(fr), "+v"(fq));
        const u32x4* ga = (const u32x4*)GF + ((((size_t)u.pm * 4 + u.pn) * 8 + (wr * 4 + wc)) * 16) * 64 + (fq * 16 + fr);
        const u32x4* gm = ga + (size_t)(NREAL / BM) * 4 * 8 * 16 * 64;
#pragma unroll
        for (int q = 0; q < 16; ++q) {
            const int ai = q >> 3, bj = (q >> 2) & 1, m = q & 3;
            const u32x4 a = ga[q * 64], b = gm[q * 64];
            float r[8];
#define EG_R(a_, m_) ((a_) * __builtin_amdgcn_rcpf(m_))
            r[0] = EG_R(bflo(a.x), bflo(b.x)); r[1] = EG_R(bfhi(a.x), bfhi(b.x)); r[2] = EG_R(bflo(a.y), bflo(b.y)); r[3] = EG_R(bfhi(a.y), bfhi(b.y));
            r[4] = EG_R(bflo(a.z), bflo(b.z)); r[5] = EG_R(bfhi(a.z), bfhi(b.z)); r[6] = EG_R(bflo(a.w), bflo(b.w)); r[7] = EG_R(bfhi(a.w), bfhi(b.w));
#undef EG_R
            acc[ai][bj][m][0] = acc[ai][bj][m][0] * (f32x4){r[0], r[1], r[2], r[3]}; acc[ai][bj][m][1] = acc[ai][bj][m][1] * (f32x4){r[4], r[5], r[6], r[7]};
            asm volatile("" : "+v"(acc[ai][bj][m][0]), "+v"(acc[ai][bj][m][1]));
            if ((q & 7) == 7) asm volatile("" ::: "memory");
        }
    }
    __device__ __forceinline__ void operator()(const f32x4 (&acc)[2][2][4][2], const Unit& u, int wr, int wc, int fr, int fq) const {
        const int row0 = u.pm * BM + wr * 64 + fr, col0 = u.pn * BM + wc * 32 + 8 * fq;
        const u32x4* gm = (const u32x4*)GF + (size_t)(NREAL / BM) * 4 * 8 * 16 * 64 + ((((size_t)u.pm * 4 + u.pn) * 8 + (wr * 4 + wc)) * 16) * 64 + (fq * 16 + fr);
#pragma unroll
        for (int ai = 0; ai < 2; ++ai)
#pragma unroll
            for (int m = 0; m < 4; ++m) {
                bf16_t* mrgp = MRG + (size_t)(row0 + ai * HALF + m * 16) * DM + col0;
#pragma unroll
                for (int bj = 0; bj < 2; ++bj) {
                    const u32x4 g = gm[((ai * 2 + bj) * 4 + m) * 64];
                    const f32x4 v0 = acc[ai][bj][m][0], v1 = acc[ai][bj][m][1];
                    u32x4 w; w.x = pkbf(bflo(g.x) * v0[0], bfhi(g.x) * v0[1]); w.y = pkbf(bflo(g.y) * v0[2], bfhi(g.y) * v0[3]);
                    w.z = pkbf(bflo(g.z) * v1[0], bfhi(g.z) * v1[1]); w.w = pkbf(bflo(g.w) * v1[2], bfhi(g.w) * v1[3]);
                    *(u32x4*)(mrgp + bj * HALF) = w;
                }
            }
    }
};
struct EpiStoreBf16 {
    static constexpr bool PERM = true;
    bf16_t* O; int ldc;
    __device__ __forceinline__ void operator()(const f32x4 (&acc)[2][2][4][2], const Unit& u, int wr, int wc, int fr, int fq) const {
        const int row0 = u.pm * BM + wr * 64 + fr, col0 = u.pn * BM + wc * 32 + 8 * fq;
#pragma unroll
        for (int ai = 0; ai < 2; ++ai)
#pragma unroll
            for (int m = 0; m < 4; ++m) { bf16_t* rowp = O + (size_t)(row0 + ai * HALF + m * 16) * ldc + col0;
#pragma unroll
                for (int bj = 0; bj < 2; ++bj) { const f32x4 v0 = acc[ai][bj][m][0], v1 = acc[ai][bj][m][1];
                    u32x4 w; w.x = pkbf(v0[0], v0[1]); w.y = pkbf(v0[2], v0[3]); w.z = pkbf(v1[0], v1[1]); w.w = pkbf(v1[2], v1[3]);
                    *(u32x4*)(rowp + bj * HALF) = w; } }
    }
};
struct EpiPre1 {
    static constexpr bool PERM = false;
    float* P1; const float* x; const float* meta; const float* stats; const float* g0; const float* b0;
    __device__ __forceinline__ void operator()(const f32x4 (&acc)[2][2][4][2], const Unit& u, int wr, int wc, int fr, int fq) const {
        const int row0 = u.pm * BM + wr * 64 + fr, col0 = u.pn * BM + wc * 32 + 4 * fq;
        f32x4 gv[2][2], bv[2][2];
#pragma unroll
        for (int bj = 0; bj < 2; ++bj)
#pragma unroll
            for (int n = 0; n < 2; ++n) { gv[bj][n] = *(const f32x4*)(g0 + col0 + bj * HALF + n * 16); bv[bj][n] = *(const f32x4*)(b0 + col0 + bj * HALF + n * 16); }
#pragma unroll
        for (int ai = 0; ai < 2; ++ai)
#pragma unroll
            for (int m = 0; m < 4; ++m) {
                const int row = row0 + ai * HALF + m * 16;
                const float* xr = x + (size_t)row * DM;
                const float mean = ld_agent_f(stats + 2 * row), rstd = ld_agent_f(stats + 2 * row + 1);
                float* orow = P1 + (size_t)row * (NZ / 2) + col0;
#pragma unroll
                for (int bj = 0; bj < 2; ++bj)
#pragma unroll
                    for (int n = 0; n < 2; ++n) { const f32x4 xv = *(const f32x4*)(xr + col0 + bj * HALF + n * 16);
                        const f32x4 hv = (xv - mean) * rstd * gv[bj][n] + bv[bj][n];
                        *(f32x4*)(orow + bj * HALF + n * 16) = hv * DN_ALPHA + acc[ai][bj][m][n]; }
            }
    }
};
struct EpiAct {
    static constexpr bool PERM = true;
    bf16_t* ACT; const float* b_gu; const int* tile_exp; int pm0; float ascale;
    __device__ __forceinline__ void operator()(const f32x4 (&acc)[2][2][4][2], const Unit& u, int wr, int wc, int fr, int fq) const {
        { int tq_ = threadIdx.x; asm volatile("" : "+v"(tq_)); fr = tq_ & 15; fq = (tq_ >> 4) & 3; }
        const int e = u.e;
        const int ac0 = u.pn * HALF + wc * 32 + 8 * fq;
        const float* bp = b_gu + (size_t)e * 2 * FF + 2 * ac0;
        f32x2 bg[4], bl[4];
#pragma unroll
        for (int q = 0; q < 4; ++q) { const f32x4 v0 = *(const f32x4*)(bp + 4 * q); bg[q] = (f32x2){v0[0], v0[2]}; bl[q] = (f32x2){v0[1], v0[3]}; }
        const int row0 = u.pm * BM + wr * 64 + fr;
#pragma unroll
        for (int ai = 0; ai < 2; ++ai)
#pragma unroll
            for (int m = 0; m < 4; ++m) {
                float o[8];
#pragma unroll
                for (int q = 0; q < 4; ++q) {
                    const f32x4 ag = acc[ai][0][m][q >> 1], al = acc[ai][1][m][q >> 1];
                    f32x2 gl = (f32x2){ag[2 * (q & 1)], ag[2 * (q & 1) + 1]} * ascale + bg[q], li = (f32x2){al[2 * (q & 1)], al[2 * (q & 1) + 1]} * ascale + bl[q];
                    gl = (f32x2){fminf(gl[0], 7.0f), fminf(gl[1], 7.0f)}; li = (f32x2){fminf(fmaxf(li[0], -7.0f), 7.0f), fminf(fmaxf(li[1], -7.0f), 7.0f)};
                    const f32x2 tt = gl * (-1.702f * 1.4426950408889634f);
                    const f32x2 den = (f32x2){__builtin_amdgcn_exp2f(tt[0]), __builtin_amdgcn_exp2f(tt[1])} + 1.0f;
                    const f32x2 sg = (f32x2){__builtin_amdgcn_rcpf(den[0]), __builtin_amdgcn_rcpf(den[1])};
                    const f32x2 r = (gl * sg) * (li + 1.0f);
                    o[2 * q] = r[0]; o[2 * q + 1] = r[1];
                }
                u32x2 w; w.x = pkfp8x4(o[0] * FP8_SA2, o[1] * FP8_SA2, o[2] * FP8_SA2, o[3] * FP8_SA2); w.y = pkfp8x4(o[4] * FP8_SA2, o[5] * FP8_SA2, o[6] * FP8_SA2, o[7] * FP8_SA2);
                *(u32x2*)((unsigned char*)ACT + (size_t)(row0 + ai * HALF + m * 16) * FF + ac0) = w;
            }
    }
};
struct EpiDown {
    static constexpr bool PERM = true;
    bf16_t* Y; const float* b_down; const int* tile_exp; const int* row_slot; const float* row_gate; int pm0; float ascale;
    __device__ __forceinline__ void operator()(const f32x4 (&acc)[2][2][4][2], const Unit& u, int wr, int wc, int fr, int fq) const {
        { int tq_ = threadIdx.x; asm volatile("" : "+v"(tq_)); fr = tq_ & 15; fq = (tq_ >> 4) & 3; }
        const int e = u.e;
        const int col0 = u.pn * BM + wc * 32 + 8 * fq;
        f32x4 bv[2][2];
#pragma unroll
        for (int bj = 0; bj < 2; ++bj)
#pragma unroll
            for (int n = 0; n < 2; ++n) bv[bj][n] = *(const f32x4*)(b_down + (size_t)e * DM + col0 + bj * HALF + 4 * n);
        const int r0 = (pm0 + u.pm) * BM + wr * 64 + fr;
#pragma unroll
        for (int ai = 0; ai < 2; ++ai)
#pragma unroll
            for (int m = 0; m < 4; ++m) {
                const int r = r0 + ai * HALF + m * 16;
                const int slot = row_slot[r]; const float gt = row_gate[r];
                bf16_t* rowp = Y + (size_t)slot * DM + col0;
#pragma unroll
                for (int bj = 0; bj < 2; ++bj) { const f32x4 v0 = (acc[ai][bj][m][0] * ascale + bv[bj][0]) * gt, v1 = (acc[ai][bj][m][1] * ascale + bv[bj][1]) * gt;
                    u32x4 w; w.x = pkbf(v0[0], v0[1]); w.y = pkbf(v0[2], v0[3]); w.z = pkbf(v1[0], v1[1]); w.w = pkbf(v1[2], v1[3]);
                    *(u32x4*)(rowp + bj * HALF) = w; }
            }
    }
};
}

namespace attn_body {
using bf16 = __hip_bfloat16;
using s16x4 = __attribute__((ext_vector_type(4))) short;
using f32x16 = __attribute__((ext_vector_type(16))) float;
constexpr int D = 64, PZ = 64, PV = 128, PO = 1024;
constexpr int NW = 8, QBLK = 32, QB = QBLK * NW, KVBLK = 64;
__device__ __forceinline__ int crow(int r, int hi) { return (r & 3) + 8 * (r >> 2) + 4 * hi; }
#define SBAR() __builtin_amdgcn_sched_barrier(0)
__device__ __forceinline__ void cmask(f32x16& p0, f32x16& p1, int jb, int qrel, int hi) {
    const float NEG = -INFINITY; const int d = qrel - 64 * jb - 4 * hi;
#pragma unroll
    for (int r = 0; r < 16; ++r) { const int c = (r & 3) + 8 * (r >> 2); if (c > d) p0[r] = NEG; if (c + 32 > d) p1[r] = NEG; }
}
constexpr int NSLOT = 3, SLOTB = 8192;
constexpr int LDS_K = 0, LDS_V = NSLOT * SLOTB, LDS_WS = 2 * NSLOT * SLOTB, LDS_OST = LDS_WS + NW * 64 * 4, LDS_BYTES_A = LDS_OST + NW * 4096;
__device__ __forceinline__ void glds16(const void* gsrc, unsigned lds_dst) { unsigned keep;
    asm volatile("s_mov_b32 %0, m0\n\ts_mov_b32 m0, %2\n\ts_nop 0\n\tglobal_load_lds_dwordx4 %1, off\n\ts_mov_b32 m0, %0" : "=&s"(keep) : "v"(gsrc), "s"(lds_dst) : "memory"); }
__device__ __forceinline__ float max3f(float a, float b, float c) { float r; asm("v_max3_f32 %0, %1, %2, %3" : "=v"(r) : "v"(a), "v"(b), "v"(c)); return r; }
__device__ __forceinline__ float max2f(float a, float b) { float r; asm("v_max_f32_e32 %0, %1, %2" : "=v"(r) : "v"(a), "v"(b)); return r; }
__device__ __forceinline__ float fadd_s(float a, float b) { float r; asm("v_add_f32_e32 %0, %1, %2" : "=v"(r) : "v"(a), "v"(b)); return r; }
__device__ __forceinline__ float fsub_s(float a, float b) { float r; asm("v_sub_f32_e32 %0, %1, %2" : "=v"(r) : "v"(a), "v"(b)); return r; }
__device__ __forceinline__ unsigned cvtpk_s(float lo, float hi) { return pkbf(lo, hi); }
#define WAIT_BAR(N) asm volatile("s_waitcnt vmcnt(" #N ") lgkmcnt(0)\n\ts_barrier" ::: "memory")
__device__ __forceinline__ void qkt(f32x16& p0, f32x16& p1, const char* Kslot, const bf16x8* qr, const f32x16& negm, int r32, int hi) {
    const char* kb = Kslot + hi * 1024 + r32 * 16;
#pragma unroll
    for (int d0 = 0; d0 < 4; ++d0) {
        const bf16x8 b0 = *reinterpret_cast<const bf16x8*>(kb + d0 * 2048);
        const bf16x8 b1 = *reinterpret_cast<const bf16x8*>(kb + d0 * 2048 + 512);
        if (d0 == 0) { p0 = __builtin_amdgcn_mfma_f32_32x32x16_bf16(b0, qr[0], negm, 0, 0, 0); p1 = __builtin_amdgcn_mfma_f32_32x32x16_bf16(b1, qr[0], negm, 0, 0, 0); }
        else { p0 = __builtin_amdgcn_mfma_f32_32x32x16_bf16(b0, qr[d0], p0, 0, 0, 0); p1 = __builtin_amdgcn_mfma_f32_32x32x16_bf16(b1, qr[d0], p1, 0, 0, 0); } }
}
typedef __attribute__((address_space(3))) const char* lds_cptr;
typedef short v4i16_t __attribute__((ext_vector_type(4)));
__device__ __forceinline__ void kload8(bf16x8* kf, lds_cptr kp) {
    kf[0] = *(const __attribute__((address_space(3))) bf16x8*)(kp);        kf[1] = *(const __attribute__((address_space(3))) bf16x8*)(kp + 512);
    kf[2] = *(const __attribute__((address_space(3))) bf16x8*)(kp + 2048); kf[3] = *(const __attribute__((address_space(3))) bf16x8*)(kp + 2560);
    kf[4] = *(const __attribute__((address_space(3))) bf16x8*)(kp + 4096); kf[5] = *(const __attribute__((address_space(3))) bf16x8*)(kp + 4608);
    kf[6] = *(const __attribute__((address_space(3))) bf16x8*)(kp + 6144); kf[7] = *(const __attribute__((address_space(3))) bf16x8*)(kp + 6656);
}
__device__ __forceinline__ void kload2(bf16x8* kf, lds_cptr kp, int j) { kf[2 * j] = *(const __attribute__((address_space(3))) bf16x8*)(kp + j * 2048); kf[2 * j + 1] = *(const __attribute__((address_space(3))) bf16x8*)(kp + j * 2048 + 512); }
__device__ __forceinline__ s16x4 vtr(lds_cptr p) { return __builtin_bit_cast(s16x4, __builtin_amdgcn_ds_read_tr16_b64_v4i16((__attribute__((address_space(3))) v4i16_t*)p)); }
__device__ __forceinline__ float rowmax(const f32x16& p0, const f32x16& p1) {
    float a = max3f(p0[0], p0[1], p1[0]), b = max3f(p0[2], p0[3], p1[1]); a = max3f(a, p1[2], p1[3]);
#pragma unroll
    for (int r = 4; r < 16; r += 4) { a = max3f(a, p0[r], p0[r + 1]); b = max3f(b, p0[r + 2], p0[r + 3]); a = max3f(a, p1[r], p1[r + 1]); b = max3f(b, p1[r + 2], p1[r + 3]); }
    const float m = max2f(a, b);
    auto rr = __builtin_amdgcn_permlane32_swap(__float_as_uint(m), __float_as_uint(m), false, false);
    return max2f(__uint_as_float(rr[0]), __uint_as_float(rr[1]));
}
__device__ __forceinline__ void pv(f32x16* o, int vb, bf16x8 pa0, bf16x8 pa1, bf16x8 pa2, bf16x8 pa3) {
#pragma unroll
    for (int d0 = 0; d0 < 2; ++d0) { s16x4 lo[4], hi[4];
#pragma unroll
        for (int ks = 0; ks < 4; ++ks) {
            asm volatile("ds_read_b64_tr_b16 %0,%1 offset:%c2" : "=&v"(lo[ks]) : "v"(vb), "i"(d0 * 4096 + ks * 1024) : "memory");
            asm volatile("ds_read_b64_tr_b16 %0,%1 offset:%c2" : "=&v"(hi[ks]) : "v"(vb), "i"(d0 * 4096 + ks * 1024 + 512) : "memory"); }
        asm volatile("s_waitcnt lgkmcnt(0)" ::: "memory"); SBAR();
#define PK(k) (bf16x8){lo[k][0], lo[k][1], lo[k][2], lo[k][3], hi[k][0], hi[k][1], hi[k][2], hi[k][3]}
        o[d0] = __builtin_amdgcn_mfma_f32_32x32x16_bf16(pa0, PK(0), o[d0], 0, 0, 0);
        o[d0] = __builtin_amdgcn_mfma_f32_32x32x16_bf16(pa1, PK(1), o[d0], 0, 0, 0);
        o[d0] = __builtin_amdgcn_mfma_f32_32x32x16_bf16(pa2, PK(2), o[d0], 0, 0, 0);
        o[d0] = __builtin_amdgcn_mfma_f32_32x32x16_bf16(pa3, PK(3), o[d0], 0, 0, 0);
#undef PK
    }
}
#define ATTN_STORE16(p, v) (*(u32x4*)(p) = (v))
template <int THRL> __device__ __forceinline__ void attn_unit(int qb, const bf16* Qh, const bf16* __restrict__ Kh, const bf16* __restrict__ Vh, bf16* Oh, char* shm) {
    const int tid = threadIdx.x; int lane = tid & 63; asm volatile("" : "+v"(lane));
    const int r32 = lane & 31, hi = lane >> 5; const int wid = __builtin_amdgcn_readfirstlane(tid >> 6);
    const int q0 = qb * QB;
    const bf16* Qw = Qh + (long)(q0 + wid * QBLK) * PZ;
    const unsigned lds0 = (unsigned)(uintptr_t)shm;
    float* wsf = (float*)(shm + LDS_WS) + wid * 64;
    const bf16* ksrc = Kh + (long)lane * PZ + wid * 8;
    const bf16* vsrc = Vh + (long)(16 * (wid & 3) + (lane >> 2)) * PV + (wid >> 2) * 32 + (lane & 3) * 8;
    const unsigned kdst = lds0 + LDS_K + wid * 1024, vdst = lds0 + LDS_V + wid * 1024;
#define DMA_K(t, slot) glds16(ksrc + (long)(t) * KVBLK * PZ, (unsigned)__builtin_amdgcn_readfirstlane(kdst + (slot)))
#define DMA_V(t, slot) glds16(vsrc + (long)(t) * KVBLK * PV, (unsigned)__builtin_amdgcn_readfirstlane(vdst + (slot)))
    const int vb0 = (int)(lds0 + LDS_V) + ((lane >> 4) & 1) * 32 + (lane & 3) * 8 + (4 * hi + ((lane & 15) >> 2)) * 64;
    const char* Kbase = shm + LDS_K; bf16x8 kf[8];
    const lds_cptr shm3 = (lds_cptr)shm; const lds_cptr kp0 = shm3 + LDS_K + hi * 1024 + r32 * 16; const lds_cptr vp0 = shm3 + LDS_V + ((lane >> 4) & 1) * 32 + (lane & 3) * 8 + (4 * hi + ((lane & 15) >> 2)) * 64;
    const int NT = (q0 + QB) / KVBLK;
    DMA_K(0, 0); DMA_V(0, 0); DMA_K(1, SLOTB);
    bf16x8 qr[4];
#pragma unroll
    for (int d0 = 0; d0 < 4; ++d0) qr[d0] = *reinterpret_cast<const bf16x8*>(&Qw[(long)r32 * PZ + d0 * 16 + hi * 8]);
    float mhat = 0.f, l_reg = 0.f; f32x16 o[2]; o[0] = f32x16{}; o[1] = f32x16{}; f32x16 negm = f32x16{}; asm volatile("" : "+v"(negm));
    const int qrel = wid * QBLK + r32;
#define CMASK(P0, P1, t) do { int jb_ = (t) - (NT - 4); if (jb_ >= 0) cmask(P0, P1, jb_, qrel, hi); } while (0)
    bool resc = false;
#define START(P0, P1) do { const float rm = rowmax(P0, P1); resc = false; \
    { const float dl = rm; mhat = fadd_s(mhat, dl); \
      _Pragma("unroll") for (int r = 0; r < 16; ++r) { P0[r] = fsub_s(P0[r], dl); P1[r] = fsub_s(P1[r], dl); } \
      _Pragma("unroll") for (int r = 0; r < 16; ++r) negm[r] = -mhat; asm volatile("" : "+v"(negm)); } \
    _Pragma("unroll") for (int r = 0; r < 16; ++r) P0[r] = __builtin_amdgcn_exp2f(P0[r]); } while (0)
#define RESC() do { if (resc) { asm volatile("s_waitcnt lgkmcnt(0)" ::: "memory"); \
      _Pragma("unroll") for (int d_ = 0; d_ < 2; ++d_) _Pragma("unroll") for (int r = 0; r < 16; ++r) o[d_][r] *= wsf[crow(r, hi)]; } } while (0)
    f32x16 pA0, pA1, pB0, pB1;
    int sl_prev = 0, sl_cur = 0, sl_next = SLOTB;
#define ROT() do { sl_prev = sl_cur; sl_cur = sl_next; sl_next = (sl_next == (NSLOT - 1) * SLOTB) ? 0 : sl_next + SLOTB; } while (0)
    DMA_K(2, 2 * SLOTB);
    WAIT_BAR(3);
    qkt(pA0, pA1, Kbase, qr, negm, r32, hi); asm volatile("s_nop 15\n\ts_nop 7" : "+v"(pA0), "+v"(pA1)); CMASK(pA0, pA1, 0);
    START(pA0, pA1);
    _Pragma("unroll") for (int r = 0; r < 16; ++r) pA1[r] = __builtin_amdgcn_exp2f(pA1[r]);
    WAIT_BAR(0);
    DMA_K(3, 0); DMA_V(1, SLOTB);
    ROT();
    kload8(kf, kp0 + sl_cur);
    WAIT_BAR(2);
    s16x4 vlo[8], vhi[8]; u32x4 pw0, pw1, pw2, pw3;
#define PKW(P, B) cvtpk_s(P[B], P[B + 1])
#define PAF(k) __builtin_bit_cast(bf16x8, pw##k)
#define VFR(i) (bf16x8){vlo[i][0], vlo[i][1], vlo[i][2], vlo[i][3], vhi[i][0], vhi[i][1], vhi[i][2], vhi[i][3]}
#define PIN(x) asm volatile("" : "+v"(x))
#define MX3(a, b, c) __builtin_fmaxf(__builtin_fmaxf((a), (b)), (c))
#define GAPA(MF, A0, A1, A2, A3, W0, W1, PW) do { MF; sacc += A0; sacc += A1; sacc += A2; sacc += A3; PIN(sacc); W0; W1; PIN(PW); SBAR(); } while (0)
#define EX(v) __builtin_amdgcn_exp2f(v)
#define GAPB(MF, X, B) do { MF; X[B] = EX(X[B]); X[B + 1] = EX(X[B + 1]); X[B + 2] = EX(X[B + 2]); X[B + 3] = EX(X[B + 3]); PIN(X); SBAR(); } while (0)
#define VRD(i) do { vlo[i] = vtr(vp_ + (((i) >> 2) * 4096 + ((i) & 3) * 1024)); vhi[i] = vtr(vp_ + (((i) >> 2) * 4096 + ((i) & 3) * 1024 + 512)); } while (0)
#define KRD(G, j) do { if (G) { kload2(kf, kp0 + sl_next, j); SBAR(); } } while (0)
#define STEP(C0, C1, P0, P1, t, GK, GV, GL) do { SBAR(); \
    const lds_cptr vp_ = vp0 + sl_prev; \
    VRD(0); SBAR(); float sacc = (P0[0] + P0[1]); \
    GAPA(C0 = __builtin_amdgcn_mfma_f32_32x32x16_bf16(kf[0], qr[0], negm, 0, 0, 0), P0[2], P0[3], P0[4], P0[5],     pw0[0] = PKW(P0, 0), pw0[1] = PKW(P0, 2), pw0); \
    VRD(4); SBAR(); GAPA(C1 = __builtin_amdgcn_mfma_f32_32x32x16_bf16(kf[1], qr[0], negm, 0, 0, 0), P0[6], P0[7], P0[8], P0[9],     pw0[2] = PKW(P0, 4), pw0[3] = PKW(P0, 6), pw0); \
    VRD(1); SBAR(); GAPA(C0 = __builtin_amdgcn_mfma_f32_32x32x16_bf16(kf[2], qr[1], C0, 0, 0, 0),   P0[10], P0[11], P0[12], P0[13], pw1[0] = PKW(P0, 8), pw1[1] = PKW(P0, 10), pw1); \
    VRD(5); SBAR(); GAPA(C1 = __builtin_amdgcn_mfma_f32_32x32x16_bf16(kf[3], qr[1], C1, 0, 0, 0),   P0[14], P0[15], P1[0], P1[1],   pw1[2] = PKW(P0, 12), pw1[3] = PKW(P0, 14), pw1); \
    VRD(2); SBAR(); GAPA(C0 = __builtin_amdgcn_mfma_f32_32x32x16_bf16(kf[4], qr[2], C0, 0, 0, 0),   P1[2], P1[3], P1[4], P1[5],     pw2[0] = PKW(P1, 0), pw2[1] = PKW(P1, 2), pw2); \
    VRD(6); SBAR(); GAPA(C1 = __builtin_amdgcn_mfma_f32_32x32x16_bf16(kf[5], qr[2], C1, 0, 0, 0),   P1[6], P1[7], P1[8], P1[9],     pw2[2] = PKW(P1, 4), pw2[3] = PKW(P1, 6), pw2); \
    VRD(3); SBAR(); GAPA(C0 = __builtin_amdgcn_mfma_f32_32x32x16_bf16(kf[6], qr[3], C0, 0, 0, 0),   P1[10], P1[11], P1[12], P1[13], pw3[0] = PKW(P1, 8), pw3[1] = PKW(P1, 10), pw3); \
    VRD(7); SBAR(); GAPA(C1 = __builtin_amdgcn_mfma_f32_32x32x16_bf16(kf[7], qr[3], C1, 0, 0, 0),   P1[14], P1[15], 0.f, 0.f,       pw3[2] = PKW(P1, 12), pw3[3] = PKW(P1, 14), pw3); \
    l_reg += sacc; \
    if (GK) { DMA_K((t) + 3, sl_cur); } if (GV) { DMA_V((t) + 1, sl_next); } \
    CMASK(C0, C1, t); \
    { float a = MX3(C0[0], C0[1], C1[0]), b = MX3(C0[2], C0[3], C1[1]); a = MX3(a, C1[2], C1[3]); \
      _Pragma("unroll") for (int r = 4; r < 16; r += 4) { a = MX3(a, C0[r], C0[r + 1]); b = MX3(b, C0[r + 2], C0[r + 3]); a = MX3(a, C1[r], C1[r + 1]); b = MX3(b, C1[r + 2], C1[r + 3]); } \
      float rm = __builtin_fmaxf(a, b); { auto rr = __builtin_amdgcn_permlane32_swap(__float_as_uint(rm), __float_as_uint(rm), false, false); rm = __builtin_fmaxf(__uint_as_float(rr[0]), __uint_as_float(rr[1])); } \
      resc = false; \
      if (__builtin_expect(__any(rm > (float)THRL), 0)) { const float dl = __builtin_fmaxf(rm, 0.f); mhat += dl; \
        _Pragma("unroll") for (int r = 0; r < 16; ++r) { C0[r] -= dl; C1[r] -= dl; } \
        _Pragma("unroll") for (int r = 0; r < 16; ++r) negm[r] = -mhat; asm volatile("" : "+v"(negm)); \
        const float f = __builtin_amdgcn_exp2f(-dl); l_reg *= f; if (hi == 0) wsf[r32] = f; resc = true; } } \
    SBAR(); \
    GAPB(o[0] = __builtin_amdgcn_mfma_f32_32x32x16_bf16(PAF(0), VFR(0), o[0], 0, 0, 0), C0, 0); \
    GAPB(o[1] = __builtin_amdgcn_mfma_f32_32x32x16_bf16(PAF(0), VFR(4), o[1], 0, 0, 0), C0, 4); \
    KRD(GL, 0); GAPB(o[0] = __builtin_amdgcn_mfma_f32_32x32x16_bf16(PAF(1), VFR(1), o[0], 0, 0, 0), C0, 8); \
    KRD(GL, 1); GAPB(o[1] = __builtin_amdgcn_mfma_f32_32x32x16_bf16(PAF(1), VFR(5), o[1], 0, 0, 0), C0, 12); \
    KRD(GL, 2); GAPB(o[0] = __builtin_amdgcn_mfma_f32_32x32x16_bf16(PAF(2), VFR(2), o[0], 0, 0, 0), C1, 0); \
    KRD(GL, 3); GAPB(o[1] = __builtin_amdgcn_mfma_f32_32x32x16_bf16(PAF(2), VFR(6), o[1], 0, 0, 0), C1, 4); \
    GAPB(o[0] = __builtin_amdgcn_mfma_f32_32x32x16_bf16(PAF(3), VFR(3), o[0], 0, 0, 0), C1, 8); \
    GAPB(o[1] = __builtin_amdgcn_mfma_f32_32x32x16_bf16(PAF(3), VFR(7), o[1], 0, 0, 0), C1, 12); \
    } while (0)
    int t = 1;
#undef CMASK
#define CMASK(P0, P1, t) do {} while (0)
    for (; t + 5 < NT; t += 2) {
        STEP(pB0, pB1, pA0, pA1, t, true, true, true);     WAIT_BAR(2); RESC(); ROT();
        STEP(pA0, pA1, pB0, pB1, t + 1, true, true, true); WAIT_BAR(2); RESC(); ROT();
    }
#undef CMASK
#define CMASK(P0, P1, t) do { int jb_ = (t) - (NT - 4); if (jb_ >= 0) cmask(P0, P1, jb_, qrel, hi); } while (0)
#define ENDW(tt) do { if ((tt) + 3 < NT) { WAIT_BAR(2); } else if ((tt) + 2 < NT) { WAIT_BAR(1); } else { WAIT_BAR(0); } } while (0)
    for (; t + 1 < NT; t += 2) {
        STEP(pB0, pB1, pA0, pA1, t, (t + 3 < NT), (t + 1 < NT), (t + 1 < NT));       ENDW(t);     RESC(); ROT();
        STEP(pA0, pA1, pB0, pB1, t + 1, (t + 4 < NT), (t + 2 < NT), (t + 2 < NT));   ENDW(t + 1); RESC(); ROT();
    }
    STEP(pB0, pB1, pA0, pA1, NT - 1, false, false, false); RESC();
    { float sacc = pB0[0] + pB0[1]; _Pragma("unroll") for (int r = 2; r < 16; ++r) sacc += pB0[r]; _Pragma("unroll") for (int r = 0; r < 16; ++r) sacc += pB1[r]; l_reg += sacc;
      pw0 = (u32x4){PKW(pB0, 0), PKW(pB0, 2), PKW(pB0, 4), PKW(pB0, 6)}; pw1 = (u32x4){PKW(pB0, 8), PKW(pB0, 10), PKW(pB0, 12), PKW(pB0, 14)}; pw2 = (u32x4){PKW(pB1, 0), PKW(pB1, 2), PKW(pB1, 4), PKW(pB1, 6)}; pw3 = (u32x4){PKW(pB1, 8), PKW(pB1, 10), PKW(pB1, 12), PKW(pB1, 14)};
      SBAR(); pv(o, vb0 + sl_cur, PAF(0), PAF(1), PAF(2), PAF(3)); }
#undef PKW
#undef PAF
#undef VFR
#undef PIN
#undef MX3
#undef GAPA
#undef GAPB
#undef EX
#undef VRD
#undef KRD
#undef STEP
#undef ENDW
    { auto rr = __builtin_amdgcn_permlane32_swap(__float_as_uint(l_reg), __float_as_uint(l_reg), false, false); l_reg = __uint_as_float(rr[0]) + __uint_as_float(rr[1]); }
    int lane2 = lane; asm volatile("" : "+v"(lane2));
    const int r32e = lane2 & 31, hie = lane2 >> 5;
    if (hie == 0) wsf[32 + r32e] = l_reg; asm volatile("s_waitcnt lgkmcnt(0)" ::: "memory");
    float rli[16];
#pragma unroll
    for (int r = 0; r < 16; ++r) rli[r] = __builtin_amdgcn_rcpf(wsf[32 + crow(r, hie)]);
    bf16* Ow = Oh + (long)(q0 + wid * QBLK) * PO;
    { bf16* stg = (bf16*)(shm + LDS_OST) + wid * 2048;
#pragma unroll
      for (int r = 0; r < 16; ++r) { const int orow = crow(r, hie);
#pragma unroll
        for (int d0 = 0; d0 < 2; ++d0) stg[orow * 64 + d0 * 32 + r32e] = __float2bfloat16(o[d0][r] * rli[r]); }
      asm volatile("s_waitcnt lgkmcnt(0)" ::: "memory");
#pragma unroll
      for (int i = 0; i < 4; ++i) { const int row = i * 8 + (lane2 >> 3), ch = lane2 & 7; const u32x4 v = *(const u32x4*)(stg + row * 64 + ch * 8); ATTN_STORE16(Ow + (long)row * PO + ch * 8, v); } }
    asm volatile("s_waitcnt lgkmcnt(0)\n\ts_barrier" ::: "memory");
#undef DMA_K
#undef DMA_V
#undef CMASK
#undef START
#undef RESC
#undef ROT
}

constexpr int A2_SLOT = 24576, A2_K = 0, A2_V = 8192, A2_WS = 4 * A2_SLOT, A2_OST = 0, A2_BYTES = A2_WS + NW * 256;
template <int THRL> __device__ __forceinline__ void attn2_unit(int qb, const bf16* Qh, const bf16* __restrict__ Kh, const bf16* __restrict__ Vh, bf16* Oh, char* shm, unsigned* prb = nullptr) {
    const int tid = threadIdx.x; int lane = tid & 63; asm volatile("" : "+v"(lane));
    const int r32 = lane & 31, hi = lane >> 5; const int wid = __builtin_amdgcn_readfirstlane(tid >> 6);
    const int q0 = qb * QB;
    const bf16* Qw = Qh + (long)(q0 + wid * QBLK) * PZ;
    const unsigned lds0 = (unsigned)(uintptr_t)shm;
    float* wsf = (float*)(shm + A2_WS) + wid * 64;
    bf16x8 qr[4];
#pragma unroll
    for (int d0 = 0; d0 < 4; ++d0) qr[d0] = *reinterpret_cast<const bf16x8*>(&Qw[(long)r32 * PZ + d0 * 16 + hi * 8]);
    const bf16* ksrc = Kh + (long)lane * PZ + wid * 8;
    const bf16* vsrc = Vh + (long)(16 * (wid & 3) + (lane >> 2)) * PV + (wid >> 2) * 32 + (lane & 3) * 8;
    const unsigned kdst = lds0 + A2_K + wid * 1024, vdst = lds0 + A2_V + wid * 1024;
#define A2_DMA(t, sl) do { glds16(ksrc + (long)(t) * KVBLK * PZ, (unsigned)__builtin_amdgcn_readfirstlane(kdst + (sl) * A2_SLOT)); \
        glds16(vsrc + (long)(t) * KVBLK * PV, (unsigned)__builtin_amdgcn_readfirstlane(vdst + (sl) * A2_SLOT)); \
        glds16(vsrc + (long)(t) * KVBLK * PV + 64, (unsigned)__builtin_amdgcn_readfirstlane(vdst + (sl) * A2_SLOT + 8192)); } while (0)
#define A2_WAITB(n1, n2) do { if (n2) asm volatile("s_waitcnt vmcnt(6)\n\ts_barrier" ::: "memory"); else if (n1) asm volatile("s_waitcnt vmcnt(3)\n\ts_barrier" ::: "memory"); else asm volatile("s_waitcnt vmcnt(0)\n\ts_barrier" ::: "memory"); } while (0)
    const int NT = (q0 + QB) / KVBLK;
    A2_DMA(0, 0); A2_DMA(1, 1); A2_DMA(2, 2);
    asm volatile("" : "+v"(qr[0]), "+v"(qr[1]), "+v"(qr[2]), "+v"(qr[3]));
    const lds_cptr shm3 = (lds_cptr)shm;
    const lds_cptr kp0 = shm3 + A2_K + hi * 1024 + r32 * 16;
    const lds_cptr vp0 = shm3 + A2_V + ((lane >> 4) & 1) * 32 + (lane & 3) * 8 + (4 * hi + ((lane & 15) >> 2)) * 64;
    float mhat = 0.f, l_reg = 0.f; f32x16 o[4]; o[0] = f32x16{}; o[1] = f32x16{}; o[2] = f32x16{}; o[3] = f32x16{}; f32x16 negm = f32x16{};
    const int qrel = wid * QBLK + r32;
#if MK_PROBE
    const unsigned long long pt0 = __builtin_amdgcn_s_memrealtime();
#endif
    for (int t = 0; t < NT; ++t) {
        A2_WAITB(t + 1 < NT, t + 2 < NT);
        if (t + 3 < NT) A2_DMA(t + 3, (t + 3) & 3);
        const int slot = t & 3;
        const lds_cptr kp = kp0 + slot * A2_SLOT; const lds_cptr vp = vp0 + slot * A2_SLOT;
        f32x16 p0, p1;
        {   bf16x8 kb[8];
#pragma unroll
            for (int d0 = 0; d0 < 4; ++d0) { kb[2 * d0] = *(const __attribute__((address_space(3))) bf16x8*)(kp + d0 * 2048); kb[2 * d0 + 1] = *(const __attribute__((address_space(3))) bf16x8*)(kp + d0 * 2048 + 512); }
            __builtin_amdgcn_sched_barrier(0);
            p0 = __builtin_amdgcn_mfma_f32_32x32x16_bf16(kb[0], qr[0], negm, 0, 0, 0); p1 = __builtin_amdgcn_mfma_f32_32x32x16_bf16(kb[1], qr[0], negm, 0, 0, 0);
#pragma unroll
            for (int d0 = 1; d0 < 4; ++d0) { p0 = __builtin_amdgcn_mfma_f32_32x32x16_bf16(kb[2 * d0], qr[d0], p0, 0, 0, 0); p1 = __builtin_amdgcn_mfma_f32_32x32x16_bf16(kb[2 * d0 + 1], qr[d0], p1, 0, 0, 0); }
        }
        { const int jb = t - (NT - 4); if (jb >= 0) cmask(p0, p1, jb, qrel, hi); }
        float rm;
        { float a = fmaxf(fmaxf(p0[0], p0[1]), p1[0]), b = fmaxf(fmaxf(p0[2], p0[3]), p1[1]); a = fmaxf(fmaxf(a, p1[2]), p1[3]);
#pragma unroll
          for (int r = 4; r < 16; r += 4) { a = fmaxf(fmaxf(a, p0[r]), p0[r + 1]); b = fmaxf(fmaxf(b, p0[r + 2]), p0[r + 3]); a = fmaxf(fmaxf(a, p1[r]), p1[r + 1]); b = fmaxf(fmaxf(b, p1[r + 2]), p1[r + 3]); }
          rm = fmaxf(a, b); auto rr = __builtin_amdgcn_permlane32_swap(__float_as_uint(rm), __float_as_uint(rm), false, false); rm = fmaxf(__uint_as_float(rr[0]), __uint_as_float(rr[1])); }
        if (t == 0 || __any(rm > (float)THRL)) {
            const float dl = (t == 0) ? rm : fmaxf(rm, 0.f); mhat += dl;
#pragma unroll
            for (int r = 0; r < 16; ++r) { p0[r] -= dl; p1[r] -= dl; negm[r] = -mhat; }
            const float f = __builtin_amdgcn_exp2f(-dl); l_reg *= f;
            if (t > 0) {
                if (hi == 0) wsf[r32] = f;
                asm volatile("s_waitcnt lgkmcnt(0)" ::: "memory");
#pragma unroll
                for (int r = 0; r < 16; ++r) { const float fr_ = wsf[crow(r, hi)];
#pragma unroll
                    for (int d_ = 0; d_ < 4; ++d_) o[d_][r] *= fr_; }
                asm volatile("s_waitcnt lgkmcnt(0)" ::: "memory");
            }
        }
        float sacc = 0.f;
#pragma unroll
        for (int r = 0; r < 16; ++r) { p0[r] = __builtin_amdgcn_exp2f(p0[r]); p1[r] = __builtin_amdgcn_exp2f(p1[r]); sacc += p0[r] + p1[r]; }
        l_reg += sacc;
        u32x4 pw[4];
        pw[0] = (u32x4){pkbf(p0[0], p0[1]), pkbf(p0[2], p0[3]), pkbf(p0[4], p0[5]), pkbf(p0[6], p0[7])};
        pw[1] = (u32x4){pkbf(p0[8], p0[9]), pkbf(p0[10], p0[11]), pkbf(p0[12], p0[13]), pkbf(p0[14], p0[15])};
        pw[2] = (u32x4){pkbf(p1[0], p1[1]), pkbf(p1[2], p1[3]), pkbf(p1[4], p1[5]), pkbf(p1[6], p1[7])};
        pw[3] = (u32x4){pkbf(p1[8], p1[9]), pkbf(p1[10], p1[11]), pkbf(p1[12], p1[13]), pkbf(p1[14], p1[15])};
        asm volatile("" : "+v"(pw[0]), "+v"(pw[1]), "+v"(pw[2]), "+v"(pw[3]));
        {   s16x4 vlo[2][4], vhh[2][4];
#pragma unroll
            for (int d0 = 0; d0 < 4; ++d0) { vlo[0][d0] = vtr(vp + d0 * 4096); vhh[0][d0] = vtr(vp + d0 * 4096 + 512); }
            __builtin_amdgcn_sched_barrier(0);
#pragma unroll
            for (int ks = 0; ks < 4; ++ks) {
                if (ks + 1 < 4) {
#pragma unroll
                    for (int d0 = 0; d0 < 4; ++d0) { vlo[(ks + 1) & 1][d0] = vtr(vp + d0 * 4096 + (ks + 1) * 1024); vhh[(ks + 1) & 1][d0] = vtr(vp + d0 * 4096 + (ks + 1) * 1024 + 512); }
                }
                __builtin_amdgcn_sched_barrier(0);
#pragma unroll
                for (int d0 = 0; d0 < 4; ++d0) {
                    const s16x4 lo = vlo[ks & 1][d0], hh = vhh[ks & 1][d0];
                    const bf16x8 vf = (bf16x8){lo[0], lo[1], lo[2], lo[3], hh[0], hh[1], hh[2], hh[3]};
                    o[d0] = __builtin_amdgcn_mfma_f32_32x32x16_bf16(__builtin_bit_cast(bf16x8, pw[ks]), vf, o[d0], 0, 0, 0);
                }
                __builtin_amdgcn_sched_barrier(0);
            }
        }
    }
#if MK_PROBE
    if (prb && tid == 0) { atomicAdd(prb, (unsigned)(__builtin_amdgcn_s_memrealtime() - pt0)); atomicAdd(prb + 1, (unsigned)NT); }
#endif
    asm volatile("s_waitcnt lgkmcnt(0)\n\ts_barrier" ::: "memory");
    { auto rr = __builtin_amdgcn_permlane32_swap(__float_as_uint(l_reg), __float_as_uint(l_reg), false, false); l_reg = __uint_as_float(rr[0]) + __uint_as_float(rr[1]); }
    if (hi == 0) wsf[32 + r32] = l_reg;
    asm volatile("s_waitcnt lgkmcnt(0)" ::: "memory");
    bf16* stg = (bf16*)(shm + A2_OST) + wid * 4096;
#pragma unroll
    for (int r = 0; r < 16; ++r) { const int orow = crow(r, hi); const float rl = __builtin_amdgcn_rcpf(wsf[32 + orow]);
#pragma unroll
        for (int d0 = 0; d0 < 4; ++d0) stg[orow * 128 + d0 * 32 + r32] = __float2bfloat16(o[d0][r] * rl); }
    asm volatile("s_waitcnt lgkmcnt(0)" ::: "memory");
    bf16* Ow = Oh + (long)(q0 + wid * QBLK) * PO;
#pragma unroll
    for (int i = 0; i < 8; ++i) { const int row = i * 4 + (lane >> 4), ch = lane & 15; const u32x4 v = *(const u32x4*)(stg + row * 128 + ch * 8); *(u32x4*)(Ow + (long)row * PO + ch * 8) = v; }
    asm volatile("s_waitcnt lgkmcnt(0)\n\ts_barrier" ::: "memory");
#undef A2_DMA
#undef A2_WAITB
}

template <int THRL> __device__ __forceinline__ void attn3_unit(int qb, const bf16* Qh, const bf16* __restrict__ Kh, const bf16* __restrict__ Vh, bf16* Oh, char* shm, unsigned* prb = nullptr) {
    const int tid = threadIdx.x; int lane = tid & 63; asm volatile("" : "+v"(lane));
    const int r32 = lane & 31, hi = lane >> 5; const int wid = __builtin_amdgcn_readfirstlane(tid >> 6);
    const int q0 = qb * QB;
    const bf16* Qw = Qh + (long)(q0 + wid * QBLK) * PZ;
    const unsigned lds0 = (unsigned)(uintptr_t)shm;
    float* wsf = (float*)(shm + A2_WS) + wid * 64;
    bf16x8 qr[4];
#pragma unroll
    for (int d0 = 0; d0 < 4; ++d0) qr[d0] = *reinterpret_cast<const bf16x8*>(&Qw[(long)r32 * PZ + d0 * 16 + hi * 8]);
    const bf16* ksrc = Kh + (long)lane * PZ + wid * 8;
    const bf16* vsrc = Vh + (long)(16 * (wid & 3) + (lane >> 2)) * PV + (wid >> 2) * 32 + (lane & 3) * 8;
    const unsigned kdst = lds0 + A2_K + wid * 1024, vdst = lds0 + A2_V + wid * 1024;
#define A3_DMA(t, sl) do { glds16(ksrc + (long)(t) * KVBLK * PZ, (unsigned)__builtin_amdgcn_readfirstlane(kdst + (sl) * A2_SLOT)); \
        glds16(vsrc + (long)(t) * KVBLK * PV, (unsigned)__builtin_amdgcn_readfirstlane(vdst + (sl) * A2_SLOT)); \
        glds16(vsrc + (long)(t) * KVBLK * PV + 64, (unsigned)__builtin_amdgcn_readfirstlane(vdst + (sl) * A2_SLOT + 8192)); } while (0)
#define A3_SB() __builtin_amdgcn_sched_barrier(0)
#define A3_MFMA(A_, B_, C_) __builtin_amdgcn_mfma_f32_32x32x16_bf16((A_), (B_), (C_), 0, 0, 0)
#define A3_KLD(D0) (*(const __attribute__((address_space(3))) bf16x8*)(kpn + (D0) * 2048))
#define A3_KLD2(D0) (*(const __attribute__((address_space(3))) bf16x8*)(kpn + (D0) * 2048 + 512))
#define A3_VLD(BUF, KS) do { _Pragma("unroll") for (int d_ = 0; d_ < 4; ++d_) { vlo[BUF][d_] = vtr(vp + d_ * 4096 + (KS) * 1024); vhh[BUF][d_] = vtr(vp + d_ * 4096 + (KS) * 1024 + 512); } } while (0)
#define A3_VF(BUF, D0) ((bf16x8){vlo[BUF][D0][0], vlo[BUF][D0][1], vlo[BUF][D0][2], vlo[BUF][D0][3], vhh[BUF][D0][0], vhh[BUF][D0][1], vhh[BUF][D0][2], vhh[BUF][D0][3]})
#define A3_EXP2(P, I) do { P[2 * (I)] = __builtin_amdgcn_exp2f(P[2 * (I)]); P[2 * (I) + 1] = __builtin_amdgcn_exp2f(P[2 * (I) + 1]); sacc += P[2 * (I)] + P[2 * (I) + 1]; } while (0)
#define A3_ROWMAX(P0, P1, RM) do { float a_ = fmaxf(fmaxf(P0[0], P0[1]), P1[0]), b_ = fmaxf(fmaxf(P0[2], P0[3]), P1[1]); a_ = fmaxf(fmaxf(a_, P1[2]), P1[3]); \
        _Pragma("unroll") for (int r_ = 4; r_ < 16; r_ += 4) { a_ = fmaxf(fmaxf(a_, P0[r_]), P0[r_ + 1]); b_ = fmaxf(fmaxf(b_, P0[r_ + 2]), P0[r_ + 3]); a_ = fmaxf(fmaxf(a_, P1[r_]), P1[r_ + 1]); b_ = fmaxf(fmaxf(b_, P1[r_ + 2]), P1[r_ + 3]); } \
        RM = fmaxf(a_, b_); auto rr_ = __builtin_amdgcn_permlane32_swap(__float_as_uint(RM), __float_as_uint(RM), false, false); RM = fmaxf(__uint_as_float(rr_[0]), __uint_as_float(rr_[1])); } while (0)
    const int NT = (q0 + QB) / KVBLK;
    A3_DMA(0, 0); A3_DMA(1, 1); A3_DMA(2, 2);
    asm volatile("" : "+v"(qr[0]), "+v"(qr[1]), "+v"(qr[2]), "+v"(qr[3]));
    const lds_cptr shm3 = (lds_cptr)shm;
    const lds_cptr kp0 = shm3 + A2_K + hi * 1024 + r32 * 16;
    const lds_cptr vp0 = shm3 + A2_V + ((lane >> 4) & 1) * 32 + (lane & 3) * 8 + (4 * hi + ((lane & 15) >> 2)) * 64;
    float mhat = 0.f, l_reg = 0.f; f32x16 o[4]; o[0] = f32x16{}; o[1] = f32x16{}; o[2] = f32x16{}; o[3] = f32x16{}; f32x16 negm = f32x16{};
    const int qrel = wid * QBLK + r32;
    f32x16 p0, p1; float rm;
    asm volatile("s_waitcnt vmcnt(6)\n\ts_barrier" ::: "memory");
    {   const lds_cptr kpn = kp0;
        p0 = A3_MFMA(A3_KLD(0), qr[0], negm); p1 = A3_MFMA(A3_KLD2(0), qr[0], negm);
#pragma unroll
        for (int d0 = 1; d0 < 4; ++d0) { p0 = A3_MFMA(A3_KLD(d0), qr[d0], p0); p1 = A3_MFMA(A3_KLD2(d0), qr[d0], p1); }
        if (NT == 4) cmask(p0, p1, 0, qrel, hi);
        A3_ROWMAX(p0, p1, rm);
        mhat = rm;
#pragma unroll
        for (int r = 0; r < 16; ++r) { p0[r] -= rm; p1[r] -= rm; negm[r] = -mhat; }
        rm = 0.f;
    }
#if MK_PROBE
    const unsigned long long pt0 = __builtin_amdgcn_s_memrealtime();
#endif
    for (int t = 0; t < NT; ++t) {
        if (t + 2 < NT) asm volatile("s_waitcnt vmcnt(3)\n\ts_barrier" ::: "memory"); else asm volatile("s_waitcnt vmcnt(0)\n\ts_barrier" ::: "memory");
        if (t + 3 < NT) A3_DMA(t + 3, (t + 3) & 3);
        const lds_cptr kpn = kp0 + ((t + 1) & 3) * A2_SLOT; const lds_cptr vp = vp0 + (t & 3) * A2_SLOT;
        if (__any(rm > (float)THRL)) {
            const float dl = fmaxf(rm, 0.f); mhat += dl;
#pragma unroll
            for (int r = 0; r < 16; ++r) { p0[r] -= dl; p1[r] -= dl; negm[r] = -mhat; }
            const float f = __builtin_amdgcn_exp2f(-dl); l_reg *= f;
            if (hi == 0) wsf[r32] = f;
            asm volatile("s_waitcnt lgkmcnt(0)" ::: "memory");
#pragma unroll
            for (int r = 0; r < 16; ++r) { const float fr_ = wsf[crow(r, hi)];
#pragma unroll
                for (int d_ = 0; d_ < 4; ++d_) o[d_][r] *= fr_; }
            asm volatile("s_waitcnt lgkmcnt(0)" ::: "memory");
        }
        float sacc = 0.f; f32x16 n0, n1; u32x4 pw0, pw1, pw2, pw3; s16x4 vlo[2][4], vhh[2][4];
        {   bf16x8 ka0 = A3_KLD(0), ka1 = A3_KLD2(0), ka2 = A3_KLD(1), ka3 = A3_KLD2(1);
            A3_VLD(0, 0);
            A3_SB();
            n0 = A3_MFMA(ka0, qr[0], negm); A3_EXP2(p0, 0); A3_SB();
            n1 = A3_MFMA(ka1, qr[0], negm); A3_EXP2(p0, 1); A3_SB();
            bf16x8 kb0 = A3_KLD(2), kb1 = A3_KLD2(2), kb2 = A3_KLD(3), kb3 = A3_KLD2(3);
            n0 = A3_MFMA(ka2, qr[1], n0); A3_EXP2(p0, 2); A3_SB();
            n1 = A3_MFMA(ka3, qr[1], n1); A3_EXP2(p0, 3); pw0 = (u32x4){pkbf(p0[0], p0[1]), pkbf(p0[2], p0[3]), pkbf(p0[4], p0[5]), pkbf(p0[6], p0[7])}; A3_SB();
            n0 = A3_MFMA(kb0, qr[2], n0); A3_EXP2(p0, 4); A3_SB();
            n1 = A3_MFMA(kb1, qr[2], n1); A3_EXP2(p0, 5); A3_SB();
            n0 = A3_MFMA(kb2, qr[3], n0); A3_EXP2(p0, 6); A3_SB();
            n1 = A3_MFMA(kb3, qr[3], n1); A3_EXP2(p0, 7); pw1 = (u32x4){pkbf(p0[8], p0[9]), pkbf(p0[10], p0[11]), pkbf(p0[12], p0[13]), pkbf(p0[14], p0[15])}; A3_SB();
        }
        A3_VLD(1, 1); A3_SB();
        o[0] = A3_MFMA(__builtin_bit_cast(bf16x8, pw0), A3_VF(0, 0), o[0]); A3_EXP2(p1, 0); A3_SB();
        o[1] = A3_MFMA(__builtin_bit_cast(bf16x8, pw0), A3_VF(0, 1), o[1]); A3_EXP2(p1, 1); A3_SB();
        o[2] = A3_MFMA(__builtin_bit_cast(bf16x8, pw0), A3_VF(0, 2), o[2]); A3_EXP2(p1, 2); A3_SB();
        o[3] = A3_MFMA(__builtin_bit_cast(bf16x8, pw0), A3_VF(0, 3), o[3]); A3_EXP2(p1, 3); pw2 = (u32x4){pkbf(p1[0], p1[1]), pkbf(p1[2], p1[3]), pkbf(p1[4], p1[5]), pkbf(p1[6], p1[7])}; A3_SB();
        A3_VLD(0, 2); A3_SB();
        o[0] = A3_MFMA(__builtin_bit_cast(bf16x8, pw1), A3_VF(1, 0), o[0]); A3_EXP2(p1, 4); A3_SB();
        o[1] = A3_MFMA(__builtin_bit_cast(bf16x8, pw1), A3_VF(1, 1), o[1]); A3_EXP2(p1, 5); A3_SB();
        o[2] = A3_MFMA(__builtin_bit_cast(bf16x8, pw1), A3_VF(1, 2), o[2]); A3_EXP2(p1, 6); A3_SB();
        o[3] = A3_MFMA(__builtin_bit_cast(bf16x8, pw1), A3_VF(1, 3), o[3]); A3_EXP2(p1, 7); pw3 = (u32x4){pkbf(p1[8], p1[9]), pkbf(p1[10], p1[11]), pkbf(p1[12], p1[13]), pkbf(p1[14], p1[15])}; A3_SB();
        l_reg += sacc;
        A3_VLD(1, 3); A3_SB();
        { const int jb = (t + 1) - (NT - 4); if (jb >= 0 && t + 1 < NT) cmask(n0, n1, jb, qrel, hi); }
        o[0] = A3_MFMA(__builtin_bit_cast(bf16x8, pw2), A3_VF(0, 0), o[0]);
        o[1] = A3_MFMA(__builtin_bit_cast(bf16x8, pw2), A3_VF(0, 1), o[1]);
        o[2] = A3_MFMA(__builtin_bit_cast(bf16x8, pw2), A3_VF(0, 2), o[2]);
        o[3] = A3_MFMA(__builtin_bit_cast(bf16x8, pw2), A3_VF(0, 3), o[3]); A3_SB();
        o[0] = A3_MFMA(__builtin_bit_cast(bf16x8, pw3), A3_VF(1, 0), o[0]);
        o[1] = A3_MFMA(__builtin_bit_cast(bf16x8, pw3), A3_VF(1, 1), o[1]);
        o[2] = A3_MFMA(__builtin_bit_cast(bf16x8, pw3), A3_VF(1, 2), o[2]);
        o[3] = A3_MFMA(__builtin_bit_cast(bf16x8, pw3), A3_VF(1, 3), o[3]);
        A3_ROWMAX(n0, n1, rm);
        p0 = n0; p1 = n1;
        A3_SB();
    }
#if MK_PROBE
    if (prb && tid == 0) { atomicAdd(prb, (unsigned)(__builtin_amdgcn_s_memrealtime() - pt0)); atomicAdd(prb + 1, (unsigned)NT); }
#endif
    asm volatile("s_waitcnt lgkmcnt(0)\n\ts_barrier" ::: "memory");
    { auto rr = __builtin_amdgcn_permlane32_swap(__float_as_uint(l_reg), __float_as_uint(l_reg), false, false); l_reg = __uint_as_float(rr[0]) + __uint_as_float(rr[1]); }
    if (hi == 0) wsf[32 + r32] = l_reg;
    asm volatile("s_waitcnt lgkmcnt(0)" ::: "memory");
    bf16* stg = (bf16*)(shm + A2_OST) + wid * 4096;
#pragma unroll
    for (int r = 0; r < 16; ++r) { const int orow = crow(r, hi); const float rl = __builtin_amdgcn_rcpf(wsf[32 + orow]);
#pragma unroll
        for (int d0 = 0; d0 < 4; ++d0) stg[orow * 128 + d0 * 32 + r32] = __float2bfloat16(o[d0][r] * rl); }
    asm volatile("s_waitcnt lgkmcnt(0)" ::: "memory");
    bf16* Ow = Oh + (long)(q0 + wid * QBLK) * PO;
#pragma unroll
    for (int i = 0; i < 8; ++i) { const int row = i * 4 + (lane >> 4), ch = lane & 15; const u32x4 v = *(const u32x4*)(stg + row * 128 + ch * 8); *(u32x4*)(Ow + (long)row * PO + ch * 8) = v; }
    asm volatile("s_waitcnt lgkmcnt(0)\n\ts_barrier" ::: "memory");
#undef A3_DMA
#undef A3_SB
#undef A3_MFMA
#undef A3_KLD
#undef A3_KLD2
#undef A3_VLD
#undef A3_VF
#undef A3_EXP2
#undef A3_ROWMAX
}
template <int THRL> __device__ __forceinline__ void attn4_unit(int qb, const bf16* Qh0, const bf16* __restrict__ Kh0, long mapstride, const bf16* __restrict__ Vh, bf16_t* YCb_, int yrow0, int ycol0, float lam, const float* gvec, u32x4* park, char* shm) {
#pragma unroll 1
  for (int mp = 0; mp < 2; ++mp) {
    const bf16* Qh = Qh0 + mp * mapstride; const bf16* Kh = Kh0 + mp * mapstride;
    const int tid = threadIdx.x; int lane = tid & 63; asm volatile("" : "+v"(lane));
    const int r32 = lane & 31, hi = lane >> 5; const int wid = __builtin_amdgcn_readfirstlane(tid >> 6);
    const int q0 = qb * QB + NMETA;
    const bf16* Qw = Qh + (long)(q0 + wid * QBLK) * PZ;
    const unsigned lds0 = (unsigned)(uintptr_t)shm;
    float* wsf = (float*)(shm + A2_WS) + wid * 64;
    bf16x8 qr[4];
#pragma unroll
    for (int d0 = 0; d0 < 4; ++d0) qr[d0] = *reinterpret_cast<const bf16x8*>(&Qw[(long)r32 * PZ + d0 * 16 + hi * 8]);
    const bf16* ksrc = Kh + (long)lane * PZ + wid * 8;
    const bf16* vsrc = Vh + (long)(16 * (wid & 3) + (lane >> 2)) * PV + (wid >> 2) * 32 + (lane & 3) * 8;
    const unsigned kdst = lds0 + A2_K + wid * 1024, vdst = lds0 + A2_V + wid * 1024;
#define A3_DMA(t, sl) do { glds16(ksrc + (long)(t) * KVBLK * PZ, (unsigned)__builtin_amdgcn_readfirstlane(kdst + (sl) * A2_SLOT)); \
        glds16(vsrc + (long)(t) * KVBLK * PV, (unsigned)__builtin_amdgcn_readfirstlane(vdst + (sl) * A2_SLOT)); \
        glds16(vsrc + (long)(t) * KVBLK * PV + 64, (unsigned)__builtin_amdgcn_readfirstlane(vdst + (sl) * A2_SLOT + 8192)); } while (0)
#define A3_SB() __builtin_amdgcn_sched_barrier(0)
#define A3_MFMA(A_, B_, C_) __builtin_amdgcn_mfma_f32_32x32x16_bf16((A_), (B_), (C_), 0, 0, 0)
#define A3_KLD(D0) (*(const __attribute__((address_space(3))) bf16x8*)(kpn + (D0) * 2048))
#define A3_KLD2(D0) (*(const __attribute__((address_space(3))) bf16x8*)(kpn + (D0) * 2048 + 512))
#define A3_VLD(BUF, KS) do { _Pragma("unroll") for (int d_ = 0; d_ < 4; ++d_) { vlo[BUF][d_] = vtr(vp + d_ * 4096 + (KS) * 1024); vhh[BUF][d_] = vtr(vp + d_ * 4096 + (KS) * 1024 + 512); } } while (0)
#define A3_VF(BUF, D0) ((bf16x8){vlo[BUF][D0][0], vlo[BUF][D0][1], vlo[BUF][D0][2], vlo[BUF][D0][3], vhh[BUF][D0][0], vhh[BUF][D0][1], vhh[BUF][D0][2], vhh[BUF][D0][3]})
#define A3_EXP2(P, I) do { P[2 * (I)] = __builtin_amdgcn_exp2f(P[2 * (I)]); P[2 * (I) + 1] = __builtin_amdgcn_exp2f(P[2 * (I) + 1]); sacc += P[2 * (I)] + P[2 * (I) + 1]; } while (0)
#define A3_ROWMAX(P0, P1, RM) do { float a_ = fmaxf(fmaxf(P0[0], P0[1]), P1[0]), b_ = fmaxf(fmaxf(P0[2], P0[3]), P1[1]); a_ = fmaxf(fmaxf(a_, P1[2]), P1[3]); \
        _Pragma("unroll") for (int r_ = 4; r_ < 16; r_ += 4) { a_ = fmaxf(fmaxf(a_, P0[r_]), P0[r_ + 1]); b_ = fmaxf(fmaxf(b_, P0[r_ + 2]), P0[r_ + 3]); a_ = fmaxf(fmaxf(a_, P1[r_]), P1[r_ + 1]); b_ = fmaxf(fmaxf(b_, P1[r_ + 2]), P1[r_ + 3]); } \
        RM = fmaxf(a_, b_); auto rr_ = __builtin_amdgcn_permlane32_swap(__float_as_uint(RM), __float_as_uint(RM), false, false); RM = fmaxf(__uint_as_float(rr_[0]), __uint_as_float(rr_[1])); } while (0)
    const int NT = 4 * qb + 5;
    const int qrel16 = wid * QBLK + r32 + NMETA;
    A3_DMA(0, 0); A3_DMA(1, 1); A3_DMA(2, 2);
    asm volatile("" : "+v"(qr[0]), "+v"(qr[1]), "+v"(qr[2]), "+v"(qr[3]));
    const lds_cptr shm3 = (lds_cptr)shm;
    const lds_cptr kp0 = shm3 + A2_K + hi * 1024 + r32 * 16;
    const lds_cptr vp0 = shm3 + A2_V + ((lane >> 4) & 1) * 32 + (lane & 3) * 8 + (4 * hi + ((lane & 15) >> 2)) * 64;
    float mhat = 0.f, l_reg = 0.f; f32x16 o[4]; o[0] = f32x16{}; o[1] = f32x16{}; o[2] = f32x16{}; o[3] = f32x16{}; f32x16 negm = f32x16{};
    const int qrel = wid * QBLK + r32;
    f32x16 p0, p1; float rm;
    asm volatile("s_waitcnt vmcnt(6)\n\ts_barrier" ::: "memory");
    {   const lds_cptr kpn = kp0;
        p0 = A3_MFMA(A3_KLD(0), qr[0], negm); p1 = A3_MFMA(A3_KLD2(0), qr[0], negm);
#pragma unroll
        for (int d0 = 1; d0 < 4; ++d0) { p0 = A3_MFMA(A3_KLD(d0), qr[d0], p0); p1 = A3_MFMA(A3_KLD2(d0), qr[d0], p1); }
        if (qb == 0) cmask(p0, p1, 0, qrel16, hi);
        A3_ROWMAX(p0, p1, rm);
        mhat = rm;
#pragma unroll
        for (int r = 0; r < 16; ++r) { p0[r] -= rm; p1[r] -= rm; negm[r] = -mhat; }
        rm = 0.f;
    }
    for (int t = 0; t < NT; ++t) {
        if (t + 2 < NT) asm volatile("s_waitcnt vmcnt(3)\n\ts_barrier" ::: "memory"); else asm volatile("s_waitcnt vmcnt(0)\n\ts_barrier" ::: "memory");
        if (t + 3 < NT) A3_DMA(t + 3, (t + 3) & 3);
        const lds_cptr kpn = kp0 + ((t + 1) & 3) * A2_SLOT; const lds_cptr vp = vp0 + (t & 3) * A2_SLOT;
        if (__any(rm > (float)THRL)) {
            const float dl = fmaxf(rm, 0.f); mhat += dl;
#pragma unroll
            for (int r = 0; r < 16; ++r) { p0[r] -= dl; p1[r] -= dl; negm[r] = -mhat; }
            const float f = __builtin_amdgcn_exp2f(-dl); l_reg *= f;
            if (hi == 0) wsf[r32] = f;
            asm volatile("s_waitcnt lgkmcnt(0)" ::: "memory");
#pragma unroll
            for (int r = 0; r < 16; ++r) { const float fr_ = wsf[crow(r, hi)];
#pragma unroll
                for (int d_ = 0; d_ < 4; ++d_) o[d_][r] *= fr_; }
            asm volatile("s_waitcnt lgkmcnt(0)" ::: "memory");
        }
        float sacc = 0.f; f32x16 n0, n1; u32x4 pw0, pw1, pw2, pw3; s16x4 vlo[2][4], vhh[2][4];
        {   bf16x8 ka0 = A3_KLD(0), ka1 = A3_KLD2(0), ka2 = A3_KLD(1), ka3 = A3_KLD2(1);
            A3_VLD(0, 0);
            A3_SB();
            n0 = A3_MFMA(ka0, qr[0], negm); A3_EXP2(p0, 0); A3_SB();
            n1 = A3_MFMA(ka1, qr[0], negm); A3_EXP2(p0, 1); A3_SB();
            bf16x8 kb0 = A3_KLD(2), kb1 = A3_KLD2(2), kb2 = A3_KLD(3), kb3 = A3_KLD2(3);
            n0 = A3_MFMA(ka2, qr[1], n0); A3_EXP2(p0, 2); A3_SB();
            n1 = A3_MFMA(ka3, qr[1], n1); A3_EXP2(p0, 3); pw0 = (u32x4){pkbf(p0[0], p0[1]), pkbf(p0[2], p0[3]), pkbf(p0[4], p0[5]), pkbf(p0[6], p0[7])}; A3_SB();
            n0 = A3_MFMA(kb0, qr[2], n0); A3_EXP2(p0, 4); A3_SB();
            n1 = A3_MFMA(kb1, qr[2], n1); A3_EXP2(p0, 5); A3_SB();
            n0 = A3_MFMA(kb2, qr[3], n0); A3_EXP2(p0, 6); A3_SB();
            n1 = A3_MFMA(kb3, qr[3], n1); A3_EXP2(p0, 7); pw1 = (u32x4){pkbf(p0[8], p0[9]), pkbf(p0[10], p0[11]), pkbf(p0[12], p0[13]), pkbf(p0[14], p0[15])}; A3_SB();
        }
        A3_VLD(1, 1); A3_SB();
        o[0] = A3_MFMA(__builtin_bit_cast(bf16x8, pw0), A3_VF(0, 0), o[0]); A3_EXP2(p1, 0); A3_SB();
        o[1] = A3_MFMA(__builtin_bit_cast(bf16x8, pw0), A3_VF(0, 1), o[1]); A3_EXP2(p1, 1); A3_SB();
        o[2] = A3_MFMA(__builtin_bit_cast(bf16x8, pw0), A3_VF(0, 2), o[2]); A3_EXP2(p1, 2); A3_SB();
        o[3] = A3_MFMA(__builtin_bit_cast(bf16x8, pw0), A3_VF(0, 3), o[3]); A3_EXP2(p1, 3); pw2 = (u32x4){pkbf(p1[0], p1[1]), pkbf(p1[2], p1[3]), pkbf(p1[4], p1[5]), pkbf(p1[6], p1[7])}; A3_SB();
        A3_VLD(0, 2); A3_SB();
        o[0] = A3_MFMA(__builtin_bit_cast(bf16x8, pw1), A3_VF(1, 0), o[0]); A3_EXP2(p1, 4); A3_SB();
        o[1] = A3_MFMA(__builtin_bit_cast(bf16x8, pw1), A3_VF(1, 1), o[1]); A3_EXP2(p1, 5); A3_SB();
        o[2] = A3_MFMA(__builtin_bit_cast(bf16x8, pw1), A3_VF(1, 2), o[2]); A3_EXP2(p1, 6); A3_SB();
        o[3] = A3_MFMA(__builtin_bit_cast(bf16x8, pw1), A3_VF(1, 3), o[3]); A3_EXP2(p1, 7); pw3 = (u32x4){pkbf(p1[8], p1[9]), pkbf(p1[10], p1[11]), pkbf(p1[12], p1[13]), pkbf(p1[14], p1[15])}; A3_SB();
        l_reg += sacc;
        A3_VLD(1, 3); A3_SB();
        { const int jb = (t + 1) - 4 * qb; if (jb >= 0 && t + 1 < NT) cmask(n0, n1, jb, qrel16, hi); }
        o[0] = A3_MFMA(__builtin_bit_cast(bf16x8, pw2), A3_VF(0, 0), o[0]);
        o[1] = A3_MFMA(__builtin_bit_cast(bf16x8, pw2), A3_VF(0, 1), o[1]);
        o[2] = A3_MFMA(__builtin_bit_cast(bf16x8, pw2), A3_VF(0, 2), o[2]);
        o[3] = A3_MFMA(__builtin_bit_cast(bf16x8, pw2), A3_VF(0, 3), o[3]); A3_SB();
        o[0] = A3_MFMA(__builtin_bit_cast(bf16x8, pw3), A3_VF(1, 0), o[0]);
        o[1] = A3_MFMA(__builtin_bit_cast(bf16x8, pw3), A3_VF(1, 1), o[1]);
        o[2] = A3_MFMA(__builtin_bit_cast(bf16x8, pw3), A3_VF(1, 2), o[2]);
        o[3] = A3_MFMA(__builtin_bit_cast(bf16x8, pw3), A3_VF(1, 3), o[3]);
        A3_ROWMAX(n0, n1, rm);
        p0 = n0; p1 = n1;
        A3_SB();
    }
    asm volatile("s_waitcnt lgkmcnt(0)\n\ts_barrier" ::: "memory");
    { auto rr = __builtin_amdgcn_permlane32_swap(__float_as_uint(l_reg), __float_as_uint(l_reg), false, false); l_reg = __uint_as_float(rr[0]) + __uint_as_float(rr[1]); }
    if (hi == 0) wsf[32 + r32] = l_reg;
    asm volatile("s_waitcnt lgkmcnt(0)" ::: "memory");
    float rl[16];
#pragma unroll
    for (int r = 0; r < 16; ++r) rl[r] = __builtin_amdgcn_rcpf(wsf[32 + crow(r, hi)]);
    if (mp == 0) {
#pragma unroll
        for (int d0 = 0; d0 < 4; ++d0)
#pragma unroll
            for (int q4 = 0; q4 < 2; ++q4) { u32x4 w;
                w.x = pkbf(o[d0][8 * q4 + 0] * rl[8 * q4 + 0], o[d0][8 * q4 + 1] * rl[8 * q4 + 1]); w.y = pkbf(o[d0][8 * q4 + 2] * rl[8 * q4 + 2], o[d0][8 * q4 + 3] * rl[8 * q4 + 3]);
                w.z = pkbf(o[d0][8 * q4 + 4] * rl[8 * q4 + 4], o[d0][8 * q4 + 5] * rl[8 * q4 + 5]); w.w = pkbf(o[d0][8 * q4 + 6] * rl[8 * q4 + 6], o[d0][8 * q4 + 7] * rl[8 * q4 + 7]);
                park[d0 * 2 + q4] = w; }
    } else {
        float ss[16];
#pragma unroll
        for (int r = 0; r < 16; ++r) ss[r] = 0.f;
#pragma unroll
        for (int d0 = 0; d0 < 4; ++d0)
#pragma unroll
            for (int q4 = 0; q4 < 2; ++q4) { const u32x4 w = park[d0 * 2 + q4];
                const float a_[8] = {bflo(w.x), bfhi(w.x), bflo(w.y), bfhi(w.y), bflo(w.z), bfhi(w.z), bflo(w.w), bfhi(w.w)};
#pragma unroll
                for (int e = 0; e < 8; ++e) { const int r = 8 * q4 + e; const float y = a_[e] - lam * (o[d0][r] * rl[r]); o[d0][r] = y; ss[r] += y * y; } }
        const f32x4 g4 = (f32x4){gvec[r32], gvec[32 + r32], gvec[64 + r32], gvec[96 + r32]} * (1.0f - LAMBDA_INIT);
#pragma unroll
        for (int r = 0; r < 16; ++r) {
            float v = row_sum16(ss[r]);
            auto rr = __builtin_amdgcn_permlane16_swap(__float_as_uint(v), __float_as_uint(v), false, false); v = __uint_as_float(rr[0]) + __uint_as_float(rr[1]);
            ss[r] = 1.0f / sqrtf(v * (1.f / 128.f) + LN_EPS);
        }
        bf16* stg = (bf16*)(shm + A2_OST) + wid * 4096;
#pragma unroll
        for (int r = 0; r < 16; ++r) { const int orow = crow(r, hi);
#pragma unroll
            for (int d0 = 0; d0 < 4; ++d0) stg[orow * 128 + d0 * 32 + r32] = __float2bfloat16(o[d0][r] * ss[r] * g4[d0]); }
        asm volatile("s_waitcnt lgkmcnt(0)" ::: "memory");
#pragma unroll
        for (int i = 0; i < 8; ++i) { const int row = i * 4 + (lane >> 4), ch = lane & 15; const int tq = q0 + wid * QBLK + row;
            if (tq >= NMETA && tq < TT) { const u32x4 v = *(const u32x4*)(stg + row * 128 + ch * 8); *(u32x4*)(YCb_ + (size_t)(yrow0 + tq - NMETA) * DM + ycol0 + ch * 8) = v; } }
    }
    asm volatile("s_waitcnt lgkmcnt(0)\n\ts_barrier" ::: "memory");
#undef A3_DMA
#undef A3_SB
#undef A3_MFMA
#undef A3_KLD
#undef A3_KLD2
#undef A3_VLD
#undef A3_VF
#undef A3_EXP2
#undef A3_ROWMAX
  }
}
#undef SBAR
#undef WAIT_BAR
}

#define XB_TMO      128
#define XB_XCNT(j)  (256  + 64 * (j))
#define XB_XSUB(j)  (1280 + 64 * (j))
#define XB_XGEN(j)  (2304 + 64 * (j))
#define XB_TOP      3328
#define XB_TOPGEN   3392
#define XCD_BAR_WORDS 3456
#define XB_SPIN_CAP (1u << 18)
__device__ __forceinline__ unsigned xb_ld(unsigned* p)              { return __hip_atomic_load(p, __ATOMIC_RELAXED, __HIP_MEMORY_SCOPE_AGENT); }
__device__ __forceinline__ unsigned xb_add(unsigned* p, unsigned v) { return __hip_atomic_fetch_add(p, v, __ATOMIC_RELAXED, __HIP_MEMORY_SCOPE_AGENT); }
__device__ __forceinline__ unsigned xb_xcc_id() { return (unsigned)__builtin_amdgcn_s_getreg((3 << 11) | 20) & 0xFu; }
#define XB_SPIN(cond, bar) do { unsigned _sp = 0; while (cond) { __builtin_amdgcn_s_sleep(1); \
    if ((++_sp & 255u) == 0u) { if (xb_ld(&(bar)[XB_TMO])) break; if (_sp > XB_SPIN_CAP) { atomicAdd(&(bar)[XB_TMO], 1u); break; } } } } while (0)
struct XcdBarrier { unsigned* bar; unsigned x; volatile LAS unsigned* st; };
__device__ __forceinline__ XcdBarrier xcd_barrier_post(unsigned* bar, volatile LAS unsigned* st) {
    XcdBarrier b; b.bar = bar; b.x = xb_xcc_id(); b.st = st;
    if (threadIdx.x == 0) (void)xb_add(&bar[XB_XCNT(b.x)], 1u);
    return b;
}
__device__ __forceinline__ void xcd_barrier_complete(unsigned* bar, unsigned x, unsigned& nloc, unsigned& nx) {
    const unsigned G = gridDim.x * gridDim.y * gridDim.z;
    unsigned sum, cnt, mine, sp = 0u;
    for (;;) {
        sum = 0u; cnt = 0u; mine = 0u;
#pragma unroll
        for (unsigned j = 0; j < 16; ++j) { const unsigned c = xb_ld(&bar[XB_XCNT(j)]); sum += c; cnt += (c > 0u) ? 1u : 0u; mine = (j == x) ? c : mine; }
        if (sum == G) break;
        __builtin_amdgcn_s_sleep(1);
        if ((++sp & 255u) == 0u) { if (xb_ld(&bar[XB_TMO])) break; if (sp > XB_SPIN_CAP) { atomicAdd(&bar[XB_TMO], 1u); break; } }
    }
    nloc = mine > 0u ? mine : 1u; nx = cnt > 0u ? cnt : 1u;
}
__device__ __forceinline__ void xcd_barrier(const XcdBarrier& b) {
    asm volatile("s_waitcnt vmcnt(0)" ::: "memory");
    __syncthreads();
    if (threadIdx.x == 0) {
        unsigned* bar = b.bar;
        __builtin_amdgcn_s_waitcnt(0);
        unsigned nloc = b.st[0], nx = b.st[1];
        if (nloc == 0u) { xcd_barrier_complete(bar, b.x, nloc, nx); b.st[0] = nloc; b.st[1] = nx; }
        const unsigned old = xb_add(&bar[XB_XSUB(b.x)], 1u);
        const unsigned gen = old / nloc;
        if (old + 1u == (gen + 1u) * nloc) {
            __builtin_amdgcn_fence(__ATOMIC_RELEASE, "agent");
            asm volatile("s_waitcnt vmcnt(0)" ::: "memory");
            const unsigned og = xb_add(&bar[XB_TOP], 1u);
            const unsigned tg = og / nx;
            if (og + 1u == (tg + 1u) * nx) xb_add(&bar[XB_TOPGEN], 1u);
            else XB_SPIN(xb_ld(&bar[XB_TOPGEN]) == tg, bar);
            __builtin_amdgcn_fence(__ATOMIC_ACQUIRE, "agent");
            xb_add(&bar[XB_XGEN(b.x)], 1u);
            asm volatile("s_waitcnt vmcnt(0)" ::: "memory");
        } else {
            XB_SPIN(xb_ld(&bar[XB_XGEN(b.x)]) == gen, bar);
            __builtin_amdgcn_fence(__ATOMIC_ACQUIRE, "agent");
            asm volatile("s_waitcnt vmcnt(0)" ::: "memory");
        }
    }
    __syncthreads();
}

struct Args {
    const float *x, *meta, *ln0_g, *ln0_b, *w_in, *conv_w, *conv_b, *gate_bias, *lq1, *lk1, *lq2, *lk2, *att_g, *ml_g, *w_att_out, *w_ml_out, *w_o,
                *ln1_g, *ln1_b, *w_router, *b_router, *w_gu, *b_gu, *w_down, *b_down, *ln2_g, *ln2_b;
    float* out; unsigned char* ws; int ph_lo, ph_hi;
};

template <class ColMap>
__device__ __forceinline__ void transpose_item(const float* W, int K, int N, bf16_t* WT, LAS float* scr, int kb, int nb, int lane, ColMap cm, int ldw = 0) {
    if (ldw == 0) ldw = K;
    const int k0 = 64 * kb, n0 = 32 * nb;
    const int lc = cm(n0 + (lane & 31));
    float tv[32];
    const float* wp = W + (size_t)(k0 + (lane >> 5)) * N + lc;
#pragma unroll
    for (int i = 0; i < 32; ++i) tv[i] = wp[(size_t)(2 * i) * N];
#pragma unroll
    for (int i = 0; i < 32; ++i) { const int kk = 2 * i + (lane >> 5); scr[kk * 33 + (lane & 31)] = tv[i]; }
    LDS_WAIT(); asm volatile("" ::: "memory");
    const int c = lane & 7;
#pragma unroll
    for (int j = 0; j < 4; ++j) { const int n = (lane >> 3) + 8 * j; const LAS float* s = scr + (8 * c) * 33 + n;
        u32x4 o; o.x = pkbf(s[0 * 33], s[1 * 33]); o.y = pkbf(s[2 * 33], s[3 * 33]); o.z = pkbf(s[4 * 33], s[5 * 33]); o.w = pkbf(s[6 * 33], s[7 * 33]);
        *(u32x4*)(WT + (size_t)(n0 + n) * ldw + k0 + 8 * c) = o; }
    LDS_WAIT(); asm volatile("" ::: "memory");
}
template <class ColMap>
__device__ __forceinline__ void transpose_item2(const float* W, int K, int N, bf16_t* WT, LAS float* scr, int kb, int nb, int lane, ColMap cm) {
    const int k0 = 64 * kb, n0 = 32 * nb;
    const int lc0 = cm(n0 + (lane & 31)), lc1 = cm(n0 + 32 + (lane & 31));
    float ta[32], tb[32];
    const float* wp = W + (size_t)(k0 + (lane >> 5)) * N;
#pragma unroll
    for (int i = 0; i < 32; ++i) { ta[i] = wp[(size_t)(2 * i) * N + lc0]; tb[i] = wp[(size_t)(2 * i) * N + lc1]; }
    LAS float* scr2 = scr + 64 * 33;
#pragma unroll
    for (int i = 0; i < 32; ++i) { const int kk = 2 * i + (lane >> 5); scr[kk * 33 + (lane & 31)] = ta[i]; scr2[kk * 33 + (lane & 31)] = tb[i]; }
    LDS_WAIT(); asm volatile("" ::: "memory");
    const int c = lane & 7;
#pragma unroll
    for (int h2 = 0; h2 < 2; ++h2) { const LAS float* sb = h2 ? scr2 : scr;
#pragma unroll
        for (int j = 0; j < 4; ++j) { const int n = (lane >> 3) + 8 * j; const LAS float* sp = sb + (8 * c) * 33 + n;
            u32x4 o; o.x = pkbf(sp[0 * 33], sp[1 * 33]); o.y = pkbf(sp[2 * 33], sp[3 * 33]); o.z = pkbf(sp[4 * 33], sp[5 * 33]); o.w = pkbf(sp[6 * 33], sp[7 * 33]);
            *(u32x4*)(WT + (size_t)(n0 + 32 * h2 + n) * K + k0 + 8 * c) = o; } }
    LDS_WAIT(); asm volatile("" ::: "memory");
}
template <class InvMap>
__device__ __forceinline__ void transpose_tile64(const float* W, int N, bf16_t* WT, int ldw, LAS unsigned char* scr, int k0, int c0, int lane, InvMap inv) {
    constexpr int TP = 136;
    asm volatile("" : "+v"(lane));
    const float* wp = W + (size_t)(k0 + (lane >> 4)) * N + c0 + (lane & 15) * 4;
#pragma unroll
    for (int hf = 0; hf < 2; ++hf) {
        f32x4 tv[8];
#pragma unroll
        for (int i = 0; i < 8; ++i) tv[i] = *(const f32x4*)(wp + (size_t)(4 * (8 * hf + i)) * N);
#pragma unroll
        for (int i = 0; i < 8; ++i) { u32x2 w; w.x = pkbf(tv[i][0], tv[i][1]); w.y = pkbf(tv[i][2], tv[i][3]);
            *(LAS u32x2*)(scr + ((lane >> 4) + 4 * (8 * hf + i)) * TP + (lane & 15) * 8) = w; }
        asm volatile("" ::: "memory");
    }
    LDS_WAIT(); asm volatile("" ::: "memory");
    const int g = lane >> 4, p = lane & 15;
#pragma unroll
    for (int it = 0; it < 8; ++it) {
        const int cq = it & 3, kq = (it >> 2) * 4 + g;
        const LAS unsigned char* a = scr + (8 * kq + (p >> 2)) * TP + (16 * cq + 4 * (p & 3)) * 2;
        const attn_body::s16x4 lo = attn_body::vtr((attn_body::lds_cptr)a), hi4 = attn_body::vtr((attn_body::lds_cptr)(a + 4 * TP));
        u32x4 o; o.x = (unsigned)(unsigned short)lo[0] | ((unsigned)(unsigned short)lo[1] << 16); o.y = (unsigned)(unsigned short)lo[2] | ((unsigned)(unsigned short)lo[3] << 16);
        o.z = (unsigned)(unsigned short)hi4[0] | ((unsigned)(unsigned short)hi4[1] << 16); o.w = (unsigned)(unsigned short)hi4[2] | ((unsigned)(unsigned short)hi4[3] << 16);
        *(u32x4*)(WT + (size_t)inv(c0 + 16 * cq + p) * ldw + k0 + 8 * kq) = o;
    }
    LDS_WAIT(); asm volatile("" ::: "memory");
}
template <class InvMap>
__device__ __forceinline__ void transpose_tile64_fp8(const float* W, int N, unsigned char* WT, int ldw, LAS unsigned char* scr, int k0, int c0, int lane, InvMap inv, float scale) {
    constexpr int TP = 136;
    asm volatile("" : "+v"(lane));
    const float* wp = W + (size_t)(k0 + (lane >> 4)) * N + c0 + (lane & 15) * 4;
#pragma unroll
    for (int hf = 0; hf < 2; ++hf) {
        f32x4 tv[8];
#pragma unroll
        for (int i = 0; i < 8; ++i) tv[i] = *(const f32x4*)(wp + (size_t)(4 * (8 * hf + i)) * N);
#pragma unroll
        for (int i = 0; i < 8; ++i) { u32x2 w; w.x = pkbf(tv[i][0], tv[i][1]); w.y = pkbf(tv[i][2], tv[i][3]);
            *(LAS u32x2*)(scr + ((lane >> 4) + 4 * (8 * hf + i)) * TP + (lane & 15) * 8) = w; }
        asm volatile("" ::: "memory");
    }
    LDS_WAIT(); asm volatile("" ::: "memory");
    const int g = lane >> 4, p = lane & 15;
#pragma unroll
    for (int cq = 0; cq < 4; ++cq) {
        const LAS unsigned char* a = scr + (16 * g + (p >> 2)) * TP + (16 * cq + 4 * (p & 3)) * 2;
        u32x4 o;
#pragma unroll
        for (int q4 = 0; q4 < 4; ++q4) { const attn_body::s16x4 t4 = attn_body::vtr((attn_body::lds_cptr)(a + 4 * q4 * TP));
            o[q4] = pkfp8x4(__uint_as_float(((unsigned)(unsigned short)t4[0]) << 16) * scale, __uint_as_float(((unsigned)(unsigned short)t4[1]) << 16) * scale,
                            __uint_as_float(((unsigned)(unsigned short)t4[2]) << 16) * scale, __uint_as_float(((unsigned)(unsigned short)t4[3]) << 16) * scale); }
        *(u32x4*)(WT + (size_t)inv(c0 + 16 * cq + p) * ldw + k0 + 16 * g) = o;
    }
    LDS_WAIT(); asm volatile("" ::: "memory");
}
struct InvIdent { __device__ __forceinline__ int operator()(int c) const { return c; } };
struct InvGu {
    __device__ __forceinline__ int operator()(int c) const { const int sgl = c & 1, idx = c >> 1; return 256 * (idx >> 7) + 128 * sgl + (idx & 127); } };
struct CmIdent { __device__ __forceinline__ int operator()(int p) const { return p; } };
struct CmWin {
    __device__ __forceinline__ int operator()(int P) const {
        if (P < 1024) { const int hb = P >> 6, p = P & 63, wcp = p >> 5, fq = (p & 31) >> 3, n = (p & 7) >> 2, j = p & 3; return hb * 64 + 32 * n + 16 * wcp + 4 * fq + j; }
        if (P < 3584) return P;
        return P + 8;
    }
};
struct CmGu {
    __device__ __forceinline__ int operator()(int P) const { const int pn = P >> 8, s = (P >> 7) & 1, i = P & 127; return 2 * (128 * pn + i) + s; }
};

__global__ void __launch_bounds__(NWAVES * 64, 2) hybrid_fwd(Args a) {
    extern __shared__ __attribute__((aligned(16))) unsigned char lds[];
    LAS unsigned char* L = (LAS unsigned char*)lds;
    const int tid = threadIdx.x, lane = tid & 63, wave = __builtin_amdgcn_readfirstlane(tid >> 6);
    const int G = gridDim.x, blk = blockIdx.x;
    const int gw = blk * NWAVES + wave, NGW = G * NWAVES;
    if (tid < 16) ((LAS unsigned*)(L + MISC_OFF))[tid] = 0u;
    LAS unsigned long long* ptab = (LAS unsigned long long*)(L + MISC_OFF + 64);
    if (tid == 0) {
        ptab[0] = (unsigned long long)a.x; ptab[1] = (unsigned long long)a.meta; ptab[2] = (unsigned long long)a.ln0_g; ptab[3] = (unsigned long long)a.ln0_b; ptab[4] = (unsigned long long)a.w_in;
        ptab[5] = (unsigned long long)a.conv_w; ptab[6] = (unsigned long long)a.conv_b; ptab[7] = (unsigned long long)a.gate_bias; ptab[8] = (unsigned long long)a.lq1; ptab[9] = (unsigned long long)a.lk1;
        ptab[10] = (unsigned long long)a.lq2; ptab[11] = (unsigned long long)a.lk2; ptab[12] = (unsigned long long)a.att_g; ptab[13] = (unsigned long long)a.ml_g; ptab[14] = (unsigned long long)a.w_att_out;
        ptab[15] = (unsigned long long)a.w_ml_out; ptab[16] = (unsigned long long)a.w_o; ptab[17] = (unsigned long long)a.ln1_g; ptab[18] = (unsigned long long)a.ln1_b; ptab[19] = (unsigned long long)a.w_router;
        ptab[20] = (unsigned long long)a.b_router; ptab[21] = (unsigned long long)a.w_gu; ptab[22] = (unsigned long long)a.b_gu; ptab[23] = (unsigned long long)a.w_down; ptab[24] = (unsigned long long)a.b_down;
        ptab[25] = (unsigned long long)a.ln2_g; ptab[26] = (unsigned long long)a.ln2_b; ptab[27] = (unsigned long long)a.out; ptab[28] = (unsigned long long)a.ws;
    }
    asm volatile("s_waitcnt lgkmcnt(0)" ::: "memory");
    __syncthreads();
    asm volatile("" ::: "memory");
#define PF(i) ((const float*)ldptr(ptab, (i)))
#define WSP ((unsigned char*)ldptr(ptab, 28))
#define DOUTP ((unsigned char*)ldptr(ptab, 27))
#define ctl ((unsigned*)(WSP + WS_CTL))
#define WinT ((bf16_t*)(WSP + WS_WIN))
#define WaT ((bf16_t*)(WSP + WS_WA))
#define WmT ((bf16_t*)(WSP + WS_WM))
#define WoT ((bf16_t*)(WSP + WS_WO))
#define ropec ((float*)(WSP + WS_ROPE))
#define ropes (ropec + TT * 32)
#define stats ((float*)(WSP + WS_STATS))
#define gates ((float*)(WSP + WS_GATES))
#define tok_e ((int*)(WSP + WS_TOKE))
#define tok_g ((float*)(WSP + WS_TOKG))
#define hist ((int*)(WSP + WS_HIST))
#define row_off ((int*)(WSP + WS_ROWOFF))
#define row_slot ((int*)(WSP + WS_ROWSLOT))
#define row_gate ((float*)(WSP + WS_ROWGATE))
#define tile_exp ((int*)(WSP + WS_TILEEXP))
#define Hb ((bf16_t*)(WSP + WS_H))
#define Z ((bf16_t*)(WSP + WS_Z))
#define Y ((bf16_t*)(WSP + WS_Y))
#define ACT ((bf16_t*)(WSP + WS_ACT))
#define Qc ((bf16_t*)(WSP + WS_QC))
#define Kc ((bf16_t*)(WSP + WS_KC))
#define Vc ((bf16_t*)(WSP + WS_VC))
#define TMPb ((bf16_t*)(WSP + WS_TMP))
#define MRGb ((bf16_t*)(WSP + WS_MRG))
#define GFb ((bf16_t*)(WSP + WS_GF))
#define YCb ((bf16_t*)(WSP + WS_H))
#define Ob ((bf16_t*)(WSP + WS_O))
#define WguT ((bf16_t*)(DOUTP + DO_WGU))
#define WdnT ((bf16_t*)(DOUTP + DO_WDN))
#if !MK_PER_PHASE
    XcdBarrier bar = xcd_barrier_post(ctl + CW_BAR, (volatile LAS unsigned*)(L + MISC_OFF + 32));
#define GRID_BAR() xcd_barrier(bar)
#else
#define GRID_BAR() do {} while (0)
#endif
    const int lo = a.ph_lo, hi = a.ph_hi;
#if MK_PROBE == 2
    LAS unsigned* pdur = (LAS unsigned*)(L + MISC_OFF + 320);
    if (blk == 0 && tid == 0) { pdur[30] = (unsigned)__builtin_amdgcn_s_memrealtime(); pdur[31] = pdur[30]; pdur[29] = pdur[30]; for (int q_ = 16; q_ < 29; ++q_) pdur[q_] = 0u; }
#define PSTAMP(k) do { if (blk == 0 && tid == 0) { const unsigned now_ = (unsigned)__builtin_amdgcn_s_memrealtime(); pdur[k] = now_ - pdur[30]; pdur[30] = now_; } } while (0)
#define CSTAMP(k) do { if (blk == 0 && tid == 0) { const unsigned now_ = (unsigned)__builtin_amdgcn_s_memrealtime(); pdur[16 + (k)] += now_ - pdur[31]; pdur[31] = now_; } } while (0)
#else
#define PSTAMP(k) do {} while (0)
#define CSTAMP(k) do {} while (0)
#endif
#define IN(k) (lo <= (k) && (k) < hi)
#define BOTH(k) (IN(k) && IN((k) + 1))

    if (IN(0)) REPLOOP(0) {
        {   LAS float* scr = (LAS float*)(L + wave * 16384);
            constexpr int I_IN = 16 * (NZP / 32), I_A = 8 * 32, I_O = 16 * 32;
            constexpr int NIT = I_IN + 2 * I_A + I_O;
            for (int it = gw; it < NIT; it += NGW) {
                int r = it;
                if (r < I_IN) { transpose_item(PF(4), 1024, NIN, WinT, scr, r / (NZP / 32), r % (NZP / 32), lane, CmWin()); continue; } r -= I_IN;
                if (r < I_A) { transpose_item(PF(14), 512, 1024, WaT, scr, r / 32, r % 32, lane, CmIdent(), 1024); continue; } r -= I_A;
                if (r < I_A) { transpose_item(PF(15), 512, 1024, WaT + 512, scr, r / 32, r % 32, lane, CmIdent(), 1024); continue; } r -= I_A;
                transpose_item(PF(16), 1024, 1024, WoT, scr, r / 32, r % 32, lane, CmIdent());
            }
        }
        for (int i = blk * 512 + tid; i < TT * 32; i += G * 512) {
            const int t = i >> 5, f = i & 31;
            const double inv = exp2(-(double)f * (13.287712379549449 / 32.0));
            const double rev = (double)t * inv * 0.15915494309189535;
            const float fr = (float)(rev - floor(rev));
            ropec[i] = __builtin_amdgcn_cosf(fr); ropes[i] = __builtin_amdgcn_sinf(fr);
        }
        __syncthreads();
        LAS float* wg = (LAS float*)L;
        for (int i = tid; i < 8 * 1024; i += 512) { const int gc = i >> 10, k = i & 1023; wg[i] = PF(4)[(size_t)k * NIN + 3584 + gc]; }
        __syncthreads();
        {
            const float* xin = PF(0); const float* metap = PF(1); const float* gbias = PF(7);
            const float* g0p = PF(2); const float* b0p = PF(3);
            bf16_t* Hbp = Hb; float* statsp = stats; float* gatesp = gates;
            const int q_of_lane = (lane >> 1) & 7, r_of_lane = lane >> 4;
            const float gb = gbias[q_of_lane];
            for (int base = gw * 4; base < MROWS; base += NGW * 4) {
                f32x4 v[4][4]; float sm[4];
#pragma unroll
                for (int r = 0; r < 4; ++r) { const int row = (base + r < MROWS) ? base + r : MROWS - 1;
                    const float* xr = (row < NREAL) ? xin + (size_t)row * DM : metap + (size_t)((row - NREAL) & (NMETA - 1)) * DM;
#pragma unroll
                    for (int j = 0; j < 4; ++j) v[r][j] = *(const f32x4*)(xr + 4 * lane + 256 * j); }
#pragma unroll
                for (int r = 0; r < 4; ++r) { float s = 0.f;
#pragma unroll
                    for (int j = 0; j < 4; ++j) s += (v[r][j][0] + v[r][j][1]) + (v[r][j][2] + v[r][j][3]);
                    sm[r] = s; }
                float mean[4], rstd[4];
#pragma unroll
                for (int r = 0; r < 4; ++r) mean[r] = wave_sum(sm[r]) * (1.f / DM);
#pragma unroll
                for (int r = 0; r < 4; ++r) { float s2 = 0.f;
#pragma unroll
                    for (int j = 0; j < 4; ++j) { const f32x4 d = v[r][j] - mean[r]; s2 += (d[0] * d[0] + d[1] * d[1]) + (d[2] * d[2] + d[3] * d[3]); }
                    sm[r] = s2; }
#pragma unroll
                for (int r = 0; r < 4; ++r) rstd[r] = 1.0f / sqrtf(wave_sum(sm[r]) * (1.f / DM) + LN_EPS);
                float gp[32];
#pragma unroll
                for (int q = 0; q < 32; ++q) gp[q] = 0.f;
#pragma unroll
                for (int j = 0; j < 4; ++j) {
                    const f32x4 ggj = *(const f32x4*)(g0p + 4 * lane + 256 * j), bbj = *(const f32x4*)(b0p + 4 * lane + 256 * j);
#pragma unroll
                    for (int r = 0; r < 4; ++r) { v[r][j] = (v[r][j] - mean[r]) * rstd[r] * ggj + bbj;
                        if (base + r < MROWS) { u32x2 w; w.x = pkbf(v[r][j][0], v[r][j][1]); w.y = pkbf(v[r][j][2], v[r][j][3]); *(u32x2*)(Hbp + (size_t)(base + r) * DM + 4 * lane + 256 * j) = w; } }
#pragma unroll
                    for (int q = 0; q < 8; ++q) { const f32x4 wv = *(const LAS f32x4*)(wg + q * 1024 + 4 * lane + 256 * j);
#pragma unroll
                        for (int r = 0; r < 4; ++r) gp[r * 8 + q] += (v[r][j][0] * wv[0] + v[r][j][1] * wv[1]) + (v[r][j][2] * wv[2] + v[r][j][3] * wv[3]); }
                }
                const float gsum = xreduce32(gp, lane);
                const int rowl = base + r_of_lane;
                if (rowl < MROWS) {
                    if ((lane & 1) == 0) { float gv = gsum + gb;
                        if (q_of_lane >= 4) gv = (gv >= 0.f) ? -log1pf(expf(-gv)) : gv - log1pf(expf(gv));
                        gatesp[(size_t)rowl * 8 + q_of_lane] = gv; }
                    if ((lane & 15) == 0) { const float mr = (r_of_lane == 0) ? mean[0] : (r_of_lane == 1) ? mean[1] : (r_of_lane == 2) ? mean[2] : mean[3];
                        const float rr = (r_of_lane == 0) ? rstd[0] : (r_of_lane == 1) ? rstd[1] : (r_of_lane == 2) ? rstd[2] : rstd[3];
                        statsp[2 * rowl] = mr; statsp[2 * rowl + 1] = rr; }
                }
            }
        }
        __syncthreads();
        if (BOTH(0) || rep_ + 1 < REP_0) GRID_BAR();
    }
    PSTAMP(0);

    if (IN(1)) REPLOOP(1) {
        pg8::Gemm g{Hb, WinT, DM, DM, NZP / 256, nullptr, nullptr, 0};
        pg8::StaticOrder S; S.init(MROWS / 256, NZP / 256, G, blk);
        pg8::EpiZ E{Z, Qc, Kc, Vc, ropec, ropes, GFb};
        pg8::gemm_phase<0, pg8::EpiZ>(L, g, S, E);
        if (BOTH(1) || rep_ + 1 < REP_1) GRID_BAR();
    }
    PSTAMP(1);

    if (IN(2)) {
        REPLOOP(2B) {
            constexpr int PQ = 136;
            LAS bf16_t* Qs = (LAS bf16_t*)L;
            LAS bf16_t* Ks = Qs + 128 * PQ;
            LAS bf16_t* VTs = Ks + 128 * PQ;
            LAS bf16_t* Cs = VTs + 144 * PQ;
            LAS float* fv = (LAS float*)(Cs + 144 * PQ);
            LAS float* v_a = fv;
            LAS float* v_M = fv + 128;
            LAS float* v_b = fv + 256;
            LAS float* v_w = fv + 384;
            LAS float* v_sc = fv + 512;
            LAS float* cw = fv + 528;
            const float* convw = PF(5); const float* convb = PF(6); const float* mlg = PF(13); const float* gatesp = gates;
            bf16_t* Zp = Z; bf16_t* YCp = YCb;
            for (int u = blk; u < NB * 4; u += G) {
                const int b = u >> 2, h = u & 3;
                __syncthreads();
                for (int i = tid; i < 5 * 256; i += 512) { const int j = i >> 8, c = i & 255; const int ch = (c < 128) ? (h * 128 + c) : (512 + h * 128 + (c - 128));
                    cw[i] = (j < 4) ? convw[j * 1024 + ch] : convb[ch]; }
                for (int i = tid; i < 144 * PQ; i += 512) { const int rr = i / PQ; VTs[i] = (rr == 128) ? (bf16_t)0x3f80 : (bf16_t)0; Cs[i] = 0; }
                if (tid == 0) v_sc[0] = 0.f;
                f32x4 Cst[9];
#pragma unroll
                for (int jt = 0; jt < 9; ++jt) Cst[jt] = (f32x4){0.f, 0.f, 0.f, 0.f};
                LAS float* gml_s = cw + 1280 + 384;
                int tid_o = tid; asm volatile("" : "+v"(tid_o));
#define ML_IDX() int tq_ = tid_o; asm volatile("" : "+v"(tq_)); const int dg = tq_ & 15, s0 = (tq_ >> 4) * 4, fr = tq_ & 15, quad = (tq_ >> 4) & 3; (void)dg; (void)s0; (void)fr; (void)quad;
                LAS bf16_t* halo = (LAS bf16_t*)(cw + 1280);
                for (int i = tid_o; i < 2 * 3 * 128; i += 512) halo[i] = 0;
                if (tid_o < 128) gml_s[tid_o] = mlg[h * 128 + tid_o];
                u32x4 rq[4], rk[4], rv[4]; float gx0 = 0.f, gx1 = 0.f, gi0 = -1e30f, gi1 = -1e30f;
#define ML_LBAR() asm volatile("s_waitcnt lgkmcnt(0)\n\ts_barrier" ::: "memory")
#define ML_LOADRAW(tc0) do { \
                    _Pragma("unroll") for (int i_ = 0; i_ < 4; ++i_) { const int t_ = (tc0) + s0 + i_; rq[i_] = (u32x4){0u, 0u, 0u, 0u}; rk[i_] = rq[i_]; rv[i_] = rq[i_]; \
                        if (t_ < TT) { const bf16_t* zr_ = Zp + (size_t)row_of(b, t_) * NZ + h * 128 + dg * 8; rq[i_] = *(const u32x4*)(zr_ + ZMQ); rk[i_] = *(const u32x4*)(zr_ + ZMK); rv[i_] = *(const u32x4*)(zr_ + ZMV); } } \
                    if (wave == 0) { const int ta_ = (tc0) + 2 * lane, tb_ = ta_ + 1; \
                        gx0 = (ta_ < TT) ? ld_agent_f(gatesp + (size_t)row_of(b, ta_) * 8 + 4 + h) : 0.f; gi0 = (ta_ < TT) ? ld_agent_f(gatesp + (size_t)row_of(b, ta_) * 8 + h) : -1e30f; \
                        gx1 = (tb_ < TT) ? ld_agent_f(gatesp + (size_t)row_of(b, tb_) * 8 + 4 + h) : 0.f; gi1 = (tb_ < TT) ? ld_agent_f(gatesp + (size_t)row_of(b, tb_) * 8 + h) : -1e30f; } } while (0)
                { ML_IDX(); ML_LOADRAW(0); }
                for (int c = 0; c < 33; ++c) {
                    const int t0 = c * 128;
                    ML_LBAR(); CSTAMP(0);
                    if (wave == 0) {
                        const float m_old0 = v_sc[0];
                        const float x0 = gx0, x1 = gx1, i0 = gi0, i1 = gi1;
                        const float sacc = wave_scan_add(x0 + x1);
                        const float ex = sacc - (x0 + x1);
                        const float b0 = ex + x0, b1 = b0 + x1;
                        const float a0 = i0 - b0, a1 = i1 - b1;
                        const float mx = wave_scan_max(fmaxf(a0, a1));
                        float exm = __shfl_up(mx, 1); if (lane == 0) exm = -INFINITY;
                        const float M0 = fmaxf(fmaxf(m_old0, exm), a0), M1 = fmaxf(M0, a1);
                        const float Ml = __shfl(M1, 63);
                        v_b[2 * lane] = b0; v_b[2 * lane + 1] = b1; v_a[2 * lane] = a0; v_a[2 * lane + 1] = a1; v_M[2 * lane] = M0; v_M[2 * lane + 1] = M1;
                        v_w[2 * lane] = (t0 + 2 * lane < TT) ? __expf(a0 - Ml) : 0.f; v_w[2 * lane + 1] = (t0 + 2 * lane + 1 < TT) ? __expf(a1 - Ml) : 0.f;
                        if (lane == 63) v_sc[1] = M1;
                    }
                    { ML_IDX();
#pragma unroll
                    for (int i = 0; i < 4; ++i) { *(LAS u32x4*)(Qs + (s0 + i) * PQ + dg * 8) = rq[i]; *(LAS u32x4*)(Ks + (s0 + i) * PQ + dg * 8) = rk[i]; }
#pragma unroll
                    for (int w2 = 0; w2 < 4; ++w2) {
                        const unsigned a0_ = rv[0][w2], a1_ = rv[1][w2], a2_ = rv[2][w2], a3_ = rv[3][w2];
                        u32x2 lo2, hi2; lo2.x = (a0_ & 0xffffu) | (a1_ << 16); lo2.y = (a2_ & 0xffffu) | (a3_ << 16);
                        hi2.x = (a0_ >> 16) | (a1_ & 0xffff0000u); hi2.y = (a2_ >> 16) | (a3_ & 0xffff0000u);
                        *(LAS u32x2*)(VTs + (dg * 8 + 2 * w2) * PQ + s0) = lo2; *(LAS u32x2*)(VTs + (dg * 8 + 2 * w2 + 1) * PQ + s0) = hi2;
                    } }
                    ML_LBAR(); CSTAMP(1);
                    {   ML_IDX();
                        u32x4 hq[3], hk[3];
#pragma unroll
                        for (int i = 0; i < 3; ++i) {
                            if (s0 > 0) { hq[i] = *(const LAS u32x4*)(Qs + (s0 - 3 + i) * PQ + dg * 8); hk[i] = *(const LAS u32x4*)(Ks + (s0 - 3 + i) * PQ + dg * 8); }
                            else { hq[i] = *(const LAS u32x4*)(halo + i * 128 + dg * 8); hk[i] = *(const LAS u32x4*)(halo + 384 + i * 128 + dg * 8); }
                        }
                        asm volatile("s_waitcnt lgkmcnt(0)" ::: "memory");
                        ML_LBAR(); CSTAMP(2);
                        u32x4 cq[4], ck[4];
#pragma unroll
                        for (int w2 = 0; w2 < 4; ++w2) {
                            int dgo = dg; asm volatile("" : "+v"(dgo));
                            f32x2 xq[7], xk[7];
#pragma unroll
                            for (int r = 0; r < 7; ++r) { const unsigned uq = (r < 3) ? hq[r < 3 ? r : 0][w2] : rq[r >= 3 ? r - 3 : 0][w2], uk = (r < 3) ? hk[r < 3 ? r : 0][w2] : rk[r >= 3 ? r - 3 : 0][w2];
                                xq[r] = (f32x2){bflo(uq), bfhi(uq)}; xk[r] = (f32x2){bflo(uk), bfhi(uk)}; }
                            const LAS f32x2* wp = (const LAS f32x2*)(cw + dgo * 8 + 2 * w2);
                            f32x2 wq[4], wk[4];
#pragma unroll
                            for (int j = 0; j < 4; ++j) { wq[j] = wp[j * 128]; wk[j] = wp[j * 128 + 64]; }
                            const f32x2 bq = wp[4 * 128], bk = wp[4 * 128 + 64];
#pragma unroll
                            for (int i = 0; i < 4; ++i) {
                                f32x2 aq = bq, ak = bk;
#pragma unroll
                                for (int j = 0; j < 4; ++j) { aq += wq[j] * xq[i + j]; ak += wk[j] * xk[i + j]; }
                                const bool live = (t0 + s0 + i < TT);
                                const float q0 = live ? aq[0] * sigmoidf_(aq[0]) : 0.f, q1 = live ? aq[1] * sigmoidf_(aq[1]) : 0.f;
                                const float k0 = live ? ak[0] * sigmoidf_(ak[0]) * 0.08838834764831845f : 0.f, k1 = live ? ak[1] * sigmoidf_(ak[1]) * 0.08838834764831845f : 0.f;
                                cq[i][w2] = pkbf(q0, q1); ck[i][w2] = pkbf(k0, k1);
                            }
                        }
#pragma unroll
                        for (int i = 0; i < 4; ++i) { *(LAS u32x4*)(Qs + (s0 + i) * PQ + dg * 8) = cq[i]; *(LAS u32x4*)(Ks + (s0 + i) * PQ + dg * 8) = ck[i]; }
                    if (s0 == 124) {
#pragma unroll
                        for (int i = 0; i < 3; ++i) { *(LAS u32x4*)(halo + i * 128 + dg * 8) = rq[i + 1]; *(LAS u32x4*)(halo + 384 + i * 128 + dg * 8) = rk[i + 1]; }
                    }
                    if (c + 1 < 33) ML_LOADRAW(t0 + 128);
                    }
                    ML_LBAR(); CSTAMP(3);
                    const float Mlast = v_sc[1], m_old = v_sc[0];
                    f32x4 St[8];
#pragma unroll
                    for (int j = 0; j < 8; ++j) St[j] = (f32x4){0.f, 0.f, 0.f, 0.f};
                    {   ML_IDX();
                        bf16x8 af[4];
#pragma unroll
                        for (int kk = 0; kk < 4; ++kk) af[kk] = *(const LAS bf16x8*)(Qs + (16 * wave + fr) * PQ + kk * 32 + quad * 8);
#pragma unroll
                        for (int j = 0; j < 8; ++j) if (j <= wave) {
#pragma unroll
                            for (int kk = 0; kk < 4; ++kk) { const bf16x8 bfv = *(const LAS bf16x8*)(Ks + (16 * j + fr) * PQ + kk * 32 + quad * 8);
                                St[j] = __builtin_amdgcn_mfma_f32_16x16x32_bf16(af[kk], bfv, St[j], 0, 0, 0); }
                        }
                    }
                    {   ML_IDX();
                        const float w_old = __expf(m_old - Mlast);
#pragma unroll
                        for (int jt = 0; jt < 9; ++jt) Cst[jt] = Cst[jt] * w_old;
#pragma unroll
                        for (int kk = 0; kk < 4; ++kk) {
                            const int rb = 32 * kk + 8 * quad;
                            const LAS bf16_t* kp = Ks + (rb + (fr >> 2)) * PQ + 16 * wave + 4 * (fr & 3);
                            const attn_body::s16x4 lo = attn_body::vtr((attn_body::lds_cptr)kp), hi4 = attn_body::vtr((attn_body::lds_cptr)(kp + 4 * PQ));
                            const f32x4 w0 = *(const LAS f32x4*)(v_w + rb), w1 = *(const LAS f32x4*)(v_w + rb + 4);
                            float kf[8];
#pragma unroll
                            for (int q = 0; q < 4; ++q) { kf[q] = __uint_as_float(((unsigned)(unsigned short)lo[q]) << 16) * w0[q]; kf[4 + q] = __uint_as_float(((unsigned)(unsigned short)hi4[q]) << 16) * w1[q]; }
                            u32x4 kw; kw.x = pkbf(kf[0], kf[1]); kw.y = pkbf(kf[2], kf[3]); kw.z = pkbf(kf[4], kf[5]); kw.w = pkbf(kf[6], kf[7]);
                            const bf16x8 bk = __builtin_bit_cast(bf16x8, kw);
#pragma unroll
                            for (int jt = 0; jt < 9; ++jt) { const bf16x8 av = *(const LAS bf16x8*)(VTs + (16 * jt + fr) * PQ + kk * 32 + quad * 8);
                                Cst[jt] = __builtin_amdgcn_mfma_f32_16x16x32_bf16(av, bk, Cst[jt], 0, 0, 0); }
                        }
                    }
                    ML_LBAR(); CSTAMP(4);
                    {   ML_IDX();
                        float Ms[4];
#pragma unroll
                        for (int jj = 0; jj < 4; ++jj) Ms[jj] = v_M[16 * wave + 4 * quad + jj];
#pragma unroll
                        for (int j = 0; j < 8; ++j) {
                            const int r = 16 * j + fr; const float ar = v_a[r];
#pragma unroll
                            for (int jj = 0; jj < 4; ++jj) { const int sx = 16 * wave + 4 * quad + jj;
                                const float w = (j <= wave && r <= sx) ? St[j][jj] * __expf(ar - Ms[jj]) : 0.f;
                                Ks[sx * PQ + r] = (bf16_t)(pkbf(w, 0.f) & 0xffffu); }
                        }
                    }
                    ML_LBAR(); CSTAMP(5);
                    float hv[8][4];
                    {   ML_IDX();
                        bf16x8 af[4], as_[4];
#pragma unroll
                        for (int kk = 0; kk < 4; ++kk) { af[kk] = *(const LAS bf16x8*)(Qs + (16 * wave + fr) * PQ + kk * 32 + quad * 8); as_[kk] = *(const LAS bf16x8*)(Ks + (16 * wave + fr) * PQ + kk * 32 + quad * 8); }
                        float winter[4], rd[4], ssq[4];
                        {   f32x4 n1 = (f32x4){0.f, 0.f, 0.f, 0.f}, n2 = n1;
#pragma unroll
                            for (int kk = 0; kk < 4; ++kk) { const bf16x8 bc = *(const LAS bf16x8*)(Cs + (128 + fr) * PQ + kk * 32 + quad * 8); const bf16x8 bvv = *(const LAS bf16x8*)(VTs + (128 + fr) * PQ + kk * 32 + quad * 8);
                                n1 = __builtin_amdgcn_mfma_f32_16x16x32_bf16(af[kk], bc, n1, 0, 0, 0); n2 = __builtin_amdgcn_mfma_f32_16x16x32_bf16(as_[kk], bvv, n2, 0, 0, 0); }
#pragma unroll
                            for (int jj = 0; jj < 4; ++jj) { const int sx = 16 * wave + 4 * quad + jj; const float Ms = v_M[sx]; winter[jj] = __expf(m_old - Ms);
                                float den = winter[jj] * n1[jj] + n2[jj];
                                den = __shfl(den, lane & 48);
                                rd[jj] = 1.0f / fmaxf(fabsf(den), __expf(-(v_b[sx] + Ms))); ssq[jj] = 0.f; }
                        }
#pragma unroll
                        for (int g2 = 0; g2 < 2; ++g2) {
                            f32x4 n1[4], n2[4];
#pragma unroll
                            for (int q = 0; q < 4; ++q) { n1[q] = (f32x4){0.f, 0.f, 0.f, 0.f}; n2[q] = n1[q]; }
#pragma unroll
                            for (int kk = 0; kk < 4; ++kk)
#pragma unroll
                                for (int q = 0; q < 4; ++q) { const int jt = 4 * g2 + q;
                                    const bf16x8 bc = *(const LAS bf16x8*)(Cs + (16 * jt + fr) * PQ + kk * 32 + quad * 8); const bf16x8 bvv = *(const LAS bf16x8*)(VTs + (16 * jt + fr) * PQ + kk * 32 + quad * 8);
                                    n1[q] = __builtin_amdgcn_mfma_f32_16x16x32_bf16(af[kk], bc, n1[q], 0, 0, 0); n2[q] = __builtin_amdgcn_mfma_f32_16x16x32_bf16(as_[kk], bvv, n2[q], 0, 0, 0); }
#pragma unroll
                            for (int q = 0; q < 4; ++q)
#pragma unroll
                                for (int jj = 0; jj < 4; ++jj) { const float x = (winter[jj] * n1[q][jj] + n2[q][jj]) * rd[jj]; hv[4 * g2 + q][jj] = x; ssq[jj] += x * x; }
                        }
#pragma unroll
                        for (int jj = 0; jj < 4; ++jj) { const float rs = 1.0f / sqrtf(row_sum16(ssq[jj]) * (1.f / 128.f) + LN_EPS);
#pragma unroll
                            for (int jt = 0; jt < 8; ++jt) hv[jt][jj] *= rs * gml_s[16 * jt + fr]; }
                    }
                    ML_LBAR(); CSTAMP(6);
                    u32x4 rmo[4];
                    { ML_IDX();
#pragma unroll
                    for (int i = 0; i < 4; ++i) { const int t = t0 + s0 + i; rmo[i] = (u32x4){0u, 0u, 0u, 0u};
                        if (t >= NMETA && t < TT) rmo[i] = *(const u32x4*)(Zp + (size_t)row_of(b, t) * NZ + ZMO + h * 128 + dg * 8); }
#pragma unroll
                    for (int jt = 0; jt < 8; ++jt)
#pragma unroll
                        for (int jj = 0; jj < 4; ++jj) Qs[(16 * wave + 4 * quad + jj) * PQ + 16 * jt + fr] = (bf16_t)(pkbf(hv[jt][jj], 0.f) & 0xffffu);
#pragma unroll
                    for (int jt = 0; jt < 9; ++jt)
#pragma unroll
                        for (int jj = 0; jj < 4; ++jj) Cs[(16 * jt + 4 * quad + jj) * PQ + 16 * wave + fr] = (bf16_t)(pkbf(Cst[jt][jj], 0.f) & 0xffffu);
                    if (tid == 0) v_sc[0] = v_b[127] + Mlast;
                    }
                    ML_LBAR(); CSTAMP(7);
                    { ML_IDX();
#pragma unroll
                    for (int i = 0; i < 4; ++i) {
                        const int s = s0 + i, t = t0 + s;
                        if (t >= NMETA && t < TT) {
                            const u32x4 hw = *(const LAS u32x4*)(Qs + s * PQ + dg * 8);
                            const u32x4 mw = rmo[i];
                            u32x4 wy;
                            wy.x = pkbf(sigmoidf_(bflo(mw.x)) * bflo(hw.x), sigmoidf_(bfhi(mw.x)) * bfhi(hw.x)); wy.y = pkbf(sigmoidf_(bflo(mw.y)) * bflo(hw.y), sigmoidf_(bfhi(mw.y)) * bfhi(hw.y));
                            wy.z = pkbf(sigmoidf_(bflo(mw.z)) * bflo(hw.z), sigmoidf_(bfhi(mw.z)) * bfhi(hw.z)); wy.w = pkbf(sigmoidf_(bflo(mw.w)) * bflo(hw.w), sigmoidf_(bfhi(mw.w)) * bfhi(hw.w));
                            *(u32x4*)(YCp + (size_t)row_of(b, t) * DM + 512 + h * 128 + dg * 8) = wy;
                        }
                    } }
                }
            }
        }
#undef ML_LOADRAW
#undef ML_LBAR
#undef ML_IDX
        PSTAMP(13);
        __syncthreads();
        REPLOOP(2A) {
            LAS int* tkt = (LAS int*)(L + MISC_OFF + 16);
            bf16_t* Qcp = Qc; bf16_t* Kcp = Kc; bf16_t* Vcp = Vc; bf16_t* YCp2 = YCb; unsigned* tctr = ctl + CW_TICKET + 64 * rep_;
            const float* attg = PF(12); unsigned char* parkb = WSP + WS_O;
            float lam;
            { const float p1 = wave_sum(PF(8)[lane] * PF(9)[lane]), p2 = wave_sum(PF(10)[lane] * PF(11)[lane]); lam = expf(p1) - expf(p2) + LAMBDA_INIT; }
            const float* wgu = PF(21); const float* wdn = PF(23); bf16_t* WguTp = WguT; bf16_t* WdnTp = WdnT;
            constexpr int NATT = NB * 4 * 16, NJOB = NE * 16;
            int nextT = 0;
            if (tid == 0) nextT = (int)__hip_atomic_fetch_add(tctr, 1u, RLX_AGENT);
            for (;;) {
                __syncthreads();
                if (tid == 0) { *tkt = nextT; nextT = (int)__hip_atomic_fetch_add(tctr, 1u, RLX_AGENT); }
                __syncthreads();
                const int T = __builtin_amdgcn_readfirstlane(*tkt);
                if (T >= NATT + NJOB) break;
                int Lidx;
                { const int q = T / 3, r = T - q * 3;
                  if (q < NJOB) {
                      if (r == 2) {
                          const int e = q >> 4, kb = q & 15; LAS unsigned char* scr = L + wave * 17408;
                          for (int it = wave; it < 48; it += NWAVES) {
                              if (it < 32) transpose_tile64_fp8(wgu + (size_t)e * 1024 * 2048, 2048, (unsigned char*)WguTp + (size_t)e * 2048 * 1024, 1024, scr, 64 * kb, 64 * it, lane, InvGu(), FP8_SB1);
                              else transpose_tile64_fp8(wdn + (size_t)e * 1024 * 1024, 1024, (unsigned char*)WdnTp + (size_t)e * 1024 * 1024, 1024, scr, 64 * kb, 64 * (it - 32), lane, InvIdent(), FP8_SB2);
                          }
                          continue;
                      }
                      Lidx = q * 2 + r;
                  } else Lidx = T - NJOB; }
                const int bh = Lidx & 63, qb = 15 - (Lidx >> 6);
                const int b = bh >> 2, h = bh & 3;
                int tid_p = tid; asm volatile("" : "+v"(tid_p));
                u32x4* parkp = (u32x4*)parkb + ((size_t)blk * 512 + tid_p) * 8;
                attn_body::attn4_unit<8>(qb, (const attn_body::bf16*)(Qcp + (size_t)(b * 8 + 2 * h) * TT * 64), (const attn_body::bf16*)(Kcp + (size_t)(b * 8 + 2 * h) * TT * 64), (long)TT * 64,
                                         (const attn_body::bf16*)(Vcp + (size_t)(b * 4 + h) * TT * 128), YCp2, b * SEQ, h * 128, lam, attg, parkp, (char*)lds);
            }
        }
        __syncthreads();
        if (BOTH(2)) GRID_BAR();
    }
    PSTAMP(2);

    PSTAMP(3);

    if (IN(4)) REPLOOP(4) {
        {   pg8::Gemm g{YCb, WaT, DM, 1024, 4, nullptr, nullptr, 0};
            pg8::StaticOrder S; S.init(NREAL / 256, 4, G, blk);
            pg8::EpiGateFused E{GFb, MRGb};
            pg8::gemm_phase<0, pg8::EpiGateFused, true>(L, g, S, E); }
        if (BOTH(4) || rep_ + 1 < REP_4) GRID_BAR();
    }
    PSTAMP(4);

    if (IN(5)) REPLOOP(5) {
        pg8::Gemm g{MRGb, WoT, DM, 1024, 4, nullptr, nullptr, 0};
        pg8::StaticOrder S; S.init(NREAL / 256, 4, G, blk);
        pg8::EpiStoreBf16 E{TMPb, DM};
        pg8::gemm_phase<0, pg8::EpiStoreBf16>(L, g, S, E);
        if (BOTH(5) || rep_ + 1 < REP_5) GRID_BAR();
    }
    PSTAMP(5);

    constexpr int NPART = 256, RPP = NREAL / NPART;
    static_assert(NPART * RPP == NREAL, "partitions");
    if (IN(6)) REPLOOP(6) {
        LAS float* wrT = (LAS float*)L;
        LAS int* hcnt = (LAS int*)(L + 131072);
        { const float* wr = PF(19);
          for (int i = tid; i < 8 * 1024; i += 512) { const int k = i & 1023, q4 = i >> 10; const f32x4 v = *(const f32x4*)(wr + k * 32 + 4 * q4);
              wrT[(4 * q4 + 0) * 1024 + k] = v[0]; wrT[(4 * q4 + 1) * 1024 + k] = v[1]; wrT[(4 * q4 + 2) * 1024 + k] = v[2]; wrT[(4 * q4 + 3) * 1024 + k] = v[3]; } }
        const float* xin = PF(0); const float* g0p = PF(2); const float* b0p = PF(3); const float* statsp = stats; const bf16_t* mixp = TMPb;
        const float* g1p = PF(17); const float* b1p = PF(18);
        const float brt = PF(20)[(lane >> 1) & 31];
        bf16_t* Hbp = Hb; int* tokE = tok_e; float* tokG = tok_g; int* histp = hist; unsigned char* H8p = WSP + WS_H8;
        for (int part = blk; part < NPART; part += G) {
            __syncthreads();
            if (tid < 32) hcnt[tid] = 0;
            __syncthreads();
            const int rbeg = part * RPP, rend = rbeg + RPP;
            constexpr int RPW = (RPP + NWAVES - 1) / NWAVES;
            const int wbeg = rbeg + wave * RPW, wend = (wbeg + RPW < rend) ? wbeg + RPW : rend;
            for (int row = wbeg; row < wend; row += 2) {
                int lane_o = lane; asm volatile("" : "+v"(lane_o));
                const bool two = (row + 1 < wend);
                const int row1 = two ? row + 1 : row;
                const float m0_ = ld_agent_f(statsp + 2 * row), r0_ = ld_agent_f(statsp + 2 * row + 1), m1_ = ld_agent_f(statsp + 2 * row1), r1_ = ld_agent_f(statsp + 2 * row1 + 1);
                f32x4 v0[4], v1[4]; float s0 = 0.f, s1 = 0.f;
#pragma unroll
                for (int j = 0; j < 4; ++j) { v0[j] = *(const f32x4*)(xin + (size_t)row * DM + 4 * lane_o + 256 * j); v1[j] = *(const f32x4*)(xin + (size_t)row1 * DM + 4 * lane_o + 256 * j); }
#pragma unroll
                for (int j = 0; j < 4; ++j) {
                    const u32x2 x0 = *(const u32x2*)(mixp + (size_t)row * DM + 4 * lane_o + 256 * j), x1 = *(const u32x2*)(mixp + (size_t)row1 * DM + 4 * lane_o + 256 * j);
                    const f32x4 g0v = *(const f32x4*)(g0p + 4 * lane_o + 256 * j), b0v = *(const f32x4*)(b0p + 4 * lane_o + 256 * j);
                    v0[j] = ((v0[j] - m0_) * r0_ * g0v + b0v) * DN_ALPHA + (f32x4){bflo(x0.x), bfhi(x0.x), bflo(x0.y), bfhi(x0.y)};
                    v1[j] = ((v1[j] - m1_) * r1_ * g0v + b0v) * DN_ALPHA + (f32x4){bflo(x1.x), bfhi(x1.x), bflo(x1.y), bfhi(x1.y)};
                }
#pragma unroll
                for (int j = 0; j < 4; ++j) { s0 += (v0[j][0] + v0[j][1]) + (v0[j][2] + v0[j][3]); s1 += (v1[j][0] + v1[j][1]) + (v1[j][2] + v1[j][3]); }
                const float mean0 = wave_sum(s0) * (1.f / DM), mean1 = wave_sum(s1) * (1.f / DM); float q0 = 0.f, q1 = 0.f;
#pragma unroll
                for (int j = 0; j < 4; ++j) { const f32x4 d0 = v0[j] - mean0, d1 = v1[j] - mean1;
                    q0 += (d0[0] * d0[0] + d0[1] * d0[1]) + (d0[2] * d0[2] + d0[3] * d0[3]); q1 += (d1[0] * d1[0] + d1[1] * d1[1]) + (d1[2] * d1[2] + d1[3] * d1[3]); }
                const float rstd0 = 1.0f / sqrtf(wave_sum(q0) * (1.f / DM) + LN_EPS), rstd1 = 1.0f / sqrtf(wave_sum(q1) * (1.f / DM) + LN_EPS);
#pragma unroll
                for (int j = 0; j < 4; ++j) {
                    const f32x4 ggj = *(const f32x4*)(g1p + 4 * lane_o + 256 * j), bbj = *(const f32x4*)(b1p + 4 * lane_o + 256 * j);
                    v0[j] = (v0[j] - mean0) * rstd0 * ggj + bbj; v1[j] = (v1[j] - mean1) * rstd1 * ggj + bbj;
                    u32x2 w; w.x = pkbf(v0[j][0], v0[j][1]); w.y = pkbf(v0[j][2], v0[j][3]);
                    *(u32x2*)(Hbp + (size_t)row * DM + 4 * lane_o + 256 * j) = w;
                    *(unsigned*)(H8p + (size_t)row * DM + 4 * lane_o + 256 * j) = pkfp8x4(v0[j][0] * FP8_SA1, v0[j][1] * FP8_SA1, v0[j][2] * FP8_SA1, v0[j][3] * FP8_SA1);
                    if (two) { w.x = pkbf(v1[j][0], v1[j][1]); w.y = pkbf(v1[j][2], v1[j][3]); *(u32x2*)(Hbp + (size_t)row1 * DM + 4 * lane_o + 256 * j) = w;
                        *(unsigned*)(H8p + (size_t)row1 * DM + 4 * lane_o + 256 * j) = pkfp8x4(v1[j][0] * FP8_SA1, v1[j][1] * FP8_SA1, v1[j][2] * FP8_SA1, v1[j][3] * FP8_SA1); }
                }
                float p0[32], p1[32];
#pragma unroll
                for (int e = 0; e < 32; ++e) {
                    f32x2 a0 = (f32x2){0.f, 0.f}, a1 = a0;
#pragma unroll
                    for (int j = 0; j < 4; ++j) { const f32x4 wv = *(const LAS f32x4*)(wrT + e * 1024 + 4 * lane_o + 256 * j);
                        const f32x2 wl = (f32x2){wv[0], wv[1]}, wh = (f32x2){wv[2], wv[3]};
                        a0 += (f32x2){v0[j][0], v0[j][1]} * wl; a0 += (f32x2){v0[j][2], v0[j][3]} * wh;
                        a1 += (f32x2){v1[j][0], v1[j][1]} * wl; a1 += (f32x2){v1[j][2], v1[j][3]} * wh; }
                    p0[e] = a0[0] + a0[1]; p1[e] = a1[0] + a1[1];
                    if ((e & 3) == 3) __builtin_amdgcn_sched_barrier(0);
                }
                float lg0 = xreduce32(p0, lane_o) + brt, lg1 = xreduce32(p1, lane_o) + brt;
#pragma unroll
                for (int rr = 0; rr < 2; ++rr) {
                    float lg = rr ? lg1 : lg0; const int rw = rr ? row1 : row;
                    float tv[4]; int ti[4];
#pragma unroll
                    for (int k = 0; k < 4; ++k) {
                        const float mx = wave_max(lg);
                        const unsigned long long bal = __ballot(lg == mx);
                        const int idx = (__ffsll((long long)bal) - 1) >> 1;
                        tv[k] = mx; ti[k] = idx;
                        if ((lane_o >> 1) == idx) lg = -INFINITY;
                    }
                    const float e1 = __expf(tv[1] - tv[0]), e2 = __expf(tv[2] - tv[0]), e3 = __expf(tv[3] - tv[0]);
                    const float inv = 1.0f / (1.0f + e1 + e2 + e3);
                    if (lane_o < 4 && (rr == 0 || two)) {
                        const int idx = (lane_o == 0) ? ti[0] : (lane_o == 1) ? ti[1] : (lane_o == 2) ? ti[2] : ti[3];
                        const float gv = ((lane_o == 0) ? 1.0f : (lane_o == 1) ? e1 : (lane_o == 2) ? e2 : e3) * inv;
                        tokE[(size_t)rw * 4 + lane_o] = idx; tokG[(size_t)rw * 4 + lane_o] = gv;
                        atomicAdd((int*)&hcnt[idx], 1);
                    }
                }
            }
            __syncthreads();
            if (tid < 32) histp[part * 32 + tid] = hcnt[tid];
        }
        if (BOTH(6) || rep_ + 1 < REP_6) GRID_BAR();
    }
    PSTAMP(6);

    if (IN(7)) REPLOOP(7) {
        LAS int* cnt_s = (LAS int*)L; LAS int* base_s = cnt_s + 32; LAS int* pst_s = cnt_s + 64;
        LAS int* ptot = cnt_s + 128; LAS int* pbase = ptot + 512;
        LAS int* ccnt = pbase + 512;
        LAS int* ent = ccnt + 1024; LAS int* lrank = ent + RPP * 4 + 64;
        int* rowOff = row_off; int* rowSlot = row_slot; float* rowGate = row_gate; const int* histp = hist; const int* tokE = tok_e; const float* tokG = tok_g;
        for (int part = blk; part < NPART; part += G) {
            __syncthreads();
            { const int e = tid & 31, q = tid >> 5; int tot = 0, bs = 0;
#pragma unroll 4
              for (int b2 = q * 16; b2 < q * 16 + 16; ++b2) { const int v = ld_agent_i(histp + b2 * 32 + e); tot += v; bs += (b2 < part) ? v : 0; }
              ptot[q * 32 + e] = tot; pbase[q * 32 + e] = bs; }
            const int rbeg = part * RPP, n4 = RPP * 4;
            for (int i = tid; i < n4; i += 512) ent[i] = ld_agent_i(tokE + (size_t)rbeg * 4 + i);
            __syncthreads();
            if (tid < 32) { int tot = 0, bs = 0;
#pragma unroll
                for (int q = 0; q < 16; ++q) { tot += ptot[q * 32 + tid]; bs += pbase[q * 32 + tid]; }
                cnt_s[tid] = tot; base_s[tid] = bs; }
            constexpr int NCH = (RPP * 4 + 63) / 64;
            for (int c = wave; c < NCH; c += NWAVES) {
                const int i = 64 * c + lane; const int my = (i < n4) ? ent[i] : -1; int lr = 0;
#pragma unroll 4
                for (int e = 0; e < 32; ++e) { const unsigned long long b = __ballot(my == e);
                    if (lane == e) ccnt[c * 32 + e] = __popcll(b);
                    if (my == e) lr = __popcll(b & ((1ull << lane) - 1ull)); }
                if (i < n4) lrank[i] = lr;
            }
            __syncthreads();
            if (tid == 0) { int p = 0; for (int e = 0; e < 32; ++e) { pst_s[e] = p; p += (cnt_s[e] + 255) & ~255; } pst_s[32] = p; }
            __syncthreads();
            if (tid < 32) { int run = pst_s[tid] + base_s[tid];
                for (int c = 0; c < NCH; ++c) { const int tmp = ccnt[c * 32 + tid]; ccnt[c * 32 + tid] = run; run += tmp; } }
            __syncthreads();
            for (int i = tid; i < n4; i += 512) { const int e = ent[i]; const int pos = ccnt[(i >> 6) * 32 + e] + lrank[i];
                rowOff[pos] = (rbeg + (i >> 2)) * DM;        rowSlot[pos] = rbeg * 4 + i; rowGate[pos] = ld_agent_f(tokG + (size_t)rbeg * 4 + i); }
            if (part < 32) { const int e = part; for (int r = pst_s[e] + cnt_s[e] + tid; r < pst_s[e + 1]; r += 512) { rowOff[r] = 0; rowSlot[r] = NREAL * 4; rowGate[r] = 0.f; } }
            if (part == 0) { const int nT = pst_s[32] >> 8; int* te = tile_exp;
                for (int t = tid; t < nT; t += 512) { int e = 0; while (e < 31 && t * 256 >= pst_s[e + 1]) ++e; te[t] = e; }
                if (tid == 0) __hip_atomic_store((int*)(ctl + CW_NT), nT, RLX_AGENT); }
        }
        __syncthreads();
        if (BOTH(7) || rep_ + 1 < REP_7) GRID_BAR();
    }
    PSTAMP(7);

    {
        int nT = 0, TPC = 0;
        if (lo < 12 && hi > 8) { nT = __builtin_amdgcn_readfirstlane(ld_agent_i((const int*)(ctl + CW_NT))); TPC = (nT > 512) ? 512 : nT; }
        if (IN(8)) REPLOOP(8) {
            pg8::Gemm g{(const bf16_t*)(WSP + WS_H8), WguT, DM, DM / 2, 8, row_off, tile_exp, 0};
            pg8::StaticOrder S; S.init(TPC, 8, G, blk);
            pg8::EpiAct E{ACT, PF(22), tile_exp, 0, 1.0f / (FP8_SA1 * FP8_SB1)};
            pg8::gemm_phase<1, pg8::EpiAct, false, true>(L, g, S, E);
            if (BOTH(8) || rep_ + 1 < REP_8) GRID_BAR();
        }
        PSTAMP(8);
        if (IN(9)) REPLOOP(9) {
            pg8::Gemm g{ACT, WdnT, FF / 2, FF / 2, 4, nullptr, tile_exp, 0};
            pg8::StaticOrder S; S.init(TPC, 4, G, blk);
            pg8::EpiDown E{Y, PF(24), tile_exp, row_slot, row_gate, 0, 1.0f / (FP8_SA2 * FP8_SB2)};
            pg8::gemm_phase<2, pg8::EpiDown, false, true>(L, g, S, E);
            if (BOTH(9) || rep_ + 1 < REP_9) GRID_BAR();
        }
        PSTAMP(9);
        if (IN(10)) REPLOOP(10) {
            pg8::Gemm g{(const bf16_t*)(WSP + WS_H8), WguT, DM, DM / 2, 8, row_off, tile_exp, TPC};
            pg8::StaticOrder S; S.init(nT - TPC, 8, G, blk);
            pg8::EpiAct E{ACT, PF(22), tile_exp, TPC, 1.0f / (FP8_SA1 * FP8_SB1)};
            pg8::gemm_phase<1, pg8::EpiAct, false, true>(L, g, S, E);
            if (BOTH(10) || rep_ + 1 < REP_10) GRID_BAR();
        }
        PSTAMP(10);
        if (IN(11)) REPLOOP(11) {
            pg8::Gemm g{ACT, WdnT, FF / 2, FF / 2, 4, nullptr, tile_exp, TPC};
            pg8::StaticOrder S; S.init(nT - TPC, 4, G, blk);
            pg8::EpiDown E{Y, PF(24), tile_exp, row_slot, row_gate, TPC, 1.0f / (FP8_SA2 * FP8_SB2)};
            pg8::gemm_phase<2, pg8::EpiDown, false, true>(L, g, S, E);
            if (BOTH(11) || rep_ + 1 < REP_11) GRID_BAR();
        }
        PSTAMP(11);
    }

    if (IN(12)) REPLOOP(12) {
        for (int row = gw; row < NREAL; row += NGW) {
            f32x4 v[4]; float s = 0.f;
#pragma unroll
            for (int j = 0; j < 4; ++j) {
                const u32x2 hw = *(const u32x2*)(Hb + (size_t)row * DM + 4 * lane + 256 * j);
                f32x4 acc = (f32x4){bflo(hw.x), bfhi(hw.x), bflo(hw.y), bfhi(hw.y)} * DN_ALPHA;
#pragma unroll
                for (int k = 0; k < 4; ++k) { const u32x2 yw = *(const u32x2*)(Y + ((size_t)row * 4 + k) * DM + 4 * lane + 256 * j);
                    acc += (f32x4){bflo(yw.x), bfhi(yw.x), bflo(yw.y), bfhi(yw.y)}; }
                v[j] = acc; s += (acc[0] + acc[1]) + (acc[2] + acc[3]);
            }
            const float mean = wave_sum(s) * (1.f / DM); float s2 = 0.f;
#pragma unroll
            for (int j = 0; j < 4; ++j) { const f32x4 d = v[j] - mean; s2 += (d[0] * d[0] + d[1] * d[1]) + (d[2] * d[2] + d[3] * d[3]); }
            const float rstd = 1.0f / sqrtf(wave_sum(s2) * (1.f / DM) + LN_EPS);
            float* orow = (float*)DOUTP + (size_t)row * DM;
#pragma unroll
            for (int j = 0; j < 4; ++j) {
                const f32x4 gg = *(const f32x4*)(PF(25) + 4 * lane + 256 * j), bb = *(const f32x4*)(PF(26) + 4 * lane + 256 * j);
                *(f32x4*)(orow + 4 * lane + 256 * j) = (v[j] - mean) * rstd * gg + bb;
            }
        }
#if MK_PROBE == 2
        __syncthreads();
        PSTAMP(12);
        if (blk == 0 && tid == 0) pdur[14] = pdur[30] - pdur[29];
        if (blk == 0 && tid == 0) { asm volatile("s_waitcnt vmcnt(0)" ::: "memory"); ((float*)DOUTP)[0] += (float)pdur[MK_PROBE_K] * (0.01f / MK_PROBE_DIV); }
#elif MK_PROBE
        __syncthreads();
        if (blk == 0 && tid == 0) { const unsigned cyc = __hip_atomic_load(ctl + CW_PROBE, RLX_AGENT), st = __hip_atomic_load(ctl + CW_PROBE + 1, RLX_AGENT);
            asm volatile("s_waitcnt vmcnt(0)" ::: "memory"); ((float*)DOUTP)[0] += (float)cyc / (float)(st ? st : 1u); }
#endif
    }
#undef IN
#undef BOTH
#undef GRID_BAR
}

constexpr int N_PHASES = 13;
extern "C" void kernel_launch(void* const* d_in, const int* in_sizes, int n_in, void* d_out, int out_size, void* d_ws, size_t ws_size, hipStream_t stream) {
    static int grid = 0;
    if (grid == 0) {
        if (n_in != 27 || ws_size < WS_END) { fprintf(stderr, "kernel_launch: unexpected n_in %d / ws_size %zu\n", n_in, ws_size); grid = -1; return; }
        int dev = 0, cus = 0;
        if (hipGetDevice(&dev) != hipSuccess || hipDeviceGetAttribute(&cus, hipDeviceAttributeMultiprocessorCount, dev) != hipSuccess) { grid = -1; return; }
        if (hipFuncSetAttribute((const void*)hybrid_fwd, hipFuncAttributeMaxDynamicSharedMemorySize, LDS_BYTES) != hipSuccess) { fprintf(stderr, "kernel_launch: hipFuncSetAttribute failed\n"); grid = -1; return; }
        int per_cu = 0;
        (void)hipOccupancyMaxActiveBlocksPerMultiprocessor(&per_cu, (const void*)hybrid_fwd, NWAVES * 64, LDS_BYTES);
        (void)hipGetLastError();
        grid = cus > 0 ? cus : 256;
    }
    if (grid < 0) return;
    (void)hipMemsetAsync((char*)d_ws + WS_CTL, 0, CTL_ZERO_BYTES, stream);
    Args a{};
    const float** fp = (const float**)&a;
    for (int i = 0; i < 27; ++i) fp[i] = (const float*)d_in[i];
    a.out = (float*)d_out; a.ws = (unsigned char*)d_ws;
#if MK_PER_PHASE
    for (int p = 0; p < N_PHASES; ++p) { a.ph_lo = p; a.ph_hi = p + 1; hipLaunchKernelGGL(hybrid_fwd, dim3(grid), dim3(NWAVES * 64), LDS_BYTES, stream, a); }
#else
    a.ph_lo = 0; a.ph_hi = N_PHASES;
    hipLaunchKernelGGL(hybrid_fwd, dim3(grid), dim3(NWAVES * 64), LDS_BYTES, stream, a);
#endif
}
```

```cpp
#include <hip/hip_runtime.h>
#include <hip/hip_bf16.h>
#include <cstdio>
#include <cstdint>
#include <cmath>

#ifndef MK_PER_PHASE
#define MK_PER_PHASE 0
#endif

#ifndef REP_ALL
#define REP_ALL 1
#endif
#ifndef REP_0
#define REP_0 REP_ALL
#endif
#ifndef REP_1
#define REP_1 REP_ALL
#endif
#ifndef REP_2A
#define REP_2A REP_ALL
#endif
#ifndef REP_2B
#define REP_2B REP_ALL
#endif
#ifndef REP_3
#define REP_3 REP_ALL
#endif
#ifndef REP_4
#define REP_4 REP_ALL
#endif
#ifndef REP_5
#define REP_5 REP_ALL
#endif
#ifndef REP_6
#define REP_6 REP_ALL
#endif
#ifndef REP_7
#define REP_7 REP_ALL
#endif
#ifndef REP_8
#define REP_8 REP_ALL
#endif
#ifndef REP_9
#define REP_9 REP_ALL
#endif
#ifndef REP_10
#define REP_10 REP_ALL
#endif
#ifndef REP_11
#define REP_11 REP_ALL
#endif
#ifndef REP_12
#define REP_12 REP_ALL
#endif
#define REPLOOP(k) _Pragma("unroll 1") for (int rep_ = 0; rep_ < REP_##k; ++rep_)
#ifndef MK_PROBE
#define MK_PROBE 0
#endif
#ifndef MK_PROBE_K
#define MK_PROBE_K 2
#define MK_PROBE_DIV 10.0f
#endif
#define LAS __attribute__((address_space(3)))
#define GAS __attribute__((address_space(1)))
typedef unsigned short bf16_t;
typedef short bf16x8 __attribute__((ext_vector_type(8)));
typedef float f32x4 __attribute__((ext_vector_type(4)));
typedef float f32x2 __attribute__((ext_vector_type(2)));
typedef unsigned u32x4 __attribute__((ext_vector_type(4)));
typedef unsigned u32x2 __attribute__((ext_vector_type(2)));
typedef __bf16 bf16x2_t __attribute__((ext_vector_type(2)));
#define RLX_AGENT __ATOMIC_RELAXED, __HIP_MEMORY_SCOPE_AGENT

constexpr int NB = 16, SEQ = 4096, NMETA = 16, TT = SEQ + NMETA  , MROWS = NB * TT  , DM = 1024;
constexpr int NREAL = NB * SEQ;
constexpr int NZP = 5632;
constexpr int NZ = 2080;
constexpr int ZMQ = 0, ZMK = 512, ZMV = 1024, ZMO = 1536, ZGA = 2048, ZGM = 3072;
constexpr int ZYC = 0;
constexpr int NIN = 5640;
constexpr int NE = 32, FF = 1024;
constexpr int OROWS = 4352;
constexpr float LN_EPS = 1e-5f;
constexpr float DN_ALPHA = 1.189207115002721f;
constexpr float LAMBDA_INIT = 0.2f;
constexpr float FP8_SA2 = 8.0f, FP8_SB2 = 512.0f;
constexpr float FP8_SA1 = 16.0f, FP8_SB1 = 512.0f;
constexpr float ATT_C2 = 0.125f * 1.4426950408889634f;

constexpr size_t MiB = 1u << 20;
constexpr size_t WS_CTL = 0, CTL_ZERO_BYTES = 32768;
constexpr size_t WS_WIN = 2 * MiB;
constexpr size_t WS_WA = 13 * MiB;
constexpr size_t WS_WM = 14 * MiB;
constexpr size_t WS_WO = 15 * MiB;
constexpr size_t WS_ROPE = 17 * MiB;
constexpr size_t WS_STATS = 19 * MiB;
constexpr size_t WS_GATES = 20 * MiB;
constexpr size_t WS_TOKE = 23 * MiB;
constexpr size_t WS_TOKG = 24 * MiB + 512 * 1024;
constexpr size_t WS_HIST = 26 * MiB;
constexpr size_t WS_ROWOFF = 27 * MiB;
constexpr size_t WS_ROWSLOT = 28 * MiB + 512 * 1024;
constexpr size_t WS_ROWGATE = 30 * MiB;
constexpr size_t WS_TILEEXP = 31 * MiB + 512 * 1024;
constexpr size_t WS_H = 32 * MiB;
constexpr size_t WS_Z = 162 * MiB;
constexpr size_t WS_Y = WS_Z;
constexpr size_t WS_ACT = WS_Z + 516 * MiB;
constexpr size_t WS_GF = 424 * MiB;
constexpr size_t WS_QC = 686 * MiB;
constexpr size_t WS_KC = 751 * MiB;
constexpr size_t WS_VC = 816 * MiB;
constexpr size_t WS_TMP = 686 * MiB;
constexpr size_t WS_MRG = 816 * MiB;
constexpr size_t WS_O = 882 * MiB;
constexpr size_t WS_H8 = 952 * MiB;
constexpr size_t WS_WIN8 = 1017 * MiB;
constexpr size_t WS_END = 1024 * MiB;
constexpr size_t DO_WGU = 0;
constexpr size_t DO_WDN = 128 * MiB;
constexpr int CW_TMO = 0, CW_NT = 64, CW_TICKET = 128  , CW_PROBE = 1024, CW_BAR = 4096;

constexpr int LDS_BYTES = 163840;
constexpr int MISC_OFF = 163840 - 512;
constexpr int NWAVES = 8;

__device__ __forceinline__ unsigned pkbf(float lo, float hi) { f32x2 v = {lo, hi}; bf16x2_t b = __builtin_convertvector(v, bf16x2_t); return __builtin_bit_cast(unsigned, b); }
__device__ __forceinline__ float bflo(unsigned w) { return __uint_as_float(w << 16); }
__device__ __forceinline__ float bfhi(unsigned w) { return __uint_as_float(w & 0xffff0000u); }
__device__ __forceinline__ float sigmoidf_(float x) { return __builtin_amdgcn_rcpf(1.0f + __expf(-x)); }
template <int CTRL> __device__ __forceinline__ float dppf(float v) { return __builtin_bit_cast(float, __builtin_amdgcn_update_dpp(0, __builtin_bit_cast(int, v), CTRL, 0xF, 0xF, true)); }
__device__ __forceinline__ float rdlane(float v, int l) { return __builtin_bit_cast(float, __builtin_amdgcn_readlane(__builtin_bit_cast(int, v), l)); }
__device__ __forceinline__ float row_sum16(float v) { v += dppf<0xB1>(v); v += dppf<0x4E>(v); v += dppf<0x141>(v); v += dppf<0x140>(v); return v; }
__device__ __forceinline__ float wave_sum(float v) { v = row_sum16(v); return (rdlane(v, 0) + rdlane(v, 16)) + (rdlane(v, 32) + rdlane(v, 48)); }
__device__ __forceinline__ float wave_max(float v) {
    v = fmaxf(v, dppf<0xB1>(v)); v = fmaxf(v, dppf<0x4E>(v)); v = fmaxf(v, dppf<0x141>(v)); v = fmaxf(v, dppf<0x140>(v));
    return fmaxf(fmaxf(rdlane(v, 0), rdlane(v, 16)), fmaxf(rdlane(v, 32), rdlane(v, 48)));
}
__device__ __forceinline__ float xreduce32(float (&p)[32], int lane) {
    float a[16], b[8], c[4], d[2];
#pragma unroll
    for (int i = 0; i < 16; ++i) { auto r = __builtin_amdgcn_permlane32_swap(__float_as_uint(p[i]), __float_as_uint(p[16 + i]), false, false); a[i] = __uint_as_float(r[0]) + __uint_as_float(r[1]); }
#pragma unroll
    for (int i = 0; i < 8; ++i) { auto r = __builtin_amdgcn_permlane16_swap(__float_as_uint(a[i]), __float_as_uint(a[8 + i]), false, false); b[i] = __uint_as_float(r[0]) + __uint_as_float(r[1]); }
    const bool b3 = (lane & 8) != 0, b2 = (lane & 4) != 0, b1 = (lane & 2) != 0;
#pragma unroll
    for (int i = 0; i < 4; ++i) { const float keep = b3 ? b[4 + i] : b[i], send = b3 ? b[i] : b[4 + i]; c[i] = keep + dppf<0x128>(send); }
#pragma unroll
    for (int i = 0; i < 2; ++i) { const float keep = b2 ? c[2 + i] : c[i], send = b2 ? c[i] : c[2 + i]; d[i] = keep + dppf<0x141>(send); }
    const float keep = b1 ? d[1] : d[0], send = b1 ? d[0] : d[1];
    float r = keep + dppf<0x4E>(send);
    r += dppf<0xB1>(r);
    return r;
}
__device__ __forceinline__ int ld_agent_i(const int* p) { return __hip_atomic_load(p, RLX_AGENT); }
__device__ __forceinline__ float ld_agent_f(const float* p) { return __hip_atomic_load(p, RLX_AGENT); }
#define LDS_WAIT() asm volatile("s_waitcnt lgkmcnt(0)" ::: "memory")
template <int CTRL, int RMASK> __device__ __forceinline__ float dpp_old(float old, float v) { return __builtin_bit_cast(float, __builtin_amdgcn_update_dpp(__builtin_bit_cast(int, old), __builtin_bit_cast(int, v), CTRL, RMASK, 0xF, false)); }
__device__ __forceinline__ float wave_scan_add(float v) {
    v += dpp_old<0x111, 0xF>(0.f, v); v += dpp_old<0x112, 0xF>(0.f, v); v += dpp_old<0x114, 0xF>(0.f, v); v += dpp_old<0x118, 0xF>(0.f, v);
    v += dpp_old<0x142, 0xA>(0.f, v); v += dpp_old<0x143, 0xC>(0.f, v); return v; }
__device__ __forceinline__ float wave_scan_max(float v) {
    const float ninf = -INFINITY;
    v = fmaxf(v, dpp_old<0x111, 0xF>(ninf, v)); v = fmaxf(v, dpp_old<0x112, 0xF>(ninf, v)); v = fmaxf(v, dpp_old<0x114, 0xF>(ninf, v)); v = fmaxf(v, dpp_old<0x118, 0xF>(ninf, v));
    v = fmaxf(v, dpp_old<0x142, 0xA>(ninf, v)); v = fmaxf(v, dpp_old<0x143, 0xC>(ninf, v)); return v; }
__device__ __forceinline__ int row_of(int b, int t) { return (t < NMETA) ? NREAL + b * NMETA + t : b * SEQ + (t - NMETA); }
__device__ __forceinline__ void bt_of(int row, int& b, int& t) { if (row < NREAL) { b = row >> 12; t = (row & (SEQ - 1)) + NMETA; } else { const int m = row - NREAL; b = m >> 4; t = m & (NMETA - 1); } }
__device__ __forceinline__ unsigned pkfp8x4(float a, float b, float c, float d) {
    a = fminf(fmaxf(a, -448.f), 448.f); b = fminf(fmaxf(b, -448.f), 448.f); c = fminf(fmaxf(c, -448.f), 448.f); d = fminf(fmaxf(d, -448.f), 448.f);
    int w = 0; w = __builtin_amdgcn_cvt_pk_fp8_f32(a, b, w, false); w = __builtin_amdgcn_cvt_pk_fp8_f32(c, d, w, true); return (unsigned)w; }
__device__ __forceinline__ const void* ldptr(LAS const unsigned long long* t, int i) { const unsigned long long v = t[i];
    const unsigned lo = (unsigned)__builtin_amdgcn_readfirstlane((int)(unsigned)v), hi = (unsigned)__builtin_amdgcn_readfirstlane((int)(unsigned)(v >> 32));
    return (const void*)(const GAS void*)(((unsigned long long)hi << 32) | lo); }

namespace pg8 {
constexpr int BM = 256, BK = 64, HALF = 128, HTB = HALF * BK * 2, STAGE_BYTES = 8 * HTB, NXCD = 8, WGM = 8;
__host__ __device__ __forceinline__ int lds_byte(int r, int c) { const int st = (r >> 4) * 2 + (c >> 5), rr = r & 15, cc = c & 31, ob = rr * 64 + cc * 2; return st * 1024 + (ob ^ (((ob >> 9) & 1) << 5)); }
__host__ __device__ __forceinline__ void stage_rc(int b, int& R, int& C) { const int st = b / 1024, sb = b % 1024, swz = sb ^ (((sb >> 9) & 1) << 5); R = (st >> 1) * 16 + swz / 64; C = (st & 1) * 32 + (swz % 64) / 2; }
__host__ __device__ __forceinline__ int perm32(int rho) { const int n = rho >> 4, i = rho & 15; return 8 * (i >> 2) + 4 * n + (i & 3); }

struct Unit { int pm, pn, e; };
struct Gemm { const bf16_t* A; const bf16_t* Bt; int lda, K, nN; const int* row_off; const int* tile_exp; int pm0; int pn_split, pn_add0, pn_add1; };
struct StaticOrder {
    int nM, nN, nwg, G, c;
    __device__ __forceinline__ void init(int nM_, int nN_, int G_, int c_) { nM = nM_; nN = nN_; nwg = nM * nN; G = G_; c = c_; }
    __device__ __forceinline__ bool next(int i, Unit& u) const {
        const long L = (long)i * G + c; if (L >= nwg) return false;
        int wgid = (int)L; { const int q = nwg / NXCD, r = nwg % NXCD, xcd = wgid % NXCD, off = wgid / NXCD; wgid = (xcd < r ? xcd * (q + 1) : r * (q + 1) + (xcd - r) * q) + off; }
        const int nig = WGM * nN, gid = wgid / nig, fm = gid * WGM, gsz = (nM - fm) < WGM ? (nM - fm) : WGM;
        u.pm = fm + ((wgid % nig) % gsz); u.pn = (wgid % nig) / gsz; u.e = 0; return true;
    }
};

template <int MODE, class Epi, bool MID = false, bool FP8 = false>
__device__ __forceinline__ void gemm_phase(LAS unsigned char* lds, const Gemm g, const StaticOrder& S, const Epi& E) {
    int tid_ = threadIdx.x; asm volatile("" : "+v"(tid_));
    const int tid = tid_, wid = __builtin_amdgcn_readfirstlane(tid >> 6), lane = tid & 63, wr = wid >> 2, wc = wid & 3, fr = lane & 15, fq = lane >> 4;
    const int K = g.K, nt = K / BK;
    unsigned voffA[2], voffB[2];
#pragma unroll
    for (int i = 0; i < 2; ++i) { int R, C; stage_rc(tid * 16 + i * 8192, R, C); const int Rb = Epi::PERM ? ((R & ~31) + perm32(R & 31)) : R;
        voffA[i] = (unsigned)(R * g.lda + C) * 2u; voffB[i] = (unsigned)(Rb * K + C) * 2u; }
    const size_t kstep = (size_t)(BK * 2);
    const size_t hstepA = (size_t)HALF * g.lda * 2, hstepB = (size_t)HALF * K * 2;
    const size_t tstepA = 2 * hstepA, tstepB = 2 * hstepB;
    const unsigned ldsw = (unsigned)wid * 1024u;
    LAS unsigned char* pa = lds + lds_byte(wr * 64 + fr, fq * 8); LAS unsigned char* pb = lds + 4 * HTB + lds_byte(wc * 32 + fr, fq * 8);
    asm volatile("" : "+v"(pa), "+v"(pb));
    unsigned vC[2][2] = {{0u, 0u}, {0u, 0u}};
    constexpr int GOFF = 8 * HTB;
#define PG8_SA(b, h) (((b) * 2 + (h)) * HTB)
#define PG8_SB(b, h) ((4 + (b) * 2 + (h)) * HTB)
#define PG8_STAGE_B(bufoff, gbase) do { _Pragma("unroll") for (int _i = 0; _i < 2; ++_i) { unsigned vb_ = voffB[_i]; asm volatile("" : "+v"(vb_)); \
        __builtin_amdgcn_global_load_lds((const unsigned*)((const char*)(gbase) + vb_), (LAS unsigned*)(lds + (bufoff) + ldsw + _i * 8192), 16, 0, 0); } } while (0)
#define PG8_STAGE_A(bufoff, gbase, h) do { _Pragma("unroll") for (int _i = 0; _i < 2; ++_i) { unsigned va_ = (MODE == 1) ? vC[h][_i] : voffA[_i]; if (MODE != 1) asm volatile("" : "+v"(va_)); \
        const char* _p = (MODE == 1) ? ((const char*)(gbase) + va_) : ((const char*)(gbase) + (h) * hstepA + va_); \
        __builtin_amdgcn_global_load_lds((const unsigned*)_p, (LAS unsigned*)(lds + (bufoff) + ldsw + _i * 8192), 16, 0, 0); } } while (0)
#define PG8_LD8(dst, cnt, base) do { _Pragma("unroll") for (int q_ = 0; q_ < (cnt); ++q_) { const pg8_v4i lo_ = *(const LAS pg8_v4i*)((base) + q_ * 2048), hi_ = *(const LAS pg8_v4i*)((base) + q_ * 2048 + 1024); \
        dst[q_] = __builtin_shufflevector(lo_, hi_, 0, 1, 2, 3, 4, 5, 6, 7); } } while (0)
#define PG8_LDA(dst, b, h) do { if constexpr (FP8) { PG8_LD8(dst##8, 4, pa + PG8_SA(b, h)); } else { _Pragma("unroll") for (int m = 0; m < 4; ++m) _Pragma("unroll") for (int k = 0; k < 2; ++k) dst[m][k] = *(const LAS bf16x8*)(pa + PG8_SA(b, h) + m * 2048 + k * 1024); } } while (0)
#define PG8_LDB(dst, b, h) do { if constexpr (FP8) { PG8_LD8(dst##8, 2, pb + PG8_SA(b, h)); } else { _Pragma("unroll") for (int n = 0; n < 2; ++n) _Pragma("unroll") for (int k = 0; k < 2; ++k) dst[n][k] = *(const LAS bf16x8*)(pb + PG8_SA(b, h) + n * 2048 + k * 1024); } } while (0)
#define PG8_MMA(ai, bj, At, Bt) do { __builtin_amdgcn_s_setprio(1); _Pragma("unroll") for (int m = 0; m < 4; ++m) _Pragma("unroll") for (int n = 0; n < 2; ++n) { \
        if constexpr (FP8) {   \
            acc[ai][bj][m][n] = __builtin_amdgcn_mfma_scale_f32_16x16x128_f8f6f4(Bt##8[n], At##8[m], acc[ai][bj][m][n], 0, 0, 0, 0x7f7f7f7f, 0, 0x7f7f7f7f); \
        } else { _Pragma("unroll") for (int k = 0; k < 2; ++k) acc[ai][bj][m][n] = __builtin_amdgcn_mfma_f32_16x16x32_bf16(Bt[n][k], At[m][k], acc[ai][bj][m][n], 0, 0, 0); } } \
        __builtin_amdgcn_s_setprio(0); } while (0)
#define PG8_WAIT_V(n) asm volatile("s_waitcnt vmcnt(" #n ")" ::: "memory")
#define PG8_WAIT_L(n) asm volatile("s_waitcnt lgkmcnt(" #n ")" ::: "memory")
#define PG8_BAR __builtin_amdgcn_s_barrier()
#define PG8_SCHED __builtin_amdgcn_sched_barrier(0)
#define PG8_ABASE(u) ((MODE == 1) ? (const char*)g.A : (const char*)g.A + (size_t)(u).pm * tstepA)
#define PG8_BBASE(u) ((MODE == 0) ? (const char*)g.Bt + (size_t)(u).pn * tstepB : (const char*)g.Bt + ((size_t)((u).e = __builtin_amdgcn_readfirstlane(ld_agent_i(g.tile_exp + g.pm0 + (u).pm))) * g.nN + (u).pn) * tstepB)
#define PG8_GATHER(dst, u) do { if (MODE == 1) { int tq_ = tid; asm volatile("" : "+v"(tq_)); _Pragma("unroll") for (int _i = 0; _i < 2; ++_i) { int R_, C_; stage_rc(tq_ * 16 + _i * 8192, R_, C_); \
        _Pragma("unroll") for (int _h = 0; _h < 2; ++_h) dst[_h][_i] = (unsigned)ld_agent_i(g.row_off + (size_t)(g.pm0 + (u).pm) * BM + _h * HALF + R_) + (unsigned)(C_ * 2); } } } while (0)
#define PG8_GATHER_DMA(u) do { if (MODE == 1) { int tq_ = tid; asm volatile("" : "+v"(tq_)); _Pragma("unroll") for (int _i = 0; _i < 2; ++_i) { int R_, C_; stage_rc(tq_ * 16 + _i * 8192, R_, C_); \
        _Pragma("unroll") for (int _h = 0; _h < 2; ++_h) __builtin_amdgcn_global_load_lds((const unsigned*)(g.row_off + (size_t)(g.pm0 + (u).pm) * BM + _h * HALF + R_), (LAS unsigned*)(lds + GOFF + (_h * 2 + _i) * 2048 + wid * 256), 4, 0, 0); } } } while (0)
#define PG8_GATHER_LDS(dst) do { if (MODE == 1) { int tq_ = tid; asm volatile("" : "+v"(tq_)); _Pragma("unroll") for (int _i = 0; _i < 2; ++_i) { int R_, C_; stage_rc(tq_ * 16 + _i * 8192, R_, C_); \
        _Pragma("unroll") for (int _h = 0; _h < 2; ++_h) dst[_h][_i] = *(const LAS unsigned*)(lds + GOFF + (_h * 2 + _i) * 2048 + tq_ * 4) + (unsigned)(C_ * 2); } } } while (0)
    Unit cur, nxt; int ui = 0;
    if (!S.next(0, cur)) return;
    if (MODE == 0) cur.pn += (cur.pn < g.pn_split) ? g.pn_add0 : g.pn_add1;
    f32x4 acc[2][2][4][2];
#pragma unroll
    for (int a = 0; a < 2; ++a)
#pragma unroll
        for (int b = 0; b < 2; ++b)
#pragma unroll
            for (int m = 0; m < 4; ++m)
#pragma unroll
                for (int n = 0; n < 2; ++n) acc[a][b][m][n] = (f32x4){0.f, 0.f, 0.f, 0.f};
    bf16x8 At[4][2], B0[2][2], B1[2][2];
    typedef int pg8_v8i __attribute__((ext_vector_type(8))); typedef int pg8_v4i __attribute__((ext_vector_type(4)));
    pg8_v8i At8[4], B08[2], B18[2];
    const char* cA = PG8_ABASE(cur); const char* cB = PG8_BBASE(cur);
    PG8_GATHER(vC, cur);
    PG8_STAGE_B(PG8_SB(0, 0), cB); PG8_STAGE_B(PG8_SB(0, 1), cB + hstepB); PG8_STAGE_A(PG8_SA(0, 0), cA, 0); PG8_STAGE_A(PG8_SA(0, 1), cA, 1);
    if (wr == 1) PG8_BAR;
    PG8_WAIT_V(2); PG8_BAR;
    PG8_STAGE_B(PG8_SB(1, 0), cB + kstep); PG8_STAGE_A(PG8_SA(1, 0), cA + kstep, 0); PG8_STAGE_B(PG8_SB(1, 1), cB + hstepB + kstep);
    PG8_WAIT_V(6); PG8_BAR;
    for (;;) {
        const bool has_next = S.next(ui + 1, nxt);
        if (MODE == 0) nxt.pn += (nxt.pn < g.pn_split) ? g.pn_add0 : g.pn_add1;
        const char* nA = has_next ? PG8_ABASE(nxt) : cA; const char* nB = has_next ? PG8_BBASE(nxt) : cB;
        if (has_next) PG8_GATHER_DMA(nxt);
#pragma unroll 1
        for (int t = 0; t < nt; t += 2) {
            if constexpr (MID) { if (t == nt / 2) { if (wr == 0) PG8_BAR; E.mid(acc, cur, wr, wc, fr, fq); if (wr == 1) PG8_BAR; } }
            const bool last = (t == nt - 2);
            const char* a1 = cA + (size_t)(t + 1) * kstep;
            const char* a2 = last ? nA : cA + (size_t)(t + 2) * kstep; const char* b2 = last ? nB : cB + (size_t)(t + 2) * kstep;
            const char* a3 = a2 + kstep; const char* b3 = b2 + kstep;
            PG8_LDB(B0, 0, 0); PG8_LDB(B1, 0, 1); PG8_SCHED; PG8_LDA(At, 0, 0); PG8_STAGE_A(PG8_SA(1, 1), a1, 1);
            if (MODE == 1) { if (last && has_next) PG8_GATHER_LDS(vC); }
            PG8_WAIT_V(8); PG8_WAIT_L(0); PG8_BAR; PG8_MMA(0, 0, At, B0); PG8_MMA(0, 1, At, B1); PG8_BAR; PG8_SCHED;
            PG8_LDA(At, 0, 1); PG8_STAGE_B(PG8_SB(0, 0), b2); PG8_STAGE_B(PG8_SB(0, 1), b2 + hstepB); PG8_STAGE_A(PG8_SA(0, 0), a2, 0);
            PG8_WAIT_V(8); PG8_WAIT_L(0); PG8_BAR; PG8_MMA(1, 0, At, B0); PG8_MMA(1, 1, At, B1); PG8_BAR; PG8_SCHED;
            PG8_LDB(B0, 1, 0); PG8_LDB(B1, 1, 1); PG8_SCHED; PG8_LDA(At, 1, 0); PG8_STAGE_A(PG8_SA(0, 1), a2, 1);
            PG8_WAIT_V(8); PG8_WAIT_L(0); PG8_BAR; PG8_MMA(0, 0, At, B0); PG8_MMA(0, 1, At, B1); PG8_BAR; PG8_SCHED;
            PG8_LDA(At, 1, 1); PG8_STAGE_B(PG8_SB(1, 0), b3); PG8_STAGE_B(PG8_SB(1, 1), b3 + hstepB); PG8_STAGE_A(PG8_SA(1, 0), a3, 0);
            PG8_WAIT_V(8); PG8_WAIT_L(0); PG8_BAR; PG8_MMA(1, 0, At, B0); PG8_MMA(1, 1, At, B1); PG8_BAR; PG8_SCHED;
        }
        if (wr == 0) PG8_BAR;
        E(acc, cur, wr, wc, fr, fq);
        if (!has_next) break;
#pragma unroll
        for (int a = 0; a < 2; ++a)
#pragma unroll
            for (int b = 0; b < 2; ++b)
#pragma unroll
                for (int m = 0; m < 4; ++m)
#pragma unroll
                    for (int n = 0; n < 2; ++n) acc[a][b][m][n] = (f32x4){0.f, 0.f, 0.f, 0.f};
        cur = nxt; cA = nA; cB = nB; ++ui;
        if (wr == 1) PG8_BAR;
    }
    PG8_WAIT_V(0);
    PG8_BAR;
#undef PG8_SA
#undef PG8_SB
#undef PG8_STAGE_A
#undef PG8_STAGE_B
#undef PG8_LD8
#undef PG8_LDA
#undef PG8_LDB
#undef PG8_MMA
#undef PG8_WAIT_V
#undef PG8_WAIT_L
#undef PG8_BAR
#undef PG8_SCHED
#undef PG8_ABASE
#undef PG8_BBASE
#undef PG8_GATHER
#undef PG8_GATHER_DMA
#undef PG8_GATHER_LDS
}

struct EpiZ {
    static constexpr bool PERM = true;
    bf16_t* Z; bf16_t* Qc; bf16_t* Kc; bf16_t* Vc; const float* ropec; const float* ropes; bf16_t* GF; float ascale;
    __device__ __forceinline__ void operator()(const f32x4 (&acc)[2][2][4][2], const Unit& u, int wr, int wc, int fr, int fq) const {
        { int tq_ = threadIdx.x; asm volatile("" : "+v"(tq_)); fr = tq_ & 15; fq = (tq_ >> 4) & 3; }
        const int row0 = u.pm * BM + wr * 64 + fr;
        if (u.pn < 4) {
            const float sc = (u.pn < 2) ? ATT_C2 : 1.0f;
            bf16_t* base = (u.pn < 2) ? Qc : Kc;
            const int dl = 16 * (wc & 1) + 4 * fq;
#pragma unroll
            for (int ai = 0; ai < 2; ++ai)
#pragma unroll
                for (int m = 0; m < 4; ++m) {
                    const int row = row0 + ai * HALF + m * 16; int b, t; bt_of(row, b, t);
                    const f32x4 c = *(const f32x4*)(ropec + t * 32 + dl) * sc, s = *(const f32x4*)(ropes + t * 32 + dl) * sc;
#pragma unroll
                    for (int bj = 0; bj < 2; ++bj) {
                        const int hm = 4 * (u.pn & 1) + 2 * bj + (wc >> 1);
                        const f32x4 x1 = acc[ai][bj][m][0], x2 = acc[ai][bj][m][1];
                        const f32x4 o1 = x1 * c - x2 * s, o2 = x2 * c + x1 * s;
                        bf16_t* p = base + ((size_t)(b * 8 + hm) * TT + t) * 64 + dl;
                        u32x2 w1, w2; w1.x = pkbf(o1[0], o1[1]); w1.y = pkbf(o1[2], o1[3]); w2.x = pkbf(o2[0], o2[1]); w2.y = pkbf(o2[2], o2[3]);
                        *(u32x2*)p = w1; *(u32x2*)(p + 32) = w2;
                    }
                }
        } else if (u.pn < 6) {
            const int e0 = wc * 32 + 8 * fq;
#pragma unroll
            for (int ai = 0; ai < 2; ++ai)
#pragma unroll
                for (int m = 0; m < 4; ++m) {
                    const int row = row0 + ai * HALF + m * 16; int b, t; bt_of(row, b, t);
#pragma unroll
                    for (int bj = 0; bj < 2; ++bj) { const int h = (u.pn - 4) * 2 + bj; const f32x4 v0 = acc[ai][bj][m][0] * ascale, v1 = acc[ai][bj][m][1] * ascale;
                        u32x4 w; w.x = pkbf(v0[0], v0[1]); w.y = pkbf(v0[2], v0[3]); w.z = pkbf(v1[0], v1[1]); w.w = pkbf(v1[2], v1[3]);
                        *(u32x4*)(Vc + ((size_t)(b * 4 + h) * TT + t) * 128 + e0) = w; }
                }
        } else if (u.pn < 14) {
            const int col0 = (u.pn - 6) * BM + wc * 32 + 8 * fq;
#pragma unroll
            for (int ai = 0; ai < 2; ++ai)
#pragma unroll
                for (int m = 0; m < 4; ++m) {
                    bf16_t* rowp = Z + (size_t)(row0 + ai * HALF + m * 16) * NZ + col0;
#pragma unroll
                    for (int bj = 0; bj < 2; ++bj) { const f32x4 v0 = acc[ai][bj][m][0] * ascale, v1 = acc[ai][bj][m][1] * ascale;
                        u32x4 w; w.x = pkbf(v0[0], v0[1]); w.y = pkbf(v0[2], v0[3]); w.z = pkbf(v1[0], v1[1]); w.w = pkbf(v1[2], v1[3]);
                        *(u32x4*)(rowp + bj * HALF) = w; }
                }
        } else if (u.pm < NREAL / BM) {
            const int gi = (u.pn - 14) >> 2, pn4 = (u.pn - 14) & 3;
            u32x4* gp = (u32x4*)GF + ((((size_t)(gi * (NREAL / BM) + u.pm) * 4 + pn4) * 8 + (wr * 4 + wc)) * 16) * 64 + (fq * 16 + fr);
#pragma unroll
            for (int ai = 0; ai < 2; ++ai)
#pragma unroll
                for (int bj = 0; bj < 2; ++bj)
#pragma unroll
                    for (int m = 0; m < 4; ++m) { const f32x4 v0 = acc[ai][bj][m][0] * ascale, v1 = acc[ai][bj][m][1] * ascale;
                        u32x4 w; w.x = pkbf(sigmoidf_(v0[0]), sigmoidf_(v0[1])); w.y = pkbf(sigmoidf_(v0[2]), sigmoidf_(v0[3])); w.z = pkbf(sigmoidf_(v1[0]), sigmoidf_(v1[1])); w.w = pkbf(sigmoidf_(v1[2]), sigmoidf_(v1[3]));
                        gp[((ai * 2 + bj) * 4 + m) * 64] = w; }
        }
    }
};
template <bool SECOND> struct EpiGate {
    static constexpr bool PERM = true;
    bf16_t* Z; bf16_t* TMP; bf16_t* MRG;
    __device__ __forceinline__ void operator()(const f32x4 (&acc)[2][2][4][2], const Unit& u, int wr, int wc, int fr, int fq) const {
        const int row0 = u.pm * BM + wr * 64 + fr, col0 = u.pn * BM + wc * 32 + 8 * fq;
#pragma unroll
        for (int ai = 0; ai < 2; ++ai)
#pragma unroll
            for (int m = 0; m < 4; ++m) {
                bf16_t* rowp = Z + (size_t)(row0 + ai * HALF + m * 16) * NZ + col0; bf16_t* tmpp = TMP + (size_t)(row0 + ai * HALF + m * 16) * DM + col0; bf16_t* mrgp = MRG + (size_t)(row0 + ai * HALF + m * 16) * DM + col0;
#pragma unroll
                for (int bj = 0; bj < 2; ++bj) {
                    const u32x4 gw = *(const u32x4*)(rowp + (SECOND ? ZGM : ZGA) + bj * HALF);
                    const f32x4 v0 = acc[ai][bj][m][0], v1 = acc[ai][bj][m][1];
                    float o[8];
                    o[0] = sigmoidf_(bflo(gw.x)) * v0[0]; o[1] = sigmoidf_(bfhi(gw.x)) * v0[1]; o[2] = sigmoidf_(bflo(gw.y)) * v0[2]; o[3] = sigmoidf_(bfhi(gw.y)) * v0[3];
                    o[4] = sigmoidf_(bflo(gw.z)) * v1[0]; o[5] = sigmoidf_(bfhi(gw.z)) * v1[1]; o[6] = sigmoidf_(bflo(gw.w)) * v1[2]; o[7] = sigmoidf_(bfhi(gw.w)) * v1[3];
                    if (SECOND) { const u32x4 tw = *(const u32x4*)(tmpp + bj * HALF);
                        o[0] += bflo(tw.x); o[1] += bfhi(tw.x); o[2] += bflo(tw.y); o[3] += bfhi(tw.y); o[4] += bflo(tw.z); o[5] += bfhi(tw.z); o[6] += bflo(tw.w); o[7] += bfhi(tw.w); }
                    u32x4 w; w.x = pkbf(o[0], o[1]); w.y = pkbf(o[2], o[3]); w.z = pkbf(o[4], o[5]); w.w = pkbf(o[6], o[7]);
                    if (SECOND) *(u32x4*)(mrgp + bj * HALF) = w; else *(u32x4*)(tmpp + bj * HALF) = w;
                }
            }
    }
};
struct EpiGateFused {
    static constexpr bool PERM = true;
    const bf16_t* GF; bf16_t* MRG;
    __device__ __forceinline__ void mid(f32x4 (&acc)[2][2][4][2], const Unit& u, int wr, int wc, int fr, int fq) const {
        asm volatile("" : "+v"(fr), "+v"(fq));
        const u32x4* ga = (const u32x4*)GF + ((((size_t)u.pm * 4 + u.pn) * 8 + (wr * 4 + wc)) * 16) * 64 + (fq * 16 + fr);
        const u32x4* gm = ga + (size_t)(NREAL / BM) * 4 * 8 * 16 * 64;
#pragma unroll
        for (int q = 0; q < 16; ++q) {
            const int ai = q >> 3, bj = (q >> 2) & 1, m = q & 3;
            const u32x4 a = ga[q * 64], b = gm[q * 64];
            float r[8];
#define EG_R(a_, m_) ((a_) * __builtin_amdgcn_rcpf(m_))
            r[0] = EG_R(bflo(a.x), bflo(b.x)); r[1] = EG_R(bfhi(a.x), bfhi(b.x)); r[2] = EG_R(bflo(a.y), bflo(b.y)); r[3] = EG_R(bfhi(a.y), bfhi(b.y));
            r[4] = EG_R(bflo(a.z), bflo(b.z)); r[5] = EG_R(bfhi(a.z), bfhi(b.z)); r[6] = EG_R(bflo(a.w), bflo(b.w)); r[7] = EG_R(bfhi(a.w), bfhi(b.w));
#undef EG_R
            acc[ai][bj][m][0] = acc[ai][bj][m][0] * (f32x4){r[0], r[1], r[2], r[3]}; acc[ai][bj][m][1] = acc[ai][bj][m][1] * (f32x4){r[4], r[5], r[6], r[7]};
            asm volatile("" : "+v"(acc[ai][bj][m][0]), "+v"(acc[ai][bj][m][1]));
            if ((q & 7) == 7) asm volatile("" ::: "memory");
        }
    }
    __device__ __forceinline__ void operator()(const f32x4 (&acc)[2][2][4][2], const Unit& u, int wr, int wc, int fr, int fq) const {
        const int row0 = u.pm * BM + wr * 64 + fr, col0 = u.pn * BM + wc * 32 + 8 * fq;
        const u32x4* gm = (const u32x4*)GF + (size_t)(NREAL / BM) * 4 * 8 * 16 * 64 + ((((size_t)u.pm * 4 + u.pn) * 8 + (wr * 4 + wc)) * 16) * 64 + (fq * 16 + fr);
#pragma unroll
        for (int ai = 0; ai < 2; ++ai)
#pragma unroll
            for (int m = 0; m < 4; ++m) {
                bf16_t* mrgp = MRG + (size_t)(row0 + ai * HALF + m * 16) * DM + col0;
#pragma unroll
                for (int bj = 0; bj < 2; ++bj) {
                    const u32x4 g = gm[((ai * 2 + bj) * 4 + m) * 64];
                    const f32x4 v0 = acc[ai][bj][m][0], v1 = acc[ai][bj][m][1];
                    u32x4 w; w.x = pkbf(bflo(g.x) * v0[0], bfhi(g.x) * v0[1]); w.y = pkbf(bflo(g.y) * v0[2], bfhi(g.y) * v0[3]);
                    w.z = pkbf(bflo(g.z) * v1[0], bfhi(g.z) * v1[1]); w.w = pkbf(bflo(g.w) * v1[2], bfhi(g.w) * v1[3]);
                    *(u32x4*)(mrgp + bj * HALF) = w;
                }
            }
    }
};
struct EpiStoreBf16 {
    static constexpr bool PERM = true;
    bf16_t* O; int ldc;
    __device__ __forceinline__ void operator()(const f32x4 (&acc)[2][2][4][2], const Unit& u, int wr, int wc, int fr, int fq) const {
        const int row0 = u.pm * BM + wr * 64 + fr, col0 = u.pn * BM + wc * 32 + 8 * fq;
#pragma unroll
        for (int ai = 0; ai < 2; ++ai)
#pragma unroll
            for (int m = 0; m < 4; ++m) { bf16_t* rowp = O + (size_t)(row0 + ai * HALF + m * 16) * ldc + col0;
#pragma unroll
                for (int bj = 0; bj < 2; ++bj) { const f32x4 v0 = acc[ai][bj][m][0], v1 = acc[ai][bj][m][1];
                    u32x4 w; w.x = pkbf(v0[0], v0[1]); w.y = pkbf(v0[2], v0[3]); w.z = pkbf(v1[0], v1[1]); w.w = pkbf(v1[2], v1[3]);
                    *(u32x4*)(rowp + bj * HALF) = w; } }
    }
};
struct EpiPre1 {
    static constexpr bool PERM = false;
    float* P1; const float* x; const float* meta; const float* stats; const float* g0; const float* b0;
    __device__ __forceinline__ void operator()(const f32x4 (&acc)[2][2][4][2], const Unit& u, int wr, int wc, int fr, int fq) const {
        const int row0 = u.pm * BM + wr * 64 + fr, col0 = u.pn * BM + wc * 32 + 4 * fq;
        f32x4 gv[2][2], bv[2][2];
#pragma unroll
        for (int bj = 0; bj < 2; ++bj)
#pragma unroll
            for (int n = 0; n < 2; ++n) { gv[bj][n] = *(const f32x4*)(g0 + col0 + bj * HALF + n * 16); bv[bj][n] = *(const f32x4*)(b0 + col0 + bj * HALF + n * 16); }
#pragma unroll
        for (int ai = 0; ai < 2; ++ai)
#pragma unroll
            for (int m = 0; m < 4; ++m) {
                const int row = row0 + ai * HALF + m * 16;
                const float* xr = x + (size_t)row * DM;
                const float mean = ld_agent_f(stats + 2 * row), rstd = ld_agent_f(stats + 2 * row + 1);
                float* orow = P1 + (size_t)row * (NZ / 2) + col0;
#pragma unroll
                for (int bj = 0; bj < 2; ++bj)
#pragma unroll
                    for (int n = 0; n < 2; ++n) { const f32x4 xv = *(const f32x4*)(xr + col0 + bj * HALF + n * 16);
                        const f32x4 hv = (xv - mean) * rstd * gv[bj][n] + bv[bj][n];
                        *(f32x4*)(orow + bj * HALF + n * 16) = hv * DN_ALPHA + acc[ai][bj][m][n]; }
            }
    }
};
struct EpiAct {
    static constexpr bool PERM = true;
    bf16_t* ACT; const float* b_gu; const int* tile_exp; int pm0; float ascale;
    __device__ __forceinline__ void operator()(const f32x4 (&acc)[2][2][4][2], const Unit& u, int wr, int wc, int fr, int fq) const {
        { int tq_ = threadIdx.x; asm volatile("" : "+v"(tq_)); fr = tq_ & 15; fq = (tq_ >> 4) & 3; }
        const int e = u.e;
        const int ac0 = u.pn * HALF + wc * 32 + 8 * fq;
        const float* bp = b_gu + (size_t)e * 2 * FF + 2 * ac0;
        f32x2 bg[4], bl[4];
#pragma unroll
        for (int q = 0; q < 4; ++q) { const f32x4 v0 = *(const f32x4*)(bp + 4 * q); bg[q] = (f32x2){v0[0], v0[2]}; bl[q] = (f32x2){v0[1], v0[3]}; }
        const int row0 = u.pm * BM + wr * 64 + fr;
#pragma unroll
        for (int ai = 0; ai < 2; ++ai)
#pragma unroll
            for (int m = 0; m < 4; ++m) {
                float o[8];
#pragma unroll
                for (int q = 0; q < 4; ++q) {
                    const f32x4 ag = acc[ai][0][m][q >> 1], al = acc[ai][1][m][q >> 1];
                    f32x2 gl = (f32x2){ag[2 * (q & 1)], ag[2 * (q & 1) + 1]} * ascale + bg[q], li = (f32x2){al[2 * (q & 1)], al[2 * (q & 1) + 1]} * ascale + bl[q];
                    gl = (f32x2){fminf(gl[0], 7.0f), fminf(gl[1], 7.0f)}; li = (f32x2){fminf(fmaxf(li[0], -7.0f), 7.0f), fminf(fmaxf(li[1], -7.0f), 7.0f)};
                    const f32x2 tt = gl * (-1.702f * 1.4426950408889634f);
                    const f32x2 den = (f32x2){__builtin_amdgcn_exp2f(tt[0]), __builtin_amdgcn_exp2f(tt[1])} + 1.0f;
                    const f32x2 sg = (f32x2){__builtin_amdgcn_rcpf(den[0]), __builtin_amdgcn_rcpf(den[1])};
                    const f32x2 r = (gl * sg) * (li + 1.0f);
                    o[2 * q] = r[0]; o[2 * q + 1] = r[1];
                }
                u32x2 w; w.x = pkfp8x4(o[0] * FP8_SA2, o[1] * FP8_SA2, o[2] * FP8_SA2, o[3] * FP8_SA2); w.y = pkfp8x4(o[4] * FP8_SA2, o[5] * FP8_SA2, o[6] * FP8_SA2, o[7] * FP8_SA2);
                *(u32x2*)((unsigned char*)ACT + (size_t)(row0 + ai * HALF + m * 16) * FF + ac0) = w;
            }
    }
};
struct EpiDown {
    static constexpr bool PERM = true;
    bf16_t* Y; const float* b_down; const int* tile_exp; const int* row_slot; const float* row_gate; int pm0; float ascale;
    __device__ __forceinline__ void operator()(const f32x4 (&acc)[2][2][4][2], const Unit& u, int wr, int wc, int fr, int fq) const {
        { int tq_ = threadIdx.x; asm volatile("" : "+v"(tq_)); fr = tq_ & 15; fq = (tq_ >> 4) & 3; }
        const int e = u.e;
        const int col0 = u.pn * BM + wc * 32 + 8 * fq;
        f32x4 bv[2][2];
#pragma unroll
        for (int bj = 0; bj < 2; ++bj)
#pragma unroll
            for (int n = 0; n < 2; ++n) bv[bj][n] = *(const f32x4*)(b_down + (size_t)e * DM + col0 + bj * HALF + 4 * n);
        const int r0 = (pm0 + u.pm) * BM + wr * 64 + fr;
#pragma unroll
        for (int ai = 0; ai < 2; ++ai)
#pragma unroll
            for (int m = 0; m < 4; ++m) {
                const int r = r0 + ai * HALF + m * 16;
                const int slot = row_slot[r]; const float gt = row_gate[r];
                bf16_t* rowp = Y + (size_t)slot * DM + col0;
#pragma unroll
                for (int bj = 0; bj < 2; ++bj) { const f32x4 v0 = (acc[ai][bj][m][0] * ascale + bv[bj][0]) * gt, v1 = (acc[ai][bj][m][1] * ascale + bv[bj][1]) * gt;
                    u32x4 w; w.x = pkbf(v0[0], v0[1]); w.y = pkbf(v0[2], v0[3]); w.z = pkbf(v1[0], v1[1]); w.w = pkbf(v1[2], v1[3]);
                    *(u32x4*)(rowp + bj * HALF) = w; }
            }
    }
};
}

namespace attn_body {
using bf16 = __hip_bfloat16;
using s16x4 = __attribute__((ext_vector_type(4))) short;
using f32x16 = __attribute__((ext_vector_type(16))) float;
constexpr int D = 64, PZ = 64, PV = 128, PO = 1024;
constexpr int NW = 8, QBLK = 32, QB = QBLK * NW, KVBLK = 64;
__device__ __forceinline__ int crow(int r, int hi) { return (r & 3) + 8 * (r >> 2) + 4 * hi; }
#define SBAR() __builtin_amdgcn_sched_barrier(0)
__device__ __forceinline__ void cmask(f32x16& p0, f32x16& p1, int jb, int qrel, int hi) {
    const float NEG = -INFINITY; const int d = qrel - 64 * jb - 4 * hi;
#pragma unroll
    for (int r = 0; r < 16; ++r) { const int c = (r & 3) + 8 * (r >> 2); if (c > d) p0[r] = NEG; if (c + 32 > d) p1[r] = NEG; }
}
constexpr int NSLOT = 3, SLOTB = 8192;
constexpr int LDS_K = 0, LDS_V = NSLOT * SLOTB, LDS_WS = 2 * NSLOT * SLOTB, LDS_OST = LDS_WS + NW * 64 * 4, LDS_BYTES_A = LDS_OST + NW * 4096;
__device__ __forceinline__ void glds16(const void* gsrc, unsigned lds_dst) { unsigned keep;
    asm volatile("s_mov_b32 %0, m0\n\ts_mov_b32 m0, %2\n\ts_nop 0\n\tglobal_load_lds_dwordx4 %1, off\n\ts_mov_b32 m0, %0" : "=&s"(keep) : "v"(gsrc), "s"(lds_dst) : "memory"); }
__device__ __forceinline__ float max3f(float a, float b, float c) { float r; asm("v_max3_f32 %0, %1, %2, %3" : "=v"(r) : "v"(a), "v"(b), "v"(c)); return r; }
__device__ __forceinline__ float max2f(float a, float b) { float r; asm("v_max_f32_e32 %0, %1, %2" : "=v"(r) : "v"(a), "v"(b)); return r; }
__device__ __forceinline__ float fadd_s(float a, float b) { float r; asm("v_add_f32_e32 %0, %1, %2" : "=v"(r) : "v"(a), "v"(b)); return r; }
__device__ __forceinline__ float fsub_s(float a, float b) { float r; asm("v_sub_f32_e32 %0, %1, %2" : "=v"(r) : "v"(a), "v"(b)); return r; }
__device__ __forceinline__ unsigned cvtpk_s(float lo, float hi) { return pkbf(lo, hi); }
#define WAIT_BAR(N) asm volatile("s_waitcnt vmcnt(" #N ") lgkmcnt(0)\n\ts_barrier" ::: "memory")
__device__ __forceinline__ void qkt(f32x16& p0, f32x16& p1, const char* Kslot, const bf16x8* qr, const f32x16& negm, int r32, int hi) {
    const char* kb = Kslot + hi * 1024 + r32 * 16;
#pragma unroll
    for (int d0 = 0; d0 < 4; ++d0) {
        const bf16x8 b0 = *reinterpret_cast<const bf16x8*>(kb + d0 * 2048);
        const bf16x8 b1 = *reinterpret_cast<const bf16x8*>(kb + d0 * 2048 + 512);
        if (d0 == 0) { p0 = __builtin_amdgcn_mfma_f32_32x32x16_bf16(b0, qr[0], negm, 0, 0, 0); p1 = __builtin_amdgcn_mfma_f32_32x32x16_bf16(b1, qr[0], negm, 0, 0, 0); }
        else { p0 = __builtin_amdgcn_mfma_f32_32x32x16_bf16(b0, qr[d0], p0, 0, 0, 0); p1 = __builtin_amdgcn_mfma_f32_32x32x16_bf16(b1, qr[d0], p1, 0, 0, 0); } }
}
typedef __attribute__((address_space(3))) const char* lds_cptr;
typedef short v4i16_t __attribute__((ext_vector_type(4)));
__device__ __forceinline__ void kload8(bf16x8* kf, lds_cptr kp) {
    kf[0] = *(const __attribute__((address_space(3))) bf16x8*)(kp);        kf[1] = *(const __attribute__((address_space(3))) bf16x8*)(kp + 512);
    kf[2] = *(const __attribute__((address_space(3))) bf16x8*)(kp + 2048); kf[3] = *(const __attribute__((address_space(3))) bf16x8*)(kp + 2560);
    kf[4] = *(const __attribute__((address_space(3))) bf16x8*)(kp + 4096); kf[5] = *(const __attribute__((address_space(3))) bf16x8*)(kp + 4608);
    kf[6] = *(const __attribute__((address_space(3))) bf16x8*)(kp + 6144); kf[7] = *(const __attribute__((address_space(3))) bf16x8*)(kp + 6656);
}
__device__ __forceinline__ void kload2(bf16x8* kf, lds_cptr kp, int j) { kf[2 * j] = *(const __attribute__((address_space(3))) bf16x8*)(kp + j * 2048); kf[2 * j + 1] = *(const __attribute__((address_space(3))) bf16x8*)(kp + j * 2048 + 512); }
__device__ __forceinline__ s16x4 vtr(lds_cptr p) { return __builtin_bit_cast(s16x4, __builtin_amdgcn_ds_read_tr16_b64_v4i16((__attribute__((address_space(3))) v4i16_t*)p)); }
__device__ __forceinline__ float rowmax(const f32x16& p0, const f32x16& p1) {
    float a = max3f(p0[0], p0[1], p1[0]), b = max3f(p0[2], p0[3], p1[1]); a = max3f(a, p1[2], p1[3]);
#pragma unroll
    for (int r = 4; r < 16; r += 4) { a = max3f(a, p0[r], p0[r + 1]); b = max3f(b, p0[r + 2], p0[r + 3]); a = max3f(a, p1[r], p1[r + 1]); b = max3f(b, p1[r + 2], p1[r + 3]); }
    const float m = max2f(a, b);
    auto rr = __builtin_amdgcn_permlane32_swap(__float_as_uint(m), __float_as_uint(m), false, false);
    return max2f(__uint_as_float(rr[0]), __uint_as_float(rr[1]));
}
__device__ __forceinline__ void pv(f32x16* o, int vb, bf16x8 pa0, bf16x8 pa1, bf16x8 pa2, bf16x8 pa3) {
#pragma unroll
    for (int d0 = 0; d0 < 2; ++d0) { s16x4 lo[4], hi[4];
#pragma unroll
        for (int ks = 0; ks < 4; ++ks) {
            asm volatile("ds_read_b64_tr_b16 %0,%1 offset:%c2" : "=&v"(lo[ks]) : "v"(vb), "i"(d0 * 4096 + ks * 1024) : "memory");
            asm volatile("ds_read_b64_tr_b16 %0,%1 offset:%c2" : "=&v"(hi[ks]) : "v"(vb), "i"(d0 * 4096 + ks * 1024 + 512) : "memory"); }
        asm volatile("s_waitcnt lgkmcnt(0)" ::: "memory"); SBAR();
#define PK(k) (bf16x8){lo[k][0], lo[k][1], lo[k][2], lo[k][3], hi[k][0], hi[k][1], hi[k][2], hi[k][3]}
        o[d0] = __builtin_amdgcn_mfma_f32_32x32x16_bf16(pa0, PK(0), o[d0], 0, 0, 0);
        o[d0] = __builtin_amdgcn_mfma_f32_32x32x16_bf16(pa1, PK(1), o[d0], 0, 0, 0);
        o[d0] = __builtin_amdgcn_mfma_f32_32x32x16_bf16(pa2, PK(2), o[d0], 0, 0, 0);
        o[d0] = __builtin_amdgcn_mfma_f32_32x32x16_bf16(pa3, PK(3), o[d0], 0, 0, 0);
#undef PK
    }
}
#define ATTN_STORE16(p, v) (*(u32x4*)(p) = (v))
template <int THRL> __device__ __forceinline__ void attn_unit(int qb, const bf16* Qh, const bf16* __restrict__ Kh, const bf16* __restrict__ Vh, bf16* Oh, char* shm) {
    const int tid = threadIdx.x; int lane = tid & 63; asm volatile("" : "+v"(lane));
    const int r32 = lane & 31, hi = lane >> 5; const int wid = __builtin_amdgcn_readfirstlane(tid >> 6);
    const int q0 = qb * QB;
    const bf16* Qw = Qh + (long)(q0 + wid * QBLK) * PZ;
    const unsigned lds0 = (unsigned)(uintptr_t)shm;
    float* wsf = (float*)(shm + LDS_WS) + wid * 64;
    const bf16* ksrc = Kh + (long)lane * PZ + wid * 8;
    const bf16* vsrc = Vh + (long)(16 * (wid & 3) + (lane >> 2)) * PV + (wid >> 2) * 32 + (lane & 3) * 8;
    const unsigned kdst = lds0 + LDS_K + wid * 1024, vdst = lds0 + LDS_V + wid * 1024;
#define DMA_K(t, slot) glds16(ksrc + (long)(t) * KVBLK * PZ, (unsigned)__builtin_amdgcn_readfirstlane(kdst + (slot)))
#define DMA_V(t, slot) glds16(vsrc + (long)(t) * KVBLK * PV, (unsigned)__builtin_amdgcn_readfirstlane(vdst + (slot)))
    const int vb0 = (int)(lds0 + LDS_V) + ((lane >> 4) & 1) * 32 + (lane & 3) * 8 + (4 * hi + ((lane & 15) >> 2)) * 64;
    const char* Kbase = shm + LDS_K; bf16x8 kf[8];
    const lds_cptr shm3 = (lds_cptr)shm; const lds_cptr kp0 = shm3 + LDS_K + hi * 1024 + r32 * 16; const lds_cptr vp0 = shm3 + LDS_V + ((lane >> 4) & 1) * 32 + (lane & 3) * 8 + (4 * hi + ((lane & 15) >> 2)) * 64;
    const int NT = (q0 + QB) / KVBLK;
    DMA_K(0, 0); DMA_V(0, 0); DMA_K(1, SLOTB);
    bf16x8 qr[4];
#pragma unroll
    for (int d0 = 0; d0 < 4; ++d0) qr[d0] = *reinterpret_cast<const bf16x8*>(&Qw[(long)r32 * PZ + d0 * 16 + hi * 8]);
    float mhat = 0.f, l_reg = 0.f; f32x16 o[2]; o[0] = f32x16{}; o[1] = f32x16{}; f32x16 negm = f32x16{}; asm volatile("" : "+v"(negm));
    const int qrel = wid * QBLK + r32;
#define CMASK(P0, P1, t) do { int jb_ = (t) - (NT - 4); if (jb_ >= 0) cmask(P0, P1, jb_, qrel, hi); } while (0)
    bool resc = false;
#define START(P0, P1) do { const float rm = rowmax(P0, P1); resc = false; \
    { const float dl = rm; mhat = fadd_s(mhat, dl); \
      _Pragma("unroll") for (int r = 0; r < 16; ++r) { P0[r] = fsub_s(P0[r], dl); P1[r] = fsub_s(P1[r], dl); } \
      _Pragma("unroll") for (int r = 0; r < 16; ++r) negm[r] = -mhat; asm volatile("" : "+v"(negm)); } \
    _Pragma("unroll") for (int r = 0; r < 16; ++r) P0[r] = __builtin_amdgcn_exp2f(P0[r]); } while (0)
#define RESC() do { if (resc) { asm volatile("s_waitcnt lgkmcnt(0)" ::: "memory"); \
      _Pragma("unroll") for (int d_ = 0; d_ < 2; ++d_) _Pragma("unroll") for (int r = 0; r < 16; ++r) o[d_][r] *= wsf[crow(r, hi)]; } } while (0)
    f32x16 pA0, pA1, pB0, pB1;
    int sl_prev = 0, sl_cur = 0, sl_next = SLOTB;
#define ROT() do { sl_prev = sl_cur; sl_cur = sl_next; sl_next = (sl_next == (NSLOT - 1) * SLOTB) ? 0 : sl_next + SLOTB; } while (0)
    DMA_K(2, 2 * SLOTB);
    WAIT_BAR(3);
    qkt(pA0, pA1, Kbase, qr, negm, r32, hi); asm volatile("s_nop 15\n\ts_nop 7" : "+v"(pA0), "+v"(pA1)); CMASK(pA0, pA1, 0);
    START(pA0, pA1);
    _Pragma("unroll") for (int r = 0; r < 16; ++r) pA1[r] = __builtin_amdgcn_exp2f(pA1[r]);
    WAIT_BAR(0);
    DMA_K(3, 0); DMA_V(1, SLOTB);
    ROT();
    kload8(kf, kp0 + sl_cur);
    WAIT_BAR(2);
    s16x4 vlo[8], vhi[8]; u32x4 pw0, pw1, pw2, pw3;
#define PKW(P, B) cvtpk_s(P[B], P[B + 1])
#define PAF(k) __builtin_bit_cast(bf16x8, pw##k)
#define VFR(i) (bf16x8){vlo[i][0], vlo[i][1], vlo[i][2], vlo[i][3], vhi[i][0], vhi[i][1], vhi[i][2], vhi[i][3]}
#define PIN(x) asm volatile("" : "+v"(x))
#define MX3(a, b, c) __builtin_fmaxf(__builtin_fmaxf((a), (b)), (c))
#define GAPA(MF, A0, A1, A2, A3, W0, W1, PW) do { MF; sacc += A0; sacc += A1; sacc += A2; sacc += A3; PIN(sacc); W0; W1; PIN(PW); SBAR(); } while (0)
#define EX(v) __builtin_amdgcn_exp2f(v)
#define GAPB(MF, X, B) do { MF; X[B] = EX(X[B]); X[B + 1] = EX(X[B + 1]); X[B + 2] = EX(X[B + 2]); X[B + 3] = EX(X[B + 3]); PIN(X); SBAR(); } while (0)
#define VRD(i) do { vlo[i] = vtr(vp_ + (((i) >> 2) * 4096 + ((i) & 3) * 1024)); vhi[i] = vtr(vp_ + (((i) >> 2) * 4096 + ((i) & 3) * 1024 + 512)); } while (0)
#define KRD(G, j) do { if (G) { kload2(kf, kp0 + sl_next, j); SBAR(); } } while (0)
#define STEP(C0, C1, P0, P1, t, GK, GV, GL) do { SBAR(); \
    const lds_cptr vp_ = vp0 + sl_prev; \
    VRD(0); SBAR(); float sacc = (P0[0] + P0[1]); \
    GAPA(C0 = __builtin_amdgcn_mfma_f32_32x32x16_bf16(kf[0], qr[0], negm, 0, 0, 0), P0[2], P0[3], P0[4], P0[5],     pw0[0] = PKW(P0, 0), pw0[1] = PKW(P0, 2), pw0); \
    VRD(4); SBAR(); GAPA(C1 = __builtin_amdgcn_mfma_f32_32x32x16_bf16(kf[1], qr[0], negm, 0, 0, 0), P0[6], P0[7], P0[8], P0[9],     pw0[2] = PKW(P0, 4), pw0[3] = PKW(P0, 6), pw0); \
    VRD(1); SBAR(); GAPA(C0 = __builtin_amdgcn_mfma_f32_32x32x16_bf16(kf[2], qr[1], C0, 0, 0, 0),   P0[10], P0[11], P0[12], P0[13], pw1[0] = PKW(P0, 8), pw1[1] = PKW(P0, 10), pw1); \
    VRD(5); SBAR(); GAPA(C1 = __builtin_amdgcn_mfma_f32_32x32x16_bf16(kf[3], qr[1], C1, 0, 0, 0),   P0[14], P0[15], P1[0], P1[1],   pw1[2] = PKW(P0, 12), pw1[3] = PKW(P0, 14), pw1); \
    VRD(2); SBAR(); GAPA(C0 = __builtin_amdgcn_mfma_f32_32x32x16_bf16(kf[4], qr[2], C0, 0, 0, 0),   P1[2], P1[3], P1[4], P1[5],     pw2[0] = PKW(P1, 0), pw2[1] = PKW(P1, 2), pw2); \
    VRD(6); SBAR(); GAPA(C1 = __builtin_amdgcn_mfma_f32_32x32x16_bf16(kf[5], qr[2], C1, 0, 0, 0),   P1[6], P1[7], P1[8], P1[9],     pw2[2] = PKW(P1, 4), pw2[3] = PKW(P1, 6), pw2); \
    VRD(3); SBAR(); GAPA(C0 = __builtin_amdgcn_mfma_f32_32x32x16_bf16(kf[6], qr[3], C0, 0, 0, 0),   P1[10], P1[11], P1[12], P1[13], pw3[0] = PKW(P1, 8), pw3[1] = PKW(P1, 10), pw3); \
    VRD(7); SBAR(); GAPA(C1 = __builtin_amdgcn_mfma_f32_32x32x16_bf16(kf[7], qr[3], C1, 0, 0, 0),   P1[14], P1[15], 0.f, 0.f,       pw3[2] = PKW(P1, 12), pw3[3] = PKW(P1, 14), pw3); \
    l_reg += sacc; \
    if (GK) { DMA_K((t) + 3, sl_cur); } if (GV) { DMA_V((t) + 1, sl_next); } \
    CMASK(C0, C1, t); \
    { float a = MX3(C0[0], C0[1], C1[0]), b = MX3(C0[2], C0[3], C1[1]); a = MX3(a, C1[2], C1[3]); \
      _Pragma("unroll") for (int r = 4; r < 16; r += 4) { a = MX3(a, C0[r], C0[r + 1]); b = MX3(b, C0[r + 2], C0[r + 3]); a = MX3(a, C1[r], C1[r + 1]); b = MX3(b, C1[r + 2], C1[r + 3]); } \
      float rm = __builtin_fmaxf(a, b); { auto rr = __builtin_amdgcn_permlane32_swap(__float_as_uint(rm), __float_as_uint(rm), false, false); rm = __builtin_fmaxf(__uint_as_float(rr[0]), __uint_as_float(rr[1])); } \
      resc = false; \
      if (__builtin_expect(__any(rm > (float)THRL), 0)) { const float dl = __builtin_fmaxf(rm, 0.f); mhat += dl; \
        _Pragma("unroll") for (int r = 0; r < 16; ++r) { C0[r] -= dl; C1[r] -= dl; } \
        _Pragma("unroll") for (int r = 0; r < 16; ++r) negm[r] = -mhat; asm volatile("" : "+v"(negm)); \
        const float f = __builtin_amdgcn_exp2f(-dl); l_reg *= f; if (hi == 0) wsf[r32] = f; resc = true; } } \
    SBAR(); \
    GAPB(o[0] = __builtin_amdgcn_mfma_f32_32x32x16_bf16(PAF(0), VFR(0), o[0], 0, 0, 0), C0, 0); \
    GAPB(o[1] = __builtin_amdgcn_mfma_f32_32x32x16_bf16(PAF(0), VFR(4), o[1], 0, 0, 0), C0, 4); \
    KRD(GL, 0); GAPB(o[0] = __builtin_amdgcn_mfma_f32_32x32x16_bf16(PAF(1), VFR(1), o[0], 0, 0, 0), C0, 8); \
    KRD(GL, 1); GAPB(o[1] = __builtin_amdgcn_mfma_f32_32x32x16_bf16(PAF(1), VFR(5), o[1], 0, 0, 0), C0, 12); \
    KRD(GL, 2); GAPB(o[0] = __builtin_amdgcn_mfma_f32_32x32x16_bf16(PAF(2), VFR(2), o[0], 0, 0, 0), C1, 0); \
    KRD(GL, 3); GAPB(o[1] = __builtin_amdgcn_mfma_f32_32x32x16_bf16(PAF(2), VFR(6), o[1], 0, 0, 0), C1, 4); \
    GAPB(o[0] = __builtin_amdgcn_mfma_f32_32x32x16_bf16(PAF(3), VFR(3), o[0], 0, 0, 0), C1, 8); \
    GAPB(o[1] = __builtin_amdgcn_mfma_f32_32x32x16_bf16(PAF(3), VFR(7), o[1], 0, 0, 0), C1, 12); \
    } while (0)
    int t = 1;
#undef CMASK
#define CMASK(P0, P1, t) do {} while (0)
    for (; t + 5 < NT; t += 2) {
        STEP(pB0, pB1, pA0, pA1, t, true, true, true);     WAIT_BAR(2); RESC(); ROT();
        STEP(pA0, pA1, pB0, pB1, t + 1, true, true, true); WAIT_BAR(2); RESC(); ROT();
    }
#undef CMASK
#define CMASK(P0, P1, t) do { int jb_ = (t) - (NT - 4); if (jb_ >= 0) cmask(P0, P1, jb_, qrel, hi); } while (0)
#define ENDW(tt) do { if ((tt) + 3 < NT) { WAIT_BAR(2); } else if ((tt) + 2 < NT) { WAIT_BAR(1); } else { WAIT_BAR(0); } } while (0)
    for (; t + 1 < NT; t += 2) {
        STEP(pB0, pB1, pA0, pA1, t, (t + 3 < NT), (t + 1 < NT), (t + 1 < NT));       ENDW(t);     RESC(); ROT();
        STEP(pA0, pA1, pB0, pB1, t + 1, (t + 4 < NT), (t + 2 < NT), (t + 2 < NT));   ENDW(t + 1); RESC(); ROT();
    }
    STEP(pB0, pB1, pA0, pA1, NT - 1, false, false, false); RESC();
    { float sacc = pB0[0] + pB0[1]; _Pragma("unroll") for (int r = 2; r < 16; ++r) sacc += pB0[r]; _Pragma("unroll") for (int r = 0; r < 16; ++r) sacc += pB1[r]; l_reg += sacc;
      pw0 = (u32x4){PKW(pB0, 0), PKW(pB0, 2), PKW(pB0, 4), PKW(pB0, 6)}; pw1 = (u32x4){PKW(pB0, 8), PKW(pB0, 10), PKW(pB0, 12), PKW(pB0, 14)}; pw2 = (u32x4){PKW(pB1, 0), PKW(pB1, 2), PKW(pB1, 4), PKW(pB1, 6)}; pw3 = (u32x4){PKW(pB1, 8), PKW(pB1, 10), PKW(pB1, 12), PKW(pB1, 14)};
      SBAR(); pv(o, vb0 + sl_cur, PAF(0), PAF(1), PAF(2), PAF(3)); }
#undef PKW
#undef PAF
#undef VFR
#undef PIN
#undef MX3
#undef GAPA
#undef GAPB
#undef EX
#undef VRD
#undef KRD
#undef STEP
#undef ENDW
    { auto rr = __builtin_amdgcn_permlane32_swap(__float_as_uint(l_reg), __float_as_uint(l_reg), false, false); l_reg = __uint_as_float(rr[0]) + __uint_as_float(rr[1]); }
    int lane2 = lane; asm volatile("" : "+v"(lane2));
    const int r32e = lane2 & 31, hie = lane2 >> 5;
    if (hie == 0) wsf[32 + r32e] = l_reg; asm volatile("s_waitcnt lgkmcnt(0)" ::: "memory");
    float rli[16];
#pragma unroll
    for (int r = 0; r < 16; ++r) rli[r] = __builtin_amdgcn_rcpf(wsf[32 + crow(r, hie)]);
    bf16* Ow = Oh + (long)(q0 + wid * QBLK) * PO;
    { bf16* stg = (bf16*)(shm + LDS_OST) + wid * 2048;
#pragma unroll
      for (int r = 0; r < 16; ++r) { const int orow = crow(r, hie);
#pragma unroll
        for (int d0 = 0; d0 < 2; ++d0) stg[orow * 64 + d0 * 32 + r32e] = __float2bfloat16(o[d0][r] * rli[r]); }
      asm volatile("s_waitcnt lgkmcnt(0)" ::: "memory");
#pragma unroll
      for (int i = 0; i < 4; ++i) { const int row = i * 8 + (lane2 >> 3), ch = lane2 & 7; const u32x4 v = *(const u32x4*)(stg + row * 64 + ch * 8); ATTN_STORE16(Ow + (long)row * PO + ch * 8, v); } }
    asm volatile("s_waitcnt lgkmcnt(0)\n\ts_barrier" ::: "memory");
#undef DMA_K
#undef DMA_V
#undef CMASK
#undef START
#undef RESC
#undef ROT
}

constexpr int A2_SLOT = 24576, A2_K = 0, A2_V = 8192, A2_WS = 4 * A2_SLOT, A2_OST = 0, A2_BYTES = A2_WS + NW * 256;
template <int THRL> __device__ __forceinline__ void attn2_unit(int qb, const bf16* Qh, const bf16* __restrict__ Kh, const bf16* __restrict__ Vh, bf16* Oh, char* shm, unsigned* prb = nullptr) {
    const int tid = threadIdx.x; int lane = tid & 63; asm volatile("" : "+v"(lane));
    const int r32 = lane & 31, hi = lane >> 5; const int wid = __builtin_amdgcn_readfirstlane(tid >> 6);
    const int q0 = qb * QB;
    const bf16* Qw = Qh + (long)(q0 + wid * QBLK) * PZ;
    const unsigned lds0 = (unsigned)(uintptr_t)shm;
    float* wsf = (float*)(shm + A2_WS) + wid * 64;
    bf16x8 qr[4];
#pragma unroll
    for (int d0 = 0; d0 < 4; ++d0) qr[d0] = *reinterpret_cast<const bf16x8*>(&Qw[(long)r32 * PZ + d0 * 16 + hi * 8]);
    const bf16* ksrc = Kh + (long)lane * PZ + wid * 8;
    const bf16* vsrc = Vh + (long)(16 * (wid & 3) + (lane >> 2)) * PV + (wid >> 2) * 32 + (lane & 3) * 8;
    const unsigned kdst = lds0 + A2_K + wid * 1024, vdst = lds0 + A2_V + wid * 1024;
#define A2_DMA(t, sl) do { glds16(ksrc + (long)(t) * KVBLK * PZ, (unsigned)__builtin_amdgcn_readfirstlane(kdst + (sl) * A2_SLOT)); \
        glds16(vsrc + (long)(t) * KVBLK * PV, (unsigned)__builtin_amdgcn_readfirstlane(vdst + (sl) * A2_SLOT)); \
        glds16(vsrc + (long)(t) * KVBLK * PV + 64, (unsigned)__builtin_amdgcn_readfirstlane(vdst + (sl) * A2_SLOT + 8192)); } while (0)
#define A2_WAITB(n1, n2) do { if (n2) asm volatile("s_waitcnt vmcnt(6)\n\ts_barrier" ::: "memory"); else if (n1) asm volatile("s_waitcnt vmcnt(3)\n\ts_barrier" ::: "memory"); else asm volatile("s_waitcnt vmcnt(0)\n\ts_barrier" ::: "memory"); } while (0)
    const int NT = (q0 + QB) / KVBLK;
    A2_DMA(0, 0); A2_DMA(1, 1); A2_DMA(2, 2);
    asm volatile("" : "+v"(qr[0]), "+v"(qr[1]), "+v"(qr[2]), "+v"(qr[3]));
    const lds_cptr shm3 = (lds_cptr)shm;
    const lds_cptr kp0 = shm3 + A2_K + hi * 1024 + r32 * 16;
    const lds_cptr vp0 = shm3 + A2_V + ((lane >> 4) & 1) * 32 + (lane & 3) * 8 + (4 * hi + ((lane & 15) >> 2)) * 64;
    float mhat = 0.f, l_reg = 0.f; f32x16 o[4]; o[0] = f32x16{}; o[1] = f32x16{}; o[2] = f32x16{}; o[3] = f32x16{}; f32x16 negm = f32x16{};
    const int qrel = wid * QBLK + r32;
#if MK_PROBE
    const unsigned long long pt0 = __builtin_amdgcn_s_memrealtime();
#endif
    for (int t = 0; t < NT; ++t) {
        A2_WAITB(t + 1 < NT, t + 2 < NT);
        if (t + 3 < NT) A2_DMA(t + 3, (t + 3) & 3);
        const int slot = t & 3;
        const lds_cptr kp = kp0 + slot * A2_SLOT; const lds_cptr vp = vp0 + slot * A2_SLOT;
        f32x16 p0, p1;
        {   bf16x8 kb[8];
#pragma unroll
            for (int d0 = 0; d0 < 4; ++d0) { kb[2 * d0] = *(const __attribute__((address_space(3))) bf16x8*)(kp + d0 * 2048); kb[2 * d0 + 1] = *(const __attribute__((address_space(3))) bf16x8*)(kp + d0 * 2048 + 512); }
            __builtin_amdgcn_sched_barrier(0);
            p0 = __builtin_amdgcn_mfma_f32_32x32x16_bf16(kb[0], qr[0], negm, 0, 0, 0); p1 = __builtin_amdgcn_mfma_f32_32x32x16_bf16(kb[1], qr[0], negm, 0, 0, 0);
#pragma unroll
            for (int d0 = 1; d0 < 4; ++d0) { p0 = __builtin_amdgcn_mfma_f32_32x32x16_bf16(kb[2 * d0], qr[d0], p0, 0, 0, 0); p1 = __builtin_amdgcn_mfma_f32_32x32x16_bf16(kb[2 * d0 + 1], qr[d0], p1, 0, 0, 0); }
        }
        { const int jb = t - (NT - 4); if (jb >= 0) cmask(p0, p1, jb, qrel, hi); }
        float rm;
        { float a = fmaxf(fmaxf(p0[0], p0[1]), p1[0]), b = fmaxf(fmaxf(p0[2], p0[3]), p1[1]); a = fmaxf(fmaxf(a, p1[2]), p1[3]);
#pragma unroll
          for (int r = 4; r < 16; r += 4) { a = fmaxf(fmaxf(a, p0[r]), p0[r + 1]); b = fmaxf(fmaxf(b, p0[r + 2]), p0[r + 3]); a = fmaxf(fmaxf(a, p1[r]), p1[r + 1]); b = fmaxf(fmaxf(b, p1[r + 2]), p1[r + 3]); }
          rm = fmaxf(a, b); auto rr = __builtin_amdgcn_permlane32_swap(__float_as_uint(rm), __float_as_uint(rm), false, false); rm = fmaxf(__uint_as_float(rr[0]), __uint_as_float(rr[1])); }
        if (t == 0 || __any(rm > (float)THRL)) {
            const float dl = (t == 0) ? rm : fmaxf(rm, 0.f); mhat += dl;
#pragma unroll
            for (int r = 0; r < 16; ++r) { p0[r] -= dl; p1[r] -= dl; negm[r] = -mhat; }
            const float f = __builtin_amdgcn_exp2f(-dl); l_reg *= f;
            if (t > 0) {
                if (hi == 0) wsf[r32] = f;
                asm volatile("s_waitcnt lgkmcnt(0)" ::: "memory");
#pragma unroll
                for (int r = 0; r < 16; ++r) { const float fr_ = wsf[crow(r, hi)];
#pragma unroll
                    for (int d_ = 0; d_ < 4; ++d_) o[d_][r] *= fr_; }
                asm volatile("s_waitcnt lgkmcnt(0)" ::: "memory");
            }
        }
        float sacc = 0.f;
#pragma unroll
        for (int r = 0; r < 16; ++r) { p0[r] = __builtin_amdgcn_exp2f(p0[r]); p1[r] = __builtin_amdgcn_exp2f(p1[r]); sacc += p0[r] + p1[r]; }
        l_reg += sacc;
        u32x4 pw[4];
        pw[0] = (u32x4){pkbf(p0[0], p0[1]), pkbf(p0[2], p0[3]), pkbf(p0[4], p0[5]), pkbf(p0[6], p0[7])};
        pw[1] = (u32x4){pkbf(p0[8], p0[9]), pkbf(p0[10], p0[11]), pkbf(p0[12], p0[13]), pkbf(p0[14], p0[15])};
        pw[2] = (u32x4){pkbf(p1[0], p1[1]), pkbf(p1[2], p1[3]), pkbf(p1[4], p1[5]), pkbf(p1[6], p1[7])};
        pw[3] = (u32x4){pkbf(p1[8], p1[9]), pkbf(p1[10], p1[11]), pkbf(p1[12], p1[13]), pkbf(p1[14], p1[15])};
        asm volatile("" : "+v"(pw[0]), "+v"(pw[1]), "+v"(pw[2]), "+v"(pw[3]));
        {   s16x4 vlo[2][4], vhh[2][4];
#pragma unroll
            for (int d0 = 0; d0 < 4; ++d0) { vlo[0][d0] = vtr(vp + d0 * 4096); vhh[0][d0] = vtr(vp + d0 * 4096 + 512); }
            __builtin_amdgcn_sched_barrier(0);
#pragma unroll
            for (int ks = 0; ks < 4; ++ks) {
                if (ks + 1 < 4) {
#pragma unroll
                    for (int d0 = 0; d0 < 4; ++d0) { vlo[(ks + 1) & 1][d0] = vtr(vp + d0 * 4096 + (ks + 1) * 1024); vhh[(ks + 1) & 1][d0] = vtr(vp + d0 * 4096 + (ks + 1) * 1024 + 512); }
                }
                __builtin_amdgcn_sched_barrier(0);
#pragma unroll
                for (int d0 = 0; d0 < 4; ++d0) {
                    const s16x4 lo = vlo[ks & 1][d0], hh = vhh[ks & 1][d0];
                    const bf16x8 vf = (bf16x8){lo[0], lo[1], lo[2], lo[3], hh[0], hh[1], hh[2], hh[3]};
                    o[d0] = __builtin_amdgcn_mfma_f32_32x32x16_bf16(__builtin_bit_cast(bf16x8, pw[ks]), vf, o[d0], 0, 0, 0);
                }
                __builtin_amdgcn_sched_barrier(0);
            }
        }
    }
#if MK_PROBE
    if (prb && tid == 0) { atomicAdd(prb, (unsigned)(__builtin_amdgcn_s_memrealtime() - pt0)); atomicAdd(prb + 1, (unsigned)NT); }
#endif
    asm volatile("s_waitcnt lgkmcnt(0)\n\ts_barrier" ::: "memory");
    { auto rr = __builtin_amdgcn_permlane32_swap(__float_as_uint(l_reg), __float_as_uint(l_reg), false, false); l_reg = __uint_as_float(rr[0]) + __uint_as_float(rr[1]); }
    if (hi == 0) wsf[32 + r32] = l_reg;
    asm volatile("s_waitcnt lgkmcnt(0)" ::: "memory");
    bf16* stg = (bf16*)(shm + A2_OST) + wid * 4096;
#pragma unroll
    for (int r = 0; r < 16; ++r) { const int orow = crow(r, hi); const float rl = __builtin_amdgcn_rcpf(wsf[32 + orow]);
#pragma unroll
        for (int d0 = 0; d0 < 4; ++d0) stg[orow * 128 + d0 * 32 + r32] = __float2bfloat16(o[d0][r] * rl); }
    asm volatile("s_waitcnt lgkmcnt(0)" ::: "memory");
    bf16* Ow = Oh + (long)(q0 + wid * QBLK) * PO;
#pragma unroll
    for (int i = 0; i < 8; ++i) { const int row = i * 4 + (lane >> 4), ch = lane & 15; const u32x4 v = *(const u32x4*)(stg + row * 128 + ch * 8); *(u32x4*)(Ow + (long)row * PO + ch * 8) = v; }
    asm volatile("s_waitcnt lgkmcnt(0)\n\ts_barrier" ::: "memory");
#undef A2_DMA
#undef A2_WAITB
}

template <int THRL> __device__ __forceinline__ void attn3_unit(int qb, const bf16* Qh, const bf16* __restrict__ Kh, const bf16* __restrict__ Vh, bf16* Oh, char* shm, unsigned* prb = nullptr) {
    const int tid = threadIdx.x; int lane = tid & 63; asm volatile("" : "+v"(lane));
    const int r32 = lane & 31, hi = lane >> 5; const int wid = __builtin_amdgcn_readfirstlane(tid >> 6);
    const int q0 = qb * QB;
    const bf16* Qw = Qh + (long)(q0 + wid * QBLK) * PZ;
    const unsigned lds0 = (unsigned)(uintptr_t)shm;
    float* wsf = (float*)(shm + A2_WS) + wid * 64;
    bf16x8 qr[4];
#pragma unroll
    for (int d0 = 0; d0 < 4; ++d0) qr[d0] = *reinterpret_cast<const bf16x8*>(&Qw[(long)r32 * PZ + d0 * 16 + hi * 8]);
    const bf16* ksrc = Kh + (long)lane * PZ + wid * 8;
    const bf16* vsrc = Vh + (long)(16 * (wid & 3) + (lane >> 2)) * PV + (wid >> 2) * 32 + (lane & 3) * 8;
    const unsigned kdst = lds0 + A2_K + wid * 1024, vdst = lds0 + A2_V + wid * 1024;
#define A3_DMA(t, sl) do { glds16(ksrc + (long)(t) * KVBLK * PZ, (unsigned)__builtin_amdgcn_readfirstlane(kdst + (sl) * A2_SLOT)); \
        glds16(vsrc + (long)(t) * KVBLK * PV, (unsigned)__builtin_amdgcn_readfirstlane(vdst + (sl) * A2_SLOT)); \
        glds16(vsrc + (long)(t) * KVBLK * PV + 64, (unsigned)__builtin_amdgcn_readfirstlane(vdst + (sl) * A2_SLOT + 8192)); } while (0)
#define A3_SB() __builtin_amdgcn_sched_barrier(0)
#define A3_MFMA(A_, B_, C_) __builtin_amdgcn_mfma_f32_32x32x16_bf16((A_), (B_), (C_), 0, 0, 0)
#define A3_KLD(D0) (*(const __attribute__((address_space(3))) bf16x8*)(kpn + (D0) * 2048))
#define A3_KLD2(D0) (*(const __attribute__((address_space(3))) bf16x8*)(kpn + (D0) * 2048 + 512))
#define A3_VLD(BUF, KS) do { _Pragma("unroll") for (int d_ = 0; d_ < 4; ++d_) { vlo[BUF][d_] = vtr(vp + d_ * 4096 + (KS) * 1024); vhh[BUF][d_] = vtr(vp + d_ * 4096 + (KS) * 1024 + 512); } } while (0)
#define A3_VF(BUF, D0) ((bf16x8){vlo[BUF][D0][0], vlo[BUF][D0][1], vlo[BUF][D0][2], vlo[BUF][D0][3], vhh[BUF][D0][0], vhh[BUF][D0][1], vhh[BUF][D0][2], vhh[BUF][D0][3]})
#define A3_EXP2(P, I) do { P[2 * (I)] = __builtin_amdgcn_exp2f(P[2 * (I)]); P[2 * (I) + 1] = __builtin_amdgcn_exp2f(P[2 * (I) + 1]); sacc += P[2 * (I)] + P[2 * (I) + 1]; } while (0)
#define A3_ROWMAX(P0, P1, RM) do { float a_ = fmaxf(fmaxf(P0[0], P0[1]), P1[0]), b_ = fmaxf(fmaxf(P0[2], P0[3]), P1[1]); a_ = fmaxf(fmaxf(a_, P1[2]), P1[3]); \
        _Pragma("unroll") for (int r_ = 4; r_ < 16; r_ += 4) { a_ = fmaxf(fmaxf(a_, P0[r_]), P0[r_ + 1]); b_ = fmaxf(fmaxf(b_, P0[r_ + 2]), P0[r_ + 3]); a_ = fmaxf(fmaxf(a_, P1[r_]), P1[r_ + 1]); b_ = fmaxf(fmaxf(b_, P1[r_ + 2]), P1[r_ + 3]); } \
        RM = fmaxf(a_, b_); auto rr_ = __builtin_amdgcn_permlane32_swap(__float_as_uint(RM), __float_as_uint(RM), false, false); RM = fmaxf(__uint_as_float(rr_[0]), __uint_as_float(rr_[1])); } while (0)
    const int NT = (q0 + QB) / KVBLK;
    A3_DMA(0, 0); A3_DMA(1, 1); A3_DMA(2, 2);
    asm volatile("" : "+v"(qr[0]), "+v"(qr[1]), "+v"(qr[2]), "+v"(qr[3]));
    const lds_cptr shm3 = (lds_cptr)shm;
    const lds_cptr kp0 = shm3 + A2_K + hi * 1024 + r32 * 16;
    const lds_cptr vp0 = shm3 + A2_V + ((lane >> 4) & 1) * 32 + (lane & 3) * 8 + (4 * hi + ((lane & 15) >> 2)) * 64;
    float mhat = 0.f, l_reg = 0.f; f32x16 o[4]; o[0] = f32x16{}; o[1] = f32x16{}; o[2] = f32x16{}; o[3] = f32x16{}; f32x16 negm = f32x16{};
    const int qrel = wid * QBLK + r32;
    f32x16 p0, p1; float rm;
    asm volatile("s_waitcnt vmcnt(6)\n\ts_barrier" ::: "memory");
    {   const lds_cptr kpn = kp0;
        p0 = A3_MFMA(A3_KLD(0), qr[0], negm); p1 = A3_MFMA(A3_KLD2(0), qr[0], negm);
#pragma unroll
        for (int d0 = 1; d0 < 4; ++d0) { p0 = A3_MFMA(A3_KLD(d0), qr[d0], p0); p1 = A3_MFMA(A3_KLD2(d0), qr[d0], p1); }
        if (NT == 4) cmask(p0, p1, 0, qrel, hi);
        A3_ROWMAX(p0, p1, rm);
        mhat = rm;
#pragma unroll
        for (int r = 0; r < 16; ++r) { p0[r] -= rm; p1[r] -= rm; negm[r] = -mhat; }
        rm = 0.f;
    }
#if MK_PROBE
    const unsigned long long pt0 = __builtin_amdgcn_s_memrealtime();
#endif
    for (int t = 0; t < NT; ++t) {
        if (t + 2 < NT) asm volatile("s_waitcnt vmcnt(3)\n\ts_barrier" ::: "memory"); else asm volatile("s_waitcnt vmcnt(0)\n\ts_barrier" ::: "memory");
        if (t + 3 < NT) A3_DMA(t + 3, (t + 3) & 3);
        const lds_cptr kpn = kp0 + ((t + 1) & 3) * A2_SLOT; const lds_cptr vp = vp0 + (t & 3) * A2_SLOT;
        if (__any(rm > (float)THRL)) {
            const float dl = fmaxf(rm, 0.f); mhat += dl;
#pragma unroll
            for (int r = 0; r < 16; ++r) { p0[r] -= dl; p1[r] -= dl; negm[r] = -mhat; }
            const float f = __builtin_amdgcn_exp2f(-dl); l_reg *= f;
            if (hi == 0) wsf[r32] = f;
            asm volatile("s_waitcnt lgkmcnt(0)" ::: "memory");
#pragma unroll
            for (int r = 0; r < 16; ++r) { const float fr_ = wsf[crow(r, hi)];
#pragma unroll
                for (int d_ = 0; d_ < 4; ++d_) o[d_][r] *= fr_; }
            asm volatile("s_waitcnt lgkmcnt(0)" ::: "memory");
        }
        float sacc = 0.f; f32x16 n0, n1; u32x4 pw0, pw1, pw2, pw3; s16x4 vlo[2][4], vhh[2][4];
        {   bf16x8 ka0 = A3_KLD(0), ka1 = A3_KLD2(0), ka2 = A3_KLD(1), ka3 = A3_KLD2(1);
            A3_VLD(0, 0);
            A3_SB();
            n0 = A3_MFMA(ka0, qr[0], negm); A3_EXP2(p0, 0); A3_SB();
            n1 = A3_MFMA(ka1, qr[0], negm); A3_EXP2(p0, 1); A3_SB();
            bf16x8 kb0 = A3_KLD(2), kb1 = A3_KLD2(2), kb2 = A3_KLD(3), kb3 = A3_KLD2(3);
            n0 = A3_MFMA(ka2, qr[1], n0); A3_EXP2(p0, 2); A3_SB();
            n1 = A3_MFMA(ka3, qr[1], n1); A3_EXP2(p0, 3); pw0 = (u32x4){pkbf(p0[0], p0[1]), pkbf(p0[2], p0[3]), pkbf(p0[4], p0[5]), pkbf(p0[6], p0[7])}; A3_SB();
            n0 = A3_MFMA(kb0, qr[2], n0); A3_EXP2(p0, 4); A3_SB();
            n1 = A3_MFMA(kb1, qr[2], n1); A3_EXP2(p0, 5); A3_SB();
            n0 = A3_MFMA(kb2, qr[3], n0); A3_EXP2(p0, 6); A3_SB();
            n1 = A3_MFMA(kb3, qr[3], n1); A3_EXP2(p0, 7); pw1 = (u32x4){pkbf(p0[8], p0[9]), pkbf(p0[10], p0[11]), pkbf(p0[12], p0[13]), pkbf(p0[14], p0[15])}; A3_SB();
        }
        A3_VLD(1, 1); A3_SB();
        o[0] = A3_MFMA(__builtin_bit_cast(bf16x8, pw0), A3_VF(0, 0), o[0]); A3_EXP2(p1, 0); A3_SB();
        o[1] = A3_MFMA(__builtin_bit_cast(bf16x8, pw0), A3_VF(0, 1), o[1]); A3_EXP2(p1, 1); A3_SB();
        o[2] = A3_MFMA(__builtin_bit_cast(bf16x8, pw0), A3_VF(0, 2), o[2]); A3_EXP2(p1, 2); A3_SB();
        o[3] = A3_MFMA(__builtin_bit_cast(bf16x8, pw0), A3_VF(0, 3), o[3]); A3_EXP2(p1, 3); pw2 = (u32x4){pkbf(p1[0], p1[1]), pkbf(p1[2], p1[3]), pkbf(p1[4], p1[5]), pkbf(p1[6], p1[7])}; A3_SB();
        A3_VLD(0, 2); A3_SB();
        o[0] = A3_MFMA(__builtin_bit_cast(bf16x8, pw1), A3_VF(1, 0), o[0]); A3_EXP2(p1, 4); A3_SB();
        o[1] = A3_MFMA(__builtin_bit_cast(bf16x8, pw1), A3_VF(1, 1), o[1]); A3_EXP2(p1, 5); A3_SB();
        o[2] = A3_MFMA(__builtin_bit_cast(bf16x8, pw1), A3_VF(1, 2), o[2]); A3_EXP2(p1, 6); A3_SB();
        o[3] = A3_MFMA(__builtin_bit_cast(bf16x8, pw1), A3_VF(1, 3), o[3]); A3_EXP2(p1, 7); pw3 = (u32x4){pkbf(p1[8], p1[9]), pkbf(p1[10], p1[11]), pkbf(p1[12], p1[13]), pkbf(p1[14], p1[15])}; A3_SB();
        l_reg += sacc;
        A3_VLD(1, 3); A3_SB();
        { const int jb = (t + 1) - (NT - 4); if (jb >= 0 && t + 1 < NT) cmask(n0, n1, jb, qrel, hi); }
        o[0] = A3_MFMA(__builtin_bit_cast(bf16x8, pw2), A3_VF(0, 0), o[0]);
        o[1] = A3_MFMA(__builtin_bit_cast(bf16x8, pw2), A3_VF(0, 1), o[1]);
        o[2] = A3_MFMA(__builtin_bit_cast(bf16x8, pw2), A3_VF(0, 2), o[2]);
        o[3] = A3_MFMA(__builtin_bit_cast(bf16x8, pw2), A3_VF(0, 3), o[3]); A3_SB();
        o[0] = A3_MFMA(__builtin_bit_cast(bf16x8, pw3), A3_VF(1, 0), o[0]);
        o[1] = A3_MFMA(__builtin_bit_cast(bf16x8, pw3), A3_VF(1, 1), o[1]);
        o[2] = A3_MFMA(__builtin_bit_cast(bf16x8, pw3), A3_VF(1, 2), o[2]);
        o[3] = A3_MFMA(__builtin_bit_cast(bf16x8, pw3), A3_VF(1, 3), o[3]);
        A3_ROWMAX(n0, n1, rm);
        p0 = n0; p1 = n1;
        A3_SB();
    }
#if MK_PROBE
    if (prb && tid == 0) { atomicAdd(prb, (unsigned)(__builtin_amdgcn_s_memrealtime() - pt0)); atomicAdd(prb + 1, (unsigned)NT); }
#endif
    asm volatile("s_waitcnt lgkmcnt(0)\n\ts_barrier" ::: "memory");
    { auto rr = __builtin_amdgcn_permlane32_swap(__float_as_uint(l_reg), __float_as_uint(l_reg), false, false); l_reg = __uint_as_float(rr[0]) + __uint_as_float(rr[1]); }
    if (hi == 0) wsf[32 + r32] = l_reg;
    asm volatile("s_waitcnt lgkmcnt(0)" ::: "memory");
    bf16* stg = (bf16*)(shm + A2_OST) + wid * 4096;
#pragma unroll
    for (int r = 0; r < 16; ++r) { const int orow = crow(r, hi); const float rl = __builtin_amdgcn_rcpf(wsf[32 + orow]);
#pragma unroll
        for (int d0 = 0; d0 < 4; ++d0) stg[orow * 128 + d0 * 32 + r32] = __float2bfloat16(o[d0][r] * rl); }
    asm volatile("s_waitcnt lgkmcnt(0)" ::: "memory");
    bf16* Ow = Oh + (long)(q0 + wid * QBLK) * PO;
#pragma unroll
    for (int i = 0; i < 8; ++i) { const int row = i * 4 + (lane >> 4), ch = lane & 15; const u32x4 v = *(const u32x4*)(stg + row * 128 + ch * 8); *(u32x4*)(Ow + (long)row * PO + ch * 8) = v; }
    asm volatile("s_waitcnt lgkmcnt(0)\n\ts_barrier" ::: "memory");
#undef A3_DMA
#undef A3_SB
#undef A3_MFMA
#undef A3_KLD
#undef A3_KLD2
#undef A3_VLD
#undef A3_VF
#undef A3_EXP2
#undef A3_ROWMAX
}
template <int THRL> __device__ __forceinline__ void attn4_unit(int qb, const bf16* Qh0, const bf16* __restrict__ Kh0, long mapstride, const bf16* __restrict__ Vh, bf16_t* YCb_, int yrow0, int ycol0, float lam, const float* gvec, u32x4* park, char* shm) {
#pragma unroll 1
  for (int mp = 0; mp < 2; ++mp) {
    const bf16* Qh = Qh0 + mp * mapstride; const bf16* Kh = Kh0 + mp * mapstride;
    const int tid = threadIdx.x; int lane = tid & 63; asm volatile("" : "+v"(lane));
    const int r32 = lane & 31, hi = lane >> 5; const int wid = __builtin_amdgcn_readfirstlane(tid >> 6);
    const int q0 = qb * QB + NMETA;
    const bf16* Qw = Qh + (long)(q0 + wid * QBLK) * PZ;
    const unsigned lds0 = (unsigned)(uintptr_t)shm;
    float* wsf = (float*)(shm + A2_WS) + wid * 64;
    bf16x8 qr[4];
#pragma unroll
    for (int d0 = 0; d0 < 4; ++d0) qr[d0] = *reinterpret_cast<const bf16x8*>(&Qw[(long)r32 * PZ + d0 * 16 + hi * 8]);
    const bf16* ksrc = Kh + (long)lane * PZ + wid * 8;
    const bf16* vsrc = Vh + (long)(16 * (wid & 3) + (lane >> 2)) * PV + (wid >> 2) * 32 + (lane & 3) * 8;
    const unsigned kdst = lds0 + A2_K + wid * 1024, vdst = lds0 + A2_V + wid * 1024;
#define A3_DMA(t, sl) do { glds16(ksrc + (long)(t) * KVBLK * PZ, (unsigned)__builtin_amdgcn_readfirstlane(kdst + (sl) * A2_SLOT)); \
        glds16(vsrc + (long)(t) * KVBLK * PV, (unsigned)__builtin_amdgcn_readfirstlane(vdst + (sl) * A2_SLOT)); \
        glds16(vsrc + (long)(t) * KVBLK * PV + 64, (unsigned)__builtin_amdgcn_readfirstlane(vdst + (sl) * A2_SLOT + 8192)); } while (0)
#define A3_SB() __builtin_amdgcn_sched_barrier(0)
#define A3_MFMA(A_, B_, C_) __builtin_amdgcn_mfma_f32_32x32x16_bf16((A_), (B_), (C_), 0, 0, 0)
#define A3_KLD(D0) (*(const __attribute__((address_space(3))) bf16x8*)(kpn + (D0) * 2048))
#define A3_KLD2(D0) (*(const __attribute__((address_space(3))) bf16x8*)(kpn + (D0) * 2048 + 512))
#define A3_VLD(BUF, KS) do { _Pragma("unroll") for (int d_ = 0; d_ < 4; ++d_) { vlo[BUF][d_] = vtr(vp + d_ * 4096 + (KS) * 1024); vhh[BUF][d_] = vtr(vp + d_ * 4096 + (KS) * 1024 + 512); } } while (0)
#define A3_VF(BUF, D0) ((bf16x8){vlo[BUF][D0][0], vlo[BUF][D0][1], vlo[BUF][D0][2], vlo[BUF][D0][3], vhh[BUF][D0][0], vhh[BUF][D0][1], vhh[BUF][D0][2], vhh[BUF][D0][3]})
#define A3_EXP2(P, I) do { P[2 * (I)] = __builtin_amdgcn_exp2f(P[2 * (I)]); P[2 * (I) + 1] = __builtin_amdgcn_exp2f(P[2 * (I) + 1]); sacc += P[2 * (I)] + P[2 * (I) + 1]; } while (0)
#define A3_ROWMAX(P0, P1, RM) do { float a_ = fmaxf(fmaxf(P0[0], P0[1]), P1[0]), b_ = fmaxf(fmaxf(P0[2], P0[3]), P1[1]); a_ = fmaxf(fmaxf(a_, P1[2]), P1[3]); \
        _Pragma("unroll") for (int r_ = 4; r_ < 16; r_ += 4) { a_ = fmaxf(fmaxf(a_, P0[r_]), P0[r_ + 1]); b_ = fmaxf(fmaxf(b_, P0[r_ + 2]), P0[r_ + 3]); a_ = fmaxf(fmaxf(a_, P1[r_]), P1[r_ + 1]); b_ = fmaxf(fmaxf(b_, P1[r_ + 2]), P1[r_ + 3]); } \
        RM = fmaxf(a_, b_); auto rr_ = __builtin_amdgcn_permlane32_swap(__float_as_uint(RM), __float_as_uint(RM), false, false); RM = fmaxf(__uint_as_float(rr_[0]), __uint_as_float(rr_[1])); } while (0)
    const int NT = 4 * qb + 5;
    const int qrel16 = wid * QBLK + r32 + NMETA;
    A3_DMA(0, 0); A3_DMA(1, 1); A3_DMA(2, 2);
    asm volatile("" : "+v"(qr[0]), "+v"(qr[1]), "+v"(qr[2]), "+v"(qr[3]));
    const lds_cptr shm3 = (lds_cptr)shm;
    const lds_cptr kp0 = shm3 + A2_K + hi * 1024 + r32 * 16;
    const lds_cptr vp0 = shm3 + A2_V + ((lane >> 4) & 1) * 32 + (lane & 3) * 8 + (4 * hi + ((lane & 15) >> 2)) * 64;
    float mhat = 0.f, l_reg = 0.f; f32x16 o[4]; o[0] = f32x16{}; o[1] = f32x16{}; o[2] = f32x16{}; o[3] = f32x16{}; f32x16 negm = f32x16{};
    const int qrel = wid * QBLK + r32;
    f32x16 p0, p1; float rm;
    asm volatile("s_waitcnt vmcnt(6)\n\ts_barrier" ::: "memory");
    {   const lds_cptr kpn = kp0;
        p0 = A3_MFMA(A3_KLD(0), qr[0], negm); p1 = A3_MFMA(A3_KLD2(0), qr[0], negm);
#pragma unroll
        for (int d0 = 1; d0 < 4; ++d0) { p0 = A3_MFMA(A3_KLD(d0), qr[d0], p0); p1 = A3_MFMA(A3_KLD2(d0), qr[d0], p1); }
        if (qb == 0) cmask(p0, p1, 0, qrel16, hi);
        A3_ROWMAX(p0, p1, rm);
        mhat = rm;
#pragma unroll
        for (int r = 0; r < 16; ++r) { p0[r] -= rm; p1[r] -= rm; negm[r] = -mhat; }
        rm = 0.f;
    }
    for (int t = 0; t < NT; ++t) {
        if (t + 2 < NT) asm volatile("s_waitcnt vmcnt(3)\n\ts_barrier" ::: "memory"); else asm volatile("s_waitcnt vmcnt(0)\n\ts_barrier" ::: "memory");
        if (t + 3 < NT) A3_DMA(t + 3, (t + 3) & 3);
        const lds_cptr kpn = kp0 + ((t + 1) & 3) * A2_SLOT; const lds_cptr vp = vp0 + (t & 3) * A2_SLOT;
        if (__any(rm > (float)THRL)) {
            const float dl = fmaxf(rm, 0.f); mhat += dl;
#pragma unroll
            for (int r = 0; r < 16; ++r) { p0[r] -= dl; p1[r] -= dl; negm[r] = -mhat; }
            const float f = __builtin_amdgcn_exp2f(-dl); l_reg *= f;
            if (hi == 0) wsf[r32] = f;
            asm volatile("s_waitcnt lgkmcnt(0)" ::: "memory");
#pragma unroll
            for (int r = 0; r < 16; ++r) { const float fr_ = wsf[crow(r, hi)];
#pragma unroll
                for (int d_ = 0; d_ < 4; ++d_) o[d_][r] *= fr_; }
            asm volatile("s_waitcnt lgkmcnt(0)" ::: "memory");
        }
        float sacc = 0.f; f32x16 n0, n1; u32x4 pw0, pw1, pw2, pw3; s16x4 vlo[2][4], vhh[2][4];
        {   bf16x8 ka0 = A3_KLD(0), ka1 = A3_KLD2(0), ka2 = A3_KLD(1), ka3 = A3_KLD2(1);
            A3_VLD(0, 0);
            A3_SB();
            n0 = A3_MFMA(ka0, qr[0], negm); A3_EXP2(p0, 0); A3_SB();
            n1 = A3_MFMA(ka1, qr[0], negm); A3_EXP2(p0, 1); A3_SB();
            bf16x8 kb0 = A3_KLD(2), kb1 = A3_KLD2(2), kb2 = A3_KLD(3), kb3 = A3_KLD2(3);
            n0 = A3_MFMA(ka2, qr[1], n0); A3_EXP2(p0, 2); A3_SB();
            n1 = A3_MFMA(ka3, qr[1], n1); A3_EXP2(p0, 3); pw0 = (u32x4){pkbf(p0[0], p0[1]), pkbf(p0[2], p0[3]), pkbf(p0[4], p0[5]), pkbf(p0[6], p0[7])}; A3_SB();
            n0 = A3_MFMA(kb0, qr[2], n0); A3_EXP2(p0, 4); A3_SB();
            n1 = A3_MFMA(kb1, qr[2], n1); A3_EXP2(p0, 5); A3_SB();
            n0 = A3_MFMA(kb2, qr[3], n0); A3_EXP2(p0, 6); A3_SB();
            n1 = A3_MFMA(kb3, qr[3], n1); A3_EXP2(p0, 7); pw1 = (u32x4){pkbf(p0[8], p0[9]), pkbf(p0[10], p0[11]), pkbf(p0[12], p0[13]), pkbf(p0[14], p0[15])}; A3_SB();
        }
        A3_VLD(1, 1); A3_SB();
        o[0] = A3_MFMA(__builtin_bit_cast(bf16x8, pw0), A3_VF(0, 0), o[0]); A3_EXP2(p1, 0); A3_SB();
        o[1] = A3_MFMA(__builtin_bit_cast(bf16x8, pw0), A3_VF(0, 1), o[1]); A3_EXP2(p1, 1); A3_SB();
        o[2] = A3_MFMA(__builtin_bit_cast(bf16x8, pw0), A3_VF(0, 2), o[2]); A3_EXP2(p1, 2); A3_SB();
        o[3] = A3_MFMA(__builtin_bit_cast(bf16x8, pw0), A3_VF(0, 3), o[3]); A3_EXP2(p1, 3); pw2 = (u32x4){pkbf(p1[0], p1[1]), pkbf(p1[2], p1[3]), pkbf(p1[4], p1[5]), pkbf(p1[6], p1[7])}; A3_SB();
        A3_VLD(0, 2); A3_SB();
        o[0] = A3_MFMA(__builtin_bit_cast(bf16x8, pw1), A3_VF(1, 0), o[0]); A3_EXP2(p1, 4); A3_SB();
        o[1] = A3_MFMA(__builtin_bit_cast(bf16x8, pw1), A3_VF(1, 1), o[1]); A3_EXP2(p1, 5); A3_SB();
        o[2] = A3_MFMA(__builtin_bit_cast(bf16x8, pw1), A3_VF(1, 2), o[2]); A3_EXP2(p1, 6); A3_SB();
        o[3] = A3_MFMA(__builtin_bit_cast(bf16x8, pw1), A3_VF(1, 3), o[3]); A3_EXP2(p1, 7); pw3 = (u32x4){pkbf(p1[8], p1[9]), pkbf(p1[10], p1[11]), pkbf(p1[12], p1[13]), pkbf(p1[14], p1[15])}; A3_SB();
        l_reg += sacc;
        A3_VLD(1, 3); A3_SB();
        { const int jb = (t + 1) - 4 * qb; if (jb >= 0 && t + 1 < NT) cmask(n0, n1, jb, qrel16, hi); }
        o[0] = A3_MFMA(__builtin_bit_cast(bf16x8, pw2), A3_VF(0, 0), o[0]);
        o[1] = A3_MFMA(__builtin_bit_cast(bf16x8, pw2), A3_VF(0, 1), o[1]);
        o[2] = A3_MFMA(__builtin_bit_cast(bf16x8, pw2), A3_VF(0, 2), o[2]);
        o[3] = A3_MFMA(__builtin_bit_cast(bf16x8, pw2), A3_VF(0, 3), o[3]); A3_SB();
        o[0] = A3_MFMA(__builtin_bit_cast(bf16x8, pw3), A3_VF(1, 0), o[0]);
        o[1] = A3_MFMA(__builtin_bit_cast(bf16x8, pw3), A3_VF(1, 1), o[1]);
        o[2] = A3_MFMA(__builtin_bit_cast(bf16x8, pw3), A3_VF(1, 2), o[2]);
        o[3] = A3_MFMA(__builtin_bit_cast(bf16x8, pw3), A3_VF(1, 3), o[3]);
        A3_ROWMAX(n0, n1, rm);
        p0 = n0; p1 = n1;
        A3_SB();
    }
    asm volatile("s_waitcnt lgkmcnt(0)\n\ts_barrier" ::: "memory");
    { auto rr = __builtin_amdgcn_permlane32_swap(__float_as_uint(l_reg), __float_as_uint(l_reg), false, false); l_reg = __uint_as_float(rr[0]) + __uint_as_float(rr[1]); }
    if (hi == 0) wsf[32 + r32] = l_reg;
    asm volatile("s_waitcnt lgkmcnt(0)" ::: "memory");
    float rl[16];
#pragma unroll
    for (int r = 0; r < 16; ++r) rl[r] = __builtin_amdgcn_rcpf(wsf[32 + crow(r, hi)]);
    if (mp == 0) {
#pragma unroll
        for (int d0 = 0; d0 < 4; ++d0)
#pragma unroll
            for (int q4 = 0; q4 < 2; ++q4) { u32x4 w;
                w.x = pkbf(o[d0][8 * q4 + 0] * rl[8 * q4 + 0], o[d0][8 * q4 + 1] * rl[8 * q4 + 1]); w.y = pkbf(o[d0][8 * q4 + 2] * rl[8 * q4 + 2], o[d0][8 * q4 + 3] * rl[8 * q4 + 3]);
                w.z = pkbf(o[d0][8 * q4 + 4] * rl[8 * q4 + 4], o[d0][8 * q4 + 5] * rl[8 * q4 + 5]); w.w = pkbf(o[d0][8 * q4 + 6] * rl[8 * q4 + 6], o[d0][8 * q4 + 7] * rl[8 * q4 + 7]);
                park[d0 * 2 + q4] = w; }
    } else {
        float ss[16];
#pragma unroll
        for (int r = 0; r < 16; ++r) ss[r] = 0.f;
#pragma unroll
        for (int d0 = 0; d0 < 4; ++d0)
#pragma unroll
            for (int q4 = 0; q4 < 2; ++q4) { const u32x4 w = park[d0 * 2 + q4];
                const float a_[8] = {bflo(w.x), bfhi(w.x), bflo(w.y), bfhi(w.y), bflo(w.z), bfhi(w.z), bflo(w.w), bfhi(w.w)};
#pragma unroll
                for (int e = 0; e < 8; ++e) { const int r = 8 * q4 + e; const float y = a_[e] - lam * (o[d0][r] * rl[r]); o[d0][r] = y; ss[r] += y * y; } }
        const f32x4 g4 = (f32x4){gvec[r32], gvec[32 + r32], gvec[64 + r32], gvec[96 + r32]} * (1.0f - LAMBDA_INIT);
#pragma unroll
        for (int r = 0; r < 16; ++r) {
            float v = row_sum16(ss[r]);
            auto rr = __builtin_amdgcn_permlane16_swap(__float_as_uint(v), __float_as_uint(v), false, false); v = __uint_as_float(rr[0]) + __uint_as_float(rr[1]);
            ss[r] = 1.0f / sqrtf(v * (1.f / 128.f) + LN_EPS);
        }
        bf16* stg = (bf16*)(shm + A2_OST) + wid * 4096;
#pragma unroll
        for (int r = 0; r < 16; ++r) { const int orow = crow(r, hi);
#pragma unroll
            for (int d0 = 0; d0 < 4; ++d0) stg[orow * 128 + d0 * 32 + r32] = __float2bfloat16(o[d0][r] * ss[r] * g4[d0]); }
        asm volatile("s_waitcnt lgkmcnt(0)" ::: "memory");
#pragma unroll
        for (int i = 0; i < 8; ++i) { const int row = i * 4 + (lane >> 4), ch = lane & 15; const int tq = q0 + wid * QBLK + row;
            if (tq >= NMETA && tq < TT) { const u32x4 v = *(const u32x4*)(stg + row * 128 + ch * 8); *(u32x4*)(YCb_ + (size_t)(yrow0 + tq - NMETA) * DM + ycol0 + ch * 8) = v; } }
    }
    asm volatile("s_waitcnt lgkmcnt(0)\n\ts_barrier" ::: "memory");
#undef A3_DMA
#undef A3_SB
#undef A3_MFMA
#undef A3_KLD
#undef A3_KLD2
#undef A3_VLD
#undef A3_VF
#undef A3_EXP2
#undef A3_ROWMAX
  }
}
#undef SBAR
#undef WAIT_BAR
}

#define XB_TMO      128
#define XB_XCNT(j)  (256  + 64 * (j))
#define XB_XSUB(j)  (1280 + 64 * (j))
#define XB_XGEN(j)  (2304 + 64 * (j))
#define XB_TOP      3328
#define XB_TOPGEN   3392
#define XCD_BAR_WORDS 3456
#define XB_SPIN_CAP (1u << 18)
__device__ __forceinline__ unsigned xb_ld(unsigned* p)              { return __hip_atomic_load(p, __ATOMIC_RELAXED, __HIP_MEMORY_SCOPE_AGENT); }
__device__ __forceinline__ unsigned xb_add(unsigned* p, unsigned v) { return __hip_atomic_fetch_add(p, v, __ATOMIC_RELAXED, __HIP_MEMORY_SCOPE_AGENT); }
__device__ __forceinline__ unsigned xb_xcc_id() { return (unsigned)__builtin_amdgcn_s_getreg((3 << 11) | 20) & 0xFu; }
#define XB_SPIN(cond, bar) do { unsigned _sp = 0; while (cond) { __builtin_amdgcn_s_sleep(1); \
    if ((++_sp & 255u) == 0u) { if (xb_ld(&(bar)[XB_TMO])) break; if (_sp > XB_SPIN_CAP) { atomicAdd(&(bar)[XB_TMO], 1u); break; } } } } while (0)
struct XcdBarrier { unsigned* bar; unsigned x; volatile LAS unsigned* st; };
__device__ __forceinline__ XcdBarrier xcd_barrier_post(unsigned* bar, volatile LAS unsigned* st) {
    XcdBarrier b; b.bar = bar; b.x = xb_xcc_id(); b.st = st;
    if (threadIdx.x == 0) (void)xb_add(&bar[XB_XCNT(b.x)], 1u);
    return b;
}
__device__ __forceinline__ void xcd_barrier_complete(unsigned* bar, unsigned x, unsigned& nloc, unsigned& nx) {
    const unsigned G = gridDim.x * gridDim.y * gridDim.z;
    unsigned sum, cnt, mine, sp = 0u;
    for (;;) {
        sum = 0u; cnt = 0u; mine = 0u;
#pragma unroll
        for (unsigned j = 0; j < 16; ++j) { const unsigned c = xb_ld(&bar[XB_XCNT(j)]); sum += c; cnt += (c > 0u) ? 1u : 0u; mine = (j == x) ? c : mine; }
        if (sum == G) break;
        __builtin_amdgcn_s_sleep(1);
        if ((++sp & 255u) == 0u) { if (xb_ld(&bar[XB_TMO])) break; if (sp > XB_SPIN_CAP) { atomicAdd(&bar[XB_TMO], 1u); break; } }
    }
    nloc = mine > 0u ? mine : 1u; nx = cnt > 0u ? cnt : 1u;
}
__device__ __forceinline__ void xcd_barrier(const XcdBarrier& b) {
    asm volatile("s_waitcnt vmcnt(0)" ::: "memory");
    __syncthreads();
    if (threadIdx.x == 0) {
        unsigned* bar = b.bar;
        __builtin_amdgcn_s_waitcnt(0);
        unsigned nloc = b.st[0], nx = b.st[1];
        if (nloc == 0u) { xcd_barrier_complete(bar, b.x, nloc, nx); b.st[0] = nloc; b.st[1] = nx; }
        const unsigned old = xb_add(&bar[XB_XSUB(b.x)], 1u);
        const unsigned gen = old / nloc;
        if (old + 1u == (gen + 1u) * nloc) {
            __builtin_amdgcn_fence(__ATOMIC_RELEASE, "agent");
            asm volatile("s_waitcnt vmcnt(0)" ::: "memory");
            const unsigned og = xb_add(&bar[XB_TOP], 1u);
            const unsigned tg = og / nx;
            if (og + 1u == (tg + 1u) * nx) xb_add(&bar[XB_TOPGEN], 1u);
            else XB_SPIN(xb_ld(&bar[XB_TOPGEN]) == tg, bar);
            __builtin_amdgcn_fence(__ATOMIC_ACQUIRE, "agent");
            xb_add(&bar[XB_XGEN(b.x)], 1u);
            asm volatile("s_waitcnt vmcnt(0)" ::: "memory");
        } else {
            XB_SPIN(xb_ld(&bar[XB_XGEN(b.x)]) == gen, bar);
            __builtin_amdgcn_fence(__ATOMIC_ACQUIRE, "agent");
            asm volatile("s_waitcnt vmcnt(0)" ::: "memory");
        }
    }
    __syncthreads();
}

struct Args {
    const float *x, *meta, *ln0_g, *ln0_b, *w_in, *conv_w, *conv_b, *gate_bias, *lq1, *lk1, *lq2, *lk2, *att_g, *ml_g, *w_att_out, *w_ml_out, *w_o,
                *ln1_g, *ln1_b, *w_router, *b_router, *w_gu, *b_gu, *w_down, *b_down, *ln2_g, *ln2_b;
    float* out; unsigned char* ws; int ph_lo, ph_hi;
};

template <class ColMap>
__device__ __forceinline__ void transpose_item(const float* W, int K, int N, bf16_t* WT, LAS float* scr, int kb, int nb, int lane, ColMap cm, int ldw = 0, unsigned char* WT8 = nullptr, float s8 = 1.f) {
    if (ldw == 0) ldw = K;
    const int k0 = 64 * kb, n0 = 32 * nb;
    const int lc = cm(n0 + (lane & 31));
    float tv[32];
    const float* wp = W + (size_t)(k0 + (lane >> 5)) * N + lc;
#pragma unroll
    for (int i = 0; i < 32; ++i) tv[i] = wp[(size_t)(2 * i) * N];
#pragma unroll
    for (int i = 0; i < 32; ++i) { const int kk = 2 * i + (lane >> 5); scr[kk * 33 + (lane & 31)] = tv[i]; }
    LDS_WAIT(); asm volatile("" ::: "memory");
    const int c = lane & 7;
#pragma unroll
    for (int j = 0; j < 4; ++j) { const int n = (lane >> 3) + 8 * j; const LAS float* s = scr + (8 * c) * 33 + n;
        if (WT8) { u32x2 o8; o8.x = pkfp8x4(s[0 * 33] * s8, s[1 * 33] * s8, s[2 * 33] * s8, s[3 * 33] * s8); o8.y = pkfp8x4(s[4 * 33] * s8, s[5 * 33] * s8, s[6 * 33] * s8, s[7 * 33] * s8);
            *(u32x2*)(WT8 + (size_t)(n0 + n) * ldw + k0 + 8 * c) = o8; }
        else { u32x4 o; o.x = pkbf(s[0 * 33], s[1 * 33]); o.y = pkbf(s[2 * 33], s[3 * 33]); o.z = pkbf(s[4 * 33], s[5 * 33]); o.w = pkbf(s[6 * 33], s[7 * 33]);
            *(u32x4*)(WT + (size_t)(n0 + n) * ldw + k0 + 8 * c) = o; } }
    LDS_WAIT(); asm volatile("" ::: "memory");
}
template <class ColMap>
__device__ __forceinline__ void transpose_item2(const float* W, int K, int N, bf16_t* WT, LAS float* scr, int kb, int nb, int lane, ColMap cm) {
    const int k0 = 64 * kb, n0 = 32 * nb;
    const int lc0 = cm(n0 + (lane & 31)), lc1 = cm(n0 + 32 + (lane & 31));
    float ta[32], tb[32];
    const float* wp = W + (size_t)(k0 + (lane >> 5)) * N;
#pragma unroll
    for (int i = 0; i < 32; ++i) { ta[i] = wp[(size_t)(2 * i) * N + lc0]; tb[i] = wp[(size_t)(2 * i) * N + lc1]; }
    LAS float* scr2 = scr + 64 * 33;
#pragma unroll
    for (int i = 0; i < 32; ++i) { const int kk = 2 * i + (lane >> 5); scr[kk * 33 + (lane & 31)] = ta[i]; scr2[kk * 33 + (lane & 31)] = tb[i]; }
    LDS_WAIT(); asm volatile("" ::: "memory");
    const int c = lane & 7;
#pragma unroll
    for (int h2 = 0; h2 < 2; ++h2) { const LAS float* sb = h2 ? scr2 : scr;
#pragma unroll
        for (int j = 0; j < 4; ++j) { const int n = (lane >> 3) + 8 * j; const LAS float* sp = sb + (8 * c) * 33 + n;
            u32x4 o; o.x = pkbf(sp[0 * 33], sp[1 * 33]); o.y = pkbf(sp[2 * 33], sp[3 * 33]); o.z = pkbf(sp[4 * 33], sp[5 * 33]); o.w = pkbf(sp[6 * 33], sp[7 * 33]);
            *(u32x4*)(WT + (size_t)(n0 + 32 * h2 + n) * K + k0 + 8 * c) = o; } }
    LDS_WAIT(); asm volatile("" ::: "memory");
}
template <class InvMap>
__device__ __forceinline__ void transpose_tile64(const float* W, int N, bf16_t* WT, int ldw, LAS unsigned char* scr, int k0, int c0, int lane, InvMap inv) {
    constexpr int TP = 136;
    asm volatile("" : "+v"(lane));
    const float* wp = W + (size_t)(k0 + (lane >> 4)) * N + c0 + (lane & 15) * 4;
#pragma unroll
    for (int hf = 0; hf < 2; ++hf) {
        f32x4 tv[8];
#pragma unroll
        for (int i = 0; i < 8; ++i) tv[i] = *(const f32x4*)(wp + (size_t)(4 * (8 * hf + i)) * N);
#pragma unroll
        for (int i = 0; i < 8; ++i) { u32x2 w; w.x = pkbf(tv[i][0], tv[i][1]); w.y = pkbf(tv[i][2], tv[i][3]);
            *(LAS u32x2*)(scr + ((lane >> 4) + 4 * (8 * hf + i)) * TP + (lane & 15) * 8) = w; }
        asm volatile("" ::: "memory");
    }
    LDS_WAIT(); asm volatile("" ::: "memory");
    const int g = lane >> 4, p = lane & 15;
#pragma unroll
    for (int it = 0; it < 8; ++it) {
        const int cq = it & 3, kq = (it >> 2) * 4 + g;
        const LAS unsigned char* a = scr + (8 * kq + (p >> 2)) * TP + (16 * cq + 4 * (p & 3)) * 2;
        const attn_body::s16x4 lo = attn_body::vtr((attn_body::lds_cptr)a), hi4 = attn_body::vtr((attn_body::lds_cptr)(a + 4 * TP));
        u32x4 o; o.x = (unsigned)(unsigned short)lo[0] | ((unsigned)(unsigned short)lo[1] << 16); o.y = (unsigned)(unsigned short)lo[2] | ((unsigned)(unsigned short)lo[3] << 16);
        o.z = (unsigned)(unsigned short)hi4[0] | ((unsigned)(unsigned short)hi4[1] << 16); o.w = (unsigned)(unsigned short)hi4[2] | ((unsigned)(unsigned short)hi4[3] << 16);
        *(u32x4*)(WT + (size_t)inv(c0 + 16 * cq + p) * ldw + k0 + 8 * kq) = o;
    }
    LDS_WAIT(); asm volatile("" ::: "memory");
}
template <class InvMap>
__device__ __forceinline__ void transpose_tile64_fp8(const float* W, int N, unsigned char* WT, int ldw, LAS unsigned char* scr, int k0, int c0, int lane, InvMap inv, float scale) {
    constexpr int TP = 136;
    asm volatile("" : "+v"(lane));
    const float* wp = W + (size_t)(k0 + (lane >> 4)) * N + c0 + (lane & 15) * 4;
#pragma unroll
    for (int hf = 0; hf < 2; ++hf) {
        f32x4 tv[8];
#pragma unroll
        for (int i = 0; i < 8; ++i) tv[i] = *(const f32x4*)(wp + (size_t)(4 * (8 * hf + i)) * N);
#pragma unroll
        for (int i = 0; i < 8; ++i) { u32x2 w; w.x = pkbf(tv[i][0], tv[i][1]); w.y = pkbf(tv[i][2], tv[i][3]);
            *(LAS u32x2*)(scr + ((lane >> 4) + 4 * (8 * hf + i)) * TP + (lane & 15) * 8) = w; }
        asm volatile("" ::: "memory");
    }
    LDS_WAIT(); asm volatile("" ::: "memory");
    const int g = lane >> 4, p = lane & 15;
#pragma unroll
    for (int cq = 0; cq < 4; ++cq) {
        const LAS unsigned char* a = scr + (16 * g + (p >> 2)) * TP + (16 * cq + 4 * (p & 3)) * 2;
        u32x4 o;
#pragma unroll
        for (int q4 = 0; q4 < 4; ++q4) { const attn_body::s16x4 t4 = attn_body::vtr((attn_body::lds_cptr)(a + 4 * q4 * TP));
            o[q4] = pkfp8x4(__uint_as_float(((unsigned)(unsigned short)t4[0]) << 16) * scale, __uint_as_float(((unsigned)(unsigned short)t4[1]) << 16) * scale,
                            __uint_as_float(((unsigned)(unsigned short)t4[2]) << 16) * scale, __uint_as_float(((unsigned)(unsigned short)t4[3]) << 16) * scale); }
        *(u32x4*)(WT + (size_t)inv(c0 + 16 * cq + p) * ldw + k0 + 16 * g) = o;
    }
    LDS_WAIT(); asm volatile("" ::: "memory");
}
struct InvIdent { __device__ __forceinline__ int operator()(int c) const { return c; } };
struct InvGu {
    __device__ __forceinline__ int operator()(int c) const { const int sgl = c & 1, idx = c >> 1; return 256 * (idx >> 7) + 128 * sgl + (idx & 127); } };
struct CmIdent { __device__ __forceinline__ int operator()(int p) const { return p; } };
struct CmWin {
    __device__ __forceinline__ int operator()(int P) const {
        if (P < 1024) { const int hb = P >> 6, p = P & 63, wcp = p >> 5, fq = (p & 31) >> 3, n = (p & 7) >> 2, j = p & 3; return hb * 64 + 32 * n + 16 * wcp + 4 * fq + j; }
        if (P < 3584) return P;
        return P + 8;
    }
};
struct CmGu {
    __device__ __forceinline__ int operator()(int P) const { const int pn = P >> 8, s = (P >> 7) & 1, i = P & 127; return 2 * (128 * pn + i) + s; }
};

__global__ void __launch_bounds__(NWAVES * 64, 2) hybrid_fwd(Args a) {
    extern __shared__ __attribute__((aligned(16))) unsigned char lds[];
    LAS unsigned char* L = (LAS unsigned char*)lds;
    const int tid = threadIdx.x, lane = tid & 63, wave = __builtin_amdgcn_readfirstlane(tid >> 6);
    const int G = gridDim.x, blk = blockIdx.x;
    const int gw = blk * NWAVES + wave, NGW = G * NWAVES;
    if (tid < 16) ((LAS unsigned*)(L + MISC_OFF))[tid] = 0u;
    LAS unsigned long long* ptab = (LAS unsigned long long*)(L + MISC_OFF + 64);
    if (tid == 0) {
        ptab[0] = (unsigned long long)a.x; ptab[1] = (unsigned long long)a.meta; ptab[2] = (unsigned long long)a.ln0_g; ptab[3] = (unsigned long long)a.ln0_b; ptab[4] = (unsigned long long)a.w_in;
        ptab[5] = (unsigned long long)a.conv_w; ptab[6] = (unsigned long long)a.conv_b; ptab[7] = (unsigned long long)a.gate_bias; ptab[8] = (unsigned long long)a.lq1; ptab[9] = (unsigned long long)a.lk1;
        ptab[10] = (unsigned long long)a.lq2; ptab[11] = (unsigned long long)a.lk2; ptab[12] = (unsigned long long)a.att_g; ptab[13] = (unsigned long long)a.ml_g; ptab[14] = (unsigned long long)a.w_att_out;
        ptab[15] = (unsigned long long)a.w_ml_out; ptab[16] = (unsigned long long)a.w_o; ptab[17] = (unsigned long long)a.ln1_g; ptab[18] = (unsigned long long)a.ln1_b; ptab[19] = (unsigned long long)a.w_router;
        ptab[20] = (unsigned long long)a.b_router; ptab[21] = (unsigned long long)a.w_gu; ptab[22] = (unsigned long long)a.b_gu; ptab[23] = (unsigned long long)a.w_down; ptab[24] = (unsigned long long)a.b_down;
        ptab[25] = (unsigned long long)a.ln2_g; ptab[26] = (unsigned long long)a.ln2_b; ptab[27] = (unsigned long long)a.out; ptab[28] = (unsigned long long)a.ws;
    }
    asm volatile("s_waitcnt lgkmcnt(0)" ::: "memory");
    __syncthreads();
    asm volatile("" ::: "memory");
#define PF(i) ((const float*)ldptr(ptab, (i)))
#define WSP ((unsigned char*)ldptr(ptab, 28))
#define DOUTP ((unsigned char*)ldptr(ptab, 27))
#define ctl ((unsigned*)(WSP + WS_CTL))
#define WinT ((bf16_t*)(WSP + WS_WIN))
#define WaT ((bf16_t*)(WSP + WS_WA))
#define WmT ((bf16_t*)(WSP + WS_WM))
#define WoT ((bf16_t*)(WSP + WS_WO))
#define ropec ((float*)(WSP + WS_ROPE))
#define ropes (ropec + TT * 32)
#define stats ((float*)(WSP + WS_STATS))
#define gates ((float*)(WSP + WS_GATES))
#define tok_e ((int*)(WSP + WS_TOKE))
#define tok_g ((float*)(WSP + WS_TOKG))
#define hist ((int*)(WSP + WS_HIST))
#define row_off ((int*)(WSP + WS_ROWOFF))
#define row_slot ((int*)(WSP + WS_ROWSLOT))
#define row_gate ((float*)(WSP + WS_ROWGATE))
#define tile_exp ((int*)(WSP + WS_TILEEXP))
#define Hb ((bf16_t*)(WSP + WS_H))
#define Z ((bf16_t*)(WSP + WS_Z))
#define Y ((bf16_t*)(WSP + WS_Y))
#define ACT ((bf16_t*)(WSP + WS_ACT))
#define Qc ((bf16_t*)(WSP + WS_QC))
#define Kc ((bf16_t*)(WSP + WS_KC))
#define Vc ((bf16_t*)(WSP + WS_VC))
#define TMPb ((bf16_t*)(WSP + WS_TMP))
#define MRGb ((bf16_t*)(WSP + WS_MRG))
#define GFb ((bf16_t*)(WSP + WS_GF))
#define YCb ((bf16_t*)(WSP + WS_H))
#define Ob ((bf16_t*)(WSP + WS_O))
#define WguT ((bf16_t*)(DOUTP + DO_WGU))
#define WdnT ((bf16_t*)(DOUTP + DO_WDN))
#if !MK_PER_PHASE
    XcdBarrier bar = xcd_barrier_post(ctl + CW_BAR, (volatile LAS unsigned*)(L + MISC_OFF + 32));
#define GRID_BAR() xcd_barrier(bar)
#else
#define GRID_BAR() do {} while (0)
#endif
    const int lo = a.ph_lo, hi = a.ph_hi;
#if MK_PROBE == 2
    LAS unsigned* pdur = (LAS unsigned*)(L + MISC_OFF + 320);
    if (blk == 0 && tid == 0) { pdur[30] = (unsigned)__builtin_amdgcn_s_memrealtime(); pdur[31] = pdur[30]; pdur[29] = pdur[30]; for (int q_ = 16; q_ < 29; ++q_) pdur[q_] = 0u; }
#define PSTAMP(k) do { if (blk == 0 && tid == 0) { const unsigned now_ = (unsigned)__builtin_amdgcn_s_memrealtime(); pdur[k] = now_ - pdur[30]; pdur[30] = now_; } } while (0)
#define CSTAMP(k) do { if (blk == 0 && tid == 0) { const unsigned now_ = (unsigned)__builtin_amdgcn_s_memrealtime(); pdur[16 + (k)] += now_ - pdur[31]; pdur[31] = now_; } } while (0)
#else
#define PSTAMP(k) do {} while (0)
#define CSTAMP(k) do {} while (0)
#endif
#define IN(k) (lo <= (k) && (k) < hi)
#define BOTH(k) (IN(k) && IN((k) + 1))

    if (IN(0)) REPLOOP(0) {
        {   LAS float* scr = (LAS float*)(L + wave * 16384);
            constexpr int I_IN = 16 * (NZP / 32), I_A = 8 * 32, I_O = 16 * 32;
            constexpr int NIT = I_IN + 2 * I_A + I_O;
            for (int it = gw; it < NIT; it += NGW) {
                int r = it;
                if (r < I_IN) { const int tl_ = (r % (NZP / 32)) >> 3;
                    const bool f8_ = (tl_ == 4) || (tl_ == 5) || (tl_ >= 10);
                    transpose_item(PF(4), 1024, NIN, WinT, scr, r / (NZP / 32), r % (NZP / 32), lane, CmWin(), f8_ ? 1024 : 0, f8_ ? WSP + WS_WIN8 : (unsigned char*)nullptr, FP8_SB1); continue; } r -= I_IN;
                if (r < I_A) { transpose_item(PF(14), 512, 1024, WaT, scr, r / 32, r % 32, lane, CmIdent(), 1024); continue; } r -= I_A;
                if (r < I_A) { transpose_item(PF(15), 512, 1024, WaT + 512, scr, r / 32, r % 32, lane, CmIdent(), 1024); continue; } r -= I_A;
                transpose_item(PF(16), 1024, 1024, WoT, scr, r / 32, r % 32, lane, CmIdent());
            }
        }
        for (int i = blk * 512 + tid; i < TT * 32; i += G * 512) {
            const int t = i >> 5, f = i & 31;
            const double inv = exp2(-(double)f * (13.287712379549449 / 32.0));
            const double rev = (double)t * inv * 0.15915494309189535;
            const float fr = (float)(rev - floor(rev));
            ropec[i] = __builtin_amdgcn_cosf(fr); ropes[i] = __builtin_amdgcn_sinf(fr);
        }
        __syncthreads();
        LAS float* wg = (LAS float*)L;
        for (int i = tid; i < 8 * 1024; i += 512) { const int gc = i >> 10, k = i & 1023; wg[i] = PF(4)[(size_t)k * NIN + 3584 + gc]; }
        __syncthreads();
        {
            const float* xin = PF(0); const float* metap = PF(1); const float* gbias = PF(7);
            const float* g0p = PF(2); const float* b0p = PF(3);
            bf16_t* Hbp = Hb; float* statsp = stats; float* gatesp = gates;
            unsigned char* H8p0 = WSP + WS_H8;
            for (int base = gw * 4; base < MROWS; base += NGW * 4) {
                f32x4 v[4][4]; float sm[4];
#pragma unroll
                for (int r = 0; r < 4; ++r) { const int row = (base + r < MROWS) ? base + r : MROWS - 1;
                    const float* xr = (row < NREAL) ? xin + (size_t)row * DM : metap + (size_t)((row - NREAL) & (NMETA - 1)) * DM;
#pragma unroll
                    for (int j = 0; j < 4; ++j) v[r][j] = *(const f32x4*)(xr + 4 * lane + 256 * j); }
#pragma unroll
                for (int r = 0; r < 4; ++r) { float s = 0.f;
#pragma unroll
                    for (int j = 0; j < 4; ++j) s += (v[r][j][0] + v[r][j][1]) + (v[r][j][2] + v[r][j][3]);
                    sm[r] = s; }
                float mean[4], rstd[4];
#pragma unroll
                for (int r = 0; r < 4; ++r) mean[r] = wave_sum(sm[r]) * (1.f / DM);
#pragma unroll
                for (int r = 0; r < 4; ++r) { float s2 = 0.f;
#pragma unroll
                    for (int j = 0; j < 4; ++j) { const f32x4 d = v[r][j] - mean[r]; s2 += (d[0] * d[0] + d[1] * d[1]) + (d[2] * d[2] + d[3] * d[3]); }
                    sm[r] = s2; }
#pragma unroll
                for (int r = 0; r < 4; ++r) rstd[r] = 1.0f / sqrtf(wave_sum(sm[r]) * (1.f / DM) + LN_EPS);
                float gp[32];
#pragma unroll
                for (int q = 0; q < 32; ++q) gp[q] = 0.f;
#pragma unroll
                for (int j = 0; j < 4; ++j) {
                    const f32x4 ggj = *(const f32x4*)(g0p + 4 * lane + 256 * j), bbj = *(const f32x4*)(b0p + 4 * lane + 256 * j);
#pragma unroll
                    for (int r = 0; r < 4; ++r) { v[r][j] = (v[r][j] - mean[r]) * rstd[r] * ggj + bbj;
                        if (base + r < MROWS) { u32x2 w; w.x = pkbf(v[r][j][0], v[r][j][1]); w.y = pkbf(v[r][j][2], v[r][j][3]); *(u32x2*)(Hbp + (size_t)(base + r) * DM + 4 * lane + 256 * j) = w;
                            *(unsigned*)(H8p0 + (size_t)(base + r) * DM + 4 * lane + 256 * j) = pkfp8x4(v[r][j][0] * FP8_SA1, v[r][j][1] * FP8_SA1, v[r][j][2] * FP8_SA1, v[r][j][3] * FP8_SA1); } }
#pragma unroll
                    for (int q = 0; q < 8; ++q) { const f32x4 wv = *(const LAS f32x4*)(wg + q * 1024 + 4 * lane + 256 * j);
#pragma unroll
                        for (int r = 0; r < 4; ++r) gp[r * 8 + q] += (v[r][j][0] * wv[0] + v[r][j][1] * wv[1]) + (v[r][j][2] * wv[2] + v[r][j][3] * wv[3]); }
                }
                const float gsum = xreduce32(gp, lane);
                int lane_o = lane; asm volatile("" : "+v"(lane_o));
                const int q_of_lane = (lane_o >> 1) & 7, r_of_lane = lane_o >> 4;
                const float gb = gbias[q_of_lane];
                const int rowl = base + r_of_lane;
                if (rowl < MROWS) {
                    if ((lane_o & 1) == 0) { float gv = gsum + gb;
                        if (q_of_lane >= 4) gv = (gv >= 0.f) ? -log1pf(expf(-gv)) : gv - log1pf(expf(gv));
                        gatesp[(size_t)rowl * 8 + q_of_lane] = gv; }
                    if ((lane_o & 15) == 0) { const float mr = (r_of_lane == 0) ? mean[0] : (r_of_lane == 1) ? mean[1] : (r_of_lane == 2) ? mean[2] : mean[3];
                        const float rr = (r_of_lane == 0) ? rstd[0] : (r_of_lane == 1) ? rstd[1] : (r_of_lane == 2) ? rstd[2] : rstd[3];
                        statsp[2 * rowl] = mr; statsp[2 * rowl + 1] = rr; }
                }
            }
        }
        __syncthreads();
        if (BOTH(0) || rep_ + 1 < REP_0) GRID_BAR();
    }
    PSTAMP(0);

    if (IN(1)) REPLOOP(1) {
        {
            pg8::Gemm g{Hb, WinT, DM, DM, 8, nullptr, nullptr, 0, 4, 0, 2};
            pg8::StaticOrder S; S.init(MROWS / 256, 8, G, blk);
            pg8::EpiZ E{Z, Qc, Kc, Vc, ropec, ropes, GFb, 1.0f};
            pg8::gemm_phase<0, pg8::EpiZ>(L, g, S, E); }
        {
            pg8::Gemm g{(const bf16_t*)(WSP + WS_H8), (const bf16_t*)(WSP + WS_WIN8), DM / 2, DM / 2, 14, nullptr, nullptr, 0, 2, 4, 8};
            pg8::StaticOrder S; S.init(MROWS / 256, 14, G, blk);
            pg8::EpiZ E{Z, Qc, Kc, Vc, ropec, ropes, GFb, 1.0f / (FP8_SA1 * FP8_SB1)};
            pg8::gemm_phase<0, pg8::EpiZ, false, true>(L, g, S, E); }
        if (BOTH(1) || rep_ + 1 < REP_1) GRID_BAR();
    }
    PSTAMP(1);

    if (IN(2)) {
        REPLOOP(2B) {
            constexpr int PQ = 136;
            LAS bf16_t* Qs = (LAS bf16_t*)L;
            LAS bf16_t* Ks = Qs + 128 * PQ;
            LAS bf16_t* VTs = Ks + 128 * PQ;
            LAS bf16_t* Cs = VTs + 144 * PQ;
            LAS float* fv = (LAS float*)(Cs + 144 * PQ);
            LAS float* v_a = fv;
            LAS float* v_M = fv + 128;
            LAS float* v_b = fv + 256;
            LAS float* v_w = fv + 384;
            LAS float* v_sc = fv + 512;
            LAS float* cw = fv + 528;
            const float* convw = PF(5); const float* convb = PF(6); const float* mlg = PF(13); const float* gatesp = gates;
            bf16_t* Zp = Z; bf16_t* YCp = YCb;
            for (int u = blk; u < NB * 4; u += G) {
                const int b = u >> 2, h = u & 3;
                __syncthreads();
                for (int i = tid; i < 5 * 256; i += 512) { const int j = i >> 8, c = i & 255; const int ch = (c < 128) ? (h * 128 + c) : (512 + h * 128 + (c - 128));
                    cw[i] = (j < 4) ? convw[j * 1024 + ch] : convb[ch]; }
                for (int i = tid; i < 144 * PQ; i += 512) { const int rr = i / PQ; VTs[i] = (rr == 128) ? (bf16_t)0x3f80 : (bf16_t)0; Cs[i] = 0; }
                if (tid == 0) v_sc[0] = 0.f;
                f32x4 Cst[9];
#pragma unroll
                for (int jt = 0; jt < 9; ++jt) Cst[jt] = (f32x4){0.f, 0.f, 0.f, 0.f};
                LAS float* gml_s = cw + 1280 + 384;
                int tid_o = tid; asm volatile("" : "+v"(tid_o));
#define ML_IDX() int tq_ = tid_o; asm volatile("" : "+v"(tq_)); const int dg = tq_ & 15, s0 = (tq_ >> 4) * 4, fr = tq_ & 15, quad = (tq_ >> 4) & 3; (void)dg; (void)s0; (void)fr; (void)quad;
                LAS bf16_t* halo = (LAS bf16_t*)(cw + 1280);
                for (int i = tid_o; i < 2 * 3 * 128; i += 512) halo[i] = 0;
                if (tid_o < 128) gml_s[tid_o] = mlg[h * 128 + tid_o];
                u32x4 rq[4], rk[4], rv[4]; float gx0 = 0.f, gx1 = 0.f, gi0 = -1e30f, gi1 = -1e30f;
#define ML_LBAR() asm volatile("s_waitcnt lgkmcnt(0)\n\ts_barrier" ::: "memory")
#define ML_LOADRAW(tc0) do { \
                    _Pragma("unroll") for (int i_ = 0; i_ < 4; ++i_) { const int t_ = (tc0) + s0 + i_; rq[i_] = (u32x4){0u, 0u, 0u, 0u}; rk[i_] = rq[i_]; rv[i_] = rq[i_]; \
                        if (t_ < TT) { const bf16_t* zr_ = Zp + (size_t)row_of(b, t_) * NZ + h * 128 + dg * 8; rq[i_] = *(const u32x4*)(zr_ + ZMQ); rk[i_] = *(const u32x4*)(zr_ + ZMK); rv[i_] = *(const u32x4*)(zr_ + ZMV); } } \
                    if (wave == 0) { const int ta_ = (tc0) + 2 * lane, tb_ = ta_ + 1; \
                        gx0 = (ta_ < TT) ? ld_agent_f(gatesp + (size_t)row_of(b, ta_) * 8 + 4 + h) : 0.f; gi0 = (ta_ < TT) ? ld_agent_f(gatesp + (size_t)row_of(b, ta_) * 8 + h) : -1e30f; \
                        gx1 = (tb_ < TT) ? ld_agent_f(gatesp + (size_t)row_of(b, tb_) * 8 + 4 + h) : 0.f; gi1 = (tb_ < TT) ? ld_agent_f(gatesp + (size_t)row_of(b, tb_) * 8 + h) : -1e30f; } } while (0)
                { ML_IDX(); ML_LOADRAW(0); }
                for (int c = 0; c < 33; ++c) {
                    const int t0 = c * 128;
                    ML_LBAR(); CSTAMP(0);
                    if (wave == 0) {
                        const float m_old0 = v_sc[0];
                        const float x0 = gx0, x1 = gx1, i0 = gi0, i1 = gi1;
                        const float sacc = wave_scan_add(x0 + x1);
                        const float ex = sacc - (x0 + x1);
                        const float b0 = ex + x0, b1 = b0 + x1;
                        const float a0 = i0 - b0, a1 = i1 - b1;
                        const float mx = wave_scan_max(fmaxf(a0, a1));
                        float exm = __shfl_up(mx, 1); if (lane == 0) exm = -INFINITY;
                        const float M0 = fmaxf(fmaxf(m_old0, exm), a0), M1 = fmaxf(M0, a1);
                        const float Ml = __shfl(M1, 63);
                        v_b[2 * lane] = b0; v_b[2 * lane + 1] = b1; v_a[2 * lane] = a0; v_a[2 * lane + 1] = a1; v_M[2 * lane] = M0; v_M[2 * lane + 1] = M1;
                        v_w[2 * lane] = (t0 + 2 * lane < TT) ? __expf(a0 - Ml) : 0.f; v_w[2 * lane + 1] = (t0 + 2 * lane + 1 < TT) ? __expf(a1 - Ml) : 0.f;
                        if (lane == 63) v_sc[1] = M1;
                    }
                    { ML_IDX();
#pragma unroll
                    for (int i = 0; i < 4; ++i) { *(LAS u32x4*)(Qs + (s0 + i) * PQ + dg * 8) = rq[i]; *(LAS u32x4*)(Ks + (s0 + i) * PQ + dg * 8) = rk[i]; }
#pragma unroll
                    for (int w2 = 0; w2 < 4; ++w2) {
                        const unsigned a0_ = rv[0][w2], a1_ = rv[1][w2], a2_ = rv[2][w2], a3_ = rv[3][w2];
                        u32x2 lo2, hi2; lo2.x = (a0_ & 0xffffu) | (a1_ << 16); lo2.y = (a2_ & 0xffffu) | (a3_ << 16);
                        hi2.x = (a0_ >> 16) | (a1_ & 0xffff0000u); hi2.y = (a2_ >> 16) | (a3_ & 0xffff0000u);
                        *(LAS u32x2*)(VTs + (dg * 8 + 2 * w2) * PQ + s0) = lo2; *(LAS u32x2*)(VTs + (dg * 8 + 2 * w2 + 1) * PQ + s0) = hi2;
                    } }
                    ML_LBAR(); CSTAMP(1);
                    {   ML_IDX();
                        u32x4 hq[3], hk[3];
#pragma unroll
                        for (int i = 0; i < 3; ++i) {
                            if (s0 > 0) { hq[i] = *(const LAS u32x4*)(Qs + (s0 - 3 + i) * PQ + dg * 8); hk[i] = *(const LAS u32x4*)(Ks + (s0 - 3 + i) * PQ + dg * 8); }
                            else { hq[i] = *(const LAS u32x4*)(halo + i * 128 + dg * 8); hk[i] = *(const LAS u32x4*)(halo + 384 + i * 128 + dg * 8); }
                        }
                        asm volatile("s_waitcnt lgkmcnt(0)" ::: "memory");
                        ML_LBAR(); CSTAMP(2);
                        u32x4 cq[4], ck[4];
#pragma unroll
                        for (int w2 = 0; w2 < 4; ++w2) {
                            int dgo = dg; asm volatile("" : "+v"(dgo));
                            f32x2 xq[7], xk[7];
#pragma unroll
                            for (int r = 0; r < 7; ++r) { const unsigned uq = (r < 3) ? hq[r < 3 ? r : 0][w2] : rq[r >= 3 ? r - 3 : 0][w2], uk = (r < 3) ? hk[r < 3 ? r : 0][w2] : rk[r >= 3 ? r - 3 : 0][w2];
                                xq[r] = (f32x2){bflo(uq), bfhi(uq)}; xk[r] = (f32x2){bflo(uk), bfhi(uk)}; }
                            const LAS f32x2* wp = (const LAS f32x2*)(cw + dgo * 8 + 2 * w2);
                            f32x2 wq[4], wk[4];
#pragma unroll
                            for (int j = 0; j < 4; ++j) { wq[j] = wp[j * 128]; wk[j] = wp[j * 128 + 64]; }
                            const f32x2 bq = wp[4 * 128], bk = wp[4 * 128 + 64];
#pragma unroll
                            for (int i = 0; i < 4; ++i) {
                                f32x2 aq = bq, ak = bk;
#pragma unroll
                                for (int j = 0; j < 4; ++j) { aq += wq[j] * xq[i + j]; ak += wk[j] * xk[i + j]; }
                                const bool live = (t0 + s0 + i < TT);
                                const float q0 = live ? aq[0] * sigmoidf_(aq[0]) : 0.f, q1 = live ? aq[1] * sigmoidf_(aq[1]) : 0.f;
                                const float k0 = live ? ak[0] * sigmoidf_(ak[0]) * 0.08838834764831845f : 0.f, k1 = live ? ak[1] * sigmoidf_(ak[1]) * 0.08838834764831845f : 0.f;
                                cq[i][w2] = pkbf(q0, q1); ck[i][w2] = pkbf(k0, k1);
                            }
                        }
#pragma unroll
                        for (int i = 0; i < 4; ++i) { *(LAS u32x4*)(Qs + (s0 + i) * PQ + dg * 8) = cq[i]; *(LAS u32x4*)(Ks + (s0 + i) * PQ + dg * 8) = ck[i]; }
                    if (s0 == 124) {
#pragma unroll
                        for (int i = 0; i < 3; ++i) { *(LAS u32x4*)(halo + i * 128 + dg * 8) = rq[i + 1]; *(LAS u32x4*)(halo + 384 + i * 128 + dg * 8) = rk[i + 1]; }
                    }
                    if (c + 1 < 33) ML_LOADRAW(t0 + 128);
                    }
                    ML_LBAR(); CSTAMP(3);
                    const float Mlast = v_sc[1], m_old = v_sc[0];
                    f32x4 St[8];
#pragma unroll
                    for (int j = 0; j < 8; ++j) St[j] = (f32x4){0.f, 0.f, 0.f, 0.f};
                    {   ML_IDX();
                        bf16x8 af[4];
#pragma unroll
                        for (int kk = 0; kk < 4; ++kk) af[kk] = *(const LAS bf16x8*)(Qs + (16 * wave + fr) * PQ + kk * 32 + quad * 8);
#pragma unroll
                        for (int j = 0; j < 8; ++j) if (j <= wave) {
#pragma unroll
                            for (int kk = 0; kk < 4; ++kk) { const bf16x8 bfv = *(const LAS bf16x8*)(Ks + (16 * j + fr) * PQ + kk * 32 + quad * 8);
                                St[j] = __builtin_amdgcn_mfma_f32_16x16x32_bf16(af[kk], bfv, St[j], 0, 0, 0); }
                        }
                    }
                    {   ML_IDX();
                        const float w_old = __expf(m_old - Mlast);
#pragma unroll
                        for (int jt = 0; jt < 9; ++jt) Cst[jt] = Cst[jt] * w_old;
#pragma unroll
                        for (int kk = 0; kk < 4; ++kk) {
                            const int rb = 32 * kk + 8 * quad;
                            const LAS bf16_t* kp = Ks + (rb + (fr >> 2)) * PQ + 16 * wave + 4 * (fr & 3);
                            const attn_body::s16x4 lo = attn_body::vtr((attn_body::lds_cptr)kp), hi4 = attn_body::vtr((attn_body::lds_cptr)(kp + 4 * PQ));
                            const f32x4 w0 = *(const LAS f32x4*)(v_w + rb), w1 = *(const LAS f32x4*)(v_w + rb + 4);
                            float kf[8];
#pragma unroll
                            for (int q = 0; q < 4; ++q) { kf[q] = __uint_as_float(((unsigned)(unsigned short)lo[q]) << 16) * w0[q]; kf[4 + q] = __uint_as_float(((unsigned)(unsigned short)hi4[q]) << 16) * w1[q]; }
                            u32x4 kw; kw.x = pkbf(kf[0], kf[1]); kw.y = pkbf(kf[2], kf[3]); kw.z = pkbf(kf[4], kf[5]); kw.w = pkbf(kf[6], kf[7]);
                            const bf16x8 bk = __builtin_bit_cast(bf16x8, kw);
#pragma unroll
                            for (int jt = 0; jt < 9; ++jt) { const bf16x8 av = *(const LAS bf16x8*)(VTs + (16 * jt + fr) * PQ + kk * 32 + quad * 8);
                                Cst[jt] = __builtin_amdgcn_mfma_f32_16x16x32_bf16(av, bk, Cst[jt], 0, 0, 0); }
                        }
                    }
                    ML_LBAR(); CSTAMP(4);
                    {   ML_IDX();
                        float Ms[4];
#pragma unroll
                        for (int jj = 0; jj < 4; ++jj) Ms[jj] = v_M[16 * wave + 4 * quad + jj];
#pragma unroll
                        for (int j = 0; j < 8; ++j) {
                            const int r = 16 * j + fr; const float ar = v_a[r];
#pragma unroll
                            for (int jj = 0; jj < 4; ++jj) { const int sx = 16 * wave + 4 * quad + jj;
                                const float w = (j <= wave && r <= sx) ? St[j][jj] * __expf(ar - Ms[jj]) : 0.f;
                                Ks[sx * PQ + r] = (bf16_t)(pkbf(w, 0.f) & 0xffffu); }
                        }
                    }
                    ML_LBAR(); CSTAMP(5);
                    float hv[8][4];
                    {   ML_IDX();
                        bf16x8 af[4], as_[4];
#pragma unroll
                        for (int kk = 0; kk < 4; ++kk) { af[kk] = *(const LAS bf16x8*)(Qs + (16 * wave + fr) * PQ + kk * 32 + quad * 8); as_[kk] = *(const LAS bf16x8*)(Ks + (16 * wave + fr) * PQ + kk * 32 + quad * 8); }
                        float winter[4], rd[4], ssq[4];
                        {   f32x4 n1 = (f32x4){0.f, 0.f, 0.f, 0.f}, n2 = n1;
#pragma unroll
                            for (int kk = 0; kk < 4; ++kk) { const bf16x8 bc = *(const LAS bf16x8*)(Cs + (128 + fr) * PQ + kk * 32 + quad * 8); const bf16x8 bvv = *(const LAS bf16x8*)(VTs + (128 + fr) * PQ + kk * 32 + quad * 8);
                                n1 = __builtin_amdgcn_mfma_f32_16x16x32_bf16(af[kk], bc, n1, 0, 0, 0); n2 = __builtin_amdgcn_mfma_f32_16x16x32_bf16(as_[kk], bvv, n2, 0, 0, 0); }
#pragma unroll
                            for (int jj = 0; jj < 4; ++jj) { const int sx = 16 * wave + 4 * quad + jj; const float Ms = v_M[sx]; winter[jj] = __expf(m_old - Ms);
                                float den = winter[jj] * n1[jj] + n2[jj];
                                den = __shfl(den, lane & 48);
                                rd[jj] = 1.0f / fmaxf(fabsf(den), __expf(-(v_b[sx] + Ms))); ssq[jj] = 0.f; }
                        }
#pragma unroll
                        for (int g2 = 0; g2 < 2; ++g2) {
                            f32x4 n1[4], n2[4];
#pragma unroll
                            for (int q = 0; q < 4; ++q) { n1[q] = (f32x4){0.f, 0.f, 0.f, 0.f}; n2[q] = n1[q]; }
#pragma unroll
                            for (int kk = 0; kk < 4; ++kk)
#pragma unroll
                                for (int q = 0; q < 4; ++q) { const int jt = 4 * g2 + q;
                                    const bf16x8 bc = *(const LAS bf16x8*)(Cs + (16 * jt + fr) * PQ + kk * 32 + quad * 8); const bf16x8 bvv = *(const LAS bf16x8*)(VTs + (16 * jt + fr) * PQ + kk * 32 + quad * 8);
                                    n1[q] = __builtin_amdgcn_mfma_f32_16x16x32_bf16(af[kk], bc, n1[q], 0, 0, 0); n2[q] = __builtin_amdgcn_mfma_f32_16x16x32_bf16(as_[kk], bvv, n2[q], 0, 0, 0); }
#pragma unroll
                            for (int q = 0; q < 4; ++q)
#pragma unroll
                                for (int jj = 0; jj < 4; ++jj) { const float x = (winter[jj] * n1[q][jj] + n2[q][jj]) * rd[jj]; hv[4 * g2 + q][jj] = x; ssq[jj] += x * x; }
                        }
#pragma unroll
                        for (int jj = 0; jj < 4; ++jj) { const float rs = 1.0f / sqrtf(row_sum16(ssq[jj]) * (1.f / 128.f) + LN_EPS);
#pragma unroll
                            for (int jt = 0; jt < 8; ++jt) hv[jt][jj] *= rs * gml_s[16 * jt + fr]; }
                    }
                    ML_LBAR(); CSTAMP(6);
                    u32x4 rmo[4];
                    { ML_IDX();
#pragma unroll
                    for (int i = 0; i < 4; ++i) { const int t = t0 + s0 + i; rmo[i] = (u32x4){0u, 0u, 0u, 0u};
                        if (t >= NMETA && t < TT) rmo[i] = *(const u32x4*)(Zp + (size_t)row_of(b, t) * NZ + ZMO + h * 128 + dg * 8); }
#pragma unroll
                    for (int jt = 0; jt < 8; ++jt)
#pragma unroll
                        for (int jj = 0; jj < 4; ++jj) Qs[(16 * wave + 4 * quad + jj) * PQ + 16 * jt + fr] = (bf16_t)(pkbf(hv[jt][jj], 0.f) & 0xffffu);
#pragma unroll
                    for (int jt = 0; jt < 9; ++jt)
#pragma unroll
                        for (int jj = 0; jj < 4; ++jj) Cs[(16 * jt + 4 * quad + jj) * PQ + 16 * wave + fr] = (bf16_t)(pkbf(Cst[jt][jj], 0.f) & 0xffffu);
                    if (tid == 0) v_sc[0] = v_b[127] + Mlast;
                    }
                    ML_LBAR(); CSTAMP(7);
                    { ML_IDX();
#pragma unroll
                    for (int i = 0; i < 4; ++i) {
                        const int s = s0 + i, t = t0 + s;
                        if (t >= NMETA && t < TT) {
                            const u32x4 hw = *(const LAS u32x4*)(Qs + s * PQ + dg * 8);
                            const u32x4 mw = rmo[i];
                            u32x4 wy;
                            wy.x = pkbf(sigmoidf_(bflo(mw.x)) * bflo(hw.x), sigmoidf_(bfhi(mw.x)) * bfhi(hw.x)); wy.y = pkbf(sigmoidf_(bflo(mw.y)) * bflo(hw.y), sigmoidf_(bfhi(mw.y)) * bfhi(hw.y));
                            wy.z = pkbf(sigmoidf_(bflo(mw.z)) * bflo(hw.z), sigmoidf_(bfhi(mw.z)) * bfhi(hw.z)); wy.w = pkbf(sigmoidf_(bflo(mw.w)) * bflo(hw.w), sigmoidf_(bfhi(mw.w)) * bfhi(hw.w));
                            *(u32x4*)(YCp + (size_t)row_of(b, t) * DM + 512 + h * 128 + dg * 8) = wy;
                        }
                    } }
                }
            }
        }
#undef ML_LOADRAW
#undef ML_LBAR
#undef ML_IDX
        PSTAMP(13);
        __syncthreads();
        REPLOOP(2A) {
            LAS int* tkt = (LAS int*)(L + MISC_OFF + 16);
            bf16_t* Qcp = Qc; bf16_t* Kcp = Kc; bf16_t* Vcp = Vc; bf16_t* YCp2 = YCb; unsigned* tctr = ctl + CW_TICKET + 64 * rep_;
            const float* attg = PF(12); unsigned char* parkb = WSP + WS_O;
            float lam;
            { const float p1 = wave_sum(PF(8)[lane] * PF(9)[lane]), p2 = wave_sum(PF(10)[lane] * PF(11)[lane]); lam = expf(p1) - expf(p2) + LAMBDA_INIT; }
            const float* wgu = PF(21); const float* wdn = PF(23); bf16_t* WguTp = WguT; bf16_t* WdnTp = WdnT;
            constexpr int NATT = NB * 4 * 16, NJOB = NE * 16;
            int nextT = 0;
            if (tid == 0) nextT = (int)__hip_atomic_fetch_add(tctr, 1u, RLX_AGENT);
            for (;;) {
                __syncthreads();
                if (tid == 0) { *tkt = nextT; nextT = (int)__hip_atomic_fetch_add(tctr, 1u, RLX_AGENT); }
                __syncthreads();
                const int T = __builtin_amdgcn_readfirstlane(*tkt);
                if (T >= NATT + NJOB) break;
                int Lidx;
                { const int q = T / 3, r = T - q * 3;
                  if (q < NJOB) {
                      if (r == 2) {
                          const int e = q >> 4, kb = q & 15; LAS unsigned char* scr = L + wave * 17408;
                          for (int it = wave; it < 48; it += NWAVES) {
                              if (it < 32) transpose_tile64_fp8(wgu + (size_t)e * 1024 * 2048, 2048, (unsigned char*)WguTp + (size_t)e * 2048 * 1024, 1024, scr, 64 * kb, 64 * it, lane, InvGu(), FP8_SB1);
                              else transpose_tile64_fp8(wdn + (size_t)e * 1024 * 1024, 1024, (unsigned char*)WdnTp + (size_t)e * 1024 * 1024, 1024, scr, 64 * kb, 64 * (it - 32), lane, InvIdent(), FP8_SB2);
                          }
                          continue;
                      }
                      Lidx = q * 2 + r;
                  } else Lidx = T - NJOB; }
                const int bh = Lidx & 63, qb = 15 - (Lidx >> 6);
                const int b = bh >> 2, h = bh & 3;
                int tid_p = tid; asm volatile("" : "+v"(tid_p));
                u32x4* parkp = (u32x4*)parkb + ((size_t)blk * 512 + tid_p) * 8;
                attn_body::attn4_unit<8>(qb, (const attn_body::bf16*)(Qcp + (size_t)(b * 8 + 2 * h) * TT * 64), (const attn_body::bf16*)(Kcp + (size_t)(b * 8 + 2 * h) * TT * 64), (long)TT * 64,
                                         (const attn_body::bf16*)(Vcp + (size_t)(b * 4 + h) * TT * 128), YCp2, b * SEQ, h * 128, lam, attg, parkp, (char*)lds);
            }
        }
        __syncthreads();
        if (BOTH(2)) GRID_BAR();
    }
    PSTAMP(2);

    PSTAMP(3);

    if (IN(4)) REPLOOP(4) {
        {   pg8::Gemm g{YCb, WaT, DM, 1024, 4, nullptr, nullptr, 0};
            pg8::StaticOrder S; S.init(NREAL / 256, 4, G, blk);
            pg8::EpiGateFused E{GFb, MRGb};
            pg8::gemm_phase<0, pg8::EpiGateFused, true>(L, g, S, E); }
        if (BOTH(4) || rep_ + 1 < REP_4) GRID_BAR();
    }
    PSTAMP(4);

    if (IN(5)) REPLOOP(5) {
        pg8::Gemm g{MRGb, WoT, DM, 1024, 4, nullptr, nullptr, 0};
        pg8::StaticOrder S; S.init(NREAL / 256, 4, G, blk);
        pg8::EpiStoreBf16 E{TMPb, DM};
        pg8::gemm_phase<0, pg8::EpiStoreBf16>(L, g, S, E);
        if (BOTH(5) || rep_ + 1 < REP_5) GRID_BAR();
    }
    PSTAMP(5);

    constexpr int NPART = 256, RPP = NREAL / NPART;
    static_assert(NPART * RPP == NREAL, "partitions");
    if (IN(6)) REPLOOP(6) {
        LAS float* wrT = (LAS float*)L;
        LAS int* hcnt = (LAS int*)(L + 131072);
        { const float* wr = PF(19);
          for (int i = tid; i < 8 * 1024; i += 512) { const int k = i & 1023, q4 = i >> 10; const f32x4 v = *(const f32x4*)(wr + k * 32 + 4 * q4);
              wrT[(4 * q4 + 0) * 1024 + k] = v[0]; wrT[(4 * q4 + 1) * 1024 + k] = v[1]; wrT[(4 * q4 + 2) * 1024 + k] = v[2]; wrT[(4 * q4 + 3) * 1024 + k] = v[3]; } }
        const float* xin = PF(0); const float* g0p = PF(2); const float* b0p = PF(3); const float* statsp = stats; const bf16_t* mixp = TMPb;
        const float* g1p = PF(17); const float* b1p = PF(18);
        const float brt = PF(20)[(lane >> 1) & 31];
        bf16_t* Hbp = Hb; int* tokE = tok_e; float* tokG = tok_g; int* histp = hist; unsigned char* H8p = WSP + WS_H8;
        for (int part = blk; part < NPART; part += G) {
            __syncthreads();
            if (tid < 32) hcnt[tid] = 0;
            __syncthreads();
            const int rbeg = part * RPP, rend = rbeg + RPP;
            constexpr int RPW = (RPP + NWAVES - 1) / NWAVES;
            const int wbeg = rbeg + wave * RPW, wend = (wbeg + RPW < rend) ? wbeg + RPW : rend;
            for (int row = wbeg; row < wend; row += 2) {
                int lane_o = lane; asm volatile("" : "+v"(lane_o));
                const bool two = (row + 1 < wend);
                const int row1 = two ? row + 1 : row;
                const float m0_ = ld_agent_f(statsp + 2 * row), r0_ = ld_agent_f(statsp + 2 * row + 1), m1_ = ld_agent_f(statsp + 2 * row1), r1_ = ld_agent_f(statsp + 2 * row1 + 1);
                f32x4 v0[4], v1[4]; float s0 = 0.f, s1 = 0.f;
#pragma unroll
                for (int j = 0; j < 4; ++j) { v0[j] = *(const f32x4*)(xin + (size_t)row * DM + 4 * lane_o + 256 * j); v1[j] = *(const f32x4*)(xin + (size_t)row1 * DM + 4 * lane_o + 256 * j); }
#pragma unroll
                for (int j = 0; j < 4; ++j) {
                    const u32x2 x0 = *(const u32x2*)(mixp + (size_t)row * DM + 4 * lane_o + 256 * j), x1 = *(const u32x2*)(mixp + (size_t)row1 * DM + 4 * lane_o + 256 * j);
                    const f32x4 g0v = *(const f32x4*)(g0p + 4 * lane_o + 256 * j), b0v = *(const f32x4*)(b0p + 4 * lane_o + 256 * j);
                    v0[j] = ((v0[j] - m0_) * r0_ * g0v + b0v) * DN_ALPHA + (f32x4){bflo(x0.x), bfhi(x0.x), bflo(x0.y), bfhi(x0.y)};
                    v1[j] = ((v1[j] - m1_) * r1_ * g0v + b0v) * DN_ALPHA + (f32x4){bflo(x1.x), bfhi(x1.x), bflo(x1.y), bfhi(x1.y)};
                }
#pragma unroll
                for (int j = 0; j < 4; ++j) { s0 += (v0[j][0] + v0[j][1]) + (v0[j][2] + v0[j][3]); s1 += (v1[j][0] + v1[j][1]) + (v1[j][2] + v1[j][3]); }
                const float mean0 = wave_sum(s0) * (1.f / DM), mean1 = wave_sum(s1) * (1.f / DM); float q0 = 0.f, q1 = 0.f;
#pragma unroll
                for (int j = 0; j < 4; ++j) { const f32x4 d0 = v0[j] - mean0, d1 = v1[j] - mean1;
                    q0 += (d0[0] * d0[0] + d0[1] * d0[1]) + (d0[2] * d0[2] + d0[3] * d0[3]); q1 += (d1[0] * d1[0] + d1[1] * d1[1]) + (d1[2] * d1[2] + d1[3] * d1[3]); }
                const float rstd0 = 1.0f / sqrtf(wave_sum(q0) * (1.f / DM) + LN_EPS), rstd1 = 1.0f / sqrtf(wave_sum(q1) * (1.f / DM) + LN_EPS);
#pragma unroll
                for (int j = 0; j < 4; ++j) {
                    const f32x4 ggj = *(const f32x4*)(g1p + 4 * lane_o + 256 * j), bbj = *(const f32x4*)(b1p + 4 * lane_o + 256 * j);
                    v0[j] = (v0[j] - mean0) * rstd0 * ggj + bbj; v1[j] = (v1[j] - mean1) * rstd1 * ggj + bbj;
                    u32x2 w; w.x = pkbf(v0[j][0], v0[j][1]); w.y = pkbf(v0[j][2], v0[j][3]);
                    *(u32x2*)(Hbp + (size_t)row * DM + 4 * lane_o + 256 * j) = w;
                    *(unsigned*)(H8p + (size_t)row * DM + 4 * lane_o + 256 * j) = pkfp8x4(v0[j][0] * FP8_SA1, v0[j][1] * FP8_SA1, v0[j][2] * FP8_SA1, v0[j][3] * FP8_SA1);
                    if (two) { w.x = pkbf(v1[j][0], v1[j][1]); w.y = pkbf(v1[j][2], v1[j][3]); *(u32x2*)(Hbp + (size_t)row1 * DM + 4 * lane_o + 256 * j) = w;
                        *(unsigned*)(H8p + (size_t)row1 * DM + 4 * lane_o + 256 * j) = pkfp8x4(v1[j][0] * FP8_SA1, v1[j][1] * FP8_SA1, v1[j][2] * FP8_SA1, v1[j][3] * FP8_SA1); }
                }
                float p0[32], p1[32];
#pragma unroll
                for (int e = 0; e < 32; ++e) {
                    f32x2 a0 = (f32x2){0.f, 0.f}, a1 = a0;
#pragma unroll
                    for (int j = 0; j < 4; ++j) { const f32x4 wv = *(const LAS f32x4*)(wrT + e * 1024 + 4 * lane_o + 256 * j);
                        const f32x2 wl = (f32x2){wv[0], wv[1]}, wh = (f32x2){wv[2], wv[3]};
                        a0 += (f32x2){v0[j][0], v0[j][1]} * wl; a0 += (f32x2){v0[j][2], v0[j][3]} * wh;
                        a1 += (f32x2){v1[j][0], v1[j][1]} * wl; a1 += (f32x2){v1[j][2], v1[j][3]} * wh; }
                    p0[e] = a0[0] + a0[1]; p1[e] = a1[0] + a1[1];
                    if ((e & 3) == 3) __builtin_amdgcn_sched_barrier(0);
                }
                float lg0 = xreduce32(p0, lane_o) + brt, lg1 = xreduce32(p1, lane_o) + brt;
#pragma unroll
                for (int rr = 0; rr < 2; ++rr) {
                    float lg = rr ? lg1 : lg0; const int rw = rr ? row1 : row;
                    float tv[4]; int ti[4];
#pragma unroll
                    for (int k = 0; k < 4; ++k) {
                        const float mx = wave_max(lg);
                        const unsigned long long bal = __ballot(lg == mx);
                        const int idx = (__ffsll((long long)bal) - 1) >> 1;
                        tv[k] = mx; ti[k] = idx;
                        if ((lane_o >> 1) == idx) lg = -INFINITY;
                    }
                    const float e1 = __expf(tv[1] - tv[0]), e2 = __expf(tv[2] - tv[0]), e3 = __expf(tv[3] - tv[0]);
                    const float inv = 1.0f / (1.0f + e1 + e2 + e3);
                    if (lane_o < 4 && (rr == 0 || two)) {
                        const int idx = (lane_o == 0) ? ti[0] : (lane_o == 1) ? ti[1] : (lane_o == 2) ? ti[2] : ti[3];
                        const float gv = ((lane_o == 0) ? 1.0f : (lane_o == 1) ? e1 : (lane_o == 2) ? e2 : e3) * inv;
                        tokE[(size_t)rw * 4 + lane_o] = idx; tokG[(size_t)rw * 4 + lane_o] = gv;
                        atomicAdd((int*)&hcnt[idx], 1);
                    }
                }
            }
            __syncthreads();
            if (tid < 32) histp[part * 32 + tid] = hcnt[tid];
        }
        if (BOTH(6) || rep_ + 1 < REP_6) GRID_BAR();
    }
    PSTAMP(6);

    if (IN(7)) REPLOOP(7) {
        LAS int* cnt_s = (LAS int*)L; LAS int* base_s = cnt_s + 32; LAS int* pst_s = cnt_s + 64;
        LAS int* ptot = cnt_s + 128; LAS int* pbase = ptot + 512;
        LAS int* ccnt = pbase + 512;
        LAS int* ent = ccnt + 1024; LAS int* lrank = ent + RPP * 4 + 64;
        int* rowOff = row_off; int* rowSlot = row_slot; float* rowGate = row_gate; const int* histp = hist; const int* tokE = tok_e; const float* tokG = tok_g;
        for (int part = blk; part < NPART; part += G) {
            __syncthreads();
            { const int e = tid & 31, q = tid >> 5; int tot = 0, bs = 0;
#pragma unroll 4
              for (int b2 = q * 16; b2 < q * 16 + 16; ++b2) { const int v = ld_agent_i(histp + b2 * 32 + e); tot += v; bs += (b2 < part) ? v : 0; }
              ptot[q * 32 + e] = tot; pbase[q * 32 + e] = bs; }
            const int rbeg = part * RPP, n4 = RPP * 4;
            for (int i = tid; i < n4; i += 512) ent[i] = ld_agent_i(tokE + (size_t)rbeg * 4 + i);
            __syncthreads();
            if (tid < 32) { int tot = 0, bs = 0;
#pragma unroll
                for (int q = 0; q < 16; ++q) { tot += ptot[q * 32 + tid]; bs += pbase[q * 32 + tid]; }
                cnt_s[tid] = tot; base_s[tid] = bs; }
            constexpr int NCH = (RPP * 4 + 63) / 64;
            for (int c = wave; c < NCH; c += NWAVES) {
                const int i = 64 * c + lane; const int my = (i < n4) ? ent[i] : -1; int lr = 0;
#pragma unroll 4
                for (int e = 0; e < 32; ++e) { const unsigned long long b = __ballot(my == e);
                    if (lane == e) ccnt[c * 32 + e] = __popcll(b);
                    if (my == e) lr = __popcll(b & ((1ull << lane) - 1ull)); }
                if (i < n4) lrank[i] = lr;
            }
            __syncthreads();
            if (tid == 0) { int p = 0; for (int e = 0; e < 32; ++e) { pst_s[e] = p; p += (cnt_s[e] + 255) & ~255; } pst_s[32] = p; }
            __syncthreads();
            if (tid < 32) { int run = pst_s[tid] + base_s[tid];
                for (int c = 0; c < NCH; ++c) { const int tmp = ccnt[c * 32 + tid]; ccnt[c * 32 + tid] = run; run += tmp; } }
            __syncthreads();
            for (int i = tid; i < n4; i += 512) { const int e = ent[i]; const int pos = ccnt[(i >> 6) * 32 + e] + lrank[i];
                rowOff[pos] = (rbeg + (i >> 2)) * DM;        rowSlot[pos] = rbeg * 4 + i; rowGate[pos] = ld_agent_f(tokG + (size_t)rbeg * 4 + i); }
            if (part < 32) { const int e = part; for (int r = pst_s[e] + cnt_s[e] + tid; r < pst_s[e + 1]; r += 512) { rowOff[r] = 0; rowSlot[r] = NREAL * 4; rowGate[r] = 0.f; } }
            if (part == 0) { const int nT = pst_s[32] >> 8; int* te = tile_exp;
                for (int t = tid; t < nT; t += 512) { int e = 0; while (e < 31 && t * 256 >= pst_s[e + 1]) ++e; te[t] = e; }
                if (tid == 0) __hip_atomic_store((int*)(ctl + CW_NT), nT, RLX_AGENT); }
        }
        __syncthreads();
        if (BOTH(7) || rep_ + 1 < REP_7) GRID_BAR();
    }
    PSTAMP(7);

    {
        int nT = 0, TPC = 0;
        if (lo < 12 && hi > 8) { nT = __builtin_amdgcn_readfirstlane(ld_agent_i((const int*)(ctl + CW_NT))); TPC = (nT > 512) ? 512 : nT; }
        if (IN(8)) REPLOOP(8) {
            pg8::Gemm g{(const bf16_t*)(WSP + WS_H8), WguT, DM, DM / 2, 8, row_off, tile_exp, 0};
            pg8::StaticOrder S; S.init(TPC, 8, G, blk);
            pg8::EpiAct E{ACT, PF(22), tile_exp, 0, 1.0f / (FP8_SA1 * FP8_SB1)};
            pg8::gemm_phase<1, pg8::EpiAct, false, true>(L, g, S, E);
            if (BOTH(8) || rep_ + 1 < REP_8) GRID_BAR();
        }
        PSTAMP(8);
        if (IN(9)) REPLOOP(9) {
            pg8::Gemm g{ACT, WdnT, FF / 2, FF / 2, 4, nullptr, tile_exp, 0};
            pg8::StaticOrder S; S.init(TPC, 4, G, blk);
            pg8::EpiDown E{Y, PF(24), tile_exp, row_slot, row_gate, 0, 1.0f / (FP8_SA2 * FP8_SB2)};
            pg8::gemm_phase<2, pg8::EpiDown, false, true>(L, g, S, E);
            if (BOTH(9) || rep_ + 1 < REP_9) GRID_BAR();
        }
        PSTAMP(9);
        if (IN(10)) REPLOOP(10) {
            pg8::Gemm g{(const bf16_t*)(WSP + WS_H8), WguT, DM, DM / 2, 8, row_off, tile_exp, TPC};
            pg8::StaticOrder S; S.init(nT - TPC, 8, G, blk);
            pg8::EpiAct E{ACT, PF(22), tile_exp, TPC, 1.0f / (FP8_SA1 * FP8_SB1)};
            pg8::gemm_phase<1, pg8::EpiAct, false, true>(L, g, S, E);
            if (BOTH(10) || rep_ + 1 < REP_10) GRID_BAR();
        }
        PSTAMP(10);
        if (IN(11)) REPLOOP(11) {
            pg8::Gemm g{ACT, WdnT, FF / 2, FF / 2, 4, nullptr, tile_exp, TPC};
            pg8::StaticOrder S; S.init(nT - TPC, 4, G, blk);
            pg8::EpiDown E{Y, PF(24), tile_exp, row_slot, row_gate, TPC, 1.0f / (FP8_SA2 * FP8_SB2)};
            pg8::gemm_phase<2, pg8::EpiDown, false, true>(L, g, S, E);
            if (BOTH(11) || rep_ + 1 < REP_11) GRID_BAR();
        }
        PSTAMP(11);
    }

    if (IN(12)) REPLOOP(12) {
        for (int row = gw; row < NREAL; row += NGW) {
            f32x4 v[4]; float s = 0.f;
#pragma unroll
            for (int j = 0; j < 4; ++j) {
                const u32x2 hw = *(const u32x2*)(Hb + (size_t)row * DM + 4 * lane + 256 * j);
                f32x4 acc = (f32x4){bflo(hw.x), bfhi(hw.x), bflo(hw.y), bfhi(hw.y)} * DN_ALPHA;
#pragma unroll
                for (int k = 0; k < 4; ++k) { const u32x2 yw = *(const u32x2*)(Y + ((size_t)row * 4 + k) * DM + 4 * lane + 256 * j);
                    acc += (f32x4){bflo(yw.x), bfhi(yw.x), bflo(yw.y), bfhi(yw.y)}; }
                v[j] = acc; s += (acc[0] + acc[1]) + (acc[2] + acc[3]);
            }
            const float mean = wave_sum(s) * (1.f / DM); float s2 = 0.f;
#pragma unroll
            for (int j = 0; j < 4; ++j) { const f32x4 d = v[j] - mean; s2 += (d[0] * d[0] + d[1] * d[1]) + (d[2] * d[2] + d[3] * d[3]); }
            const float rstd = 1.0f / sqrtf(wave_sum(s2) * (1.f / DM) + LN_EPS);
            float* orow = (float*)DOUTP + (size_t)row * DM;
#pragma unroll
            for (int j = 0; j < 4; ++j) {
                const f32x4 gg = *(const f32x4*)(PF(25) + 4 * lane + 256 * j), bb = *(const f32x4*)(PF(26) + 4 * lane + 256 * j);
                *(f32x4*)(orow + 4 * lane + 256 * j) = (v[j] - mean) * rstd * gg + bb;
            }
        }
#if MK_PROBE == 2
        __syncthreads();
        PSTAMP(12);
        if (blk == 0 && tid == 0) pdur[14] = pdur[30] - pdur[29];
        if (blk == 0 && tid == 0) { asm volatile("s_waitcnt vmcnt(0)" ::: "memory"); ((float*)DOUTP)[0] += (float)pdur[MK_PROBE_K] * (0.01f / MK_PROBE_DIV); }
#elif MK_PROBE
        __syncthreads();
        if (blk == 0 && tid == 0) { const unsigned cyc = __hip_atomic_load(ctl + CW_PROBE, RLX_AGENT), st = __hip_atomic_load(ctl + CW_PROBE + 1, RLX_AGENT);
            asm volatile("s_waitcnt vmcnt(0)" ::: "memory"); ((float*)DOUTP)[0] += (float)cyc / (float)(st ? st : 1u); }
#endif
    }
#undef IN
#undef BOTH
#undef GRID_BAR
}

constexpr int N_PHASES = 13;
extern "C" void kernel_launch(void* const* d_in, const int* in_sizes, int n_in, void* d_out, int out_size, void* d_ws, size_t ws_size, hipStream_t stream) {
    static int grid = 0;
    if (grid == 0) {
        if (n_in != 27 || ws_size < WS_END) { fprintf(stderr, "kernel_launch: unexpected n_in %d / ws_size %zu\n", n_in, ws_size); grid = -1; return; }
        int dev = 0, cus = 0;
        if (hipGetDevice(&dev) != hipSuccess || hipDeviceGetAttribute(&cus, hipDeviceAttributeMultiprocessorCount, dev) != hipSuccess) { grid = -1; return; }
        if (hipFuncSetAttribute((const void*)hybrid_fwd, hipFuncAttributeMaxDynamicSharedMemorySize, LDS_BYTES) != hipSuccess) { fprintf(stderr, "kernel_launch: hipFuncSetAttribute failed\n"); grid = -1; return; }
        int per_cu = 0;
        (void)hipOccupancyMaxActiveBlocksPerMultiprocessor(&per_cu, (const void*)hybrid_fwd, NWAVES * 64, LDS_BYTES);
        (void)hipGetLastError();
        grid = cus > 0 ? cus : 256;
    }
    if (grid < 0) return;
    (void)hipMemsetAsync((char*)d_ws + WS_CTL, 0, CTL_ZERO_BYTES, stream);
    Args a{};
    const float** fp = (const float**)&a;
    for (int i = 0; i < 27; ++i) fp[i] = (const float*)d_in[i];
    a.out = (float*)d_out; a.ws = (unsigned char*)d_ws;
#if MK_PER_PHASE
    for (int p = 0; p < N_PHASES; ++p) { a.ph_lo = p; a.ph_hi = p + 1; hipLaunchKernelGGL(hybrid_fwd, dim3(grid), dim3(NWAVES * 64), LDS_BYTES, stream, a); }
#else
    a.ph_lo = 0; a.ph_hi = N_PHASES;
    hipLaunchKernelGGL(hybrid_fwd, dim3(grid), dim3(NWAVES * 64), LDS_BYTES, stream, a);
#endif
}
```

```cpp
#include <hip/hip_runtime.h>
#include <hip/hip_bf16.h>
#include <cstdio>
#include <cstdint>
#include <cmath>

#ifndef MK_PER_PHASE
#define MK_PER_PHASE 0
#endif

#ifndef REP_ALL
#define REP_ALL 1
#endif
#ifndef REP_0
#define REP_0 REP_ALL
#endif
#ifndef REP_1
#define REP_1 REP_ALL
#endif
#ifndef REP_2A
#define REP_2A REP_ALL
#endif
#ifndef REP_2B
#define REP_2B REP_ALL
#endif
#ifndef REP_3
#define REP_3 REP_ALL
#endif
#ifndef REP_4
#define REP_4 REP_ALL
#endif
#ifndef REP_5
#define REP_5 REP_ALL
#endif
#ifndef REP_6
#define REP_6 REP_ALL
#endif
#ifndef REP_7
#define REP_7 REP_ALL
#endif
#ifndef REP_8
#define REP_8 REP_ALL
#endif
#ifndef REP_9
#define REP_9 REP_ALL
#endif
#ifndef REP_10
#define REP_10 REP_ALL
#endif
#ifndef REP_11
#define REP_11 REP_ALL
#endif
#ifndef REP_12
#define REP_12 REP_ALL
#endif
#define REPLOOP(k) _Pragma("unroll 1") for (int rep_ = 0; rep_ < REP_##k; ++rep_)
#ifndef MK_PROBE
#define MK_PROBE 0
#endif
#ifndef MK_PROBE_K
#define MK_PROBE_K 2
#define MK_PROBE_DIV 10.0f
#endif
#define LAS __attribute__((address_space(3)))
#define GAS __attribute__((address_space(1)))
typedef unsigned short bf16_t;
typedef short bf16x8 __attribute__((ext_vector_type(8)));
typedef float f32x4 __attribute__((ext_vector_type(4)));
typedef float f32x2 __attribute__((ext_vector_type(2)));
typedef unsigned u32x4 __attribute__((ext_vector_type(4)));
typedef unsigned u32x2 __attribute__((ext_vector_type(2)));
typedef __bf16 bf16x2_t __attribute__((ext_vector_type(2)));
#define RLX_AGENT __ATOMIC_RELAXED, __HIP_MEMORY_SCOPE_AGENT

constexpr int NB = 16, SEQ = 4096, NMETA = 16, TT = SEQ + NMETA  , MROWS = NB * TT  , DM = 1024;
constexpr int NREAL = NB * SEQ;
constexpr int NZP = 5632;
constexpr int NZ = 2080;
constexpr int ZMQ = 0, ZMK = 512, ZMV = 1024, ZMO = 1536, ZGA = 2048, ZGM = 3072;
constexpr int ZYC = 0;
constexpr int NIN = 5640;
constexpr int NE = 32, FF = 1024;
constexpr int OROWS = 4352;
constexpr float LN_EPS = 1e-5f;
constexpr float DN_ALPHA = 1.189207115002721f;
constexpr float LAMBDA_INIT = 0.2f;
constexpr float FP8_SA3 = 16.0f, FP8_SA4 = 64.0f, FP8_SB3 = 512.0f;
constexpr float FP8_SY = 256.0f;
constexpr float FP8_SA2 = 8.0f, FP8_SB2 = 512.0f;
constexpr float FP8_SA1 = 16.0f, FP8_SB1 = 512.0f;
constexpr float ATT_C2 = 0.125f * 1.4426950408889634f;

constexpr size_t MiB = 1u << 20;
constexpr size_t WS_CTL = 0, CTL_ZERO_BYTES = 32768;
constexpr size_t WS_WIN = 2 * MiB;
constexpr size_t WS_WA = 13 * MiB;
constexpr size_t WS_WM = 14 * MiB;
constexpr size_t WS_WO = 15 * MiB;
constexpr size_t WS_ROPE = 17 * MiB;
constexpr size_t WS_STATS = 19 * MiB;
constexpr size_t WS_GATES = 20 * MiB;
constexpr size_t WS_TOKE = 23 * MiB;
constexpr size_t WS_TOKG = 24 * MiB + 512 * 1024;
constexpr size_t WS_HIST = 26 * MiB;
constexpr size_t WS_ROWOFF = 27 * MiB;
constexpr size_t WS_ROWSLOT = 28 * MiB + 512 * 1024;
constexpr size_t WS_ROWGATE = 30 * MiB;
constexpr size_t WS_TILEEXP = 31 * MiB + 512 * 1024;
constexpr size_t WS_H = 32 * MiB;
constexpr size_t WS_Z = 162 * MiB;
constexpr size_t WS_Y = WS_Z;
constexpr size_t WS_ACT = WS_Z + 516 * MiB;
constexpr size_t WS_GF = 424 * MiB;
constexpr size_t WS_QC = 686 * MiB;
constexpr size_t WS_KC = 751 * MiB;
constexpr size_t WS_VC = 816 * MiB;
constexpr size_t WS_TMP = 686 * MiB;
constexpr size_t WS_MRG = 816 * MiB;
constexpr size_t WS_O = 882 * MiB;
constexpr size_t WS_H8 = 952 * MiB;
constexpr size_t WS_WIN8 = 1017 * MiB;
constexpr size_t WS_END = 1024 * MiB;
constexpr size_t DO_WGU = 0;
constexpr size_t DO_YC = 160 * MiB;
constexpr size_t DO_WDN = 128 * MiB;
constexpr int CW_TMO = 0, CW_NT = 64, CW_TICKET = 128  , CW_PROBE = 1024, CW_BAR = 4096;

constexpr int LDS_BYTES = 163840;
constexpr int MISC_OFF = 163840 - 512;
constexpr int NWAVES = 8;

__device__ __forceinline__ unsigned pkbf(float lo, float hi) { f32x2 v = {lo, hi}; bf16x2_t b = __builtin_convertvector(v, bf16x2_t); return __builtin_bit_cast(unsigned, b); }
__device__ __forceinline__ float bflo(unsigned w) { return __uint_as_float(w << 16); }
__device__ __forceinline__ float bfhi(unsigned w) { return __uint_as_float(w & 0xffff0000u); }
__device__ __forceinline__ float sigmoidf_(float x) { return __builtin_amdgcn_rcpf(1.0f + __expf(-x)); }
template <int CTRL> __device__ __forceinline__ float dppf(float v) { return __builtin_bit_cast(float, __builtin_amdgcn_update_dpp(0, __builtin_bit_cast(int, v), CTRL, 0xF, 0xF, true)); }
__device__ __forceinline__ float rdlane(float v, int l) { return __builtin_bit_cast(float, __builtin_amdgcn_readlane(__builtin_bit_cast(int, v), l)); }
__device__ __forceinline__ float row_sum16(float v) { v += dppf<0xB1>(v); v += dppf<0x4E>(v); v += dppf<0x141>(v); v += dppf<0x140>(v); return v; }
__device__ __forceinline__ float wave_sum(float v) { v = row_sum16(v); return (rdlane(v, 0) + rdlane(v, 16)) + (rdlane(v, 32) + rdlane(v, 48)); }
__device__ __forceinline__ float wave_max(float v) {
    v = fmaxf(v, dppf<0xB1>(v)); v = fmaxf(v, dppf<0x4E>(v)); v = fmaxf(v, dppf<0x141>(v)); v = fmaxf(v, dppf<0x140>(v));
    return fmaxf(fmaxf(rdlane(v, 0), rdlane(v, 16)), fmaxf(rdlane(v, 32), rdlane(v, 48)));
}
__device__ __forceinline__ float xreduce32(float (&p)[32], int lane) {
    float a[16], b[8], c[4], d[2];
#pragma unroll
    for (int i = 0; i < 16; ++i) { auto r = __builtin_amdgcn_permlane32_swap(__float_as_uint(p[i]), __float_as_uint(p[16 + i]), false, false); a[i] = __uint_as_float(r[0]) + __uint_as_float(r[1]); }
#pragma unroll
    for (int i = 0; i < 8; ++i) { auto r = __builtin_amdgcn_permlane16_swap(__float_as_uint(a[i]), __float_as_uint(a[8 + i]), false, false); b[i] = __uint_as_float(r[0]) + __uint_as_float(r[1]); }
    const bool b3 = (lane & 8) != 0, b2 = (lane & 4) != 0, b1 = (lane & 2) != 0;
#pragma unroll
    for (int i = 0; i < 4; ++i) { const float keep = b3 ? b[4 + i] : b[i], send = b3 ? b[i] : b[4 + i]; c[i] = keep + dppf<0x128>(send); }
#pragma unroll
    for (int i = 0; i < 2; ++i) { const float keep = b2 ? c[2 + i] : c[i], send = b2 ? c[i] : c[2 + i]; d[i] = keep + dppf<0x141>(send); }
    const float keep = b1 ? d[1] : d[0], send = b1 ? d[0] : d[1];
    float r = keep + dppf<0x4E>(send);
    r += dppf<0xB1>(r);
    return r;
}
__device__ __forceinline__ int ld_agent_i(const int* p) { return __hip_atomic_load(p, RLX_AGENT); }
__device__ __forceinline__ float ld_agent_f(const float* p) { return __hip_atomic_load(p, RLX_AGENT); }
#define LDS_WAIT() asm volatile("s_waitcnt lgkmcnt(0)" ::: "memory")
template <int CTRL, int RMASK> __device__ __forceinline__ float dpp_old(float old, float v) { return __builtin_bit_cast(float, __builtin_amdgcn_update_dpp(__builtin_bit_cast(int, old), __builtin_bit_cast(int, v), CTRL, RMASK, 0xF, false)); }
__device__ __forceinline__ float wave_scan_add(float v) {
    v += dpp_old<0x111, 0xF>(0.f, v); v += dpp_old<0x112, 0xF>(0.f, v); v += dpp_old<0x114, 0xF>(0.f, v); v += dpp_old<0x118, 0xF>(0.f, v);
    v += dpp_old<0x142, 0xA>(0.f, v); v += dpp_old<0x143, 0xC>(0.f, v); return v; }
__device__ __forceinline__ float wave_scan_max(float v) {
    const float ninf = -INFINITY;
    v = fmaxf(v, dpp_old<0x111, 0xF>(ninf, v)); v = fmaxf(v, dpp_old<0x112, 0xF>(ninf, v)); v = fmaxf(v, dpp_old<0x114, 0xF>(ninf, v)); v = fmaxf(v, dpp_old<0x118, 0xF>(ninf, v));
    v = fmaxf(v, dpp_old<0x142, 0xA>(ninf, v)); v = fmaxf(v, dpp_old<0x143, 0xC>(ninf, v)); return v; }
__device__ __forceinline__ int row_of(int b, int t) { return (t < NMETA) ? NREAL + b * NMETA + t : b * SEQ + (t - NMETA); }
__device__ __forceinline__ void bt_of(int row, int& b, int& t) { if (row < NREAL) { b = row >> 12; t = (row & (SEQ - 1)) + NMETA; } else { const int m = row - NREAL; b = m >> 4; t = m & (NMETA - 1); } }
__device__ __forceinline__ unsigned pkfp8x4_nc(float a, float b, float c, float d) {
    int w = 0; w = __builtin_amdgcn_cvt_pk_fp8_f32(a, b, w, false); w = __builtin_amdgcn_cvt_pk_fp8_f32(c, d, w, true); return (unsigned)w; }
__device__ __forceinline__ unsigned pkfp8x4(float a, float b, float c, float d) {
    a = fminf(fmaxf(a, -448.f), 448.f); b = fminf(fmaxf(b, -448.f), 448.f); c = fminf(fmaxf(c, -448.f), 448.f); d = fminf(fmaxf(d, -448.f), 448.f);
    int w = 0; w = __builtin_amdgcn_cvt_pk_fp8_f32(a, b, w, false); w = __builtin_amdgcn_cvt_pk_fp8_f32(c, d, w, true); return (unsigned)w; }
__device__ __forceinline__ unsigned pku8x4(float a, float b, float c, float d) {
    unsigned w = 0; w = __builtin_amdgcn_cvt_pk_u8_f32(a, 0, w); w = __builtin_amdgcn_cvt_pk_u8_f32(b, 1, w); w = __builtin_amdgcn_cvt_pk_u8_f32(c, 2, w); w = __builtin_amdgcn_cvt_pk_u8_f32(d, 3, w); return w; }
__device__ __forceinline__ float sig_u8(float x) { return fmaxf(__builtin_rintf(sigmoidf_(x) * 255.0f), 1.0f); }
__device__ __forceinline__ float ub(unsigned w, int i) { return (float)((w >> (8 * i)) & 0xffu); }
__device__ __forceinline__ const void* ldptr(LAS const unsigned long long* t, int i) { const unsigned long long v = t[i];
    const unsigned lo = (unsigned)__builtin_amdgcn_readfirstlane((int)(unsigned)v), hi = (unsigned)__builtin_amdgcn_readfirstlane((int)(unsigned)(v >> 32));
    return (const void*)(const GAS void*)(((unsigned long long)hi << 32) | lo); }

namespace pg8 {
constexpr int BM = 256, BK = 64, HALF = 128, HTB = HALF * BK * 2, STAGE_BYTES = 8 * HTB, NXCD = 8, WGM = 8;
__host__ __device__ __forceinline__ int lds_byte(int r, int c) { const int st = (r >> 4) * 2 + (c >> 5), rr = r & 15, cc = c & 31, ob = rr * 64 + cc * 2; return st * 1024 + (ob ^ (((ob >> 9) & 1) << 5)); }
__host__ __device__ __forceinline__ void stage_rc(int b, int& R, int& C) { const int st = b / 1024, sb = b % 1024, swz = sb ^ (((sb >> 9) & 1) << 5); R = (st >> 1) * 16 + swz / 64; C = (st & 1) * 32 + (swz % 64) / 2; }
__host__ __device__ __forceinline__ int perm32(int rho) { const int n = rho >> 4, i = rho & 15; return 8 * (i >> 2) + 4 * n + (i & 3); }

struct Unit { int pm, pn, e; };
struct Gemm { const bf16_t* A; const bf16_t* Bt; int lda, K, nN; const int* row_off; const int* tile_exp; int pm0; int pn_split, pn_add0, pn_add1; };
struct StaticOrder {
    int nM, nN, nwg, G, c;
    __device__ __forceinline__ void init(int nM_, int nN_, int G_, int c_) { nM = nM_; nN = nN_; nwg = nM * nN; G = G_; c = c_; }
    __device__ __forceinline__ bool next(int i, Unit& u) const {
        const int L = i * G + c; if (L >= nwg) return false;
        int wgid = L; { const int q = nwg / NXCD, r = nwg % NXCD, xcd = wgid % NXCD, off = wgid / NXCD; wgid = (xcd < r ? xcd * (q + 1) : r * (q + 1) + (xcd - r) * q) + off; }
        const int nig = WGM * nN, gid = wgid / nig, fm = gid * WGM, gsz = (nM - fm) < WGM ? (nM - fm) : WGM;
        u.pm = fm + ((wgid % nig) % gsz); u.pn = (wgid % nig) / gsz; u.e = 0; return true;
    }
};

template <int MODE, class Epi, bool MID = false, bool FP8 = false>
__device__ __forceinline__ void gemm_phase(LAS unsigned char* lds, const Gemm g, const StaticOrder& S, const Epi& E) {
    int tid_ = threadIdx.x; asm volatile("" : "+v"(tid_));
    const int tid = tid_, wid = __builtin_amdgcn_readfirstlane(tid >> 6), lane = tid & 63, wr = wid >> 2, wc = wid & 3, fr = lane & 15, fq = lane >> 4;
    const int K = g.K, nt = K / BK;
    unsigned voffA[2], voffB[2];
#pragma unroll
    for (int i = 0; i < 2; ++i) { int R, C; stage_rc(tid * 16 + i * 8192, R, C); const int Rb = Epi::PERM2 ? (64 * (R >> 5) + 16 * ((R & 15) >> 2) + 4 * ((R >> 4) & 1) + (R & 3)) : Epi::PERM ? ((R & ~31) + perm32(R & 31)) : R;
        voffA[i] = (unsigned)(R * g.lda + C) * 2u; voffB[i] = (unsigned)(Rb * K + C) * 2u; }
    const size_t kstep = (size_t)(BK * 2);
    const size_t hstepA = (size_t)HALF * g.lda * 2, hstepB = Epi::PERM2 ? (size_t)8 * K * 2 : (size_t)HALF * K * 2;
    const size_t tstepA = 2 * hstepA, tstepB = 2 * (size_t)HALF * K * 2;
    const unsigned ldsw = (unsigned)wid * 1024u;
    LAS unsigned char* pa = lds + lds_byte(wr * 64 + fr, fq * 8); LAS unsigned char* pb = lds + 4 * HTB + lds_byte(wc * 32 + fr, fq * 8);
    asm volatile("" : "+v"(pa), "+v"(pb));
    unsigned vC[2][2] = {{0u, 0u}, {0u, 0u}};
    constexpr int GOFF = 8 * HTB;
#define PG8_SA(b, h) (((b) * 2 + (h)) * HTB)
#define PG8_SB(b, h) ((4 + (b) * 2 + (h)) * HTB)
#define PG8_STAGE_B(bufoff, gbase) do { _Pragma("unroll") for (int _i = 0; _i < 2; ++_i) { unsigned vb_ = voffB[_i]; asm volatile("" : "+v"(vb_)); \
        __builtin_amdgcn_global_load_lds((const unsigned*)((const char*)(gbase) + vb_), (LAS unsigned*)(lds + (bufoff) + ldsw + _i * 8192), 16, 0, 0); } } while (0)
#define PG8_STAGE_A(bufoff, gbase, h) do { _Pragma("unroll") for (int _i = 0; _i < 2; ++_i) { unsigned va_ = (MODE == 1) ? vC[h][_i] : voffA[_i]; if (MODE != 1) asm volatile("" : "+v"(va_)); \
        const char* _p = (MODE == 1) ? ((const char*)(gbase) + va_) : ((const char*)(gbase) + (h) * hstepA + va_); \
        __builtin_amdgcn_global_load_lds((const unsigned*)_p, (LAS unsigned*)(lds + (bufoff) + ldsw + _i * 8192), 16, 0, 0); } } while (0)
#define PG8_LD8(dst, cnt, base) do { _Pragma("unroll") for (int q_ = 0; q_ < (cnt); ++q_) { const pg8_v4i lo_ = *(const LAS pg8_v4i*)((base) + q_ * 2048), hi_ = *(const LAS pg8_v4i*)((base) + q_ * 2048 + 1024); \
        dst[q_] = __builtin_shufflevector(lo_, hi_, 0, 1, 2, 3, 4, 5, 6, 7); } } while (0)
#define PG8_LDA(dst, b, h) do { if constexpr (FP8) { PG8_LD8(dst##8, 4, pa + PG8_SA(b, h)); } else { _Pragma("unroll") for (int m = 0; m < 4; ++m) _Pragma("unroll") for (int k = 0; k < 2; ++k) dst[m][k] = *(const LAS bf16x8*)(pa + PG8_SA(b, h) + m * 2048 + k * 1024); } } while (0)
#define PG8_LDB(dst, b, h) do { if constexpr (FP8) { PG8_LD8(dst##8, 2, pb + PG8_SA(b, h)); } else { _Pragma("unroll") for (int n = 0; n < 2; ++n) _Pragma("unroll") for (int k = 0; k < 2; ++k) dst[n][k] = *(const LAS bf16x8*)(pb + PG8_SA(b, h) + n * 2048 + k * 1024); } } while (0)
#define PG8_MMA(ai, bj, At, Bt) do { __builtin_amdgcn_s_setprio(1); _Pragma("unroll") for (int m = 0; m < 4; ++m) _Pragma("unroll") for (int n = 0; n < 2; ++n) { \
        if constexpr (FP8) {   \
            acc[ai][bj][m][n] = __builtin_amdgcn_mfma_scale_f32_16x16x128_f8f6f4(Bt##8[n], At##8[m], acc[ai][bj][m][n], 0, 0, 0, 0x7f7f7f7f, 0, 0x7f7f7f7f); \
        } else { _Pragma("unroll") for (int k = 0; k < 2; ++k) acc[ai][bj][m][n] = __builtin_amdgcn_mfma_f32_16x16x32_bf16(Bt[n][k], At[m][k], acc[ai][bj][m][n], 0, 0, 0); } } \
        __builtin_amdgcn_s_setprio(0); } while (0)
#define PG8_WAIT_V(n) asm volatile("s_waitcnt vmcnt(" #n ")" ::: "memory")
#define PG8_WAIT_L(n) asm volatile("s_waitcnt lgkmcnt(" #n ")" ::: "memory")
#define PG8_BAR __builtin_amdgcn_s_barrier()
#define PG8_SCHED __builtin_amdgcn_sched_barrier(0)
#define PG8_ABASE(u) ((MODE == 1) ? (const char*)g.A : (const char*)g.A + (size_t)(u).pm * tstepA)
#define PG8_BBASE(u) ((MODE == 0) ? (const char*)g.Bt + (size_t)(u).pn * tstepB : (const char*)g.Bt + ((size_t)((u).e = __builtin_amdgcn_readfirstlane(ld_agent_i(g.tile_exp + g.pm0 + (u).pm))) * g.nN + (u).pn) * tstepB)
#define PG8_GATHER(dst, u) do { if (MODE == 1) { int tq_ = tid; asm volatile("" : "+v"(tq_)); _Pragma("unroll") for (int _i = 0; _i < 2; ++_i) { int R_, C_; stage_rc(tq_ * 16 + _i * 8192, R_, C_); \
        _Pragma("unroll") for (int _h = 0; _h < 2; ++_h) dst[_h][_i] = (unsigned)ld_agent_i(g.row_off + (size_t)(g.pm0 + (u).pm) * BM + _h * HALF + R_) + (unsigned)(C_ * 2); } } } while (0)
#define PG8_GATHER_DMA(u) do { if (MODE == 1) { int tq_ = tid; asm volatile("" : "+v"(tq_)); _Pragma("unroll") for (int _i = 0; _i < 2; ++_i) { int R_, C_; stage_rc(tq_ * 16 + _i * 8192, R_, C_); \
        _Pragma("unroll") for (int _h = 0; _h < 2; ++_h) __builtin_amdgcn_global_load_lds((const unsigned*)(g.row_off + (size_t)(g.pm0 + (u).pm) * BM + _h * HALF + R_), (LAS unsigned*)(lds + GOFF + (_h * 2 + _i) * 2048 + wid * 256), 4, 0, 0); } } } while (0)
#define PG8_GATHER_LDS(dst) do { if (MODE == 1) { int tq_ = tid; asm volatile("" : "+v"(tq_)); _Pragma("unroll") for (int _i = 0; _i < 2; ++_i) { int R_, C_; stage_rc(tq_ * 16 + _i * 8192, R_, C_); \
        _Pragma("unroll") for (int _h = 0; _h < 2; ++_h) dst[_h][_i] = *(const LAS unsigned*)(lds + GOFF + (_h * 2 + _i) * 2048 + tq_ * 4) + (unsigned)(C_ * 2); } } } while (0)
    Unit cur, nxt; int ui = 0;
    if (!S.next(0, cur)) return;
    if (MODE == 0) cur.pn += (cur.pn < g.pn_split) ? g.pn_add0 : g.pn_add1;
    f32x4 acc[2][2][4][2];
#pragma unroll
    for (int a = 0; a < 2; ++a)
#pragma unroll
        for (int b = 0; b < 2; ++b)
#pragma unroll
            for (int m = 0; m < 4; ++m)
#pragma unroll
                for (int n = 0; n < 2; ++n) acc[a][b][m][n] = (f32x4){0.f, 0.f, 0.f, 0.f};
    bf16x8 At[4][2], B0[2][2], B1[2][2];
    typedef int pg8_v8i __attribute__((ext_vector_type(8))); typedef int pg8_v4i __attribute__((ext_vector_type(4)));
    pg8_v8i At8[4], B08[2], B18[2];
    const char* cA = PG8_ABASE(cur); const char* cB = PG8_BBASE(cur);
    PG8_GATHER(vC, cur);
    if constexpr (Epi::PRE) E.prefetch(lds + GOFF + 8192, cur, tid);
    PG8_STAGE_B(PG8_SB(0, 0), cB); PG8_STAGE_B(PG8_SB(0, 1), cB + hstepB); PG8_STAGE_A(PG8_SA(0, 0), cA, 0); PG8_STAGE_A(PG8_SA(0, 1), cA, 1);
    if (wr == 1) PG8_BAR;
    PG8_WAIT_V(2); PG8_BAR;
    PG8_STAGE_B(PG8_SB(1, 0), cB + kstep); PG8_STAGE_A(PG8_SA(1, 0), cA + kstep, 0); PG8_STAGE_B(PG8_SB(1, 1), cB + hstepB + kstep);
    PG8_WAIT_V(6); PG8_BAR;
    for (;;) {
        const bool has_next = S.next(ui + 1, nxt);
        if (MODE == 0) nxt.pn += (nxt.pn < g.pn_split) ? g.pn_add0 : g.pn_add1;
        const char* nA = has_next ? PG8_ABASE(nxt) : cA; const char* nB = has_next ? PG8_BBASE(nxt) : cB;
        if (has_next) PG8_GATHER_DMA(nxt);
#pragma unroll 1
        for (int t = 0; t < nt; t += 2) {
            if constexpr (MID) { if (t == nt / 2) { if (wr == 0) PG8_BAR; E.mid(acc, cur, wr, wc, fr, fq); if (wr == 1) PG8_BAR; } }
            const bool last = (t == nt - 2);
            const char* a1 = cA + (size_t)(t + 1) * kstep;
            const char* a2 = last ? nA : cA + (size_t)(t + 2) * kstep; const char* b2 = last ? nB : cB + (size_t)(t + 2) * kstep;
            const char* a3 = a2 + kstep; const char* b3 = b2 + kstep;
            PG8_LDB(B0, 0, 0); PG8_LDB(B1, 0, 1); PG8_SCHED; PG8_LDA(At, 0, 0); PG8_STAGE_A(PG8_SA(1, 1), a1, 1);
            if (MODE == 1) { if (last && has_next) PG8_GATHER_LDS(vC); }
            PG8_WAIT_V(8); PG8_WAIT_L(0); PG8_BAR; PG8_MMA(0, 0, At, B0); PG8_MMA(0, 1, At, B1); PG8_BAR; PG8_SCHED;
            PG8_LDA(At, 0, 1); PG8_STAGE_B(PG8_SB(0, 0), b2); PG8_STAGE_B(PG8_SB(0, 1), b2 + hstepB); PG8_STAGE_A(PG8_SA(0, 0), a2, 0);
            PG8_WAIT_V(8); PG8_WAIT_L(0); PG8_BAR; PG8_MMA(1, 0, At, B0); PG8_MMA(1, 1, At, B1); PG8_BAR; PG8_SCHED;
            PG8_LDB(B0, 1, 0); PG8_LDB(B1, 1, 1); PG8_SCHED; PG8_LDA(At, 1, 0); PG8_STAGE_A(PG8_SA(0, 1), a2, 1);
            PG8_WAIT_V(8); PG8_WAIT_L(0); PG8_BAR; PG8_MMA(0, 0, At, B0); PG8_MMA(0, 1, At, B1); PG8_BAR; PG8_SCHED;
            PG8_LDA(At, 1, 1); PG8_STAGE_B(PG8_SB(1, 0), b3); PG8_STAGE_B(PG8_SB(1, 1), b3 + hstepB); PG8_STAGE_A(PG8_SA(1, 0), a3, 0);
            PG8_WAIT_V(8); PG8_WAIT_L(0); PG8_BAR; PG8_MMA(1, 0, At, B0); PG8_MMA(1, 1, At, B1); PG8_BAR; PG8_SCHED;
        }
        if (wr == 0) PG8_BAR;
        if constexpr (Epi::PRE) E(acc, cur, wr, wc, fr, fq, lds + GOFF + 8192 + (ui & 1) * 4096); else E(acc, cur, wr, wc, fr, fq);
        if (!has_next) break;
#pragma unroll
        for (int a = 0; a < 2; ++a)
#pragma unroll
            for (int b = 0; b < 2; ++b)
#pragma unroll
                for (int m = 0; m < 4; ++m)
#pragma unroll
                    for (int n = 0; n < 2; ++n) acc[a][b][m][n] = (f32x4){0.f, 0.f, 0.f, 0.f};
        cur = nxt; cA = nA; cB = nB; ++ui;
        if constexpr (Epi::PRE) E.prefetch(lds + GOFF + 8192 + (ui & 1) * 4096, cur, tid);
        if (wr == 1) PG8_BAR;
    }
    PG8_WAIT_V(0);
    PG8_BAR;
#undef PG8_SA
#undef PG8_SB
#undef PG8_STAGE_A
#undef PG8_STAGE_B
#undef PG8_LD8
#undef PG8_LDA
#undef PG8_LDB
#undef PG8_MMA
#undef PG8_WAIT_V
#undef PG8_WAIT_L
#undef PG8_BAR
#undef PG8_SCHED
#undef PG8_ABASE
#undef PG8_BBASE
#undef PG8_GATHER
#undef PG8_GATHER_DMA
#undef PG8_GATHER_LDS
}

struct EpiZ {
    static constexpr bool PERM2 = false; static constexpr bool PERM = true; static constexpr bool PRE = false;
    bf16_t* Z; bf16_t* Qc; bf16_t* Kc; bf16_t* Vc; const float* ropec; const float* ropes; bf16_t* GF; float ascale;
    __device__ __forceinline__ void operator()(const f32x4 (&acc)[2][2][4][2], const Unit& u, int wr, int wc, int fr, int fq) const {
        { int tq_ = threadIdx.x; asm volatile("" : "+v"(tq_)); fr = tq_ & 15; fq = (tq_ >> 4) & 3; }
        const int row0 = u.pm * BM + wr * 64 + fr;
        if (u.pn < 4) {
            const float sc = ((u.pn < 2) ? ATT_C2 : 1.0f) * ascale;
            bf16_t* base = (u.pn < 2) ? Qc : Kc;
            const int dl = 16 * (wc & 1) + 4 * fq;
#pragma unroll
            for (int ai = 0; ai < 2; ++ai) {
                f32x4 cc[4], ssn[4]; int bb[4], tt[4];
#pragma unroll
                for (int m = 0; m < 4; ++m) { const int row = row0 + ai * HALF + m * 16; bt_of(row, bb[m], tt[m]);
                    cc[m] = *(const f32x4*)(ropec + tt[m] * 32 + dl); ssn[m] = *(const f32x4*)(ropes + tt[m] * 32 + dl); }
                asm volatile("" ::: "memory");
#pragma unroll
                for (int m = 0; m < 4; ++m) {
                    const int b = bb[m], t = tt[m];
                    const f32x4 c = cc[m] * sc, s = ssn[m] * sc;
#pragma unroll
                    for (int bj = 0; bj < 2; ++bj) {
                        const int hm = 2 * (2 * bj + (wc >> 1)) + (u.pn & 1);
                        const f32x4 x1 = acc[ai][bj][m][0], x2 = acc[ai][bj][m][1];
                        const f32x4 o1 = x1 * c - x2 * s, o2 = x2 * c + x1 * s;
                        bf16_t* p = base + ((size_t)(b * 8 + hm) * TT + t) * 64 + dl;
                        u32x2 w1, w2; w1.x = pkbf(o1[0], o1[1]); w1.y = pkbf(o1[2], o1[3]); w2.x = pkbf(o2[0], o2[1]); w2.y = pkbf(o2[2], o2[3]);
                        *(u32x2*)p = w1; *(u32x2*)(p + 32) = w2;
                    }
                }
            }
        } else if (u.pn < 6) {
            const int e0 = wc * 32 + 8 * fq;
#pragma unroll
            for (int ai = 0; ai < 2; ++ai)
#pragma unroll
                for (int m = 0; m < 4; ++m) {
                    const int row = row0 + ai * HALF + m * 16; int b, t; bt_of(row, b, t);
#pragma unroll
                    for (int bj = 0; bj < 2; ++bj) { const int h = (u.pn - 4) * 2 + bj; const f32x4 v0 = acc[ai][bj][m][0] * ascale, v1 = acc[ai][bj][m][1] * ascale;
                        u32x4 w; w.x = pkbf(v0[0], v0[1]); w.y = pkbf(v0[2], v0[3]); w.z = pkbf(v1[0], v1[1]); w.w = pkbf(v1[2], v1[3]);
                        *(u32x4*)(Vc + ((size_t)(b * 4 + h) * TT + t) * 128 + e0) = w; }
                }
        } else if (u.pn < 14) {
            const int col0 = (u.pn - 6) * BM + wc * 32 + 8 * fq;
#pragma unroll
            for (int ai = 0; ai < 2; ++ai)
#pragma unroll
                for (int m = 0; m < 4; ++m) {
                    bf16_t* rowp = Z + (size_t)(row0 + ai * HALF + m * 16) * NZ + col0;
#pragma unroll
                    for (int bj = 0; bj < 2; ++bj) { const f32x4 v0 = acc[ai][bj][m][0] * ascale, v1 = acc[ai][bj][m][1] * ascale;
                        if (u.pn >= 12) {
                            u32x2 w8; w8.x = pku8x4(sig_u8(v0[0]), sig_u8(v0[1]), sig_u8(v0[2]), sig_u8(v0[3])); w8.y = pku8x4(sig_u8(v1[0]), sig_u8(v1[1]), sig_u8(v1[2]), sig_u8(v1[3]));
                            *(u32x2*)((unsigned char*)(Z + (size_t)(row0 + ai * HALF + m * 16) * NZ + ZMO) + (col0 - ZMO) + bj * HALF) = w8;
                        } else {
                        u32x4 w; w.x = pkbf(v0[0], v0[1]); w.y = pkbf(v0[2], v0[3]); w.z = pkbf(v1[0], v1[1]); w.w = pkbf(v1[2], v1[3]);
                        *(u32x4*)(rowp + bj * HALF) = w; } }
                }
        } else if (u.pm < NREAL / BM) {
            const int gi = (u.pn - 14) >> 2, pn4 = (u.pn - 14) & 3;
            u32x2* gp = (u32x2*)GF + ((((size_t)(gi * (NREAL / BM) + u.pm) * 4 + pn4) * 8 + (wr * 4 + wc)) * 16) * 64 + (fq * 16 + fr);
#pragma unroll
            for (int ai = 0; ai < 2; ++ai)
#pragma unroll
                for (int bj = 0; bj < 2; ++bj)
#pragma unroll
                    for (int m = 0; m < 4; ++m) { const f32x4 v0 = acc[ai][bj][m][0] * ascale, v1 = acc[ai][bj][m][1] * ascale;
                        u32x2 w; w.x = pku8x4(sig_u8(v0[0]), sig_u8(v0[1]), sig_u8(v0[2]), sig_u8(v0[3])); w.y = pku8x4(sig_u8(v1[0]), sig_u8(v1[1]), sig_u8(v1[2]), sig_u8(v1[3]));
                        gp[((ai * 2 + bj) * 4 + m) * 64] = w; }
        }
    }
};
template <bool SECOND> struct EpiGate {
    static constexpr bool PERM2 = false; static constexpr bool PERM = true; static constexpr bool PRE = false;
    bf16_t* Z; bf16_t* TMP; bf16_t* MRG;
    __device__ __forceinline__ void operator()(const f32x4 (&acc)[2][2][4][2], const Unit& u, int wr, int wc, int fr, int fq) const {
        const int row0 = u.pm * BM + wr * 64 + fr, col0 = u.pn * BM + wc * 32 + 8 * fq;
#pragma unroll
        for (int ai = 0; ai < 2; ++ai)
#pragma unroll
            for (int m = 0; m < 4; ++m) {
                bf16_t* rowp = Z + (size_t)(row0 + ai * HALF + m * 16) * NZ + col0; bf16_t* tmpp = TMP + (size_t)(row0 + ai * HALF + m * 16) * DM + col0; bf16_t* mrgp = MRG + (size_t)(row0 + ai * HALF + m * 16) * DM + col0;
#pragma unroll
                for (int bj = 0; bj < 2; ++bj) {
                    const u32x4 gw = *(const u32x4*)(rowp + (SECOND ? ZGM : ZGA) + bj * HALF);
                    const f32x4 v0 = acc[ai][bj][m][0], v1 = acc[ai][bj][m][1];
                    float o[8];
                    o[0] = sigmoidf_(bflo(gw.x)) * v0[0]; o[1] = sigmoidf_(bfhi(gw.x)) * v0[1]; o[2] = sigmoidf_(bflo(gw.y)) * v0[2]; o[3] = sigmoidf_(bfhi(gw.y)) * v0[3];
                    o[4] = sigmoidf_(bflo(gw.z)) * v1[0]; o[5] = sigmoidf_(bfhi(gw.z)) * v1[1]; o[6] = sigmoidf_(bflo(gw.w)) * v1[2]; o[7] = sigmoidf_(bfhi(gw.w)) * v1[3];
                    if (SECOND) { const u32x4 tw = *(const u32x4*)(tmpp + bj * HALF);
                        o[0] += bflo(tw.x); o[1] += bfhi(tw.x); o[2] += bflo(tw.y); o[3] += bfhi(tw.y); o[4] += bflo(tw.z); o[5] += bfhi(tw.z); o[6] += bflo(tw.w); o[7] += bfhi(tw.w); }
                    u32x4 w; w.x = pkbf(o[0], o[1]); w.y = pkbf(o[2], o[3]); w.z = pkbf(o[4], o[5]); w.w = pkbf(o[6], o[7]);
                    if (SECOND) *(u32x4*)(mrgp + bj * HALF) = w; else *(u32x4*)(tmpp + bj * HALF) = w;
                }
            }
    }
};
struct EpiGateFused {
    static constexpr bool PERM2 = false; static constexpr bool PERM = true; static constexpr bool PRE = false;
    const bf16_t* GF; bf16_t* MRG; float oscale;
    __device__ __forceinline__ void mid(f32x4 (&acc)[2][2][4][2], const Unit& u, int wr, int wc, int fr, int fq) const {
        { int tq_ = threadIdx.x; asm volatile("" : "+v"(tq_)); fr = tq_ & 15; fq = (tq_ >> 4) & 3; }
        const u32x2* ga = (const u32x2*)GF + ((((size_t)u.pm * 4 + u.pn) * 8 + (wr * 4 + wc)) * 16) * 64 + (fq * 16 + fr);
        const u32x2* gm = ga + (size_t)(NREAL / BM) * 4 * 8 * 16 * 64;
#pragma unroll
        for (int q = 0; q < 16; ++q) {
            const int ai = q >> 3, bj = (q >> 2) & 1, m = q & 3;
            const u32x2 a = ga[q * 64], b = gm[q * 64];
            float r[8];
#define EG_R(a_, m_) ((a_) * __builtin_amdgcn_rcpf(m_))
            r[0] = EG_R(ub(a.x, 0), ub(b.x, 0)); r[1] = EG_R(ub(a.x, 1), ub(b.x, 1)); r[2] = EG_R(ub(a.x, 2), ub(b.x, 2)); r[3] = EG_R(ub(a.x, 3), ub(b.x, 3));
            r[4] = EG_R(ub(a.y, 0), ub(b.y, 0)); r[5] = EG_R(ub(a.y, 1), ub(b.y, 1)); r[6] = EG_R(ub(a.y, 2), ub(b.y, 2)); r[7] = EG_R(ub(a.y, 3), ub(b.y, 3));
#undef EG_R
            acc[ai][bj][m][0] = acc[ai][bj][m][0] * (f32x4){r[0], r[1], r[2], r[3]}; acc[ai][bj][m][1] = acc[ai][bj][m][1] * (f32x4){r[4], r[5], r[6], r[7]};
            asm volatile("" : "+v"(acc[ai][bj][m][0]), "+v"(acc[ai][bj][m][1]));
            if ((q & 3) == 3) asm volatile("" ::: "memory");
        }
    }
    __device__ __forceinline__ void operator()(const f32x4 (&acc)[2][2][4][2], const Unit& u, int wr, int wc, int fr, int fq) const {
        { int tq_ = threadIdx.x; asm volatile("" : "+v"(tq_)); fr = tq_ & 15; fq = (tq_ >> 4) & 3; }
        const int row0 = u.pm * BM + wr * 64 + fr, col0 = u.pn * BM + wc * 32 + 8 * fq;
        const u32x2* gm = (const u32x2*)GF + (size_t)(NREAL / BM) * 4 * 8 * 16 * 64 + ((((size_t)u.pm * 4 + u.pn) * 8 + (wr * 4 + wc)) * 16) * 64 + (fq * 16 + fr);
#pragma unroll
        for (int ai = 0; ai < 2; ++ai) {
            u32x2 gg[4][2];
#pragma unroll
            for (int m = 0; m < 4; ++m)
#pragma unroll
                for (int bj = 0; bj < 2; ++bj) gg[m][bj] = gm[((ai * 2 + bj) * 4 + m) * 64];
            asm volatile("" ::: "memory");
#pragma unroll
            for (int m = 0; m < 4; ++m) {
                unsigned char* mrgp = (unsigned char*)MRG + (size_t)(row0 + ai * HALF + m * 16) * DM + col0;
#pragma unroll
                for (int bj = 0; bj < 2; ++bj) {
                    const u32x2 g = gg[m][bj];
                    const f32x4 v0 = acc[ai][bj][m][0] * oscale, v1 = acc[ai][bj][m][1] * oscale;
                    u32x2 w; w.x = pkfp8x4(ub(g.x, 0) * v0[0], ub(g.x, 1) * v0[1], ub(g.x, 2) * v0[2], ub(g.x, 3) * v0[3]);
                    w.y = pkfp8x4(ub(g.y, 0) * v1[0], ub(g.y, 1) * v1[1], ub(g.y, 2) * v1[2], ub(g.y, 3) * v1[3]);
                    *(u32x2*)(mrgp + bj * HALF) = w;
                }
            }
        }
    }
};
struct EpiStoreBf16 {
    static constexpr bool PERM2 = false; static constexpr bool PERM = true; static constexpr bool PRE = false;
    bf16_t* O; int ldc; float ascale;
    __device__ __forceinline__ void operator()(const f32x4 (&acc)[2][2][4][2], const Unit& u, int wr, int wc, int fr, int fq) const {
        { int tq_ = threadIdx.x; asm volatile("" : "+v"(tq_)); fr = tq_ & 15; fq = (tq_ >> 4) & 3; }
        const int row0 = u.pm * BM + wr * 64 + fr, col0 = u.pn * BM + wc * 32 + 8 * fq;
#pragma unroll
        for (int ai = 0; ai < 2; ++ai)
#pragma unroll
            for (int m = 0; m < 4; ++m) { bf16_t* rowp = O + (size_t)(row0 + ai * HALF + m * 16) * ldc + col0;
#pragma unroll
                for (int bj = 0; bj < 2; ++bj) { const f32x4 v0 = acc[ai][bj][m][0] * ascale, v1 = acc[ai][bj][m][1] * ascale;
                    u32x4 w; w.x = pkbf(v0[0], v0[1]); w.y = pkbf(v0[2], v0[3]); w.z = pkbf(v1[0], v1[1]); w.w = pkbf(v1[2], v1[3]);
                    *(u32x4*)(rowp + bj * HALF) = w; } }
    }
};
struct EpiPre1 {
    static constexpr bool PERM2 = false; static constexpr bool PERM = false; static constexpr bool PRE = false;
    float* P1; const float* x; const float* meta; const float* stats; const float* g0; const float* b0;
    __device__ __forceinline__ void operator()(const f32x4 (&acc)[2][2][4][2], const Unit& u, int wr, int wc, int fr, int fq) const {
        const int row0 = u.pm * BM + wr * 64 + fr, col0 = u.pn * BM + wc * 32 + 4 * fq;
        f32x4 gv[2][2], bv[2][2];
#pragma unroll
        for (int bj = 0; bj < 2; ++bj)
#pragma unroll
            for (int n = 0; n < 2; ++n) { gv[bj][n] = *(const f32x4*)(g0 + col0 + bj * HALF + n * 16); bv[bj][n] = *(const f32x4*)(b0 + col0 + bj * HALF + n * 16); }
#pragma unroll
        for (int ai = 0; ai < 2; ++ai)
#pragma unroll
            for (int m = 0; m < 4; ++m) {
                const int row = row0 + ai * HALF + m * 16;
                const float* xr = x + (size_t)row * DM;
                const float mean = ld_agent_f(stats + 2 * row), rstd = ld_agent_f(stats + 2 * row + 1);
                float* orow = P1 + (size_t)row * (NZ / 2) + col0;
#pragma unroll
                for (int bj = 0; bj < 2; ++bj)
#pragma unroll
                    for (int n = 0; n < 2; ++n) { const f32x4 xv = *(const f32x4*)(xr + col0 + bj * HALF + n * 16);
                        const f32x4 hv = (xv - mean) * rstd * gv[bj][n] + bv[bj][n];
                        *(f32x4*)(orow + bj * HALF + n * 16) = hv * DN_ALPHA + acc[ai][bj][m][n]; }
            }
    }
};
struct EpiAct {
    static constexpr bool PERM2 = false; static constexpr bool PERM = true; static constexpr bool PRE = true;
    bf16_t* ACT; const float* b_gu; const int* tile_exp; int pm0; float ascale;
    __device__ __forceinline__ void prefetch(LAS unsigned char* buf, const Unit& u, int) const {
        int tid = threadIdx.x; asm volatile("" : "+v"(tid));
        __builtin_amdgcn_global_load_lds((const unsigned*)(b_gu + (size_t)u.e * 2 * FF + 2 * (u.pn * HALF) + tid), (LAS unsigned*)(buf + (tid >> 6) * 256), 4, 0, 0);
    }
    __device__ __forceinline__ void operator()(const f32x4 (&acc)[2][2][4][2], const Unit& u, int wr, int wc, int fr, int fq, LAS unsigned char* buf) const {
        { int tq_ = threadIdx.x; asm volatile("" : "+v"(tq_)); fr = tq_ & 15; fq = (tq_ >> 4) & 3; }
        const int ac0 = u.pn * HALF + wc * 32 + 8 * fq;
        const LAS float* bp = (const LAS float*)buf + 2 * (wc * 32 + 8 * fq);
        f32x2 bg[4], bl[4];
#pragma unroll
        for (int q = 0; q < 4; ++q) { const f32x4 v0 = *(const LAS f32x4*)(bp + 4 * q); bg[q] = (f32x2){v0[0], v0[2]}; bl[q] = (f32x2){v0[1], v0[3]}; }
        const int row0 = u.pm * BM + wr * 64 + fr;
#pragma unroll
        for (int ai = 0; ai < 2; ++ai)
#pragma unroll
            for (int m = 0; m < 4; ++m) {
                float o[8];
#pragma unroll
                for (int q = 0; q < 4; ++q) {
                    const f32x4 ag = acc[ai][0][m][q >> 1], al = acc[ai][1][m][q >> 1];
                    f32x2 gl = (f32x2){ag[2 * (q & 1)], ag[2 * (q & 1) + 1]} * ascale + bg[q], li = (f32x2){al[2 * (q & 1)], al[2 * (q & 1) + 1]} * ascale + bl[q];
                    gl = (f32x2){fminf(gl[0], 7.0f), fminf(gl[1], 7.0f)}; li = (f32x2){fminf(fmaxf(li[0], -7.0f), 7.0f), fminf(fmaxf(li[1], -7.0f), 7.0f)};
                    const f32x2 tt = gl * (-1.702f * 1.4426950408889634f);
                    const f32x2 den = (f32x2){__builtin_amdgcn_exp2f(tt[0]), __builtin_amdgcn_exp2f(tt[1])} + 1.0f;
                    const f32x2 sg = (f32x2){__builtin_amdgcn_rcpf(den[0]), __builtin_amdgcn_rcpf(den[1])};
                    const f32x2 r = (gl * sg) * (li * FP8_SA2 + FP8_SA2);
                    o[2 * q] = r[0]; o[2 * q + 1] = r[1];
                }
                u32x2 w; w.x = pkfp8x4_nc(o[0], o[1], o[2], o[3]); w.y = pkfp8x4_nc(o[4], o[5], o[6], o[7]);
                *(u32x2*)((unsigned char*)ACT + (size_t)(row0 + ai * HALF + m * 16) * FF + ac0) = w;
            }
    }
};
struct EpiDown {
    static constexpr bool PERM2 = true;    static constexpr bool PERM = true; static constexpr bool PRE = true;
    bf16_t* Y; const float* b_down; const int* tile_exp; const int* row_slot; const float* row_gate; int pm0; float ascale;
    __device__ __forceinline__ void prefetch(LAS unsigned char* buf, const Unit& u, int) const {
        int tid = threadIdx.x; asm volatile("" : "+v"(tid));
        const size_t r = (size_t)(pm0 + u.pm) * BM;
        const unsigned* src = (tid < 256) ? (const unsigned*)(row_slot + r + tid) : (const unsigned*)(row_gate + r + (tid - 256));
        __builtin_amdgcn_global_load_lds(src, (LAS unsigned*)(buf + (tid >> 6) * 256), 4, 0, 0);
        __builtin_amdgcn_global_load_lds((const unsigned*)(b_down + (size_t)u.e * DM + u.pn * BM + (tid & 255)), (LAS unsigned*)(buf + 2048 + (tid >> 6) * 256), 4, 0, 0);
    }
    __device__ __forceinline__ void operator()(const f32x4 (&acc)[2][2][4][2], const Unit& u, int wr, int wc, int fr, int fq, LAS unsigned char* buf) const {
        { int tq_ = threadIdx.x; asm volatile("" : "+v"(tq_)); fr = tq_ & 15; fq = (tq_ >> 4) & 3; }
        const int lc0 = wc * 64 + 16 * fq;
        f32x4 bv[2][2];
#pragma unroll
        for (int bj = 0; bj < 2; ++bj)
#pragma unroll
            for (int n = 0; n < 2; ++n) bv[bj][n] = *(const LAS f32x4*)((const LAS float*)(buf + 2048) + lc0 + 8 * bj + 4 * n);
        const int rl0 = wr * 64 + fr;
        int slots[8]; float gts[8];
#pragma unroll
        for (int q = 0; q < 8; ++q) { const int rl = rl0 + (q >> 2) * HALF + (q & 3) * 16; slots[q] = ((const LAS int*)buf)[rl]; gts[q] = ((const LAS float*)buf)[256 + rl] * FP8_SY; }
#pragma unroll
        for (int ai = 0; ai < 2; ++ai)
#pragma unroll
            for (int m = 0; m < 4; ++m) {
                const int slot = slots[ai * 4 + m]; const float gt = gts[ai * 4 + m];
                u32x4 w;
#pragma unroll
                for (int bj = 0; bj < 2; ++bj) { const f32x4 v0 = (acc[ai][bj][m][0] * ascale + bv[bj][0]) * gt, v1 = (acc[ai][bj][m][1] * ascale + bv[bj][1]) * gt;
                    w[2 * bj] = pkfp8x4(v0[0], v0[1], v0[2], v0[3]); w[2 * bj + 1] = pkfp8x4(v1[0], v1[1], v1[2], v1[3]); }
                *(u32x4*)((unsigned char*)Y + (size_t)slot * DM + u.pn * BM + lc0) = w;
            }
    }
};
}

namespace attn_body {
using bf16 = __hip_bfloat16;
using s16x4 = __attribute__((ext_vector_type(4))) short;
using f32x16 = __attribute__((ext_vector_type(16))) float;
constexpr int D = 64, PZ = 64, PV = 128, PO = 1024;
constexpr int NW = 8, QBLK = 32, QB = QBLK * NW, KVBLK = 64;
__device__ __forceinline__ int crow(int r, int hi) { return (r & 3) + 8 * (r >> 2) + 4 * hi; }
#define SBAR() __builtin_amdgcn_sched_barrier(0)
__device__ __forceinline__ void cmask(f32x16& p0, f32x16& p1, int jb, int qrel, int hi) {
    const float NEG = -INFINITY; const int d = qrel - 64 * jb - 4 * hi;
#pragma unroll
    for (int r = 0; r < 16; ++r) { const int c = (r & 3) + 8 * (r >> 2); if (c > d) p0[r] = NEG; if (c + 32 > d) p1[r] = NEG; }
}
constexpr int NSLOT = 3, SLOTB = 8192;
constexpr int LDS_K = 0, LDS_V = NSLOT * SLOTB, LDS_WS = 2 * NSLOT * SLOTB, LDS_OST = LDS_WS + NW * 64 * 4, LDS_BYTES_A = LDS_OST + NW * 4096;
__device__ __forceinline__ void glds16(const void* gsrc, unsigned lds_dst) { unsigned keep;
    asm volatile("s_mov_b32 %0, m0\n\ts_mov_b32 m0, %2\n\ts_nop 0\n\tglobal_load_lds_dwordx4 %1, off\n\ts_mov_b32 m0, %0" : "=&s"(keep) : "v"(gsrc), "s"(lds_dst) : "memory"); }
__device__ __forceinline__ float max3f(float a, float b, float c) { float r; asm("v_max3_f32 %0, %1, %2, %3" : "=v"(r) : "v"(a), "v"(b), "v"(c)); return r; }
__device__ __forceinline__ float max2f(float a, float b) { float r; asm("v_max_f32_e32 %0, %1, %2" : "=v"(r) : "v"(a), "v"(b)); return r; }
__device__ __forceinline__ float fadd_s(float a, float b) { float r; asm("v_add_f32_e32 %0, %1, %2" : "=v"(r) : "v"(a), "v"(b)); return r; }
__device__ __forceinline__ float fsub_s(float a, float b) { float r; asm("v_sub_f32_e32 %0, %1, %2" : "=v"(r) : "v"(a), "v"(b)); return r; }
__device__ __forceinline__ unsigned cvtpk_s(float lo, float hi) { return pkbf(lo, hi); }
#define WAIT_BAR(N) asm volatile("s_waitcnt vmcnt(" #N ") lgkmcnt(0)\n\ts_barrier" ::: "memory")
__device__ __forceinline__ void qkt(f32x16& p0, f32x16& p1, const char* Kslot, const bf16x8* qr, const f32x16& negm, int r32, int hi) {
    const char* kb = Kslot + hi * 1024 + r32 * 16;
#pragma unroll
    for (int d0 = 0; d0 < 4; ++d0) {
        const bf16x8 b0 = *reinterpret_cast<const bf16x8*>(kb + d0 * 2048);
        const bf16x8 b1 = *reinterpret_cast<const bf16x8*>(kb + d0 * 2048 + 512);
        if (d0 == 0) { p0 = __builtin_amdgcn_mfma_f32_32x32x16_bf16(b0, qr[0], negm, 0, 0, 0); p1 = __builtin_amdgcn_mfma_f32_32x32x16_bf16(b1, qr[0], negm, 0, 0, 0); }
        else { p0 = __builtin_amdgcn_mfma_f32_32x32x16_bf16(b0, qr[d0], p0, 0, 0, 0); p1 = __builtin_amdgcn_mfma_f32_32x32x16_bf16(b1, qr[d0], p1, 0, 0, 0); } }
}
typedef __attribute__((address_space(3))) const char* lds_cptr;
typedef short v4i16_t __attribute__((ext_vector_type(4)));
__device__ __forceinline__ void kload8(bf16x8* kf, lds_cptr kp) {
    kf[0] = *(const __attribute__((address_space(3))) bf16x8*)(kp);        kf[1] = *(const __attribute__((address_space(3))) bf16x8*)(kp + 512);
    kf[2] = *(const __attribute__((address_space(3))) bf16x8*)(kp + 2048); kf[3] = *(const __attribute__((address_space(3))) bf16x8*)(kp + 2560);
    kf[4] = *(const __attribute__((address_space(3))) bf16x8*)(kp + 4096); kf[5] = *(const __attribute__((address_space(3))) bf16x8*)(kp + 4608);
    kf[6] = *(const __attribute__((address_space(3))) bf16x8*)(kp + 6144); kf[7] = *(const __attribute__((address_space(3))) bf16x8*)(kp + 6656);
}
__device__ __forceinline__ void kload2(bf16x8* kf, lds_cptr kp, int j) { kf[2 * j] = *(const __attribute__((address_space(3))) bf16x8*)(kp + j * 2048); kf[2 * j + 1] = *(const __attribute__((address_space(3))) bf16x8*)(kp + j * 2048 + 512); }
__device__ __forceinline__ s16x4 vtr(lds_cptr p) { return __builtin_bit_cast(s16x4, __builtin_amdgcn_ds_read_tr16_b64_v4i16((__attribute__((address_space(3))) v4i16_t*)p)); }
__device__ __forceinline__ float rowmax(const f32x16& p0, const f32x16& p1) {
    float a = max3f(p0[0], p0[1], p1[0]), b = max3f(p0[2], p0[3], p1[1]); a = max3f(a, p1[2], p1[3]);
#pragma unroll
    for (int r = 4; r < 16; r += 4) { a = max3f(a, p0[r], p0[r + 1]); b = max3f(b, p0[r + 2], p0[r + 3]); a = max3f(a, p1[r], p1[r + 1]); b = max3f(b, p1[r + 2], p1[r + 3]); }
    const float m = max2f(a, b);
    auto rr = __builtin_amdgcn_permlane32_swap(__float_as_uint(m), __float_as_uint(m), false, false);
    return max2f(__uint_as_float(rr[0]), __uint_as_float(rr[1]));
}
__device__ __forceinline__ void pv(f32x16* o, int vb, bf16x8 pa0, bf16x8 pa1, bf16x8 pa2, bf16x8 pa3) {
#pragma unroll
    for (int d0 = 0; d0 < 2; ++d0) { s16x4 lo[4], hi[4];
#pragma unroll
        for (int ks = 0; ks < 4; ++ks) {
            asm volatile("ds_read_b64_tr_b16 %0,%1 offset:%c2" : "=&v"(lo[ks]) : "v"(vb), "i"(d0 * 4096 + ks * 1024) : "memory");
            asm volatile("ds_read_b64_tr_b16 %0,%1 offset:%c2" : "=&v"(hi[ks]) : "v"(vb), "i"(d0 * 4096 + ks * 1024 + 512) : "memory"); }
        asm volatile("s_waitcnt lgkmcnt(0)" ::: "memory"); SBAR();
#define PK(k) (bf16x8){lo[k][0], lo[k][1], lo[k][2], lo[k][3], hi[k][0], hi[k][1], hi[k][2], hi[k][3]}
        o[d0] = __builtin_amdgcn_mfma_f32_32x32x16_bf16(pa0, PK(0), o[d0], 0, 0, 0);
        o[d0] = __builtin_amdgcn_mfma_f32_32x32x16_bf16(pa1, PK(1), o[d0], 0, 0, 0);
        o[d0] = __builtin_amdgcn_mfma_f32_32x32x16_bf16(pa2, PK(2), o[d0], 0, 0, 0);
        o[d0] = __builtin_amdgcn_mfma_f32_32x32x16_bf16(pa3, PK(3), o[d0], 0, 0, 0);
#undef PK
    }
}
#define ATTN_STORE16(p, v) (*(u32x4*)(p) = (v))
template <int THRL> __device__ __forceinline__ void attn_unit(int qb, const bf16* Qh, const bf16* __restrict__ Kh, const bf16* __restrict__ Vh, bf16* Oh, char* shm) {
    const int tid = threadIdx.x; int lane = tid & 63; asm volatile("" : "+v"(lane));
    const int r32 = lane & 31, hi = lane >> 5; const int wid = __builtin_amdgcn_readfirstlane(tid >> 6);
    const int q0 = qb * QB;
    const bf16* Qw = Qh + (long)(q0 + wid * QBLK) * PZ;
    const unsigned lds0 = (unsigned)(uintptr_t)shm;
    float* wsf = (float*)(shm + LDS_WS) + wid * 64;
    const bf16* ksrc = Kh + (long)lane * PZ + wid * 8;
    const bf16* vsrc = Vh + (long)(16 * (wid & 3) + (lane >> 2)) * PV + (wid >> 2) * 32 + (lane & 3) * 8;
    const unsigned kdst = lds0 + LDS_K + wid * 1024, vdst = lds0 + LDS_V + wid * 1024;
#define DMA_K(t, slot) glds16(ksrc + (long)(t) * KVBLK * PZ, (unsigned)__builtin_amdgcn_readfirstlane(kdst + (slot)))
#define DMA_V(t, slot) glds16(vsrc + (long)(t) * KVBLK * PV, (unsigned)__builtin_amdgcn_readfirstlane(vdst + (slot)))
    const int vb0 = (int)(lds0 + LDS_V) + ((lane >> 4) & 1) * 32 + (lane & 3) * 8 + (4 * hi + ((lane & 15) >> 2)) * 64;
    const char* Kbase = shm + LDS_K; bf16x8 kf[8];
    const lds_cptr shm3 = (lds_cptr)shm; const lds_cptr kp0 = shm3 + LDS_K + hi * 1024 + r32 * 16; const lds_cptr vp0 = shm3 + LDS_V + ((lane >> 4) & 1) * 32 + (lane & 3) * 8 + (4 * hi + ((lane & 15) >> 2)) * 64;
    const int NT = (q0 + QB) / KVBLK;
    DMA_K(0, 0); DMA_V(0, 0); DMA_K(1, SLOTB);
    bf16x8 qr[4];
#pragma unroll
    for (int d0 = 0; d0 < 4; ++d0) qr[d0] = *reinterpret_cast<const bf16x8*>(&Qw[(long)r32 * PZ + d0 * 16 + hi * 8]);
    float mhat = 0.f, l_reg = 0.f; f32x16 o[2]; o[0] = f32x16{}; o[1] = f32x16{}; f32x16 negm = f32x16{}; asm volatile("" : "+v"(negm));
    const int qrel = wid * QBLK + r32;
#define CMASK(P0, P1, t) do { int jb_ = (t) - (NT - 4); if (jb_ >= 0) cmask(P0, P1, jb_, qrel, hi); } while (0)
    bool resc = false;
#define START(P0, P1) do { const float rm = rowmax(P0, P1); resc = false; \
    { const float dl = rm; mhat = fadd_s(mhat, dl); \
      _Pragma("unroll") for (int r = 0; r < 16; ++r) { P0[r] = fsub_s(P0[r], dl); P1[r] = fsub_s(P1[r], dl); } \
      _Pragma("unroll") for (int r = 0; r < 16; ++r) negm[r] = -mhat; asm volatile("" : "+v"(negm)); } \
    _Pragma("unroll") for (int r = 0; r < 16; ++r) P0[r] = __builtin_amdgcn_exp2f(P0[r]); } while (0)
#define RESC() do { if (resc) { asm volatile("s_waitcnt lgkmcnt(0)" ::: "memory"); \
      _Pragma("unroll") for (int d_ = 0; d_ < 2; ++d_) _Pragma("unroll") for (int r = 0; r < 16; ++r) o[d_][r] *= wsf[crow(r, hi)]; } } while (0)
    f32x16 pA0, pA1, pB0, pB1;
    int sl_prev = 0, sl_cur = 0, sl_next = SLOTB;
#define ROT() do { sl_prev = sl_cur; sl_cur = sl_next; sl_next = (sl_next == (NSLOT - 1) * SLOTB) ? 0 : sl_next + SLOTB; } while (0)
    DMA_K(2, 2 * SLOTB);
    WAIT_BAR(3);
    qkt(pA0, pA1, Kbase, qr, negm, r32, hi); asm volatile("s_nop 15\n\ts_nop 7" : "+v"(pA0), "+v"(pA1)); CMASK(pA0, pA1, 0);
    START(pA0, pA1);
    _Pragma("unroll") for (int r = 0; r < 16; ++r) pA1[r] = __builtin_amdgcn_exp2f(pA1[r]);
    WAIT_BAR(0);
    DMA_K(3, 0); DMA_V(1, SLOTB);
    ROT();
    kload8(kf, kp0 + sl_cur);
    WAIT_BAR(2);
    s16x4 vlo[8], vhi[8]; u32x4 pw0, pw1, pw2, pw3;
#define PKW(P, B) cvtpk_s(P[B], P[B + 1])
#define PAF(k) __builtin_bit_cast(bf16x8, pw##k)
#define VFR(i) (bf16x8){vlo[i][0], vlo[i][1], vlo[i][2], vlo[i][3], vhi[i][0], vhi[i][1], vhi[i][2], vhi[i][3]}
#define PIN(x) asm volatile("" : "+v"(x))
#define MX3(a, b, c) __builtin_fmaxf(__builtin_fmaxf((a), (b)), (c))
#define GAPA(MF, A0, A1, A2, A3, W0, W1, PW) do { MF; sacc += A0; sacc += A1; sacc += A2; sacc += A3; PIN(sacc); W0; W1; PIN(PW); SBAR(); } while (0)
#define EX(v) __builtin_amdgcn_exp2f(v)
#define GAPB(MF, X, B) do { MF; X[B] = EX(X[B]); X[B + 1] = EX(X[B + 1]); X[B + 2] = EX(X[B + 2]); X[B + 3] = EX(X[B + 3]); PIN(X); SBAR(); } while (0)
#define VRD(i) do { vlo[i] = vtr(vp_ + (((i) >> 2) * 4096 + ((i) & 3) * 1024)); vhi[i] = vtr(vp_ + (((i) >> 2) * 4096 + ((i) & 3) * 1024 + 512)); } while (0)
#define KRD(G, j) do { if (G) { kload2(kf, kp0 + sl_next, j); SBAR(); } } while (0)
#define STEP(C0, C1, P0, P1, t, GK, GV, GL) do { SBAR(); \
    const lds_cptr vp_ = vp0 + sl_prev; \
    VRD(0); SBAR(); float sacc = (P0[0] + P0[1]); \
    GAPA(C0 = __builtin_amdgcn_mfma_f32_32x32x16_bf16(kf[0], qr[0], negm, 0, 0, 0), P0[2], P0[3], P0[4], P0[5],     pw0[0] = PKW(P0, 0), pw0[1] = PKW(P0, 2), pw0); \
    VRD(4); SBAR(); GAPA(C1 = __builtin_amdgcn_mfma_f32_32x32x16_bf16(kf[1], qr[0], negm, 0, 0, 0), P0[6], P0[7], P0[8], P0[9],     pw0[2] = PKW(P0, 4), pw0[3] = PKW(P0, 6), pw0); \
    VRD(1); SBAR(); GAPA(C0 = __builtin_amdgcn_mfma_f32_32x32x16_bf16(kf[2], qr[1], C0, 0, 0, 0),   P0[10], P0[11], P0[12], P0[13], pw1[0] = PKW(P0, 8), pw1[1] = PKW(P0, 10), pw1); \
    VRD(5); SBAR(); GAPA(C1 = __builtin_amdgcn_mfma_f32_32x32x16_bf16(kf[3], qr[1], C1, 0, 0, 0),   P0[14], P0[15], P1[0], P1[1],   pw1[2] = PKW(P0, 12), pw1[3] = PKW(P0, 14), pw1); \
    VRD(2); SBAR(); GAPA(C0 = __builtin_amdgcn_mfma_f32_32x32x16_bf16(kf[4], qr[2], C0, 0, 0, 0),   P1[2], P1[3], P1[4], P1[5],     pw2[0] = PKW(P1, 0), pw2[1] = PKW(P1, 2), pw2); \
    VRD(6); SBAR(); GAPA(C1 = __builtin_amdgcn_mfma_f32_32x32x16_bf16(kf[5], qr[2], C1, 0, 0, 0),   P1[6], P1[7], P1[8], P1[9],     pw2[2] = PKW(P1, 4), pw2[3] = PKW(P1, 6), pw2); \
    VRD(3); SBAR(); GAPA(C0 = __builtin_amdgcn_mfma_f32_32x32x16_bf16(kf[6], qr[3], C0, 0, 0, 0),   P1[10], P1[11], P1[12], P1[13], pw3[0] = PKW(P1, 8), pw3[1] = PKW(P1, 10), pw3); \
    VRD(7); SBAR(); GAPA(C1 = __builtin_amdgcn_mfma_f32_32x32x16_bf16(kf[7], qr[3], C1, 0, 0, 0),   P1[14], P1[15], 0.f, 0.f,       pw3[2] = PKW(P1, 12), pw3[3] = PKW(P1, 14), pw3); \
    l_reg += sacc; \
    if (GK) { DMA_K((t) + 3, sl_cur); } if (GV) { DMA_V((t) + 1, sl_next); } \
    CMASK(C0, C1, t); \
    { float a = MX3(C0[0], C0[1], C1[0]), b = MX3(C0[2], C0[3], C1[1]); a = MX3(a, C1[2], C1[3]); \
      _Pragma("unroll") for (int r = 4; r < 16; r += 4) { a = MX3(a, C0[r], C0[r + 1]); b = MX3(b, C0[r + 2], C0[r + 3]); a = MX3(a, C1[r], C1[r + 1]); b = MX3(b, C1[r + 2], C1[r + 3]); } \
      float rm = __builtin_fmaxf(a, b); { auto rr = __builtin_amdgcn_permlane32_swap(__float_as_uint(rm), __float_as_uint(rm), false, false); rm = __builtin_fmaxf(__uint_as_float(rr[0]), __uint_as_float(rr[1])); } \
      resc = false; \
      if (__builtin_expect(__any(rm > (float)THRL), 0)) { const float dl = __builtin_fmaxf(rm, 0.f); mhat += dl; \
        _Pragma("unroll") for (int r = 0; r < 16; ++r) { C0[r] -= dl; C1[r] -= dl; } \
        _Pragma("unroll") for (int r = 0; r < 16; ++r) negm[r] = -mhat; asm volatile("" : "+v"(negm)); \
        const float f = __builtin_amdgcn_exp2f(-dl); l_reg *= f; if (hi == 0) wsf[r32] = f; resc = true; } } \
    SBAR(); \
    GAPB(o[0] = __builtin_amdgcn_mfma_f32_32x32x16_bf16(PAF(0), VFR(0), o[0], 0, 0, 0), C0, 0); \
    GAPB(o[1] = __builtin_amdgcn_mfma_f32_32x32x16_bf16(PAF(0), VFR(4), o[1], 0, 0, 0), C0, 4); \
    KRD(GL, 0); GAPB(o[0] = __builtin_amdgcn_mfma_f32_32x32x16_bf16(PAF(1), VFR(1), o[0], 0, 0, 0), C0, 8); \
    KRD(GL, 1); GAPB(o[1] = __builtin_amdgcn_mfma_f32_32x32x16_bf16(PAF(1), VFR(5), o[1], 0, 0, 0), C0, 12); \
    KRD(GL, 2); GAPB(o[0] = __builtin_amdgcn_mfma_f32_32x32x16_bf16(PAF(2), VFR(2), o[0], 0, 0, 0), C1, 0); \
    KRD(GL, 3); GAPB(o[1] = __builtin_amdgcn_mfma_f32_32x32x16_bf16(PAF(2), VFR(6), o[1], 0, 0, 0), C1, 4); \
    GAPB(o[0] = __builtin_amdgcn_mfma_f32_32x32x16_bf16(PAF(3), VFR(3), o[0], 0, 0, 0), C1, 8); \
    GAPB(o[1] = __builtin_amdgcn_mfma_f32_32x32x16_bf16(PAF(3), VFR(7), o[1], 0, 0, 0), C1, 12); \
    } while (0)
    int t = 1;
#undef CMASK
#define CMASK(P0, P1, t) do {} while (0)
    for (; t + 5 < NT; t += 2) {
        STEP(pB0, pB1, pA0, pA1, t, true, true, true);     WAIT_BAR(2); RESC(); ROT();
        STEP(pA0, pA1, pB0, pB1, t + 1, true, true, true); WAIT_BAR(2); RESC(); ROT();
    }
#undef CMASK
#define CMASK(P0, P1, t) do { int jb_ = (t) - (NT - 4); if (jb_ >= 0) cmask(P0, P1, jb_, qrel, hi); } while (0)
#define ENDW(tt) do { if ((tt) + 3 < NT) { WAIT_BAR(2); } else if ((tt) + 2 < NT) { WAIT_BAR(1); } else { WAIT_BAR(0); } } while (0)
    for (; t + 1 < NT; t += 2) {
        STEP(pB0, pB1, pA0, pA1, t, (t + 3 < NT), (t + 1 < NT), (t + 1 < NT));       ENDW(t);     RESC(); ROT();
        STEP(pA0, pA1, pB0, pB1, t + 1, (t + 4 < NT), (t + 2 < NT), (t + 2 < NT));   ENDW(t + 1); RESC(); ROT();
    }
    STEP(pB0, pB1, pA0, pA1, NT - 1, false, false, false); RESC();
    { float sacc = pB0[0] + pB0[1]; _Pragma("unroll") for (int r = 2; r < 16; ++r) sacc += pB0[r]; _Pragma("unroll") for (int r = 0; r < 16; ++r) sacc += pB1[r]; l_reg += sacc;
      pw0 = (u32x4){PKW(pB0, 0), PKW(pB0, 2), PKW(pB0, 4), PKW(pB0, 6)}; pw1 = (u32x4){PKW(pB0, 8), PKW(pB0, 10), PKW(pB0, 12), PKW(pB0, 14)}; pw2 = (u32x4){PKW(pB1, 0), PKW(pB1, 2), PKW(pB1, 4), PKW(pB1, 6)}; pw3 = (u32x4){PKW(pB1, 8), PKW(pB1, 10), PKW(pB1, 12), PKW(pB1, 14)};
      SBAR(); pv(o, vb0 + sl_cur, PAF(0), PAF(1), PAF(2), PAF(3)); }
#undef PKW
#undef PAF
#undef VFR
#undef PIN
#undef MX3
#undef GAPA
#undef GAPB
#undef EX
#undef VRD
#undef KRD
#undef STEP
#undef ENDW
    { auto rr = __builtin_amdgcn_permlane32_swap(__float_as_uint(l_reg), __float_as_uint(l_reg), false, false); l_reg = __uint_as_float(rr[0]) + __uint_as_float(rr[1]); }
    int lane2 = lane; asm volatile("" : "+v"(lane2));
    const int r32e = lane2 & 31, hie = lane2 >> 5;
    if (hie == 0) wsf[32 + r32e] = l_reg; asm volatile("s_waitcnt lgkmcnt(0)" ::: "memory");
    float rli[16];
#pragma unroll
    for (int r = 0; r < 16; ++r) rli[r] = __builtin_amdgcn_rcpf(wsf[32 + crow(r, hie)]);
    bf16* Ow = Oh + (long)(q0 + wid * QBLK) * PO;
    { bf16* stg = (bf16*)(shm + LDS_OST) + wid * 2048;
#pragma unroll
      for (int r = 0; r < 16; ++r) { const int orow = crow(r, hie);
#pragma unroll
        for (int d0 = 0; d0 < 2; ++d0) stg[orow * 64 + d0 * 32 + r32e] = __float2bfloat16(o[d0][r] * rli[r]); }
      asm volatile("s_waitcnt lgkmcnt(0)" ::: "memory");
#pragma unroll
      for (int i = 0; i < 4; ++i) { const int row = i * 8 + (lane2 >> 3), ch = lane2 & 7; const u32x4 v = *(const u32x4*)(stg + row * 64 + ch * 8); ATTN_STORE16(Ow + (long)row * PO + ch * 8, v); } }
    asm volatile("s_waitcnt lgkmcnt(0)\n\ts_barrier" ::: "memory");
#undef DMA_K
#undef DMA_V
#undef CMASK
#undef START
#undef RESC
#undef ROT
}

constexpr int A2_SLOT = 24576, A2_K = 0, A2_V = 8192, A2_WS = 4 * A2_SLOT, A2_OST = 0, A2_BYTES = A2_WS + NW * 256;
template <int THRL> __device__ __forceinline__ void attn2_unit(int qb, const bf16* Qh, const bf16* __restrict__ Kh, const bf16* __restrict__ Vh, bf16* Oh, char* shm, unsigned* prb = nullptr) {
    const int tid = threadIdx.x; int lane = tid & 63; asm volatile("" : "+v"(lane));
    const int r32 = lane & 31, hi = lane >> 5; const int wid = __builtin_amdgcn_readfirstlane(tid >> 6);
    const int q0 = qb * QB;
    const bf16* Qw = Qh + (long)(q0 + wid * QBLK) * PZ;
    const unsigned lds0 = (unsigned)(uintptr_t)shm;
    float* wsf = (float*)(shm + A2_WS) + wid * 64;
    bf16x8 qr[4];
#pragma unroll
    for (int d0 = 0; d0 < 4; ++d0) qr[d0] = *reinterpret_cast<const bf16x8*>(&Qw[(long)r32 * PZ + d0 * 16 + hi * 8]);
    const bf16* ksrc = Kh + (long)lane * PZ + wid * 8;
    const bf16* vsrc = Vh + (long)(16 * (wid & 3) + (lane >> 2)) * PV + (wid >> 2) * 32 + (lane & 3) * 8;
    const unsigned kdst = lds0 + A2_K + wid * 1024, vdst = lds0 + A2_V + wid * 1024;
#define A2_DMA(t, sl) do { glds16(ksrc + (long)(t) * KVBLK * PZ, (unsigned)__builtin_amdgcn_readfirstlane(kdst + (sl) * A2_SLOT)); \
        glds16(vsrc + (long)(t) * KVBLK * PV, (unsigned)__builtin_amdgcn_readfirstlane(vdst + (sl) * A2_SLOT)); \
        glds16(vsrc + (long)(t) * KVBLK * PV + 64, (unsigned)__builtin_amdgcn_readfirstlane(vdst + (sl) * A2_SLOT + 8192)); } while (0)
#define A2_WAITB(n1, n2) do { if (n2) asm volatile("s_waitcnt vmcnt(6)\n\ts_barrier" ::: "memory"); else if (n1) asm volatile("s_waitcnt vmcnt(3)\n\ts_barrier" ::: "memory"); else asm volatile("s_waitcnt vmcnt(0)\n\ts_barrier" ::: "memory"); } while (0)
    const int NT = (q0 + QB) / KVBLK;
    A2_DMA(0, 0); A2_DMA(1, 1); A2_DMA(2, 2);
    asm volatile("" : "+v"(qr[0]), "+v"(qr[1]), "+v"(qr[2]), "+v"(qr[3]));
    const lds_cptr shm3 = (lds_cptr)shm;
    const lds_cptr kp0 = shm3 + A2_K + hi * 1024 + r32 * 16;
    const lds_cptr vp0 = shm3 + A2_V + ((lane >> 4) & 1) * 32 + (lane & 3) * 8 + (4 * hi + ((lane & 15) >> 2)) * 64;
    float mhat = 0.f, l_reg = 0.f; f32x16 o[4]; o[0] = f32x16{}; o[1] = f32x16{}; o[2] = f32x16{}; o[3] = f32x16{}; f32x16 negm = f32x16{};
    const int qrel = wid * QBLK + r32;
#if MK_PROBE
    const unsigned long long pt0 = __builtin_amdgcn_s_memrealtime();
#endif
    for (int t = 0; t < NT; ++t) {
        A2_WAITB(t + 1 < NT, t + 2 < NT);
        if (t + 3 < NT) A2_DMA(t + 3, (t + 3) & 3);
        const int slot = t & 3;
        const lds_cptr kp = kp0 + slot * A2_SLOT; const lds_cptr vp = vp0 + slot * A2_SLOT;
        f32x16 p0, p1;
        {   bf16x8 kb[8];
#pragma unroll
            for (int d0 = 0; d0 < 4; ++d0) { kb[2 * d0] = *(const __attribute__((address_space(3))) bf16x8*)(kp + d0 * 2048); kb[2 * d0 + 1] = *(const __attribute__((address_space(3))) bf16x8*)(kp + d0 * 2048 + 512); }
            __builtin_amdgcn_sched_barrier(0);
            p0 = __builtin_amdgcn_mfma_f32_32x32x16_bf16(kb[0], qr[0], negm, 0, 0, 0); p1 = __builtin_amdgcn_mfma_f32_32x32x16_bf16(kb[1], qr[0], negm, 0, 0, 0);
#pragma unroll
            for (int d0 = 1; d0 < 4; ++d0) { p0 = __builtin_amdgcn_mfma_f32_32x32x16_bf16(kb[2 * d0], qr[d0], p0, 0, 0, 0); p1 = __builtin_amdgcn_mfma_f32_32x32x16_bf16(kb[2 * d0 + 1], qr[d0], p1, 0, 0, 0); }
        }
        { const int jb = t - (NT - 4); if (jb >= 0) cmask(p0, p1, jb, qrel, hi); }
        float rm;
        { float a = fmaxf(fmaxf(p0[0], p0[1]), p1[0]), b = fmaxf(fmaxf(p0[2], p0[3]), p1[1]); a = fmaxf(fmaxf(a, p1[2]), p1[3]);
#pragma unroll
          for (int r = 4; r < 16; r += 4) { a = fmaxf(fmaxf(a, p0[r]), p0[r + 1]); b = fmaxf(fmaxf(b, p0[r + 2]), p0[r + 3]); a = fmaxf(fmaxf(a, p1[r]), p1[r + 1]); b = fmaxf(fmaxf(b, p1[r + 2]), p1[r + 3]); }
          rm = fmaxf(a, b); auto rr = __builtin_amdgcn_permlane32_swap(__float_as_uint(rm), __float_as_uint(rm), false, false); rm = fmaxf(__uint_as_float(rr[0]), __uint_as_float(rr[1])); }
        if (t == 0 || __any(rm > (float)THRL)) {
            const float dl = (t == 0) ? rm : fmaxf(rm, 0.f); mhat += dl;
#pragma unroll
            for (int r = 0; r < 16; ++r) { p0[r] -= dl; p1[r] -= dl; negm[r] = -mhat; }
            const float f = __builtin_amdgcn_exp2f(-dl); l_reg *= f;
            if (t > 0) {
                if (hi == 0) wsf[r32] = f;
                asm volatile("s_waitcnt lgkmcnt(0)" ::: "memory");
#pragma unroll
                for (int r = 0; r < 16; ++r) { const float fr_ = wsf[crow(r, hi)];
#pragma unroll
                    for (int d_ = 0; d_ < 4; ++d_) o[d_][r] *= fr_; }
                asm volatile("s_waitcnt lgkmcnt(0)" ::: "memory");
            }
        }
        float sacc = 0.f;
#pragma unroll
        for (int r = 0; r < 16; ++r) { p0[r] = __builtin_amdgcn_exp2f(p0[r]); p1[r] = __builtin_amdgcn_exp2f(p1[r]); sacc += p0[r] + p1[r]; }
        l_reg += sacc;
        u32x4 pw[4];
        pw[0] = (u32x4){pkbf(p0[0], p0[1]), pkbf(p0[2], p0[3]), pkbf(p0[4], p0[5]), pkbf(p0[6], p0[7])};
        pw[1] = (u32x4){pkbf(p0[8], p0[9]), pkbf(p0[10], p0[11]), pkbf(p0[12], p0[13]), pkbf(p0[14], p0[15])};
        pw[2] = (u32x4){pkbf(p1[0], p1[1]), pkbf(p1[2], p1[3]), pkbf(p1[4], p1[5]), pkbf(p1[6], p1[7])};
        pw[3] = (u32x4){pkbf(p1[8], p1[9]), pkbf(p1[10], p1[11]), pkbf(p1[12], p1[13]), pkbf(p1[14], p1[15])};
        asm volatile("" : "+v"(pw[0]), "+v"(pw[1]), "+v"(pw[2]), "+v"(pw[3]));
        {   s16x4 vlo[2][4], vhh[2][4];
#pragma unroll
            for (int d0 = 0; d0 < 4; ++d0) { vlo[0][d0] = vtr(vp + d0 * 4096); vhh[0][d0] = vtr(vp + d0 * 4096 + 512); }
            __builtin_amdgcn_sched_barrier(0);
#pragma unroll
            for (int ks = 0; ks < 4; ++ks) {
                if (ks + 1 < 4) {
#pragma unroll
                    for (int d0 = 0; d0 < 4; ++d0) { vlo[(ks + 1) & 1][d0] = vtr(vp + d0 * 4096 + (ks + 1) * 1024); vhh[(ks + 1) & 1][d0] = vtr(vp + d0 * 4096 + (ks + 1) * 1024 + 512); }
                }
                __builtin_amdgcn_sched_barrier(0);
#pragma unroll
                for (int d0 = 0; d0 < 4; ++d0) {
                    const s16x4 lo = vlo[ks & 1][d0], hh = vhh[ks & 1][d0];
                    const bf16x8 vf = (bf16x8){lo[0], lo[1], lo[2], lo[3], hh[0], hh[1], hh[2], hh[3]};
                    o[d0] = __builtin_amdgcn_mfma_f32_32x32x16_bf16(__builtin_bit_cast(bf16x8, pw[ks]), vf, o[d0], 0, 0, 0);
                }
                __builtin_amdgcn_sched_barrier(0);
            }
        }
    }
#if MK_PROBE
    if (prb && tid == 0) { atomicAdd(prb, (unsigned)(__builtin_amdgcn_s_memrealtime() - pt0)); atomicAdd(prb + 1, (unsigned)NT); }
#endif
    asm volatile("s_waitcnt lgkmcnt(0)\n\ts_barrier" ::: "memory");
    { auto rr = __builtin_amdgcn_permlane32_swap(__float_as_uint(l_reg), __float_as_uint(l_reg), false, false); l_reg = __uint_as_float(rr[0]) + __uint_as_float(rr[1]); }
    if (hi == 0) wsf[32 + r32] = l_reg;
    asm volatile("s_waitcnt lgkmcnt(0)" ::: "memory");
    bf16* stg = (bf16*)(shm + A2_OST) + wid * 4096;
#pragma unroll
    for (int r = 0; r < 16; ++r) { const int orow = crow(r, hi); const float rl = __builtin_amdgcn_rcpf(wsf[32 + orow]);
#pragma unroll
        for (int d0 = 0; d0 < 4; ++d0) stg[orow * 128 + d0 * 32 + r32] = __float2bfloat16(o[d0][r] * rl); }
    asm volatile("s_waitcnt lgkmcnt(0)" ::: "memory");
    bf16* Ow = Oh + (long)(q0 + wid * QBLK) * PO;
#pragma unroll
    for (int i = 0; i < 8; ++i) { const int row = i * 4 + (lane >> 4), ch = lane & 15; const u32x4 v = *(const u32x4*)(stg + row * 128 + ch * 8); *(u32x4*)(Ow + (long)row * PO + ch * 8) = v; }
    asm volatile("s_waitcnt lgkmcnt(0)\n\ts_barrier" ::: "memory");
#undef A2_DMA
#undef A2_WAITB
}

template <int THRL> __device__ __forceinline__ void attn3_unit(int qb, const bf16* Qh, const bf16* __restrict__ Kh, const bf16* __restrict__ Vh, bf16* Oh, char* shm, unsigned* prb = nullptr) {
    const int tid = threadIdx.x; int lane = tid & 63; asm volatile("" : "+v"(lane));
    const int r32 = lane & 31, hi = lane >> 5; const int wid = __builtin_amdgcn_readfirstlane(tid >> 6);
    const int q0 = qb * QB;
    const bf16* Qw = Qh + (long)(q0 + wid * QBLK) * PZ;
    const unsigned lds0 = (unsigned)(uintptr_t)shm;
    float* wsf = (float*)(shm + A2_WS) + wid * 64;
    bf16x8 qr[4];
#pragma unroll
    for (int d0 = 0; d0 < 4; ++d0) qr[d0] = *reinterpret_cast<const bf16x8*>(&Qw[(long)r32 * PZ + d0 * 16 + hi * 8]);
    const bf16* ksrc = Kh + (long)lane * PZ + wid * 8;
    const bf16* vsrc = Vh + (long)(16 * (wid & 3) + (lane >> 2)) * PV + (wid >> 2) * 32 + (lane & 3) * 8;
    const unsigned kdst = lds0 + A2_K + wid * 1024, vdst = lds0 + A2_V + wid * 1024;
#define A3_DMA(t, sl) do { glds16(ksrc + (long)(t) * KVBLK * PZ, (unsigned)__builtin_amdgcn_readfirstlane(kdst + (sl) * A2_SLOT)); \
        glds16(vsrc + (long)(t) * KVBLK * PV, (unsigned)__builtin_amdgcn_readfirstlane(vdst + (sl) * A2_SLOT)); \
        glds16(vsrc + (long)(t) * KVBLK * PV + 64, (unsigned)__builtin_amdgcn_readfirstlane(vdst + (sl) * A2_SLOT + 8192)); } while (0)
#define A3_SB() __builtin_amdgcn_sched_barrier(0)
#define A3_MFMA(A_, B_, C_) __builtin_amdgcn_mfma_f32_32x32x16_bf16((A_), (B_), (C_), 0, 0, 0)
#define A3_KLD(D0) (*(const __attribute__((address_space(3))) bf16x8*)(kpn + (D0) * 2048))
#define A3_KLD2(D0) (*(const __attribute__((address_space(3))) bf16x8*)(kpn + (D0) * 2048 + 512))
#define A3_VLD(BUF, KS) do { _Pragma("unroll") for (int d_ = 0; d_ < 4; ++d_) { vlo[BUF][d_] = vtr(vp + d_ * 4096 + (KS) * 1024); vhh[BUF][d_] = vtr(vp + d_ * 4096 + (KS) * 1024 + 512); } } while (0)
#define A3_VF(BUF, D0) ((bf16x8){vlo[BUF][D0][0], vlo[BUF][D0][1], vlo[BUF][D0][2], vlo[BUF][D0][3], vhh[BUF][D0][0], vhh[BUF][D0][1], vhh[BUF][D0][2], vhh[BUF][D0][3]})
#define A3_EXP2(P, I) do { P[2 * (I)] = __builtin_amdgcn_exp2f(P[2 * (I)]); P[2 * (I) + 1] = __builtin_amdgcn_exp2f(P[2 * (I) + 1]); sacc += P[2 * (I)] + P[2 * (I) + 1]; } while (0)
#define A3_ROWMAX(P0, P1, RM) do { float a_ = fmaxf(fmaxf(P0[0], P0[1]), P1[0]), b_ = fmaxf(fmaxf(P0[2], P0[3]), P1[1]); a_ = fmaxf(fmaxf(a_, P1[2]), P1[3]); \
        _Pragma("unroll") for (int r_ = 4; r_ < 16; r_ += 4) { a_ = fmaxf(fmaxf(a_, P0[r_]), P0[r_ + 1]); b_ = fmaxf(fmaxf(b_, P0[r_ + 2]), P0[r_ + 3]); a_ = fmaxf(fmaxf(a_, P1[r_]), P1[r_ + 1]); b_ = fmaxf(fmaxf(b_, P1[r_ + 2]), P1[r_ + 3]); } \
        RM = fmaxf(a_, b_); auto rr_ = __builtin_amdgcn_permlane32_swap(__float_as_uint(RM), __float_as_uint(RM), false, false); RM = fmaxf(__uint_as_float(rr_[0]), __uint_as_float(rr_[1])); } while (0)
    const int NT = (q0 + QB) / KVBLK;
    A3_DMA(0, 0); A3_DMA(1, 1); A3_DMA(2, 2);
    asm volatile("" : "+v"(qr[0]), "+v"(qr[1]), "+v"(qr[2]), "+v"(qr[3]));
    const lds_cptr shm3 = (lds_cptr)shm;
    const lds_cptr kp0 = shm3 + A2_K + hi * 1024 + r32 * 16;
    const lds_cptr vp0 = shm3 + A2_V + ((lane >> 4) & 1) * 32 + (lane & 3) * 8 + (4 * hi + ((lane & 15) >> 2)) * 64;
    float mhat = 0.f, l_reg = 0.f; f32x16 o[4]; o[0] = f32x16{}; o[1] = f32x16{}; o[2] = f32x16{}; o[3] = f32x16{}; f32x16 negm = f32x16{};
    const int qrel = wid * QBLK + r32;
    f32x16 p0, p1; float rm;
    asm volatile("s_waitcnt vmcnt(6)\n\ts_barrier" ::: "memory");
    {   const lds_cptr kpn = kp0;
        p0 = A3_MFMA(A3_KLD(0), qr[0], negm); p1 = A3_MFMA(A3_KLD2(0), qr[0], negm);
#pragma unroll
        for (int d0 = 1; d0 < 4; ++d0) { p0 = A3_MFMA(A3_KLD(d0), qr[d0], p0); p1 = A3_MFMA(A3_KLD2(d0), qr[d0], p1); }
        if (NT == 4) cmask(p0, p1, 0, qrel, hi);
        A3_ROWMAX(p0, p1, rm);
        mhat = rm;
#pragma unroll
        for (int r = 0; r < 16; ++r) { p0[r] -= rm; p1[r] -= rm; negm[r] = -mhat; }
        rm = 0.f;
    }
#if MK_PROBE
    const unsigned long long pt0 = __builtin_amdgcn_s_memrealtime();
#endif
    for (int t = 0; t < NT; ++t) {
        if (t + 2 < NT) asm volatile("s_waitcnt vmcnt(3)\n\ts_barrier" ::: "memory"); else asm volatile("s_waitcnt vmcnt(0)\n\ts_barrier" ::: "memory");
        if (t + 3 < NT) A3_DMA(t + 3, (t + 3) & 3);
        const lds_cptr kpn = kp0 + ((t + 1) & 3) * A2_SLOT; const lds_cptr vp = vp0 + (t & 3) * A2_SLOT;
        if (__any(rm > (float)THRL)) {
            const float dl = fmaxf(rm, 0.f); mhat += dl;
#pragma unroll
            for (int r = 0; r < 16; ++r) { p0[r] -= dl; p1[r] -= dl; negm[r] = -mhat; }
            const float f = __builtin_amdgcn_exp2f(-dl); l_reg *= f;
            if (hi == 0) wsf[r32] = f;
            asm volatile("s_waitcnt lgkmcnt(0)" ::: "memory");
#pragma unroll
            for (int r = 0; r < 16; ++r) { const float fr_ = wsf[crow(r, hi)];
#pragma unroll
                for (int d_ = 0; d_ < 4; ++d_) o[d_][r] *= fr_; }
            asm volatile("s_waitcnt lgkmcnt(0)" ::: "memory");
        }
        float sacc = 0.f; f32x16 n0, n1; u32x4 pw0, pw1, pw2, pw3; s16x4 vlo[2][4], vhh[2][4];
        {   bf16x8 ka0 = A3_KLD(0), ka1 = A3_KLD2(0), ka2 = A3_KLD(1), ka3 = A3_KLD2(1);
            A3_VLD(0, 0);
            A3_SB();
            n0 = A3_MFMA(ka0, qr[0], negm); A3_EXP2(p0, 0); A3_SB();
            n1 = A3_MFMA(ka1, qr[0], negm); A3_EXP2(p0, 1); A3_SB();
            bf16x8 kb0 = A3_KLD(2), kb1 = A3_KLD2(2), kb2 = A3_KLD(3), kb3 = A3_KLD2(3);
            n0 = A3_MFMA(ka2, qr[1], n0); A3_EXP2(p0, 2); A3_SB();
            n1 = A3_MFMA(ka3, qr[1], n1); A3_EXP2(p0, 3); pw0 = (u32x4){pkbf(p0[0], p0[1]), pkbf(p0[2], p0[3]), pkbf(p0[4], p0[5]), pkbf(p0[6], p0[7])}; A3_SB();
            n0 = A3_MFMA(kb0, qr[2], n0); A3_EXP2(p0, 4); A3_SB();
            n1 = A3_MFMA(kb1, qr[2], n1); A3_EXP2(p0, 5); A3_SB();
            n0 = A3_MFMA(kb2, qr[3], n0); A3_EXP2(p0, 6); A3_SB();
            n1 = A3_MFMA(kb3, qr[3], n1); A3_EXP2(p0, 7); pw1 = (u32x4){pkbf(p0[8], p0[9]), pkbf(p0[10], p0[11]), pkbf(p0[12], p0[13]), pkbf(p0[14], p0[15])}; A3_SB();
        }
        A3_VLD(1, 1); A3_SB();
        o[0] = A3_MFMA(__builtin_bit_cast(bf16x8, pw0), A3_VF(0, 0), o[0]); A3_EXP2(p1, 0); A3_SB();
        o[1] = A3_MFMA(__builtin_bit_cast(bf16x8, pw0), A3_VF(0, 1), o[1]); A3_EXP2(p1, 1); A3_SB();
        o[2] = A3_MFMA(__builtin_bit_cast(bf16x8, pw0), A3_VF(0, 2), o[2]); A3_EXP2(p1, 2); A3_SB();
        o[3] = A3_MFMA(__builtin_bit_cast(bf16x8, pw0), A3_VF(0, 3), o[3]); A3_EXP2(p1, 3); pw2 = (u32x4){pkbf(p1[0], p1[1]), pkbf(p1[2], p1[3]), pkbf(p1[4], p1[5]), pkbf(p1[6], p1[7])}; A3_SB();
        A3_VLD(0, 2); A3_SB();
        o[0] = A3_MFMA(__builtin_bit_cast(bf16x8, pw1), A3_VF(1, 0), o[0]); A3_EXP2(p1, 4); A3_SB();
        o[1] = A3_MFMA(__builtin_bit_cast(bf16x8, pw1), A3_VF(1, 1), o[1]); A3_EXP2(p1, 5); A3_SB();
        o[2] = A3_MFMA(__builtin_bit_cast(bf16x8, pw1), A3_VF(1, 2), o[2]); A3_EXP2(p1, 6); A3_SB();
        o[3] = A3_MFMA(__builtin_bit_cast(bf16x8, pw1), A3_VF(1, 3), o[3]); A3_EXP2(p1, 7); pw3 = (u32x4){pkbf(p1[8], p1[9]), pkbf(p1[10], p1[11]), pkbf(p1[12], p1[13]), pkbf(p1[14], p1[15])}; A3_SB();
        l_reg += sacc;
        A3_VLD(1, 3); A3_SB();
        { const int jb = (t + 1) - (NT - 4); if (jb >= 0 && t + 1 < NT) cmask(n0, n1, jb, qrel, hi); }
        o[0] = A3_MFMA(__builtin_bit_cast(bf16x8, pw2), A3_VF(0, 0), o[0]);
        o[1] = A3_MFMA(__builtin_bit_cast(bf16x8, pw2), A3_VF(0, 1), o[1]);
        o[2] = A3_MFMA(__builtin_bit_cast(bf16x8, pw2), A3_VF(0, 2), o[2]);
        o[3] = A3_MFMA(__builtin_bit_cast(bf16x8, pw2), A3_VF(0, 3), o[3]); A3_SB();
        o[0] = A3_MFMA(__builtin_bit_cast(bf16x8, pw3), A3_VF(1, 0), o[0]);
        o[1] = A3_MFMA(__builtin_bit_cast(bf16x8, pw3), A3_VF(1, 1), o[1]);
        o[2] = A3_MFMA(__builtin_bit_cast(bf16x8, pw3), A3_VF(1, 2), o[2]);
        o[3] = A3_MFMA(__builtin_bit_cast(bf16x8, pw3), A3_VF(1, 3), o[3]);
        A3_ROWMAX(n0, n1, rm);
        p0 = n0; p1 = n1;
        A3_SB();
    }
#if MK_PROBE
    if (prb && tid == 0) { atomicAdd(prb, (unsigned)(__builtin_amdgcn_s_memrealtime() - pt0)); atomicAdd(prb + 1, (unsigned)NT); }
#endif
    asm volatile("s_waitcnt lgkmcnt(0)\n\ts_barrier" ::: "memory");
    { auto rr = __builtin_amdgcn_permlane32_swap(__float_as_uint(l_reg), __float_as_uint(l_reg), false, false); l_reg = __uint_as_float(rr[0]) + __uint_as_float(rr[1]); }
    if (hi == 0) wsf[32 + r32] = l_reg;
    asm volatile("s_waitcnt lgkmcnt(0)" ::: "memory");
    bf16* stg = (bf16*)(shm + A2_OST) + wid * 4096;
#pragma unroll
    for (int r = 0; r < 16; ++r) { const int orow = crow(r, hi); const float rl = __builtin_amdgcn_rcpf(wsf[32 + orow]);
#pragma unroll
        for (int d0 = 0; d0 < 4; ++d0) stg[orow * 128 + d0 * 32 + r32] = __float2bfloat16(o[d0][r] * rl); }
    asm volatile("s_waitcnt lgkmcnt(0)" ::: "memory");
    bf16* Ow = Oh + (long)(q0 + wid * QBLK) * PO;
#pragma unroll
    for (int i = 0; i < 8; ++i) { const int row = i * 4 + (lane >> 4), ch = lane & 15; const u32x4 v = *(const u32x4*)(stg + row * 128 + ch * 8); *(u32x4*)(Ow + (long)row * PO + ch * 8) = v; }
    asm volatile("s_waitcnt lgkmcnt(0)\n\ts_barrier" ::: "memory");
#undef A3_DMA
#undef A3_SB
#undef A3_MFMA
#undef A3_KLD
#undef A3_KLD2
#undef A3_VLD
#undef A3_VF
#undef A3_EXP2
#undef A3_ROWMAX
}
template <int THRL> __device__ __forceinline__ void attn4_unit(int qb, const bf16* Qh0, const bf16* __restrict__ Kh0, long mapstride, const bf16* __restrict__ Vh, bf16_t* YCb_, int yrow0, int ycol0, float lam, const float* gvec, u32x4* park, char* shm) {
#pragma unroll 1
  for (int mp = 0; mp < 2; ++mp) {
    const bf16* Qh = Qh0 + mp * mapstride; const bf16* Kh = Kh0 + mp * mapstride;
    const int tid = threadIdx.x; int lane = tid & 63; asm volatile("" : "+v"(lane));
    const int r32 = lane & 31, hi = lane >> 5; const int wid = __builtin_amdgcn_readfirstlane(tid >> 6);
    const int q0 = qb * QB + NMETA;
    const bf16* Qw = Qh + (long)(q0 + wid * QBLK) * PZ;
    const unsigned lds0 = (unsigned)(uintptr_t)shm;
    float* wsf = (float*)(shm + A2_WS) + wid * 64;
    bf16x8 qr[4];
#pragma unroll
    for (int d0 = 0; d0 < 4; ++d0) qr[d0] = *reinterpret_cast<const bf16x8*>(&Qw[(long)r32 * PZ + d0 * 16 + hi * 8]);
    const bf16* ksrc = Kh + (long)lane * PZ + wid * 8;
    const bf16* vsrc = Vh + (long)(16 * (wid & 3) + (lane >> 2)) * PV + (wid >> 2) * 32 + (lane & 3) * 8;
    const unsigned kdst = lds0 + A2_K + wid * 1024, vdst = lds0 + A2_V + wid * 1024;
#define A3_DMA(t, sl) do { glds16(ksrc + (long)(t) * KVBLK * PZ, (unsigned)__builtin_amdgcn_readfirstlane(kdst + (sl) * A2_SLOT)); \
        glds16(vsrc + (long)(t) * KVBLK * PV, (unsigned)__builtin_amdgcn_readfirstlane(vdst + (sl) * A2_SLOT)); \
        glds16(vsrc + (long)(t) * KVBLK * PV + 64, (unsigned)__builtin_amdgcn_readfirstlane(vdst + (sl) * A2_SLOT + 8192)); } while (0)
#define A3_SB() __builtin_amdgcn_sched_barrier(0)
#define A3_MFMA(A_, B_, C_) __builtin_amdgcn_mfma_f32_32x32x16_bf16((A_), (B_), (C_), 0, 0, 0)
#define A3_KLD(D0) (*(const __attribute__((address_space(3))) bf16x8*)(kpn + (D0) * 2048))
#define A3_KLD2(D0) (*(const __attribute__((address_space(3))) bf16x8*)(kpn + (D0) * 2048 + 512))
#define A3_VLD(BUF, KS) do { _Pragma("unroll") for (int d_ = 0; d_ < 4; ++d_) { vlo[BUF][d_] = vtr(vp + d_ * 4096 + (KS) * 1024); vhh[BUF][d_] = vtr(vp + d_ * 4096 + (KS) * 1024 + 512); } } while (0)
#define A3_VF(BUF, D0) ((bf16x8){vlo[BUF][D0][0], vlo[BUF][D0][1], vlo[BUF][D0][2], vlo[BUF][D0][3], vhh[BUF][D0][0], vhh[BUF][D0][1], vhh[BUF][D0][2], vhh[BUF][D0][3]})
#define A3_EXP2(P, I) do { P[2 * (I)] = __builtin_amdgcn_exp2f(P[2 * (I)]); P[2 * (I) + 1] = __builtin_amdgcn_exp2f(P[2 * (I) + 1]); sacc += P[2 * (I)] + P[2 * (I) + 1]; } while (0)
#define A3_ROWMAX(P0, P1, RM) do { float a_ = fmaxf(fmaxf(P0[0], P0[1]), P1[0]), b_ = fmaxf(fmaxf(P0[2], P0[3]), P1[1]); a_ = fmaxf(fmaxf(a_, P1[2]), P1[3]); \
        _Pragma("unroll") for (int r_ = 4; r_ < 16; r_ += 4) { a_ = fmaxf(fmaxf(a_, P0[r_]), P0[r_ + 1]); b_ = fmaxf(fmaxf(b_, P0[r_ + 2]), P0[r_ + 3]); a_ = fmaxf(fmaxf(a_, P1[r_]), P1[r_ + 1]); b_ = fmaxf(fmaxf(b_, P1[r_ + 2]), P1[r_ + 3]); } \
        RM = fmaxf(a_, b_); auto rr_ = __builtin_amdgcn_permlane32_swap(__float_as_uint(RM), __float_as_uint(RM), false, false); RM = fmaxf(__uint_as_float(rr_[0]), __uint_as_float(rr_[1])); } while (0)
    const int NT = 4 * qb + 5;
    const int qrel16 = wid * QBLK + r32 + NMETA;
    A3_DMA(0, 0); A3_DMA(1, 1); A3_DMA(2, 2);
    asm volatile("" : "+v"(qr[0]), "+v"(qr[1]), "+v"(qr[2]), "+v"(qr[3]));
    const lds_cptr shm3 = (lds_cptr)shm;
    const lds_cptr kp0 = shm3 + A2_K + hi * 1024 + r32 * 16;
    const lds_cptr vp0 = shm3 + A2_V + ((lane >> 4) & 1) * 32 + (lane & 3) * 8 + (4 * hi + ((lane & 15) >> 2)) * 64;
    float mhat = 0.f, l_reg = 0.f; f32x16 o[4]; o[0] = f32x16{}; o[1] = f32x16{}; o[2] = f32x16{}; o[3] = f32x16{}; f32x16 negm = f32x16{};
    const int qrel = wid * QBLK + r32;
    f32x16 p0, p1; float rm;
    asm volatile("s_waitcnt vmcnt(6)\n\ts_barrier" ::: "memory");
    {   const lds_cptr kpn = kp0;
        p0 = A3_MFMA(A3_KLD(0), qr[0], negm); p1 = A3_MFMA(A3_KLD2(0), qr[0], negm);
#pragma unroll
        for (int d0 = 1; d0 < 4; ++d0) { p0 = A3_MFMA(A3_KLD(d0), qr[d0], p0); p1 = A3_MFMA(A3_KLD2(d0), qr[d0], p1); }
        if (qb == 0) cmask(p0, p1, 0, qrel16, hi);
        A3_ROWMAX(p0, p1, rm);
        mhat = rm;
#pragma unroll
        for (int r = 0; r < 16; ++r) { p0[r] -= rm; p1[r] -= rm; negm[r] = -mhat; }
        rm = 0.f;
    }
    for (int t = 0; t < NT; ++t) {
        if (t + 2 < NT) asm volatile("s_waitcnt vmcnt(3)\n\ts_barrier" ::: "memory"); else asm volatile("s_waitcnt vmcnt(0)\n\ts_barrier" ::: "memory");
        if (t + 3 < NT) A3_DMA(t + 3, (t + 3) & 3);
        const lds_cptr kpn = kp0 + ((t + 1) & 3) * A2_SLOT; const lds_cptr vp = vp0 + (t & 3) * A2_SLOT;
        if (__any(rm > (float)THRL)) {
            const float dl = fmaxf(rm, 0.f); mhat += dl;
#pragma unroll
            for (int r = 0; r < 16; ++r) { p0[r] -= dl; p1[r] -= dl; negm[r] = -mhat; }
            const float f = __builtin_amdgcn_exp2f(-dl); l_reg *= f;
            if (hi == 0) wsf[r32] = f;
            asm volatile("s_waitcnt lgkmcnt(0)" ::: "memory");
#pragma unroll
            for (int r = 0; r < 16; ++r) { const float fr_ = wsf[crow(r, hi)];
#pragma unroll
                for (int d_ = 0; d_ < 4; ++d_) o[d_][r] *= fr_; }
            asm volatile("s_waitcnt lgkmcnt(0)" ::: "memory");
        }
        float sacc = 0.f; f32x16 n0, n1; u32x4 pw0, pw1, pw2, pw3; s16x4 vlo[2][4], vhh[2][4];
        {   bf16x8 ka0 = A3_KLD(0), ka1 = A3_KLD2(0), ka2 = A3_KLD(1), ka3 = A3_KLD2(1);
            A3_VLD(0, 0);
            A3_SB();
            n0 = A3_MFMA(ka0, qr[0], negm); A3_EXP2(p0, 0); A3_SB();
            n1 = A3_MFMA(ka1, qr[0], negm); A3_EXP2(p0, 1); A3_SB();
            bf16x8 kb0 = A3_KLD(2), kb1 = A3_KLD2(2), kb2 = A3_KLD(3), kb3 = A3_KLD2(3);
            n0 = A3_MFMA(ka2, qr[1], n0); A3_EXP2(p0, 2); A3_SB();
            n1 = A3_MFMA(ka3, qr[1], n1); A3_EXP2(p0, 3); pw0 = (u32x4){pkbf(p0[0], p0[1]), pkbf(p0[2], p0[3]), pkbf(p0[4], p0[5]), pkbf(p0[6], p0[7])}; A3_SB();
            n0 = A3_MFMA(kb0, qr[2], n0); A3_EXP2(p0, 4); A3_SB();
            n1 = A3_MFMA(kb1, qr[2], n1); A3_EXP2(p0, 5); A3_SB();
            n0 = A3_MFMA(kb2, qr[3], n0); A3_EXP2(p0, 6); A3_SB();
            n1 = A3_MFMA(kb3, qr[3], n1); A3_EXP2(p0, 7); pw1 = (u32x4){pkbf(p0[8], p0[9]), pkbf(p0[10], p0[11]), pkbf(p0[12], p0[13]), pkbf(p0[14], p0[15])}; A3_SB();
        }
        A3_VLD(1, 1); A3_SB();
        o[0] = A3_MFMA(__builtin_bit_cast(bf16x8, pw0), A3_VF(0, 0), o[0]); A3_EXP2(p1, 0); A3_SB();
        o[1] = A3_MFMA(__builtin_bit_cast(bf16x8, pw0), A3_VF(0, 1), o[1]); A3_EXP2(p1, 1); A3_SB();
        o[2] = A3_MFMA(__builtin_bit_cast(bf16x8, pw0), A3_VF(0, 2), o[2]); A3_EXP2(p1, 2); A3_SB();
        o[3] = A3_MFMA(__builtin_bit_cast(bf16x8, pw0), A3_VF(0, 3), o[3]); A3_EXP2(p1, 3); pw2 = (u32x4){pkbf(p1[0], p1[1]), pkbf(p1[2], p1[3]), pkbf(p1[4], p1[5]), pkbf(p1[6], p1[7])}; A3_SB();
        A3_VLD(0, 2); A3_SB();
        o[0] = A3_MFMA(__builtin_bit_cast(bf16x8, pw1), A3_VF(1, 0), o[0]); A3_EXP2(p1, 4); A3_SB();
        o[1] = A3_MFMA(__builtin_bit_cast(bf16x8, pw1), A3_VF(1, 1), o[1]); A3_EXP2(p1, 5); A3_SB();
        o[2] = A3_MFMA(__builtin_bit_cast(bf16x8, pw1), A3_VF(1, 2), o[2]); A3_EXP2(p1, 6); A3_SB();
        o[3] = A3_MFMA(__builtin_bit_cast(bf16x8, pw1), A3_VF(1, 3), o[3]); A3_EXP2(p1, 7); pw3 = (u32x4){pkbf(p1[8], p1[9]), pkbf(p1[10], p1[11]), pkbf(p1[12], p1[13]), pkbf(p1[14], p1[15])}; A3_SB();
        l_reg += sacc;
        A3_VLD(1, 3); A3_SB();
        { const int jb = (t + 1) - 4 * qb; if (jb >= 0 && t + 1 < NT) cmask(n0, n1, jb, qrel16, hi); }
        o[0] = A3_MFMA(__builtin_bit_cast(bf16x8, pw2), A3_VF(0, 0), o[0]);
        o[1] = A3_MFMA(__builtin_bit_cast(bf16x8, pw2), A3_VF(0, 1), o[1]);
        o[2] = A3_MFMA(__builtin_bit_cast(bf16x8, pw2), A3_VF(0, 2), o[2]);
        o[3] = A3_MFMA(__builtin_bit_cast(bf16x8, pw2), A3_VF(0, 3), o[3]); A3_SB();
        o[0] = A3_MFMA(__builtin_bit_cast(bf16x8, pw3), A3_VF(1, 0), o[0]);
        o[1] = A3_MFMA(__builtin_bit_cast(bf16x8, pw3), A3_VF(1, 1), o[1]);
        o[2] = A3_MFMA(__builtin_bit_cast(bf16x8, pw3), A3_VF(1, 2), o[2]);
        o[3] = A3_MFMA(__builtin_bit_cast(bf16x8, pw3), A3_VF(1, 3), o[3]);
        A3_ROWMAX(n0, n1, rm);
        p0 = n0; p1 = n1;
        A3_SB();
    }
    asm volatile("s_waitcnt lgkmcnt(0)\n\ts_barrier" ::: "memory");
    { auto rr = __builtin_amdgcn_permlane32_swap(__float_as_uint(l_reg), __float_as_uint(l_reg), false, false); l_reg = __uint_as_float(rr[0]) + __uint_as_float(rr[1]); }
    if (hi == 0) wsf[32 + r32] = l_reg;
    asm volatile("s_waitcnt lgkmcnt(0)" ::: "memory");
    float rl[16];
#pragma unroll
    for (int r = 0; r < 16; ++r) rl[r] = __builtin_amdgcn_rcpf(wsf[32 + crow(r, hi)]);
    if (mp == 0) {
#pragma unroll
        for (int d0 = 0; d0 < 4; ++d0)
#pragma unroll
            for (int q4 = 0; q4 < 2; ++q4) { u32x4 w;
                w.x = pkbf(o[d0][8 * q4 + 0] * rl[8 * q4 + 0], o[d0][8 * q4 + 1] * rl[8 * q4 + 1]); w.y = pkbf(o[d0][8 * q4 + 2] * rl[8 * q4 + 2], o[d0][8 * q4 + 3] * rl[8 * q4 + 3]);
                w.z = pkbf(o[d0][8 * q4 + 4] * rl[8 * q4 + 4], o[d0][8 * q4 + 5] * rl[8 * q4 + 5]); w.w = pkbf(o[d0][8 * q4 + 6] * rl[8 * q4 + 6], o[d0][8 * q4 + 7] * rl[8 * q4 + 7]);
                park[d0 * 2 + q4] = w; }
    } else {
        float ss[16];
#pragma unroll
        for (int r = 0; r < 16; ++r) ss[r] = 0.f;
#pragma unroll
        for (int d0 = 0; d0 < 4; ++d0)
#pragma unroll
            for (int q4 = 0; q4 < 2; ++q4) { const u32x4 w = park[d0 * 2 + q4];
                const float a_[8] = {bflo(w.x), bfhi(w.x), bflo(w.y), bfhi(w.y), bflo(w.z), bfhi(w.z), bflo(w.w), bfhi(w.w)};
#pragma unroll
                for (int e = 0; e < 8; ++e) { const int r = 8 * q4 + e; const float y = a_[e] - lam * (o[d0][r] * rl[r]); o[d0][r] = y; ss[r] += y * y; } }
        const f32x4 g4 = (f32x4){gvec[r32], gvec[32 + r32], gvec[64 + r32], gvec[96 + r32]} * (1.0f - LAMBDA_INIT);
#pragma unroll
        for (int r = 0; r < 16; ++r) {
            float v = row_sum16(ss[r]);
            auto rr = __builtin_amdgcn_permlane16_swap(__float_as_uint(v), __float_as_uint(v), false, false); v = __uint_as_float(rr[0]) + __uint_as_float(rr[1]);
            ss[r] = 1.0f / sqrtf(v * (1.f / 128.f) + LN_EPS);
        }
        bf16* stg = (bf16*)(shm + A2_OST) + wid * 4096;
#pragma unroll
        for (int r = 0; r < 16; ++r) { const int orow = crow(r, hi);
#pragma unroll
            for (int d0 = 0; d0 < 4; ++d0) stg[orow * 128 + d0 * 32 + r32] = __float2bfloat16(o[d0][r] * ss[r] * g4[d0]); }
        asm volatile("s_waitcnt lgkmcnt(0)" ::: "memory");
#pragma unroll
        for (int i = 0; i < 8; ++i) { const int row = i * 4 + (lane >> 4), ch = lane & 15; const int tq = q0 + wid * QBLK + row;
            if (tq >= NMETA && tq < TT) { const u32x4 v = *(const u32x4*)(stg + row * 128 + ch * 8);
                u32x2 w8; w8.x = pkfp8x4(bflo(v.x) * FP8_SA3, bfhi(v.x) * FP8_SA3, bflo(v.y) * FP8_SA3, bfhi(v.y) * FP8_SA3); w8.y = pkfp8x4(bflo(v.z) * FP8_SA3, bfhi(v.z) * FP8_SA3, bflo(v.w) * FP8_SA3, bfhi(v.w) * FP8_SA3);
                *(u32x2*)((unsigned char*)YCb_ + (size_t)(yrow0 + tq - NMETA) * DM + ycol0 + ch * 8) = w8; } }
    }
    asm volatile("s_waitcnt lgkmcnt(0)\n\ts_barrier" ::: "memory");
#undef A3_DMA
#undef A3_SB
#undef A3_MFMA
#undef A3_KLD
#undef A3_KLD2
#undef A3_VLD
#undef A3_VF
#undef A3_EXP2
#undef A3_ROWMAX
  }
}
#undef SBAR
#undef WAIT_BAR
}

#define XB_TMO      128
#define XB_XCNT(j)  (256  + 64 * (j))
#define XB_XSUB(j)  (1280 + 64 * (j))
#define XB_XGEN(j)  (2304 + 64 * (j))
#define XB_TOP      3328
#define XB_TOPGEN   3392
#define XCD_BAR_WORDS 3456
#define XB_SPIN_CAP (1u << 18)
__device__ __forceinline__ unsigned xb_ld(unsigned* p)              { return __hip_atomic_load(p, __ATOMIC_RELAXED, __HIP_MEMORY_SCOPE_AGENT); }
__device__ __forceinline__ unsigned xb_add(unsigned* p, unsigned v) { return __hip_atomic_fetch_add(p, v, __ATOMIC_RELAXED, __HIP_MEMORY_SCOPE_AGENT); }
__device__ __forceinline__ unsigned xb_xcc_id() { return (unsigned)__builtin_amdgcn_s_getreg((3 << 11) | 20) & 0xFu; }
#define XB_SPIN(cond, bar) do { unsigned _sp = 0; while (cond) { __builtin_amdgcn_s_sleep(1); \
    if ((++_sp & 255u) == 0u) { if (xb_ld(&(bar)[XB_TMO])) break; if (_sp > XB_SPIN_CAP) { atomicAdd(&(bar)[XB_TMO], 1u); break; } } } } while (0)
struct XcdBarrier { unsigned* bar; unsigned x; volatile LAS unsigned* st; };
__device__ __forceinline__ XcdBarrier xcd_barrier_post(unsigned* bar, volatile LAS unsigned* st) {
    XcdBarrier b; b.bar = bar; b.x = xb_xcc_id(); b.st = st;
    if (threadIdx.x == 0) (void)xb_add(&bar[XB_XCNT(b.x)], 1u);
    return b;
}
__device__ __forceinline__ void xcd_barrier_complete(unsigned* bar, unsigned x, unsigned& nloc, unsigned& nx) {
    const unsigned G = gridDim.x * gridDim.y * gridDim.z;
    unsigned sum, cnt, mine, sp = 0u;
    for (;;) {
        sum = 0u; cnt = 0u; mine = 0u;
#pragma unroll
        for (unsigned j = 0; j < 16; ++j) { const unsigned c = xb_ld(&bar[XB_XCNT(j)]); sum += c; cnt += (c > 0u) ? 1u : 0u; mine = (j == x) ? c : mine; }
        if (sum == G) break;
        __builtin_amdgcn_s_sleep(1);
        if ((++sp & 255u) == 0u) { if (xb_ld(&bar[XB_TMO])) break; if (sp > XB_SPIN_CAP) { atomicAdd(&bar[XB_TMO], 1u); break; } }
    }
    nloc = mine > 0u ? mine : 1u; nx = cnt > 0u ? cnt : 1u;
}
__device__ __forceinline__ void xcd_barrier(const XcdBarrier& b) {
    asm volatile("s_waitcnt vmcnt(0)" ::: "memory");
    __syncthreads();
    if (threadIdx.x == 0) {
        unsigned* bar = b.bar;
        __builtin_amdgcn_s_waitcnt(0);
        unsigned nloc = b.st[0], nx = b.st[1];
        if (nloc == 0u) { xcd_barrier_complete(bar, b.x, nloc, nx); b.st[0] = nloc; b.st[1] = nx; }
        const unsigned old = xb_add(&bar[XB_XSUB(b.x)], 1u);
        const unsigned gen = old / nloc;
        if (old + 1u == (gen + 1u) * nloc) {
            __builtin_amdgcn_fence(__ATOMIC_RELEASE, "agent");
            asm volatile("s_waitcnt vmcnt(0)" ::: "memory");
            const unsigned og = xb_add(&bar[XB_TOP], 1u);
            const unsigned tg = og / nx;
            if (og + 1u == (tg + 1u) * nx) xb_add(&bar[XB_TOPGEN], 1u);
            else XB_SPIN(xb_ld(&bar[XB_TOPGEN]) == tg, bar);
            __builtin_amdgcn_fence(__ATOMIC_ACQUIRE, "agent");
            xb_add(&bar[XB_XGEN(b.x)], 1u);
            asm volatile("s_waitcnt vmcnt(0)" ::: "memory");
        } else {
            XB_SPIN(xb_ld(&bar[XB_XGEN(b.x)]) == gen, bar);
            __builtin_amdgcn_fence(__ATOMIC_ACQUIRE, "agent");
            asm volatile("s_waitcnt vmcnt(0)" ::: "memory");
        }
    }
    __syncthreads();
}

struct Args {
    const float *x, *meta, *ln0_g, *ln0_b, *w_in, *conv_w, *conv_b, *gate_bias, *lq1, *lk1, *lq2, *lk2, *att_g, *ml_g, *w_att_out, *w_ml_out, *w_o,
                *ln1_g, *ln1_b, *w_router, *b_router, *w_gu, *b_gu, *w_down, *b_down, *ln2_g, *ln2_b;
    float* out; unsigned char* ws; int ph_lo, ph_hi;
};

template <class ColMap>
__device__ __forceinline__ void transpose_item(const float* W, int K, int N, bf16_t* WT, LAS float* scr, int kb, int nb, int lane, ColMap cm, int ldw = 0, unsigned char* WT8 = nullptr, float s8 = 1.f) {
    if (ldw == 0) ldw = K;
    const int k0 = 64 * kb, n0 = 32 * nb;
    const int lc = cm(n0 + (lane & 31));
    float tv[32];
    const float* wp = W + (size_t)(k0 + (lane >> 5)) * N + lc;
#pragma unroll
    for (int i = 0; i < 32; ++i) tv[i] = wp[(size_t)(2 * i) * N];
#pragma unroll
    for (int i = 0; i < 32; ++i) { const int kk = 2 * i + (lane >> 5); scr[kk * 33 + (lane & 31)] = tv[i]; }
    LDS_WAIT(); asm volatile("" ::: "memory");
    const int c = lane & 7;
#pragma unroll
    for (int j = 0; j < 4; ++j) { const int n = (lane >> 3) + 8 * j; const LAS float* s = scr + (8 * c) * 33 + n;
        if (WT8) { u32x2 o8; o8.x = pkfp8x4(s[0 * 33] * s8, s[1 * 33] * s8, s[2 * 33] * s8, s[3 * 33] * s8); o8.y = pkfp8x4(s[4 * 33] * s8, s[5 * 33] * s8, s[6 * 33] * s8, s[7 * 33] * s8);
            *(u32x2*)(WT8 + (size_t)(n0 + n) * ldw + k0 + 8 * c) = o8; }
        else { u32x4 o; o.x = pkbf(s[0 * 33], s[1 * 33]); o.y = pkbf(s[2 * 33], s[3 * 33]); o.z = pkbf(s[4 * 33], s[5 * 33]); o.w = pkbf(s[6 * 33], s[7 * 33]);
            *(u32x4*)(WT + (size_t)(n0 + n) * ldw + k0 + 8 * c) = o; } }
    LDS_WAIT(); asm volatile("" ::: "memory");
}
template <class ColMap>
__device__ __forceinline__ void transpose_item2(const float* W, int K, int N, bf16_t* WT, LAS float* scr, int kb, int nb, int lane, ColMap cm) {
    const int k0 = 64 * kb, n0 = 32 * nb;
    const int lc0 = cm(n0 + (lane & 31)), lc1 = cm(n0 + 32 + (lane & 31));
    float ta[32], tb[32];
    const float* wp = W + (size_t)(k0 + (lane >> 5)) * N;
#pragma unroll
    for (int i = 0; i < 32; ++i) { ta[i] = wp[(size_t)(2 * i) * N + lc0]; tb[i] = wp[(size_t)(2 * i) * N + lc1]; }
    LAS float* scr2 = scr + 64 * 33;
#pragma unroll
    for (int i = 0; i < 32; ++i) { const int kk = 2 * i + (lane >> 5); scr[kk * 33 + (lane & 31)] = ta[i]; scr2[kk * 33 + (lane & 31)] = tb[i]; }
    LDS_WAIT(); asm volatile("" ::: "memory");
    const int c = lane & 7;
#pragma unroll
    for (int h2 = 0; h2 < 2; ++h2) { const LAS float* sb = h2 ? scr2 : scr;
#pragma unroll
        for (int j = 0; j < 4; ++j) { const int n = (lane >> 3) + 8 * j; const LAS float* sp = sb + (8 * c) * 33 + n;
            u32x4 o; o.x = pkbf(sp[0 * 33], sp[1 * 33]); o.y = pkbf(sp[2 * 33], sp[3 * 33]); o.z = pkbf(sp[4 * 33], sp[5 * 33]); o.w = pkbf(sp[6 * 33], sp[7 * 33]);
            *(u32x4*)(WT + (size_t)(n0 + 32 * h2 + n) * K + k0 + 8 * c) = o; } }
    LDS_WAIT(); asm volatile("" ::: "memory");
}
template <class InvMap>
__device__ __forceinline__ void transpose_tile64(const float* W, int N, bf16_t* WT, int ldw, LAS unsigned char* scr, int k0, int c0, int lane, InvMap inv) {
    constexpr int TP = 136;
    asm volatile("" : "+v"(lane));
    const float* wp = W + (size_t)(k0 + (lane >> 4)) * N + c0 + (lane & 15) * 4;
#pragma unroll
    for (int hf = 0; hf < 2; ++hf) {
        f32x4 tv[8];
#pragma unroll
        for (int i = 0; i < 8; ++i) tv[i] = *(const f32x4*)(wp + (size_t)(4 * (8 * hf + i)) * N);
#pragma unroll
        for (int i = 0; i < 8; ++i) { u32x2 w; w.x = pkbf(tv[i][0], tv[i][1]); w.y = pkbf(tv[i][2], tv[i][3]);
            *(LAS u32x2*)(scr + ((lane >> 4) + 4 * (8 * hf + i)) * TP + (lane & 15) * 8) = w; }
        asm volatile("" ::: "memory");
    }
    LDS_WAIT(); asm volatile("" ::: "memory");
    const int g = lane >> 4, p = lane & 15;
#pragma unroll
    for (int it = 0; it < 8; ++it) {
        const int cq = it & 3, kq = (it >> 2) * 4 + g;
        const LAS unsigned char* a = scr + (8 * kq + (p >> 2)) * TP + (16 * cq + 4 * (p & 3)) * 2;
        const attn_body::s16x4 lo = attn_body::vtr((attn_body::lds_cptr)a), hi4 = attn_body::vtr((attn_body::lds_cptr)(a + 4 * TP));
        u32x4 o; o.x = (unsigned)(unsigned short)lo[0] | ((unsigned)(unsigned short)lo[1] << 16); o.y = (unsigned)(unsigned short)lo[2] | ((unsigned)(unsigned short)lo[3] << 16);
        o.z = (unsigned)(unsigned short)hi4[0] | ((unsigned)(unsigned short)hi4[1] << 16); o.w = (unsigned)(unsigned short)hi4[2] | ((unsigned)(unsigned short)hi4[3] << 16);
        *(u32x4*)(WT + (size_t)inv(c0 + 16 * cq + p) * ldw + k0 + 8 * kq) = o;
    }
    LDS_WAIT(); asm volatile("" ::: "memory");
}
template <class InvMap>
__device__ __forceinline__ void transpose_tile64_fp8(const float* W, int N, unsigned char* WT, int ldw, LAS unsigned char* scr, int k0, int c0, int lane, InvMap inv, float scale) {
    constexpr int TP = 136;
    asm volatile("" : "+v"(lane));
    const float* wp = W + (size_t)(k0 + (lane >> 4)) * N + c0 + (lane & 15) * 4;
#pragma unroll
    for (int hf = 0; hf < 2; ++hf) {
        f32x4 tv[8];
#pragma unroll
        for (int i = 0; i < 8; ++i) tv[i] = __builtin_nontemporal_load((const f32x4*)(wp + (size_t)(4 * (8 * hf + i)) * N));
#pragma unroll
        for (int i = 0; i < 8; ++i) { u32x2 w; w.x = pkbf(tv[i][0], tv[i][1]); w.y = pkbf(tv[i][2], tv[i][3]);
            *(LAS u32x2*)(scr + ((lane >> 4) + 4 * (8 * hf + i)) * TP + (lane & 15) * 8) = w; }
        asm volatile("" ::: "memory");
    }
    LDS_WAIT(); asm volatile("" ::: "memory");
    const int g = lane >> 4, p = lane & 15;
#pragma unroll
    for (int cq = 0; cq < 4; ++cq) {
        const LAS unsigned char* a = scr + (16 * g + (p >> 2)) * TP + (16 * cq + 4 * (p & 3)) * 2;
        u32x4 o;
#pragma unroll
        for (int q4 = 0; q4 < 4; ++q4) { const attn_body::s16x4 t4 = attn_body::vtr((attn_body::lds_cptr)(a + 4 * q4 * TP));
            o[q4] = pkfp8x4(__uint_as_float(((unsigned)(unsigned short)t4[0]) << 16) * scale, __uint_as_float(((unsigned)(unsigned short)t4[1]) << 16) * scale,
                            __uint_as_float(((unsigned)(unsigned short)t4[2]) << 16) * scale, __uint_as_float(((unsigned)(unsigned short)t4[3]) << 16) * scale); }
        *(u32x4*)(WT + (size_t)inv(c0 + 16 * cq + p) * ldw + k0 + 16 * g) = o;
    }
    LDS_WAIT(); asm volatile("" ::: "memory");
}
struct InvIdent { __device__ __forceinline__ int operator()(int c) const { return c; } };
struct InvGu {
    __device__ __forceinline__ int operator()(int c) const { const int sgl = c & 1, idx = c >> 1; return 256 * (idx >> 7) + 128 * sgl + (idx & 127); } };
struct CmIdent { __device__ __forceinline__ int operator()(int p) const { return p; } };
struct CmWin {
    __device__ __forceinline__ int operator()(int P) const {
        if (P < 1024) { const int hbp = P >> 6, tile = hbp >> 2, slot = hbp & 3, hb = 8 * (tile >> 1) + 2 * slot + (tile & 1);
            const int p = P & 63, wcp = p >> 5, fq = (p & 31) >> 3, n = (p & 7) >> 2, j = p & 3; return hb * 64 + 32 * n + 16 * wcp + 4 * fq + j; }
        if (P < 3584) return P;
        return P + 8;
    }
};
struct CmGu {
    __device__ __forceinline__ int operator()(int P) const { const int pn = P >> 8, s = (P >> 7) & 1, i = P & 127; return 2 * (128 * pn + i) + s; }
};

__global__ void __launch_bounds__(NWAVES * 64, 2) hybrid_fwd(Args a) {
    extern __shared__ __attribute__((aligned(16))) unsigned char lds[];
    LAS unsigned char* L = (LAS unsigned char*)lds;
    const int tid = threadIdx.x, lane = tid & 63, wave = __builtin_amdgcn_readfirstlane(tid >> 6);
    const int G = gridDim.x, blk = blockIdx.x;
    const int gw = blk * NWAVES + wave, NGW = G * NWAVES;
    if (tid < 16) ((LAS unsigned*)(L + MISC_OFF))[tid] = 0u;
    LAS unsigned long long* ptab = (LAS unsigned long long*)(L + MISC_OFF + 64);
    if (tid == 0) {
        ptab[0] = (unsigned long long)a.x; ptab[1] = (unsigned long long)a.meta; ptab[2] = (unsigned long long)a.ln0_g; ptab[3] = (unsigned long long)a.ln0_b; ptab[4] = (unsigned long long)a.w_in;
        ptab[5] = (unsigned long long)a.conv_w; ptab[6] = (unsigned long long)a.conv_b; ptab[7] = (unsigned long long)a.gate_bias; ptab[8] = (unsigned long long)a.lq1; ptab[9] = (unsigned long long)a.lk1;
        ptab[10] = (unsigned long long)a.lq2; ptab[11] = (unsigned long long)a.lk2; ptab[12] = (unsigned long long)a.att_g; ptab[13] = (unsigned long long)a.ml_g; ptab[14] = (unsigned long long)a.w_att_out;
        ptab[15] = (unsigned long long)a.w_ml_out; ptab[16] = (unsigned long long)a.w_o; ptab[17] = (unsigned long long)a.ln1_g; ptab[18] = (unsigned long long)a.ln1_b; ptab[19] = (unsigned long long)a.w_router;
        ptab[20] = (unsigned long long)a.b_router; ptab[21] = (unsigned long long)a.w_gu; ptab[22] = (unsigned long long)a.b_gu; ptab[23] = (unsigned long long)a.w_down; ptab[24] = (unsigned long long)a.b_down;
        ptab[25] = (unsigned long long)a.ln2_g; ptab[26] = (unsigned long long)a.ln2_b; ptab[27] = (unsigned long long)a.out; ptab[28] = (unsigned long long)a.ws;
    }
    asm volatile("s_waitcnt lgkmcnt(0)" ::: "memory");
    __syncthreads();
    asm volatile("" ::: "memory");
#define PF(i) ((const float*)ldptr(ptab, (i)))
#define WSP ((unsigned char*)ldptr(ptab, 28))
#define DOUTP ((unsigned char*)ldptr(ptab, 27))
#define ctl ((unsigned*)(WSP + WS_CTL))
#define WinT ((bf16_t*)(WSP + WS_WIN))
#define WaT ((bf16_t*)(WSP + WS_WA))
#define WmT ((bf16_t*)(WSP + WS_WM))
#define WoT ((bf16_t*)(WSP + WS_WO))
#define ropec ((float*)(WSP + WS_ROPE))
#define ropes (ropec + TT * 32)
#define stats ((float*)(WSP + WS_STATS))
#define gates ((float*)(WSP + WS_GATES))
#define tok_e ((int*)(WSP + WS_TOKE))
#define tok_g ((float*)(WSP + WS_TOKG))
#define hist ((int*)(WSP + WS_HIST))
#define row_off ((int*)(WSP + WS_ROWOFF))
#define row_slot ((int*)(WSP + WS_ROWSLOT))
#define row_gate ((float*)(WSP + WS_ROWGATE))
#define tile_exp ((int*)(WSP + WS_TILEEXP))
#define Hb ((bf16_t*)(WSP + WS_H))
#define Z ((bf16_t*)(WSP + WS_Z))
#define Y ((bf16_t*)(WSP + WS_Y))
#define ACT ((bf16_t*)(WSP + WS_ACT))
#define Qc ((bf16_t*)(WSP + WS_QC))
#define Kc ((bf16_t*)(WSP + WS_KC))
#define Vc ((bf16_t*)(WSP + WS_VC))
#define TMPb ((bf16_t*)(WSP + WS_TMP))
#define MRGb ((bf16_t*)(WSP + WS_MRG))
#define GFb ((bf16_t*)(WSP + WS_GF))
#define YCb ((bf16_t*)(DOUTP + DO_YC))
#define Ob ((bf16_t*)(WSP + WS_O))
#define WguT ((bf16_t*)(DOUTP + DO_WGU))
#define WdnT ((bf16_t*)(DOUTP + DO_WDN))
#if !MK_PER_PHASE
    XcdBarrier bar = xcd_barrier_post(ctl + CW_BAR, (volatile LAS unsigned*)(L + MISC_OFF + 32));
#define GRID_BAR() xcd_barrier(bar)
#else
#define GRID_BAR() do {} while (0)
#endif
    const int lo = a.ph_lo, hi = a.ph_hi;
#if MK_PROBE == 2
    LAS unsigned* pdur = (LAS unsigned*)(L + MISC_OFF + 320);
    if (blk == 0 && tid == 0) { pdur[30] = (unsigned)__builtin_amdgcn_s_memrealtime(); pdur[31] = pdur[30]; pdur[29] = pdur[30]; for (int q_ = 16; q_ < 29; ++q_) pdur[q_] = 0u; }
#define PSTAMP(k) do { if (blk == 0 && tid == 0) { const unsigned now_ = (unsigned)__builtin_amdgcn_s_memrealtime(); pdur[k] = now_ - pdur[30]; pdur[30] = now_; } } while (0)
#define CSTAMP(k) do { if (blk == 0 && tid == 0) { const unsigned now_ = (unsigned)__builtin_amdgcn_s_memrealtime(); pdur[16 + (k)] += now_ - pdur[31]; pdur[31] = now_; } } while (0)
#else
#define PSTAMP(k) do {} while (0)
#define CSTAMP(k) do {} while (0)
#endif
#define IN(k) (lo <= (k) && (k) < hi)
#define BOTH(k) (IN(k) && IN((k) + 1))

    if (IN(0)) REPLOOP(0) {
        {   LAS float* scr = (LAS float*)(L + wave * 16384);
            constexpr int I_IN = 16 * (NZP / 32), I_A = 8 * 32, I_O = 16 * 32;
            constexpr int NIT = I_IN + 2 * I_A + I_O;
            for (int it = gw; it < NIT; it += NGW) {
                int r = it;
                if (r < I_IN) { const int tl_ = (r % (NZP / 32)) >> 3;
                    const bool f8_ = (tl_ != 0) && (tl_ != 2);
                    transpose_item(PF(4), 1024, NIN, WinT, scr, r / (NZP / 32), r % (NZP / 32), lane, CmWin(), f8_ ? 1024 : 0, f8_ ? WSP + WS_WIN8 : (unsigned char*)nullptr, FP8_SB1); continue; } r -= I_IN;
                if (r < I_A) { transpose_item(PF(14), 512, 1024, WaT, scr, r / 32, r % 32, lane, CmIdent(), 1024, (unsigned char*)WaT, FP8_SB3); continue; } r -= I_A;
                if (r < I_A) { transpose_item(PF(15), 512, 1024, WaT, scr, r / 32, r % 32, lane, CmIdent(), 1024, (unsigned char*)WaT + 512, FP8_SB3); continue; } r -= I_A;
                transpose_item(PF(16), 1024, 1024, WoT, scr, r / 32, r % 32, lane, CmIdent(), 1024, (unsigned char*)WoT, FP8_SB3);
            }
        }
        for (int i = blk * 512 + tid; i < TT * 32; i += G * 512) {
            const int t = i >> 5, f = i & 31;
            const double inv = exp2(-(double)f * (13.287712379549449 / 32.0));
            const double rev = (double)t * inv * 0.15915494309189535;
            const float fr = (float)(rev - floor(rev));
            ropec[i] = __builtin_amdgcn_cosf(fr); ropes[i] = __builtin_amdgcn_sinf(fr);
        }
        __syncthreads();
        LAS float* wg = (LAS float*)L;
        for (int k = tid; k < 1024; k += 512) {
            const f32x4 ga_ = *(const f32x4*)(PF(4) + (size_t)k * NIN + 3584), gb_ = *(const f32x4*)(PF(4) + (size_t)k * NIN + 3588);
            wg[0 * 1024 + k] = ga_[0]; wg[1 * 1024 + k] = ga_[1]; wg[2 * 1024 + k] = ga_[2]; wg[3 * 1024 + k] = ga_[3];
            wg[4 * 1024 + k] = gb_[0]; wg[5 * 1024 + k] = gb_[1]; wg[6 * 1024 + k] = gb_[2]; wg[7 * 1024 + k] = gb_[3]; }
        __syncthreads();
        {
            const float* xin = PF(0); const float* metap = PF(1); const float* gbias = PF(7);
            const float* g0p = PF(2); const float* b0p = PF(3);
            bf16_t* Hbp = Hb; float* gatesp = gates;
            unsigned char* H8p0 = WSP + WS_H8;
            auto ln_rows = [&](const int base, const bool meta) __attribute__((always_inline)) {
                f32x4 v[4][4]; float sm[4];
#pragma unroll
                for (int r = 0; r < 4; ++r) { const float* xr = (meta ? metap : xin) + (size_t)(base + r) * DM;
#pragma unroll
                    for (int j = 0; j < 4; ++j) v[r][j] = __builtin_nontemporal_load((const f32x4*)(xr + 4 * lane + 256 * j)); }
#pragma unroll
                for (int r = 0; r < 4; ++r) { float s = 0.f;
#pragma unroll
                    for (int j = 0; j < 4; ++j) s += (v[r][j][0] + v[r][j][1]) + (v[r][j][2] + v[r][j][3]);
                    sm[r] = s; }
                float mean[4], rstd[4];
#pragma unroll
                for (int r = 0; r < 4; ++r) mean[r] = wave_sum(sm[r]) * (1.f / DM);
#pragma unroll
                for (int r = 0; r < 4; ++r) { float s2 = 0.f;
#pragma unroll
                    for (int j = 0; j < 4; ++j) { const f32x4 d = v[r][j] - mean[r]; s2 += (d[0] * d[0] + d[1] * d[1]) + (d[2] * d[2] + d[3] * d[3]); }
                    sm[r] = s2; }
#pragma unroll
                for (int r = 0; r < 4; ++r) rstd[r] = 1.0f / sqrtf(wave_sum(sm[r]) * (1.f / DM) + LN_EPS);
                float gp[32];
#pragma unroll
                for (int q = 0; q < 32; ++q) gp[q] = 0.f;
#pragma unroll
                for (int j = 0; j < 4; ++j) {
                    const f32x4 ggj = *(const f32x4*)(g0p + 4 * lane + 256 * j), bbj = *(const f32x4*)(b0p + 4 * lane + 256 * j);
#pragma unroll
                    for (int r = 0; r < 4; ++r) { v[r][j] = (v[r][j] - mean[r]) * rstd[r] * ggj + bbj;
                        u32x2 w; w.x = pkbf(v[r][j][0], v[r][j][1]); w.y = pkbf(v[r][j][2], v[r][j][3]);
                        const unsigned w8 = pkfp8x4(v[r][j][0] * FP8_SA1, v[r][j][1] * FP8_SA1, v[r][j][2] * FP8_SA1, v[r][j][3] * FP8_SA1);
                        if (!meta) { *(u32x2*)(Hbp + (size_t)(base + r) * DM + 4 * lane + 256 * j) = w; *(unsigned*)(H8p0 + (size_t)(base + r) * DM + 4 * lane + 256 * j) = w8; }
                        else {
#pragma unroll 1
                            for (int bb_ = 0; bb_ < NB; ++bb_) { const size_t ro = (size_t)(NREAL + bb_ * NMETA + base + r) * DM + 4 * lane + 256 * j; *(u32x2*)(Hbp + ro) = w; *(unsigned*)(H8p0 + ro) = w8; } } }
#pragma unroll
                    for (int q = 0; q < 8; ++q) { const f32x4 wv = *(const LAS f32x4*)(wg + q * 1024 + 4 * lane + 256 * j);
#pragma unroll
                        for (int r = 0; r < 4; ++r) gp[r * 8 + q] += (v[r][j][0] * wv[0] + v[r][j][1] * wv[1]) + (v[r][j][2] * wv[2] + v[r][j][3] * wv[3]); }
                }
                const float gsum = xreduce32(gp, lane);
                int lane_o = lane; asm volatile("" : "+v"(lane_o));
                const int q_of_lane = (lane_o >> 1) & 7, r_of_lane = lane_o >> 4;
                const float gb = gbias[q_of_lane];
                if ((lane_o & 1) == 0) { float gv = gsum + gb;
                    if (q_of_lane >= 4) gv = (gv >= 0.f) ? -log1pf(expf(-gv)) : gv - log1pf(expf(gv));
                    if (!meta) gatesp[(size_t)(base + r_of_lane) * 8 + q_of_lane] = gv;
                    else {
#pragma unroll 1
                        for (int bb_ = 0; bb_ < NB; ++bb_) gatesp[(size_t)(NREAL + bb_ * NMETA + base + r_of_lane) * 8 + q_of_lane] = gv; } }
            };
            if (gw < NMETA / 4) ln_rows(gw * 4, true);
            for (int base = gw * 4; base < NREAL; base += NGW * 4) ln_rows(base, false);
        }
        __syncthreads();
        if (BOTH(0) || rep_ + 1 < REP_0) GRID_BAR();
    }
    PSTAMP(0);

    if (IN(1)) REPLOOP(1) {
        {
            pg8::Gemm g{Hb, WinT, DM, DM, 2, nullptr, nullptr, 0, 1, 0, 1};
            pg8::StaticOrder S; S.init(MROWS / 256, 2, G, blk);
            pg8::EpiZ E{Z, Qc, Kc, Vc, ropec, ropes, GFb, 1.0f};
            pg8::gemm_phase<0, pg8::EpiZ>(L, g, S, E); }
        {
            pg8::Gemm g{(const bf16_t*)(WSP + WS_H8), (const bf16_t*)(WSP + WS_WIN8), DM / 2, DM / 2, 20, nullptr, nullptr, 0, 1, 1, 2};
            pg8::StaticOrder S; S.init(MROWS / 256, 20, G, blk);
            pg8::EpiZ E{Z, Qc, Kc, Vc, ropec, ropes, GFb, 1.0f / (FP8_SA1 * FP8_SB1)};
            pg8::gemm_phase<0, pg8::EpiZ, false, true>(L, g, S, E); }
        if (BOTH(1) || rep_ + 1 < REP_1) GRID_BAR();
    }
    PSTAMP(1);

    if (IN(2)) {
        REPLOOP(2B) {
            constexpr int PQ = 136;
            LAS bf16_t* Qs = (LAS bf16_t*)L;
            LAS bf16_t* Ks = Qs + 128 * PQ;
            LAS bf16_t* VTs = Ks + 128 * PQ;
            LAS bf16_t* Cs = VTs + 144 * PQ;
            LAS float* fv = (LAS float*)(Cs + 144 * PQ);
            LAS float* v_a = fv;
            LAS float* v_M = fv + 128;
            LAS float* v_b = fv + 256;
            LAS float* v_w = fv + 384;
            LAS float* v_sc = fv + 512;
            LAS float* cw = fv + 528;
            const float* convw = PF(5); const float* convb = PF(6); const float* mlg = PF(13); const float* gatesp = gates;
            bf16_t* Zp = Z; bf16_t* YCp = YCb;
            for (int u = blk; u < NB * 4; u += G) {
                const int b = u >> 2, h = u & 3;
                __syncthreads();
                for (int i = tid; i < 5 * 256; i += 512) { const int j = i >> 8, c = i & 255; const int ch = (c < 128) ? (h * 128 + c) : (512 + h * 128 + (c - 128));
                    cw[i] = (j < 4) ? convw[j * 1024 + ch] : convb[ch]; }
                for (int i = tid; i < 144 * PQ; i += 512) { const int rr = i / PQ; VTs[i] = (rr == 128) ? (bf16_t)0x3f80 : (bf16_t)0; Cs[i] = 0; }
                if (tid == 0) v_sc[0] = 0.f;
                f32x4 Cst[9];
#pragma unroll
                for (int jt = 0; jt < 9; ++jt) Cst[jt] = (f32x4){0.f, 0.f, 0.f, 0.f};
                LAS float* gml_s = cw + 1280 + 384;
                int tid_o = tid; asm volatile("" : "+v"(tid_o));
#define ML_IDX() int tq_ = tid_o; asm volatile("" : "+v"(tq_)); const int dg = tq_ & 15, s0 = (tq_ >> 4) * 4, fr = tq_ & 15, quad = (tq_ >> 4) & 3; (void)dg; (void)s0; (void)fr; (void)quad;
                LAS bf16_t* halo = (LAS bf16_t*)(cw + 1280);
                for (int i = tid_o; i < 2 * 3 * 128; i += 512) halo[i] = 0;
                if (tid_o < 128) gml_s[tid_o] = mlg[h * 128 + tid_o];
                u32x4 rq[4], rk[4], rv[4]; float gx0 = 0.f, gx1 = 0.f, gi0 = -1e30f, gi1 = -1e30f;
#define ML_LBAR() asm volatile("s_waitcnt lgkmcnt(0)\n\ts_barrier" ::: "memory")
#define ML_LOADRAW(tc0) do { \
                    _Pragma("unroll") for (int i_ = 0; i_ < 4; ++i_) { const int t_ = (tc0) + s0 + i_; rq[i_] = (u32x4){0u, 0u, 0u, 0u}; rk[i_] = rq[i_]; rv[i_] = rq[i_]; \
                        if (t_ < TT) { const bf16_t* zr_ = Zp + (size_t)row_of(b, t_) * NZ + h * 128 + dg * 8; rq[i_] = *(const u32x4*)(zr_ + ZMQ); rk[i_] = *(const u32x4*)(zr_ + ZMK); rv[i_] = *(const u32x4*)(zr_ + ZMV); } } \
                    if (wave == 0) { const int ta_ = (tc0) + 2 * lane, tb_ = ta_ + 1; \
                        gx0 = (ta_ < TT) ? ld_agent_f(gatesp + (size_t)row_of(b, ta_) * 8 + 4 + h) : 0.f; gi0 = (ta_ < TT) ? ld_agent_f(gatesp + (size_t)row_of(b, ta_) * 8 + h) : -1e30f; \
                        gx1 = (tb_ < TT) ? ld_agent_f(gatesp + (size_t)row_of(b, tb_) * 8 + 4 + h) : 0.f; gi1 = (tb_ < TT) ? ld_agent_f(gatesp + (size_t)row_of(b, tb_) * 8 + h) : -1e30f; } } while (0)
                { ML_IDX(); ML_LOADRAW(0); }
                for (int c = 0; c < 33; ++c) {
                    const int t0 = c * 128;
                    ML_LBAR(); CSTAMP(0);
                    if (wave == 0) {
                        const float m_old0 = v_sc[0];
                        const float x0 = gx0, x1 = gx1, i0 = gi0, i1 = gi1;
                        const float sacc = wave_scan_add(x0 + x1);
                        const float ex = sacc - (x0 + x1);
                        const float b0 = ex + x0, b1 = b0 + x1;
                        const float a0 = i0 - b0, a1 = i1 - b1;
                        const float mx = wave_scan_max(fmaxf(a0, a1));
                        float exm = __shfl_up(mx, 1); if (lane == 0) exm = -INFINITY;
                        const float M0 = fmaxf(fmaxf(m_old0, exm), a0), M1 = fmaxf(M0, a1);
                        const float Ml = __shfl(M1, 63);
                        v_b[2 * lane] = b0; v_b[2 * lane + 1] = b1; v_a[2 * lane] = a0; v_a[2 * lane + 1] = a1; v_M[2 * lane] = M0; v_M[2 * lane + 1] = M1;
                        v_w[2 * lane] = (t0 + 2 * lane < TT) ? __expf(a0 - Ml) : 0.f; v_w[2 * lane + 1] = (t0 + 2 * lane + 1 < TT) ? __expf(a1 - Ml) : 0.f;
                        if (lane == 63) v_sc[1] = M1;
                    }
                    { ML_IDX();
#pragma unroll
                    for (int i = 0; i < 4; ++i) { *(LAS u32x4*)(Qs + (s0 + i) * PQ + dg * 8) = rq[i]; *(LAS u32x4*)(Ks + (s0 + i) * PQ + dg * 8) = rk[i]; }
#pragma unroll
                    for (int w2 = 0; w2 < 4; ++w2) {
                        const unsigned a0_ = rv[0][w2], a1_ = rv[1][w2], a2_ = rv[2][w2], a3_ = rv[3][w2];
                        u32x2 lo2, hi2; lo2.x = (a0_ & 0xffffu) | (a1_ << 16); lo2.y = (a2_ & 0xffffu) | (a3_ << 16);
                        hi2.x = (a0_ >> 16) | (a1_ & 0xffff0000u); hi2.y = (a2_ >> 16) | (a3_ & 0xffff0000u);
                        *(LAS u32x2*)(VTs + (dg * 8 + 2 * w2) * PQ + s0) = lo2; *(LAS u32x2*)(VTs + (dg * 8 + 2 * w2 + 1) * PQ + s0) = hi2;
                    } }
                    ML_LBAR(); CSTAMP(1);
                    {   ML_IDX();
                        u32x4 hq[3], hk[3];
#pragma unroll
                        for (int i = 0; i < 3; ++i) {
                            if (s0 > 0) { hq[i] = *(const LAS u32x4*)(Qs + (s0 - 3 + i) * PQ + dg * 8); hk[i] = *(const LAS u32x4*)(Ks + (s0 - 3 + i) * PQ + dg * 8); }
                            else { hq[i] = *(const LAS u32x4*)(halo + i * 128 + dg * 8); hk[i] = *(const LAS u32x4*)(halo + 384 + i * 128 + dg * 8); }
                        }
                        asm volatile("s_waitcnt lgkmcnt(0)" ::: "memory");
                        ML_LBAR(); CSTAMP(2);
                        u32x4 cq[4], ck[4];
#pragma unroll
                        for (int w2 = 0; w2 < 4; ++w2) {
                            int dgo = dg; asm volatile("" : "+v"(dgo));
                            f32x2 xq[7], xk[7];
#pragma unroll
                            for (int r = 0; r < 7; ++r) { const unsigned uq = (r < 3) ? hq[r < 3 ? r : 0][w2] : rq[r >= 3 ? r - 3 : 0][w2], uk = (r < 3) ? hk[r < 3 ? r : 0][w2] : rk[r >= 3 ? r - 3 : 0][w2];
                                xq[r] = (f32x2){bflo(uq), bfhi(uq)}; xk[r] = (f32x2){bflo(uk), bfhi(uk)}; }
                            const LAS f32x2* wp = (const LAS f32x2*)(cw + dgo * 8 + 2 * w2);
                            f32x2 wq[4], wk[4];
#pragma unroll
                            for (int j = 0; j < 4; ++j) { wq[j] = wp[j * 128]; wk[j] = wp[j * 128 + 64]; }
                            const f32x2 bq = wp[4 * 128], bk = wp[4 * 128 + 64];
#pragma unroll
                            for (int i = 0; i < 4; ++i) {
                                f32x2 aq = bq, ak = bk;
#pragma unroll
                                for (int j = 0; j < 4; ++j) { aq += wq[j] * xq[i + j]; ak += wk[j] * xk[i + j]; }
                                const bool live = (t0 + s0 + i < TT);
                                const float q0 = live ? aq[0] * sigmoidf_(aq[0]) : 0.f, q1 = live ? aq[1] * sigmoidf_(aq[1]) : 0.f;
                                const float k0 = live ? ak[0] * sigmoidf_(ak[0]) * 0.08838834764831845f : 0.f, k1 = live ? ak[1] * sigmoidf_(ak[1]) * 0.08838834764831845f : 0.f;
                                cq[i][w2] = pkbf(q0, q1); ck[i][w2] = pkbf(k0, k1);
                            }
                        }
#pragma unroll
                        for (int i = 0; i < 4; ++i) { *(LAS u32x4*)(Qs + (s0 + i) * PQ + dg * 8) = cq[i]; *(LAS u32x4*)(Ks + (s0 + i) * PQ + dg * 8) = ck[i]; }
                    if (s0 == 124) {
#pragma unroll
                        for (int i = 0; i < 3; ++i) { *(LAS u32x4*)(halo + i * 128 + dg * 8) = rq[i + 1]; *(LAS u32x4*)(halo + 384 + i * 128 + dg * 8) = rk[i + 1]; }
                    }
                    if (c + 1 < 33) ML_LOADRAW(t0 + 128);
                    }
                    ML_LBAR(); CSTAMP(3);
                    const float Mlast = v_sc[1], m_old = v_sc[0];
                    f32x4 St[8];
#pragma unroll
                    for (int j = 0; j < 8; ++j) St[j] = (f32x4){0.f, 0.f, 0.f, 0.f};
                    {   ML_IDX();
                        bf16x8 af[4];
#pragma unroll
                        for (int kk = 0; kk < 4; ++kk) af[kk] = *(const LAS bf16x8*)(Qs + (16 * wave + fr) * PQ + kk * 32 + quad * 8);
#pragma unroll
                        for (int j = 0; j < 8; ++j) if (j <= wave) {
#pragma unroll
                            for (int kk = 0; kk < 4; ++kk) { const bf16x8 bfv = *(const LAS bf16x8*)(Ks + (16 * j + fr) * PQ + kk * 32 + quad * 8);
                                St[j] = __builtin_amdgcn_mfma_f32_16x16x32_bf16(af[kk], bfv, St[j], 0, 0, 0); }
                        }
                    }
                    {   ML_IDX();
                        const float w_old = __expf(m_old - Mlast);
#pragma unroll
                        for (int jt = 0; jt < 9; ++jt) Cst[jt] = Cst[jt] * w_old;
#pragma unroll
                        for (int kk = 0; kk < 4; ++kk) {
                            const int rb = 32 * kk + 8 * quad;
                            const LAS bf16_t* kp = Ks + (rb + (fr >> 2)) * PQ + 16 * wave + 4 * (fr & 3);
                            const attn_body::s16x4 lo = attn_body::vtr((attn_body::lds_cptr)kp), hi4 = attn_body::vtr((attn_body::lds_cptr)(kp + 4 * PQ));
                            const f32x4 w0 = *(const LAS f32x4*)(v_w + rb), w1 = *(const LAS f32x4*)(v_w + rb + 4);
                            float kf[8];
#pragma unroll
                            for (int q = 0; q < 4; ++q) { kf[q] = __uint_as_float(((unsigned)(unsigned short)lo[q]) << 16) * w0[q]; kf[4 + q] = __uint_as_float(((unsigned)(unsigned short)hi4[q]) << 16) * w1[q]; }
                            u32x4 kw; kw.x = pkbf(kf[0], kf[1]); kw.y = pkbf(kf[2], kf[3]); kw.z = pkbf(kf[4], kf[5]); kw.w = pkbf(kf[6], kf[7]);
                            const bf16x8 bk = __builtin_bit_cast(bf16x8, kw);
#pragma unroll
                            for (int jt = 0; jt < 9; ++jt) { const bf16x8 av = *(const LAS bf16x8*)(VTs + (16 * jt + fr) * PQ + kk * 32 + quad * 8);
                                Cst[jt] = __builtin_amdgcn_mfma_f32_16x16x32_bf16(av, bk, Cst[jt], 0, 0, 0); }
                        }
                    }
                    ML_LBAR(); CSTAMP(4);
                    {   ML_IDX();
                        float Ms[4];
#pragma unroll
                        for (int jj = 0; jj < 4; ++jj) Ms[jj] = v_M[16 * wave + 4 * quad + jj];
#pragma unroll
                        for (int j = 0; j < 8; ++j) {
                            const int r = 16 * j + fr; const float ar = v_a[r];
#pragma unroll
                            for (int jj = 0; jj < 4; ++jj) { const int sx = 16 * wave + 4 * quad + jj;
                                const float ev = __builtin_amdgcn_exp2f(fminf(ar - Ms[jj], 0.f) * 1.4426950408889634f);
                                const float w = (j <= wave && r <= sx) ? St[j][jj] * ev : 0.f;
                                Ks[sx * PQ + r] = (bf16_t)(pkbf(w, 0.f) & 0xffffu); }
                        }
                    }
                    ML_LBAR(); CSTAMP(5);
                    float hv[8][4];
                    {   ML_IDX();
                        bf16x8 af[4], as_[4];
#pragma unroll
                        for (int kk = 0; kk < 4; ++kk) { af[kk] = *(const LAS bf16x8*)(Qs + (16 * wave + fr) * PQ + kk * 32 + quad * 8); as_[kk] = *(const LAS bf16x8*)(Ks + (16 * wave + fr) * PQ + kk * 32 + quad * 8); }
                        float winter[4], rd[4], ssq[4];
                        {   f32x4 n1 = (f32x4){0.f, 0.f, 0.f, 0.f}, n2 = n1;
#pragma unroll
                            for (int kk = 0; kk < 4; ++kk) { const bf16x8 bc = *(const LAS bf16x8*)(Cs + (128 + fr) * PQ + kk * 32 + quad * 8); const bf16x8 bvv = *(const LAS bf16x8*)(VTs + (128 + fr) * PQ + kk * 32 + quad * 8);
                                n1 = __builtin_amdgcn_mfma_f32_16x16x32_bf16(af[kk], bc, n1, 0, 0, 0); n2 = __builtin_amdgcn_mfma_f32_16x16x32_bf16(as_[kk], bvv, n2, 0, 0, 0); }
#pragma unroll
                            for (int jj = 0; jj < 4; ++jj) { const int sx = 16 * wave + 4 * quad + jj; const float Ms = v_M[sx]; winter[jj] = __expf(m_old - Ms);
                                float den = winter[jj] * n1[jj] + n2[jj];
                                den = __shfl(den, lane & 48);
                                rd[jj] = 1.0f / fmaxf(fabsf(den), __expf(-(v_b[sx] + Ms))); ssq[jj] = 0.f; }
                        }
#pragma unroll
                        for (int g2 = 0; g2 < 2; ++g2) {
                            f32x4 n1[4], n2[4];
#pragma unroll
                            for (int q = 0; q < 4; ++q) { n1[q] = (f32x4){0.f, 0.f, 0.f, 0.f}; n2[q] = n1[q]; }
#pragma unroll
                            for (int kk = 0; kk < 4; ++kk)
#pragma unroll
                                for (int q = 0; q < 4; ++q) { const int jt = 4 * g2 + q;
                                    const bf16x8 bc = *(const LAS bf16x8*)(Cs + (16 * jt + fr) * PQ + kk * 32 + quad * 8); const bf16x8 bvv = *(const LAS bf16x8*)(VTs + (16 * jt + fr) * PQ + kk * 32 + quad * 8);
                                    n1[q] = __builtin_amdgcn_mfma_f32_16x16x32_bf16(af[kk], bc, n1[q], 0, 0, 0); n2[q] = __builtin_amdgcn_mfma_f32_16x16x32_bf16(as_[kk], bvv, n2[q], 0, 0, 0); }
#pragma unroll
                            for (int q = 0; q < 4; ++q)
#pragma unroll
                                for (int jj = 0; jj < 4; ++jj) { const float x = (winter[jj] * n1[q][jj] + n2[q][jj]) * rd[jj]; hv[4 * g2 + q][jj] = x; ssq[jj] += x * x; }
                        }
#pragma unroll
                        for (int jj = 0; jj < 4; ++jj) { const float rs = 1.0f / sqrtf(row_sum16(ssq[jj]) * (1.f / 128.f) + LN_EPS);
#pragma unroll
                            for (int jt = 0; jt < 8; ++jt) hv[jt][jj] *= rs * gml_s[16 * jt + fr]; }
                    }
                    ML_LBAR(); CSTAMP(6);
                    u32x2 rmo[4];
                    { ML_IDX();
#pragma unroll
                    for (int i = 0; i < 4; ++i) { const int t = t0 + s0 + i; rmo[i] = (u32x2){0u, 0u};
                        if (t >= NMETA && t < TT) rmo[i] = *(const u32x2*)((const unsigned char*)(Zp + (size_t)row_of(b, t) * NZ + ZMO) + h * 128 + dg * 8); }
#pragma unroll
                    for (int jt = 0; jt < 8; ++jt)
#pragma unroll
                        for (int jj = 0; jj < 4; ++jj) Qs[(16 * wave + 4 * quad + jj) * PQ + 16 * jt + fr] = (bf16_t)(pkbf(hv[jt][jj], 0.f) & 0xffffu);
#pragma unroll
                    for (int jt = 0; jt < 9; ++jt)
#pragma unroll
                        for (int jj = 0; jj < 4; ++jj) Cs[(16 * jt + 4 * quad + jj) * PQ + 16 * wave + fr] = (bf16_t)(pkbf(Cst[jt][jj], 0.f) & 0xffffu);
                    if (tid == 0) v_sc[0] = v_b[127] + Mlast;
                    }
                    ML_LBAR(); CSTAMP(7);
                    { ML_IDX();
#pragma unroll
                    for (int i = 0; i < 4; ++i) {
                        const int s = s0 + i, t = t0 + s;
                        if (t >= NMETA && t < TT) {
                            const u32x4 hw = *(const LAS u32x4*)(Qs + s * PQ + dg * 8);
                            const u32x2 mw = rmo[i]; constexpr float MS = FP8_SA3 / 255.0f;
                            u32x2 wy;
                            wy.x = pkfp8x4(ub(mw.x, 0) * MS * bflo(hw.x), ub(mw.x, 1) * MS * bfhi(hw.x), ub(mw.x, 2) * MS * bflo(hw.y), ub(mw.x, 3) * MS * bfhi(hw.y));
                            wy.y = pkfp8x4(ub(mw.y, 0) * MS * bflo(hw.z), ub(mw.y, 1) * MS * bfhi(hw.z), ub(mw.y, 2) * MS * bflo(hw.w), ub(mw.y, 3) * MS * bfhi(hw.w));
                            *(u32x2*)((unsigned char*)YCp + (size_t)row_of(b, t) * DM + 512 + h * 128 + dg * 8) = wy;
                        }
                    } }
                }
            }
        }
#undef ML_LOADRAW
#undef ML_LBAR
#undef ML_IDX
        PSTAMP(13);
        __syncthreads();
        REPLOOP(2A) {
            LAS int* tkt = (LAS int*)(L + MISC_OFF + 16);
            bf16_t* Qcp = Qc; bf16_t* Kcp = Kc; bf16_t* Vcp = Vc; bf16_t* YCp2 = YCb; unsigned* tctr = ctl + CW_TICKET + 64 * rep_;
            const float* attg = PF(12); unsigned char* parkb = WSP + WS_O;
            float lam;
            { const float p1 = wave_sum(PF(8)[lane] * PF(9)[lane]), p2 = wave_sum(PF(10)[lane] * PF(11)[lane]); lam = expf(p1) - expf(p2) + LAMBDA_INIT; }
            const float* wgu = PF(21); const float* wdn = PF(23); bf16_t* WguTp = WguT; bf16_t* WdnTp = WdnT;
            constexpr int NATT = NB * 4 * 16, NJOB = NE * 16;
            int nextT = 0;
            if (tid == 0) nextT = (int)__hip_atomic_fetch_add(tctr, 1u, RLX_AGENT);
            for (;;) {
                __syncthreads();
                if (tid == 0) { *tkt = nextT; nextT = (int)__hip_atomic_fetch_add(tctr, 1u, RLX_AGENT); }
                __syncthreads();
                const int T = __builtin_amdgcn_readfirstlane(*tkt);
                if (T >= NATT + NJOB) break;
                int Lidx;
                { const int q = T / 3, r = T - q * 3;
                  if (q < NJOB) {
                      if (r == 2) {
                          const int e = q >> 4, kb = q & 15; LAS unsigned char* scr = L + wave * 17408;
                          for (int it = wave; it < 48; it += NWAVES) {
                              if (it < 32) transpose_tile64_fp8(wgu + (size_t)e * 1024 * 2048, 2048, (unsigned char*)WguTp + (size_t)e * 2048 * 1024, 1024, scr, 64 * kb, 64 * it, lane, InvGu(), FP8_SB1);
                              else transpose_tile64_fp8(wdn + (size_t)e * 1024 * 1024, 1024, (unsigned char*)WdnTp + (size_t)e * 1024 * 1024, 1024, scr, 64 * kb, 64 * (it - 32), lane, InvIdent(), FP8_SB2);
                          }
                          continue;
                      }
                      Lidx = q * 2 + r;
                  } else Lidx = T - NJOB; }
                const int bh = Lidx & 63, qb = 15 - (Lidx >> 6);
                const int b = bh >> 2, h = bh & 3;
                int tid_p = tid; asm volatile("" : "+v"(tid_p));
                u32x4* parkp = (u32x4*)parkb + ((size_t)blk * 512 + tid_p) * 8;
                attn_body::attn4_unit<8>(qb, (const attn_body::bf16*)(Qcp + (size_t)(b * 8 + 2 * h) * TT * 64), (const attn_body::bf16*)(Kcp + (size_t)(b * 8 + 2 * h) * TT * 64), (long)TT * 64,
                                         (const attn_body::bf16*)(Vcp + (size_t)(b * 4 + h) * TT * 128), YCp2, b * SEQ, h * 128, lam, attg, parkp, (char*)lds);
            }
        }
        __syncthreads();
        if (BOTH(2)) GRID_BAR();
    }
    PSTAMP(2);

    PSTAMP(3);

    if (IN(4)) REPLOOP(4) {
        {   pg8::Gemm g{YCb, WaT, DM / 2, DM / 2, 4, nullptr, nullptr, 0};
            pg8::StaticOrder S; S.init(NREAL / 256, 4, G, blk);
            pg8::EpiGateFused E{GFb, MRGb, FP8_SA4 / (255.0f * FP8_SA3 * FP8_SB3)};
            pg8::gemm_phase<0, pg8::EpiGateFused, true, true>(L, g, S, E); }
        if (BOTH(4) || rep_ + 1 < REP_4) GRID_BAR();
    }
    PSTAMP(4);

    if (IN(5)) REPLOOP(5) {
        pg8::Gemm g{MRGb, WoT, DM / 2, DM / 2, 4, nullptr, nullptr, 0};
        pg8::StaticOrder S; S.init(NREAL / 256, 4, G, blk);
        pg8::EpiStoreBf16 E{TMPb, DM, 1.0f / (FP8_SA4 * FP8_SB3)};
        pg8::gemm_phase<0, pg8::EpiStoreBf16, false, true>(L, g, S, E);
        if (BOTH(5) || rep_ + 1 < REP_5) GRID_BAR();
    }
    PSTAMP(5);

    constexpr int NPART = 256, RPP = NREAL / NPART;
    static_assert(NPART * RPP == NREAL, "partitions");
    if (IN(6)) REPLOOP(6) {
        LAS float* wrT = (LAS float*)L;
        LAS int* hcnt = (LAS int*)(L + 131072);
        { const float* wr = PF(19);
          for (int i = tid; i < 8 * 1024; i += 512) { const int k = i & 1023, q4 = i >> 10; const f32x4 v = *(const f32x4*)(wr + k * 32 + 4 * q4);
              wrT[(4 * q4 + 0) * 1024 + k] = v[0]; wrT[(4 * q4 + 1) * 1024 + k] = v[1]; wrT[(4 * q4 + 2) * 1024 + k] = v[2]; wrT[(4 * q4 + 3) * 1024 + k] = v[3]; } }
        const bf16_t* mixp = TMPb;
        const float* g1p = PF(17); const float* b1p = PF(18);
        const float brt = PF(20)[(lane >> 1) & 31];
        bf16_t* Hbp = Hb; int* tokE = tok_e; float* tokG = tok_g; int* histp = hist; unsigned char* H8p = WSP + WS_H8;
        for (int part = blk; part < NPART; part += G) {
            __syncthreads();
            if (tid < 32) hcnt[tid] = 0;
            __syncthreads();
            const int rbeg = part * RPP, rend = rbeg + RPP;
            constexpr int RPW = (RPP + NWAVES - 1) / NWAVES;
            const int wbeg = rbeg + wave * RPW, wend = (wbeg + RPW < rend) ? wbeg + RPW : rend;
            u32x2 nh0[4], nh1[4], nx0[4], nx1[4];
#define P6_LOAD(r_) do { int lq_ = lane; asm volatile("" : "+v"(lq_)); const int ra_ = (r_), rb_ = ((r_) + 1 < wend) ? (r_) + 1 : (r_); \
                _Pragma("unroll") for (int j = 0; j < 4; ++j) { nh0[j] = *(const u32x2*)(Hbp + (size_t)ra_ * DM + 4 * lq_ + 256 * j); nh1[j] = *(const u32x2*)(Hbp + (size_t)rb_ * DM + 4 * lq_ + 256 * j); \
                    nx0[j] = *(const u32x2*)(mixp + (size_t)ra_ * DM + 4 * lq_ + 256 * j); nx1[j] = *(const u32x2*)(mixp + (size_t)rb_ * DM + 4 * lq_ + 256 * j); } } while (0)
            if (wbeg < wend) P6_LOAD(wbeg);
            for (int row = wbeg; row < wend; row += 2) {
                int lane_o = lane; asm volatile("" : "+v"(lane_o));
                const bool two = (row + 1 < wend);
                const int row1 = two ? row + 1 : row;
                f32x4 v0[4], v1[4]; float s0 = 0.f, s1 = 0.f;
#pragma unroll
                for (int j = 0; j < 4; ++j) {
                    const u32x2 h0 = nh0[j], h1_ = nh1[j], x0 = nx0[j], x1 = nx1[j];
                    v0[j] = (f32x4){bflo(h0.x), bfhi(h0.x), bflo(h0.y), bfhi(h0.y)} * DN_ALPHA + (f32x4){bflo(x0.x), bfhi(x0.x), bflo(x0.y), bfhi(x0.y)};
                    v1[j] = (f32x4){bflo(h1_.x), bfhi(h1_.x), bflo(h1_.y), bfhi(h1_.y)} * DN_ALPHA + (f32x4){bflo(x1.x), bfhi(x1.x), bflo(x1.y), bfhi(x1.y)};
                }
                asm volatile("" ::: "memory");
                if (row + 2 < wend) P6_LOAD(row + 2);
#pragma unroll
                for (int j = 0; j < 4; ++j) { s0 += (v0[j][0] + v0[j][1]) + (v0[j][2] + v0[j][3]); s1 += (v1[j][0] + v1[j][1]) + (v1[j][2] + v1[j][3]); }
                const float mean0 = wave_sum(s0) * (1.f / DM), mean1 = wave_sum(s1) * (1.f / DM); float q0 = 0.f, q1 = 0.f;
#pragma unroll
                for (int j = 0; j < 4; ++j) { const f32x4 d0 = v0[j] - mean0, d1 = v1[j] - mean1;
                    q0 += (d0[0] * d0[0] + d0[1] * d0[1]) + (d0[2] * d0[2] + d0[3] * d0[3]); q1 += (d1[0] * d1[0] + d1[1] * d1[1]) + (d1[2] * d1[2] + d1[3] * d1[3]); }
                const float rstd0 = 1.0f / sqrtf(wave_sum(q0) * (1.f / DM) + LN_EPS), rstd1 = 1.0f / sqrtf(wave_sum(q1) * (1.f / DM) + LN_EPS);
#pragma unroll
                for (int j = 0; j < 4; ++j) {
                    const f32x4 ggj = *(const f32x4*)(g1p + 4 * lane_o + 256 * j), bbj = *(const f32x4*)(b1p + 4 * lane_o + 256 * j);
                    v0[j] = (v0[j] - mean0) * rstd0 * ggj + bbj; v1[j] = (v1[j] - mean1) * rstd1 * ggj + bbj;
                    u32x2 w; w.x = pkbf(v0[j][0], v0[j][1]); w.y = pkbf(v0[j][2], v0[j][3]);
                    *(u32x2*)(Hbp + (size_t)row * DM + 4 * lane_o + 256 * j) = w;
                    *(unsigned*)(H8p + (size_t)row * DM + 4 * lane_o + 256 * j) = pkfp8x4(v0[j][0] * FP8_SA1, v0[j][1] * FP8_SA1, v0[j][2] * FP8_SA1, v0[j][3] * FP8_SA1);
                    if (two) { w.x = pkbf(v1[j][0], v1[j][1]); w.y = pkbf(v1[j][2], v1[j][3]); *(u32x2*)(Hbp + (size_t)row1 * DM + 4 * lane_o + 256 * j) = w;
                        *(unsigned*)(H8p + (size_t)row1 * DM + 4 * lane_o + 256 * j) = pkfp8x4(v1[j][0] * FP8_SA1, v1[j][1] * FP8_SA1, v1[j][2] * FP8_SA1, v1[j][3] * FP8_SA1); }
                }
                float p0[32], p1[32];
#pragma unroll
                for (int e = 0; e < 32; ++e) {
                    f32x2 a0 = (f32x2){0.f, 0.f}, a1 = a0;
#pragma unroll
                    for (int j = 0; j < 4; ++j) { const f32x4 wv = *(const LAS f32x4*)(wrT + e * 1024 + 4 * lane_o + 256 * j);
                        const f32x2 wl = (f32x2){wv[0], wv[1]}, wh = (f32x2){wv[2], wv[3]};
                        a0 += (f32x2){v0[j][0], v0[j][1]} * wl; a0 += (f32x2){v0[j][2], v0[j][3]} * wh;
                        a1 += (f32x2){v1[j][0], v1[j][1]} * wl; a1 += (f32x2){v1[j][2], v1[j][3]} * wh; }
                    p0[e] = a0[0] + a0[1]; p1[e] = a1[0] + a1[1];
                    if ((e & 3) == 3) __builtin_amdgcn_sched_barrier(0);
                }
                float lg0 = xreduce32(p0, lane_o) + brt, lg1 = xreduce32(p1, lane_o) + brt;
#pragma unroll
                for (int rr = 0; rr < 2; ++rr) {
                    float lg = rr ? lg1 : lg0; const int rw = rr ? row1 : row;
                    float tv[4]; int ti[4];
#pragma unroll
                    for (int k = 0; k < 4; ++k) {
                        const float mx = wave_max(lg);
                        const unsigned long long bal = __ballot(lg == mx);
                        const int idx = (__ffsll((long long)bal) - 1) >> 1;
                        tv[k] = mx; ti[k] = idx;
                        if ((lane_o >> 1) == idx) lg = -INFINITY;
                    }
                    const float e1 = __expf(tv[1] - tv[0]), e2 = __expf(tv[2] - tv[0]), e3 = __expf(tv[3] - tv[0]);
                    const float inv = 1.0f / (1.0f + e1 + e2 + e3);
                    if (lane_o < 4 && (rr == 0 || two)) {
                        const int idx = (lane_o == 0) ? ti[0] : (lane_o == 1) ? ti[1] : (lane_o == 2) ? ti[2] : ti[3];
                        const float gv = ((lane_o == 0) ? 1.0f : (lane_o == 1) ? e1 : (lane_o == 2) ? e2 : e3) * inv;
                        tokE[(size_t)rw * 4 + lane_o] = idx; tokG[(size_t)rw * 4 + lane_o] = gv;
                        atomicAdd((int*)&hcnt[idx], 1);
                    }
                }
            }
#undef P6_LOAD
            __syncthreads();
            if (tid < 32) histp[part * 32 + tid] = hcnt[tid];
        }
        if (BOTH(6) || rep_ + 1 < REP_6) GRID_BAR();
    }
    PSTAMP(6);

    if (IN(7)) REPLOOP(7) {
        LAS int* cnt_s = (LAS int*)L; LAS int* base_s = cnt_s + 32; LAS int* pst_s = cnt_s + 64;
        LAS int* ptot = cnt_s + 128; LAS int* pbase = ptot + 512;
        LAS int* ccnt = pbase + 512;
        LAS int* ent = ccnt + 1024; LAS int* lrank = ent + RPP * 4 + 64;
        int* rowOff = row_off; int* rowSlot = row_slot; float* rowGate = row_gate; const int* histp = hist; const int* tokE = tok_e; const float* tokG = tok_g;
        for (int part = blk; part < NPART; part += G) {
            __syncthreads();
            { const int e = tid & 31, q = tid >> 5; int tot = 0, bs = 0;
#pragma unroll 4
              for (int b2 = q * 16; b2 < q * 16 + 16; ++b2) { const int v = ld_agent_i(histp + b2 * 32 + e); tot += v; bs += (b2 < part) ? v : 0; }
              ptot[q * 32 + e] = tot; pbase[q * 32 + e] = bs; }
            const int rbeg = part * RPP, n4 = RPP * 4;
            for (int i = tid; i < n4; i += 512) ent[i] = ld_agent_i(tokE + (size_t)rbeg * 4 + i);
            __syncthreads();
            if (tid < 32) { int tot = 0, bs = 0;
#pragma unroll
                for (int q = 0; q < 16; ++q) { tot += ptot[q * 32 + tid]; bs += pbase[q * 32 + tid]; }
                cnt_s[tid] = tot; base_s[tid] = bs; }
            constexpr int NCH = (RPP * 4 + 63) / 64;
            for (int c = wave; c < NCH; c += NWAVES) {
                const int i = 64 * c + lane; const int my = (i < n4) ? ent[i] : -1; int lr = 0;
#pragma unroll 4
                for (int e = 0; e < 32; ++e) { const unsigned long long b = __ballot(my == e);
                    if (lane == e) ccnt[c * 32 + e] = __popcll(b);
                    if (my == e) lr = __popcll(b & ((1ull << lane) - 1ull)); }
                if (i < n4) lrank[i] = lr;
            }
            __syncthreads();
            if (tid == 0) { int p = 0; for (int e = 0; e < 32; ++e) { pst_s[e] = p; p += (cnt_s[e] + 255) & ~255; } pst_s[32] = p; }
            __syncthreads();
            if (tid < 32) { int run = pst_s[tid] + base_s[tid];
                for (int c = 0; c < NCH; ++c) { const int tmp = ccnt[c * 32 + tid]; ccnt[c * 32 + tid] = run; run += tmp; } }
            __syncthreads();
            for (int i = tid; i < n4; i += 512) { const int e = ent[i]; const int pos = ccnt[(i >> 6) * 32 + e] + lrank[i];
                rowOff[pos] = (rbeg + (i >> 2)) * DM;        rowSlot[pos] = rbeg * 4 + i; rowGate[pos] = ld_agent_f(tokG + (size_t)rbeg * 4 + i); }
            if (part < 32) { const int e = part; for (int r = pst_s[e] + cnt_s[e] + tid; r < pst_s[e + 1]; r += 512) { rowOff[r] = 0; rowSlot[r] = NREAL * 4; rowGate[r] = 0.f; } }
            if (part == 0) { const int nT = pst_s[32] >> 8; int* te = tile_exp;
                for (int t = tid; t < nT; t += 512) { int e = 0; while (e < 31 && t * 256 >= pst_s[e + 1]) ++e; te[t] = e; }
                if (tid == 0) __hip_atomic_store((int*)(ctl + CW_NT), nT, RLX_AGENT); }
        }
        __syncthreads();
        if (BOTH(7) || rep_ + 1 < REP_7) GRID_BAR();
    }
    PSTAMP(7);

    {
        int nT = 0, TPC = 0;
        if (lo < 12 && hi > 8) { nT = __builtin_amdgcn_readfirstlane(ld_agent_i((const int*)(ctl + CW_NT))); TPC = nT; }
        if (IN(8)) REPLOOP(8) {
            pg8::Gemm g{(const bf16_t*)(WSP + WS_H8), WguT, DM, DM / 2, 8, row_off, tile_exp, 0};
            pg8::StaticOrder S; S.init(TPC, 8, G, blk);
            pg8::EpiAct E{ACT, PF(22), tile_exp, 0, 1.0f / (FP8_SA1 * FP8_SB1)};
            pg8::gemm_phase<1, pg8::EpiAct, false, true>(L, g, S, E);
            if (BOTH(8) || rep_ + 1 < REP_8) GRID_BAR();
        }
        PSTAMP(8);
        if (IN(9)) REPLOOP(9) {
            pg8::Gemm g{ACT, WdnT, FF / 2, FF / 2, 4, nullptr, tile_exp, 0};
            pg8::StaticOrder S; S.init(TPC, 4, G, blk);
            pg8::EpiDown E{Y, PF(24), tile_exp, row_slot, row_gate, 0, 1.0f / (FP8_SA2 * FP8_SB2)};
            pg8::gemm_phase<2, pg8::EpiDown, false, true>(L, g, S, E);
            if (BOTH(9) || rep_ + 1 < REP_9) GRID_BAR();
        }
        PSTAMP(9);
        PSTAMP(10);
        PSTAMP(11);
    }

    if (IN(12)) REPLOOP(12) {
        for (int row = gw; row < NREAL; row += NGW) {
            f32x4 v[4]; float s = 0.f;
#pragma unroll
            for (int j = 0; j < 4; ++j) {
                const u32x2 hw = __builtin_nontemporal_load((const u32x2*)(Hb + (size_t)row * DM + 4 * lane + 256 * j));
                f32x4 acc = (f32x4){bflo(hw.x), bfhi(hw.x), bflo(hw.y), bfhi(hw.y)} * DN_ALPHA;
                f32x4 ys = (f32x4){0.f, 0.f, 0.f, 0.f};
#pragma unroll
                for (int k = 0; k < 4; ++k) { const unsigned yw = __builtin_nontemporal_load((const unsigned*)((const unsigned char*)Y + ((size_t)row * 4 + k) * DM + 4 * lane + 256 * j));
                    const f32x2 ylo = __builtin_amdgcn_cvt_pk_f32_fp8((int)yw, false), yhi = __builtin_amdgcn_cvt_pk_f32_fp8((int)yw, true);
                    ys += (f32x4){ylo[0], ylo[1], yhi[0], yhi[1]}; }
                acc += ys * (1.0f / FP8_SY);
                v[j] = acc; s += (acc[0] + acc[1]) + (acc[2] + acc[3]);
            }
            const float mean = wave_sum(s) * (1.f / DM); float s2 = 0.f;
#pragma unroll
            for (int j = 0; j < 4; ++j) { const f32x4 d = v[j] - mean; s2 += (d[0] * d[0] + d[1] * d[1]) + (d[2] * d[2] + d[3] * d[3]); }
            const float rstd = 1.0f / sqrtf(wave_sum(s2) * (1.f / DM) + LN_EPS);
            float* orow = (float*)DOUTP + (size_t)row * DM;
#pragma unroll
            for (int j = 0; j < 4; ++j) {
                const f32x4 gg = *(const f32x4*)(PF(25) + 4 * lane + 256 * j), bb = *(const f32x4*)(PF(26) + 4 * lane + 256 * j);
                __builtin_nontemporal_store((v[j] - mean) * rstd * gg + bb, (f32x4*)(orow + 4 * lane + 256 * j));
            }
        }
#if MK_PROBE == 2
        __syncthreads();
        PSTAMP(12);
        if (blk == 0 && tid == 0) pdur[14] = pdur[30] - pdur[29];
        if (blk == 0 && tid == 0) { asm volatile("s_waitcnt vmcnt(0)" ::: "memory"); ((float*)DOUTP)[0] += (float)pdur[MK_PROBE_K] * (0.01f / MK_PROBE_DIV); }
#elif MK_PROBE
        __syncthreads();
        if (blk == 0 && tid == 0) { const unsigned cyc = __hip_atomic_load(ctl + CW_PROBE, RLX_AGENT), st = __hip_atomic_load(ctl + CW_PROBE + 1, RLX_AGENT);
            asm volatile("s_waitcnt vmcnt(0)" ::: "memory"); ((float*)DOUTP)[0] += (float)cyc / (float)(st ? st : 1u); }
#endif
    }
#undef IN
#undef BOTH
#undef GRID_BAR
}

constexpr int N_PHASES = 13;
extern "C" void kernel_launch(void* const* d_in, const int* in_sizes, int n_in, void* d_out, int out_size, void* d_ws, size_t ws_size, hipStream_t stream) {
    static int grid = 0;
    if (grid == 0) {
        if (n_in != 27 || ws_size < WS_END) { fprintf(stderr, "kernel_launch: unexpected n_in %d / ws_size %zu\n", n_in, ws_size); grid = -1; return; }
        int dev = 0, cus = 0;
        if (hipGetDevice(&dev) != hipSuccess || hipDeviceGetAttribute(&cus, hipDeviceAttributeMultiprocessorCount, dev) != hipSuccess) { grid = -1; return; }
        if (hipFuncSetAttribute((const void*)hybrid_fwd, hipFuncAttributeMaxDynamicSharedMemorySize, LDS_BYTES) != hipSuccess) { fprintf(stderr, "kernel_launch: hipFuncSetAttribute failed\n"); grid = -1; return; }
        int per_cu = 0;
        (void)hipOccupancyMaxActiveBlocksPerMultiprocessor(&per_cu, (const void*)hybrid_fwd, NWAVES * 64, LDS_BYTES);
        (void)hipGetLastError();
        grid = cus > 0 ? cus : 256;
    }
    if (grid < 0) return;
    (void)hipMemsetAsync((char*)d_ws + WS_CTL, 0, CTL_ZERO_BYTES, stream);
    Args a{};
    const float** fp = (const float**)&a;
    for (int i = 0; i < 27; ++i) fp[i] = (const float*)d_in[i];
    a.out = (float*)d_out; a.ws = (unsigned char*)d_ws;
#if MK_PER_PHASE
    for (int p = 0; p < N_PHASES; ++p) { a.ph_lo = p; a.ph_hi = p + 1; hipLaunchKernelGGL(hybrid_fwd, dim3(grid), dim3(NWAVES * 64), LDS_BYTES, stream, a); }
#else
    a.ph_lo = 0; a.ph_hi = N_PHASES;
    hipLaunchKernelGGL(hybrid_fwd, dim3(grid), dim3(NWAVES * 64), LDS_BYTES, stream, a);
#endif
}
```
